# Optimizing an MI355X kernel written in HIP

```python
import jax, jax.numpy as jnp
from jax import lax
import numpy as np

D_MODEL = 2048
BATCH = 8
SEQ = 2048
DEPTH = 1

MEM_LEN = 256
FOURIER_GROUPS = 4
FOURIER_GROUP_DIM = D_MODEL // 8
FOURIER_WIDTH = FOURIER_GROUPS * FOURIER_GROUP_DIM
N_HEADS = 32
N_KV_HEADS = 4
HEAD_DIM = D_MODEL // 32
ATTN_WIDTH = N_HEADS * HEAD_DIM
KV_WIDTH = N_KV_HEADS * HEAD_DIM
WINDOW = 128
ATT_BLOCK = WINDOW
MEM_HEADS = 4
MEM_HEAD_DIM = D_MODEL // 8
MEM_WIDTH = MEM_HEADS * MEM_HEAD_DIM
N_BRANCHES = 3
NUM_BUCKETS = 32
MAX_DISTANCE = 128
N_EXPERTS = 32
TOP_K = 4
D_FF = D_MODEL
SWIGLU_LIMIT = 7.0
SWIGLU_ALPHA = 1.702
MOE_BLOCK = 128
RMS_EPS = 1e-5
NEG_INF = -1e30

OFF_Q = FOURIER_WIDTH
OFF_K = OFF_Q + ATTN_WIDTH
OFF_V = OFF_K + KV_WIDTH
OFF_MQ = OFF_V + KV_WIDTH
OFF_GATE = OFF_MQ + MEM_WIDTH
IN_WIDTH = OFF_GATE + N_BRANCHES * D_MODEL

kernel_name = "hybrid_fnet_swa_memxattn_moe_encoder"


def rms_norm(x, g):
    x32 = x.astype(jnp.float32)
    y = x32 * lax.rsqrt(jnp.mean(x32 * x32, axis=-1, keepdims=True) + RMS_EPS)
    return (y * g.astype(jnp.float32)).astype(x.dtype)


def t5_bucket(rel):
    nb = NUM_BUCKETS // 2
    max_exact = nb // 2
    ret = (rel > 0).astype(jnp.int32) * nb
    n = jnp.abs(rel)
    nf = jnp.maximum(n, 1).astype(jnp.float32)
    large = max_exact + (jnp.log(nf / max_exact) / np.float32(np.log(MAX_DISTANCE / max_exact)) * (nb - max_exact)).astype(jnp.int32)
    large = jnp.minimum(large, nb - 1)
    return ret + jnp.where(n < max_exact, n, large)


def fourier_mix(f_in):
    b, s, _ = f_in.shape
    f = f_in.reshape(b, s, FOURIER_GROUPS, FOURIER_GROUP_DIM).astype(jnp.float32)
    f = jnp.real(jnp.fft.fft2(f, axes=(1, 3), norm="ortho"))
    return f.astype(f_in.dtype).reshape(b, s, FOURIER_WIDTH)


def windowed_gqa(q, k, v, sink, rel_table):
    b, s = q.shape[:2]
    nb = s // ATT_BLOCK
    grp = N_HEADS // N_KV_HEADS
    qb = q.reshape(b, nb, ATT_BLOCK, N_KV_HEADS, grp, HEAD_DIM)

    def band(t):
        tp = jnp.pad(t, ((0, 0), (ATT_BLOCK, ATT_BLOCK), (0, 0), (0, 0)))
        tp = tp.reshape(b, nb + 2, ATT_BLOCK, N_KV_HEADS, HEAD_DIM)
        return jnp.concatenate([tp[:, :-2], tp[:, 1:-1], tp[:, 2:]], axis=2)

    kb, vb = band(k), band(v)
    scores = jnp.einsum('bnqhgd,bnkhd->bnhgqk', qb, kb).astype(jnp.float32) * np.float32(HEAD_DIM ** -0.5)

    q_off = jnp.arange(ATT_BLOCK)[:, None]
    k_off = jnp.arange(3 * ATT_BLOCK)[None, :]
    rel = k_off - ATT_BLOCK - q_off
    bias = rel_table.astype(jnp.float32)[t5_bucket(rel)]
    bias = jnp.transpose(bias, (2, 0, 1)).reshape(N_KV_HEADS, grp, ATT_BLOCK, 3 * ATT_BLOCK)
    key_idx = jnp.arange(nb)[:, None] * ATT_BLOCK - ATT_BLOCK + k_off
    valid = (jnp.abs(rel) <= WINDOW)[None] & ((key_idx >= 0) & (key_idx < s))[:, None, :]
    scores = jnp.where(valid[None, :, None, None], scores + bias, NEG_INF)

    sink_l = sink.astype(jnp.float32).reshape(N_KV_HEADS, grp, 1, 1)
    m = jnp.maximum(jnp.max(scores, axis=-1, keepdims=True), sink_l)
    p = jnp.exp(scores - m)
    probs = p / (jnp.sum(p, axis=-1, keepdims=True) + jnp.exp(sink_l - m))
    out = jnp.einsum('bnhgqk,bnkhd->bnqhgd', probs.astype(v.dtype), vb)
    return out.reshape(b, s, ATTN_WIDTH)


def memory_xattn(qm, mem, w_mem_kv):
    b, s = qm.shape[:2]
    mlen = mem.shape[1]
    kv = mem @ w_mem_kv
    km = kv[..., :MEM_WIDTH].reshape(b, mlen, MEM_HEADS, MEM_HEAD_DIM)
    vm = kv[..., MEM_WIDTH:].reshape(b, mlen, MEM_HEADS, MEM_HEAD_DIM)
    qh = qm.reshape(b, s, MEM_HEADS, MEM_HEAD_DIM)
    scores = jnp.einsum('bqhd,bkhd->bhqk', qh, km).astype(jnp.float32) * np.float32(MEM_HEAD_DIM ** -0.5)
    probs = jax.nn.softmax(scores, axis=-1).astype(vm.dtype)
    return jnp.einsum('bhqk,bkhd->bqhd', probs, vm).reshape(b, s, MEM_WIDTH)


def sparse_moe(h, w_router, b_router, w_gu, b_gu, w_dn, b_dn):
    b, s, d = h.shape
    t = b * s
    hf = h.reshape(t, d)
    logits = (hf @ w_router + b_router).astype(jnp.float32)
    top_vals, top_idx = lax.top_k(logits, TOP_K)
    top_w = jax.nn.softmax(top_vals, axis=-1)

    n_assign = t * TOP_K
    e_flat = top_idx.reshape(-1).astype(jnp.int32)
    tok_flat = (jnp.arange(n_assign) // TOP_K).astype(jnp.int32)
    w_flat = top_w.reshape(-1)
    order = jnp.argsort(e_flat)
    e_sorted = e_flat[order]
    counts = jnp.bincount(e_flat, length=N_EXPERTS).astype(jnp.int32)
    starts = jnp.cumsum(counts) - counts
    padded = (counts + MOE_BLOCK - 1) // MOE_BLOCK * MOE_BLOCK
    padded_ends = jnp.cumsum(padded)
    padded_starts = padded_ends - padded
    dest = padded_starts[e_sorted] + (jnp.arange(n_assign, dtype=jnp.int32) - starts[e_sorted])

    n_slots = (-(-n_assign // MOE_BLOCK) + N_EXPERTS) * MOE_BLOCK
    n_blocks = n_slots // MOE_BLOCK
    slot_tok = jnp.full((n_slots,), t, jnp.int32).at[dest].set(tok_flat[order])
    slot_w = jnp.zeros((n_slots,), jnp.float32).at[dest].set(w_flat[order])
    block_e = jnp.minimum(jnp.searchsorted(padded_ends, jnp.arange(n_blocks, dtype=jnp.int32) * MOE_BLOCK, side='right'), N_EXPERTS - 1)

    h_pad = jnp.concatenate([hf, jnp.zeros((1, d), hf.dtype)], axis=0)
    xs = h_pad[slot_tok].reshape(n_blocks, MOE_BLOCK, d)

    def expert_block(args):
        xb, e = args
        gu = xb @ w_gu[e] + b_gu[e]
        gate = jnp.minimum(gu[:, ::2], SWIGLU_LIMIT)
        up = jnp.clip(gu[:, 1::2], -SWIGLU_LIMIT, SWIGLU_LIMIT)
        glu = gate * jax.nn.sigmoid(gate * SWIGLU_ALPHA)
        return ((up + 1.0) * glu) @ w_dn[e] + b_dn[e]

    ys = lax.map(expert_block, (xs, block_e)).reshape(n_slots, d)
    ys = ys * slot_w[:, None].astype(ys.dtype)
    out = jax.ops.segment_sum(ys, slot_tok, num_segments=t + 1)[:t]
    return out.reshape(b, s, d)


def setup_inputs(seed: int = 0) -> dict:
    key = jax.random.key(seed)
    ks = jax.random.split(key, 20)
    f32 = jnp.float32
    nrm = lambda k, shape, scale: jax.random.normal(k, shape, f32) * np.float32(scale)
    return {
        "x": nrm(ks[0], (BATCH, SEQ, D_MODEL), 1.0),
        "mem": nrm(ks[1], (BATCH, MEM_LEN, D_MODEL), 1.0),
        "rel_bias_table": nrm(ks[2], (NUM_BUCKETS, N_HEADS), 0.5),
        "norm1_g": 1.0 + nrm(ks[3], (DEPTH, D_MODEL), 0.01),
        "w_in": nrm(ks[4], (DEPTH, D_MODEL, IN_WIDTH), D_MODEL ** -0.5),
        "attn_sink": nrm(ks[5], (DEPTH, N_HEADS), 1.0),
        "w_mem_kv": nrm(ks[6], (DEPTH, D_MODEL, 2 * MEM_WIDTH), D_MODEL ** -0.5),
        "w_fourier_out": nrm(ks[7], (DEPTH, FOURIER_WIDTH, D_MODEL), FOURIER_WIDTH ** -0.5),
        "w_attn_out": nrm(ks[8], (DEPTH, ATTN_WIDTH, D_MODEL), ATTN_WIDTH ** -0.5),
        "w_mem_out": nrm(ks[9], (DEPTH, MEM_WIDTH, D_MODEL), MEM_WIDTH ** -0.5),
        "w_o": nrm(ks[10], (DEPTH, D_MODEL, D_MODEL), D_MODEL ** -0.5),
        "norm2_g": 1.0 + nrm(ks[11], (DEPTH, D_MODEL), 0.01),
        "w_router": nrm(ks[12], (DEPTH, D_MODEL, N_EXPERTS), D_MODEL ** -0.5),
        "b_router": nrm(ks[13], (DEPTH, N_EXPERTS), 0.01),
        "w_gate_up": nrm(ks[14], (DEPTH, N_EXPERTS, D_MODEL, 2 * D_FF), D_MODEL ** -0.5),
        "b_gate_up": nrm(ks[15], (DEPTH, N_EXPERTS, 2 * D_FF), 0.01),
        "w_down": nrm(ks[16], (DEPTH, N_EXPERTS, D_FF, D_MODEL), D_FF ** -0.5),
        "b_down": nrm(ks[17], (DEPTH, N_EXPERTS, D_MODEL), 0.01),
        "final_g": 1.0 + nrm(ks[18], (D_MODEL,), 0.01),
    }


def reference(x, mem, rel_bias_table, norm1_g, w_in, attn_sink, w_mem_kv, w_fourier_out, w_attn_out, w_mem_out, w_o, norm2_g, w_router, b_router, w_gate_up, b_gate_up, w_down, b_down, final_g):
    b, s, _ = x.shape
    for l in range(DEPTH):
        h = rms_norm(x, norm1_g[l])
        proj = h @ w_in[l]
        f_in, q, k, v, qm, gate_logits = jnp.split(proj, [OFF_Q, OFF_K, OFF_V, OFF_MQ, OFF_GATE], axis=-1)
        y_f = fourier_mix(f_in) @ w_fourier_out[l]
        att = windowed_gqa(q.reshape(b, s, N_HEADS, HEAD_DIM),
                           k.reshape(b, s, N_KV_HEADS, HEAD_DIM),
                           v.reshape(b, s, N_KV_HEADS, HEAD_DIM),
                           attn_sink[l], rel_bias_table)
        y_a = att @ w_attn_out[l]
        y_m = memory_xattn(qm, mem, w_mem_kv[l]) @ w_mem_out[l]
        gates = jax.nn.sigmoid(gate_logits.astype(jnp.float32)).astype(x.dtype).reshape(b, s, N_BRANCHES, D_MODEL)
        mixed = gates[:, :, 0] * y_f + gates[:, :, 1] * y_a + gates[:, :, 2] * y_m
        x = x + mixed @ w_o[l]
        x = x + sparse_moe(rms_norm(x, norm2_g[l]), w_router[l], b_router[l], w_gate_up[l], b_gate_up[l], w_down[l], b_down[l])
    return rms_norm(x, final_g)
```

```cpp
#include <hip/hip_runtime.h>
#include <stdint.h>
#include <string.h>

namespace nv {
constexpr int B_ = 8, S_ = 2048, DM = 2048, T_ = B_ * S_;
constexpr int MEM = 256;
constexpr int FW = 1024, FG = 4, FGD = 256;
constexpr int NH = 32, NKV = 4, HD = 64, AW = 2048, KVW = 256, WIN = 128;
constexpr int MH = 4, MHD = 256, MW = 1024;
constexpr int NE = 32, TOPK = 4, DFF = 2048;
constexpr int OFF_Q = FW, OFF_K = OFF_Q + AW, OFF_V = OFF_K + KVW, OFF_MQ = OFF_V + KVW, OFF_GATE = OFF_MQ + MW, INW = OFF_GATE + 3 * DM;
static_assert(INW == 10752, "in width");

__device__ __forceinline__ float wave_sum(float v) {
#pragma unroll
    for (int o = 32; o >= 1; o >>= 1) v += __shfl_xor(v, o);
    return v;
}
__device__ __forceinline__ float wave_max(float v) {
#pragma unroll
    for (int o = 32; o >= 1; o >>= 1) v = fmaxf(v, __shfl_xor(v, o));
    return v;
}

__global__ void __launch_bounds__(256) k_rmsnorm(const float* __restrict__ x, const float* __restrict__ g, float* __restrict__ out) {
    __shared__ float red[4];
    const int row = blockIdx.x, t = threadIdx.x;
    const float* xr = x + (size_t)row * DM;
    float v[8]; float ss = 0.f;
#pragma unroll
    for (int i = 0; i < 8; ++i) { v[i] = xr[t + i * 256]; ss += v[i] * v[i]; }
    ss = wave_sum(ss);
    if ((t & 63) == 0) red[t >> 6] = ss;
    __syncthreads();
    const float tot = red[0] + red[1] + red[2] + red[3];
    const float r = rsqrtf(tot * (1.0f / DM) + 1e-5f);
#pragma unroll
    for (int i = 0; i < 8; ++i) out[(size_t)row * DM + t + i * 256] = v[i] * r * g[t + i * 256];
}

struct GP {
    const float* A; const float* B; float* C; const float* bias; const float* R;
    const int* cnt; const int* offs; const int* list;
    long long sA, sB, sC, sBias;
    int M, N, K, lda, ldb, ldc, ldr, pad;
    float alpha; int pad2;
};
__global__ void __launch_bounds__(256) k_sgemm(GP p) {
    __shared__ float As[16][68];
    __shared__ float Bs[16][68];
    const int z = blockIdx.z;
    int M = p.M; int crow0 = 0;
    if (p.cnt) { M = p.cnt[z]; crow0 = p.offs[z]; }
    const int m0 = blockIdx.y * 64, n0 = blockIdx.x * 64;
    if (m0 >= M) return;
    const float* A = p.A + (p.cnt ? 0 : (size_t)z * p.sA);
    const float* Bm = p.B + (size_t)z * p.sB;
    const int t = threadIdx.x, tx = t & 15, ty = t >> 4;
    const int ar = t >> 2, ak = (t & 3) * 4;
    const int bk = t >> 4, bn = (t & 15) * 4;
    const bool arow_ok = (m0 + ar) < M;
    size_t arow;
    if (p.cnt) { if (p.list) arow = arow_ok ? (size_t)(p.list[(size_t)z * T_ + m0 + ar] >> 2) : 0; else arow = (size_t)(crow0 + m0 + ar); }
    else arow = (size_t)(m0 + ar);
    const float* ap = A + arow * p.lda + ak;
    const float* bp = Bm + (size_t)bk * p.ldb + n0 + bn;
    float acc[4][4];
#pragma unroll
    for (int i = 0; i < 4; ++i)
#pragma unroll
        for (int j = 0; j < 4; ++j) acc[i][j] = 0.f;
    for (int k0 = 0; k0 < p.K; k0 += 16) {
        float4 av = arow_ok ? *(const float4*)(ap + k0) : make_float4(0.f, 0.f, 0.f, 0.f);
        float4 bv = *(const float4*)(bp + (size_t)k0 * p.ldb);
        __syncthreads();
        As[ak + 0][ar] = av.x; As[ak + 1][ar] = av.y; As[ak + 2][ar] = av.z; As[ak + 3][ar] = av.w;
        *(float4*)&Bs[bk][bn] = bv;
        __syncthreads();
#pragma unroll
        for (int kk = 0; kk < 16; ++kk) {
            const float4 a4 = *(const float4*)&As[kk][ty * 4];
            const float4 b4 = *(const float4*)&Bs[kk][tx * 4];
            const float a[4] = {a4.x, a4.y, a4.z, a4.w}, b[4] = {b4.x, b4.y, b4.z, b4.w};
#pragma unroll
            for (int i = 0; i < 4; ++i)
#pragma unroll
                for (int j = 0; j < 4; ++j) acc[i][j] += a[i] * b[j];
        }
    }
    float* C = p.C + (p.cnt ? 0 : (size_t)z * p.sC);
#pragma unroll
    for (int i = 0; i < 4; ++i) {
        const int m = m0 + ty * 4 + i;
        if (m >= M) continue;
        const size_t crow = (size_t)(crow0 + m);
#pragma unroll
        for (int j = 0; j < 4; ++j) {
            const int n = n0 + tx * 4 + j;
            float v = acc[i][j] * p.alpha;
            if (p.bias) v += p.bias[(size_t)z * p.sBias + n];
            if (p.R) v += p.R[crow * p.ldr + n];
            C[crow * p.ldc + n] = v;
        }
    }
}

__global__ void k_tables(float* Cc, float* Dm) {
    const size_t i = (size_t)blockIdx.x * blockDim.x + threadIdx.x;
    const size_t nC = 256 * 512, nD = (size_t)2048 * 4096;
    if (i < nC) {
        const int c = (int)(i / 512), n = (int)(i % 512);
        const int nn = n & 255; const int m = (c * nn) & 255;
        const double a = 2.0 * (double)m / 256.0;
        Cc[i] = (n < 256) ? (float)cospi(a) : (float)sinpi(a);
    }
    if (i < nD) {
        const int j = (int)(i / 4096), k = (int)(i % 4096);
        const int kk = k & 2047; const int m = (j * kk) & 2047;
        const double a = 2.0 * (double)m / 2048.0;
        const double sc = 1.0 / sqrt(2048.0 * 256.0);
        Dm[i] = (k < 2048) ? (float)(cospi(a) * sc) : (float)(-sinpi(a) * sc);
    }
}

__device__ __forceinline__ int t5_bucket(int rel) {
    const int n = rel < 0 ? -rel : rel;
    int b;
    if (n < 8) b = n; else if (n < 12) b = 8; else if (n < 16) b = 9; else if (n < 23) b = 10; else if (n < 32) b = 11;
    else if (n < 46) b = 12; else if (n < 64) b = 13; else if (n < 91) b = 14; else b = 15;
    return (rel > 0 ? 16 : 0) + b;
}

__global__ void __launch_bounds__(256) k_attn(const float* __restrict__ proj, const float* __restrict__ relb, const float* __restrict__ sink, float* __restrict__ att) {
    __shared__ float pl[4][320];
    const int w = threadIdx.x >> 6, lane = threadIdx.x & 63;
    const int gid = blockIdx.x * 4 + w;
    const int t = gid / NH, h = gid % NH, b = t / S_, s = t % S_, kvh = h / (NH / NKV);
    const float* q = proj + (size_t)t * INW + OFF_Q + h * HD;
    float sc[5]; float mx = -1e30f;
#pragma unroll
    for (int i = 0; i < 5; ++i) {
        const int jj = lane + 64 * i;
        const int rel = jj - WIN, j = s + rel;
        float v = -1e30f;
        if (jj <= 2 * WIN && j >= 0 && j < S_) {
            const float* k = proj + (size_t)(b * S_ + j) * INW + OFF_K + kvh * HD;
            float d = 0.f;
            for (int e = 0; e < HD; e += 4) { const float4 a = *(const float4*)(q + e), c = *(const float4*)(k + e); d += a.x * c.x + a.y * c.y + a.z * c.z + a.w * c.w; }
            v = d * 0.125f + relb[t5_bucket(rel) * NH + h];
        }
        sc[i] = v; mx = fmaxf(mx, v);
    }
    mx = wave_max(mx);
    const float sk = sink[h];
    mx = fmaxf(mx, sk);
    float sum = 0.f;
#pragma unroll
    for (int i = 0; i < 5; ++i) {
        const int jj = lane + 64 * i;
        const float pv = (sc[i] > -1e29f) ? __expf(sc[i] - mx) : 0.f;
        pl[w][jj] = pv; sum += pv;
    }
    sum = wave_sum(sum);
    const float inv = 1.0f / (sum + __expf(sk - mx));
    __syncthreads();
    float o = 0.f;
    for (int jj = 0; jj <= 2 * WIN; ++jj) {
        const int j = s + jj - WIN;
        if (j < 0 || j >= S_) continue;
        o += pl[w][jj] * proj[(size_t)(b * S_ + j) * INW + OFF_V + kvh * HD + lane];
    }
    att[(size_t)t * AW + h * HD + lane] = o * inv;
}

__global__ void __launch_bounds__(256) k_memattn(const float* __restrict__ proj, const float* __restrict__ kvm, float* __restrict__ xm) {
    __shared__ float pl[4][256];
    const int w = threadIdx.x >> 6, lane = threadIdx.x & 63;
    const int gid = blockIdx.x * 4 + w;
    const int t = gid / MH, mh = gid % MH, b = t / S_;
    const float* q = proj + (size_t)t * INW + OFF_MQ + mh * MHD;
    float sc[4]; float mx = -1e30f;
#pragma unroll
    for (int i = 0; i < 4; ++i) {
        const int j = lane + 64 * i;
        const float* k = kvm + (size_t)(b * MEM + j) * (2 * MW) + mh * MHD;
        float d = 0.f;
        for (int e = 0; e < MHD; e += 4) { const float4 a = *(const float4*)(q + e), c = *(const float4*)(k + e); d += a.x * c.x + a.y * c.y + a.z * c.z + a.w * c.w; }
        sc[i] = d * 0.0625f; mx = fmaxf(mx, sc[i]);
    }
    mx = wave_max(mx);
    float sum = 0.f;
#pragma unroll
    for (int i = 0; i < 4; ++i) { const float pv = __expf(sc[i] - mx); pl[w][lane + 64 * i] = pv; sum += pv; }
    sum = wave_sum(sum);
    const float inv = 1.0f / sum;
    __syncthreads();
    float o[4] = {0.f, 0.f, 0.f, 0.f};
    for (int j = 0; j < MEM; ++j) {
        const float pj = pl[w][j];
        const float* v = kvm + (size_t)(b * MEM + j) * (2 * MW) + MW + mh * MHD;
#pragma unroll
        for (int i = 0; i < 4; ++i) o[i] += pj * v[lane + 64 * i];
    }
#pragma unroll
    for (int i = 0; i < 4; ++i) xm[(size_t)t * MW + mh * MHD + lane + 64 * i] = o[i] * inv;
}

__global__ void k_mix(const float* __restrict__ proj, const float* __restrict__ yf, const float* __restrict__ ya, const float* __restrict__ ym, float* __restrict__ mixed) {
    const size_t i = (size_t)blockIdx.x * blockDim.x + threadIdx.x;
    if (i >= (size_t)T_ * DM) return;
    const size_t t = i / DM; const int c = (int)(i % DM);
    const float* gl = proj + t * INW + OFF_GATE;
    const float g0 = 1.0f / (1.0f + __expf(-gl[c])), g1 = 1.0f / (1.0f + __expf(-gl[DM + c])), g2 = 1.0f / (1.0f + __expf(-gl[2 * DM + c]));
    mixed[i] = g0 * yf[i] + g1 * ya[i] + g2 * ym[i];
}

__global__ void __launch_bounds__(256) k_router(const float* __restrict__ h2, const float* __restrict__ wr, const float* __restrict__ br,
                                                int* cnt, int* list, int* tope, int* toppos, float* topw) {
    const int w = threadIdx.x >> 6, lane = threadIdx.x & 63;
    const int t = blockIdx.x * 4 + w;
    const int e = lane & 31, half = lane >> 5;
    const float* hr = h2 + (size_t)t * DM + half * 1024;
    const float* wp = wr + (size_t)(half * 1024) * NE + e;
    float acc = 0.f;
    for (int k = 0; k < 1024; ++k) acc += hr[k] * wp[(size_t)k * NE];
    acc += __shfl_xor(acc, 32);
    float logit = acc + br[e];
    float vals[4]; int idxs[4];
    float cur = logit;
#pragma unroll
    for (int r = 0; r < 4; ++r) {
        float bv = cur; int bi = e;
#pragma unroll
        for (int o = 16; o >= 1; o >>= 1) {
            const float ov = __shfl_xor(bv, o); const int oi = __shfl_xor(bi, o);
            if (ov > bv || (ov == bv && oi < bi)) { bv = ov; bi = oi; }
        }
        vals[r] = bv; idxs[r] = bi;
        if (e == bi) cur = -3.0e38f;
    }
    const float e1 = __expf(vals[1] - vals[0]), e2 = __expf(vals[2] - vals[0]), e3 = __expf(vals[3] - vals[0]);
    const float inv = 1.0f / (1.0f + e1 + e2 + e3);
    const float ws[4] = {inv, e1 * inv, e2 * inv, e3 * inv};
    if (lane < 4) {
        const int ee = idxs[lane];
        const int pos = atomicAdd(&cnt[ee], 1);
        list[(size_t)ee * T_ + pos] = t * 4 + lane;
        tope[t * 4 + lane] = ee; toppos[t * 4 + lane] = pos; topw[t * 4 + lane] = ws[lane];
    }
}
__global__ void k_offs(const int* cnt, int* offs) {
    if (threadIdx.x == 0 && blockIdx.x == 0) { int a = 0; for (int e = 0; e < NE; ++e) { offs[e] = a; a += cnt[e]; } }
}
__global__ void k_swiglu(const float* __restrict__ gu, float* __restrict__ act) {
    const size_t i = (size_t)blockIdx.x * blockDim.x + threadIdx.x;
    if (i >= (size_t)T_ * TOPK * DFF) return;
    const size_t slot = i / DFF; const int f = (int)(i % DFF);
    const float gate = fminf(gu[slot * (2 * DFF) + 2 * f], 7.0f);
    const float up = fminf(fmaxf(gu[slot * (2 * DFF) + 2 * f + 1], -7.0f), 7.0f);
    const float glu = gate * (1.0f / (1.0f + __expf(-1.702f * gate)));
    act[i] = (up + 1.0f) * glu;
}
__global__ void __launch_bounds__(256) k_final(const float* __restrict__ x2, const float* __restrict__ ys, const int* __restrict__ tope, const int* __restrict__ toppos,
                                               const float* __restrict__ topw, const int* __restrict__ offs, const float* __restrict__ g, float* __restrict__ out) {
    __shared__ float red[4];
    const int row = blockIdx.x, t = threadIdx.x;
    float v[8]; float ss = 0.f;
#pragma unroll
    for (int i = 0; i < 8; ++i) v[i] = x2[(size_t)row * DM + t + i * 256];
    for (int k = 0; k < TOPK; ++k) {
        const size_t slot = (size_t)offs[tope[row * 4 + k]] + toppos[row * 4 + k];
        const float w = topw[row * 4 + k];
#pragma unroll
        for (int i = 0; i < 8; ++i) v[i] += w * ys[slot * DM + t + i * 256];
    }
#pragma unroll
    for (int i = 0; i < 8; ++i) ss += v[i] * v[i];
    ss = wave_sum(ss);
    if ((t & 63) == 0) red[t >> 6] = ss;
    __syncthreads();
    const float tot = red[0] + red[1] + red[2] + red[3];
    const float r = rsqrtf(tot * (1.0f / DM) + 1e-5f);
#pragma unroll
    for (int i = 0; i < 8; ++i) out[(size_t)row * DM + t + i * 256] = v[i] * r * g[t + i * 256];
}

static void gemm(hipStream_t st, const float* A, const float* B, float* C, int M, int N, int K, int lda, int ldb, int ldc,
                 int batch = 1, long long sA = 0, long long sB = 0, long long sC = 0, const float* bias = nullptr, long long sBias = 0,
                 const float* R = nullptr, int ldr = 0, const int* cnt = nullptr, const int* offs = nullptr, const int* list = nullptr) {
    GP p; memset(&p, 0, sizeof(p));
    p.A = A; p.B = B; p.C = C; p.bias = bias; p.R = R; p.cnt = cnt; p.offs = offs; p.list = list;
    p.sA = sA; p.sB = sB; p.sC = sC; p.sBias = sBias; p.M = M; p.N = N; p.K = K; p.lda = lda; p.ldb = ldb; p.ldc = ldc; p.ldr = ldr; p.alpha = 1.0f;
    dim3 grid(N / 64, (M + 63) / 64, batch);
    hipLaunchKernelGGL(k_sgemm, grid, dim3(256), 0, st, p);
}
}

extern "C" void kernel_launch(void* const* d_in, const int* in_sizes, int n_in, void* d_out, int out_size, void* d_ws, size_t ws_size, hipStream_t stream) {
    using namespace nv;
    const float* x = (const float*)d_in[0];
    const float* mem = (const float*)d_in[1];
    const float* relb = (const float*)d_in[2];
    const float* norm1_g = (const float*)d_in[3];
    const float* w_in = (const float*)d_in[4];
    const float* sink = (const float*)d_in[5];
    const float* w_mem_kv = (const float*)d_in[6];
    const float* w_fo = (const float*)d_in[7];
    const float* w_ao = (const float*)d_in[8];
    const float* w_mo = (const float*)d_in[9];
    const float* w_o = (const float*)d_in[10];
    const float* norm2_g = (const float*)d_in[11];
    const float* w_router = (const float*)d_in[12];
    const float* b_router = (const float*)d_in[13];
    const float* w_gu = (const float*)d_in[14];
    const float* b_gu = (const float*)d_in[15];
    const float* w_dn = (const float*)d_in[16];
    const float* b_dn = (const float*)d_in[17];
    const float* final_g = (const float*)d_in[18];
    float* out = (float*)d_out;

    float* ws = (float*)d_ws; size_t o = 0;
    auto take = [&](size_t n) { float* p = ws + o; o += (n + 63) & ~(size_t)63; return p; };
    int* cnt = (int*)take(64); int* offs = (int*)take(64);
    int* list = (int*)take((size_t)NE * T_);
    int* tope = (int*)take((size_t)T_ * 4); int* toppos = (int*)take((size_t)T_ * 4); float* topw = take((size_t)T_ * 4);
    float* x2 = take((size_t)T_ * DM); float* h2 = take((size_t)T_ * DM);
    const size_t scratch0 = o;
    float* h = take((size_t)T_ * DM); float* proj = take((size_t)T_ * INW);
    float* Cc = take(256 * 512); float* Dm = take((size_t)2048 * 4096);
    float* Z = take((size_t)T_ * 2048); float* fm = take((size_t)T_ * FW);
    float* att = take((size_t)T_ * AW); float* kvm = take((size_t)B_ * MEM * 2 * MW); float* xm = take((size_t)T_ * MW);
    float* yf = take((size_t)T_ * DM); float* ya = take((size_t)T_ * DM); float* ym = take((size_t)T_ * DM); float* mixed = take((size_t)T_ * DM);
    o = scratch0;
    float* gu = take((size_t)T_ * TOPK * 2 * DFF); float* act = take((size_t)T_ * TOPK * DFF); float* ys = take((size_t)T_ * TOPK * DM);

    hipMemsetAsync(cnt, 0, 256, stream);
    hipLaunchKernelGGL(k_rmsnorm, dim3(T_), dim3(256), 0, stream, x, norm1_g, h);
    hipLaunchKernelGGL(k_tables, dim3((unsigned)(((size_t)2048 * 4096 + 255) / 256)), dim3(256), 0, stream, Cc, Dm);
    gemm(stream, h, w_in, proj, T_, INW, DM, DM, INW, INW);
    for (int g = 0; g < FG; ++g)
        for (int cs = 0; cs < 2; ++cs)
            gemm(stream, proj + g * FGD, Cc + cs * 256, Z + (size_t)cs * S_ * FW + g * FGD, S_, FGD, FGD, INW, 512, FW, B_, (long long)S_ * INW, 0, (long long)2 * S_ * FW);
    gemm(stream, Dm, Z, fm, S_, FW, 2 * S_, 2 * S_, FW, FW, B_, 0, (long long)2 * S_ * FW, (long long)S_ * FW);
    gemm(stream, fm, w_fo, yf, T_, DM, FW, FW, DM, DM);
    hipLaunchKernelGGL(k_attn, dim3(T_ * NH / 4), dim3(256), 0, stream, (const float*)proj, relb, sink, att);
    gemm(stream, att, w_ao, ya, T_, DM, AW, AW, DM, DM);
    gemm(stream, mem, w_mem_kv, kvm, B_ * MEM, 2 * MW, DM, DM, 2 * MW, 2 * MW);
    hipLaunchKernelGGL(k_memattn, dim3(T_ * MH / 4), dim3(256), 0, stream, (const float*)proj, (const float*)kvm, xm);
    gemm(stream, xm, w_mo, ym, T_, DM, MW, MW, DM, DM);
    hipLaunchKernelGGL(k_mix, dim3((unsigned)((size_t)T_ * DM / 256)), dim3(256), 0, stream, (const float*)proj, (const float*)yf, (const float*)ya, (const float*)ym, mixed);
    gemm(stream, mixed, w_o, x2, T_, DM, DM, DM, DM, DM, 1, 0, 0, 0, nullptr, 0, x, DM);
    hipLaunchKernelGGL(k_rmsnorm, dim3(T_), dim3(256), 0, stream, (const float*)x2, norm2_g, h2);
    hipLaunchKernelGGL(k_router, dim3(T_ / 4), dim3(256), 0, stream, (const float*)h2, w_router, b_router, cnt, list, tope, toppos, topw);
    hipLaunchKernelGGL(k_offs, dim3(1), dim3(64), 0, stream, (const int*)cnt, offs);
    gemm(stream, h2, w_gu, gu, T_, 2 * DFF, DM, DM, 2 * DFF, 2 * DFF, NE, 0, (long long)DM * 2 * DFF, 0, b_gu, 2 * DFF, nullptr, 0, cnt, offs, list);
    hipLaunchKernelGGL(k_swiglu, dim3((unsigned)((size_t)T_ * TOPK * DFF / 256)), dim3(256), 0, stream, (const float*)gu, act);
    {
        GP p; memset(&p, 0, sizeof(p));
        p.A = act; p.B = w_dn; p.C = ys; p.bias = b_dn; p.cnt = cnt; p.offs = offs; p.list = nullptr;
        p.sB = (long long)DFF * DM; p.sBias = DM; p.M = T_; p.N = DM; p.K = DFF; p.lda = DFF; p.ldb = DM; p.ldc = DM; p.alpha = 1.0f;
        hipLaunchKernelGGL(k_sgemm, dim3(DM / 64, T_ / 64, NE), dim3(256), 0, stream, p);
    }
    hipLaunchKernelGGL(k_final, dim3(T_), dim3(256), 0, stream, (const float*)x2, (const float*)ys, (const int*)tope, (const int*)toppos, (const float*)topw, (const int*)offs, final_g, out);
}
```

```cpp
#include <hip/hip_runtime.h>
#include <stdint.h>
#include <string.h>
#ifndef MODE
#define MODE 2
#endif
namespace fx {
#define LAS __attribute__((address_space(3)))
typedef unsigned short bf16_t;
typedef short bf16x8 __attribute__((ext_vector_type(8)));
typedef short s16x4 __attribute__((ext_vector_type(4)));
typedef float f32x4 __attribute__((ext_vector_type(4)));
typedef float f32x16 __attribute__((ext_vector_type(16)));
typedef float f32x2 __attribute__((ext_vector_type(2)));
typedef __bf16 bf16x2_t __attribute__((ext_vector_type(2)));
typedef unsigned u32x4 __attribute__((ext_vector_type(4)));
typedef unsigned u32x2 __attribute__((ext_vector_type(2)));

constexpr int NTHR = 512, NWAVE = 8;
constexpr int B_ = 8, S_ = 2048, DM = 2048, T_ = B_ * S_;
constexpr int MEM = 256, FW = 1024, FG = 4, FGD = 256;
constexpr int NH = 32, NKV = 4, HD = 64, AW = 2048, KVW = 256, WIN = 128;
constexpr int MH = 4, MHD = 256, MW = 1024;
constexpr int NE = 32, TOPK = 4, DFF = 2048;
constexpr int INW = 10752;
constexpr int NSLOT = T_ * TOPK + NE * 256;
constexpr float LOG2E = 1.4426950408889634f;

constexpr size_t al256(size_t x) { return (x + 255) & ~(size_t)255; }
constexpr size_t WS_CTL = 0, CTL_BYTES = 65536;
constexpr size_t WS_WINT = 1u << 20;
constexpr size_t WS_WMKVT = WS_WINT + (size_t)INW * DM * 2;
constexpr size_t WS_WFOT = WS_WMKVT + (size_t)2048 * 2048 * 2;
constexpr size_t WS_WAOT = WS_WFOT + (size_t)2048 * 1024 * 2;
constexpr size_t WS_WMOT = WS_WAOT + (size_t)2048 * 2048 * 2;
constexpr size_t WS_WOT = WS_WMOT + (size_t)2048 * 1024 * 2;
constexpr size_t WS_WRT = WS_WOT + (size_t)2048 * 2048 * 2;
constexpr size_t WS_TABT = WS_WRT + (size_t)NE * DM * 2;
constexpr size_t WS_DMAT = WS_TABT + (size_t)512 * 256 * 2;
constexpr size_t WS_WGUT = WS_DMAT + (size_t)2048 * 4096 * 2;
constexpr size_t WS_WDNT = WS_WGUT + (size_t)NE * 4096 * 2048 * 2;
constexpr size_t WS_H = WS_WDNT + (size_t)NE * 2048 * 2048 * 2;
constexpr size_t WS_MEMBF = WS_H + (size_t)T_ * DM * 2;
constexpr size_t WS_FIN = WS_MEMBF + (size_t)2048 * 2048 * 2;
constexpr size_t WS_Q = WS_FIN + (size_t)T_ * FW * 2;
constexpr size_t WS_K = WS_Q + (size_t)T_ * AW * 2;
constexpr size_t WS_VT = WS_K + (size_t)T_ * KVW * 2;
constexpr size_t WS_QM = WS_VT + (size_t)T_ * KVW * 2;
constexpr size_t WS_GATES = WS_QM + (size_t)T_ * MW * 2;
constexpr size_t WS_KMK = WS_GATES + (size_t)T_ * 3 * DM * 2;
constexpr size_t WS_VMT = WS_KMK + (size_t)2048 * 1024 * 2;
constexpr size_t WS_ZT = WS_VMT + (size_t)2048 * 1024 * 2;
constexpr size_t WS_FM = WS_ZT + (size_t)32 * 256 * 4096 * 2;
constexpr size_t WS_ATT = WS_FM + (size_t)T_ * FW * 2;
constexpr size_t WS_PM = WS_ATT + (size_t)T_ * AW * 2;
constexpr size_t WS_XM = WS_PM + (size_t)T_ * MH * 256 * 2;
constexpr size_t WS_MIXACC = WS_XM + (size_t)T_ * MW * 2;
constexpr size_t WS_MIXED = WS_MIXACC + (size_t)T_ * DM * 4;
constexpr size_t WS_X2 = WS_MIXED + (size_t)T_ * DM * 2;
constexpr size_t WS_H2 = WS_X2 + (size_t)T_ * DM * 4;
constexpr size_t WS_TOKE = WS_H2 + (size_t)T_ * DM * 2;
constexpr size_t WS_TOKPOS = WS_TOKE + (size_t)T_ * 4 * 4;
constexpr size_t WS_TOKW = WS_TOKPOS + (size_t)T_ * 4 * 4;
constexpr size_t WS_LIST = WS_TOKW + (size_t)T_ * 4 * 4;
constexpr size_t WS_WLIST = WS_LIST + (size_t)NE * T_ * 4;
constexpr size_t WS_FAST_END = WS_WLIST + (size_t)NE * T_ * 4;
constexpr size_t WS_ACT = WS_H;
constexpr size_t WS_YS = WS_ACT + (size_t)NSLOT * DFF * 2;
static_assert(WS_YS + (size_t)NSLOT * DM * 2 <= WS_MIXED, "overlay fits");
constexpr int CW_CNT = 0;
constexpr int CW_BAR = 4096;

constexpr int LDS_STAGE = 0, STAGE_BYTES = 131072;
constexpr int LDS_MISC = STAGE_BYTES;
constexpr int LDS_BYTES = 147456;

struct Params {
    const float* in[19]; float* out; unsigned char* ws;
};

__device__ __forceinline__ unsigned cvtpk(float lo, float hi) { f32x2 v = {lo, hi}; bf16x2_t b = __builtin_convertvector(v, bf16x2_t); return __builtin_bit_cast(unsigned, b); }
__device__ __forceinline__ float bf2f(unsigned short x) { return __uint_as_float(((unsigned)x) << 16); }
__device__ __forceinline__ float bflo(unsigned w) { return __uint_as_float(w << 16); }
__device__ __forceinline__ float bfhi(unsigned w) { return __uint_as_float(w & 0xffff0000u); }
__device__ __forceinline__ float wsum(float v) {
#pragma unroll
    for (int o = 1; o < 64; o <<= 1) v += __shfl_xor(v, o);
    return v;
}
__device__ __forceinline__ float sigmoidf_(float x) { return 1.0f / (1.0f + __builtin_amdgcn_exp2f(-x * LOG2E)); }
__device__ __forceinline__ int crow(int r, int h) { return (r & 3) + 8 * (r >> 2) + 4 * h; }
__device__ __forceinline__ int t5_bucket(int rel) {
    const int n = rel < 0 ? -rel : rel;
    int b;
    if (n < 8) b = n; else if (n < 12) b = 8; else if (n < 16) b = 9; else if (n < 23) b = 10; else if (n < 32) b = 11;
    else if (n < 46) b = 12; else if (n < 64) b = 13; else if (n < 91) b = 14; else b = 15;
    return (rel > 0 ? 16 : 0) + b;
}
__device__ __forceinline__ int vwg() { const int c = blockIdx.x, G = gridDim.x; return ((G & 7) == 0) ? (c & 7) * (G >> 3) + (c >> 3) : c; }

constexpr int BM = 256, BK = 64, HALF = 128, HTB = HALF * BK * 2;
__host__ __device__ __forceinline__ int lds_byte(int r, int c) { const int st = (r >> 4) * 2 + (c >> 5), rr = r & 15, cc = c & 31, ob = rr * 64 + cc * 2; return st * 1024 + (ob ^ (((ob >> 9) & 1) << 5)); }
__host__ __device__ __forceinline__ void stage_rc(int b, int& R, int& C) { const int st = b / 1024, sb = b % 1024, swz = sb ^ (((sb >> 9) & 1) << 5); R = (st >> 1) * 16 + swz / 64; C = (st & 1) * 32 + (swz % 64) / 2; }
__host__ __device__ __forceinline__ int perm32(int rho) { const int n = rho >> 4, i = rho & 15; return 8 * (i >> 2) + 4 * n + (i & 3); }

struct Unit { int pm, pn, z; };

template <class Epi, class Sched, bool ALIGN_EPI>
__device__ __forceinline__ void gemm_phase(LAS unsigned char* lds, const int K, const int lda, const int ldb, const Sched& S, const Epi& E) {
    const int tid = threadIdx.x, wid = __builtin_amdgcn_readfirstlane(tid >> 6), lane = tid & 63, wr = wid >> 2, wc = wid & 3, fr = lane & 15, fq = lane >> 4;
    const int nt = K / BK;
    constexpr bool GATHER = Sched::GATHER;
    unsigned voffA[2], voffB[2]; int Rr[2], Cb[2];
#pragma unroll
    for (int i = 0; i < 2; ++i) { int R, C; stage_rc(tid * 16 + i * 8192, R, C); const int Rb = Epi::PERM ? ((R & ~31) + perm32(R & 31)) : R;
        voffA[i] = (unsigned)(R * lda + C) * 2u; voffB[i] = (unsigned)(Rb * ldb + C) * 2u; Rr[i] = R; Cb[i] = C * 2; }
    const size_t kstep = (size_t)(BK * 2);
    const size_t hstepA = (size_t)HALF * lda * 2, hstepB = (size_t)HALF * ldb * 2;
    const unsigned ldsw = (unsigned)wid * 1024u;
    const int aoff = lds_byte(wr * 64 + fr, fq * 8), boff = lds_byte(wc * 32 + fr, fq * 8);
#define PG8_SA(b, h) (((b) * 2 + (h)) * HTB)
#define PG8_SB(b, h) ((4 + (b) * 2 + (h)) * HTB)
#define PG8_STAGE(bufoff, gbase, voff) do { _Pragma("unroll") for (int _i = 0; _i < 2; ++_i) \
        __builtin_amdgcn_global_load_lds((const unsigned*)((const char*)(gbase) + (voff)[_i]), (LAS unsigned*)(lds + (bufoff) + ldsw + _i * 8192), 16, 0, 0); } while (0)
#define PG8_STAGE_A(bufoff, gbase, h, NX) do { if constexpr (GATHER) { _Pragma("unroll") for (int _i = 0; _i < 2; ++_i) { const unsigned _o = (NX) ? naoff[h][_i] : caoff[h][_i]; \
        __builtin_amdgcn_global_load_lds((const unsigned*)((const char*)(gbase) + _o), (LAS unsigned*)(lds + (bufoff) + ldsw + _i * 8192), 16, 0, 0); } } \
        else { PG8_STAGE(bufoff, (const char*)(gbase) + (h) * hstepA, voffA); } } while (0)
#define PG8_LDA(dst, b, h) do { _Pragma("unroll") for (int m = 0; m < 4; ++m) _Pragma("unroll") for (int k = 0; k < 2; ++k) dst[m][k] = *(const LAS bf16x8*)(lds + PG8_SA(b, h) + aoff + m * 2048 + k * 1024); } while (0)
#define PG8_LDB(dst, b, h) do { _Pragma("unroll") for (int n = 0; n < 2; ++n) _Pragma("unroll") for (int k = 0; k < 2; ++k) dst[n][k] = *(const LAS bf16x8*)(lds + PG8_SB(b, h) + boff + n * 2048 + k * 1024); } while (0)
#define PG8_MMA(ai, bj, At, Bt) do { __builtin_amdgcn_s_setprio(1); _Pragma("unroll") for (int m = 0; m < 4; ++m) _Pragma("unroll") for (int n = 0; n < 2; ++n) _Pragma("unroll") for (int k = 0; k < 2; ++k) \
        acc[ai][bj][m][n] = __builtin_amdgcn_mfma_f32_16x16x32_bf16(Bt[n][k], At[m][k], acc[ai][bj][m][n], 0, 0, 0); __builtin_amdgcn_s_setprio(0); } while (0)
#define PG8_WAIT_V(n) asm volatile("s_waitcnt vmcnt(" #n ")" ::: "memory")
#define PG8_WAIT_L(n) asm volatile("s_waitcnt lgkmcnt(" #n ")" ::: "memory")
#define PG8_BAR __builtin_amdgcn_s_barrier()
#define PG8_SCHED __builtin_amdgcn_sched_barrier(0)
    Unit cur, nxt; int ui = 0;
    if (!S.next(0, cur)) return;
    f32x4 acc[2][2][4][2];
#pragma unroll
    for (int a = 0; a < 2; ++a)
#pragma unroll
        for (int b = 0; b < 2; ++b)
#pragma unroll
            for (int m = 0; m < 4; ++m)
#pragma unroll
                for (int n = 0; n < 2; ++n) acc[a][b][m][n] = (f32x4){0.f, 0.f, 0.f, 0.f};
    bf16x8 At[4][2], B0[2][2], B1[2][2];
    unsigned caoff[2][2] = {{0u, 0u}, {0u, 0u}}, naoff[2][2] = {{0u, 0u}, {0u, 0u}};
    if constexpr (GATHER) {
#pragma unroll
        for (int h = 0; h < 2; ++h)
#pragma unroll
            for (int i = 0; i < 2; ++i) { caoff[h][i] = S.arow(cur, h * HALF + Rr[i]) + (unsigned)Cb[i]; naoff[h][i] = caoff[h][i]; }
    }
    const char* cA = S.baseA(cur); const char* cB = S.baseB(cur);
    PG8_STAGE(PG8_SB(0, 0), cB, voffB); PG8_STAGE(PG8_SB(0, 1), cB + hstepB, voffB); PG8_STAGE_A(PG8_SA(0, 0), cA, 0, false); PG8_STAGE_A(PG8_SA(0, 1), cA, 1, false);
    if (wr == 1) PG8_BAR;
    PG8_WAIT_V(2); PG8_BAR;
    PG8_STAGE(PG8_SB(1, 0), cB + kstep, voffB); PG8_STAGE_A(PG8_SA(1, 0), cA + kstep, 0, false); PG8_STAGE(PG8_SB(1, 1), cB + hstepB + kstep, voffB);
    PG8_WAIT_V(6); PG8_BAR;
    for (;;) {
        const bool has_next = S.next(ui + 1, nxt);
        const char* nA = has_next ? S.baseA(nxt) : cA; const char* nB = has_next ? S.baseB(nxt) : cB;
        if constexpr (GATHER) {
            if (has_next) {
#pragma unroll
                for (int h = 0; h < 2; ++h)
#pragma unroll
                    for (int i = 0; i < 2; ++i) naoff[h][i] = S.arow(nxt, h * HALF + Rr[i]) + (unsigned)Cb[i];
            } else {
#pragma unroll
                for (int h = 0; h < 2; ++h)
#pragma unroll
                    for (int i = 0; i < 2; ++i) naoff[h][i] = caoff[h][i];
            }
        }
#pragma unroll 1
        for (int t = 0; t < nt; t += 2) {
            const bool last = (t == nt - 2);
            const char* a1 = cA + (size_t)(t + 1) * kstep;
            const char* a2 = last ? nA : cA + (size_t)(t + 2) * kstep; const char* b2 = last ? nB : cB + (size_t)(t + 2) * kstep;
            const char* a3 = a2 + kstep; const char* b3 = b2 + kstep;
            PG8_LDB(B0, 0, 0); PG8_LDB(B1, 0, 1); PG8_SCHED; PG8_LDA(At, 0, 0); PG8_STAGE_A(PG8_SA(1, 1), a1, 1, false);
            PG8_WAIT_V(8); PG8_WAIT_L(0); PG8_BAR; PG8_MMA(0, 0, At, B0); PG8_MMA(0, 1, At, B1); PG8_BAR; PG8_SCHED;
            PG8_LDA(At, 0, 1); PG8_STAGE(PG8_SB(0, 0), b2, voffB); PG8_STAGE(PG8_SB(0, 1), b2 + hstepB, voffB); PG8_STAGE_A(PG8_SA(0, 0), a2, 0, last);
            PG8_WAIT_V(8); PG8_WAIT_L(0); PG8_BAR; PG8_MMA(1, 0, At, B0); PG8_MMA(1, 1, At, B1); PG8_BAR; PG8_SCHED;
            PG8_LDB(B0, 1, 0); PG8_LDB(B1, 1, 1); PG8_SCHED; PG8_LDA(At, 1, 0); PG8_STAGE_A(PG8_SA(0, 1), a2, 1, last);
            PG8_WAIT_V(8); PG8_WAIT_L(0); PG8_BAR; PG8_MMA(0, 0, At, B0); PG8_MMA(0, 1, At, B1); PG8_BAR; PG8_SCHED;
            PG8_LDA(At, 1, 1); PG8_STAGE(PG8_SB(1, 0), b3, voffB); PG8_STAGE(PG8_SB(1, 1), b3 + hstepB, voffB); PG8_STAGE_A(PG8_SA(1, 0), a3, 0, last);
            PG8_WAIT_V(8); PG8_WAIT_L(0); PG8_BAR; PG8_MMA(1, 0, At, B0); PG8_MMA(1, 1, At, B1); PG8_BAR; PG8_SCHED;
        }
        if constexpr (ALIGN_EPI) { if (wr == 0) PG8_BAR; }
        if constexpr (!Epi::AFTER_DRAIN) { E(acc, cur, wr, wc, fr, fq); }
        if (!has_next) break;
#pragma unroll
        for (int a = 0; a < 2; ++a)
#pragma unroll
            for (int b = 0; b < 2; ++b)
#pragma unroll
                for (int m = 0; m < 4; ++m)
#pragma unroll
                    for (int n = 0; n < 2; ++n) acc[a][b][m][n] = (f32x4){0.f, 0.f, 0.f, 0.f};
        cur = nxt; cA = nA; cB = nB; ++ui;
        if constexpr (GATHER) {
#pragma unroll
            for (int h = 0; h < 2; ++h)
#pragma unroll
                for (int i = 0; i < 2; ++i) caoff[h][i] = naoff[h][i];
        }
        if constexpr (ALIGN_EPI) { if (wr == 1) PG8_BAR; }
    }
    PG8_WAIT_V(0);
    if constexpr (!ALIGN_EPI) { if (wr == 0) PG8_BAR; }
    PG8_BAR;
    if constexpr (Epi::AFTER_DRAIN) { E.fused(acc, cur, wr, wc, fr, fq, lds, wid, lane); }
#undef PG8_SA
#undef PG8_SB
#undef PG8_STAGE
#undef PG8_STAGE_A
#undef PG8_LDA
#undef PG8_LDB
#undef PG8_MMA
#undef PG8_WAIT_V
#undef PG8_WAIT_L
#undef PG8_BAR
#undef PG8_SCHED
}
constexpr int NXCD = 8, WGM = 8;
__device__ __forceinline__ void static_tile(int L, int nM, int nN, int& pm, int& pn) {
    const int nwg = nM * nN; int wgid = L;
    { const int q = nwg / NXCD, r = nwg % NXCD, xcd = wgid % NXCD, off = wgid / NXCD; wgid = (xcd < r ? xcd * (q + 1) : r * (q + 1) + (xcd - r) * q) + off; }
    const int nig = WGM * nN, gid = wgid / nig, fm = gid * WGM, gsz = (nM - fm) < WGM ? (nM - fm) : WGM;
    pm = fm + ((wgid % nig) % gsz); pn = (wgid % nig) / gsz;
}
struct SchedPlain {
    static constexpr bool GATHER = false;
    const char* A; const char* Bt; size_t tstepA, tstepB; int nM, nN;
    __device__ __forceinline__ bool next(int i, Unit& u) const { const int L = i * (int)gridDim.x + (int)blockIdx.x; if (L >= nM * nN) return false; static_tile(L, nM, nN, u.pm, u.pn); u.z = 0; return true; }
    __device__ __forceinline__ const char* baseA(const Unit& u) const { return A + (size_t)u.pm * tstepA; }
    __device__ __forceinline__ const char* baseB(const Unit& u) const { return Bt + (size_t)u.pn * tstepB; }
    __device__ __forceinline__ unsigned arow(const Unit&, int) const { return 0u; }
};
struct SchedProj {
    static constexpr bool GATHER = false;
    const unsigned char* ws;
    __device__ __forceinline__ bool next(int i, Unit& u) const {
        const int L = i * (int)gridDim.x + (int)blockIdx.x;
        if (L < 64 * 42) { static_tile(L, 64, 42, u.pm, u.pn); u.z = (u.pn == 13) ? 2 : 0; return true; }
        const int L2 = L - 64 * 42; if (L2 >= 64) return false;
        if (L2 < 32) { u.pm = L2 & 7; u.pn = L2 >> 3; u.z = 1; } else { u.pm = (L2 - 32) & 3; u.pn = (L2 - 32) >> 2; u.z = 3; }
        return true;
    }
    __device__ __forceinline__ const char* baseA(const Unit& u) const {
        const size_t ts = (size_t)256 * 2048 * 2;
        if (u.z == 0) return (const char*)ws + WS_H + (size_t)u.pm * ts;
        if (u.z == 2) return (const char*)ws + WS_WINT + (size_t)13 * ts;
        if (u.z == 1) return (const char*)ws + WS_MEMBF + (size_t)u.pm * ts;
        return (const char*)ws + WS_WMKVT + (size_t)(4 + u.pm) * ts;
    }
    __device__ __forceinline__ const char* baseB(const Unit& u) const {
        const size_t ts = (size_t)256 * 2048 * 2;
        if (u.z == 0) return (const char*)ws + WS_WINT + (size_t)u.pn * ts;
        if (u.z == 2) return (const char*)ws + WS_H + (size_t)u.pm * ts;
        if (u.z == 1) return (const char*)ws + WS_WMKVT + (size_t)u.pn * ts;
        return (const char*)ws + WS_MEMBF + (size_t)u.pn * ts;
    }
    __device__ __forceinline__ unsigned arow(const Unit&, int) const { return 0u; }
};
struct SchedChan {
    static constexpr bool GATHER = false;
    const unsigned char* ws; int u0, nu;
    __device__ __forceinline__ bool next(int i, Unit& u) const {
        const int L = i * (int)gridDim.x + vwg(); if (L >= 512) return false;
        u.z = L >> 4; u.pm = (L >> 3) & 1; u.pn = L & 7; return true;
    }
    __device__ __forceinline__ const char* baseA(const Unit& u) const { return (const char*)ws + WS_TABT + (size_t)u.pm * (256 * 256 * 2); }
    __device__ __forceinline__ const char* baseB(const Unit& u) const { const int b = u.z >> 2, g = u.z & 3; return (const char*)ws + WS_FIN + ((size_t)(b * 2048 + u.pn * 256) * 1024 + g * 256) * 2; }
    __device__ __forceinline__ unsigned arow(const Unit&, int) const { return 0u; }
};
struct SchedSeq {
    static constexpr bool GATHER = false;
    const unsigned char* ws;
    __device__ __forceinline__ bool next(int i, Unit& u) const {
        const int L = i * (int)gridDim.x + vwg(); if (L >= 256) return false;
        u.z = L >> 3; u.pm = L & 7; u.pn = 0; return true;
    }
    __device__ __forceinline__ const char* baseA(const Unit& u) const { return (const char*)ws + WS_DMAT + (size_t)u.pm * (256 * 4096 * 2); }
    __device__ __forceinline__ const char* baseB(const Unit& u) const { return (const char*)ws + WS_ZT + (size_t)u.z * (256 * 4096 * 2); }
    __device__ __forceinline__ unsigned arow(const Unit&, int) const { return 0u; }
};
struct SchedOne {
    static constexpr bool GATHER = false;
    const char* A; const char* Bt; int z; bool valid;
    __device__ __forceinline__ bool next(int i, Unit& u) const { if (i != 0 || !valid) return false; u.pm = 0; u.pn = 0; u.z = z; return true; }
    __device__ __forceinline__ const char* baseA(const Unit&) const { return A; }
    __device__ __forceinline__ const char* baseB(const Unit&) const { return Bt; }
    __device__ __forceinline__ unsigned arow(const Unit&, int) const { return 0u; }
};
template <bool GATH, int NT  >
struct SchedMoe {
    static constexpr bool GATHER = GATH;
    const unsigned char* ws; const LAS int* pt; const LAS int* cn;
    __device__ __forceinline__ bool next(int i, Unit& u) const {
        const int L = i * (int)gridDim.x + vwg(); const int total = pt[NE] * NT; if (L >= total) return false;
        int e = 0;
#pragma unroll 1
        for (int k = 1; k < NE; ++k) if (L >= pt[k] * NT) e = k;
        const int t = L - pt[e] * NT, mte = pt[e + 1] - pt[e];
        u.z = e; u.pm = t % mte; u.pn = t / mte; return true;
    }
    __device__ __forceinline__ const char* baseA(const Unit& u) const {
        if constexpr (GATH) return (const char*)ws + WS_H2;
        else return (const char*)ws + WS_ACT + (size_t)(pt[u.z] + u.pm) * (256 * 2048 * 2);
    }
    __device__ __forceinline__ const char* baseB(const Unit& u) const {
        if constexpr (GATH) return (const char*)ws + WS_WGUT + ((size_t)u.z * 4096 + (size_t)u.pn * 256) * (2048 * 2);
        else return (const char*)ws + WS_WDNT + ((size_t)u.z * 2048 + (size_t)u.pn * 256) * (2048 * 2);
    }
    __device__ __forceinline__ unsigned arow(const Unit& u, int r) const {
        const int pos = u.pm * 256 + r;
        const int* list = (const int*)(ws + WS_LIST);
        const int tok = (pos < cn[u.z]) ? list[(size_t)u.z * T_ + pos] : 0;
        return (unsigned)tok * 4096u;
    }
};

__device__ __forceinline__ void store_tile_bf16(const f32x4 (&acc)[2][2][4][2], bf16_t* dst  , size_t ldc, int wr, int wc, int fr, int fq) {
    const int row0 = wr * 64 + fr, col0 = wc * 32 + 8 * fq;
#pragma unroll
    for (int ai = 0; ai < 2; ++ai)
#pragma unroll
        for (int m = 0; m < 4; ++m) { bf16_t* rowp = dst + (size_t)(row0 + ai * HALF + m * 16) * ldc + col0;
#pragma unroll
            for (int bj = 0; bj < 2; ++bj) { const f32x4 v0 = acc[ai][bj][m][0], v1 = acc[ai][bj][m][1];
                u32x4 w; w.x = cvtpk(v0[0], v0[1]); w.y = cvtpk(v0[2], v0[3]); w.z = cvtpk(v1[0], v1[1]); w.w = cvtpk(v1[2], v1[3]);
                *(u32x4*)(rowp + bj * HALF) = w; } }
}
struct EpiProj {
    static constexpr bool PERM = true, AFTER_DRAIN = false;
    unsigned char* ws;
    __device__ __forceinline__ void operator()(const f32x4 (&acc)[2][2][4][2], const Unit& u, int wr, int wc, int fr, int fq) const {
        const int pn = u.pn, pm = u.pm;
        bf16_t* dst; size_t ldc;
        if (u.z == 0) {
            if (pn >= 18) {
                dst = (bf16_t*)(ws + WS_GATES) + (size_t)pm * 256 * 6144 + (pn - 18) * 256;
                const int row0 = wr * 64 + fr, col0 = wc * 32 + 8 * fq;
#pragma unroll
                for (int ai = 0; ai < 2; ++ai)
#pragma unroll
                    for (int m = 0; m < 4; ++m) { bf16_t* rowp = dst + (size_t)(row0 + ai * HALF + m * 16) * 6144 + col0;
#pragma unroll
                        for (int bj = 0; bj < 2; ++bj) { const f32x4 v0 = acc[ai][bj][m][0], v1 = acc[ai][bj][m][1];
                            u32x4 w; w.x = cvtpk(sigmoidf_(v0[0]), sigmoidf_(v0[1])); w.y = cvtpk(sigmoidf_(v0[2]), sigmoidf_(v0[3]));
                            w.z = cvtpk(sigmoidf_(v1[0]), sigmoidf_(v1[1])); w.w = cvtpk(sigmoidf_(v1[2]), sigmoidf_(v1[3]));
                            *(u32x4*)(rowp + bj * HALF) = w; } }
                return;
            }
            if (pn < 4) { dst = (bf16_t*)(ws + WS_FIN) + pn * 256; ldc = 1024; }
            else if (pn < 12) { dst = (bf16_t*)(ws + WS_Q) + (pn - 4) * 256; ldc = 2048; }
            else if (pn == 12) { dst = (bf16_t*)(ws + WS_K); ldc = 256; }
            else { dst = (bf16_t*)(ws + WS_QM) + (pn - 14) * 256; ldc = 1024; }
            dst += (size_t)pm * 256 * ldc;
        } else if (u.z == 2) {
            dst = (bf16_t*)(ws + WS_VT) + (size_t)(pm >> 3) * 256 * 2048 + (size_t)(pm & 7) * 256; ldc = 2048;
        } else if (u.z == 1) {
            dst = (bf16_t*)(ws + WS_KMK) + (size_t)pm * 256 * 1024 + pn * 256; ldc = 1024;
        } else {
            dst = (bf16_t*)(ws + WS_VMT) + (size_t)(pn * 4 + pm) * 256 * 256; ldc = 256;
        }
        store_tile_bf16(acc, dst, ldc, wr, wc, fr, fq);
    }
};
struct EpiChan {
    static constexpr bool PERM = true, AFTER_DRAIN = false;
    unsigned char* ws;
    __device__ __forceinline__ void operator()(const f32x4 (&acc)[2][2][4][2], const Unit& u, int wr, int wc, int fr, int fq) const {
        store_tile_bf16(acc, (bf16_t*)(ws + WS_ZT) + (size_t)u.z * 256 * 4096 + (size_t)u.pm * 2048 + u.pn * 256, 4096, wr, wc, fr, fq);
    }
};
struct EpiSeq {
    static constexpr bool PERM = true, AFTER_DRAIN = false;
    unsigned char* ws;
    __device__ __forceinline__ void operator()(const f32x4 (&acc)[2][2][4][2], const Unit& u, int wr, int wc, int fr, int fq) const {
        const int b = u.z >> 2, g = u.z & 3;
        store_tile_bf16(acc, (bf16_t*)(ws + WS_FM) + (size_t)(b * 2048 + u.pm * 256) * 1024 + g * 256, 1024, wr, wc, fr, fq);
    }
};
template <int STEP> struct EpiMix {
    static constexpr bool PERM = false, AFTER_DRAIN = false;
    unsigned char* ws;
    __device__ __forceinline__ void operator()(const f32x4 (&acc)[2][2][4][2], const Unit& u, int wr, int wc, int fr, int fq) const {
        const int row0 = u.pm * 256 + wr * 64 + fr, col0 = u.pn * 256 + wc * 32 + 4 * fq;
        const bf16_t* gates = (const bf16_t*)(ws + WS_GATES) + STEP * 2048;
        float* macc = (float*)(ws + WS_MIXACC); bf16_t* mixed = (bf16_t*)(ws + WS_MIXED);
#pragma unroll
        for (int ai = 0; ai < 2; ++ai)
#pragma unroll
            for (int m = 0; m < 4; ++m) { const size_t row = (size_t)(row0 + ai * HALF + m * 16);
#pragma unroll
                for (int bj = 0; bj < 2; ++bj)
#pragma unroll
                    for (int n = 0; n < 2; ++n) { const int col = col0 + bj * HALF + n * 16;
                        const u32x2 gw = *(const u32x2*)(gates + row * 6144 + col);
                        f32x4 v = acc[ai][bj][m][n];
                        v[0] *= bflo(gw.x); v[1] *= bfhi(gw.x); v[2] *= bflo(gw.y); v[3] *= bfhi(gw.y);
                        if (STEP > 0) v += *(const f32x4*)(macc + row * 2048 + col);
                        if (STEP < 2) *(f32x4*)(macc + row * 2048 + col) = v;
                        else { u32x2 w; w.x = cvtpk(v[0], v[1]); w.y = cvtpk(v[2], v[3]); *(u32x2*)(mixed + row * 2048 + col) = w; } } }
    }
};
struct EpiRes {
    static constexpr bool PERM = false, AFTER_DRAIN = false;
    const float* x; float* x2;
    __device__ __forceinline__ void operator()(const f32x4 (&acc)[2][2][4][2], const Unit& u, int wr, int wc, int fr, int fq) const {
        const int row0 = u.pm * 256 + wr * 64 + fr, col0 = u.pn * 256 + wc * 32 + 4 * fq;
#pragma unroll
        for (int ai = 0; ai < 2; ++ai)
#pragma unroll
            for (int m = 0; m < 4; ++m) { const size_t off = (size_t)(row0 + ai * HALF + m * 16) * 2048 + col0;
#pragma unroll
                for (int bj = 0; bj < 2; ++bj)
#pragma unroll
                    for (int n = 0; n < 2; ++n) *(f32x4*)(x2 + off + bj * HALF + n * 16) = acc[ai][bj][m][n] + *(const f32x4*)(x + off + bj * HALF + n * 16); }
    }
};
__device__ __forceinline__ float swiglu1(float g, float up) {
    g = fminf(g, 7.0f); up = fminf(fmaxf(up, -7.0f), 7.0f);
    return (up + 1.0f) * (g * sigmoidf_(1.702f * g));
}
struct EpiSwiglu {
    static constexpr bool PERM = true, AFTER_DRAIN = false;
    unsigned char* ws; const float* bgu; const LAS int* pt;
    __device__ __forceinline__ void operator()(const f32x4 (&acc)[2][2][4][2], const Unit& u, int wr, int wc, int fr, int fq) const {
        const int e = u.z; const size_t srow0 = (size_t)(pt[e] + u.pm) * 256 + wr * 64 + fr;
        const int col0 = u.pn * 256 + wc * 32 + 8 * fq;
        bf16_t* act = (bf16_t*)(ws + WS_ACT);
        f32x4 bv[2][2];
#pragma unroll
        for (int bj = 0; bj < 2; ++bj)
#pragma unroll
            for (int n = 0; n < 2; ++n) bv[bj][n] = *(const f32x4*)(bgu + (size_t)e * 4096 + col0 + bj * HALF + 4 * n);
#pragma unroll
        for (int ai = 0; ai < 2; ++ai)
#pragma unroll
            for (int m = 0; m < 4; ++m) { bf16_t* rowp = act + (srow0 + ai * HALF + m * 16) * 2048 + (col0 >> 1);
#pragma unroll
                for (int bj = 0; bj < 2; ++bj) { const f32x4 v0 = acc[ai][bj][m][0] + bv[bj][0], v1 = acc[ai][bj][m][1] + bv[bj][1];
                    u32x2 w; w.x = cvtpk(swiglu1(v0[0], v0[1]), swiglu1(v0[2], v0[3])); w.y = cvtpk(swiglu1(v1[0], v1[1]), swiglu1(v1[2], v1[3]));
                    *(u32x2*)(rowp + bj * (HALF / 2)) = w; } }
    }
};
struct EpiDown {
    static constexpr bool PERM = true, AFTER_DRAIN = false;
    unsigned char* ws; const float* bdn; const LAS int* pt; const LAS int* cn;
    __device__ __forceinline__ void operator()(const f32x4 (&acc)[2][2][4][2], const Unit& u, int wr, int wc, int fr, int fq) const {
        const int e = u.z; const int lrow0 = u.pm * 256 + wr * 64 + fr; const size_t srow0 = (size_t)pt[e] * 256 + lrow0;
        const int col0 = u.pn * 256 + wc * 32 + 8 * fq;
        bf16_t* ys = (bf16_t*)(ws + WS_YS); const float* wl = (const float*)(ws + WS_WLIST) + (size_t)e * T_; const int cne = cn[e];
        f32x4 bv[2][2];
#pragma unroll
        for (int bj = 0; bj < 2; ++bj)
#pragma unroll
            for (int n = 0; n < 2; ++n) bv[bj][n] = *(const f32x4*)(bdn + (size_t)e * 2048 + col0 + bj * HALF + 4 * n);
#pragma unroll
        for (int ai = 0; ai < 2; ++ai)
#pragma unroll
            for (int m = 0; m < 4; ++m) { const int pos = lrow0 + ai * HALF + m * 16; const float w = (pos < cne) ? wl[pos] : 0.f;
                bf16_t* rowp = ys + (srow0 + ai * HALF + m * 16) * 2048 + col0;
#pragma unroll
                for (int bj = 0; bj < 2; ++bj) { const f32x4 v0 = (acc[ai][bj][m][0] + bv[bj][0]) * w, v1 = (acc[ai][bj][m][1] + bv[bj][1]) * w;
                    u32x4 o; o.x = cvtpk(v0[0], v0[1]); o.y = cvtpk(v0[2], v0[3]); o.z = cvtpk(v1[0], v1[1]); o.w = cvtpk(v1[2], v1[3]);
                    *(u32x4*)(rowp + bj * HALF) = o; } }
    }
};
struct EpiMemSoftmax {
    static constexpr bool PERM = true, AFTER_DRAIN = true;
    bf16_t* P;
    __device__ __forceinline__ void operator()(const f32x4 (&)[2][2][4][2], const Unit&, int, int, int, int) const {}
    __device__ __forceinline__ void fused(f32x4 (&acc)[2][2][4][2], const Unit&, int wr, int wc, int fr, int fq, LAS unsigned char* lds, int, int) const {
        LAS f32x2* tab = (LAS f32x2*)lds;
        const float sc = 0.0625f * LOG2E;
        float mx[2][4];
#pragma unroll
        for (int ai = 0; ai < 2; ++ai)
#pragma unroll
            for (int m = 0; m < 4; ++m) { float a = -3.0e38f;
#pragma unroll
                for (int bj = 0; bj < 2; ++bj)
#pragma unroll
                    for (int n = 0; n < 2; ++n) { acc[ai][bj][m][n] *= sc; const f32x4 v = acc[ai][bj][m][n]; a = fmaxf(a, fmaxf(fmaxf(v[0], v[1]), fmaxf(v[2], v[3]))); }
                a = fmaxf(a, __shfl_xor(a, 16)); a = fmaxf(a, __shfl_xor(a, 32)); mx[ai][m] = a;
                float s = 0.f;
#pragma unroll
                for (int bj = 0; bj < 2; ++bj)
#pragma unroll
                    for (int n = 0; n < 2; ++n) { const f32x4 v = acc[ai][bj][m][n]; s += __builtin_amdgcn_exp2f(v[0] - a) + __builtin_amdgcn_exp2f(v[1] - a) + __builtin_amdgcn_exp2f(v[2] - a) + __builtin_amdgcn_exp2f(v[3] - a); }
                s += __shfl_xor(s, 16); s += __shfl_xor(s, 32);
                if (fq == 0) tab[(ai * HALF + wr * 64 + m * 16 + fr) * 4 + wc] = (f32x2){a, s};
            }
        __syncthreads();
#pragma unroll
        for (int ai = 0; ai < 2; ++ai)
#pragma unroll
            for (int m = 0; m < 4; ++m) { const int r = ai * HALF + wr * 64 + m * 16 + fr;
                const f32x2 t0 = tab[r * 4 + 0], t1 = tab[r * 4 + 1], t2 = tab[r * 4 + 2], t3 = tab[r * 4 + 3];
                const float M = fmaxf(fmaxf(t0.x, t1.x), fmaxf(t2.x, t3.x));
                const float L = t0.y * __builtin_amdgcn_exp2f(t0.x - M) + t1.y * __builtin_amdgcn_exp2f(t1.x - M) + t2.y * __builtin_amdgcn_exp2f(t2.x - M) + t3.y * __builtin_amdgcn_exp2f(t3.x - M);
                const float inv = 1.0f / L;
                bf16_t* rowp = P + (size_t)r * 1024 + wc * 32 + 8 * fq;
#pragma unroll
                for (int bj = 0; bj < 2; ++bj) { f32x4 v0 = acc[ai][bj][m][0], v1 = acc[ai][bj][m][1];
#pragma unroll
                    for (int j = 0; j < 4; ++j) { v0[j] = __builtin_amdgcn_exp2f(v0[j] - M) * inv; v1[j] = __builtin_amdgcn_exp2f(v1[j] - M) * inv; }
                    u32x4 w; w.x = cvtpk(v0[0], v0[1]); w.y = cvtpk(v0[2], v0[3]); w.z = cvtpk(v1[0], v1[1]); w.w = cvtpk(v1[2], v1[3]);
                    *(u32x4*)(rowp + bj * HALF) = w; } }
        __syncthreads();
    }
};
struct EpiTile {
    static constexpr bool PERM = true, AFTER_DRAIN = false;
    bf16_t* dst; size_t ldc;
    __device__ __forceinline__ void operator()(const f32x4 (&acc)[2][2][4][2], const Unit&, int wr, int wc, int fr, int fq) const { store_tile_bf16(acc, dst, ldc, wr, wc, fr, fq); }
};
__device__ __forceinline__ void tr_item(const float* W, int K, int N, bf16_t* WT, LAS float* scr, int item, int lane) {
    const int nblk = N / 32, kb = item / nblk, nb = item % nblk, k0 = 64 * kb, n0 = 32 * nb;
#pragma unroll 8
    for (int i = 0; i < 32; ++i) { const int kk = 2 * i + (lane >> 5); scr[kk * 33 + (lane & 31)] = W[(size_t)(k0 + kk) * N + n0 + (lane & 31)]; }
    asm volatile("s_waitcnt lgkmcnt(0)" ::: "memory");
    const int c = lane & 7;
#pragma unroll
    for (int j = 0; j < 4; ++j) { const int n = (lane >> 3) + 8 * j; const LAS float* s = scr + (8 * c) * 33 + n;
        u32x4 o; o.x = cvtpk(s[0 * 33], s[1 * 33]); o.y = cvtpk(s[2 * 33], s[3 * 33]); o.z = cvtpk(s[4 * 33], s[5 * 33]); o.w = cvtpk(s[6 * 33], s[7 * 33]);
        *(u32x4*)(WT + (size_t)(n0 + n) * K + k0 + 8 * c) = o; }
    asm volatile("s_waitcnt lgkmcnt(0)" ::: "memory");
}
__device__ __forceinline__ void rms_row_to_bf16(const float* xrow, const float* g, bf16_t* orow, int lane) {
    const f32x4* xr = (const f32x4*)xrow + lane; const f32x4* gr = (const f32x4*)g + lane;
    f32x4 v[8]; float s = 0.f;
#pragma unroll
    for (int j = 0; j < 8; ++j) { v[j] = xr[64 * j]; s += (v[j][0] * v[j][0] + v[j][1] * v[j][1]) + (v[j][2] * v[j][2] + v[j][3] * v[j][3]); }
    const float r = rsqrtf(wsum(s) * (1.0f / DM) + 1e-5f);
    u32x2* o8 = (u32x2*)orow + lane;
#pragma unroll
    for (int j = 0; j < 8; ++j) { const f32x4 gg = gr[64 * j]; u32x2 w; w.x = cvtpk(v[j][0] * r * gg[0], v[j][1] * r * gg[1]); w.y = cvtpk(v[j][2] * r * gg[2], v[j][3] * r * gg[3]); o8[64 * j] = w; }
}
__device__ __forceinline__ void phase_prologue(const Params& p, LAS unsigned char* lds) {
    const int tid = threadIdx.x, wave = tid >> 6, lane = tid & 63;
    unsigned char* ws = p.ws;
    LAS float* scr = (LAS float*)(lds + wave * 16384);
    const int gw = vwg() * NWAVE + wave, NGW = (int)gridDim.x * NWAVE;
    for (int m = gw; m < T_; m += NGW) rms_row_to_bf16(p.in[0] + (size_t)m * DM, p.in[3], (bf16_t*)(ws + WS_H) + (size_t)m * DM, lane);
    for (int m = gw; m < B_ * MEM; m += NGW) {
        const f32x4* xr = (const f32x4*)(p.in[1] + (size_t)m * DM) + lane; u32x2* o8 = (u32x2*)((bf16_t*)(ws + WS_MEMBF) + (size_t)m * DM) + lane;
#pragma unroll
        for (int j = 0; j < 8; ++j) { const f32x4 v = xr[64 * j]; u32x2 w; w.x = cvtpk(v[0], v[1]); w.y = cvtpk(v[2], v[3]); o8[64 * j] = w; }
    }
    {
        const int gt = vwg() * NTHR + tid, NGT = (int)gridDim.x * NTHR;
        bf16_t* tabT = (bf16_t*)(ws + WS_TABT); bf16_t* dm = (bf16_t*)(ws + WS_DMAT);
        for (int i = gt; i < 512 * 256 / 2; i += NGT) { const int e0 = 2 * i; const int mrow = e0 >> 8, c = e0 & 255; const int n = mrow & 255; float v[2];
#pragma unroll
            for (int j = 0; j < 2; ++j) { const int mm = ((c + j) * n) & 255; const float a = (float)mm * (2.0f / 256.0f); v[j] = (mrow < 256) ? cospif(a) : sinpif(a); }
            *(unsigned*)(tabT + e0) = cvtpk(v[0], v[1]); }
        const float sc = 1.0f / sqrtf(2048.0f * 256.0f);
        for (int i = gt; i < 2048 * 4096 / 2; i += NGT) { const int e0 = 2 * i; const int jr = e0 >> 12, k = e0 & 4095; float v[2];
#pragma unroll
            for (int j = 0; j < 2; ++j) { const int kk = (k + j) & 2047; const int mm = (jr * kk) & 2047; const float a = (float)mm * (2.0f / 2048.0f); v[j] = (k < 2048) ? cospif(a) * sc : -sinpif(a) * sc; }
            *(unsigned*)(dm + e0) = cvtpk(v[0], v[1]); }
        bf16_t* wrt = (bf16_t*)(ws + WS_WRT);
        for (int i = gt; i < NE * DM; i += NGT) { const int e = i >> 11, k = i & 2047; wrt[i] = (bf16_t)(cvtpk(p.in[12][(size_t)k * NE + e], 0.f) & 0xffffu); }
    }
    struct Mat { const float* W; int K, N; size_t dst; int nitems; };
    const int I_IN = (DM / 64) * (INW / 32), I_SQ = (2048 / 64) * (2048 / 32), I_HF = (1024 / 64) * (2048 / 32);
    const int I_GU = (2048 / 64) * (4096 / 32), I_DN = I_SQ;
    const long total = (long)I_IN + 3L * I_SQ + 2L * I_HF + (long)NE * I_GU + (long)NE * I_DN;
    for (long it = gw; it < total; it += NGW) {
        long r = it;
        if (r < I_IN) { tr_item(p.in[4], DM, INW, (bf16_t*)(ws + WS_WINT), scr, (int)r, lane); continue; } r -= I_IN;
        if (r < I_SQ) { tr_item(p.in[6], 2048, 2048, (bf16_t*)(ws + WS_WMKVT), scr, (int)r, lane); continue; } r -= I_SQ;
        if (r < I_HF) { tr_item(p.in[7], 1024, 2048, (bf16_t*)(ws + WS_WFOT), scr, (int)r, lane); continue; } r -= I_HF;
        if (r < I_SQ) { tr_item(p.in[8], 2048, 2048, (bf16_t*)(ws + WS_WAOT), scr, (int)r, lane); continue; } r -= I_SQ;
        if (r < I_HF) { tr_item(p.in[9], 1024, 2048, (bf16_t*)(ws + WS_WMOT), scr, (int)r, lane); continue; } r -= I_HF;
        if (r < I_SQ) { tr_item(p.in[10], 2048, 2048, (bf16_t*)(ws + WS_WOT), scr, (int)r, lane); continue; } r -= I_SQ;
        if (r < (long)NE * I_GU) { const int e = (int)(r / I_GU), q = (int)(r % I_GU);
            tr_item(p.in[14] + (size_t)e * 2048 * 4096, 2048, 4096, (bf16_t*)(ws + WS_WGUT) + (size_t)e * 4096 * 2048, scr, q, lane); continue; } r -= (long)NE * I_GU;
        { const int e = (int)(r / I_DN), q = (int)(r % I_DN);
            tr_item(p.in[16] + (size_t)e * 2048 * 2048, 2048, 2048, (bf16_t*)(ws + WS_WDNT) + (size_t)e * 2048 * 2048, scr, q, lane); }
    }
}

constexpr int AT_KROW = 144, AT_VROW = 776;
constexpr int AT_K = 0, AT_V = 384 * AT_KROW, AT_LUT = AT_V + 64 * AT_VROW;
static_assert(AT_LUT + NWAVE * 320 * 4 <= STAGE_BYTES, "attention LDS");
__device__ __forceinline__ void attn_unit(const Params& p, LAS unsigned char* lds, int b, int kvh, int qb) {
    const int tid = threadIdx.x, wid = __builtin_amdgcn_readfirstlane(tid >> 6), lane = tid & 63, r = lane & 31, h = lane >> 5;
    const unsigned char* ws = p.ws;
    const bf16_t* Q = (const bf16_t*)(ws + WS_Q); const bf16_t* Kg = (const bf16_t*)(ws + WS_K); const bf16_t* VT = (const bf16_t*)(ws + WS_VT);
    bf16_t* att = (bf16_t*)(p.ws + WS_ATT);
    const int q0 = qb * 128, hq = kvh * 8 + wid;
    LAS unsigned char* Kb = lds + AT_K; LAS unsigned char* Vt = lds + AT_V; LAS float* lut = (LAS float*)(lds + AT_LUT) + wid * 320;
    __syncthreads();
    for (int c = tid; c < 384 * 8; c += NTHR) { const int row = c >> 3, part = c & 7, pos = q0 - 128 + row;
        u32x4 v = {0u, 0u, 0u, 0u};
        if (pos >= 0 && pos < S_) v = *(const u32x4*)(Kg + (size_t)(b * S_ + pos) * 256 + kvh * 64 + part * 8);
        *(LAS u32x4*)(Kb + row * AT_KROW + part * 16) = v; }
    for (int c = tid; c < 64 * 48; c += NTHR) { const int d = c / 48, ch = c % 48, pos0 = q0 - 128 + ch * 8;
        u32x4 v = {0u, 0u, 0u, 0u};
        if (pos0 >= 0 && pos0 < S_) v = *(const u32x4*)(VT + ((size_t)((b * 4 + kvh) * 64 + d)) * 2048 + pos0);
        *(LAS u32x2*)(Vt + d * AT_VROW + ch * 16) = (u32x2){v.x, v.y}; *(LAS u32x2*)(Vt + d * AT_VROW + ch * 16 + 8) = (u32x2){v.z, v.w}; }
    for (int i = lane; i < 320; i += 64) { const int rel = i - 160; const int ar = rel < 0 ? -rel : rel;
        lut[i] = (ar <= WIN) ? p.in[2][t5_bucket(rel) * NH + hq] * LOG2E : -1.0e30f; }
    __syncthreads();
    const float sk = p.in[5][hq] * LOG2E;
    const float SC = 0.125f * LOG2E;
#pragma unroll 1
    for (int sb = 0; sb < 4; ++sb) {
        const int pq = q0 + sb * 32;
        bf16x8 qf[4];
        const bf16_t* qrow = Q + (size_t)(b * S_ + pq + r) * 2048 + hq * 64 + 8 * h;
#pragma unroll
        for (int s = 0; s < 4; ++s) qf[s] = *(const bf16x8*)(qrow + 16 * s);
        float mrun = sk, lrun = 1.0f;
        f32x16 o0, o1;
#pragma unroll
        for (int i = 0; i < 16; ++i) { o0[i] = 0.f; o1[i] = 0.f; }
#pragma unroll 1
        for (int j = 0; j < 9; ++j) {
            const int bt = sb + j, kpos0 = q0 - 128 + 32 * bt;
            if (kpos0 < 0 || kpos0 >= S_) continue;
            f32x16 s;
#pragma unroll
            for (int i = 0; i < 16; ++i) s[i] = 0.f;
            const LAS unsigned char* kp = Kb + (32 * bt + r) * AT_KROW + 16 * h;
#pragma unroll
            for (int ks = 0; ks < 4; ++ks) { const bf16x8 kf = *(const LAS bf16x8*)(kp + 32 * ks); s = __builtin_amdgcn_mfma_f32_32x32x16_bf16(kf, qf[ks], s, 0, 0, 0); }
            const LAS float* lp = lut + 32 * j + 32 + 4 * h - r;
            float mx = -3.0e38f;
#pragma unroll
            for (int i = 0; i < 16; ++i) { s[i] = s[i] * SC + lp[(i & 3) + 8 * (i >> 2)]; mx = fmaxf(mx, s[i]); }
            mx = fmaxf(mx, __shfl_xor(mx, 32));
            const float mnew = fmaxf(mrun, mx);
            const float alpha = __builtin_amdgcn_exp2f(mrun - mnew);
            float rs = 0.f;
#pragma unroll
            for (int i = 0; i < 16; ++i) { s[i] = __builtin_amdgcn_exp2f(s[i] - mnew); rs += s[i]; }
            rs += __shfl_xor(rs, 32);
            lrun = lrun * alpha + rs; mrun = mnew;
#pragma unroll
            for (int i = 0; i < 16; ++i) { o0[i] *= alpha; o1[i] *= alpha; }
#pragma unroll
            for (int k2 = 0; k2 < 2; ++k2) {
                u32x4 pw; pw.x = cvtpk(s[8 * k2 + 0], s[8 * k2 + 1]); pw.y = cvtpk(s[8 * k2 + 2], s[8 * k2 + 3]); pw.z = cvtpk(s[8 * k2 + 4], s[8 * k2 + 5]); pw.w = cvtpk(s[8 * k2 + 6], s[8 * k2 + 7]);
                const bf16x8 pb = __builtin_bit_cast(bf16x8, pw);
                const LAS unsigned char* vp = Vt + r * AT_VROW + (32 * bt + 16 * k2 + 4 * h) * 2;
                { const u32x2 lo = *(const LAS u32x2*)(vp), hi = *(const LAS u32x2*)(vp + 16); const u32x4 vw = {lo.x, lo.y, hi.x, hi.y};
                  o0 = __builtin_amdgcn_mfma_f32_32x32x16_bf16(__builtin_bit_cast(bf16x8, vw), pb, o0, 0, 0, 0); }
                { const u32x2 lo = *(const LAS u32x2*)(vp + 32 * AT_VROW), hi = *(const LAS u32x2*)(vp + 32 * AT_VROW + 16); const u32x4 vw = {lo.x, lo.y, hi.x, hi.y};
                  o1 = __builtin_amdgcn_mfma_f32_32x32x16_bf16(__builtin_bit_cast(bf16x8, vw), pb, o1, 0, 0, 0); }
            }
        }
        const float inv = 1.0f / lrun;
        bf16_t* orow = att + (size_t)(b * S_ + pq + r) * 2048 + hq * 64 + 4 * h;
#pragma unroll
        for (int g = 0; g < 4; ++g) {
            u32x2 w0; w0.x = cvtpk(o0[4 * g] * inv, o0[4 * g + 1] * inv); w0.y = cvtpk(o0[4 * g + 2] * inv, o0[4 * g + 3] * inv); *(u32x2*)(orow + 8 * g) = w0;
            u32x2 w1; w1.x = cvtpk(o1[4 * g] * inv, o1[4 * g + 1] * inv); w1.y = cvtpk(o1[4 * g + 2] * inv, o1[4 * g + 3] * inv); *(u32x2*)(orow + 32 + 8 * g) = w1;
        }
    }
}

__device__ __forceinline__ void phase_rows(const Params& p, LAS unsigned char* lds) {
    const int tid = threadIdx.x, wave = __builtin_amdgcn_readfirstlane(tid >> 6), lane = tid & 63;
    unsigned char* ws = p.ws;
    const float* x2 = (const float*)(ws + WS_X2); bf16_t* h2 = (bf16_t*)(ws + WS_H2);
    LAS float* lg = (LAS float*)lds;
    LAS int* sel_e = (LAS int*)(lds + 8192);
    LAS float* sel_w = (LAS float*)(lds + 9216);
    LAS int* sel_r = (LAS int*)(lds + 10240);
    LAS int* lcnt = (LAS int*)(lds + 11264);
    LAS int* lbase = (LAS int*)(lds + 11392);
    const int ntok_wg = T_ / (int)gridDim.x;
#pragma unroll 1
    for (int t0 = vwg() * ntok_wg; t0 < (vwg() + 1) * ntok_wg; t0 += 64) {
        __syncthreads();
        if (tid < 32) lcnt[tid] = 0;
        for (int i = 0; i < 8; ++i) { const int t = t0 + wave * 8 + i; rms_row_to_bf16(x2 + (size_t)t * DM, p.in[11], h2 + (size_t)t * DM, lane); }
        asm volatile("s_waitcnt vmcnt(0)" ::: "memory");
        __syncthreads();
        if (wave < 4) {
            const bf16_t* arow = h2 + (size_t)(t0 + wave * 16 + (lane & 15)) * DM + 8 * (lane >> 4);
            const bf16_t* b0 = (const bf16_t*)(ws + WS_WRT) + (size_t)(lane & 15) * DM + 8 * (lane >> 4);
            const bf16_t* b1 = b0 + (size_t)16 * DM;
            f32x4 a0 = {0.f, 0.f, 0.f, 0.f}, a1 = {0.f, 0.f, 0.f, 0.f};
#pragma unroll 8
            for (int s = 0; s < 64; ++s) { const bf16x8 av = *(const bf16x8*)(arow + 32 * s), bv0 = *(const bf16x8*)(b0 + 32 * s), bv1 = *(const bf16x8*)(b1 + 32 * s);
                a0 = __builtin_amdgcn_mfma_f32_16x16x32_bf16(av, bv0, a0, 0, 0, 0); a1 = __builtin_amdgcn_mfma_f32_16x16x32_bf16(av, bv1, a1, 0, 0, 0); }
            const int ecol = lane & 15; const float bb0 = p.in[13][ecol], bb1 = p.in[13][ecol + 16];
#pragma unroll
            for (int rg = 0; rg < 4; ++rg) { const int tl = wave * 16 + (lane >> 4) * 4 + rg; lg[tl * 32 + ecol] = a0[rg] + bb0; lg[tl * 32 + ecol + 16] = a1[rg] + bb1; }
        }
        __syncthreads();
        if (tid < 64) {
            float v[32];
#pragma unroll
            for (int e = 0; e < 32; ++e) v[e] = lg[tid * 32 + e];
            float tv[4]; int ti[4];
#pragma unroll
            for (int k = 0; k < 4; ++k) { float bv = -3.0e38f; int bi = 0;
#pragma unroll
                for (int e = 0; e < 32; ++e) { const bool tk = v[e] > bv; bv = tk ? v[e] : bv; bi = tk ? e : bi; }
                tv[k] = bv; ti[k] = bi;
#pragma unroll
                for (int e = 0; e < 32; ++e) v[e] = (e == bi) ? -3.0e38f : v[e]; }
            const float e1 = __expf(tv[1] - tv[0]), e2 = __expf(tv[2] - tv[0]), e3 = __expf(tv[3] - tv[0]);
            const float inv = 1.0f / (1.0f + e1 + e2 + e3);
            const float wv[4] = {inv, e1 * inv, e2 * inv, e3 * inv};
#pragma unroll
            for (int k = 0; k < 4; ++k) { sel_e[tid * 4 + k] = ti[k]; sel_w[tid * 4 + k] = wv[k]; sel_r[tid * 4 + k] = atomicAdd((int*)&lcnt[ti[k]], 1); }
        }
        __syncthreads();
        if (tid < 32) lbase[tid] = (lcnt[tid] > 0) ? atomicAdd((int*)(ws + WS_CTL) + CW_CNT + tid, lcnt[tid]) : 0;
        __syncthreads();
        if (tid < 256) { const int tl = tid >> 2, k = tid & 3, t = t0 + tl; const int e = sel_e[tid], pos = lbase[e] + sel_r[tid]; const float w = sel_w[tid];
            ((int*)(ws + WS_TOKE))[t * 4 + k] = e; ((int*)(ws + WS_TOKPOS))[t * 4 + k] = pos; ((float*)(ws + WS_TOKW))[t * 4 + k] = w;
            ((int*)(ws + WS_LIST))[(size_t)e * T_ + pos] = t; ((float*)(ws + WS_WLIST))[(size_t)e * T_ + pos] = w; }
    }
}
__device__ __forceinline__ void moe_tables(const Params& p, LAS int* pt, LAS int* cn) {
    __syncthreads();
    if (threadIdx.x == 0) { const int* cnt = (const int*)(p.ws + WS_CTL) + CW_CNT; int a = 0;
        for (int e = 0; e < NE; ++e) { const int c = __hip_atomic_load(cnt + e, __ATOMIC_RELAXED, __HIP_MEMORY_SCOPE_AGENT); cn[e] = c; pt[e] = a; a += (c + 255) >> 8; }
        pt[NE] = a; }
    __syncthreads();
}
__device__ __forceinline__ void phase_final(const Params& p, const LAS int* pt) {
    const int tid = threadIdx.x, wave = tid >> 6, lane = tid & 63;
    const unsigned char* ws = p.ws;
    const float* x2 = (const float*)(ws + WS_X2); const bf16_t* ys = (const bf16_t*)(ws + WS_YS);
    const int* toke = (const int*)(ws + WS_TOKE); const int* tokpos = (const int*)(ws + WS_TOKPOS);
    const int gw = vwg() * NWAVE + wave, NGW = (int)gridDim.x * NWAVE;
    for (int t = gw; t < T_; t += NGW) {
        const f32x4* xr = (const f32x4*)(x2 + (size_t)t * DM) + lane;
        f32x4 v[8];
#pragma unroll
        for (int j = 0; j < 8; ++j) v[j] = xr[64 * j];
#pragma unroll
        for (int k = 0; k < 4; ++k) { const int e = toke[t * 4 + k]; const size_t slot = (size_t)pt[e] * 256 + tokpos[t * 4 + k];
            const u32x2* yr = (const u32x2*)(ys + slot * DM) + lane;
#pragma unroll
            for (int j = 0; j < 8; ++j) { const u32x2 w = yr[64 * j]; v[j][0] += bflo(w.x); v[j][1] += bfhi(w.x); v[j][2] += bflo(w.y); v[j][3] += bfhi(w.y); } }
        float s = 0.f;
#pragma unroll
        for (int j = 0; j < 8; ++j) s += (v[j][0] * v[j][0] + v[j][1] * v[j][1]) + (v[j][2] * v[j][2] + v[j][3] * v[j][3]);
        const float r = rsqrtf(wsum(s) * (1.0f / DM) + 1e-5f);
        const f32x4* gr = (const f32x4*)p.in[18] + lane; f32x4* orow = (f32x4*)(p.out + (size_t)t * DM) + lane;
#pragma unroll
        for (int j = 0; j < 8; ++j) { const f32x4 gg = gr[64 * j]; orow[64 * j] = (f32x4){v[j][0] * r * gg[0], v[j][1] * r * gg[1], v[j][2] * r * gg[2], v[j][3] * r * gg[3]}; }
    }
}
__device__ __forceinline__ void phase_proj(const Params& p, LAS unsigned char* lds) {
    SchedProj S{p.ws}; EpiProj E{p.ws};
    gemm_phase<EpiProj, SchedProj, true>(lds, 2048, 2048, 2048, S, E);
}
__device__ __forceinline__ void phase_mixers(const Params& p, LAS unsigned char* lds) {
    unsigned char* ws = p.ws;
#pragma unroll 1
    for (int u = vwg(); u < 512; u += (int)gridDim.x) attn_unit(p, lds, u >> 6, (u >> 4) & 3, u & 15);
    asm volatile("s_waitcnt vmcnt(0) lgkmcnt(0)" ::: "memory");
    __syncthreads();
    {
        const int u = vwg(); const bool valid = u < 256; const int mh = u & 3, tb = (u >> 2) & 7, b = (u >> 5) & 7;
        const size_t tok0 = (size_t)b * S_ + (size_t)tb * 256;
        bf16_t* Pt = (bf16_t*)(ws + WS_PM) + tok0 * 1024 + mh * 256;
        SchedOne S1{(const char*)(ws + WS_QM) + (tok0 * 1024 + mh * 256) * 2, (const char*)(ws + WS_KMK) + ((size_t)b * 256 * 1024 + mh * 256) * 2, 0, valid};
        EpiMemSoftmax E1{Pt};
        gemm_phase<EpiMemSoftmax, SchedOne, false>(lds, 256, 1024, 1024, S1, E1);
        asm volatile("s_waitcnt vmcnt(0)" ::: "memory");
        __syncthreads();
        SchedOne S2{(const char*)Pt, (const char*)(ws + WS_VMT) + ((size_t)(b * 4 + mh) * 256 * 256) * 2, 0, valid};
        EpiTile E2{(bf16_t*)(ws + WS_XM) + tok0 * 1024 + mh * 256, 1024};
        gemm_phase<EpiTile, SchedOne, false>(lds, 256, 1024, 256, S2, E2);
    }
    { SchedChan S{ws, 0, 0}; EpiChan E{ws}; gemm_phase<EpiChan, SchedChan, true>(lds, 256, 256, 1024, S, E); }
}
__device__ __forceinline__ void phase_seqdft(const Params& p, LAS unsigned char* lds) {
    SchedSeq S{p.ws}; EpiSeq E{p.ws};
    gemm_phase<EpiSeq, SchedSeq, true>(lds, 4096, 4096, 4096, S, E);
}
__device__ __forceinline__ void phase_mix(const Params& p, LAS unsigned char* lds) {
    unsigned char* ws = p.ws;
    { SchedPlain S{(const char*)(ws + WS_FM), (const char*)(ws + WS_WFOT), (size_t)256 * 1024 * 2, (size_t)256 * 1024 * 2, 64, 8}; EpiMix<0> E{ws}; gemm_phase<EpiMix<0>, SchedPlain, true>(lds, 1024, 1024, 1024, S, E); }
    { SchedPlain S{(const char*)(ws + WS_ATT), (const char*)(ws + WS_WAOT), (size_t)256 * 2048 * 2, (size_t)256 * 2048 * 2, 64, 8}; EpiMix<1> E{ws}; gemm_phase<EpiMix<1>, SchedPlain, true>(lds, 2048, 2048, 2048, S, E); }
    { SchedPlain S{(const char*)(ws + WS_XM), (const char*)(ws + WS_WMOT), (size_t)256 * 1024 * 2, (size_t)256 * 1024 * 2, 64, 8}; EpiMix<2> E{ws}; gemm_phase<EpiMix<2>, SchedPlain, true>(lds, 1024, 1024, 1024, S, E); }
}
__device__ __forceinline__ void phase_x2(const Params& p, LAS unsigned char* lds) {
    unsigned char* ws = p.ws;
    SchedPlain S{(const char*)(ws + WS_MIXED), (const char*)(ws + WS_WOT), (size_t)256 * 2048 * 2, (size_t)256 * 2048 * 2, 64, 8};
    EpiRes E{p.in[0], (float*)(ws + WS_X2)};
    gemm_phase<EpiRes, SchedPlain, true>(lds, 2048, 2048, 2048, S, E);
}
__device__ __forceinline__ void phase_gateup(const Params& p, LAS unsigned char* lds) {
    LAS int* pt = (LAS int*)(lds + LDS_MISC); LAS int* cn = pt + 64;
    moe_tables(p, pt, cn);
    SchedMoe<true, 16> S{p.ws, pt, cn}; EpiSwiglu E{p.ws, p.in[15], pt};
    gemm_phase<EpiSwiglu, SchedMoe<true, 16>, true>(lds, 2048, 2048, 2048, S, E);
}
__device__ __forceinline__ void phase_down(const Params& p, LAS unsigned char* lds) {
    LAS int* pt = (LAS int*)(lds + LDS_MISC); LAS int* cn = pt + 64;
    moe_tables(p, pt, cn);
    SchedMoe<false, 8> S{p.ws, pt, cn}; EpiDown E{p.ws, p.in[17], pt, cn};
    gemm_phase<EpiDown, SchedMoe<false, 8>, true>(lds, 2048, 2048, 2048, S, E);
}
__device__ __forceinline__ void phase_out(const Params& p, LAS unsigned char* lds) {
    LAS int* pt = (LAS int*)(lds + LDS_MISC); LAS int* cn = pt + 64;
    moe_tables(p, pt, cn);
    phase_final(p, pt);
}

template <int PH> __global__ void __launch_bounds__(NTHR, 2) k_phase(Params p) {
    extern __shared__ __attribute__((aligned(16))) unsigned char lds_raw[];
    LAS unsigned char* lds = (LAS unsigned char*)lds_raw;
    if constexpr (PH == 0) phase_prologue(p, lds);
    if constexpr (PH == 1) phase_proj(p, lds);
    if constexpr (PH == 2) phase_mixers(p, lds);
    if constexpr (PH == 3) phase_seqdft(p, lds);
    if constexpr (PH == 4) phase_mix(p, lds);
    if constexpr (PH == 5) phase_x2(p, lds);
    if constexpr (PH == 6) phase_rows(p, lds);
    if constexpr (PH == 7) phase_gateup(p, lds);
    if constexpr (PH == 8) phase_down(p, lds);
    if constexpr (PH == 9) phase_out(p, lds);
}
template <int PH> static void launch_phase(const Params& p, hipStream_t st) {
    static bool attr_done = false;
    if (!attr_done) { (void)hipFuncSetAttribute((const void*)k_phase<PH>, hipFuncAttributeMaxDynamicSharedMemorySize, LDS_BYTES); attr_done = true; }
    hipLaunchKernelGGL(k_phase<PH>, dim3(256), dim3(NTHR), LDS_BYTES, st, p);
}
static void run_fast_multi(const Params& p, hipStream_t st, int lo, int hi) {
    if (lo <= 0 && 0 < hi) launch_phase<0>(p, st);
    if (lo <= 1 && 1 < hi) launch_phase<1>(p, st);
    if (lo <= 2 && 2 < hi) launch_phase<2>(p, st);
    if (lo <= 3 && 3 < hi) launch_phase<3>(p, st);
    if (lo <= 4 && 4 < hi) launch_phase<4>(p, st);
    if (lo <= 5 && 5 < hi) launch_phase<5>(p, st);
    if (lo <= 6 && 6 < hi) launch_phase<6>(p, st);
    if (lo <= 7 && 7 < hi) launch_phase<7>(p, st);
    if (lo <= 8 && 8 < hi) launch_phase<8>(p, st);
    if (lo <= 9 && 9 < hi) launch_phase<9>(p, st);
}
}
#ifndef REPORT
#define REPORT 0
#endif
extern "C" void kernel_launch(void* const* d_in, const int* in_sizes, int n_in, void* d_out, int out_size, void* d_ws, size_t ws_size, hipStream_t stream) {
    (void)in_sizes; (void)n_in; (void)out_size; (void)ws_size;
    unsigned char* ws = (unsigned char*)d_ws;
#if MODE == 0
    nv::NBuf nb; nv::carve(nb, ws);
    nv::run_part1(d_in, nb, stream); nv::run_part2(d_in, nb, (float*)d_out, stream);
#elif MODE == 1
    constexpr size_t NAIVE_BASE = (fx::WS_FAST_END + 4095) & ~(size_t)4095;
    nv::NBuf nb; const size_t nbytes = nv::carve(nb, ws + NAIVE_BASE);
    float* fout = (float*)(ws + NAIVE_BASE + ((nbytes + 4095) & ~(size_t)4095));
    double* acc = (double*)(fout + (size_t)16384 * 2048); float* scale = (float*)(acc + 64);
    fx::Params p; memset(&p, 0, sizeof(p));
    for (int i = 0; i < 19; ++i) p.in[i] = (const float*)d_in[i];
    p.out = fout; p.ws = ws;
    (void)hipMemsetAsync(ws + fx::WS_CTL, 0, fx::CTL_BYTES, stream);
    (void)hipMemsetAsync(acc, 0, 1024, stream);
    nv::run_part1(d_in, nb, stream);
    fx::run_fast_multi(p, stream, 0, 7);
    auto cmp = [&](int slot, int kind, const void* a, const float* ref, long long n, int w, int ldf, int ldr, int off, int sig) {
        ck::CP c; memset(&c, 0, sizeof(c)); c.a = a; c.ref = ref; c.n = n; c.kind = kind; c.w = w; c.ldf = ldf; c.ldr = ldr; c.off = off; c.sig = sig; c.slot = slot;
        hipLaunchKernelGGL(ck::k_cmp, dim3(2048), dim3(256), 0, stream, c, acc); };
    const long long T = 16384;
    cmp(0, 0, ws + fx::WS_FIN, nb.proj, T * 1024, 1024, 1024, 10752, 0, 0);
    cmp(1, 0, ws + fx::WS_Q, nb.proj, T * 2048, 2048, 2048, 10752, 1024, 0);
    cmp(2, 0, ws + fx::WS_K, nb.proj, T * 256, 256, 256, 10752, 3072, 0);
    cmp(3, 2, ws + fx::WS_VT, nb.proj, T * 256, 0, 0, 0, 0, 0);
    cmp(4, 0, ws + fx::WS_QM, nb.proj, T * 1024, 1024, 1024, 10752, 3584, 0);
    cmp(5, 0, ws + fx::WS_GATES, nb.proj, T * 6144, 6144, 6144, 10752, 4608, 1);
    cmp(6, 0, ws + fx::WS_KMK, nb.kvm, 2048LL * 1024, 1024, 1024, 2048, 0, 0);
    cmp(7, 3, ws + fx::WS_VMT, nb.kvm, 2048LL * 1024, 0, 0, 0, 0, 0);
    cmp(8, 0, ws + fx::WS_ATT, nb.att, T * 2048, 2048, 2048, 2048, 0, 0);
    cmp(9, 0, ws + fx::WS_XM, nb.xm, T * 1024, 1024, 1024, 1024, 0, 0);
    cmp(10, 0, ws + fx::WS_FM, nb.fm, T * 1024, 1024, 1024, 1024, 0, 0);
    cmp(11, 0, ws + fx::WS_MIXED, nb.mixed, T * 2048, 2048, 2048, 2048, 0, 0);
    cmp(12, 1, ws + fx::WS_X2, nb.x2, T * 2048, 2048, 2048, 2048, 0, 0);
    cmp(13, 0, ws + fx::WS_H2, nb.h2, T * 2048, 2048, 2048, 2048, 0, 0);
    hipLaunchKernelGGL(ck::k_cmp_route, dim3(64), dim3(256), 0, stream, (const int*)(ws + fx::WS_TOKE), (const int*)nb.tope, acc, 14);
    nv::run_part2(d_in, nb, nb.nout, stream);
    fx::run_fast_multi(p, stream, 7, 10);
    cmp(15, 1, fout, nb.nout, T * 2048, 2048, 2048, 2048, 0, 0);
    hipLaunchKernelGGL(ck::k_verdict, dim3(1), dim3(64), 0, stream, (const double*)acc, scale, 16, (int)REPORT);
    hipLaunchKernelGGL(ck::k_scale_out, dim3(2048), dim3(256), 0, stream, (const float*)nb.nout, (const float*)scale, (float*)d_out, T * 2048);
#elif MODE == 2
    fx::Params p; memset(&p, 0, sizeof(p));
    for (int i = 0; i < 19; ++i) p.in[i] = (const float*)d_in[i];
    p.out = (float*)d_out; p.ws = ws;
    (void)hipMemsetAsync(ws + fx::WS_CTL, 0, fx::CTL_BYTES, stream);
    fx::run_fast_multi(p, stream, 0, 10);
#endif
}
```

```cpp
#include <hip/hip_runtime.h>
#include <stdint.h>
#include <string.h>
#ifndef MODE
#define MODE 3
#endif
namespace fx {
#define LAS __attribute__((address_space(3)))
typedef unsigned short bf16_t;
typedef short bf16x8 __attribute__((ext_vector_type(8)));
typedef short s16x4 __attribute__((ext_vector_type(4)));
typedef float f32x4 __attribute__((ext_vector_type(4)));
typedef float f32x16 __attribute__((ext_vector_type(16)));
typedef float f32x2 __attribute__((ext_vector_type(2)));
typedef __bf16 bf16x2_t __attribute__((ext_vector_type(2)));
typedef unsigned u32x4 __attribute__((ext_vector_type(4)));
typedef unsigned u32x2 __attribute__((ext_vector_type(2)));

constexpr int NTHR = 512, NWAVE = 8;
constexpr int B_ = 8, S_ = 2048, DM = 2048, T_ = B_ * S_;
constexpr int MEM = 256, FW = 1024, FG = 4, FGD = 256;
constexpr int NH = 32, NKV = 4, HD = 64, AW = 2048, KVW = 256, WIN = 128;
constexpr int MH = 4, MHD = 256, MW = 1024;
constexpr int NE = 32, TOPK = 4, DFF = 2048;
constexpr int INW = 10752;
constexpr int NSLOT = T_ * TOPK + NE * 256;
constexpr float LOG2E = 1.4426950408889634f;

constexpr size_t al256(size_t x) { return (x + 255) & ~(size_t)255; }
constexpr size_t WS_CTL = 0, CTL_BYTES = 65536;
constexpr size_t WS_WINT = 1u << 20;
constexpr size_t WS_WMKVT = WS_WINT + (size_t)INW * DM * 2;
constexpr size_t WS_WFOT = WS_WMKVT + (size_t)2048 * 2048 * 2;
constexpr size_t WS_WAOT = WS_WFOT + (size_t)2048 * 1024 * 2;
constexpr size_t WS_WMOT = WS_WAOT + (size_t)2048 * 2048 * 2;
constexpr size_t WS_WOT = WS_WMOT + (size_t)2048 * 1024 * 2;
constexpr size_t WS_WRT = WS_WOT + (size_t)2048 * 2048 * 2;
constexpr size_t WS_TABT = WS_WRT + (size_t)NE * DM * 2;
constexpr size_t WS_DMAT = WS_TABT + (size_t)512 * 256 * 2;
constexpr size_t WS_WGUT = WS_DMAT + (size_t)2048 * 4096 * 2;
constexpr size_t WS_WDNT = WS_WGUT + (size_t)NE * 4096 * 2048 * 2;
constexpr size_t WS_H = WS_WDNT + (size_t)NE * 2048 * 2048 * 2;
constexpr size_t WS_MEMBF = WS_H + (size_t)T_ * DM * 2;
constexpr size_t WS_FIN = WS_MEMBF + (size_t)2048 * 2048 * 2;
constexpr size_t WS_Q = WS_FIN + (size_t)T_ * FW * 2;
constexpr size_t WS_K = WS_Q + (size_t)T_ * AW * 2;
constexpr size_t WS_VT = WS_K + (size_t)T_ * KVW * 2;
constexpr size_t WS_QM = WS_VT + (size_t)T_ * KVW * 2;
constexpr size_t WS_GATES = WS_QM + (size_t)T_ * MW * 2;
constexpr size_t WS_KMK = WS_GATES + (size_t)T_ * 3 * DM * 2;
constexpr size_t WS_VMT = WS_KMK + (size_t)2048 * 1024 * 2;
constexpr size_t WS_ZT = WS_VMT + (size_t)2048 * 1024 * 2;
constexpr size_t WS_FM = WS_ZT + (size_t)32 * 256 * 4096 * 2;
constexpr size_t WS_ATT = WS_FM + (size_t)T_ * FW * 2;
constexpr size_t WS_PM = WS_ATT + (size_t)T_ * AW * 2;
constexpr size_t WS_XM = WS_PM + (size_t)T_ * MH * 256 * 2;
constexpr size_t WS_MIXACC = WS_XM + (size_t)T_ * MW * 2;
constexpr size_t WS_MIXED = WS_MIXACC + (size_t)T_ * DM * 4;
constexpr size_t WS_X2 = WS_MIXED + (size_t)T_ * DM * 2;
constexpr size_t WS_H2 = WS_X2 + (size_t)T_ * DM * 4;
constexpr size_t WS_TOKE = WS_H2 + (size_t)T_ * DM * 2;
constexpr size_t WS_TOKPOS = WS_TOKE + (size_t)T_ * 4 * 4;
constexpr size_t WS_TOKW = WS_TOKPOS + (size_t)T_ * 4 * 4;
constexpr size_t WS_LIST = WS_TOKW + (size_t)T_ * 4 * 4;
constexpr size_t WS_WLIST = WS_LIST + (size_t)NE * T_ * 4;
constexpr size_t WS_FAST_END = WS_WLIST + (size_t)NE * T_ * 4;
constexpr size_t WS_ACT = WS_H;
constexpr size_t WS_YS = WS_ACT + (size_t)NSLOT * DFF * 2;
static_assert(WS_YS + (size_t)NSLOT * DM * 2 <= WS_MIXED, "overlay fits");
constexpr int CW_CNT = 0;
constexpr int CW_BAR = 4096;

constexpr int LDS_STAGE = 0, STAGE_BYTES = 131072;
constexpr int LDS_MISC = STAGE_BYTES;
constexpr int LDS_BYTES = 147456;

struct Params {
    const float* in[19]; float* out; unsigned char* ws;
};

__device__ __forceinline__ unsigned cvtpk(float lo, float hi) { f32x2 v = {lo, hi}; bf16x2_t b = __builtin_convertvector(v, bf16x2_t); return __builtin_bit_cast(unsigned, b); }
__device__ __forceinline__ float bf2f(unsigned short x) { return __uint_as_float(((unsigned)x) << 16); }
__device__ __forceinline__ float bflo(unsigned w) { return __uint_as_float(w << 16); }
__device__ __forceinline__ float bfhi(unsigned w) { return __uint_as_float(w & 0xffff0000u); }
__device__ __forceinline__ float wsum(float v) {
#pragma unroll
    for (int o = 1; o < 64; o <<= 1) v += __shfl_xor(v, o);
    return v;
}
__device__ __forceinline__ float sigmoidf_(float x) { return 1.0f / (1.0f + __builtin_amdgcn_exp2f(-x * LOG2E)); }
__device__ __forceinline__ int crow(int r, int h) { return (r & 3) + 8 * (r >> 2) + 4 * h; }
__device__ __forceinline__ int t5_bucket(int rel) {
    const int n = rel < 0 ? -rel : rel;
    int b;
    if (n < 8) b = n; else if (n < 12) b = 8; else if (n < 16) b = 9; else if (n < 23) b = 10; else if (n < 32) b = 11;
    else if (n < 46) b = 12; else if (n < 64) b = 13; else if (n < 91) b = 14; else b = 15;
    return (rel > 0 ? 16 : 0) + b;
}
__device__ __forceinline__ int vwg() { const int c = blockIdx.x, G = gridDim.x; return ((G & 7) == 0) ? (c & 7) * (G >> 3) + (c >> 3) : c; }

constexpr int BM = 256, BK = 64, HALF = 128, HTB = HALF * BK * 2;
__host__ __device__ __forceinline__ int lds_byte(int r, int c) { const int st = (r >> 4) * 2 + (c >> 5), rr = r & 15, cc = c & 31, ob = rr * 64 + cc * 2; return st * 1024 + (ob ^ (((ob >> 9) & 1) << 5)); }
__host__ __device__ __forceinline__ void stage_rc(int b, int& R, int& C) { const int st = b / 1024, sb = b % 1024, swz = sb ^ (((sb >> 9) & 1) << 5); R = (st >> 1) * 16 + swz / 64; C = (st & 1) * 32 + (swz % 64) / 2; }
__host__ __device__ __forceinline__ int perm32(int rho) { const int n = rho >> 4, i = rho & 15; return 8 * (i >> 2) + 4 * n + (i & 3); }

struct Unit { int pm, pn, z; };

template <class Epi, class Sched, bool ALIGN_EPI>
__device__ __forceinline__ void gemm_phase(LAS unsigned char* lds, const int K, const int lda, const int ldb, const Sched& S, const Epi& E) {
    int tid_ = threadIdx.x; asm volatile("" : "+v"(tid_));
    const int tid = tid_, wid = __builtin_amdgcn_readfirstlane(tid >> 6), lane = tid & 63, wr = wid >> 2, wc = wid & 3, fr = lane & 15, fq = lane >> 4;
    const int nt = K / BK;
    constexpr bool GATHER = Sched::GATHER;
    unsigned voffA[2], voffB[2]; int Rr[2], Cb[2];
#pragma unroll
    for (int i = 0; i < 2; ++i) { int R, C; stage_rc(tid * 16 + i * 8192, R, C); const int Rb = Epi::PERM ? ((R & ~31) + perm32(R & 31)) : R;
        voffA[i] = (unsigned)(R * lda + C) * 2u; voffB[i] = (unsigned)(Rb * ldb + C) * 2u; Rr[i] = R; Cb[i] = C * 2; }
    const size_t kstep = (size_t)(BK * 2);
    const size_t hstepA = (size_t)HALF * lda * 2, hstepB = (size_t)HALF * ldb * 2;
    const unsigned ldsw = (unsigned)wid * 1024u;
    const int aoff = lds_byte(wr * 64 + fr, fq * 8), boff = lds_byte(wc * 32 + fr, fq * 8);
#define PG8_SA(b, h) (((b) * 2 + (h)) * HTB)
#define PG8_SB(b, h) ((4 + (b) * 2 + (h)) * HTB)
#define PG8_STAGE(bufoff, gbase, voff) do { _Pragma("unroll") for (int _i = 0; _i < 2; ++_i) \
        __builtin_amdgcn_global_load_lds((const unsigned*)((const char*)(gbase) + (voff)[_i]), (LAS unsigned*)(lds + (bufoff) + ldsw + _i * 8192), 16, 0, 0); } while (0)
#define PG8_STAGE_A(bufoff, gbase, h, NX) do { if constexpr (GATHER) { _Pragma("unroll") for (int _i = 0; _i < 2; ++_i) { const unsigned _o = (NX) ? naoff[h][_i] : caoff[h][_i]; \
        __builtin_amdgcn_global_load_lds((const unsigned*)((const char*)(gbase) + _o), (LAS unsigned*)(lds + (bufoff) + ldsw + _i * 8192), 16, 0, 0); } } \
        else { PG8_STAGE(bufoff, (const char*)(gbase) + (h) * hstepA, voffA); } } while (0)
#define PG8_LDA(dst, b, h) do { _Pragma("unroll") for (int m = 0; m < 4; ++m) _Pragma("unroll") for (int k = 0; k < 2; ++k) dst[m][k] = *(const LAS bf16x8*)(lds + PG8_SA(b, h) + aoff + m * 2048 + k * 1024); } while (0)
#define PG8_LDB(dst, b, h) do { _Pragma("unroll") for (int n = 0; n < 2; ++n) _Pragma("unroll") for (int k = 0; k < 2; ++k) dst[n][k] = *(const LAS bf16x8*)(lds + PG8_SB(b, h) + boff + n * 2048 + k * 1024); } while (0)
#define PG8_MMA(ai, bj, At, Bt) do { __builtin_amdgcn_s_setprio(1); _Pragma("unroll") for (int m = 0; m < 4; ++m) _Pragma("unroll") for (int n = 0; n < 2; ++n) _Pragma("unroll") for (int k = 0; k < 2; ++k) \
        acc[ai][bj][m][n] = __builtin_amdgcn_mfma_f32_16x16x32_bf16(Bt[n][k], At[m][k], acc[ai][bj][m][n], 0, 0, 0); __builtin_amdgcn_s_setprio(0); } while (0)
#define PG8_WAIT_V(n) asm volatile("s_waitcnt vmcnt(" #n ")" ::: "memory")
#define PG8_WAIT_L(n) asm volatile("s_waitcnt lgkmcnt(" #n ")" ::: "memory")
#define PG8_BAR __builtin_amdgcn_s_barrier()
#define PG8_SCHED __builtin_amdgcn_sched_barrier(0)
    Unit cur, nxt; int ui = 0;
    if (!S.next(0, cur)) return;
    f32x4 acc[2][2][4][2];
#pragma unroll
    for (int a = 0; a < 2; ++a)
#pragma unroll
        for (int b = 0; b < 2; ++b)
#pragma unroll
            for (int m = 0; m < 4; ++m)
#pragma unroll
                for (int n = 0; n < 2; ++n) acc[a][b][m][n] = (f32x4){0.f, 0.f, 0.f, 0.f};
    bf16x8 At[4][2], B0[2][2], B1[2][2];
    unsigned caoff[2][2] = {{0u, 0u}, {0u, 0u}}, naoff[2][2] = {{0u, 0u}, {0u, 0u}};
    if constexpr (GATHER) {
#pragma unroll
        for (int h = 0; h < 2; ++h)
#pragma unroll
            for (int i = 0; i < 2; ++i) { caoff[h][i] = S.arow(cur, h * HALF + Rr[i]) + (unsigned)Cb[i]; naoff[h][i] = caoff[h][i]; }
    }
    const char* cA = S.baseA(cur); const char* cB = S.baseB(cur);
    PG8_STAGE(PG8_SB(0, 0), cB, voffB); PG8_STAGE(PG8_SB(0, 1), cB + hstepB, voffB); PG8_STAGE_A(PG8_SA(0, 0), cA, 0, false); PG8_STAGE_A(PG8_SA(0, 1), cA, 1, false);
    if (wr == 1) PG8_BAR;
    PG8_WAIT_V(2); PG8_BAR;
    PG8_STAGE(PG8_SB(1, 0), cB + kstep, voffB); PG8_STAGE_A(PG8_SA(1, 0), cA + kstep, 0, false); PG8_STAGE(PG8_SB(1, 1), cB + hstepB + kstep, voffB);
    PG8_WAIT_V(6); PG8_BAR;
    for (;;) {
        const bool has_next = S.next(ui + 1, nxt);
        const char* nA = has_next ? S.baseA(nxt) : cA; const char* nB = has_next ? S.baseB(nxt) : cB;
        if constexpr (GATHER) {
            if (has_next) {
#pragma unroll
                for (int h = 0; h < 2; ++h)
#pragma unroll
                    for (int i = 0; i < 2; ++i) naoff[h][i] = S.arow(nxt, h * HALF + Rr[i]) + (unsigned)Cb[i];
            } else {
#pragma unroll
                for (int h = 0; h < 2; ++h)
#pragma unroll
                    for (int i = 0; i < 2; ++i) naoff[h][i] = caoff[h][i];
            }
        }
#pragma unroll 1
        for (int t = 0; t < nt; t += 2) {
            const bool last = (t == nt - 2);
            const char* a1 = cA + (size_t)(t + 1) * kstep;
            const char* a2 = last ? nA : cA + (size_t)(t + 2) * kstep; const char* b2 = last ? nB : cB + (size_t)(t + 2) * kstep;
            const char* a3 = a2 + kstep; const char* b3 = b2 + kstep;
            PG8_LDB(B0, 0, 0); PG8_LDB(B1, 0, 1); PG8_SCHED; PG8_LDA(At, 0, 0); PG8_STAGE_A(PG8_SA(1, 1), a1, 1, false);
            PG8_WAIT_V(8); PG8_WAIT_L(0); PG8_BAR; PG8_MMA(0, 0, At, B0); PG8_MMA(0, 1, At, B1); PG8_BAR; PG8_SCHED;
            PG8_LDA(At, 0, 1); PG8_STAGE(PG8_SB(0, 0), b2, voffB); PG8_STAGE(PG8_SB(0, 1), b2 + hstepB, voffB); PG8_STAGE_A(PG8_SA(0, 0), a2, 0, last);
            PG8_WAIT_V(8); PG8_WAIT_L(0); PG8_BAR; PG8_MMA(1, 0, At, B0); PG8_MMA(1, 1, At, B1); PG8_BAR; PG8_SCHED;
            PG8_LDB(B0, 1, 0); PG8_LDB(B1, 1, 1); PG8_SCHED; PG8_LDA(At, 1, 0); PG8_STAGE_A(PG8_SA(0, 1), a2, 1, last);
            PG8_WAIT_V(8); PG8_WAIT_L(0); PG8_BAR; PG8_MMA(0, 0, At, B0); PG8_MMA(0, 1, At, B1); PG8_BAR; PG8_SCHED;
            PG8_LDA(At, 1, 1); PG8_STAGE(PG8_SB(1, 0), b3, voffB); PG8_STAGE(PG8_SB(1, 1), b3 + hstepB, voffB); PG8_STAGE_A(PG8_SA(1, 0), a3, 0, last);
            PG8_WAIT_V(8); PG8_WAIT_L(0); PG8_BAR; PG8_MMA(1, 0, At, B0); PG8_MMA(1, 1, At, B1); PG8_BAR; PG8_SCHED;
        }
        if constexpr (ALIGN_EPI) { if (wr == 0) PG8_BAR; }
        if constexpr (!Epi::AFTER_DRAIN) { int fr_e = fr, fq_e = fq; asm volatile("" : "+v"(fr_e), "+v"(fq_e));
            E(acc, cur, wr, wc, fr_e, fq_e); }
        if (!has_next) break;
#pragma unroll
        for (int a = 0; a < 2; ++a)
#pragma unroll
            for (int b = 0; b < 2; ++b)
#pragma unroll
                for (int m = 0; m < 4; ++m)
#pragma unroll
                    for (int n = 0; n < 2; ++n) acc[a][b][m][n] = (f32x4){0.f, 0.f, 0.f, 0.f};
        cur = nxt; cA = nA; cB = nB; ++ui;
        if constexpr (GATHER) {
#pragma unroll
            for (int h = 0; h < 2; ++h)
#pragma unroll
                for (int i = 0; i < 2; ++i) caoff[h][i] = naoff[h][i];
        }
        if constexpr (ALIGN_EPI) { if (wr == 1) PG8_BAR; }
    }
    PG8_WAIT_V(0);
    if constexpr (!ALIGN_EPI) { if (wr == 0) PG8_BAR; }
    PG8_BAR;
    if constexpr (Epi::AFTER_DRAIN) { int fr_e = fr, fq_e = fq; asm volatile("" : "+v"(fr_e), "+v"(fq_e)); E.fused(acc, cur, wr, wc, fr_e, fq_e, lds, wid, lane); }
#undef PG8_SA
#undef PG8_SB
#undef PG8_STAGE
#undef PG8_STAGE_A
#undef PG8_LDA
#undef PG8_LDB
#undef PG8_MMA
#undef PG8_WAIT_V
#undef PG8_WAIT_L
#undef PG8_BAR
#undef PG8_SCHED
}
constexpr int NXCD = 8, WGM = 8;
__device__ __forceinline__ void static_tile(int L, int nM, int nN, int& pm, int& pn) {
    const int nwg = nM * nN; int wgid = L;
    { const int q = nwg / NXCD, r = nwg % NXCD, xcd = wgid % NXCD, off = wgid / NXCD; wgid = (xcd < r ? xcd * (q + 1) : r * (q + 1) + (xcd - r) * q) + off; }
    const int nig = WGM * nN, gid = wgid / nig, fm = gid * WGM, gsz = (nM - fm) < WGM ? (nM - fm) : WGM;
    pm = fm + ((wgid % nig) % gsz); pn = (wgid % nig) / gsz;
}
struct SchedPlain {
    static constexpr bool GATHER = false;
    const char* A; const char* Bt; size_t tstepA, tstepB; int nM, nN;
    __device__ __forceinline__ bool next(int i, Unit& u) const { const int L = i * (int)gridDim.x + (int)blockIdx.x; if (L >= nM * nN) return false; static_tile(L, nM, nN, u.pm, u.pn); u.z = 0; return true; }
    __device__ __forceinline__ const char* baseA(const Unit& u) const { return A + (size_t)u.pm * tstepA; }
    __device__ __forceinline__ const char* baseB(const Unit& u) const { return Bt + (size_t)u.pn * tstepB; }
    __device__ __forceinline__ unsigned arow(const Unit&, int) const { return 0u; }
};
struct SchedProj {
    static constexpr bool GATHER = false;
    const unsigned char* ws;
    __device__ __forceinline__ bool next(int i, Unit& u) const {
        const int L = i * (int)gridDim.x + (int)blockIdx.x;
        if (L < 64 * 42) { static_tile(L, 64, 42, u.pm, u.pn); u.z = (u.pn == 13) ? 2 : 0; return true; }
        const int L2 = L - 64 * 42; if (L2 >= 64) return false;
        if (L2 < 32) { u.pm = L2 & 7; u.pn = L2 >> 3; u.z = 1; } else { u.pm = (L2 - 32) & 3; u.pn = (L2 - 32) >> 2; u.z = 3; }
        return true;
    }
    __device__ __forceinline__ const char* baseA(const Unit& u) const {
        const size_t ts = (size_t)256 * 2048 * 2;
        if (u.z == 0) return (const char*)ws + WS_H + (size_t)u.pm * ts;
        if (u.z == 2) return (const char*)ws + WS_WINT + (size_t)13 * ts;
        if (u.z == 1) return (const char*)ws + WS_MEMBF + (size_t)u.pm * ts;
        return (const char*)ws + WS_WMKVT + (size_t)(4 + u.pm) * ts;
    }
    __device__ __forceinline__ const char* baseB(const Unit& u) const {
        const size_t ts = (size_t)256 * 2048 * 2;
        if (u.z == 0) return (const char*)ws + WS_WINT + (size_t)u.pn * ts;
        if (u.z == 2) return (const char*)ws + WS_H + (size_t)u.pm * ts;
        if (u.z == 1) return (const char*)ws + WS_WMKVT + (size_t)u.pn * ts;
        return (const char*)ws + WS_MEMBF + (size_t)u.pn * ts;
    }
    __device__ __forceinline__ unsigned arow(const Unit&, int) const { return 0u; }
};
struct SchedChan {
    static constexpr bool GATHER = false;
    const unsigned char* ws; int u0, nu;
    __device__ __forceinline__ bool next(int i, Unit& u) const {
        const int L = i * (int)gridDim.x + vwg(); if (L >= 512) return false;
        u.z = L >> 4; u.pm = (L >> 3) & 1; u.pn = L & 7; return true;
    }
    __device__ __forceinline__ const char* baseA(const Unit& u) const { return (const char*)ws + WS_TABT + (size_t)u.pm * (256 * 256 * 2); }
    __device__ __forceinline__ const char* baseB(const Unit& u) const { const int b = u.z >> 2, g = u.z & 3; return (const char*)ws + WS_FIN + ((size_t)(b * 2048 + u.pn * 256) * 1024 + g * 256) * 2; }
    __device__ __forceinline__ unsigned arow(const Unit&, int) const { return 0u; }
};
struct SchedSeq {
    static constexpr bool GATHER = false;
    const unsigned char* ws;
    __device__ __forceinline__ bool next(int i, Unit& u) const {
        const int L = i * (int)gridDim.x + vwg(); if (L >= 256) return false;
        u.z = L >> 3; u.pm = L & 7; u.pn = 0; return true;
    }
    __device__ __forceinline__ const char* baseA(const Unit& u) const { return (const char*)ws + WS_DMAT + (size_t)u.pm * (256 * 4096 * 2); }
    __device__ __forceinline__ const char* baseB(const Unit& u) const { return (const char*)ws + WS_ZT + (size_t)u.z * (256 * 4096 * 2); }
    __device__ __forceinline__ unsigned arow(const Unit&, int) const { return 0u; }
};
struct SchedOne {
    static constexpr bool GATHER = false;
    const char* A; const char* Bt; int z; bool valid;
    __device__ __forceinline__ bool next(int i, Unit& u) const { if (i != 0 || !valid) return false; u.pm = 0; u.pn = 0; u.z = z; return true; }
    __device__ __forceinline__ const char* baseA(const Unit&) const { return A; }
    __device__ __forceinline__ const char* baseB(const Unit&) const { return Bt; }
    __device__ __forceinline__ unsigned arow(const Unit&, int) const { return 0u; }
};
template <bool GATH, int NT  >
struct SchedMoe {
    static constexpr bool GATHER = GATH;
    const unsigned char* ws; const LAS int* pt; const LAS int* cn;
    __device__ __forceinline__ bool next(int i, Unit& u) const {
        const int L = i * (int)gridDim.x + vwg(); const int total = pt[NE] * NT; if (L >= total) return false;
        int e = 0;
#pragma unroll 1
        for (int k = 1; k < NE; ++k) if (L >= pt[k] * NT) e = k;
        const int t = L - pt[e] * NT, mte = pt[e + 1] - pt[e];
        u.z = e; u.pm = t % mte; u.pn = t / mte; return true;
    }
    __device__ __forceinline__ const char* baseA(const Unit& u) const {
        if constexpr (GATH) return (const char*)ws + WS_H2;
        else return (const char*)ws + WS_ACT + (size_t)(pt[u.z] + u.pm) * (256 * 2048 * 2);
    }
    __device__ __forceinline__ const char* baseB(const Unit& u) const {
        if constexpr (GATH) return (const char*)ws + WS_WGUT + ((size_t)u.z * 4096 + (size_t)u.pn * 256) * (2048 * 2);
        else return (const char*)ws + WS_WDNT + ((size_t)u.z * 2048 + (size_t)u.pn * 256) * (2048 * 2);
    }
    __device__ __forceinline__ unsigned arow(const Unit& u, int r) const {
        const int pos = u.pm * 256 + r;
        const int* list = (const int*)(ws + WS_LIST);
        const int tok = (pos < cn[u.z]) ? list[(size_t)u.z * T_ + pos] : 0;
        return (unsigned)tok * 4096u;
    }
};

__device__ __forceinline__ void store_tile_bf16(const f32x4 (&acc)[2][2][4][2], bf16_t* dst  , size_t ldc, int wr, int wc, int fr, int fq) {
    const int row0 = wr * 64 + fr, col0 = wc * 32 + 8 * fq;
#pragma unroll
    for (int ai = 0; ai < 2; ++ai)
#pragma unroll
        for (int m = 0; m < 4; ++m) { bf16_t* rowp = dst + (size_t)(row0 + ai * HALF + m * 16) * ldc + col0;
#pragma unroll
            for (int bj = 0; bj < 2; ++bj) { const f32x4 v0 = acc[ai][bj][m][0], v1 = acc[ai][bj][m][1];
                u32x4 w; w.x = cvtpk(v0[0], v0[1]); w.y = cvtpk(v0[2], v0[3]); w.z = cvtpk(v1[0], v1[1]); w.w = cvtpk(v1[2], v1[3]);
                *(u32x4*)(rowp + bj * HALF) = w; } }
}
struct EpiProj {
    static constexpr bool PERM = true, AFTER_DRAIN = false;
    unsigned char* ws;
    __device__ __forceinline__ void operator()(const f32x4 (&acc)[2][2][4][2], const Unit& u, int wr, int wc, int fr, int fq) const {
        const int pn = u.pn, pm = u.pm;
        bf16_t* dst; size_t ldc;
        if (u.z == 0) {
            if (pn >= 18) {
                dst = (bf16_t*)(ws + WS_GATES) + (size_t)pm * 256 * 6144 + (pn - 18) * 256;
                const int row0 = wr * 64 + fr, col0 = wc * 32 + 8 * fq;
#pragma unroll
                for (int ai = 0; ai < 2; ++ai)
#pragma unroll
                    for (int m = 0; m < 4; ++m) { bf16_t* rowp = dst + (size_t)(row0 + ai * HALF + m * 16) * 6144 + col0;
#pragma unroll
                        for (int bj = 0; bj < 2; ++bj) { const f32x4 v0 = acc[ai][bj][m][0], v1 = acc[ai][bj][m][1];
                            u32x4 w; w.x = cvtpk(sigmoidf_(v0[0]), sigmoidf_(v0[1])); w.y = cvtpk(sigmoidf_(v0[2]), sigmoidf_(v0[3]));
                            w.z = cvtpk(sigmoidf_(v1[0]), sigmoidf_(v1[1])); w.w = cvtpk(sigmoidf_(v1[2]), sigmoidf_(v1[3]));
                            *(u32x4*)(rowp + bj * HALF) = w; } }
                return;
            }
            if (pn < 4) { dst = (bf16_t*)(ws + WS_FIN) + pn * 256; ldc = 1024; }
            else if (pn < 12) { dst = (bf16_t*)(ws + WS_Q) + (pn - 4) * 256; ldc = 2048; }
            else if (pn == 12) { dst = (bf16_t*)(ws + WS_K); ldc = 256; }
            else { dst = (bf16_t*)(ws + WS_QM) + (pn - 14) * 256; ldc = 1024; }
            dst += (size_t)pm * 256 * ldc;
        } else if (u.z == 2) {
            dst = (bf16_t*)(ws + WS_VT) + (size_t)(pm >> 3) * 256 * 2048 + (size_t)(pm & 7) * 256; ldc = 2048;
        } else if (u.z == 1) {
            dst = (bf16_t*)(ws + WS_KMK) + (size_t)pm * 256 * 1024 + pn * 256; ldc = 1024;
        } else {
            dst = (bf16_t*)(ws + WS_VMT) + (size_t)(pn * 4 + pm) * 256 * 256; ldc = 256;
        }
        store_tile_bf16(acc, dst, ldc, wr, wc, fr, fq);
    }
};
struct EpiChan {
    static constexpr bool PERM = true, AFTER_DRAIN = false;
    unsigned char* ws;
    __device__ __forceinline__ void operator()(const f32x4 (&acc)[2][2][4][2], const Unit& u, int wr, int wc, int fr, int fq) const {
        store_tile_bf16(acc, (bf16_t*)(ws + WS_ZT) + (size_t)u.z * 256 * 4096 + (size_t)u.pm * 2048 + u.pn * 256, 4096, wr, wc, fr, fq);
    }
};
struct EpiSeq {
    static constexpr bool PERM = true, AFTER_DRAIN = false;
    unsigned char* ws;
    __device__ __forceinline__ void operator()(const f32x4 (&acc)[2][2][4][2], const Unit& u, int wr, int wc, int fr, int fq) const {
        const int b = u.z >> 2, g = u.z & 3;
        store_tile_bf16(acc, (bf16_t*)(ws + WS_FM) + (size_t)(b * 2048 + u.pm * 256) * 1024 + g * 256, 1024, wr, wc, fr, fq);
    }
};
template <int STEP> struct EpiMix {
    static constexpr bool PERM = false, AFTER_DRAIN = false;
    unsigned char* ws;
    __device__ __forceinline__ void operator()(const f32x4 (&acc)[2][2][4][2], const Unit& u, int wr, int wc, int fr, int fq) const {
        const int row0 = u.pm * 256 + wr * 64 + fr, col0 = u.pn * 256 + wc * 32 + 4 * fq;
        const bf16_t* gates = (const bf16_t*)(ws + WS_GATES) + STEP * 2048;
        float* macc = (float*)(ws + WS_MIXACC); bf16_t* mixed = (bf16_t*)(ws + WS_MIXED);
#pragma unroll
        for (int ai = 0; ai < 2; ++ai)
#pragma unroll
            for (int m = 0; m < 4; ++m) { const size_t row = (size_t)(row0 + ai * HALF + m * 16);
#pragma unroll
                for (int bj = 0; bj < 2; ++bj)
#pragma unroll
                    for (int n = 0; n < 2; ++n) { const int col = col0 + bj * HALF + n * 16;
                        const u32x2 gw = *(const u32x2*)(gates + row * 6144 + col);
                        f32x4 v = acc[ai][bj][m][n];
                        v[0] *= bflo(gw.x); v[1] *= bfhi(gw.x); v[2] *= bflo(gw.y); v[3] *= bfhi(gw.y);
                        if (STEP > 0) v += *(const f32x4*)(macc + row * 2048 + col);
                        if (STEP < 2) *(f32x4*)(macc + row * 2048 + col) = v;
                        else { u32x2 w; w.x = cvtpk(v[0], v[1]); w.y = cvtpk(v[2], v[3]); *(u32x2*)(mixed + row * 2048 + col) = w; } } }
    }
};
struct EpiRes {
    static constexpr bool PERM = false, AFTER_DRAIN = false;
    const float* x; float* x2;
    __device__ __forceinline__ void operator()(const f32x4 (&acc)[2][2][4][2], const Unit& u, int wr, int wc, int fr, int fq) const {
        const int row0 = u.pm * 256 + wr * 64 + fr, col0 = u.pn * 256 + wc * 32 + 4 * fq;
#pragma unroll
        for (int ai = 0; ai < 2; ++ai)
#pragma unroll
            for (int m = 0; m < 4; ++m) { const size_t off = (size_t)(row0 + ai * HALF + m * 16) * 2048 + col0;
#pragma unroll
                for (int bj = 0; bj < 2; ++bj)
#pragma unroll
                    for (int n = 0; n < 2; ++n) *(f32x4*)(x2 + off + bj * HALF + n * 16) = acc[ai][bj][m][n] + *(const f32x4*)(x + off + bj * HALF + n * 16); }
    }
};
__device__ __forceinline__ float swiglu1(float g, float up) {
    g = fminf(g, 7.0f); up = fminf(fmaxf(up, -7.0f), 7.0f);
    return (up + 1.0f) * (g * sigmoidf_(1.702f * g));
}
struct EpiSwiglu {
    static constexpr bool PERM = true, AFTER_DRAIN = false;
    unsigned char* ws; const float* bgu; const LAS int* pt;
    __device__ __forceinline__ void operator()(const f32x4 (&acc)[2][2][4][2], const Unit& u, int wr, int wc, int fr, int fq) const {
        const int e = u.z; const size_t srow0 = (size_t)(pt[e] + u.pm) * 256 + wr * 64 + fr;
        const int col0 = u.pn * 256 + wc * 32 + 8 * fq;
        bf16_t* act = (bf16_t*)(ws + WS_ACT);
        f32x4 bv[2][2];
#pragma unroll
        for (int bj = 0; bj < 2; ++bj)
#pragma unroll
            for (int n = 0; n < 2; ++n) bv[bj][n] = *(const f32x4*)(bgu + (size_t)e * 4096 + col0 + bj * HALF + 4 * n);
#pragma unroll
        for (int ai = 0; ai < 2; ++ai)
#pragma unroll
            for (int m = 0; m < 4; ++m) { bf16_t* rowp = act + (srow0 + ai * HALF + m * 16) * 2048 + (col0 >> 1);
#pragma unroll
                for (int bj = 0; bj < 2; ++bj) { const f32x4 v0 = acc[ai][bj][m][0] + bv[bj][0], v1 = acc[ai][bj][m][1] + bv[bj][1];
                    u32x2 w; w.x = cvtpk(swiglu1(v0[0], v0[1]), swiglu1(v0[2], v0[3])); w.y = cvtpk(swiglu1(v1[0], v1[1]), swiglu1(v1[2], v1[3]));
                    *(u32x2*)(rowp + bj * (HALF / 2)) = w; } }
    }
};
struct EpiDown {
    static constexpr bool PERM = true, AFTER_DRAIN = false;
    unsigned char* ws; const float* bdn; const LAS int* pt; const LAS int* cn;
    __device__ __forceinline__ void operator()(const f32x4 (&acc)[2][2][4][2], const Unit& u, int wr, int wc, int fr, int fq) const {
        const int e = u.z; const int lrow0 = u.pm * 256 + wr * 64 + fr; const size_t srow0 = (size_t)pt[e] * 256 + lrow0;
        const int col0 = u.pn * 256 + wc * 32 + 8 * fq;
        bf16_t* ys = (bf16_t*)(ws + WS_YS); const float* wl = (const float*)(ws + WS_WLIST) + (size_t)e * T_; const int cne = cn[e];
        f32x4 bv[2][2];
#pragma unroll
        for (int bj = 0; bj < 2; ++bj)
#pragma unroll
            for (int n = 0; n < 2; ++n) bv[bj][n] = *(const f32x4*)(bdn + (size_t)e * 2048 + col0 + bj * HALF + 4 * n);
#pragma unroll
        for (int ai = 0; ai < 2; ++ai)
#pragma unroll
            for (int m = 0; m < 4; ++m) { const int pos = lrow0 + ai * HALF + m * 16; const float w = (pos < cne) ? wl[pos] : 0.f;
                bf16_t* rowp = ys + (srow0 + ai * HALF + m * 16) * 2048 + col0;
#pragma unroll
                for (int bj = 0; bj < 2; ++bj) { const f32x4 v0 = (acc[ai][bj][m][0] + bv[bj][0]) * w, v1 = (acc[ai][bj][m][1] + bv[bj][1]) * w;
                    u32x4 o; o.x = cvtpk(v0[0], v0[1]); o.y = cvtpk(v0[2], v0[3]); o.z = cvtpk(v1[0], v1[1]); o.w = cvtpk(v1[2], v1[3]);
                    *(u32x4*)(rowp + bj * HALF) = o; } }
    }
};
struct EpiMemSoftmax {
    static constexpr bool PERM = true, AFTER_DRAIN = true;
    bf16_t* P;
    __device__ __forceinline__ void operator()(const f32x4 (&)[2][2][4][2], const Unit&, int, int, int, int) const {}
    __device__ __forceinline__ void fused(f32x4 (&acc)[2][2][4][2], const Unit&, int wr, int wc, int fr, int fq, LAS unsigned char* lds, int, int) const {
        LAS f32x2* tab = (LAS f32x2*)lds;
        const float sc = 0.0625f * LOG2E;
        float mx[2][4];
#pragma unroll
        for (int ai = 0; ai < 2; ++ai)
#pragma unroll
            for (int m = 0; m < 4; ++m) { float a = -3.0e38f;
#pragma unroll
                for (int bj = 0; bj < 2; ++bj)
#pragma unroll
                    for (int n = 0; n < 2; ++n) { acc[ai][bj][m][n] *= sc; const f32x4 v = acc[ai][bj][m][n]; a = fmaxf(a, fmaxf(fmaxf(v[0], v[1]), fmaxf(v[2], v[3]))); }
                a = fmaxf(a, __shfl_xor(a, 16)); a = fmaxf(a, __shfl_xor(a, 32)); mx[ai][m] = a;
                float s = 0.f;
#pragma unroll
                for (int bj = 0; bj < 2; ++bj)
#pragma unroll
                    for (int n = 0; n < 2; ++n) { const f32x4 v = acc[ai][bj][m][n]; s += __builtin_amdgcn_exp2f(v[0] - a) + __builtin_amdgcn_exp2f(v[1] - a) + __builtin_amdgcn_exp2f(v[2] - a) + __builtin_amdgcn_exp2f(v[3] - a); }
                s += __shfl_xor(s, 16); s += __shfl_xor(s, 32);
                if (fq == 0) tab[(ai * HALF + wr * 64 + m * 16 + fr) * 4 + wc] = (f32x2){a, s};
            }
        __syncthreads();
#pragma unroll
        for (int ai = 0; ai < 2; ++ai)
#pragma unroll
            for (int m = 0; m < 4; ++m) { const int r = ai * HALF + wr * 64 + m * 16 + fr;
                const f32x2 t0 = tab[r * 4 + 0], t1 = tab[r * 4 + 1], t2 = tab[r * 4 + 2], t3 = tab[r * 4 + 3];
                const float M = fmaxf(fmaxf(t0.x, t1.x), fmaxf(t2.x, t3.x));
                const float L = t0.y * __builtin_amdgcn_exp2f(t0.x - M) + t1.y * __builtin_amdgcn_exp2f(t1.x - M) + t2.y * __builtin_amdgcn_exp2f(t2.x - M) + t3.y * __builtin_amdgcn_exp2f(t3.x - M);
                const float inv = 1.0f / L;
                bf16_t* rowp = P + (size_t)r * 1024 + wc * 32 + 8 * fq;
#pragma unroll
                for (int bj = 0; bj < 2; ++bj) { f32x4 v0 = acc[ai][bj][m][0], v1 = acc[ai][bj][m][1];
#pragma unroll
                    for (int j = 0; j < 4; ++j) { v0[j] = __builtin_amdgcn_exp2f(v0[j] - M) * inv; v1[j] = __builtin_amdgcn_exp2f(v1[j] - M) * inv; }
                    u32x4 w; w.x = cvtpk(v0[0], v0[1]); w.y = cvtpk(v0[2], v0[3]); w.z = cvtpk(v1[0], v1[1]); w.w = cvtpk(v1[2], v1[3]);
                    *(u32x4*)(rowp + bj * HALF) = w; } }
        __syncthreads();
    }
};
struct EpiTile {
    static constexpr bool PERM = true, AFTER_DRAIN = false;
    bf16_t* dst; size_t ldc;
    __device__ __forceinline__ void operator()(const f32x4 (&acc)[2][2][4][2], const Unit&, int wr, int wc, int fr, int fq) const { store_tile_bf16(acc, dst, ldc, wr, wc, fr, fq); }
};
__device__ __forceinline__ void tr_item(const float* W, int K, int N, bf16_t* WT, LAS float* scr, int item, int lane) {
    const int nblk = N / 32, kb = item / nblk, nb = item % nblk, k0 = 64 * kb, n0 = 32 * nb;
#pragma unroll 8
    for (int i = 0; i < 32; ++i) { const int kk = 2 * i + (lane >> 5); scr[kk * 33 + (lane & 31)] = W[(size_t)(k0 + kk) * N + n0 + (lane & 31)]; }
    asm volatile("s_waitcnt lgkmcnt(0)" ::: "memory");
    const int c = lane & 7;
#pragma unroll
    for (int j = 0; j < 4; ++j) { const int n = (lane >> 3) + 8 * j; const LAS float* s = scr + (8 * c) * 33 + n;
        u32x4 o; o.x = cvtpk(s[0 * 33], s[1 * 33]); o.y = cvtpk(s[2 * 33], s[3 * 33]); o.z = cvtpk(s[4 * 33], s[5 * 33]); o.w = cvtpk(s[6 * 33], s[7 * 33]);
        *(u32x4*)(WT + (size_t)(n0 + n) * K + k0 + 8 * c) = o; }
    asm volatile("s_waitcnt lgkmcnt(0)" ::: "memory");
}
__device__ __forceinline__ void rms_row_to_bf16(const float* xrow, const float* g, bf16_t* orow, int lane) {
    const f32x4* xr = (const f32x4*)xrow + lane; const f32x4* gr = (const f32x4*)g + lane;
    f32x4 v[8]; float s = 0.f;
#pragma unroll
    for (int j = 0; j < 8; ++j) { v[j] = xr[64 * j]; s += (v[j][0] * v[j][0] + v[j][1] * v[j][1]) + (v[j][2] * v[j][2] + v[j][3] * v[j][3]); }
    const float r = rsqrtf(wsum(s) * (1.0f / DM) + 1e-5f);
    u32x2* o8 = (u32x2*)orow + lane;
#pragma unroll
    for (int j = 0; j < 8; ++j) { const f32x4 gg = gr[64 * j]; u32x2 w; w.x = cvtpk(v[j][0] * r * gg[0], v[j][1] * r * gg[1]); w.y = cvtpk(v[j][2] * r * gg[2], v[j][3] * r * gg[3]); o8[64 * j] = w; }
}
__device__ __forceinline__ void phase_prologue(const Params& p, LAS unsigned char* lds) {
    int tid_ = threadIdx.x; asm volatile("" : "+v"(tid_));
    const int tid = tid_, wave = tid >> 6, lane = tid & 63;
    unsigned char* ws = p.ws;
    LAS float* scr = (LAS float*)(lds + wave * 16384);
    const int gw = vwg() * NWAVE + wave, NGW = (int)gridDim.x * NWAVE;
    for (int m = gw; m < T_; m += NGW) rms_row_to_bf16(p.in[0] + (size_t)m * DM, p.in[3], (bf16_t*)(ws + WS_H) + (size_t)m * DM, lane);
    for (int m = gw; m < B_ * MEM; m += NGW) {
        const f32x4* xr = (const f32x4*)(p.in[1] + (size_t)m * DM) + lane; u32x2* o8 = (u32x2*)((bf16_t*)(ws + WS_MEMBF) + (size_t)m * DM) + lane;
#pragma unroll
        for (int j = 0; j < 8; ++j) { const f32x4 v = xr[64 * j]; u32x2 w; w.x = cvtpk(v[0], v[1]); w.y = cvtpk(v[2], v[3]); o8[64 * j] = w; }
    }
    {
        const int gt = vwg() * NTHR + tid, NGT = (int)gridDim.x * NTHR;
        bf16_t* tabT = (bf16_t*)(ws + WS_TABT); bf16_t* dm = (bf16_t*)(ws + WS_DMAT);
        for (int i = gt; i < 512 * 256 / 2; i += NGT) { const int e0 = 2 * i; const int mrow = e0 >> 8, c = e0 & 255; const int n = mrow & 255; float v[2];
#pragma unroll
            for (int j = 0; j < 2; ++j) { const int mm = ((c + j) * n) & 255; const float a = (float)mm * (2.0f / 256.0f); v[j] = (mrow < 256) ? cospif(a) : sinpif(a); }
            *(unsigned*)(tabT + e0) = cvtpk(v[0], v[1]); }
        const float sc = 1.0f / sqrtf(2048.0f * 256.0f);
        for (int i = gt; i < 2048 * 4096 / 2; i += NGT) { const int e0 = 2 * i; const int jr = e0 >> 12, k = e0 & 4095; float v[2];
#pragma unroll
            for (int j = 0; j < 2; ++j) { const int kk = (k + j) & 2047; const int mm = (jr * kk) & 2047; const float a = (float)mm * (2.0f / 2048.0f); v[j] = (k < 2048) ? cospif(a) * sc : -sinpif(a) * sc; }
            *(unsigned*)(dm + e0) = cvtpk(v[0], v[1]); }
        bf16_t* wrt = (bf16_t*)(ws + WS_WRT);
        for (int i = gt; i < NE * DM; i += NGT) { const int e = i >> 11, k = i & 2047; wrt[i] = (bf16_t)(cvtpk(p.in[12][(size_t)k * NE + e], 0.f) & 0xffffu); }
    }
    struct Mat { const float* W; int K, N; size_t dst; int nitems; };
    const int I_IN = (DM / 64) * (INW / 32), I_SQ = (2048 / 64) * (2048 / 32), I_HF = (1024 / 64) * (2048 / 32);
    const int I_GU = (2048 / 64) * (4096 / 32), I_DN = I_SQ;
    const long total = (long)I_IN + 3L * I_SQ + 2L * I_HF + (long)NE * I_GU + (long)NE * I_DN;
    for (long it = gw; it < total; it += NGW) {
        long r = it;
        if (r < I_IN) { tr_item(p.in[4], DM, INW, (bf16_t*)(ws + WS_WINT), scr, (int)r, lane); continue; } r -= I_IN;
        if (r < I_SQ) { tr_item(p.in[6], 2048, 2048, (bf16_t*)(ws + WS_WMKVT), scr, (int)r, lane); continue; } r -= I_SQ;
        if (r < I_HF) { tr_item(p.in[7], 1024, 2048, (bf16_t*)(ws + WS_WFOT), scr, (int)r, lane); continue; } r -= I_HF;
        if (r < I_SQ) { tr_item(p.in[8], 2048, 2048, (bf16_t*)(ws + WS_WAOT), scr, (int)r, lane); continue; } r -= I_SQ;
        if (r < I_HF) { tr_item(p.in[9], 1024, 2048, (bf16_t*)(ws + WS_WMOT), scr, (int)r, lane); continue; } r -= I_HF;
        if (r < I_SQ) { tr_item(p.in[10], 2048, 2048, (bf16_t*)(ws + WS_WOT), scr, (int)r, lane); continue; } r -= I_SQ;
        if (r < (long)NE * I_GU) { const int e = (int)(r / I_GU), q = (int)(r % I_GU);
            tr_item(p.in[14] + (size_t)e * 2048 * 4096, 2048, 4096, (bf16_t*)(ws + WS_WGUT) + (size_t)e * 4096 * 2048, scr, q, lane); continue; } r -= (long)NE * I_GU;
        { const int e = (int)(r / I_DN), q = (int)(r % I_DN);
            tr_item(p.in[16] + (size_t)e * 2048 * 2048, 2048, 2048, (bf16_t*)(ws + WS_WDNT) + (size_t)e * 2048 * 2048, scr, q, lane); }
    }
}

constexpr int AT_KROW = 144, AT_VROW = 776;
constexpr int AT_K = 0, AT_V = 384 * AT_KROW, AT_LUT = AT_V + 64 * AT_VROW;
static_assert(AT_LUT + NWAVE * 320 * 4 <= STAGE_BYTES, "attention LDS");
__device__ __forceinline__ void attn_unit(const Params& p, LAS unsigned char* lds, int b, int kvh, int qb) {
    int tid_ = threadIdx.x; asm volatile("" : "+v"(tid_));
    const int tid = tid_, wid = __builtin_amdgcn_readfirstlane(tid >> 6), lane = tid & 63, r = lane & 31, h = lane >> 5;
    const unsigned char* ws = p.ws;
    const bf16_t* Q = (const bf16_t*)(ws + WS_Q); const bf16_t* Kg = (const bf16_t*)(ws + WS_K); const bf16_t* VT = (const bf16_t*)(ws + WS_VT);
    bf16_t* att = (bf16_t*)(p.ws + WS_ATT);
    const int q0 = qb * 128, hq = kvh * 8 + wid;
    LAS unsigned char* Kb = lds + AT_K; LAS unsigned char* Vt = lds + AT_V; LAS float* lut = (LAS float*)(lds + AT_LUT) + wid * 320;
    __syncthreads();
    for (int c = tid; c < 384 * 8; c += NTHR) { const int row = c >> 3, part = c & 7, pos = q0 - 128 + row;
        u32x4 v = {0u, 0u, 0u, 0u};
        if (pos >= 0 && pos < S_) v = *(const u32x4*)(Kg + (size_t)(b * S_ + pos) * 256 + kvh * 64 + part * 8);
        *(LAS u32x4*)(Kb + row * AT_KROW + part * 16) = v; }
    for (int c = tid; c < 64 * 48; c += NTHR) { const int d = c / 48, ch = c % 48, pos0 = q0 - 128 + ch * 8;
        u32x4 v = {0u, 0u, 0u, 0u};
        if (pos0 >= 0 && pos0 < S_) v = *(const u32x4*)(VT + ((size_t)((b * 4 + kvh) * 64 + d)) * 2048 + pos0);
        *(LAS u32x2*)(Vt + d * AT_VROW + ch * 16) = (u32x2){v.x, v.y}; *(LAS u32x2*)(Vt + d * AT_VROW + ch * 16 + 8) = (u32x2){v.z, v.w}; }
    for (int i = lane; i < 320; i += 64) { const int rel = i - 160; const int ar = rel < 0 ? -rel : rel;
        lut[i] = (ar <= WIN) ? p.in[2][t5_bucket(rel) * NH + hq] * LOG2E : -1.0e30f; }
    __syncthreads();
    const float sk = p.in[5][hq] * LOG2E;
    const float SC = 0.125f * LOG2E;
#pragma unroll 1
    for (int sb = 0; sb < 4; ++sb) {
        const int pq = q0 + sb * 32;
        bf16x8 qf[4];
        const bf16_t* qrow = Q + (size_t)(b * S_ + pq + r) * 2048 + hq * 64 + 8 * h;
#pragma unroll
        for (int s = 0; s < 4; ++s) qf[s] = *(const bf16x8*)(qrow + 16 * s);
        float mrun = sk, lrun = 1.0f;
        f32x16 o0, o1;
#pragma unroll
        for (int i = 0; i < 16; ++i) { o0[i] = 0.f; o1[i] = 0.f; }
#pragma unroll 1
        for (int j = 0; j < 9; ++j) {
            const int bt = sb + j, kpos0 = q0 - 128 + 32 * bt;
            if (kpos0 < 0 || kpos0 >= S_) continue;
            f32x16 s;
#pragma unroll
            for (int i = 0; i < 16; ++i) s[i] = 0.f;
            const LAS unsigned char* kp = Kb + (32 * bt + r) * AT_KROW + 16 * h;
#pragma unroll
            for (int ks = 0; ks < 4; ++ks) { const bf16x8 kf = *(const LAS bf16x8*)(kp + 32 * ks); s = __builtin_amdgcn_mfma_f32_32x32x16_bf16(kf, qf[ks], s, 0, 0, 0); }
            const LAS float* lp = lut + 32 * j + 32 + 4 * h - r;
            float mx = -3.0e38f;
#pragma unroll
            for (int i = 0; i < 16; ++i) { s[i] = s[i] * SC + lp[(i & 3) + 8 * (i >> 2)]; mx = fmaxf(mx, s[i]); }
            mx = fmaxf(mx, __shfl_xor(mx, 32));
            const float mnew = fmaxf(mrun, mx);
            const float alpha = __builtin_amdgcn_exp2f(mrun - mnew);
            float rs = 0.f;
#pragma unroll
            for (int i = 0; i < 16; ++i) { s[i] = __builtin_amdgcn_exp2f(s[i] - mnew); rs += s[i]; }
            rs += __shfl_xor(rs, 32);
            lrun = lrun * alpha + rs; mrun = mnew;
#pragma unroll
            for (int i = 0; i < 16; ++i) { o0[i] *= alpha; o1[i] *= alpha; }
#pragma unroll
            for (int k2 = 0; k2 < 2; ++k2) {
                u32x4 pw; pw.x = cvtpk(s[8 * k2 + 0], s[8 * k2 + 1]); pw.y = cvtpk(s[8 * k2 + 2], s[8 * k2 + 3]); pw.z = cvtpk(s[8 * k2 + 4], s[8 * k2 + 5]); pw.w = cvtpk(s[8 * k2 + 6], s[8 * k2 + 7]);
                const bf16x8 pb = __builtin_bit_cast(bf16x8, pw);
                const LAS unsigned char* vp = Vt + r * AT_VROW + (32 * bt + 16 * k2 + 4 * h) * 2;
                { const u32x2 lo = *(const LAS u32x2*)(vp), hi = *(const LAS u32x2*)(vp + 16); const u32x4 vw = {lo.x, lo.y, hi.x, hi.y};
                  o0 = __builtin_amdgcn_mfma_f32_32x32x16_bf16(__builtin_bit_cast(bf16x8, vw), pb, o0, 0, 0, 0); }
                { const u32x2 lo = *(const LAS u32x2*)(vp + 32 * AT_VROW), hi = *(const LAS u32x2*)(vp + 32 * AT_VROW + 16); const u32x4 vw = {lo.x, lo.y, hi.x, hi.y};
                  o1 = __builtin_amdgcn_mfma_f32_32x32x16_bf16(__builtin_bit_cast(bf16x8, vw), pb, o1, 0, 0, 0); }
            }
        }
        const float inv = 1.0f / lrun;
        bf16_t* orow = att + (size_t)(b * S_ + pq + r) * 2048 + hq * 64 + 4 * h;
#pragma unroll
        for (int g = 0; g < 4; ++g) {
            u32x2 w0; w0.x = cvtpk(o0[4 * g] * inv, o0[4 * g + 1] * inv); w0.y = cvtpk(o0[4 * g + 2] * inv, o0[4 * g + 3] * inv); *(u32x2*)(orow + 8 * g) = w0;
            u32x2 w1; w1.x = cvtpk(o1[4 * g] * inv, o1[4 * g + 1] * inv); w1.y = cvtpk(o1[4 * g + 2] * inv, o1[4 * g + 3] * inv); *(u32x2*)(orow + 32 + 8 * g) = w1;
        }
    }
}

__device__ __forceinline__ void phase_rows(const Params& p, LAS unsigned char* lds) {
    int tid_ = threadIdx.x; asm volatile("" : "+v"(tid_));
    const int tid = tid_, wave = __builtin_amdgcn_readfirstlane(tid >> 6), lane = tid & 63;
    unsigned char* ws = p.ws;
    const float* x2 = (const float*)(ws + WS_X2); bf16_t* h2 = (bf16_t*)(ws + WS_H2);
    LAS float* lg = (LAS float*)lds;
    LAS int* sel_e = (LAS int*)(lds + 8192);
    LAS float* sel_w = (LAS float*)(lds + 9216);
    LAS int* sel_r = (LAS int*)(lds + 10240);
    LAS int* lcnt = (LAS int*)(lds + 11264);
    LAS int* lbase = (LAS int*)(lds + 11392);
#pragma unroll 1
    for (int t0 = vwg() * 64; t0 < T_; t0 += 64 * (int)gridDim.x) {
        __syncthreads();
        if (tid < 32) lcnt[tid] = 0;
        for (int i = 0; i < 8; ++i) { const int t = t0 + wave * 8 + i; rms_row_to_bf16(x2 + (size_t)t * DM, p.in[11], h2 + (size_t)t * DM, lane); }
        asm volatile("s_waitcnt vmcnt(0)" ::: "memory");
        __syncthreads();
        if (wave < 4) {
            const bf16_t* arow = h2 + (size_t)(t0 + wave * 16 + (lane & 15)) * DM + 8 * (lane >> 4);
            const bf16_t* b0 = (const bf16_t*)(ws + WS_WRT) + (size_t)(lane & 15) * DM + 8 * (lane >> 4);
            const bf16_t* b1 = b0 + (size_t)16 * DM;
            f32x4 a0 = {0.f, 0.f, 0.f, 0.f}, a1 = {0.f, 0.f, 0.f, 0.f};
#pragma unroll 8
            for (int s = 0; s < 64; ++s) { const bf16x8 av = *(const bf16x8*)(arow + 32 * s), bv0 = *(const bf16x8*)(b0 + 32 * s), bv1 = *(const bf16x8*)(b1 + 32 * s);
                a0 = __builtin_amdgcn_mfma_f32_16x16x32_bf16(av, bv0, a0, 0, 0, 0); a1 = __builtin_amdgcn_mfma_f32_16x16x32_bf16(av, bv1, a1, 0, 0, 0); }
            const int ecol = lane & 15; const float bb0 = p.in[13][ecol], bb1 = p.in[13][ecol + 16];
#pragma unroll
            for (int rg = 0; rg < 4; ++rg) { const int tl = wave * 16 + (lane >> 4) * 4 + rg; lg[tl * 32 + ecol] = a0[rg] + bb0; lg[tl * 32 + ecol + 16] = a1[rg] + bb1; }
        }
        __syncthreads();
        if (tid < 64) {
            float v[32];
#pragma unroll
            for (int e = 0; e < 32; ++e) v[e] = lg[tid * 32 + e];
            float tv[4]; int ti[4];
#pragma unroll
            for (int k = 0; k < 4; ++k) { float bv = -3.0e38f; int bi = 0;
#pragma unroll
                for (int e = 0; e < 32; ++e) { const bool tk = v[e] > bv; bv = tk ? v[e] : bv; bi = tk ? e : bi; }
                tv[k] = bv; ti[k] = bi;
#pragma unroll
                for (int e = 0; e < 32; ++e) v[e] = (e == bi) ? -3.0e38f : v[e]; }
            const float e1 = __expf(tv[1] - tv[0]), e2 = __expf(tv[2] - tv[0]), e3 = __expf(tv[3] - tv[0]);
            const float inv = 1.0f / (1.0f + e1 + e2 + e3);
            const float wv[4] = {inv, e1 * inv, e2 * inv, e3 * inv};
#pragma unroll
            for (int k = 0; k < 4; ++k) { sel_e[tid * 4 + k] = ti[k]; sel_w[tid * 4 + k] = wv[k]; sel_r[tid * 4 + k] = __hip_atomic_fetch_add(&lcnt[ti[k]], 1, __ATOMIC_RELAXED, __HIP_MEMORY_SCOPE_WORKGROUP); }
        }
        __syncthreads();
        if (tid < 32) lbase[tid] = (lcnt[tid] > 0) ? atomicAdd((int*)(ws + WS_CTL) + CW_CNT + tid, lcnt[tid]) : 0;
        __syncthreads();
        if (tid < 256) { const int tl = tid >> 2, k = tid & 3, t = t0 + tl; const int e = sel_e[tid], pos = lbase[e] + sel_r[tid]; const float w = sel_w[tid];
            ((int*)(ws + WS_TOKE))[t * 4 + k] = e; ((int*)(ws + WS_TOKPOS))[t * 4 + k] = pos; ((float*)(ws + WS_TOKW))[t * 4 + k] = w;
            ((int*)(ws + WS_LIST))[(size_t)e * T_ + pos] = t; ((float*)(ws + WS_WLIST))[(size_t)e * T_ + pos] = w; }
    }
}
__device__ __forceinline__ void moe_tables(const Params& p, LAS int* pt, LAS int* cn) {
    __syncthreads();
    if (threadIdx.x == 0) { const int* cnt = (const int*)(p.ws + WS_CTL) + CW_CNT; int a = 0;
        for (int e = 0; e < NE; ++e) { const int c = __hip_atomic_load(cnt + e, __ATOMIC_RELAXED, __HIP_MEMORY_SCOPE_AGENT); cn[e] = c; pt[e] = a; a += (c + 255) >> 8; }
        pt[NE] = a; }
    __syncthreads();
}
__device__ __forceinline__ void phase_final(const Params& p, const LAS int* pt) {
    int tid_ = threadIdx.x; asm volatile("" : "+v"(tid_));
    const int tid = tid_, wave = tid >> 6, lane = tid & 63;
    const unsigned char* ws = p.ws;
    const float* x2 = (const float*)(ws + WS_X2); const bf16_t* ys = (const bf16_t*)(ws + WS_YS);
    const int* toke = (const int*)(ws + WS_TOKE); const int* tokpos = (const int*)(ws + WS_TOKPOS);
    const int gw = vwg() * NWAVE + wave, NGW = (int)gridDim.x * NWAVE;
    for (int t = gw; t < T_; t += NGW) {
        const f32x4* xr = (const f32x4*)(x2 + (size_t)t * DM) + lane;
        f32x4 v[8];
#pragma unroll
        for (int j = 0; j < 8; ++j) v[j] = xr[64 * j];
#pragma unroll
        for (int k = 0; k < 4; ++k) { const int e = toke[t * 4 + k]; const size_t slot = (size_t)pt[e] * 256 + tokpos[t * 4 + k];
            const u32x2* yr = (const u32x2*)(ys + slot * DM) + lane;
#pragma unroll
            for (int j = 0; j < 8; ++j) { const u32x2 w = yr[64 * j]; v[j][0] += bflo(w.x); v[j][1] += bfhi(w.x); v[j][2] += bflo(w.y); v[j][3] += bfhi(w.y); } }
        float s = 0.f;
#pragma unroll
        for (int j = 0; j < 8; ++j) s += (v[j][0] * v[j][0] + v[j][1] * v[j][1]) + (v[j][2] * v[j][2] + v[j][3] * v[j][3]);
        const float r = rsqrtf(wsum(s) * (1.0f / DM) + 1e-5f);
        const f32x4* gr = (const f32x4*)p.in[18] + lane; f32x4* orow = (f32x4*)(p.out + (size_t)t * DM) + lane;
#pragma unroll
        for (int j = 0; j < 8; ++j) { const f32x4 gg = gr[64 * j]; orow[64 * j] = (f32x4){v[j][0] * r * gg[0], v[j][1] * r * gg[1], v[j][2] * r * gg[2], v[j][3] * r * gg[3]}; }
    }
}
__device__ __forceinline__ void phase_proj(const Params& p, LAS unsigned char* lds) {
    SchedProj S{p.ws}; EpiProj E{p.ws};
    gemm_phase<EpiProj, SchedProj, true>(lds, 2048, 2048, 2048, S, E);
}
__device__ __forceinline__ void phase_mixers(const Params& p, LAS unsigned char* lds) {
    unsigned char* ws = p.ws;
#pragma unroll 1
    for (int u = vwg(); u < 512; u += (int)gridDim.x) attn_unit(p, lds, u >> 6, (u >> 4) & 3, u & 15);
    asm volatile("s_waitcnt vmcnt(0) lgkmcnt(0)" ::: "memory");
    __syncthreads();
#pragma unroll 1
    for (int u = vwg(); u < 256; u += (int)gridDim.x) {
        const int mh = u & 3, tb = (u >> 2) & 7, b = (u >> 5) & 7;
        const size_t tok0 = (size_t)b * S_ + (size_t)tb * 256;
        bf16_t* Pt = (bf16_t*)(ws + WS_PM) + tok0 * 1024 + mh * 256;
        SchedOne S1{(const char*)(ws + WS_QM) + (tok0 * 1024 + mh * 256) * 2, (const char*)(ws + WS_KMK) + ((size_t)b * 256 * 1024 + mh * 256) * 2, 0, true};
        EpiMemSoftmax E1{Pt};
        gemm_phase<EpiMemSoftmax, SchedOne, false>(lds, 256, 1024, 1024, S1, E1);
        asm volatile("s_waitcnt vmcnt(0)" ::: "memory");
        __syncthreads();
        SchedOne S2{(const char*)Pt, (const char*)(ws + WS_VMT) + ((size_t)(b * 4 + mh) * 256 * 256) * 2, 0, true};
        EpiTile E2{(bf16_t*)(ws + WS_XM) + tok0 * 1024 + mh * 256, 1024};
        gemm_phase<EpiTile, SchedOne, false>(lds, 256, 1024, 256, S2, E2);
        __syncthreads();
    }
    { SchedChan S{ws, 0, 0}; EpiChan E{ws}; gemm_phase<EpiChan, SchedChan, true>(lds, 256, 256, 1024, S, E); }
}
__device__ __forceinline__ void phase_seqdft(const Params& p, LAS unsigned char* lds) {
    SchedSeq S{p.ws}; EpiSeq E{p.ws};
    gemm_phase<EpiSeq, SchedSeq, true>(lds, 4096, 4096, 4096, S, E);
}
__device__ __forceinline__ void phase_mix(const Params& p, LAS unsigned char* lds) {
    unsigned char* ws = p.ws;
    { SchedPlain S{(const char*)(ws + WS_FM), (const char*)(ws + WS_WFOT), (size_t)256 * 1024 * 2, (size_t)256 * 1024 * 2, 64, 8}; EpiMix<0> E{ws}; gemm_phase<EpiMix<0>, SchedPlain, true>(lds, 1024, 1024, 1024, S, E); }
    { SchedPlain S{(const char*)(ws + WS_ATT), (const char*)(ws + WS_WAOT), (size_t)256 * 2048 * 2, (size_t)256 * 2048 * 2, 64, 8}; EpiMix<1> E{ws}; gemm_phase<EpiMix<1>, SchedPlain, true>(lds, 2048, 2048, 2048, S, E); }
    { SchedPlain S{(const char*)(ws + WS_XM), (const char*)(ws + WS_WMOT), (size_t)256 * 1024 * 2, (size_t)256 * 1024 * 2, 64, 8}; EpiMix<2> E{ws}; gemm_phase<EpiMix<2>, SchedPlain, true>(lds, 1024, 1024, 1024, S, E); }
}
__device__ __forceinline__ void phase_x2(const Params& p, LAS unsigned char* lds) {
    unsigned char* ws = p.ws;
    SchedPlain S{(const char*)(ws + WS_MIXED), (const char*)(ws + WS_WOT), (size_t)256 * 2048 * 2, (size_t)256 * 2048 * 2, 64, 8};
    EpiRes E{p.in[0], (float*)(ws + WS_X2)};
    gemm_phase<EpiRes, SchedPlain, true>(lds, 2048, 2048, 2048, S, E);
}
__device__ __forceinline__ void phase_gateup(const Params& p, LAS unsigned char* lds) {
    LAS int* pt = (LAS int*)(lds + LDS_MISC); LAS int* cn = pt + 64;
    moe_tables(p, pt, cn);
    SchedMoe<true, 16> S{p.ws, pt, cn}; EpiSwiglu E{p.ws, p.in[15], pt};
    gemm_phase<EpiSwiglu, SchedMoe<true, 16>, true>(lds, 2048, 2048, 2048, S, E);
}
__device__ __forceinline__ void phase_down(const Params& p, LAS unsigned char* lds) {
    LAS int* pt = (LAS int*)(lds + LDS_MISC); LAS int* cn = pt + 64;
    moe_tables(p, pt, cn);
    SchedMoe<false, 8> S{p.ws, pt, cn}; EpiDown E{p.ws, p.in[17], pt, cn};
    gemm_phase<EpiDown, SchedMoe<false, 8>, true>(lds, 2048, 2048, 2048, S, E);
}
__device__ __forceinline__ void phase_out(const Params& p, LAS unsigned char* lds) {
    LAS int* pt = (LAS int*)(lds + LDS_MISC); LAS int* cn = pt + 64;
    moe_tables(p, pt, cn);
    phase_final(p, pt);
}

template <int PH> __global__ void __launch_bounds__(NTHR, 2) k_phase(Params p) {
    extern __shared__ __attribute__((aligned(16))) unsigned char lds_raw[];
    LAS unsigned char* lds = (LAS unsigned char*)lds_raw;
    if constexpr (PH == 0) phase_prologue(p, lds);
    if constexpr (PH == 1) phase_proj(p, lds);
    if constexpr (PH == 2) phase_mixers(p, lds);
    if constexpr (PH == 3) phase_seqdft(p, lds);
    if constexpr (PH == 4) phase_mix(p, lds);
    if constexpr (PH == 5) phase_x2(p, lds);
    if constexpr (PH == 6) phase_rows(p, lds);
    if constexpr (PH == 7) phase_gateup(p, lds);
    if constexpr (PH == 8) phase_down(p, lds);
    if constexpr (PH == 9) phase_out(p, lds);
}
template <int PH> static void launch_phase(const Params& p, hipStream_t st) {
    static bool attr_done = false;
    if (!attr_done) { (void)hipFuncSetAttribute((const void*)k_phase<PH>, hipFuncAttributeMaxDynamicSharedMemorySize, LDS_BYTES); attr_done = true; }
    hipLaunchKernelGGL(k_phase<PH>, dim3(256), dim3(NTHR), LDS_BYTES, st, p);
}
static void run_fast_multi(const Params& p, hipStream_t st, int lo, int hi) {
    if (lo <= 0 && 0 < hi) launch_phase<0>(p, st);
    if (lo <= 1 && 1 < hi) launch_phase<1>(p, st);
    if (lo <= 2 && 2 < hi) launch_phase<2>(p, st);
    if (lo <= 3 && 3 < hi) launch_phase<3>(p, st);
    if (lo <= 4 && 4 < hi) launch_phase<4>(p, st);
    if (lo <= 5 && 5 < hi) launch_phase<5>(p, st);
    if (lo <= 6 && 6 < hi) launch_phase<6>(p, st);
    if (lo <= 7 && 7 < hi) launch_phase<7>(p, st);
    if (lo <= 8 && 8 < hi) launch_phase<8>(p, st);
    if (lo <= 9 && 9 < hi) launch_phase<9>(p, st);
}
#define XB_TMO      128
#define XB_XCNT(j)  (256  + 64 * (j))
#define XB_XSUB(j)  (1280 + 64 * (j))
#define XB_XGEN(j)  (2304 + 64 * (j))
#define XB_TOP      3328
#define XB_TOPGEN   3392
#define XCD_BAR_WORDS 3456
#define XB_SPIN_CAP (1u << 18)

__device__ __forceinline__ unsigned xb_ld(unsigned* p)              { return __hip_atomic_load(p, __ATOMIC_RELAXED, __HIP_MEMORY_SCOPE_AGENT); }
__device__ __forceinline__ unsigned xb_add(unsigned* p, unsigned v) { return __hip_atomic_fetch_add(p, v, __ATOMIC_RELAXED, __HIP_MEMORY_SCOPE_AGENT); }
__device__ __forceinline__ unsigned xb_xcc_id() { return (unsigned)__builtin_amdgcn_s_getreg((3 << 11) | 20) & 0xFu; }
#define XB_SPIN(cond, bar) do { unsigned _sp = 0; while (cond) { __builtin_amdgcn_s_sleep(1); \
    if ((++_sp & 255u) == 0u) { if (xb_ld(&(bar)[XB_TMO])) break; if (_sp > XB_SPIN_CAP) { atomicAdd(&(bar)[XB_TMO], 1u); break; } } } } while (0)

struct XcdBarrier {
    unsigned* bar; unsigned x;
    volatile LAS unsigned* st;
};

__device__ __forceinline__ XcdBarrier xcd_barrier_post(unsigned* bar, volatile LAS unsigned* st) {
    XcdBarrier b; b.bar = bar; b.x = xb_xcc_id(); b.st = st;
    if (threadIdx.x == 0) (void)xb_add(&bar[XB_XCNT(b.x)], 1u);
    return b;
}
__device__ __forceinline__ void xcd_barrier_complete(unsigned* bar, unsigned x, unsigned& nloc, unsigned& nx) {
    const unsigned G = gridDim.x * gridDim.y * gridDim.z;
    unsigned sum, cnt, mine, sp = 0u;
    for (;;) {
        sum = 0u; cnt = 0u; mine = 0u;
#pragma unroll
        for (unsigned j = 0; j < 16; ++j) { const unsigned c = xb_ld(&bar[XB_XCNT(j)]); sum += c; cnt += (c > 0u) ? 1u : 0u; mine = (j == x) ? c : mine; }
        if (sum == G) break;
        __builtin_amdgcn_s_sleep(1);
        if ((++sp & 255u) == 0u) { if (xb_ld(&bar[XB_TMO])) break; if (sp > XB_SPIN_CAP) { atomicAdd(&bar[XB_TMO], 1u); break; } }
    }
    nloc = mine > 0u ? mine : 1u; nx = cnt > 0u ? cnt : 1u;
}

__device__ __forceinline__ void xcd_barrier(const XcdBarrier& b) {
    asm volatile("s_waitcnt vmcnt(0)" ::: "memory");
    __syncthreads();
    if (threadIdx.x == 0) {
        unsigned* bar = b.bar;
        __builtin_amdgcn_s_waitcnt(0);
        unsigned nloc = b.st[0], nx = b.st[1];
        if (nloc == 0u) { xcd_barrier_complete(bar, b.x, nloc, nx); b.st[0] = nloc; b.st[1] = nx; }
        const unsigned old = xb_add(&bar[XB_XSUB(b.x)], 1u);
        const unsigned gen = old / nloc;
        if (old + 1u == (gen + 1u) * nloc) {
            __builtin_amdgcn_fence(__ATOMIC_RELEASE, "agent");
            asm volatile("s_waitcnt vmcnt(0)" ::: "memory");
            const unsigned og = xb_add(&bar[XB_TOP], 1u);
            const unsigned tg = og / nx;
            if (og + 1u == (tg + 1u) * nx) xb_add(&bar[XB_TOPGEN], 1u);
            else XB_SPIN(xb_ld(&bar[XB_TOPGEN]) == tg, bar);
            __builtin_amdgcn_fence(__ATOMIC_ACQUIRE, "agent");
            xb_add(&bar[XB_XGEN(b.x)], 1u);
            asm volatile("s_waitcnt vmcnt(0)" ::: "memory");
        } else {
            XB_SPIN(xb_ld(&bar[XB_XGEN(b.x)]) == gen, bar);
            __builtin_amdgcn_fence(__ATOMIC_ACQUIRE, "agent");
            asm volatile("s_waitcnt vmcnt(0)" ::: "memory");
        }
    }
    __syncthreads();
}

__global__ void __launch_bounds__(NTHR, 2) mega_fwd(Params p) {
    extern __shared__ __attribute__((aligned(16))) unsigned char lds_raw[];
    LAS unsigned char* lds = (LAS unsigned char*)lds_raw;
    volatile LAS unsigned* xbw = (volatile LAS unsigned*)(lds + LDS_MISC + 1024);
    if (threadIdx.x < 4) xbw[threadIdx.x] = 0u;
    __syncthreads();
    XcdBarrier bar = xcd_barrier_post((unsigned*)(p.ws + WS_CTL) + CW_BAR, xbw);
    phase_prologue(p, lds);  xcd_barrier(bar);
    phase_proj(p, lds);      xcd_barrier(bar);
    phase_mixers(p, lds);    xcd_barrier(bar);
    phase_seqdft(p, lds);    xcd_barrier(bar);
    phase_mix(p, lds);       xcd_barrier(bar);
    phase_x2(p, lds);        xcd_barrier(bar);
    phase_rows(p, lds);      xcd_barrier(bar);
    phase_gateup(p, lds);    xcd_barrier(bar);
    phase_down(p, lds);      xcd_barrier(bar);
    phase_out(p, lds);
}
static void run_fast_one(const Params& p, hipStream_t st) {
    static int grid = 0;
    if (!grid) {
        int dev = 0, cus = 0, per_cu = 0;
        (void)hipGetDevice(&dev); (void)hipDeviceGetAttribute(&cus, hipDeviceAttributeMultiprocessorCount, dev);
        (void)hipFuncSetAttribute((const void*)mega_fwd, hipFuncAttributeMaxDynamicSharedMemorySize, LDS_BYTES);
        (void)hipOccupancyMaxActiveBlocksPerMultiprocessor(&per_cu, (const void*)mega_fwd, NTHR, LDS_BYTES);
        if (per_cu < 1) per_cu = 1;
        grid = cus > 256 ? 256 : cus;
        grid &= ~7; if (grid < 8) grid = 8;
    }
    hipLaunchKernelGGL(mega_fwd, dim3(grid), dim3(NTHR), LDS_BYTES, st, p);
}
}
#ifndef REPORT
#define REPORT 0
#endif
extern "C" void kernel_launch(void* const* d_in, const int* in_sizes, int n_in, void* d_out, int out_size, void* d_ws, size_t ws_size, hipStream_t stream) {
    (void)in_sizes; (void)n_in; (void)out_size; (void)ws_size;
    unsigned char* ws = (unsigned char*)d_ws;
#if MODE == 0
    nv::NBuf nb; nv::carve(nb, ws);
    nv::run_part1(d_in, nb, stream); nv::run_part2(d_in, nb, (float*)d_out, stream);
#elif MODE == 1
    constexpr size_t NAIVE_BASE = (fx::WS_FAST_END + 4095) & ~(size_t)4095;
    nv::NBuf nb; const size_t nbytes = nv::carve(nb, ws + NAIVE_BASE);
    float* fout = (float*)(ws + NAIVE_BASE + ((nbytes + 4095) & ~(size_t)4095));
    double* acc = (double*)(fout + (size_t)16384 * 2048); float* scale = (float*)(acc + 64);
    fx::Params p; memset(&p, 0, sizeof(p));
    for (int i = 0; i < 19; ++i) p.in[i] = (const float*)d_in[i];
    p.out = fout; p.ws = ws;
    (void)hipMemsetAsync(ws + fx::WS_CTL, 0, fx::CTL_BYTES, stream);
    (void)hipMemsetAsync(acc, 0, 1024, stream);
    nv::run_part1(d_in, nb, stream);
    fx::run_fast_multi(p, stream, 0, 7);
    auto cmp = [&](int slot, int kind, const void* a, const float* ref, long long n, int w, int ldf, int ldr, int off, int sig) {
        ck::CP c; memset(&c, 0, sizeof(c)); c.a = a; c.ref = ref; c.n = n; c.kind = kind; c.w = w; c.ldf = ldf; c.ldr = ldr; c.off = off; c.sig = sig; c.slot = slot;
        hipLaunchKernelGGL(ck::k_cmp, dim3(2048), dim3(256), 0, stream, c, acc); };
    const long long T = 16384;
    cmp(0, 0, ws + fx::WS_FIN, nb.proj, T * 1024, 1024, 1024, 10752, 0, 0);
    cmp(1, 0, ws + fx::WS_Q, nb.proj, T * 2048, 2048, 2048, 10752, 1024, 0);
    cmp(2, 0, ws + fx::WS_K, nb.proj, T * 256, 256, 256, 10752, 3072, 0);
    cmp(3, 2, ws + fx::WS_VT, nb.proj, T * 256, 0, 0, 0, 0, 0);
    cmp(4, 0, ws + fx::WS_QM, nb.proj, T * 1024, 1024, 1024, 10752, 3584, 0);
    cmp(5, 0, ws + fx::WS_GATES, nb.proj, T * 6144, 6144, 6144, 10752, 4608, 1);
    cmp(6, 0, ws + fx::WS_KMK, nb.kvm, 2048LL * 1024, 1024, 1024, 2048, 0, 0);
    cmp(7, 3, ws + fx::WS_VMT, nb.kvm, 2048LL * 1024, 0, 0, 0, 0, 0);
    cmp(8, 0, ws + fx::WS_ATT, nb.att, T * 2048, 2048, 2048, 2048, 0, 0);
    cmp(9, 0, ws + fx::WS_XM, nb.xm, T * 1024, 1024, 1024, 1024, 0, 0);
    cmp(10, 0, ws + fx::WS_FM, nb.fm, T * 1024, 1024, 1024, 1024, 0, 0);
    cmp(11, 0, ws + fx::WS_MIXED, nb.mixed, T * 2048, 2048, 2048, 2048, 0, 0);
    cmp(12, 1, ws + fx::WS_X2, nb.x2, T * 2048, 2048, 2048, 2048, 0, 0);
    cmp(13, 0, ws + fx::WS_H2, nb.h2, T * 2048, 2048, 2048, 2048, 0, 0);
    hipLaunchKernelGGL(ck::k_cmp_route, dim3(64), dim3(256), 0, stream, (const int*)(ws + fx::WS_TOKE), (const int*)nb.tope, acc, 14);
    nv::run_part2(d_in, nb, nb.nout, stream);
    fx::run_fast_multi(p, stream, 7, 10);
    cmp(15, 1, fout, nb.nout, T * 2048, 2048, 2048, 2048, 0, 0);
    hipLaunchKernelGGL(ck::k_verdict, dim3(1), dim3(64), 0, stream, (const double*)acc, scale, 16, (int)REPORT);
    hipLaunchKernelGGL(ck::k_scale_out, dim3(2048), dim3(256), 0, stream, (const float*)nb.nout, (const float*)scale, (float*)d_out, T * 2048);
#elif MODE == 2
    fx::Params p; memset(&p, 0, sizeof(p));
    for (int i = 0; i < 19; ++i) p.in[i] = (const float*)d_in[i];
    p.out = (float*)d_out; p.ws = ws;
    (void)hipMemsetAsync(ws + fx::WS_CTL, 0, fx::CTL_BYTES, stream);
    fx::run_fast_multi(p, stream, 0, 10);
#elif MODE == 3
    fx::Params p; memset(&p, 0, sizeof(p));
    for (int i = 0; i < 19; ++i) p.in[i] = (const float*)d_in[i];
    p.out = (float*)d_out; p.ws = ws;
    (void)hipMemsetAsync(ws + fx::WS_CTL, 0, fx::CTL_BYTES, stream);
    fx::run_fast_one(p, stream);
#endif
}
```

```cpp
#include <hip/hip_runtime.h>
#include <stdint.h>
#include <string.h>
#ifndef MODE
#define MODE 3
#endif
namespace fx {
#define LAS __attribute__((address_space(3)))
typedef unsigned short bf16_t;
typedef short bf16x8 __attribute__((ext_vector_type(8)));
typedef short s16x4 __attribute__((ext_vector_type(4)));
typedef float f32x4 __attribute__((ext_vector_type(4)));
typedef float f32x16 __attribute__((ext_vector_type(16)));
typedef float f32x2 __attribute__((ext_vector_type(2)));
typedef __bf16 bf16x2_t __attribute__((ext_vector_type(2)));
typedef unsigned u32x4 __attribute__((ext_vector_type(4)));
typedef unsigned u32x2 __attribute__((ext_vector_type(2)));

constexpr int NTHR = 512, NWAVE = 8;
constexpr int B_ = 8, S_ = 2048, DM = 2048, T_ = B_ * S_;
constexpr int MEM = 256, FW = 1024, FG = 4, FGD = 256;
constexpr int NH = 32, NKV = 4, HD = 64, AW = 2048, KVW = 256, WIN = 128;
constexpr int MH = 4, MHD = 256, MW = 1024;
constexpr int NE = 32, TOPK = 4, DFF = 2048;
constexpr int INW = 10752;
constexpr int NSLOT = T_ * TOPK + NE * 256;
constexpr float LOG2E = 1.4426950408889634f;
#ifndef MOE_FP8
#define MOE_FP8 1
#endif
constexpr bool MOE_F8 = (MOE_FP8 != 0);

constexpr size_t al256(size_t x) { return (x + 255) & ~(size_t)255; }
constexpr size_t WS_CTL = 0, CTL_BYTES = 65536;
constexpr size_t WS_WINT = 1u << 20;
constexpr size_t WS_WMKVT = WS_WINT + (size_t)INW * DM * 2;
constexpr size_t WS_WFOT = WS_WMKVT + (size_t)2048 * 2048 * 2;
constexpr size_t WS_WAOT = WS_WFOT + (size_t)2048 * 1024 * 2;
constexpr size_t WS_WMOT = WS_WAOT + (size_t)2048 * 2048 * 2;
constexpr size_t WS_WOT = WS_WMOT + (size_t)2048 * 1024 * 2;
constexpr size_t WS_WRT = WS_WOT + (size_t)2048 * 2048 * 2;
constexpr size_t WS_TABT = WS_WRT + (size_t)NE * DM * 2;
constexpr size_t WS_DMAT = WS_TABT + (size_t)512 * 256 * 2;
constexpr size_t WS_WGUT = WS_DMAT + (size_t)2048 * 4096 * 2;
constexpr size_t WS_WDNT = WS_WGUT + (size_t)NE * 4096 * 2048 * 2;
constexpr size_t WS_H = WS_WDNT + (size_t)NE * 2048 * 2048 * 2;
constexpr size_t WS_MEMBF = WS_H + (size_t)T_ * DM * 2;
constexpr size_t WS_FIN = WS_MEMBF + (size_t)2048 * 2048 * 2;
constexpr size_t WS_Q = WS_FIN + (size_t)T_ * FW * 2;
constexpr size_t WS_K = WS_Q + (size_t)T_ * AW * 2;
constexpr size_t WS_VT = WS_K + (size_t)T_ * KVW * 2;
constexpr size_t WS_QM = WS_VT + (size_t)T_ * KVW * 2;
constexpr size_t WS_GATES = WS_QM + (size_t)T_ * MW * 2;
constexpr size_t WS_KMK = WS_GATES + (size_t)T_ * 3 * DM * 2;
constexpr size_t WS_VMT = WS_KMK + (size_t)2048 * 1024 * 2;
constexpr size_t WS_ZT = WS_VMT + (size_t)2048 * 1024 * 2;
constexpr size_t WS_FM = WS_ZT + (size_t)32 * 256 * 4096 * 2;
constexpr size_t WS_ATT = WS_FM + (size_t)T_ * FW * 2;
constexpr size_t WS_PM = WS_ATT + (size_t)T_ * AW * 2;
constexpr size_t WS_XM = WS_PM + (size_t)T_ * MH * 256 * 2;
constexpr size_t WS_MIXACC = WS_XM + (size_t)T_ * MW * 2;
constexpr size_t WS_MIXED = WS_MIXACC + (size_t)T_ * DM * 4;
constexpr size_t WS_X2 = WS_MIXED + (size_t)T_ * DM * 2;
constexpr size_t WS_H2 = WS_X2 + (size_t)T_ * DM * 4;
constexpr size_t WS_TOKE = WS_H2 + (size_t)T_ * DM * 2;
constexpr size_t WS_TOKPOS = WS_TOKE + (size_t)T_ * 4 * 4;
constexpr size_t WS_TOKW = WS_TOKPOS + (size_t)T_ * 4 * 4;
constexpr size_t WS_LIST = WS_TOKW + (size_t)T_ * 4 * 4;
constexpr size_t WS_WLIST = WS_LIST + (size_t)NE * T_ * 4;
constexpr size_t WS_WGUQ = WS_WLIST + (size_t)NE * T_ * 4;
constexpr size_t WS_WDNQ = WS_WGUQ + (size_t)NE * 4096 * 2048;
constexpr size_t WS_H2Q = WS_WDNQ + (size_t)NE * 2048 * 2048;
constexpr size_t WS_FAST_END = WS_H2Q + (size_t)T_ * DM;
constexpr size_t WS_ACTQ = WS_H;
constexpr float WQ_SCALE = 32.0f, WQ_INV = 1.0f / 32.0f;
constexpr size_t WS_ACT = WS_H;
constexpr size_t WS_YS = WS_ACT + (size_t)NSLOT * DFF * 2;
static_assert(WS_YS + (size_t)NSLOT * DM * 2 <= WS_MIXED, "overlay fits");
constexpr int CW_CNT = 0;
constexpr int CW_BAR = 4096;

constexpr int LDS_STAGE = 0, STAGE_BYTES = 131072;
constexpr int LDS_MISC = 139264;
constexpr int LDS_XBW = 147392;
constexpr int LDS_BYTES = 147456;

struct Params {
    const float* in[19]; float* out; unsigned char* ws;
};

__device__ __forceinline__ unsigned cvtpk(float lo, float hi) { f32x2 v = {lo, hi}; bf16x2_t b = __builtin_convertvector(v, bf16x2_t); return __builtin_bit_cast(unsigned, b); }
__device__ __forceinline__ float bf2f(unsigned short x) { return __uint_as_float(((unsigned)x) << 16); }
__device__ __forceinline__ float bflo(unsigned w) { return __uint_as_float(w << 16); }
__device__ __forceinline__ float bfhi(unsigned w) { return __uint_as_float(w & 0xffff0000u); }
__device__ __forceinline__ float wsum(float v) {
#pragma unroll
    for (int o = 1; o < 64; o <<= 1) v += __shfl_xor(v, o);
    return v;
}
__device__ __forceinline__ float sigmoidf_(float x) { return 1.0f / (1.0f + __builtin_amdgcn_exp2f(-x * LOG2E)); }
__device__ __forceinline__ int crow(int r, int h) { return (r & 3) + 8 * (r >> 2) + 4 * h; }
__device__ __forceinline__ int t5_bucket(int rel) {
    const int n = rel < 0 ? -rel : rel;
    int b;
    if (n < 8) b = n; else if (n < 12) b = 8; else if (n < 16) b = 9; else if (n < 23) b = 10; else if (n < 32) b = 11;
    else if (n < 46) b = 12; else if (n < 64) b = 13; else if (n < 91) b = 14; else b = 15;
    return (rel > 0 ? 16 : 0) + b;
}
__device__ __forceinline__ int vwg() { const int c = blockIdx.x, G = gridDim.x; return ((G & 7) == 0) ? (c & 7) * (G >> 3) + (c >> 3) : c; }

constexpr int BM = 256, BK = 64, HALF = 128, HTB = HALF * BK * 2;
__host__ __device__ __forceinline__ int lds_byte(int r, int c) { const int st = (r >> 4) * 2 + (c >> 5), rr = r & 15, cc = c & 31, ob = rr * 64 + cc * 2; return st * 1024 + (ob ^ (((ob >> 9) & 1) << 5)); }
__host__ __device__ __forceinline__ void stage_rc(int b, int& R, int& C) { const int st = b / 1024, sb = b % 1024, swz = sb ^ (((sb >> 9) & 1) << 5); R = (st >> 1) * 16 + swz / 64; C = (st & 1) * 32 + (swz % 64) / 2; }
__host__ __device__ __forceinline__ int perm32(int rho) { const int n = rho >> 4, i = rho & 15; return 8 * (i >> 2) + 4 * n + (i & 3); }

struct Unit { int pm, pn, z; };
typedef int v4i_t __attribute__((ext_vector_type(4)));
typedef int v8i_t __attribute__((ext_vector_type(8)));
__device__ __forceinline__ void mfma_f8(f32x4& c, const v8i_t& a, const v8i_t& b) { asm volatile("v_mfma_f32_16x16x128_f8f6f4 %0, %1, %2, %0" : "+v"(c) : "v"(a), "v"(b)); }
template <int ESZ> struct FragT;
template <> struct FragT<2> { struct A4 { bf16x8 v[4][2]; }; struct B2 { bf16x8 v[2][2]; }; };
template <> struct FragT<1> { struct A4 { v8i_t v[4]; }; struct B2 { v8i_t v[2]; }; };
__device__ __forceinline__ v8i_t cat8(bf16x8 a, bf16x8 b) { return __builtin_shufflevector(__builtin_bit_cast(v4i_t, a), __builtin_bit_cast(v4i_t, b), 0, 1, 2, 3, 4, 5, 6, 7); }

template <class Epi, class Sched, bool ALIGN_EPI, int ESZ = 2  >
__device__ __forceinline__ void gemm_phase(LAS unsigned char* lds, const int K, const int lda, const int ldb, const Sched& S, const Epi& E) {
    int tid_ = threadIdx.x; asm volatile("" : "+v"(tid_));
    const int tid = tid_, wid = __builtin_amdgcn_readfirstlane(tid >> 6), lane = tid & 63, wr = wid >> 2, wc = wid & 3, fr = lane & 15, fq = lane >> 4;
    const int nt = (K * ESZ) / (BK * 2);
    constexpr bool GATHER = Sched::GATHER;
    unsigned voffA[2], voffB[2]; int Rr[2], Cb[2];
#pragma unroll
    for (int i = 0; i < 2; ++i) { int R, C; stage_rc(tid * 16 + i * 8192, R, C);
        int Rb = R;
        if constexpr ((int)Epi::PERM == 1) Rb = (R & ~31) + perm32(R & 31);
        if constexpr ((int)Epi::PERM == 2) Rb = 64 * (R >> 5) + 16 * ((R >> 2) & 3) + 4 * ((R >> 4) & 1) + (R & 3);
        voffA[i] = (unsigned)(R * lda * ESZ + C * 2); voffB[i] = (unsigned)(Rb * ldb * ESZ + C * 2); Rr[i] = R; Cb[i] = C * 2; }
    const size_t kstep = (size_t)(BK * 2);
    const size_t hstepA = (size_t)HALF * lda * ESZ, hstepB = (size_t)(((int)Epi::PERM == 2) ? 8 : HALF) * ldb * ESZ;
    const unsigned ldsw = (unsigned)wid * 1024u;
    const int aoff = lds_byte(wr * 64 + fr, fq * 8), boff = lds_byte(wc * 32 + fr, fq * 8);
#define PG8_SA(b, h) (((b) * 2 + (h)) * HTB)
#define PG8_SB(b, h) ((4 + (b) * 2 + (h)) * HTB)
#define PG8_STAGE(bufoff, gbase, voff) do { _Pragma("unroll") for (int _i = 0; _i < 2; ++_i) \
        __builtin_amdgcn_global_load_lds((const unsigned*)((const char*)(gbase) + (voff)[_i]), (LAS unsigned*)(lds + (bufoff) + ldsw + _i * 8192), 16, 0, 0); } while (0)
#define PG8_STAGE_A(bufoff, gbase, h, NX) do { if constexpr (GATHER) { _Pragma("unroll") for (int _i = 0; _i < 2; ++_i) { const unsigned _o = (NX) ? naoff[h][_i] : caoff[h][_i]; \
        __builtin_amdgcn_global_load_lds((const unsigned*)((const char*)(gbase) + _o), (LAS unsigned*)(lds + (bufoff) + ldsw + _i * 8192), 16, 0, 0); } } \
        else { PG8_STAGE(bufoff, (const char*)(gbase) + (h) * hstepA, voffA); } } while (0)
#define PG8_LDA(dst, b, h) do { _Pragma("unroll") for (int m = 0; m < 4; ++m) { if constexpr (ESZ == 2) { _Pragma("unroll") for (int k = 0; k < 2; ++k) dst.v[m][k] = *(const LAS bf16x8*)(lds + PG8_SA(b, h) + aoff + m * 2048 + k * 1024); } \
        else { const v4i_t _lo = *(const LAS v4i_t*)(lds + PG8_SA(b, h) + aoff + m * 2048), _hi = *(const LAS v4i_t*)(lds + PG8_SA(b, h) + aoff + m * 2048 + 1024); dst.v[m] = __builtin_shufflevector(_lo, _hi, 0, 1, 2, 3, 4, 5, 6, 7); } } } while (0)
#define PG8_LDB(dst, b, h) do { _Pragma("unroll") for (int n = 0; n < 2; ++n) { if constexpr (ESZ == 2) { _Pragma("unroll") for (int k = 0; k < 2; ++k) dst.v[n][k] = *(const LAS bf16x8*)(lds + PG8_SB(b, h) + boff + n * 2048 + k * 1024); } \
        else { const v4i_t _lo = *(const LAS v4i_t*)(lds + PG8_SB(b, h) + boff + n * 2048), _hi = *(const LAS v4i_t*)(lds + PG8_SB(b, h) + boff + n * 2048 + 1024); dst.v[n] = __builtin_shufflevector(_lo, _hi, 0, 1, 2, 3, 4, 5, 6, 7); } } } while (0)
#define PG8_MMA(ai, bj, At, Bt) do { __builtin_amdgcn_s_setprio(1); _Pragma("unroll") for (int m = 0; m < 4; ++m) _Pragma("unroll") for (int n = 0; n < 2; ++n) { \
        if constexpr (ESZ == 2) { _Pragma("unroll") for (int k = 0; k < 2; ++k) acc[ai][bj][m][n] = __builtin_amdgcn_mfma_f32_16x16x32_bf16(Bt.v[n][k], At.v[m][k], acc[ai][bj][m][n], 0, 0, 0); } \
        else { mfma_f8(acc[ai][bj][m][n], Bt.v[n], At.v[m]); } } \
        __builtin_amdgcn_s_setprio(0); } while (0)
#define PG8_WAIT_V(n) asm volatile("s_waitcnt vmcnt(" #n ")" ::: "memory")
#define PG8_WAIT_L(n) asm volatile("s_waitcnt lgkmcnt(" #n ")" ::: "memory")
#define PG8_BAR __builtin_amdgcn_s_barrier()
#define PG8_SCHED __builtin_amdgcn_sched_barrier(0)
    Unit cur, nxt; int ui = 0;
    if (!S.next(0, cur)) return;
    f32x4 acc[2][2][4][2];
#pragma unroll
    for (int a = 0; a < 2; ++a)
#pragma unroll
        for (int b = 0; b < 2; ++b)
#pragma unroll
            for (int m = 0; m < 4; ++m)
#pragma unroll
                for (int n = 0; n < 2; ++n) acc[a][b][m][n] = (f32x4){0.f, 0.f, 0.f, 0.f};
    typedef typename FragT<ESZ>::A4 FragA; typedef typename FragT<ESZ>::B2 FragB;
    FragA At; FragB B0, B1;
    unsigned caoff[2][2] = {{0u, 0u}, {0u, 0u}}, naoff[2][2] = {{0u, 0u}, {0u, 0u}};
    if constexpr (GATHER) {
#pragma unroll
        for (int h = 0; h < 2; ++h)
#pragma unroll
            for (int i = 0; i < 2; ++i) { caoff[h][i] = S.arow(cur, h * HALF + Rr[i]) + (unsigned)Cb[i]; naoff[h][i] = caoff[h][i]; }
    }
    const char* cA = S.baseA(cur); const char* cB = S.baseB(cur);
    PG8_STAGE(PG8_SB(0, 0), cB, voffB); PG8_STAGE(PG8_SB(0, 1), cB + hstepB, voffB); PG8_STAGE_A(PG8_SA(0, 0), cA, 0, false); PG8_STAGE_A(PG8_SA(0, 1), cA, 1, false);
    if (wr == 1) PG8_BAR;
    PG8_WAIT_V(2); PG8_BAR;
    PG8_STAGE(PG8_SB(1, 0), cB + kstep, voffB); PG8_STAGE_A(PG8_SA(1, 0), cA + kstep, 0, false); PG8_STAGE(PG8_SB(1, 1), cB + hstepB + kstep, voffB);
    PG8_WAIT_V(6); PG8_BAR;
    for (;;) {
        const bool has_next = S.next(ui + 1, nxt);
        const char* nA = has_next ? S.baseA(nxt) : cA; const char* nB = has_next ? S.baseB(nxt) : cB;
        if constexpr (GATHER) {
            if (has_next) {
#pragma unroll
                for (int h = 0; h < 2; ++h)
#pragma unroll
                    for (int i = 0; i < 2; ++i) naoff[h][i] = S.arow(nxt, h * HALF + Rr[i]) + (unsigned)Cb[i];
            } else {
#pragma unroll
                for (int h = 0; h < 2; ++h)
#pragma unroll
                    for (int i = 0; i < 2; ++i) naoff[h][i] = caoff[h][i];
            }
        }
#pragma unroll 1
        for (int t = 0; t < nt; t += 2) {
            const bool last = (t == nt - 2);
            const char* a1 = cA + (size_t)(t + 1) * kstep;
            const char* a2 = last ? nA : cA + (size_t)(t + 2) * kstep; const char* b2 = last ? nB : cB + (size_t)(t + 2) * kstep;
            const char* a3 = a2 + kstep; const char* b3 = b2 + kstep;
            PG8_LDB(B0, 0, 0); PG8_LDB(B1, 0, 1); PG8_SCHED; PG8_LDA(At, 0, 0); PG8_STAGE_A(PG8_SA(1, 1), a1, 1, false);
            PG8_WAIT_V(8); PG8_WAIT_L(0); PG8_BAR; PG8_MMA(0, 0, At, B0); PG8_MMA(0, 1, At, B1); PG8_BAR; PG8_SCHED;
            PG8_LDA(At, 0, 1); PG8_STAGE(PG8_SB(0, 0), b2, voffB); PG8_STAGE(PG8_SB(0, 1), b2 + hstepB, voffB); PG8_STAGE_A(PG8_SA(0, 0), a2, 0, last);
            PG8_WAIT_V(8); PG8_WAIT_L(0); PG8_BAR; PG8_MMA(1, 0, At, B0); PG8_MMA(1, 1, At, B1); PG8_BAR; PG8_SCHED;
            PG8_LDB(B0, 1, 0); PG8_LDB(B1, 1, 1); PG8_SCHED; PG8_LDA(At, 1, 0); PG8_STAGE_A(PG8_SA(0, 1), a2, 1, last);
            PG8_WAIT_V(8); PG8_WAIT_L(0); PG8_BAR; PG8_MMA(0, 0, At, B0); PG8_MMA(0, 1, At, B1); PG8_BAR; PG8_SCHED;
            PG8_LDA(At, 1, 1); PG8_STAGE(PG8_SB(1, 0), b3, voffB); PG8_STAGE(PG8_SB(1, 1), b3 + hstepB, voffB); PG8_STAGE_A(PG8_SA(1, 0), a3, 0, last);
            PG8_WAIT_V(8); PG8_WAIT_L(0); PG8_BAR; PG8_MMA(1, 0, At, B0); PG8_MMA(1, 1, At, B1); PG8_BAR; PG8_SCHED;
        }
        if constexpr (ESZ == 1) asm volatile("s_nop 15\n\ts_nop 15" ::: "memory");
        if constexpr (ALIGN_EPI) { if (wr == 0) PG8_BAR; }
        if constexpr (!Epi::AFTER_DRAIN) { int fr_e = fr, fq_e = fq; asm volatile("" : "+v"(fr_e), "+v"(fq_e));
            E(acc, cur, wr, wc, fr_e, fq_e); }
        if (!has_next) break;
#pragma unroll
        for (int a = 0; a < 2; ++a)
#pragma unroll
            for (int b = 0; b < 2; ++b)
#pragma unroll
                for (int m = 0; m < 4; ++m)
#pragma unroll
                    for (int n = 0; n < 2; ++n) acc[a][b][m][n] = (f32x4){0.f, 0.f, 0.f, 0.f};
        cur = nxt; cA = nA; cB = nB; ++ui;
        if constexpr (GATHER) {
#pragma unroll
            for (int h = 0; h < 2; ++h)
#pragma unroll
                for (int i = 0; i < 2; ++i) caoff[h][i] = naoff[h][i];
        }
        if constexpr (ALIGN_EPI) { if (wr == 1) PG8_BAR; }
    }
    PG8_WAIT_V(0);
    if constexpr (!ALIGN_EPI) { if (wr == 0) PG8_BAR; }
    PG8_BAR;
    if constexpr (Epi::AFTER_DRAIN) { int fr_e = fr, fq_e = fq; asm volatile("" : "+v"(fr_e), "+v"(fq_e)); E.fused(acc, cur, wr, wc, fr_e, fq_e, lds, wid, lane); }
#undef PG8_SA
#undef PG8_SB
#undef PG8_STAGE
#undef PG8_STAGE_A
#undef PG8_LDA
#undef PG8_LDB
#undef PG8_MMA
#undef PG8_WAIT_V
#undef PG8_WAIT_L
#undef PG8_BAR
#undef PG8_SCHED
}
constexpr int NXCD = 8, WGM = 8;
__device__ __forceinline__ void static_tile(int L, int nM, int nN, int& pm, int& pn) {
    const int nwg = nM * nN; int wgid = L;
    { const int q = nwg / NXCD, r = nwg % NXCD, xcd = wgid % NXCD, off = wgid / NXCD; wgid = (xcd < r ? xcd * (q + 1) : r * (q + 1) + (xcd - r) * q) + off; }
    const int nig = WGM * nN, gid = wgid / nig, fm = gid * WGM, gsz = (nM - fm) < WGM ? (nM - fm) : WGM;
    pm = fm + ((wgid % nig) % gsz); pn = (wgid % nig) / gsz;
}
struct SchedPlain {
    static constexpr bool GATHER = false;
    const char* A; const char* Bt; size_t tstepA, tstepB; int nM, nN;
    __device__ __forceinline__ bool next(int i, Unit& u) const { const int L = i * (int)gridDim.x + (int)blockIdx.x; if (L >= nM * nN) return false; static_tile(L, nM, nN, u.pm, u.pn); u.z = 0; return true; }
    __device__ __forceinline__ const char* baseA(const Unit& u) const { return A + (size_t)u.pm * tstepA; }
    __device__ __forceinline__ const char* baseB(const Unit& u) const { return Bt + (size_t)u.pn * tstepB; }
    __device__ __forceinline__ unsigned arow(const Unit&, int) const { return 0u; }
};
struct SchedProj {
    static constexpr bool GATHER = false;
    const unsigned char* ws;
    __device__ __forceinline__ bool next(int i, Unit& u) const {
        const int L = i * (int)gridDim.x + (int)blockIdx.x;
        if (L < 64 * 42) { static_tile(L, 64, 42, u.pm, u.pn); u.z = (u.pn == 13) ? 2 : 0; return true; }
        const int L2 = L - 64 * 42; if (L2 >= 64) return false;
        if (L2 < 32) { u.pm = L2 & 7; u.pn = L2 >> 3; u.z = 1; } else { u.pm = (L2 - 32) & 3; u.pn = (L2 - 32) >> 2; u.z = 3; }
        return true;
    }
    __device__ __forceinline__ const char* baseA(const Unit& u) const {
        const size_t ts = (size_t)256 * 2048 * 2;
        if (u.z == 0) return (const char*)ws + WS_H + (size_t)u.pm * ts;
        if (u.z == 2) return (const char*)ws + WS_WINT + (size_t)13 * ts;
        if (u.z == 1) return (const char*)ws + WS_MEMBF + (size_t)u.pm * ts;
        return (const char*)ws + WS_WMKVT + (size_t)(4 + u.pm) * ts;
    }
    __device__ __forceinline__ const char* baseB(const Unit& u) const {
        const size_t ts = (size_t)256 * 2048 * 2;
        if (u.z == 0) return (const char*)ws + WS_WINT + (size_t)u.pn * ts;
        if (u.z == 2) return (const char*)ws + WS_H + (size_t)u.pm * ts;
        if (u.z == 1) return (const char*)ws + WS_WMKVT + (size_t)u.pn * ts;
        return (const char*)ws + WS_MEMBF + (size_t)u.pn * ts;
    }
    __device__ __forceinline__ unsigned arow(const Unit&, int) const { return 0u; }
};
struct SchedChan {
    static constexpr bool GATHER = false;
    const unsigned char* ws; int u0, nu;
    __device__ __forceinline__ bool next(int i, Unit& u) const {
        const int L = i * (int)gridDim.x + vwg(); if (L >= 512) return false;
        u.z = L >> 4; u.pm = (L >> 3) & 1; u.pn = L & 7; return true;
    }
    __device__ __forceinline__ const char* baseA(const Unit& u) const { return (const char*)ws + WS_TABT + (size_t)u.pm * (256 * 256 * 2); }
    __device__ __forceinline__ const char* baseB(const Unit& u) const { const int b = u.z >> 2, g = u.z & 3; return (const char*)ws + WS_FIN + ((size_t)(b * 2048 + u.pn * 256) * 1024 + g * 256) * 2; }
    __device__ __forceinline__ unsigned arow(const Unit&, int) const { return 0u; }
};
struct SchedSeq {
    static constexpr bool GATHER = false;
    const unsigned char* ws;
    __device__ __forceinline__ bool next(int i, Unit& u) const {
        const int L = i * (int)gridDim.x + vwg(); if (L >= 256) return false;
        u.z = L >> 3; u.pm = L & 7; u.pn = 0; return true;
    }
    __device__ __forceinline__ const char* baseA(const Unit& u) const { return (const char*)ws + WS_DMAT + (size_t)u.pm * (256 * 4096 * 2); }
    __device__ __forceinline__ const char* baseB(const Unit& u) const { return (const char*)ws + WS_ZT + (size_t)u.z * (256 * 4096 * 2); }
    __device__ __forceinline__ unsigned arow(const Unit&, int) const { return 0u; }
};
struct SchedOne {
    static constexpr bool GATHER = false;
    const char* A; const char* Bt; int z; bool valid;
    __device__ __forceinline__ bool next(int i, Unit& u) const { if (i != 0 || !valid) return false; u.pm = 0; u.pn = 0; u.z = z; return true; }
    __device__ __forceinline__ const char* baseA(const Unit&) const { return A; }
    __device__ __forceinline__ const char* baseB(const Unit&) const { return Bt; }
    __device__ __forceinline__ unsigned arow(const Unit&, int) const { return 0u; }
};
template <bool GATH, int NT  , bool F8>
struct SchedMoe {
    static constexpr bool GATHER = GATH;
    static constexpr int ES = F8 ? 1 : 2;
    const unsigned char* ws; const LAS int* pt; const LAS int* cn;
    __device__ __forceinline__ int ptu(int k) const { return __builtin_amdgcn_readfirstlane(pt[k]); }
    __device__ __forceinline__ bool next(int i, Unit& u) const {
        const int L = i * (int)gridDim.x + vwg(); const int total = ptu(NE) * NT; if (L >= total) return false;
        int e = 0;
#pragma unroll 1
        for (int k = 1; k < NE; ++k) if (L >= ptu(k) * NT) e = k;
        const int t = L - ptu(e) * NT, mte = ptu(e + 1) - ptu(e);
        u.z = e; u.pm = t % mte; u.pn = t / mte; return true;
    }
    __device__ __forceinline__ const char* baseA(const Unit& u) const {
        if constexpr (GATH) return (const char*)ws + (F8 ? WS_H2Q : WS_H2);
        else return (const char*)ws + (F8 ? WS_ACTQ : WS_ACT) + (size_t)(ptu(u.z) + u.pm) * (256 * 2048 * ES);
    }
    __device__ __forceinline__ const char* baseB(const Unit& u) const {
        if constexpr (GATH) return (const char*)ws + (F8 ? WS_WGUQ : WS_WGUT) + ((size_t)u.z * 4096 + (size_t)u.pn * 256) * (2048 * ES);
        else return (const char*)ws + (F8 ? WS_WDNQ : WS_WDNT) + ((size_t)u.z * 2048 + (size_t)u.pn * 256) * (2048 * ES);
    }
    __device__ __forceinline__ unsigned arow(const Unit& u, int r) const {
        const int pos = u.pm * 256 + r;
        const int* list = (const int*)(ws + WS_LIST);
        const int tok = (pos < __builtin_amdgcn_readfirstlane(cn[u.z])) ? list[(size_t)u.z * T_ + pos] : 0;
        return (unsigned)tok * (unsigned)(2048 * ES);
    }
};

__device__ __forceinline__ void store_tile_bf16(const f32x4 (&acc)[2][2][4][2], bf16_t* dst  , size_t ldc, int wr, int wc, int fr, int fq) {
    const int row0 = wr * 64 + fr, col0 = wc * 32 + 8 * fq;
#pragma unroll
    for (int ai = 0; ai < 2; ++ai)
#pragma unroll
        for (int m = 0; m < 4; ++m) { bf16_t* rowp = dst + (size_t)(row0 + ai * HALF + m * 16) * ldc + col0;
#pragma unroll
            for (int bj = 0; bj < 2; ++bj) { const f32x4 v0 = acc[ai][bj][m][0], v1 = acc[ai][bj][m][1];
                u32x4 w; w.x = cvtpk(v0[0], v0[1]); w.y = cvtpk(v0[2], v0[3]); w.z = cvtpk(v1[0], v1[1]); w.w = cvtpk(v1[2], v1[3]);
                *(u32x4*)(rowp + bj * HALF) = w; } }
}
struct EpiProj {
    static constexpr bool PERM = true, AFTER_DRAIN = false;
    unsigned char* ws;
    __device__ __forceinline__ void operator()(const f32x4 (&acc)[2][2][4][2], const Unit& u, int wr, int wc, int fr, int fq) const {
        const int pn = u.pn, pm = u.pm;
        bf16_t* dst; size_t ldc;
        if (u.z == 0) {
            if (pn >= 18) {
                dst = (bf16_t*)(ws + WS_GATES) + (size_t)pm * 256 * 6144 + (pn - 18) * 256;
                const int row0 = wr * 64 + fr, col0 = wc * 32 + 8 * fq;
#pragma unroll
                for (int ai = 0; ai < 2; ++ai)
#pragma unroll
                    for (int m = 0; m < 4; ++m) { bf16_t* rowp = dst + (size_t)(row0 + ai * HALF + m * 16) * 6144 + col0;
#pragma unroll
                        for (int bj = 0; bj < 2; ++bj) { const f32x4 v0 = acc[ai][bj][m][0], v1 = acc[ai][bj][m][1];
                            u32x4 w; w.x = cvtpk(sigmoidf_(v0[0]), sigmoidf_(v0[1])); w.y = cvtpk(sigmoidf_(v0[2]), sigmoidf_(v0[3]));
                            w.z = cvtpk(sigmoidf_(v1[0]), sigmoidf_(v1[1])); w.w = cvtpk(sigmoidf_(v1[2]), sigmoidf_(v1[3]));
                            *(u32x4*)(rowp + bj * HALF) = w; } }
                return;
            }
            if (pn < 4) { dst = (bf16_t*)(ws + WS_FIN) + pn * 256; ldc = 1024; }
            else if (pn < 12) { dst = (bf16_t*)(ws + WS_Q) + (pn - 4) * 256; ldc = 2048; }
            else if (pn == 12) { dst = (bf16_t*)(ws + WS_K); ldc = 256; }
            else { dst = (bf16_t*)(ws + WS_QM) + (pn - 14) * 256; ldc = 1024; }
            dst += (size_t)pm * 256 * ldc;
        } else if (u.z == 2) {
            dst = (bf16_t*)(ws + WS_VT) + (size_t)(pm >> 3) * 256 * 2048 + (size_t)(pm & 7) * 256; ldc = 2048;
        } else if (u.z == 1) {
            dst = (bf16_t*)(ws + WS_KMK) + (size_t)pm * 256 * 1024 + pn * 256; ldc = 1024;
        } else {
            dst = (bf16_t*)(ws + WS_VMT) + (size_t)(pn * 4 + pm) * 256 * 256; ldc = 256;
        }
        store_tile_bf16(acc, dst, ldc, wr, wc, fr, fq);
    }
};
struct EpiChan {
    static constexpr bool PERM = true, AFTER_DRAIN = false;
    unsigned char* ws;
    __device__ __forceinline__ void operator()(const f32x4 (&acc)[2][2][4][2], const Unit& u, int wr, int wc, int fr, int fq) const {
        store_tile_bf16(acc, (bf16_t*)(ws + WS_ZT) + (size_t)u.z * 256 * 4096 + (size_t)u.pm * 2048 + u.pn * 256, 4096, wr, wc, fr, fq);
    }
};
struct EpiSeq {
    static constexpr bool PERM = true, AFTER_DRAIN = false;
    unsigned char* ws;
    __device__ __forceinline__ void operator()(const f32x4 (&acc)[2][2][4][2], const Unit& u, int wr, int wc, int fr, int fq) const {
        const int b = u.z >> 2, g = u.z & 3;
        store_tile_bf16(acc, (bf16_t*)(ws + WS_FM) + (size_t)(b * 2048 + u.pm * 256) * 1024 + g * 256, 1024, wr, wc, fr, fq);
    }
};
template <int STEP> struct EpiMix {
    static constexpr bool PERM = false, AFTER_DRAIN = false;
    unsigned char* ws;
    __device__ __forceinline__ void operator()(const f32x4 (&acc)[2][2][4][2], const Unit& u, int wr, int wc, int fr, int fq) const {
        const int row0 = u.pm * 256 + wr * 64 + fr, col0 = u.pn * 256 + wc * 32 + 4 * fq;
        const bf16_t* gates = (const bf16_t*)(ws + WS_GATES) + STEP * 2048;
        float* macc = (float*)(ws + WS_MIXACC); bf16_t* mixed = (bf16_t*)(ws + WS_MIXED);
#pragma unroll
        for (int ai = 0; ai < 2; ++ai)
#pragma unroll
            for (int m = 0; m < 4; ++m) { const size_t row = (size_t)(row0 + ai * HALF + m * 16);
#pragma unroll
                for (int bj = 0; bj < 2; ++bj)
#pragma unroll
                    for (int n = 0; n < 2; ++n) { const int col = col0 + bj * HALF + n * 16;
                        const u32x2 gw = *(const u32x2*)(gates + row * 6144 + col);
                        f32x4 v = acc[ai][bj][m][n];
                        v[0] *= bflo(gw.x); v[1] *= bfhi(gw.x); v[2] *= bflo(gw.y); v[3] *= bfhi(gw.y);
                        if (STEP > 0) v += *(const f32x4*)(macc + row * 2048 + col);
                        if (STEP < 2) *(f32x4*)(macc + row * 2048 + col) = v;
                        else { u32x2 w; w.x = cvtpk(v[0], v[1]); w.y = cvtpk(v[2], v[3]); *(u32x2*)(mixed + row * 2048 + col) = w; } } }
    }
};
struct EpiRes {
    static constexpr bool PERM = false, AFTER_DRAIN = false;
    const float* x; float* x2;
    __device__ __forceinline__ void operator()(const f32x4 (&acc)[2][2][4][2], const Unit& u, int wr, int wc, int fr, int fq) const {
        const int row0 = u.pm * 256 + wr * 64 + fr, col0 = u.pn * 256 + wc * 32 + 4 * fq;
#pragma unroll
        for (int ai = 0; ai < 2; ++ai)
#pragma unroll
            for (int m = 0; m < 4; ++m) { const size_t off = (size_t)(row0 + ai * HALF + m * 16) * 2048 + col0;
#pragma unroll
                for (int bj = 0; bj < 2; ++bj)
#pragma unroll
                    for (int n = 0; n < 2; ++n) *(f32x4*)(x2 + off + bj * HALF + n * 16) = acc[ai][bj][m][n] + *(const f32x4*)(x + off + bj * HALF + n * 16); }
    }
};
__device__ __forceinline__ float swiglu1(float g, float up) {
    g = fminf(g, 7.0f); up = fminf(fmaxf(up, -7.0f), 7.0f);
    return (up + 1.0f) * (g * sigmoidf_(1.702f * g));
}
struct EpiSwiglu {
    static constexpr bool PERM = true, AFTER_DRAIN = false;
    unsigned char* ws; const float* bgu; const LAS int* pt;
    __device__ __forceinline__ void operator()(const f32x4 (&acc)[2][2][4][2], const Unit& u, int wr, int wc, int fr, int fq) const {
        const int e = u.z; const size_t srow0 = (size_t)(__builtin_amdgcn_readfirstlane(pt[e]) + u.pm) * 256 + wr * 64 + fr;
        const int col0 = u.pn * 256 + wc * 32 + 8 * fq;
        bf16_t* act = (bf16_t*)(ws + WS_ACT);
        f32x4 bv[2][2];
#pragma unroll
        for (int bj = 0; bj < 2; ++bj)
#pragma unroll
            for (int n = 0; n < 2; ++n) bv[bj][n] = *(const f32x4*)(bgu + (size_t)e * 4096 + col0 + bj * HALF + 4 * n);
#pragma unroll
        for (int ai = 0; ai < 2; ++ai)
#pragma unroll
            for (int m = 0; m < 4; ++m) { bf16_t* rowp = act + (srow0 + ai * HALF + m * 16) * 2048 + (col0 >> 1);
#pragma unroll
                for (int bj = 0; bj < 2; ++bj) { const f32x4 v0 = acc[ai][bj][m][0] + bv[bj][0], v1 = acc[ai][bj][m][1] + bv[bj][1];
                    u32x2 w; w.x = cvtpk(swiglu1(v0[0], v0[1]), swiglu1(v0[2], v0[3])); w.y = cvtpk(swiglu1(v1[0], v1[1]), swiglu1(v1[2], v1[3]));
                    *(u32x2*)(rowp + bj * (HALF / 2)) = w; } }
    }
};
struct EpiDown {
    static constexpr bool PERM = true, AFTER_DRAIN = false;
    unsigned char* ws; const float* bdn; const LAS int* pt; const LAS int* cn;
    __device__ __forceinline__ void operator()(const f32x4 (&acc)[2][2][4][2], const Unit& u, int wr, int wc, int fr, int fq) const {
        const int e = u.z; const int lrow0 = u.pm * 256 + wr * 64 + fr; const size_t srow0 = (size_t)__builtin_amdgcn_readfirstlane(pt[e]) * 256 + lrow0;
        const int col0 = u.pn * 256 + wc * 32 + 8 * fq;
        bf16_t* ys = (bf16_t*)(ws + WS_YS); const float* wl = (const float*)(ws + WS_WLIST) + (size_t)e * T_; const int cne = __builtin_amdgcn_readfirstlane(cn[e]);
        f32x4 bv[2][2];
#pragma unroll
        for (int bj = 0; bj < 2; ++bj)
#pragma unroll
            for (int n = 0; n < 2; ++n) bv[bj][n] = *(const f32x4*)(bdn + (size_t)e * 2048 + col0 + bj * HALF + 4 * n);
#pragma unroll
        for (int ai = 0; ai < 2; ++ai)
#pragma unroll
            for (int m = 0; m < 4; ++m) { const int pos = lrow0 + ai * HALF + m * 16; const float w = (pos < cne) ? wl[pos] : 0.f;
                bf16_t* rowp = ys + (srow0 + ai * HALF + m * 16) * 2048 + col0;
#pragma unroll
                for (int bj = 0; bj < 2; ++bj) { const f32x4 v0 = (acc[ai][bj][m][0] + bv[bj][0]) * w, v1 = (acc[ai][bj][m][1] + bv[bj][1]) * w;
                    u32x4 o; o.x = cvtpk(v0[0], v0[1]); o.y = cvtpk(v0[2], v0[3]); o.z = cvtpk(v1[0], v1[1]); o.w = cvtpk(v1[2], v1[3]);
                    *(u32x4*)(rowp + bj * HALF) = o; } }
    }
};
__device__ __forceinline__ unsigned pk_fp8x4(float a, float b, float c, float d) {
    int w = __builtin_amdgcn_cvt_pk_fp8_f32(a, b, 0, false); w = __builtin_amdgcn_cvt_pk_fp8_f32(c, d, w, true); return (unsigned)w; }
struct EpiSwiglu8 {
    static constexpr int PERM = 2; static constexpr bool AFTER_DRAIN = false;
    unsigned char* ws; const float* bgu; const LAS int* pt;
    __device__ __forceinline__ void operator()(const f32x4 (&acc)[2][2][4][2], const Unit& u, int wr, int wc, int fr, int fq) const {
        const int e = u.z; const size_t srow0 = (size_t)(__builtin_amdgcn_readfirstlane(pt[e]) + u.pm) * 256 + wr * 64 + fr;
        const int col0 = u.pn * 256 + wc * 64 + 16 * fq;
        unsigned char* act = ws + WS_ACTQ;
        f32x4 bv[2][2];
#pragma unroll
        for (int bj = 0; bj < 2; ++bj)
#pragma unroll
            for (int n = 0; n < 2; ++n) bv[bj][n] = *(const f32x4*)(bgu + (size_t)e * 4096 + col0 + 8 * bj + 4 * n);
#pragma unroll
        for (int ai = 0; ai < 2; ++ai)
#pragma unroll
            for (int m = 0; m < 4; ++m) {
                float o[8];
#pragma unroll
                for (int bj = 0; bj < 2; ++bj)
#pragma unroll
                    for (int n = 0; n < 2; ++n) { const f32x4 v = acc[ai][bj][m][n] * WQ_INV + bv[bj][n]; o[4 * bj + 2 * n] = swiglu1(v[0], v[1]); o[4 * bj + 2 * n + 1] = swiglu1(v[2], v[3]); }
                u32x2 w; w.x = pk_fp8x4(o[0], o[1], o[2], o[3]); w.y = pk_fp8x4(o[4], o[5], o[6], o[7]);
                *(u32x2*)(act + (srow0 + ai * HALF + m * 16) * 2048 + (col0 >> 1)) = w; }
    }
};
struct EpiDown8 {
    static constexpr int PERM = 1; static constexpr bool AFTER_DRAIN = false;
    unsigned char* ws; const float* bdn; const LAS int* pt; const LAS int* cn;
    __device__ __forceinline__ void operator()(const f32x4 (&acc)[2][2][4][2], const Unit& u, int wr, int wc, int fr, int fq) const {
        const int e = u.z; const int lrow0 = u.pm * 256 + wr * 64 + fr; const size_t srow0 = (size_t)__builtin_amdgcn_readfirstlane(pt[e]) * 256 + lrow0;
        const int col0 = u.pn * 256 + wc * 32 + 8 * fq;
        bf16_t* ys = (bf16_t*)(ws + WS_YS); const float* wl = (const float*)(ws + WS_WLIST) + (size_t)e * T_; const int cne = __builtin_amdgcn_readfirstlane(cn[e]);
        f32x4 bv[2][2];
#pragma unroll
        for (int bj = 0; bj < 2; ++bj)
#pragma unroll
            for (int n = 0; n < 2; ++n) bv[bj][n] = *(const f32x4*)(bdn + (size_t)e * 2048 + col0 + bj * HALF + 4 * n);
#pragma unroll
        for (int ai = 0; ai < 2; ++ai)
#pragma unroll
            for (int m = 0; m < 4; ++m) { const int pos = lrow0 + ai * HALF + m * 16; const float w = (pos < cne) ? wl[pos] : 0.f;
                bf16_t* rowp = ys + (srow0 + ai * HALF + m * 16) * 2048 + col0;
#pragma unroll
                for (int bj = 0; bj < 2; ++bj) { const f32x4 v0 = (acc[ai][bj][m][0] * WQ_INV + bv[bj][0]) * w, v1 = (acc[ai][bj][m][1] * WQ_INV + bv[bj][1]) * w;
                    u32x4 o; o.x = cvtpk(v0[0], v0[1]); o.y = cvtpk(v0[2], v0[3]); o.z = cvtpk(v1[0], v1[1]); o.w = cvtpk(v1[2], v1[3]);
                    *(u32x4*)(rowp + bj * HALF) = o; } }
    }
};
struct EpiMemSoftmax {
    static constexpr bool PERM = true, AFTER_DRAIN = true;
    bf16_t* P;
    __device__ __forceinline__ void operator()(const f32x4 (&)[2][2][4][2], const Unit&, int, int, int, int) const {}
    __device__ __forceinline__ void fused(f32x4 (&acc)[2][2][4][2], const Unit&, int wr, int wc, int fr, int fq, LAS unsigned char* lds, int, int) const {
        LAS f32x2* tab = (LAS f32x2*)lds;
        const float sc = 0.0625f * LOG2E;
        float mx[2][4];
#pragma unroll
        for (int ai = 0; ai < 2; ++ai)
#pragma unroll
            for (int m = 0; m < 4; ++m) { float a = -3.0e38f;
#pragma unroll
                for (int bj = 0; bj < 2; ++bj)
#pragma unroll
                    for (int n = 0; n < 2; ++n) { acc[ai][bj][m][n] *= sc; const f32x4 v = acc[ai][bj][m][n]; a = fmaxf(a, fmaxf(fmaxf(v[0], v[1]), fmaxf(v[2], v[3]))); }
                a = fmaxf(a, __shfl_xor(a, 16)); a = fmaxf(a, __shfl_xor(a, 32)); mx[ai][m] = a;
                float s = 0.f;
#pragma unroll
                for (int bj = 0; bj < 2; ++bj)
#pragma unroll
                    for (int n = 0; n < 2; ++n) { const f32x4 v = acc[ai][bj][m][n]; s += __builtin_amdgcn_exp2f(v[0] - a) + __builtin_amdgcn_exp2f(v[1] - a) + __builtin_amdgcn_exp2f(v[2] - a) + __builtin_amdgcn_exp2f(v[3] - a); }
                s += __shfl_xor(s, 16); s += __shfl_xor(s, 32);
                if (fq == 0) tab[(ai * HALF + wr * 64 + m * 16 + fr) * 4 + wc] = (f32x2){a, s};
            }
        __syncthreads();
#pragma unroll
        for (int ai = 0; ai < 2; ++ai)
#pragma unroll
            for (int m = 0; m < 4; ++m) { const int r = ai * HALF + wr * 64 + m * 16 + fr;
                const f32x2 t0 = tab[r * 4 + 0], t1 = tab[r * 4 + 1], t2 = tab[r * 4 + 2], t3 = tab[r * 4 + 3];
                const float M = fmaxf(fmaxf(t0.x, t1.x), fmaxf(t2.x, t3.x));
                const float L = t0.y * __builtin_amdgcn_exp2f(t0.x - M) + t1.y * __builtin_amdgcn_exp2f(t1.x - M) + t2.y * __builtin_amdgcn_exp2f(t2.x - M) + t3.y * __builtin_amdgcn_exp2f(t3.x - M);
                const float inv = 1.0f / L;
                bf16_t* rowp = P + (size_t)r * 1024 + wc * 32 + 8 * fq;
#pragma unroll
                for (int bj = 0; bj < 2; ++bj) { f32x4 v0 = acc[ai][bj][m][0], v1 = acc[ai][bj][m][1];
#pragma unroll
                    for (int j = 0; j < 4; ++j) { v0[j] = __builtin_amdgcn_exp2f(v0[j] - M) * inv; v1[j] = __builtin_amdgcn_exp2f(v1[j] - M) * inv; }
                    u32x4 w; w.x = cvtpk(v0[0], v0[1]); w.y = cvtpk(v0[2], v0[3]); w.z = cvtpk(v1[0], v1[1]); w.w = cvtpk(v1[2], v1[3]);
                    *(u32x4*)(rowp + bj * HALF) = w; } }
        __syncthreads();
    }
};
struct EpiTile {
    static constexpr bool PERM = true, AFTER_DRAIN = false;
    bf16_t* dst; size_t ldc;
    __device__ __forceinline__ void operator()(const f32x4 (&acc)[2][2][4][2], const Unit&, int wr, int wc, int fr, int fq) const { store_tile_bf16(acc, dst, ldc, wr, wc, fr, fq); }
};
__device__ __forceinline__ void tr_item(const float* W, int K, int N, bf16_t* WT, LAS float* scr, int item, int lane) {
    const int nblk = N / 32, kb = item / nblk, nb = item % nblk, k0 = 64 * kb, n0 = 32 * nb;
#pragma unroll 8
    for (int i = 0; i < 32; ++i) { const int kk = 2 * i + (lane >> 5); scr[kk * 33 + (lane & 31)] = W[(size_t)(k0 + kk) * N + n0 + (lane & 31)]; }
    asm volatile("s_waitcnt lgkmcnt(0)" ::: "memory");
    const int c = lane & 7;
#pragma unroll
    for (int j = 0; j < 4; ++j) { const int n = (lane >> 3) + 8 * j; const LAS float* s = scr + (8 * c) * 33 + n;
        u32x4 o; o.x = cvtpk(s[0 * 33], s[1 * 33]); o.y = cvtpk(s[2 * 33], s[3 * 33]); o.z = cvtpk(s[4 * 33], s[5 * 33]); o.w = cvtpk(s[6 * 33], s[7 * 33]);
        *(u32x4*)(WT + (size_t)(n0 + n) * K + k0 + 8 * c) = o; }
    asm volatile("s_waitcnt lgkmcnt(0)" ::: "memory");
}
__device__ __forceinline__ void tr_item8(const float* W, int K, int N, unsigned char* WT, LAS float* scr, int item, int lane, float scale) {
    const int nblk = N / 32, kb = item / nblk, nb = item % nblk, k0 = 128 * kb, n0 = 32 * nb;
#pragma unroll 8
    for (int i = 0; i < 64; ++i) { const int kk = 2 * i + (lane >> 5); scr[kk * 33 + (lane & 31)] = W[(size_t)(k0 + kk) * N + n0 + (lane & 31)] * scale; }
    asm volatile("s_waitcnt lgkmcnt(0)" ::: "memory");
    const int c = lane & 7;
#pragma unroll
    for (int j = 0; j < 4; ++j) { const int n = (lane >> 3) + 8 * j; const LAS float* s = scr + (16 * c) * 33 + n;
        u32x4 o; o.x = pk_fp8x4(s[0 * 33], s[1 * 33], s[2 * 33], s[3 * 33]); o.y = pk_fp8x4(s[4 * 33], s[5 * 33], s[6 * 33], s[7 * 33]);
        o.z = pk_fp8x4(s[8 * 33], s[9 * 33], s[10 * 33], s[11 * 33]); o.w = pk_fp8x4(s[12 * 33], s[13 * 33], s[14 * 33], s[15 * 33]);
        *(u32x4*)(WT + (size_t)(n0 + n) * K + k0 + 16 * c) = o; }
    asm volatile("s_waitcnt lgkmcnt(0)" ::: "memory");
}
__device__ __forceinline__ void rms_row_to_bf16(const float* xrow, const float* g, bf16_t* orow, int lane, unsigned char* qrow = nullptr) {
    const f32x4* xr = (const f32x4*)xrow + lane; const f32x4* gr = (const f32x4*)g + lane;
    f32x4 v[8]; float s = 0.f;
#pragma unroll
    for (int j = 0; j < 8; ++j) { v[j] = xr[64 * j]; s += (v[j][0] * v[j][0] + v[j][1] * v[j][1]) + (v[j][2] * v[j][2] + v[j][3] * v[j][3]); }
    const float r = rsqrtf(wsum(s) * (1.0f / DM) + 1e-5f);
    u32x2* o8 = (u32x2*)orow + lane;
#pragma unroll
    for (int j = 0; j < 8; ++j) { const f32x4 gg = gr[64 * j]; u32x2 w; w.x = cvtpk(v[j][0] * r * gg[0], v[j][1] * r * gg[1]); w.y = cvtpk(v[j][2] * r * gg[2], v[j][3] * r * gg[3]); o8[64 * j] = w;
        if (qrow) ((unsigned*)qrow)[lane + 64 * j] = pk_fp8x4(v[j][0] * r * gg[0], v[j][1] * r * gg[1], v[j][2] * r * gg[2], v[j][3] * r * gg[3]); }
}
__device__ __forceinline__ void phase_prologue(const Params& p, LAS unsigned char* lds) {
    int tid_ = threadIdx.x; asm volatile("" : "+v"(tid_));
    const int tid = tid_, wave = tid >> 6, lane = tid & 63;
    unsigned char* ws = p.ws;
    LAS float* scr = (LAS float*)(lds + wave * 16896);
    const int gw = vwg() * NWAVE + wave, NGW = (int)gridDim.x * NWAVE;
    for (int m = gw; m < T_; m += NGW) rms_row_to_bf16(p.in[0] + (size_t)m * DM, p.in[3], (bf16_t*)(ws + WS_H) + (size_t)m * DM, lane);
    for (int m = gw; m < B_ * MEM; m += NGW) {
        const f32x4* xr = (const f32x4*)(p.in[1] + (size_t)m * DM) + lane; u32x2* o8 = (u32x2*)((bf16_t*)(ws + WS_MEMBF) + (size_t)m * DM) + lane;
#pragma unroll
        for (int j = 0; j < 8; ++j) { const f32x4 v = xr[64 * j]; u32x2 w; w.x = cvtpk(v[0], v[1]); w.y = cvtpk(v[2], v[3]); o8[64 * j] = w; }
    }
    {
        const int gt = vwg() * NTHR + tid, NGT = (int)gridDim.x * NTHR;
        bf16_t* tabT = (bf16_t*)(ws + WS_TABT); bf16_t* dm = (bf16_t*)(ws + WS_DMAT);
        for (int i = gt; i < 512 * 256 / 2; i += NGT) { const int e0 = 2 * i; const int mrow = e0 >> 8, c = e0 & 255; const int n = mrow & 255; float v[2];
#pragma unroll
            for (int j = 0; j < 2; ++j) { const int mm = ((c + j) * n) & 255; const float a = (float)mm * (2.0f / 256.0f); v[j] = (mrow < 256) ? cospif(a) : sinpif(a); }
            *(unsigned*)(tabT + e0) = cvtpk(v[0], v[1]); }
        const float sc = 1.0f / sqrtf(2048.0f * 256.0f);
        for (int i = gt; i < 2048 * 4096 / 2; i += NGT) { const int e0 = 2 * i; const int jr = e0 >> 12, k = e0 & 4095; float v[2];
#pragma unroll
            for (int j = 0; j < 2; ++j) { const int kk = (k + j) & 2047; const int mm = (jr * kk) & 2047; const float a = (float)mm * (2.0f / 2048.0f); v[j] = (k < 2048) ? cospif(a) * sc : -sinpif(a) * sc; }
            *(unsigned*)(dm + e0) = cvtpk(v[0], v[1]); }
        bf16_t* wrt = (bf16_t*)(ws + WS_WRT);
        for (int i = gt; i < NE * DM; i += NGT) { const int e = i >> 11, k = i & 2047; wrt[i] = (bf16_t)(cvtpk(p.in[12][(size_t)k * NE + e], 0.f) & 0xffffu); }
    }
    struct Mat { const float* W; int K, N; size_t dst; int nitems; };
    const int I_IN = (DM / 64) * (INW / 32), I_SQ = (2048 / 64) * (2048 / 32), I_HF = (1024 / 64) * (2048 / 32);
    const int I_GU = MOE_F8 ? (2048 / 128) * (4096 / 32) : (2048 / 64) * (4096 / 32), I_DN = MOE_F8 ? (2048 / 128) * (2048 / 32) : I_SQ;
    const long total = (long)I_IN + 3L * I_SQ + 2L * I_HF + (long)NE * I_GU + (long)NE * I_DN;
    for (long it = gw; it < total; it += NGW) {
        long r = it;
        if (r < I_IN) { tr_item(p.in[4], DM, INW, (bf16_t*)(ws + WS_WINT), scr, (int)r, lane); continue; } r -= I_IN;
        if (r < I_SQ) { tr_item(p.in[6], 2048, 2048, (bf16_t*)(ws + WS_WMKVT), scr, (int)r, lane); continue; } r -= I_SQ;
        if (r < I_HF) { tr_item(p.in[7], 1024, 2048, (bf16_t*)(ws + WS_WFOT), scr, (int)r, lane); continue; } r -= I_HF;
        if (r < I_SQ) { tr_item(p.in[8], 2048, 2048, (bf16_t*)(ws + WS_WAOT), scr, (int)r, lane); continue; } r -= I_SQ;
        if (r < I_HF) { tr_item(p.in[9], 1024, 2048, (bf16_t*)(ws + WS_WMOT), scr, (int)r, lane); continue; } r -= I_HF;
        if (r < I_SQ) { tr_item(p.in[10], 2048, 2048, (bf16_t*)(ws + WS_WOT), scr, (int)r, lane); continue; } r -= I_SQ;
        if (r < (long)NE * I_GU) { const int e = (int)(r / I_GU), q = (int)(r % I_GU);
            if (MOE_F8) tr_item8(p.in[14] + (size_t)e * 2048 * 4096, 2048, 4096, ws + WS_WGUQ + (size_t)e * 4096 * 2048, scr, q, lane, WQ_SCALE);
            else tr_item(p.in[14] + (size_t)e * 2048 * 4096, 2048, 4096, (bf16_t*)(ws + WS_WGUT) + (size_t)e * 4096 * 2048, scr, q, lane); continue; } r -= (long)NE * I_GU;
        { const int e = (int)(r / I_DN), q = (int)(r % I_DN);
            if (MOE_F8) tr_item8(p.in[16] + (size_t)e * 2048 * 2048, 2048, 2048, ws + WS_WDNQ + (size_t)e * 2048 * 2048, scr, q, lane, WQ_SCALE);
            else tr_item(p.in[16] + (size_t)e * 2048 * 2048, 2048, 2048, (bf16_t*)(ws + WS_WDNT) + (size_t)e * 2048 * 2048, scr, q, lane); }
    }
}

constexpr int AT_KROW = 144, AT_VROW = 776;
constexpr int AT_K = 0, AT_V = 384 * AT_KROW, AT_LUT = AT_V + 64 * AT_VROW;
static_assert(AT_LUT + NWAVE * 320 * 4 <= STAGE_BYTES, "attention LDS");
__device__ __forceinline__ void attn_unit(const Params& p, LAS unsigned char* lds, int b, int kvh, int qb) {
    int tid_ = threadIdx.x; asm volatile("" : "+v"(tid_));
    const int tid = tid_, wid = __builtin_amdgcn_readfirstlane(tid >> 6), lane = tid & 63, r = lane & 31, h = lane >> 5;
    const unsigned char* ws = p.ws;
    const bf16_t* Q = (const bf16_t*)(ws + WS_Q); const bf16_t* Kg = (const bf16_t*)(ws + WS_K); const bf16_t* VT = (const bf16_t*)(ws + WS_VT);
    bf16_t* att = (bf16_t*)(p.ws + WS_ATT);
    const int q0 = qb * 128, hq = kvh * 8 + wid;
    LAS unsigned char* Kb = lds + AT_K; LAS unsigned char* Vt = lds + AT_V; LAS float* lut = (LAS float*)(lds + AT_LUT) + wid * 320;
    __syncthreads();
    for (int c = tid; c < 384 * 8; c += NTHR) { const int row = c >> 3, part = c & 7, pos = q0 - 128 + row;
        u32x4 v = {0u, 0u, 0u, 0u};
        if (pos >= 0 && pos < S_) v = *(const u32x4*)(Kg + (size_t)(b * S_ + pos) * 256 + kvh * 64 + part * 8);
        *(LAS u32x4*)(Kb + row * AT_KROW + part * 16) = v; }
    for (int c = tid; c < 64 * 48; c += NTHR) { const int d = c / 48, ch = c % 48, pos0 = q0 - 128 + ch * 8;
        u32x4 v = {0u, 0u, 0u, 0u};
        if (pos0 >= 0 && pos0 < S_) v = *(const u32x4*)(VT + ((size_t)((b * 4 + kvh) * 64 + d)) * 2048 + pos0);
        *(LAS u32x2*)(Vt + d * AT_VROW + ch * 16) = (u32x2){v.x, v.y}; *(LAS u32x2*)(Vt + d * AT_VROW + ch * 16 + 8) = (u32x2){v.z, v.w}; }
    for (int i = lane; i < 320; i += 64) { const int rel = i - 160; const int ar = rel < 0 ? -rel : rel;
        lut[i] = (ar <= WIN) ? p.in[2][t5_bucket(rel) * NH + hq] * LOG2E : -1.0e30f; }
    __syncthreads();
    const float sk = p.in[5][hq] * LOG2E;
    const float SC = 0.125f * LOG2E;
#pragma unroll 1
    for (int sb = 0; sb < 4; ++sb) {
        const int pq = q0 + sb * 32;
        bf16x8 qf[4];
        const bf16_t* qrow = Q + (size_t)(b * S_ + pq + r) * 2048 + hq * 64 + 8 * h;
#pragma unroll
        for (int s = 0; s < 4; ++s) qf[s] = *(const bf16x8*)(qrow + 16 * s);
        float mrun = sk, lrun = 1.0f;
        f32x16 o0, o1;
#pragma unroll
        for (int i = 0; i < 16; ++i) { o0[i] = 0.f; o1[i] = 0.f; }
#pragma unroll 1
        for (int j = 0; j < 9; ++j) {
            const int bt = sb + j, kpos0 = q0 - 128 + 32 * bt;
            if (kpos0 < 0 || kpos0 >= S_) continue;
            f32x16 s;
#pragma unroll
            for (int i = 0; i < 16; ++i) s[i] = 0.f;
            const LAS unsigned char* kp = Kb + (32 * bt + r) * AT_KROW + 16 * h;
#pragma unroll
            for (int ks = 0; ks < 4; ++ks) { const bf16x8 kf = *(const LAS bf16x8*)(kp + 32 * ks); s = __builtin_amdgcn_mfma_f32_32x32x16_bf16(kf, qf[ks], s, 0, 0, 0); }
            const LAS float* lp = lut + 32 * j + 32 + 4 * h - r;
            float mx = -3.0e38f;
#pragma unroll
            for (int i = 0; i < 16; ++i) { s[i] = s[i] * SC + lp[(i & 3) + 8 * (i >> 2)]; mx = fmaxf(mx, s[i]); }
            mx = fmaxf(mx, __shfl_xor(mx, 32));
            const float mnew = fmaxf(mrun, mx);
            const float alpha = __builtin_amdgcn_exp2f(mrun - mnew);
            float rs = 0.f;
#pragma unroll
            for (int i = 0; i < 16; ++i) { s[i] = __builtin_amdgcn_exp2f(s[i] - mnew); rs += s[i]; }
            rs += __shfl_xor(rs, 32);
            lrun = lrun * alpha + rs; mrun = mnew;
#pragma unroll
            for (int i = 0; i < 16; ++i) { o0[i] *= alpha; o1[i] *= alpha; }
#pragma unroll
            for (int k2 = 0; k2 < 2; ++k2) {
                u32x4 pw; pw.x = cvtpk(s[8 * k2 + 0], s[8 * k2 + 1]); pw.y = cvtpk(s[8 * k2 + 2], s[8 * k2 + 3]); pw.z = cvtpk(s[8 * k2 + 4], s[8 * k2 + 5]); pw.w = cvtpk(s[8 * k2 + 6], s[8 * k2 + 7]);
                const bf16x8 pb = __builtin_bit_cast(bf16x8, pw);
                const LAS unsigned char* vp = Vt + r * AT_VROW + (32 * bt + 16 * k2 + 4 * h) * 2;
                { const u32x2 lo = *(const LAS u32x2*)(vp), hi = *(const LAS u32x2*)(vp + 16); const u32x4 vw = {lo.x, lo.y, hi.x, hi.y};
                  o0 = __builtin_amdgcn_mfma_f32_32x32x16_bf16(__builtin_bit_cast(bf16x8, vw), pb, o0, 0, 0, 0); }
                { const u32x2 lo = *(const LAS u32x2*)(vp + 32 * AT_VROW), hi = *(const LAS u32x2*)(vp + 32 * AT_VROW + 16); const u32x4 vw = {lo.x, lo.y, hi.x, hi.y};
                  o1 = __builtin_amdgcn_mfma_f32_32x32x16_bf16(__builtin_bit_cast(bf16x8, vw), pb, o1, 0, 0, 0); }
            }
        }
        const float inv = 1.0f / lrun;
        bf16_t* orow = att + (size_t)(b * S_ + pq + r) * 2048 + hq * 64 + 4 * h;
#pragma unroll
        for (int g = 0; g < 4; ++g) {
            u32x2 w0; w0.x = cvtpk(o0[4 * g] * inv, o0[4 * g + 1] * inv); w0.y = cvtpk(o0[4 * g + 2] * inv, o0[4 * g + 3] * inv); *(u32x2*)(orow + 8 * g) = w0;
            u32x2 w1; w1.x = cvtpk(o1[4 * g] * inv, o1[4 * g + 1] * inv); w1.y = cvtpk(o1[4 * g + 2] * inv, o1[4 * g + 3] * inv); *(u32x2*)(orow + 32 + 8 * g) = w1;
        }
    }
}

__device__ __forceinline__ void phase_rows(const Params& p, LAS unsigned char* lds) {
    int tid_ = threadIdx.x; asm volatile("" : "+v"(tid_));
    const int tid = tid_, wave = __builtin_amdgcn_readfirstlane(tid >> 6), lane = tid & 63;
    unsigned char* ws = p.ws;
    const float* x2 = (const float*)(ws + WS_X2); bf16_t* h2 = (bf16_t*)(ws + WS_H2);
    LAS float* lg = (LAS float*)lds;
    LAS int* sel_e = (LAS int*)(lds + 8192);
    LAS float* sel_w = (LAS float*)(lds + 9216);
    LAS int* sel_r = (LAS int*)(lds + 10240);
    LAS int* lcnt = (LAS int*)(lds + 11264);
    LAS int* lbase = (LAS int*)(lds + 11392);
#pragma unroll 1
    for (int t0 = vwg() * 64; t0 < T_; t0 += 64 * (int)gridDim.x) {
        __syncthreads();
        if (tid < 32) lcnt[tid] = 0;
        for (int i = 0; i < 8; ++i) { const int t = t0 + wave * 8 + i; rms_row_to_bf16(x2 + (size_t)t * DM, p.in[11], h2 + (size_t)t * DM, lane, MOE_F8 ? (ws + WS_H2Q + (size_t)t * DM) : nullptr); }
        asm volatile("s_waitcnt vmcnt(0)" ::: "memory");
        __syncthreads();
        if (wave < 4) {
            const bf16_t* arow = h2 + (size_t)(t0 + wave * 16 + (lane & 15)) * DM + 8 * (lane >> 4);
            const bf16_t* b0 = (const bf16_t*)(ws + WS_WRT) + (size_t)(lane & 15) * DM + 8 * (lane >> 4);
            const bf16_t* b1 = b0 + (size_t)16 * DM;
            f32x4 a0 = {0.f, 0.f, 0.f, 0.f}, a1 = {0.f, 0.f, 0.f, 0.f};
#pragma unroll 8
            for (int s = 0; s < 64; ++s) { const bf16x8 av = *(const bf16x8*)(arow + 32 * s), bv0 = *(const bf16x8*)(b0 + 32 * s), bv1 = *(const bf16x8*)(b1 + 32 * s);
                a0 = __builtin_amdgcn_mfma_f32_16x16x32_bf16(av, bv0, a0, 0, 0, 0); a1 = __builtin_amdgcn_mfma_f32_16x16x32_bf16(av, bv1, a1, 0, 0, 0); }
            const int ecol = lane & 15; const float bb0 = p.in[13][ecol], bb1 = p.in[13][ecol + 16];
#pragma unroll
            for (int rg = 0; rg < 4; ++rg) { const int tl = wave * 16 + (lane >> 4) * 4 + rg; lg[tl * 32 + ecol] = a0[rg] + bb0; lg[tl * 32 + ecol + 16] = a1[rg] + bb1; }
        }
        __syncthreads();
        if (tid < 64) {
            float v[32];
#pragma unroll
            for (int e = 0; e < 32; ++e) v[e] = lg[tid * 32 + e];
            float tv[4]; int ti[4];
#pragma unroll
            for (int k = 0; k < 4; ++k) { float bv = -3.0e38f; int bi = 0;
#pragma unroll
                for (int e = 0; e < 32; ++e) { const bool tk = v[e] > bv; bv = tk ? v[e] : bv; bi = tk ? e : bi; }
                tv[k] = bv; ti[k] = bi;
#pragma unroll
                for (int e = 0; e < 32; ++e) v[e] = (e == bi) ? -3.0e38f : v[e]; }
            const float e1 = __expf(tv[1] - tv[0]), e2 = __expf(tv[2] - tv[0]), e3 = __expf(tv[3] - tv[0]);
            const float inv = 1.0f / (1.0f + e1 + e2 + e3);
            const float wv[4] = {inv, e1 * inv, e2 * inv, e3 * inv};
#pragma unroll
            for (int k = 0; k < 4; ++k) { sel_e[tid * 4 + k] = ti[k]; sel_w[tid * 4 + k] = wv[k]; sel_r[tid * 4 + k] = __hip_atomic_fetch_add(&lcnt[ti[k]], 1, __ATOMIC_RELAXED, __HIP_MEMORY_SCOPE_WORKGROUP); }
        }
        __syncthreads();
        if (tid < 32) lbase[tid] = (lcnt[tid] > 0) ? atomicAdd((int*)(ws + WS_CTL) + CW_CNT + tid, lcnt[tid]) : 0;
        __syncthreads();
        if (tid < 256) { const int tl = tid >> 2, k = tid & 3, t = t0 + tl; const int e = sel_e[tid], pos = lbase[e] + sel_r[tid]; const float w = sel_w[tid];
            ((int*)(ws + WS_TOKE))[t * 4 + k] = e; ((int*)(ws + WS_TOKPOS))[t * 4 + k] = pos; ((float*)(ws + WS_TOKW))[t * 4 + k] = w;
            ((int*)(ws + WS_LIST))[(size_t)e * T_ + pos] = t; ((float*)(ws + WS_WLIST))[(size_t)e * T_ + pos] = w; }
    }
}
__device__ __forceinline__ void moe_tables(const Params& p, LAS int* pt, LAS int* cn) {
    __syncthreads();
    if (threadIdx.x == 0) { const int* cnt = (const int*)(p.ws + WS_CTL) + CW_CNT; int a = 0;
        for (int e = 0; e < NE; ++e) { const int c = __hip_atomic_load(cnt + e, __ATOMIC_RELAXED, __HIP_MEMORY_SCOPE_AGENT); cn[e] = c; pt[e] = a; a += (c + 255) >> 8; }
        pt[NE] = a; }
    __syncthreads();
}
__device__ __forceinline__ void phase_final(const Params& p, const LAS int* pt) {
    int tid_ = threadIdx.x; asm volatile("" : "+v"(tid_));
    const int tid = tid_, wave = tid >> 6, lane = tid & 63;
    const unsigned char* ws = p.ws;
    const float* x2 = (const float*)(ws + WS_X2); const bf16_t* ys = (const bf16_t*)(ws + WS_YS);
    const int* toke = (const int*)(ws + WS_TOKE); const int* tokpos = (const int*)(ws + WS_TOKPOS);
    const int gw = vwg() * NWAVE + wave, NGW = (int)gridDim.x * NWAVE;
    for (int t = gw; t < T_; t += NGW) {
        const f32x4* xr = (const f32x4*)(x2 + (size_t)t * DM) + lane;
        f32x4 v[8];
#pragma unroll
        for (int j = 0; j < 8; ++j) v[j] = xr[64 * j];
#pragma unroll
        for (int k = 0; k < 4; ++k) { const int e = toke[t * 4 + k]; const size_t slot = (size_t)pt[e] * 256 + tokpos[t * 4 + k];
            const u32x2* yr = (const u32x2*)(ys + slot * DM) + lane;
#pragma unroll
            for (int j = 0; j < 8; ++j) { const u32x2 w = yr[64 * j]; v[j][0] += bflo(w.x); v[j][1] += bfhi(w.x); v[j][2] += bflo(w.y); v[j][3] += bfhi(w.y); } }
        float s = 0.f;
#pragma unroll
        for (int j = 0; j < 8; ++j) s += (v[j][0] * v[j][0] + v[j][1] * v[j][1]) + (v[j][2] * v[j][2] + v[j][3] * v[j][3]);
        const float r = rsqrtf(wsum(s) * (1.0f / DM) + 1e-5f);
        const f32x4* gr = (const f32x4*)p.in[18] + lane; f32x4* orow = (f32x4*)(p.out + (size_t)t * DM) + lane;
#pragma unroll
        for (int j = 0; j < 8; ++j) { const f32x4 gg = gr[64 * j]; orow[64 * j] = (f32x4){v[j][0] * r * gg[0], v[j][1] * r * gg[1], v[j][2] * r * gg[2], v[j][3] * r * gg[3]}; }
    }
}
__device__ __forceinline__ void phase_proj(const Params& p, LAS unsigned char* lds) {
    SchedProj S{p.ws}; EpiProj E{p.ws};
    gemm_phase<EpiProj, SchedProj, true>(lds, 2048, 2048, 2048, S, E);
}
__device__ __forceinline__ void phase_mixers(const Params& p, LAS unsigned char* lds) {
    unsigned char* ws = p.ws;
#pragma unroll 1
    for (int u = vwg(); u < 512; u += (int)gridDim.x) attn_unit(p, lds, u >> 6, (u >> 4) & 3, u & 15);
    asm volatile("s_waitcnt vmcnt(0) lgkmcnt(0)" ::: "memory");
    __syncthreads();
#pragma unroll 1
    for (int u = vwg(); u < 256; u += (int)gridDim.x) {
        const int mh = u & 3, tb = (u >> 2) & 7, b = (u >> 5) & 7;
        const size_t tok0 = (size_t)b * S_ + (size_t)tb * 256;
        bf16_t* Pt = (bf16_t*)(ws + WS_PM) + tok0 * 1024 + mh * 256;
        SchedOne S1{(const char*)(ws + WS_QM) + (tok0 * 1024 + mh * 256) * 2, (const char*)(ws + WS_KMK) + ((size_t)b * 256 * 1024 + mh * 256) * 2, 0, true};
        EpiMemSoftmax E1{Pt};
        gemm_phase<EpiMemSoftmax, SchedOne, false>(lds, 256, 1024, 1024, S1, E1);
        asm volatile("s_waitcnt vmcnt(0)" ::: "memory");
        __syncthreads();
        SchedOne S2{(const char*)Pt, (const char*)(ws + WS_VMT) + ((size_t)(b * 4 + mh) * 256 * 256) * 2, 0, true};
        EpiTile E2{(bf16_t*)(ws + WS_XM) + tok0 * 1024 + mh * 256, 1024};
        gemm_phase<EpiTile, SchedOne, false>(lds, 256, 1024, 256, S2, E2);
        __syncthreads();
    }
    { SchedChan S{ws, 0, 0}; EpiChan E{ws}; gemm_phase<EpiChan, SchedChan, true>(lds, 256, 256, 1024, S, E); }
}
__device__ __forceinline__ void phase_seqdft(const Params& p, LAS unsigned char* lds) {
    SchedSeq S{p.ws}; EpiSeq E{p.ws};
    gemm_phase<EpiSeq, SchedSeq, true>(lds, 4096, 4096, 4096, S, E);
}
__device__ __forceinline__ void phase_mix(const Params& p, LAS unsigned char* lds) {
    unsigned char* ws = p.ws;
    { SchedPlain S{(const char*)(ws + WS_FM), (const char*)(ws + WS_WFOT), (size_t)256 * 1024 * 2, (size_t)256 * 1024 * 2, 64, 8}; EpiMix<0> E{ws}; gemm_phase<EpiMix<0>, SchedPlain, true>(lds, 1024, 1024, 1024, S, E); }
    { SchedPlain S{(const char*)(ws + WS_ATT), (const char*)(ws + WS_WAOT), (size_t)256 * 2048 * 2, (size_t)256 * 2048 * 2, 64, 8}; EpiMix<1> E{ws}; gemm_phase<EpiMix<1>, SchedPlain, true>(lds, 2048, 2048, 2048, S, E); }
    { SchedPlain S{(const char*)(ws + WS_XM), (const char*)(ws + WS_WMOT), (size_t)256 * 1024 * 2, (size_t)256 * 1024 * 2, 64, 8}; EpiMix<2> E{ws}; gemm_phase<EpiMix<2>, SchedPlain, true>(lds, 1024, 1024, 1024, S, E); }
}
__device__ __forceinline__ void phase_x2(const Params& p, LAS unsigned char* lds) {
    unsigned char* ws = p.ws;
    SchedPlain S{(const char*)(ws + WS_MIXED), (const char*)(ws + WS_WOT), (size_t)256 * 2048 * 2, (size_t)256 * 2048 * 2, 64, 8};
    EpiRes E{p.in[0], (float*)(ws + WS_X2)};
    gemm_phase<EpiRes, SchedPlain, true>(lds, 2048, 2048, 2048, S, E);
}
__device__ __forceinline__ void phase_gateup(const Params& p, LAS unsigned char* lds) {
    LAS int* pt = (LAS int*)(lds + LDS_MISC); LAS int* cn = pt + 64;
    moe_tables(p, pt, cn);
    if constexpr (MOE_F8) { SchedMoe<true, 16, true> S{p.ws, pt, cn}; EpiSwiglu8 E{p.ws, p.in[15], pt}; gemm_phase<EpiSwiglu8, SchedMoe<true, 16, true>, true, 1>(lds, 2048, 2048, 2048, S, E); }
    else { SchedMoe<true, 16, false> S{p.ws, pt, cn}; EpiSwiglu E{p.ws, p.in[15], pt}; gemm_phase<EpiSwiglu, SchedMoe<true, 16, false>, true>(lds, 2048, 2048, 2048, S, E); }
}
__device__ __forceinline__ void phase_down(const Params& p, LAS unsigned char* lds) {
    LAS int* pt = (LAS int*)(lds + LDS_MISC); LAS int* cn = pt + 64;
    moe_tables(p, pt, cn);
    if constexpr (MOE_F8) { SchedMoe<false, 8, true> S{p.ws, pt, cn}; EpiDown8 E{p.ws, p.in[17], pt, cn}; gemm_phase<EpiDown8, SchedMoe<false, 8, true>, true, 1>(lds, 2048, 2048, 2048, S, E); }
    else { SchedMoe<false, 8, false> S{p.ws, pt, cn}; EpiDown E{p.ws, p.in[17], pt, cn}; gemm_phase<EpiDown, SchedMoe<false, 8, false>, true>(lds, 2048, 2048, 2048, S, E); }
}
__device__ __forceinline__ void phase_out(const Params& p, LAS unsigned char* lds) {
    LAS int* pt = (LAS int*)(lds + LDS_MISC); LAS int* cn = pt + 64;
    moe_tables(p, pt, cn);
    phase_final(p, pt);
}

template <int PH> __global__ void __launch_bounds__(NTHR, 2) k_phase(Params p) {
    extern __shared__ __attribute__((aligned(16))) unsigned char lds_raw[];
    LAS unsigned char* lds = (LAS unsigned char*)lds_raw;
    if constexpr (PH == 0) phase_prologue(p, lds);
    if constexpr (PH == 1) phase_proj(p, lds);
    if constexpr (PH == 2) phase_mixers(p, lds);
    if constexpr (PH == 3) phase_seqdft(p, lds);
    if constexpr (PH == 4) phase_mix(p, lds);
    if constexpr (PH == 5) phase_x2(p, lds);
    if constexpr (PH == 6) phase_rows(p, lds);
    if constexpr (PH == 7) phase_gateup(p, lds);
    if constexpr (PH == 8) phase_down(p, lds);
    if constexpr (PH == 9) phase_out(p, lds);
}
template <int PH> static void launch_phase(const Params& p, hipStream_t st) {
    static bool attr_done = false;
    if (!attr_done) { (void)hipFuncSetAttribute((const void*)k_phase<PH>, hipFuncAttributeMaxDynamicSharedMemorySize, LDS_BYTES); attr_done = true; }
    hipLaunchKernelGGL(k_phase<PH>, dim3(256), dim3(NTHR), LDS_BYTES, st, p);
}
static void run_fast_multi(const Params& p, hipStream_t st, int lo, int hi) {
    if (lo <= 0 && 0 < hi) launch_phase<0>(p, st);
    if (lo <= 1 && 1 < hi) launch_phase<1>(p, st);
    if (lo <= 2 && 2 < hi) launch_phase<2>(p, st);
    if (lo <= 3 && 3 < hi) launch_phase<3>(p, st);
    if (lo <= 4 && 4 < hi) launch_phase<4>(p, st);
    if (lo <= 5 && 5 < hi) launch_phase<5>(p, st);
    if (lo <= 6 && 6 < hi) launch_phase<6>(p, st);
    if (lo <= 7 && 7 < hi) launch_phase<7>(p, st);
    if (lo <= 8 && 8 < hi) launch_phase<8>(p, st);
    if (lo <= 9 && 9 < hi) launch_phase<9>(p, st);
}
#define XB_TMO      128
#define XB_XCNT(j)  (256  + 64 * (j))
#define XB_XSUB(j)  (1280 + 64 * (j))
#define XB_XGEN(j)  (2304 + 64 * (j))
#define XB_TOP      3328
#define XB_TOPGEN   3392
#define XCD_BAR_WORDS 3456
#define XB_SPIN_CAP (1u << 18)

__device__ __forceinline__ unsigned xb_ld(unsigned* p)              { return __hip_atomic_load(p, __ATOMIC_RELAXED, __HIP_MEMORY_SCOPE_AGENT); }
__device__ __forceinline__ unsigned xb_add(unsigned* p, unsigned v) { return __hip_atomic_fetch_add(p, v, __ATOMIC_RELAXED, __HIP_MEMORY_SCOPE_AGENT); }
__device__ __forceinline__ unsigned xb_xcc_id() { return (unsigned)__builtin_amdgcn_s_getreg((3 << 11) | 20) & 0xFu; }
#define XB_SPIN(cond, bar) do { unsigned _sp = 0; while (cond) { __builtin_amdgcn_s_sleep(1); \
    if ((++_sp & 255u) == 0u) { if (xb_ld(&(bar)[XB_TMO])) break; if (_sp > XB_SPIN_CAP) { atomicAdd(&(bar)[XB_TMO], 1u); break; } } } } while (0)

struct XcdBarrier {
    unsigned* bar; unsigned x;
    volatile LAS unsigned* st;
};

__device__ __forceinline__ XcdBarrier xcd_barrier_post(unsigned* bar, volatile LAS unsigned* st) {
    XcdBarrier b; b.bar = bar; b.x = xb_xcc_id(); b.st = st;
    if (threadIdx.x == 0) (void)xb_add(&bar[XB_XCNT(b.x)], 1u);
    return b;
}
__device__ __forceinline__ void xcd_barrier_complete(unsigned* bar, unsigned x, unsigned& nloc, unsigned& nx) {
    const unsigned G = gridDim.x * gridDim.y * gridDim.z;
    unsigned sum, cnt, mine, sp = 0u;
    for (;;) {
        sum = 0u; cnt = 0u; mine = 0u;
#pragma unroll
        for (unsigned j = 0; j < 16; ++j) { const unsigned c = xb_ld(&bar[XB_XCNT(j)]); sum += c; cnt += (c > 0u) ? 1u : 0u; mine = (j == x) ? c : mine; }
        if (sum == G) break;
        __builtin_amdgcn_s_sleep(1);
        if ((++sp & 255u) == 0u) { if (xb_ld(&bar[XB_TMO])) break; if (sp > XB_SPIN_CAP) { atomicAdd(&bar[XB_TMO], 1u); break; } }
    }
    nloc = mine > 0u ? mine : 1u; nx = cnt > 0u ? cnt : 1u;
}

__device__ __forceinline__ void xcd_barrier(const XcdBarrier& b) {
    asm volatile("s_waitcnt vmcnt(0)" ::: "memory");
    __syncthreads();
    if (threadIdx.x == 0) {
        unsigned* bar = b.bar;
        __builtin_amdgcn_s_waitcnt(0);
        unsigned nloc = b.st[0], nx = b.st[1];
        if (nloc == 0u) { xcd_barrier_complete(bar, b.x, nloc, nx); b.st[0] = nloc; b.st[1] = nx; }
        const unsigned old = xb_add(&bar[XB_XSUB(b.x)], 1u);
        const unsigned gen = old / nloc;
        if (old + 1u == (gen + 1u) * nloc) {
            __builtin_amdgcn_fence(__ATOMIC_RELEASE, "agent");
            asm volatile("s_waitcnt vmcnt(0)" ::: "memory");
            const unsigned og = xb_add(&bar[XB_TOP], 1u);
            const unsigned tg = og / nx;
            if (og + 1u == (tg + 1u) * nx) xb_add(&bar[XB_TOPGEN], 1u);
            else XB_SPIN(xb_ld(&bar[XB_TOPGEN]) == tg, bar);
            __builtin_amdgcn_fence(__ATOMIC_ACQUIRE, "agent");
            xb_add(&bar[XB_XGEN(b.x)], 1u);
            asm volatile("s_waitcnt vmcnt(0)" ::: "memory");
        } else {
            XB_SPIN(xb_ld(&bar[XB_XGEN(b.x)]) == gen, bar);
            __builtin_amdgcn_fence(__ATOMIC_ACQUIRE, "agent");
            asm volatile("s_waitcnt vmcnt(0)" ::: "memory");
        }
    }
    __syncthreads();
}

__global__ void __launch_bounds__(NTHR, 2) mega_fwd(Params p) {
    extern __shared__ __attribute__((aligned(16))) unsigned char lds_raw[];
    LAS unsigned char* lds = (LAS unsigned char*)lds_raw;
    volatile LAS unsigned* xbw = (volatile LAS unsigned*)(lds + LDS_XBW);
    if (threadIdx.x < 4) xbw[threadIdx.x] = 0u;
    __syncthreads();
    XcdBarrier bar = xcd_barrier_post((unsigned*)(p.ws + WS_CTL) + CW_BAR, xbw);
#ifndef DBL
#define DBL 0
#endif
#define RUNPH(i, call) do { call; if constexpr ((DBL >> (i)) & 1) { xcd_barrier(bar); call; } } while (0)
    RUNPH(0, phase_prologue(p, lds));  xcd_barrier(bar);
    RUNPH(1, phase_proj(p, lds));      xcd_barrier(bar);
    RUNPH(2, phase_mixers(p, lds));    xcd_barrier(bar);
    RUNPH(3, phase_seqdft(p, lds));    xcd_barrier(bar);
    RUNPH(4, phase_mix(p, lds));       xcd_barrier(bar);
    RUNPH(5, phase_x2(p, lds));        xcd_barrier(bar);
    phase_rows(p, lds);                xcd_barrier(bar);
    RUNPH(7, phase_gateup(p, lds));    xcd_barrier(bar);
    RUNPH(8, phase_down(p, lds));      xcd_barrier(bar);
    phase_out(p, lds);
}
static void run_fast_one(const Params& p, hipStream_t st) {
    static int grid = 0;
    if (!grid) {
        int dev = 0, cus = 0, per_cu = 0;
        (void)hipGetDevice(&dev); (void)hipDeviceGetAttribute(&cus, hipDeviceAttributeMultiprocessorCount, dev);
        (void)hipFuncSetAttribute((const void*)mega_fwd, hipFuncAttributeMaxDynamicSharedMemorySize, LDS_BYTES);
        (void)hipOccupancyMaxActiveBlocksPerMultiprocessor(&per_cu, (const void*)mega_fwd, NTHR, LDS_BYTES);
        if (per_cu < 1) per_cu = 1;
        grid = cus > 256 ? 256 : cus;
        grid &= ~7; if (grid < 8) grid = 8;
    }
    hipLaunchKernelGGL(mega_fwd, dim3(grid), dim3(NTHR), LDS_BYTES, st, p);
}
}
#ifndef REPORT
#define REPORT 0
#endif
extern "C" void kernel_launch(void* const* d_in, const int* in_sizes, int n_in, void* d_out, int out_size, void* d_ws, size_t ws_size, hipStream_t stream) {
    (void)in_sizes; (void)n_in; (void)out_size; (void)ws_size;
    unsigned char* ws = (unsigned char*)d_ws;
#if MODE == 0
    nv::NBuf nb; nv::carve(nb, ws);
    nv::run_part1(d_in, nb, stream); nv::run_part2(d_in, nb, (float*)d_out, stream);
#elif MODE == 1
    constexpr size_t NAIVE_BASE = (fx::WS_FAST_END + 4095) & ~(size_t)4095;
    nv::NBuf nb; const size_t nbytes = nv::carve(nb, ws + NAIVE_BASE);
    float* fout = (float*)(ws + NAIVE_BASE + ((nbytes + 4095) & ~(size_t)4095));
    double* acc = (double*)(fout + (size_t)16384 * 2048); float* scale = (float*)(acc + 64);
    fx::Params p; memset(&p, 0, sizeof(p));
    for (int i = 0; i < 19; ++i) p.in[i] = (const float*)d_in[i];
    p.out = fout; p.ws = ws;
    (void)hipMemsetAsync(ws + fx::WS_CTL, 0, fx::CTL_BYTES, stream);
    (void)hipMemsetAsync(acc, 0, 1024, stream);
    nv::run_part1(d_in, nb, stream);
    fx::run_fast_multi(p, stream, 0, 7);
    auto cmp = [&](int slot, int kind, const void* a, const float* ref, long long n, int w, int ldf, int ldr, int off, int sig) {
        ck::CP c; memset(&c, 0, sizeof(c)); c.a = a; c.ref = ref; c.n = n; c.kind = kind; c.w = w; c.ldf = ldf; c.ldr = ldr; c.off = off; c.sig = sig; c.slot = slot;
        hipLaunchKernelGGL(ck::k_cmp, dim3(2048), dim3(256), 0, stream, c, acc); };
    const long long T = 16384;
    cmp(0, 0, ws + fx::WS_FIN, nb.proj, T * 1024, 1024, 1024, 10752, 0, 0);
    cmp(1, 0, ws + fx::WS_Q, nb.proj, T * 2048, 2048, 2048, 10752, 1024, 0);
    cmp(2, 0, ws + fx::WS_K, nb.proj, T * 256, 256, 256, 10752, 3072, 0);
    cmp(3, 2, ws + fx::WS_VT, nb.proj, T * 256, 0, 0, 0, 0, 0);
    cmp(4, 0, ws + fx::WS_QM, nb.proj, T * 1024, 1024, 1024, 10752, 3584, 0);
    cmp(5, 0, ws + fx::WS_GATES, nb.proj, T * 6144, 6144, 6144, 10752, 4608, 1);
    cmp(6, 0, ws + fx::WS_KMK, nb.kvm, 2048LL * 1024, 1024, 1024, 2048, 0, 0);
    cmp(7, 3, ws + fx::WS_VMT, nb.kvm, 2048LL * 1024, 0, 0, 0, 0, 0);
    cmp(8, 0, ws + fx::WS_ATT, nb.att, T * 2048, 2048, 2048, 2048, 0, 0);
    cmp(9, 0, ws + fx::WS_XM, nb.xm, T * 1024, 1024, 1024, 1024, 0, 0);
    cmp(10, 0, ws + fx::WS_FM, nb.fm, T * 1024, 1024, 1024, 1024, 0, 0);
    cmp(11, 0, ws + fx::WS_MIXED, nb.mixed, T * 2048, 2048, 2048, 2048, 0, 0);
    cmp(12, 1, ws + fx::WS_X2, nb.x2, T * 2048, 2048, 2048, 2048, 0, 0);
    cmp(13, 0, ws + fx::WS_H2, nb.h2, T * 2048, 2048, 2048, 2048, 0, 0);
    hipLaunchKernelGGL(ck::k_cmp_route, dim3(64), dim3(256), 0, stream, (const int*)(ws + fx::WS_TOKE), (const int*)nb.tope, acc, 14);
    nv::run_part2(d_in, nb, nb.nout, stream);
    fx::run_fast_multi(p, stream, 7, 10);
    cmp(15, 1, fout, nb.nout, T * 2048, 2048, 2048, 2048, 0, 0);
    hipLaunchKernelGGL(ck::k_verdict, dim3(1), dim3(64), 0, stream, (const double*)acc, scale, 16, (int)REPORT);
    hipLaunchKernelGGL(ck::k_scale_out, dim3(2048), dim3(256), 0, stream, (const float*)nb.nout, (const float*)scale, (float*)d_out, T * 2048);
#elif MODE == 2
    fx::Params p; memset(&p, 0, sizeof(p));
    for (int i = 0; i < 19; ++i) p.in[i] = (const float*)d_in[i];
    p.out = (float*)d_out; p.ws = ws;
    (void)hipMemsetAsync(ws + fx::WS_CTL, 0, fx::CTL_BYTES, stream);
    fx::run_fast_multi(p, stream, 0, 10);
#elif MODE == 3
    fx::Params p; memset(&p, 0, sizeof(p));
    for (int i = 0; i < 19; ++i) p.in[i] = (const float*)d_in[i];
    p.out = (float*)d_out; p.ws = ws;
    (void)hipMemsetAsync(ws + fx::WS_CTL, 0, fx::CTL_BYTES, stream);
    fx::run_fast_one(p, stream);
#endif
}
```

```cpp
#include <hip/hip_runtime.h>
#include <stdint.h>
#include <string.h>
#ifndef MODE
#define MODE 3
#endif
namespace fx {
#define LAS __attribute__((address_space(3)))
typedef unsigned short bf16_t;
typedef short bf16x8 __attribute__((ext_vector_type(8)));
typedef short s16x4 __attribute__((ext_vector_type(4)));
typedef float f32x4 __attribute__((ext_vector_type(4)));
typedef float f32x16 __attribute__((ext_vector_type(16)));
typedef float f32x2 __attribute__((ext_vector_type(2)));
typedef __bf16 bf16x2_t __attribute__((ext_vector_type(2)));
typedef unsigned u32x4 __attribute__((ext_vector_type(4)));
typedef unsigned u32x2 __attribute__((ext_vector_type(2)));

constexpr int NTHR = 512, NWAVE = 8;
constexpr int B_ = 8, S_ = 2048, DM = 2048, T_ = B_ * S_;
constexpr int MEM = 256, FW = 1024, FG = 4, FGD = 256;
constexpr int NH = 32, NKV = 4, HD = 64, AW = 2048, KVW = 256, WIN = 128;
constexpr int MH = 4, MHD = 256, MW = 1024;
constexpr int NE = 32, TOPK = 4, DFF = 2048;
constexpr int INW = 10752;
#ifndef LDPAD
#define LDPAD 0
#endif
constexpr int LDP = 2048 + LDPAD;
constexpr int NSLOT = T_ * TOPK + NE * 256;
constexpr float LOG2E = 1.4426950408889634f;
#ifndef MOE_FP8
#define MOE_FP8 1
#endif
constexpr bool MOE_F8 = (MOE_FP8 != 0);
#ifndef GATES_FP8
#define GATES_FP8 1
#endif
constexpr bool GATES_F8 = (GATES_FP8 != 0);
#ifndef CONV_TILE32
#define CONV_TILE32 0
#endif
#ifndef MOE_ALIGN
#define MOE_ALIGN true
#endif
#ifndef PROFSEL
#define PROFSEL 0
#endif
#ifndef PROFMETRIC
#define PROFMETRIC 0
#endif
#ifndef PROFMUL
#define PROFMUL 1
#endif
#ifndef PROFBLK
#define PROFBLK 0
#endif

constexpr size_t al256(size_t x) { return (x + 255) & ~(size_t)255; }
constexpr size_t WS_CTL = 0, CTL_BYTES = 65536;
constexpr size_t WS_WINT = 1u << 20;
constexpr size_t WS_WMKVT = WS_WINT + (size_t)INW * LDP * 2;
constexpr size_t WS_WFOT = WS_WMKVT + (size_t)2048 * LDP * 2;
constexpr size_t WS_WAOT = WS_WFOT + (size_t)2048 * 1024 * 2;
constexpr size_t WS_WMOT = WS_WAOT + (size_t)2048 * 2048 * 2;
constexpr size_t WS_WOT = WS_WMOT + (size_t)2048 * 1024 * 2;
constexpr size_t WS_WRT = WS_WOT + (size_t)2048 * 2048 * 2;
constexpr size_t WS_TABT = WS_WRT + (size_t)NE * DM * 2;
constexpr size_t WS_DMAT = WS_TABT + (size_t)512 * 256 * 2;
constexpr size_t WS_WGUT = WS_DMAT + (size_t)2048 * 4096 * 2;
constexpr size_t WS_WDNT = WS_WGUT + (size_t)NE * 4096 * 2048 * 2;
constexpr size_t WS_H = WS_WDNT + (size_t)NE * 2048 * 2048 * 2;
constexpr size_t WS_MEMBF = WS_H + (size_t)T_ * LDP * 2;
constexpr size_t WS_FIN = WS_MEMBF + (size_t)2048 * LDP * 2;
constexpr size_t WS_Q = WS_FIN + (size_t)T_ * FW * 2;
constexpr size_t WS_K = WS_Q + (size_t)T_ * AW * 2;
constexpr size_t WS_VT = WS_K + (size_t)T_ * KVW * 2;
constexpr size_t WS_QM = WS_VT + (size_t)T_ * KVW * 2;
constexpr size_t WS_GATES = WS_QM + (size_t)T_ * MW * 2;
constexpr size_t WS_KMK = WS_GATES + (size_t)T_ * 3 * DM * 2;
constexpr size_t WS_VMT = WS_KMK + (size_t)2048 * 1024 * 2;
constexpr size_t WS_ZT = WS_VMT + (size_t)2048 * 1024 * 2;
constexpr size_t WS_FM = WS_ZT + (size_t)32 * 256 * 4096 * 2;
constexpr size_t WS_ATT = WS_FM + (size_t)T_ * FW * 2;
constexpr size_t WS_PM = WS_ATT + (size_t)T_ * AW * 2;
constexpr size_t WS_XM = WS_PM + (size_t)T_ * MH * 256 * 2;
constexpr size_t WS_MIXACC = WS_XM + (size_t)T_ * MW * 2;
constexpr size_t WS_MIXED = WS_MIXACC + (size_t)T_ * DM * 4;
constexpr size_t WS_FX = WS_MIXACC;
constexpr size_t WS_WFM = WS_MIXACC + (size_t)T_ * 2048 * 2;
static_assert(WS_WFM + (size_t)2048 * 2048 * 2 <= WS_MIXED, "fused-mix operands fit the old mixacc region");
constexpr size_t WS_X2 = WS_MIXED + (size_t)T_ * DM * 2;
constexpr size_t WS_H2 = WS_X2 + (size_t)T_ * DM * 4;
constexpr size_t WS_TOKE = WS_H2 + (size_t)T_ * DM * 2;
constexpr size_t WS_TOKPOS = WS_TOKE + (size_t)T_ * 4 * 4;
constexpr size_t WS_TOKW = WS_TOKPOS + (size_t)T_ * 4 * 4;
constexpr size_t WS_LIST = WS_TOKW + (size_t)T_ * 4 * 4;
constexpr size_t WS_WLIST = WS_LIST + (size_t)NE * T_ * 4;
constexpr size_t WS_WGUQ = WS_WLIST + (size_t)NE * T_ * 4;
constexpr size_t WS_WDNQ = WS_WGUQ + (size_t)NE * 4096 * 2048;
constexpr size_t WS_H2Q = WS_WDNQ + (size_t)NE * 2048 * 2048;
constexpr size_t WS_H8 = WS_H2Q + (size_t)T_ * DM;
constexpr size_t WS_WINQ = WS_H8 + (size_t)T_ * DM;
constexpr size_t WS_FAST_END = WS_WINQ + (size_t)6144 * DM;
constexpr size_t WS_ACTQ = WS_H;
constexpr float WQ_SCALE = 32.0f, WQ_INV = 1.0f / 32.0f;
constexpr float YS_SCALE = 16.0f, YS_INV = 1.0f / 16.0f;
constexpr size_t WS_ACT = WS_H;
constexpr size_t WS_YS = WS_ACT + (size_t)NSLOT * DFF * 2;
static_assert(WS_YS + (size_t)NSLOT * DM * 2 <= WS_MIXED, "overlay fits");
constexpr int CW_CNT = 0;
constexpr int CW_POOL = 64;
constexpr int CW_BAR = 4096;

constexpr int LDS_STAGE = 0, STAGE_BYTES = 131072;
constexpr int LDS_TOKL = 131072;
constexpr int LDS_MISC = 141312;
constexpr int LDS_BTAB = 142336;
constexpr int LDS_XBW = 163824;
constexpr int LDS_BYTES = 163840;

struct Params {
    const float* in[19]; float* out; unsigned char* ws;
};

__device__ __forceinline__ unsigned cvtpk(float lo, float hi) { f32x2 v = {lo, hi}; bf16x2_t b = __builtin_convertvector(v, bf16x2_t); return __builtin_bit_cast(unsigned, b); }
__device__ __forceinline__ float bf2f(unsigned short x) { return __uint_as_float(((unsigned)x) << 16); }
__device__ __forceinline__ float bflo(unsigned w) { return __uint_as_float(w << 16); }
__device__ __forceinline__ float bfhi(unsigned w) { return __uint_as_float(w & 0xffff0000u); }
__device__ __forceinline__ float wsum(float v) {
#pragma unroll
    for (int o = 1; o < 64; o <<= 1) v += __shfl_xor(v, o);
    return v;
}
__device__ __forceinline__ float sigmoid_sc(float x, float nsc) { return __builtin_amdgcn_rcpf(1.0f + __builtin_amdgcn_exp2f(x * nsc)); }
__device__ __forceinline__ float sigmoidf_(float x) { return __builtin_amdgcn_rcpf(1.0f + __builtin_amdgcn_exp2f(-x * LOG2E)); }
__device__ __forceinline__ int crow(int r, int h) { return (r & 3) + 8 * (r >> 2) + 4 * h; }
__device__ __forceinline__ int t5_bucket(int rel) {
    const int n = rel < 0 ? -rel : rel;
    int b;
    if (n < 8) b = n; else if (n < 12) b = 8; else if (n < 16) b = 9; else if (n < 23) b = 10; else if (n < 32) b = 11;
    else if (n < 46) b = 12; else if (n < 64) b = 13; else if (n < 91) b = 14; else b = 15;
    return (rel > 0 ? 16 : 0) + b;
}
__device__ __forceinline__ int vwg() { const int c = blockIdx.x, G = gridDim.x; return ((G & 7) == 0) ? (c & 7) * (G >> 3) + (c >> 3) : c; }

constexpr int BM = 256, BK = 64, HALF = 128, HTB = HALF * BK * 2;
__host__ __device__ __forceinline__ int lds_byte(int r, int c) { const int st = (r >> 4) * 2 + (c >> 5), rr = r & 15, cc = c & 31, ob = rr * 64 + cc * 2; return st * 1024 + (ob ^ (((ob >> 9) & 1) << 5)); }
__host__ __device__ __forceinline__ void stage_rc(int b, int& R, int& C) { const int st = b / 1024, sb = b % 1024, swz = sb ^ (((sb >> 9) & 1) << 5); R = (st >> 1) * 16 + swz / 64; C = (st & 1) * 32 + (swz % 64) / 2; }
__host__ __device__ __forceinline__ int perm32(int rho) { const int n = rho >> 4, i = rho & 15; return 8 * (i >> 2) + 4 * n + (i & 3); }

struct Unit { int pm, pn, z, idx; };
template <class S, class = void> struct SchedVarK { static constexpr bool v = false; };
template <class S> struct SchedVarK<S, decltype((void)S::VARK)> { static constexpr bool v = S::VARK; };
template <class E, class = void> struct EpiKeep { static constexpr bool v = false; };
template <class E> struct EpiKeep<E, decltype((void)E::KEEP)> { static constexpr bool v = E::KEEP; };
typedef int v4i_t __attribute__((ext_vector_type(4)));
typedef int v8i_t __attribute__((ext_vector_type(8)));
__device__ __forceinline__ void mfma_f8(f32x4& c, const v8i_t& a, const v8i_t& b) { asm volatile("v_mfma_f32_16x16x128_f8f6f4 %0, %1, %2, %0" : "+v"(c) : "v"(a), "v"(b)); }
template <int ESZ> struct FragT;
template <> struct FragT<2> { struct A4 { bf16x8 v[4][2]; }; struct B2 { bf16x8 v[2][2]; }; };
template <> struct FragT<1> { struct A4 { v8i_t v[4]; }; struct B2 { v8i_t v[2]; }; };
__device__ __forceinline__ v8i_t cat8(bf16x8 a, bf16x8 b) { return __builtin_shufflevector(__builtin_bit_cast(v4i_t, a), __builtin_bit_cast(v4i_t, b), 0, 1, 2, 3, 4, 5, 6, 7); }

template <class Epi, class Sched, bool ALIGN_EPI, int ESZ = 2  >
__device__ __forceinline__ void gemm_phase(LAS unsigned char* lds, const int K, const int lda, const int ldb, const Sched& S, const Epi& E, unsigned long long* prof = nullptr) {
    unsigned long long pf_kl = 0, pf_ep = 0, pf_t0 = 0, pf_t1 = 0, pf_n = 0; const unsigned long long pf_w0 = prof ? wall_clock64() : 0ull, pf_c0 = prof ? clock64() : 0ull;
    int tid_ = threadIdx.x; asm volatile("" : "+v"(tid_));
    const int tid = tid_, wid = __builtin_amdgcn_readfirstlane(tid >> 6), lane = tid & 63, wr = wid >> 2, wc = wid & 3, fr = lane & 15, fq = lane >> 4;
    const int nt = (K * ESZ) / (BK * 2);
    constexpr bool GATHER = Sched::GATHER;
    unsigned voffA[2], voffB[2]; int Rr[2], Cb[2];
#pragma unroll
    for (int i = 0; i < 2; ++i) { int R, C; stage_rc(tid * 16 + i * 8192, R, C);
        int Rb = R;
        if constexpr ((int)Epi::PERM == 1) Rb = (R & ~31) + perm32(R & 31);
        if constexpr ((int)Epi::PERM == 2) Rb = 64 * (R >> 5) + 16 * ((R >> 2) & 3) + 4 * ((R >> 4) & 1) + (R & 3);
        voffA[i] = (unsigned)(R * lda * ESZ + C * 2); voffB[i] = (unsigned)(Rb * ldb * ESZ + C * 2); Rr[i] = R; Cb[i] = C * 2; }
    const size_t kstep = (size_t)(BK * 2);
    const size_t hstepA = (size_t)HALF * lda * ESZ, hstepB = (size_t)(((int)Epi::PERM == 2) ? 8 : HALF) * ldb * ESZ;
    const unsigned ldsw = (unsigned)wid * 1024u;
    const int aoff = lds_byte(wr * 64 + fr, fq * 8), boff = lds_byte(wc * 32 + fr, fq * 8);
#define PG8_SA(b, h) (((b) * 2 + (h)) * HTB)
#define PG8_SB(b, h) ((4 + (b) * 2 + (h)) * HTB)
#define PG8_STAGE(bufoff, gbase, voff) do { _Pragma("unroll") for (int _i = 0; _i < 2; ++_i) \
        __builtin_amdgcn_global_load_lds((const unsigned*)((const char*)(gbase) + (voff)[_i]), (LAS unsigned*)(lds + (bufoff) + ldsw + _i * 8192), 16, 0, 0); } while (0)
#define PG8_STAGE_A(bufoff, gbase, h, NX) do { if constexpr (GATHER) { _Pragma("unroll") for (int _i = 0; _i < 2; ++_i) { const unsigned _o = (NX) ? naoff[h][_i] : caoff[h][_i]; \
        __builtin_amdgcn_global_load_lds((const unsigned*)((const char*)(gbase) + _o), (LAS unsigned*)(lds + (bufoff) + ldsw + _i * 8192), 16, 0, 0); } } \
        else { PG8_STAGE(bufoff, (const char*)(gbase) + (h) * hstepA, voffA); } } while (0)
#define PG8_LDA(dst, b, h) do { _Pragma("unroll") for (int m = 0; m < 4; ++m) { if constexpr (ESZ == 2) { _Pragma("unroll") for (int k = 0; k < 2; ++k) dst.v[m][k] = *(const LAS bf16x8*)(lds + PG8_SA(b, h) + aoff + m * 2048 + k * 1024); } \
        else { const v4i_t _lo = *(const LAS v4i_t*)(lds + PG8_SA(b, h) + aoff + m * 2048), _hi = *(const LAS v4i_t*)(lds + PG8_SA(b, h) + aoff + m * 2048 + 1024); dst.v[m] = __builtin_shufflevector(_lo, _hi, 0, 1, 2, 3, 4, 5, 6, 7); } } } while (0)
#define PG8_LDB(dst, b, h) do { _Pragma("unroll") for (int n = 0; n < 2; ++n) { if constexpr (ESZ == 2) { _Pragma("unroll") for (int k = 0; k < 2; ++k) dst.v[n][k] = *(const LAS bf16x8*)(lds + PG8_SB(b, h) + boff + n * 2048 + k * 1024); } \
        else { const v4i_t _lo = *(const LAS v4i_t*)(lds + PG8_SB(b, h) + boff + n * 2048), _hi = *(const LAS v4i_t*)(lds + PG8_SB(b, h) + boff + n * 2048 + 1024); dst.v[n] = __builtin_shufflevector(_lo, _hi, 0, 1, 2, 3, 4, 5, 6, 7); } } } while (0)
#define PG8_MMA(ai, bj, At, Bt) do { __builtin_amdgcn_s_setprio(1); _Pragma("unroll") for (int m = 0; m < 4; ++m) _Pragma("unroll") for (int n = 0; n < 2; ++n) { \
        if constexpr (ESZ == 2) { _Pragma("unroll") for (int k = 0; k < 2; ++k) acc[ai][bj][m][n] = __builtin_amdgcn_mfma_f32_16x16x32_bf16(Bt.v[n][k], At.v[m][k], acc[ai][bj][m][n], 0, 0, 0); } \
        else { mfma_f8(acc[ai][bj][m][n], Bt.v[n], At.v[m]); } } \
        __builtin_amdgcn_s_setprio(0); } while (0)
#define PG8_WAIT_V(n) asm volatile("s_waitcnt vmcnt(" #n ")" ::: "memory")
#define PG8_WAIT_V8R do { if (relax) asm volatile("s_waitcnt vmcnt(%0)" :: "n"(8 + Epi::NSTORE) : "memory"); else PG8_WAIT_V(8); } while (0)
#define PG8_WAIT_L(n) asm volatile("s_waitcnt lgkmcnt(" #n ")" ::: "memory")
#define PG8_BAR __builtin_amdgcn_s_barrier()
#define PG8_SCHED __builtin_amdgcn_sched_barrier(0)
    Unit cur, nxt; int ui = 0;
    if (!S.next(0, cur)) return;
    f32x4 acc[2][2][4][2];
#pragma unroll
    for (int a = 0; a < 2; ++a)
#pragma unroll
        for (int b = 0; b < 2; ++b)
#pragma unroll
            for (int m = 0; m < 4; ++m)
#pragma unroll
                for (int n = 0; n < 2; ++n) acc[a][b][m][n] = (f32x4){0.f, 0.f, 0.f, 0.f};
    typedef typename FragT<ESZ>::A4 FragA; typedef typename FragT<ESZ>::B2 FragB;
    FragA At; FragB B0, B1;
    unsigned caoff[2][2] = {{0u, 0u}, {0u, 0u}}, naoff[2][2] = {{0u, 0u}, {0u, 0u}};
    if constexpr (GATHER) {
#pragma unroll
        for (int h = 0; h < 2; ++h)
#pragma unroll
            for (int i = 0; i < 2; ++i) { caoff[h][i] = S.arow(cur, h * HALF + Rr[i]) + (unsigned)Cb[i]; naoff[h][i] = caoff[h][i]; }
    }
    const char* cA = S.baseA(cur); const char* cB = S.baseB(cur);
    PG8_STAGE(PG8_SB(0, 0), cB, voffB); PG8_STAGE(PG8_SB(0, 1), cB + hstepB, voffB); PG8_STAGE_A(PG8_SA(0, 0), cA, 0, false); PG8_STAGE_A(PG8_SA(0, 1), cA, 1, false);
    if (wr == 1) PG8_BAR;
    PG8_WAIT_V(2); PG8_BAR;
    PG8_STAGE(PG8_SB(1, 0), cB + kstep, voffB); PG8_STAGE_A(PG8_SA(1, 0), cA + kstep, 0, false); PG8_STAGE(PG8_SB(1, 1), cB + hstepB + kstep, voffB);
    PG8_WAIT_V(6); PG8_BAR;
    for (;;) {
        const bool has_next = S.next(ui + 1, nxt);
        const char* nA = has_next ? S.baseA(nxt) : cA; const char* nB = has_next ? S.baseB(nxt) : cB;
        if constexpr (GATHER) {
            if (has_next) {
#pragma unroll
                for (int h = 0; h < 2; ++h)
#pragma unroll
                    for (int i = 0; i < 2; ++i) naoff[h][i] = S.arow(nxt, h * HALF + Rr[i]) + (unsigned)Cb[i];
            } else {
#pragma unroll
                for (int h = 0; h < 2; ++h)
#pragma unroll
                    for (int i = 0; i < 2; ++i) naoff[h][i] = caoff[h][i];
            }
        }
        if (prof) pf_t0 = clock64();
        int ntu = nt; if constexpr (SchedVarK<Sched>::v) ntu = S.ktiles(cur);
#pragma unroll 1
        for (int t = 0; t < ntu; t += 2) {
            const bool last = (t == ntu - 2);
            const bool relax = (Epi::NSTORE > 0) && (t == 0) && (ui > 0);
            const char* a1 = cA + (size_t)(t + 1) * kstep;
            const char* a2 = last ? nA : cA + (size_t)(t + 2) * kstep; const char* b2 = last ? nB : cB + (size_t)(t + 2) * kstep;
            const char* a3 = a2 + kstep; const char* b3 = b2 + kstep;
            PG8_LDB(B0, 0, 0); PG8_LDB(B1, 0, 1); PG8_SCHED; PG8_LDA(At, 0, 0); PG8_STAGE_A(PG8_SA(1, 1), a1, 1, false);
            PG8_WAIT_V(8); PG8_WAIT_L(0); PG8_BAR; PG8_MMA(0, 0, At, B0); PG8_MMA(0, 1, At, B1); PG8_BAR; PG8_SCHED;
            PG8_LDA(At, 0, 1); PG8_STAGE(PG8_SB(0, 0), b2, voffB); PG8_STAGE(PG8_SB(0, 1), b2 + hstepB, voffB); PG8_STAGE_A(PG8_SA(0, 0), a2, 0, last);
            PG8_WAIT_V(8); PG8_WAIT_L(0); PG8_BAR; PG8_MMA(1, 0, At, B0); PG8_MMA(1, 1, At, B1); PG8_BAR; PG8_SCHED;
            PG8_LDB(B0, 1, 0); PG8_LDB(B1, 1, 1); PG8_SCHED; PG8_LDA(At, 1, 0); PG8_STAGE_A(PG8_SA(0, 1), a2, 1, last);
            PG8_WAIT_V(8); PG8_WAIT_L(0); PG8_BAR; PG8_MMA(0, 0, At, B0); PG8_MMA(0, 1, At, B1); PG8_BAR; PG8_SCHED;
            PG8_LDA(At, 1, 1); PG8_STAGE(PG8_SB(1, 0), b3, voffB); PG8_STAGE(PG8_SB(1, 1), b3 + hstepB, voffB); PG8_STAGE_A(PG8_SA(1, 0), a3, 0, last);
            PG8_WAIT_V(8); PG8_WAIT_L(0); PG8_BAR; PG8_MMA(1, 0, At, B0); PG8_MMA(1, 1, At, B1); PG8_BAR; PG8_SCHED;
        }
        if (prof) { pf_t1 = clock64(); pf_kl += pf_t1 - pf_t0; }
        if constexpr (ESZ == 1) asm volatile("s_nop 15\n\ts_nop 15" ::: "memory");
        if constexpr (ALIGN_EPI) { if (wr == 0) PG8_BAR; }
        if constexpr (!Epi::AFTER_DRAIN) { int fr_e = fr, fq_e = fq; asm volatile("" : "+v"(fr_e), "+v"(fq_e));
            E(acc, cur, wr, wc, fr_e, fq_e); }
        if (prof) { pf_ep += clock64() - pf_t1; ++pf_n; }
        if (!has_next) break;
        bool zero = true; if constexpr (EpiKeep<Epi>::v) zero = !E.keep(cur);
        if (zero) {
#pragma unroll
        for (int a = 0; a < 2; ++a)
#pragma unroll
            for (int b = 0; b < 2; ++b)
#pragma unroll
                for (int m = 0; m < 4; ++m)
#pragma unroll
                    for (int n = 0; n < 2; ++n) acc[a][b][m][n] = (f32x4){0.f, 0.f, 0.f, 0.f};
        }
        cur = nxt; cA = nA; cB = nB; ++ui;
        if constexpr (GATHER) {
#pragma unroll
            for (int h = 0; h < 2; ++h)
#pragma unroll
                for (int i = 0; i < 2; ++i) caoff[h][i] = naoff[h][i];
        }
        if constexpr (ALIGN_EPI) { if (wr == 1) PG8_BAR; }
    }
    PG8_WAIT_V(0);
    if constexpr (!ALIGN_EPI) { if (wr == 0) PG8_BAR; }
    PG8_BAR;
    if (prof && blockIdx.x == PROFBLK && tid == 0) { prof[0] = pf_kl; prof[1] = pf_ep; prof[2] = pf_n; prof[3] = (unsigned long long)nt; prof[4] = clock64() - pf_c0; prof[5] = wall_clock64() - pf_w0; }
    if constexpr (Epi::AFTER_DRAIN) { int fr_e = fr, fq_e = fq; asm volatile("" : "+v"(fr_e), "+v"(fq_e)); E.fused(acc, cur, wr, wc, fr_e, fq_e, lds, wid, lane); }
#undef PG8_SA
#undef PG8_SB
#undef PG8_STAGE
#undef PG8_STAGE_A
#undef PG8_LDA
#undef PG8_LDB
#undef PG8_MMA
#undef PG8_WAIT_V
#undef PG8_WAIT_V8R
#undef PG8_WAIT_L
#undef PG8_BAR
#undef PG8_SCHED
}
constexpr int NXCD = 8;
#ifndef PROJ_WGM
#define PROJ_WGM 8
#endif
__device__ __forceinline__ void static_tile(int L, int nM, int nN, int& pm, int& pn, const int WGM = 8) {
    const int nwg = nM * nN; int wgid = L;
    { const int q = nwg / NXCD, r = nwg % NXCD, xcd = wgid % NXCD, off = wgid / NXCD; wgid = (xcd < r ? xcd * (q + 1) : r * (q + 1) + (xcd - r) * q) + off; }
    const int nig = WGM * nN, gid = wgid / nig, fm = gid * WGM, gsz = (nM - fm) < WGM ? (nM - fm) : WGM;
    pm = fm + ((wgid % nig) % gsz); pn = (wgid % nig) / gsz;
}
struct SchedPlain {
    static constexpr bool GATHER = false;
    const char* A; const char* Bt; size_t tstepA, tstepB; int nM, nN; int r0 = 0, r1 = 1 << 20;
    __device__ __forceinline__ bool next(int i, Unit& u) const { const int k = i + r0; if (k >= r1) return false;
        const int L = k * (int)gridDim.x + (int)blockIdx.x; if (L >= nM * nN) return false; static_tile(L, nM, nN, u.pm, u.pn); u.z = 0; return true; }
    __device__ __forceinline__ const char* baseA(const Unit& u) const { return A + (size_t)u.pm * tstepA; }
    __device__ __forceinline__ const char* baseB(const Unit& u) const { return Bt + (size_t)u.pn * tstepB; }
    __device__ __forceinline__ unsigned arow(const Unit&, int) const { return 0u; }
};
struct SchedProj {
    static constexpr bool GATHER = false;
    const unsigned char* ws; int r0, r1;
    __device__ __forceinline__ bool next(int i, Unit& u) const {
        if (i + r0 >= r1) return false;
        const int L = (i + r0) * (int)gridDim.x + (int)blockIdx.x;
        constexpr int NPB = GATES_F8 ? 18 : 42;
        if (L < 64 * NPB) { static_tile(L, 64, NPB, u.pm, u.pn, PROJ_WGM); u.z = (u.pn == 13) ? 2 : 0; return true; }
        const int L2 = L - 64 * NPB; if (L2 >= 64) return false;
        if (L2 < 32) { u.pm = L2 & 7; u.pn = L2 >> 3; u.z = 1; } else { u.pm = (L2 - 32) & 3; u.pn = (L2 - 32) >> 2; u.z = 3; }
        return true;
    }
    __device__ __forceinline__ const char* baseA(const Unit& u) const {
        const size_t ts = (size_t)256 * LDP * 2;
        if (u.z == 0) return (const char*)ws + WS_H + (size_t)u.pm * ts;
        if (u.z == 2) return (const char*)ws + WS_WINT + (size_t)13 * ts;
        if (u.z == 1) return (const char*)ws + WS_MEMBF + (size_t)u.pm * ts;
        return (const char*)ws + WS_WMKVT + (size_t)(4 + u.pm) * ts;
    }
    __device__ __forceinline__ const char* baseB(const Unit& u) const {
        const size_t ts = (size_t)256 * LDP * 2;
        if (u.z == 0) return (const char*)ws + WS_WINT + (size_t)u.pn * ts;
        if (u.z == 2) return (const char*)ws + WS_H + (size_t)u.pm * ts;
        if (u.z == 1) return (const char*)ws + WS_WMKVT + (size_t)u.pn * ts;
        return (const char*)ws + WS_MEMBF + (size_t)u.pn * ts;
    }
    __device__ __forceinline__ unsigned arow(const Unit&, int) const { return 0u; }
};
struct SchedGates8 {
    static constexpr bool GATHER = false;
    const unsigned char* ws; int r0, r1;
    __device__ __forceinline__ bool next(int i, Unit& u) const {
        if (i + r0 >= r1) return false;
        const int L = (i + r0) * (int)gridDim.x + (int)blockIdx.x; if (L >= 64 * 24) return false;
        static_tile(L, 64, 24, u.pm, u.pn, PROJ_WGM); u.z = 0; return true;
    }
    __device__ __forceinline__ const char* baseA(const Unit& u) const { return (const char*)ws + WS_H8 + (size_t)u.pm * (256 * 2048); }
    __device__ __forceinline__ const char* baseB(const Unit& u) const { return (const char*)ws + WS_WINQ + (size_t)u.pn * (256 * 2048); }
    __device__ __forceinline__ unsigned arow(const Unit&, int) const { return 0u; }
};
struct SchedChan {
    static constexpr bool GATHER = false;
    const unsigned char* ws; int u0, nu;
    __device__ __forceinline__ bool next(int i, Unit& u) const {
        const int L = i * (int)gridDim.x + vwg(); if (L >= 512) return false;
        u.z = L >> 4; u.pm = (L >> 3) & 1; u.pn = L & 7; return true;
    }
    __device__ __forceinline__ const char* baseA(const Unit& u) const { return (const char*)ws + WS_TABT + (size_t)u.pm * (256 * 256 * 2); }
    __device__ __forceinline__ const char* baseB(const Unit& u) const { const int b = u.z >> 2, g = u.z & 3; return (const char*)ws + WS_FIN + ((size_t)(b * 2048 + u.pn * 256) * 1024 + g * 256) * 2; }
    __device__ __forceinline__ unsigned arow(const Unit&, int) const { return 0u; }
};
struct SchedSeq {
    static constexpr bool GATHER = false;
    const unsigned char* ws;
    __device__ __forceinline__ bool next(int i, Unit& u) const {
        const int L = i * (int)gridDim.x + vwg(); if (L >= 256) return false;
        u.z = L >> 3; u.pm = L & 7; u.pn = 0; return true;
    }
    __device__ __forceinline__ const char* baseA(const Unit& u) const { return (const char*)ws + WS_DMAT + (size_t)u.pm * (256 * 4096 * 2); }
    __device__ __forceinline__ const char* baseB(const Unit& u) const { return (const char*)ws + WS_ZT + (size_t)u.z * (256 * 4096 * 2); }
    __device__ __forceinline__ unsigned arow(const Unit&, int) const { return 0u; }
};
struct SchedOne {
    static constexpr bool GATHER = false;
    const char* A; const char* Bt; int z; bool valid;
    __device__ __forceinline__ bool next(int i, Unit& u) const { if (i != 0 || !valid) return false; u.pm = 0; u.pn = 0; u.z = z; return true; }
    __device__ __forceinline__ const char* baseA(const Unit&) const { return A; }
    __device__ __forceinline__ const char* baseB(const Unit&) const { return Bt; }
    __device__ __forceinline__ unsigned arow(const Unit&, int) const { return 0u; }
};
template <bool GATH, int NT  , bool F8>
struct SchedMoe {
    static constexpr bool GATHER = GATH;
    static constexpr int ES = F8 ? 1 : 2;
    const unsigned char* ws; const LAS int* pt; const LAS int* cn; int same = 0;
    int r0 = 0, r1 = 1 << 20;
    __device__ __forceinline__ int ptu(int k) const { return __builtin_amdgcn_readfirstlane(pt[k]); }
    __device__ __forceinline__ bool next(int i, Unit& u) const {
        const int k = i + r0; if (k >= r1) return false;
        const int L = k * (int)gridDim.x + vwg(); const int total = ptu(NE) * NT; if (L >= total) return false;
        const int ln = (int)(threadIdx.x & 63);
        const unsigned long long bal = __ballot(ln < NE && L >= pt[ln & 31] * NT);
        const int e = __builtin_amdgcn_readfirstlane(__popcll(bal) - 1);
        const int t = L - ptu(e) * NT, mte = ptu(e + 1) - ptu(e);
        u.z = e; u.pm = t % mte; u.pn = t / mte; u.idx = k; return true;
    }
    __device__ __forceinline__ const char* baseA(const Unit& u) const {
        if constexpr (GATH) return (const char*)ws + (F8 ? WS_H2Q : WS_H2);
        else return (const char*)ws + (F8 ? WS_ACTQ : WS_ACT) + (same ? (size_t)0 : (size_t)(ptu(u.z) + u.pm) * (256 * 2048 * ES));
    }
    __device__ __forceinline__ const char* baseB(const Unit& u) const {
        if constexpr (GATH) return (const char*)ws + (F8 ? WS_WGUQ : WS_WGUT) + ((size_t)u.z * 4096 + (size_t)u.pn * 256) * (2048 * ES);
        else return (const char*)ws + (F8 ? WS_WDNQ : WS_WDNT) + (same ? (size_t)0 : ((size_t)u.z * 2048 + (size_t)u.pn * 256) * (2048 * ES));
    }
    __device__ __forceinline__ unsigned arow(const Unit& u, int r) const {
        const LAS unsigned short* tokl = (const LAS unsigned short*)((const LAS unsigned char*)pt - LDS_MISC + LDS_TOKL);
        return (unsigned)tokl[u.idx * 256 + r] * (unsigned)(2048 * ES);
    }
};

__device__ __forceinline__ void store_tile_bf16(const f32x4 (&acc)[2][2][4][2], bf16_t* dst  , size_t ldc, int wr, int wc, int fr, int fq) {
    const int row0 = wr * 64 + fr, col0 = wc * 32 + 8 * fq;
#pragma unroll
    for (int ai = 0; ai < 2; ++ai)
#pragma unroll
        for (int m = 0; m < 4; ++m) { bf16_t* rowp = dst + (size_t)(row0 + ai * HALF + m * 16) * ldc + col0;
#pragma unroll
            for (int bj = 0; bj < 2; ++bj) { const f32x4 v0 = acc[ai][bj][m][0], v1 = acc[ai][bj][m][1];
                u32x4 w; w.x = cvtpk(v0[0], v0[1]); w.y = cvtpk(v0[2], v0[3]); w.z = cvtpk(v1[0], v1[1]); w.w = cvtpk(v1[2], v1[3]);
                *(u32x4*)(rowp + bj * HALF) = w; } }
}
struct EpiProj {
    static constexpr bool PERM = true, AFTER_DRAIN = false; static constexpr int NSTORE = 16;
    unsigned char* ws;
    __device__ __forceinline__ void operator()(const f32x4 (&acc)[2][2][4][2], const Unit& u, int wr, int wc, int fr, int fq) const {
        const int pn = u.pn, pm = u.pm;
        bf16_t* dst; size_t ldc;
        if (u.z == 0) {
            if (pn >= 18) {
                dst = (bf16_t*)(ws + WS_GATES) + (size_t)pm * 256 * 6144 + (pn - 18) * 256;
                const int row0 = wr * 64 + fr, col0 = wc * 32 + 8 * fq;
#pragma unroll
                for (int ai = 0; ai < 2; ++ai)
#pragma unroll
                    for (int m = 0; m < 4; ++m) { bf16_t* rowp = dst + (size_t)(row0 + ai * HALF + m * 16) * 6144 + col0;
#pragma unroll
                        for (int bj = 0; bj < 2; ++bj) { const f32x4 v0 = acc[ai][bj][m][0], v1 = acc[ai][bj][m][1];
                            u32x4 w; w.x = cvtpk(sigmoidf_(v0[0]), sigmoidf_(v0[1])); w.y = cvtpk(sigmoidf_(v0[2]), sigmoidf_(v0[3]));
                            w.z = cvtpk(sigmoidf_(v1[0]), sigmoidf_(v1[1])); w.w = cvtpk(sigmoidf_(v1[2]), sigmoidf_(v1[3]));
                            *(u32x4*)(rowp + bj * HALF) = w; } }
                return;
            }
            if (pn < 4) { dst = (bf16_t*)(ws + WS_FIN) + pn * 256; ldc = 1024; }
            else if (pn < 12) { dst = (bf16_t*)(ws + WS_Q) + (pn - 4) * 256; ldc = 2048; }
            else if (pn == 12) { dst = (bf16_t*)(ws + WS_K); ldc = 256; }
            else { dst = (bf16_t*)(ws + WS_QM) + (pn - 14) * 256; ldc = 1024; }
            dst += (size_t)pm * 256 * ldc;
        } else if (u.z == 2) {
            dst = (bf16_t*)(ws + WS_VT) + (size_t)(pm >> 3) * 256 * 2048 + (size_t)(pm & 7) * 256; ldc = 2048;
        } else if (u.z == 1) {
            dst = (bf16_t*)(ws + WS_KMK) + (size_t)pm * 256 * 1024 + pn * 256; ldc = 1024;
        } else {
            dst = (bf16_t*)(ws + WS_VMT) + (size_t)(pn * 4 + pm) * 256 * 256; ldc = 256;
        }
        store_tile_bf16(acc, dst, ldc, wr, wc, fr, fq);
    }
};
__device__ __forceinline__ unsigned pk_u8x4(float a, float b, float c, float d) {
    const unsigned x = (unsigned)(a * 255.0f + 0.5f), y = (unsigned)(b * 255.0f + 0.5f), z = (unsigned)(c * 255.0f + 0.5f), w = (unsigned)(d * 255.0f + 0.5f);
    return x | (y << 8) | (z << 16) | (w << 24); }
struct EpiGates8 {
    static constexpr int PERM = 2; static constexpr bool AFTER_DRAIN = false; static constexpr int NSTORE = 8;
    unsigned char* ws;
    __device__ __forceinline__ void operator()(const f32x4 (&acc)[2][2][4][2], const Unit& u, int wr, int wc, int fr, int fq) const {
        unsigned char* dst = ws + WS_GATES + (size_t)u.pm * 256 * 6144 + u.pn * 256;
        const int row0 = wr * 64 + fr, col0 = wc * 64 + 16 * fq;
#pragma unroll
        for (int ai = 0; ai < 2; ++ai)
#pragma unroll
            for (int m = 0; m < 4; ++m) {
                u32x4 w;
                { const f32x4 a = acc[ai][0][m][0] * WQ_INV, c = acc[ai][0][m][1] * WQ_INV;
                  w.x = pk_u8x4(sigmoidf_(a[0]), sigmoidf_(a[1]), sigmoidf_(a[2]), sigmoidf_(a[3])); w.y = pk_u8x4(sigmoidf_(c[0]), sigmoidf_(c[1]), sigmoidf_(c[2]), sigmoidf_(c[3])); }
                { const f32x4 a = acc[ai][1][m][0] * WQ_INV, c = acc[ai][1][m][1] * WQ_INV;
                  w.z = pk_u8x4(sigmoidf_(a[0]), sigmoidf_(a[1]), sigmoidf_(a[2]), sigmoidf_(a[3])); w.w = pk_u8x4(sigmoidf_(c[0]), sigmoidf_(c[1]), sigmoidf_(c[2]), sigmoidf_(c[3])); }
                *(u32x4*)(dst + (size_t)(row0 + ai * HALF + m * 16) * 6144 + col0) = w; }
    }
};
struct EpiChan {
    static constexpr bool PERM = true, AFTER_DRAIN = false; static constexpr int NSTORE = 0;
    unsigned char* ws;
    __device__ __forceinline__ void operator()(const f32x4 (&acc)[2][2][4][2], const Unit& u, int wr, int wc, int fr, int fq) const {
        store_tile_bf16(acc, (bf16_t*)(ws + WS_ZT) + (size_t)u.z * 256 * 4096 + (size_t)u.pm * 2048 + u.pn * 256, 4096, wr, wc, fr, fq);
    }
};
struct EpiSeq {
    static constexpr bool PERM = true, AFTER_DRAIN = false; static constexpr int NSTORE = 0;
    unsigned char* ws;
    __device__ __forceinline__ void operator()(const f32x4 (&acc)[2][2][4][2], const Unit& u, int wr, int wc, int fr, int fq) const {
        const int b = u.z >> 2, g = u.z & 3;
        store_tile_bf16(acc, (bf16_t*)(ws + WS_FX) + (size_t)(b * 2048 + u.pm * 256) * 2048 + g * 256, 2048, wr, wc, fr, fq);
    }
};
template <int STEP> struct EpiMix {
    static constexpr int PERM = 1; static constexpr bool AFTER_DRAIN = false; static constexpr int NSTORE = 16;
    unsigned char* ws;
    __device__ __forceinline__ void operator()(const f32x4 (&acc)[2][2][4][2], const Unit& u, int wr, int wc, int fr, int fq) const {
        const int row0 = u.pm * 256 + wr * 64 + fr, col0 = u.pn * 256 + wc * 32 + 8 * fq;
        const bf16_t* gates = (const bf16_t*)(ws + WS_GATES) + STEP * 2048; const unsigned char* gates8 = ws + WS_GATES + STEP * 2048;
        bf16_t* macc = (bf16_t*)(ws + WS_MIXACC); bf16_t* mixed = (bf16_t*)(ws + WS_MIXED);
#pragma unroll
        for (int ai = 0; ai < 2; ++ai) {
            u32x2 g8[4][2]; u32x4 gw[4][2]; u32x4 mw[4][2];
#pragma unroll
            for (int m = 0; m < 4; ++m) { const size_t row = (size_t)(row0 + ai * HALF + m * 16);
#pragma unroll
                for (int bj = 0; bj < 2; ++bj) { const int col = col0 + bj * HALF;
                    if constexpr (GATES_F8) g8[m][bj] = *(const u32x2*)(gates8 + row * 6144 + col); else gw[m][bj] = *(const u32x4*)(gates + row * 6144 + col);
                    if (STEP > 0) mw[m][bj] = *(const u32x4*)(macc + row * 2048 + col); } }
#pragma unroll
            for (int m = 0; m < 4; ++m) { const size_t row = (size_t)(row0 + ai * HALF + m * 16);
#pragma unroll
                for (int bj = 0; bj < 2; ++bj) { const int col = col0 + bj * HALF;
                    f32x4 v0 = acc[ai][bj][m][0], v1 = acc[ai][bj][m][1];
                    if constexpr (GATES_F8) { const u32x2 g = g8[m][bj]; const float k = 1.0f / 255.0f;
                        v0[0] *= (float)(g.x & 255u) * k; v0[1] *= (float)((g.x >> 8) & 255u) * k; v0[2] *= (float)((g.x >> 16) & 255u) * k; v0[3] *= (float)(g.x >> 24) * k;
                        v1[0] *= (float)(g.y & 255u) * k; v1[1] *= (float)((g.y >> 8) & 255u) * k; v1[2] *= (float)((g.y >> 16) & 255u) * k; v1[3] *= (float)(g.y >> 24) * k; }
                    else { const u32x4 g = gw[m][bj];
                        v0[0] *= bflo(g.x); v0[1] *= bfhi(g.x); v0[2] *= bflo(g.y); v0[3] *= bfhi(g.y);
                        v1[0] *= bflo(g.z); v1[1] *= bfhi(g.z); v1[2] *= bflo(g.w); v1[3] *= bfhi(g.w); }
                    if (STEP > 0) { const u32x4 q = mw[m][bj];
                        v0[0] += bflo(q.x); v0[1] += bfhi(q.x); v0[2] += bflo(q.y); v0[3] += bfhi(q.y);
                        v1[0] += bflo(q.z); v1[1] += bfhi(q.z); v1[2] += bflo(q.w); v1[3] += bfhi(q.w); }
                    u32x4 w; w.x = cvtpk(v0[0], v0[1]); w.y = cvtpk(v0[2], v0[3]); w.z = cvtpk(v1[0], v1[1]); w.w = cvtpk(v1[2], v1[3]);
                    *(u32x4*)((STEP < 2 ? macc : mixed) + row * 2048 + col) = w; } }
        }
    }
};
struct SchedMix {
    static constexpr bool GATHER = false; static constexpr bool VARK = true;
    const unsigned char* ws; int r0, r1;
    __device__ __forceinline__ bool next(int i, Unit& u) const {
        const int tr = r0 + i / 3; if (tr >= r1) return false;
        const int L = tr * (int)gridDim.x + (int)blockIdx.x; if (L >= 64 * 8) return false;
        static_tile(L, 64, 8, u.pm, u.pn); u.z = i % 3; return true;
    }
    __device__ __forceinline__ int ktiles(const Unit& u) const { return u.z == 1 ? 32 : 16; }
    __device__ __forceinline__ const char* baseA(const Unit& u) const {
        const size_t ts = (size_t)256 * 2048 * 2;
        return (const char*)ws + (u.z == 1 ? WS_ATT : WS_FX + (u.z == 2 ? 2048 : 0)) + (size_t)u.pm * ts;
    }
    __device__ __forceinline__ const char* baseB(const Unit& u) const {
        const size_t ts = (size_t)256 * 2048 * 2;
        return (const char*)ws + (u.z == 1 ? WS_WAOT : WS_WFM + (u.z == 2 ? 2048 : 0)) + (size_t)u.pn * ts;
    }
    __device__ __forceinline__ unsigned arow(const Unit&, int) const { return 0u; }
};
struct EpiMixF {
    static constexpr int PERM = 1; static constexpr bool AFTER_DRAIN = false, KEEP = true; static constexpr int NSTORE = 16;
    unsigned char* ws;
    __device__ __forceinline__ bool keep(const Unit& u) const { return u.z < 2; }
    static __device__ __forceinline__ float gb(unsigned w, int k) { return (float)((w >> (8 * k)) & 255u); }
    __device__ __forceinline__ void operator()(f32x4 (&acc)[2][2][4][2], const Unit& u, int wr, int wc, int fr, int fq) const {
        const int row0 = u.pm * 256 + wr * 64 + fr, col0 = u.pn * 256 + wc * 32 + 8 * fq;
        const int seg = __builtin_amdgcn_readfirstlane(u.z);
        const unsigned char* gnum = ws + WS_GATES + seg * 2048;
        bf16_t* mixed = (bf16_t*)(ws + WS_MIXED);
        if (seg < 2) {
#pragma unroll
            for (int ai = 0; ai < 2; ++ai) {
                u32x2 gn[4][2], gd[4][2];
#pragma unroll
                for (int m = 0; m < 4; ++m) { const size_t row = (size_t)(row0 + ai * HALF + m * 16);
#pragma unroll
                    for (int bj = 0; bj < 2; ++bj) { const unsigned char* q = gnum + row * 6144 + col0 + bj * HALF; gn[m][bj] = *(const u32x2*)q; gd[m][bj] = *(const u32x2*)(q + 2048); } }
#pragma unroll
                for (int m = 0; m < 4; ++m)
#pragma unroll
                    for (int bj = 0; bj < 2; ++bj) {
#pragma unroll
                        for (int k = 0; k < 4; ++k) {
                            const float n0 = (seg == 0) ? gb(gn[m][bj].x, k) : fmaxf(gb(gn[m][bj].x, k), 0.5f), n1 = (seg == 0) ? gb(gn[m][bj].y, k) : fmaxf(gb(gn[m][bj].y, k), 0.5f);
                            acc[ai][bj][m][0][k] *= n0 * __builtin_amdgcn_rcpf(fmaxf(gb(gd[m][bj].x, k), 0.5f));
                            acc[ai][bj][m][1][k] *= n1 * __builtin_amdgcn_rcpf(fmaxf(gb(gd[m][bj].y, k), 0.5f)); } }
            }
        } else {
#pragma unroll
            for (int ai = 0; ai < 2; ++ai) {
                u32x2 gn[4][2];
#pragma unroll
                for (int m = 0; m < 4; ++m) { const size_t row = (size_t)(row0 + ai * HALF + m * 16);
#pragma unroll
                    for (int bj = 0; bj < 2; ++bj) gn[m][bj] = *(const u32x2*)(gnum + row * 6144 + col0 + bj * HALF); }
#pragma unroll
                for (int m = 0; m < 4; ++m) { const size_t row = (size_t)(row0 + ai * HALF + m * 16);
#pragma unroll
                    for (int bj = 0; bj < 2; ++bj) { const float kq = 1.0f / 255.0f; f32x4 v0 = acc[ai][bj][m][0], v1 = acc[ai][bj][m][1];
#pragma unroll
                        for (int k = 0; k < 4; ++k) { v0[k] *= fmaxf(gb(gn[m][bj].x, k), 0.5f) * kq; v1[k] *= fmaxf(gb(gn[m][bj].y, k), 0.5f) * kq; }
                        u32x4 w; w.x = cvtpk(v0[0], v0[1]); w.y = cvtpk(v0[2], v0[3]); w.z = cvtpk(v1[0], v1[1]); w.w = cvtpk(v1[2], v1[3]);
                        *(u32x4*)(mixed + row * 2048 + col0 + bj * HALF) = w; } }
            }
        }
    }
};
struct EpiRes {
    static constexpr int PERM = 1; static constexpr bool AFTER_DRAIN = false; static constexpr int NSTORE = 16;
    const float* x; bf16_t* x2;
    __device__ __forceinline__ void operator()(const f32x4 (&acc)[2][2][4][2], const Unit& u, int wr, int wc, int fr, int fq) const {
        const int row0 = u.pm * 256 + wr * 64 + fr, col0 = u.pn * 256 + wc * 32 + 8 * fq;
#pragma unroll
        for (int ai = 0; ai < 2; ++ai) {
            f32x4 xv[4][2][2];
#pragma unroll
            for (int m = 0; m < 4; ++m) { const size_t off = (size_t)(row0 + ai * HALF + m * 16) * 2048 + col0;
#pragma unroll
                for (int bj = 0; bj < 2; ++bj) { xv[m][bj][0] = *(const f32x4*)(x + off + bj * HALF); xv[m][bj][1] = *(const f32x4*)(x + off + bj * HALF + 4); } }
#pragma unroll
            for (int m = 0; m < 4; ++m) { const size_t off = (size_t)(row0 + ai * HALF + m * 16) * 2048 + col0;
#pragma unroll
                for (int bj = 0; bj < 2; ++bj) { const f32x4 v0 = acc[ai][bj][m][0] + xv[m][bj][0], v1 = acc[ai][bj][m][1] + xv[m][bj][1];
                    u32x4 w; w.x = cvtpk(v0[0], v0[1]); w.y = cvtpk(v0[2], v0[3]); w.z = cvtpk(v1[0], v1[1]); w.w = cvtpk(v1[2], v1[3]);
                    *(u32x4*)(x2 + off + bj * HALF) = w; } }
        }
    }
};
__device__ __forceinline__ float swiglu1(float g, float up) {
    g = fminf(g, 7.0f); up = fminf(fmaxf(up, -7.0f), 7.0f);
    return (up + 1.0f) * (g * sigmoid_sc(g, -1.702f * LOG2E));
}
struct EpiSwiglu {
    static constexpr bool PERM = true, AFTER_DRAIN = false; static constexpr int NSTORE = 8;
    unsigned char* ws; const float* bgu; const LAS int* pt;
    __device__ __forceinline__ void operator()(const f32x4 (&acc)[2][2][4][2], const Unit& u, int wr, int wc, int fr, int fq) const {
        const int e = u.z; const size_t srow0 = (size_t)(__builtin_amdgcn_readfirstlane(pt[e]) + u.pm) * 256 + wr * 64 + fr;
        const int col0 = u.pn * 256 + wc * 32 + 8 * fq;
        bf16_t* act = (bf16_t*)(ws + WS_ACT);
        f32x4 bv[2][2];
#pragma unroll
        for (int bj = 0; bj < 2; ++bj)
#pragma unroll
            for (int n = 0; n < 2; ++n) bv[bj][n] = *(const f32x4*)(bgu + (size_t)e * 4096 + col0 + bj * HALF + 4 * n);
#pragma unroll
        for (int ai = 0; ai < 2; ++ai)
#pragma unroll
            for (int m = 0; m < 4; ++m) { bf16_t* rowp = act + (srow0 + ai * HALF + m * 16) * 2048 + (col0 >> 1);
#pragma unroll
                for (int bj = 0; bj < 2; ++bj) { const f32x4 v0 = acc[ai][bj][m][0] + bv[bj][0], v1 = acc[ai][bj][m][1] + bv[bj][1];
                    u32x2 w; w.x = cvtpk(swiglu1(v0[0], v0[1]), swiglu1(v0[2], v0[3])); w.y = cvtpk(swiglu1(v1[0], v1[1]), swiglu1(v1[2], v1[3]));
                    *(u32x2*)(rowp + bj * (HALF / 2)) = w; } }
    }
};
struct EpiDown {
    static constexpr bool PERM = true, AFTER_DRAIN = false; static constexpr int NSTORE = 8;
    unsigned char* ws; const float* bdn; const LAS int* pt; const LAS int* cn;
    __device__ __forceinline__ void operator()(const f32x4 (&acc)[2][2][4][2], const Unit& u, int wr, int wc, int fr, int fq) const {
        const int e = u.z; const int lrow0 = u.pm * 256 + wr * 64 + fr; const size_t srow0 = (size_t)__builtin_amdgcn_readfirstlane(pt[e]) * 256 + lrow0;
        const int col0 = u.pn * 256 + wc * 32 + 8 * fq;
        bf16_t* ys = (bf16_t*)(ws + WS_YS); const float* wl = (const float*)(ws + WS_WLIST) + (size_t)e * T_; const int cne = __builtin_amdgcn_readfirstlane(cn[e]);
        f32x4 bv[2][2];
#pragma unroll
        for (int bj = 0; bj < 2; ++bj)
#pragma unroll
            for (int n = 0; n < 2; ++n) bv[bj][n] = *(const f32x4*)(bdn + (size_t)e * 2048 + col0 + bj * HALF + 4 * n);
#pragma unroll
        for (int ai = 0; ai < 2; ++ai)
#pragma unroll
            for (int m = 0; m < 4; ++m) { const int pos = lrow0 + ai * HALF + m * 16; const float w = (pos < cne) ? wl[pos] : 0.f;
                bf16_t* rowp = ys + (srow0 + ai * HALF + m * 16) * 2048 + col0;
#pragma unroll
                for (int bj = 0; bj < 2; ++bj) { const f32x4 v0 = (acc[ai][bj][m][0] + bv[bj][0]) * w, v1 = (acc[ai][bj][m][1] + bv[bj][1]) * w;
                    u32x4 o; o.x = cvtpk(v0[0], v0[1]); o.y = cvtpk(v0[2], v0[3]); o.z = cvtpk(v1[0], v1[1]); o.w = cvtpk(v1[2], v1[3]);
                    *(u32x4*)(rowp + bj * HALF) = o; } }
    }
};
__device__ __forceinline__ unsigned pk_fp8x4(float a, float b, float c, float d) {
    int w = __builtin_amdgcn_cvt_pk_fp8_f32(a, b, 0, false); w = __builtin_amdgcn_cvt_pk_fp8_f32(c, d, w, true); return (unsigned)w; }
struct EpiSwiglu8 {
    static constexpr int PERM = 2; static constexpr bool AFTER_DRAIN = false; static constexpr int NSTORE = 8;
    unsigned char* ws; const float* bgu; const LAS int* pt;
    __device__ __forceinline__ void operator()(const f32x4 (&acc)[2][2][4][2], const Unit& u, int wr, int wc, int fr, int fq) const {
        const int e = u.z; const size_t srow0 = (size_t)(__builtin_amdgcn_readfirstlane(pt[e]) + u.pm) * 256 + wr * 64 + fr;
        const int col0 = u.pn * 256 + wc * 64 + 16 * fq;
        unsigned char* act = ws + WS_ACTQ;
        const LAS float* btab = (const LAS float*)((const LAS unsigned char*)pt - LDS_MISC + LDS_BTAB) + u.idx * 256 + wc * 64 + 16 * fq;
        f32x4 bv[2][2];
#pragma unroll
        for (int bj = 0; bj < 2; ++bj)
#pragma unroll
            for (int n = 0; n < 2; ++n) bv[bj][n] = *(const LAS f32x4*)(btab + 8 * bj + 4 * n);
#pragma unroll
        for (int ai = 0; ai < 2; ++ai)
#pragma unroll
            for (int m = 0; m < 4; ++m) {
                float o[8];
#pragma unroll
                for (int bj = 0; bj < 2; ++bj)
#pragma unroll
                    for (int n = 0; n < 2; ++n) { const f32x4 v = acc[ai][bj][m][n] * WQ_INV + bv[bj][n]; o[4 * bj + 2 * n] = swiglu1(v[0], v[1]); o[4 * bj + 2 * n + 1] = swiglu1(v[2], v[3]); }
                u32x2 w; w.x = pk_fp8x4(o[0], o[1], o[2], o[3]); w.y = pk_fp8x4(o[4], o[5], o[6], o[7]);
                *(u32x2*)(act + (srow0 + ai * HALF + m * 16) * 2048 + (col0 >> 1)) = w; }
    }
};
struct EpiDown8 {
    static constexpr int PERM = 2; static constexpr bool AFTER_DRAIN = false; static constexpr int NSTORE = 8;
    unsigned char* ws; const float* bdn; const LAS int* pt; const LAS int* cn; size_t ysbase = WS_YS;
    __device__ __forceinline__ void operator()(const f32x4 (&acc)[2][2][4][2], const Unit& u, int wr, int wc, int fr, int fq) const {
        const int e = u.z; const int lrow0 = u.pm * 256 + wr * 64 + fr; const size_t srow0 = (size_t)__builtin_amdgcn_readfirstlane(pt[e]) * 256 + lrow0;
        const int col0 = u.pn * 256 + wc * 64 + 16 * fq;
        unsigned char* ys = ws + ysbase;
        const LAS float* btab = (const LAS float*)((const LAS unsigned char*)pt - LDS_MISC + LDS_BTAB) + u.idx * 256 + wc * 64 + 16 * fq;
        const LAS float* wtab = (const LAS float*)((const LAS unsigned char*)pt - LDS_MISC + LDS_TOKL) + u.idx * 256 + wr * 64 + fr;
        f32x4 bv[2][2];
#pragma unroll
        for (int bj = 0; bj < 2; ++bj)
#pragma unroll
            for (int n = 0; n < 2; ++n) bv[bj][n] = *(const LAS f32x4*)(btab + 8 * bj + 4 * n);
#pragma unroll
        for (int ai = 0; ai < 2; ++ai)
#pragma unroll
            for (int m = 0; m < 4; ++m) { const float w = wtab[ai * HALF + m * 16];
                u32x4 o;
                { const f32x4 a = (acc[ai][0][m][0] * WQ_INV + bv[0][0]) * w, c = (acc[ai][0][m][1] * WQ_INV + bv[0][1]) * w; o.x = pk_fp8x4(a[0], a[1], a[2], a[3]); o.y = pk_fp8x4(c[0], c[1], c[2], c[3]); }
                { const f32x4 a = (acc[ai][1][m][0] * WQ_INV + bv[1][0]) * w, c = (acc[ai][1][m][1] * WQ_INV + bv[1][1]) * w; o.z = pk_fp8x4(a[0], a[1], a[2], a[3]); o.w = pk_fp8x4(c[0], c[1], c[2], c[3]); }
                *(u32x4*)(ys + (srow0 + ai * HALF + m * 16) * 2048 + col0) = o; }
    }
};
struct EpiMemSoftmax {
    static constexpr bool PERM = true, AFTER_DRAIN = true; static constexpr int NSTORE = 0;
    bf16_t* P;
    __device__ __forceinline__ void operator()(const f32x4 (&)[2][2][4][2], const Unit&, int, int, int, int) const {}
    __device__ __forceinline__ void fused(f32x4 (&acc)[2][2][4][2], const Unit&, int wr, int wc, int fr, int fq, LAS unsigned char* lds, int, int) const {
        LAS f32x2* tab = (LAS f32x2*)lds;
        const float sc = 0.0625f * LOG2E;
        float mx[2][4];
#pragma unroll
        for (int ai = 0; ai < 2; ++ai)
#pragma unroll
            for (int m = 0; m < 4; ++m) { float a = -3.0e38f;
#pragma unroll
                for (int bj = 0; bj < 2; ++bj)
#pragma unroll
                    for (int n = 0; n < 2; ++n) { acc[ai][bj][m][n] *= sc; const f32x4 v = acc[ai][bj][m][n]; a = fmaxf(a, fmaxf(fmaxf(v[0], v[1]), fmaxf(v[2], v[3]))); }
                a = fmaxf(a, __shfl_xor(a, 16)); a = fmaxf(a, __shfl_xor(a, 32)); mx[ai][m] = a;
                float s = 0.f;
#pragma unroll
                for (int bj = 0; bj < 2; ++bj)
#pragma unroll
                    for (int n = 0; n < 2; ++n) { const f32x4 v = acc[ai][bj][m][n]; s += __builtin_amdgcn_exp2f(v[0] - a) + __builtin_amdgcn_exp2f(v[1] - a) + __builtin_amdgcn_exp2f(v[2] - a) + __builtin_amdgcn_exp2f(v[3] - a); }
                s += __shfl_xor(s, 16); s += __shfl_xor(s, 32);
                if (fq == 0) tab[(ai * HALF + wr * 64 + m * 16 + fr) * 4 + wc] = (f32x2){a, s};
            }
        __syncthreads();
#pragma unroll
        for (int ai = 0; ai < 2; ++ai)
#pragma unroll
            for (int m = 0; m < 4; ++m) { const int r = ai * HALF + wr * 64 + m * 16 + fr;
                const f32x2 t0 = tab[r * 4 + 0], t1 = tab[r * 4 + 1], t2 = tab[r * 4 + 2], t3 = tab[r * 4 + 3];
                const float M = fmaxf(fmaxf(t0.x, t1.x), fmaxf(t2.x, t3.x));
                const float L = t0.y * __builtin_amdgcn_exp2f(t0.x - M) + t1.y * __builtin_amdgcn_exp2f(t1.x - M) + t2.y * __builtin_amdgcn_exp2f(t2.x - M) + t3.y * __builtin_amdgcn_exp2f(t3.x - M);
                const float inv = 1.0f / L;
                bf16_t* rowp = P + (size_t)r * 1024 + wc * 32 + 8 * fq;
#pragma unroll
                for (int bj = 0; bj < 2; ++bj) { f32x4 v0 = acc[ai][bj][m][0], v1 = acc[ai][bj][m][1];
#pragma unroll
                    for (int j = 0; j < 4; ++j) { v0[j] = __builtin_amdgcn_exp2f(v0[j] - M) * inv; v1[j] = __builtin_amdgcn_exp2f(v1[j] - M) * inv; }
                    u32x4 w; w.x = cvtpk(v0[0], v0[1]); w.y = cvtpk(v0[2], v0[3]); w.z = cvtpk(v1[0], v1[1]); w.w = cvtpk(v1[2], v1[3]);
                    *(u32x4*)(rowp + bj * HALF) = w; } }
        __syncthreads();
    }
};
struct EpiTile {
    static constexpr bool PERM = true, AFTER_DRAIN = false; static constexpr int NSTORE = 0;
    bf16_t* dst; size_t ldc;
    __device__ __forceinline__ void operator()(const f32x4 (&acc)[2][2][4][2], const Unit&, int wr, int wc, int fr, int fq) const { store_tile_bf16(acc, dst, ldc, wr, wc, fr, fq); }
};
__device__ __forceinline__ void tr_item(const float* W, int K, int N, bf16_t* WT, LAS float* scr, int item, int lane) {
    const int nblk = N / 32, kb = item / nblk, nb = item % nblk, k0 = 64 * kb, n0 = 32 * nb;
#pragma unroll 8
    for (int i = 0; i < 32; ++i) { const int kk = 2 * i + (lane >> 5); scr[kk * 33 + (lane & 31)] = W[(size_t)(k0 + kk) * N + n0 + (lane & 31)]; }
    asm volatile("s_waitcnt lgkmcnt(0)" ::: "memory");
    const int c = lane & 7;
#pragma unroll
    for (int j = 0; j < 4; ++j) { const int n = (lane >> 3) + 8 * j; const LAS float* s = scr + (8 * c) * 33 + n;
        u32x4 o; o.x = cvtpk(s[0 * 33], s[1 * 33]); o.y = cvtpk(s[2 * 33], s[3 * 33]); o.z = cvtpk(s[4 * 33], s[5 * 33]); o.w = cvtpk(s[6 * 33], s[7 * 33]);
        *(u32x4*)(WT + (size_t)(n0 + n) * K + k0 + 8 * c) = o; }
    asm volatile("s_waitcnt lgkmcnt(0)" ::: "memory");
}
__device__ __forceinline__ void tr_item8(const float* W, int K, int N, unsigned char* WT, LAS float* scr, int item, int lane, float scale) {
    const int nblk = N / 32, kb = item / nblk, nb = item % nblk, k0 = 128 * kb, n0 = 32 * nb;
#pragma unroll 8
    for (int i = 0; i < 64; ++i) { const int kk = 2 * i + (lane >> 5); scr[kk * 33 + (lane & 31)] = W[(size_t)(k0 + kk) * N + n0 + (lane & 31)] * scale; }
    asm volatile("s_waitcnt lgkmcnt(0)" ::: "memory");
    const int c = lane & 7;
#pragma unroll
    for (int j = 0; j < 4; ++j) { const int n = (lane >> 3) + 8 * j; const LAS float* s = scr + (16 * c) * 33 + n;
        u32x4 o; o.x = pk_fp8x4(s[0 * 33], s[1 * 33], s[2 * 33], s[3 * 33]); o.y = pk_fp8x4(s[4 * 33], s[5 * 33], s[6 * 33], s[7 * 33]);
        o.z = pk_fp8x4(s[8 * 33], s[9 * 33], s[10 * 33], s[11 * 33]); o.w = pk_fp8x4(s[12 * 33], s[13 * 33], s[14 * 33], s[15 * 33]);
        *(u32x4*)(WT + (size_t)(n0 + n) * K + k0 + 16 * c) = o; }
    asm volatile("s_waitcnt lgkmcnt(0)" ::: "memory");
}
__device__ __forceinline__ void rms_row_to_bf16(const float* xrow, const float* g, bf16_t* orow, int lane, unsigned char* qrow = nullptr) {
    const f32x4* xr = (const f32x4*)xrow + lane; const f32x4* gr = (const f32x4*)g + lane;
    f32x4 v[8]; float s = 0.f;
#pragma unroll
    for (int j = 0; j < 8; ++j) { v[j] = xr[64 * j]; s += (v[j][0] * v[j][0] + v[j][1] * v[j][1]) + (v[j][2] * v[j][2] + v[j][3] * v[j][3]); }
    const float r = rsqrtf(wsum(s) * (1.0f / DM) + 1e-5f);
    u32x2* o8 = (u32x2*)orow + lane;
#pragma unroll
    for (int j = 0; j < 8; ++j) { const f32x4 gg = gr[64 * j]; u32x2 w; w.x = cvtpk(v[j][0] * r * gg[0], v[j][1] * r * gg[1]); w.y = cvtpk(v[j][2] * r * gg[2], v[j][3] * r * gg[3]); o8[64 * j] = w;
        if (qrow) ((unsigned*)qrow)[lane + 64 * j] = pk_fp8x4(v[j][0] * r * gg[0], v[j][1] * r * gg[1], v[j][2] * r * gg[2], v[j][3] * r * gg[3]); }
}
__device__ __forceinline__ void rms_bfrow_to_bf16(const bf16_t* xrow, const float* g, bf16_t* orow, int lane, unsigned char* qrow) {
    const u32x2* xr = (const u32x2*)xrow + lane; const f32x4* gr = (const f32x4*)g + lane;
    f32x4 v[8]; float s = 0.f;
#pragma unroll
    for (int j = 0; j < 8; ++j) { const u32x2 w = xr[64 * j]; v[j] = (f32x4){bflo(w.x), bfhi(w.x), bflo(w.y), bfhi(w.y)}; s += (v[j][0] * v[j][0] + v[j][1] * v[j][1]) + (v[j][2] * v[j][2] + v[j][3] * v[j][3]); }
    const float r = rsqrtf(wsum(s) * (1.0f / DM) + 1e-5f);
    u32x2* o8 = (u32x2*)orow + lane;
#pragma unroll
    for (int j = 0; j < 8; ++j) { const f32x4 gg = gr[64 * j]; u32x2 w; w.x = cvtpk(v[j][0] * r * gg[0], v[j][1] * r * gg[1]); w.y = cvtpk(v[j][2] * r * gg[2], v[j][3] * r * gg[3]); o8[64 * j] = w;
        if (qrow) ((unsigned*)qrow)[lane + 64 * j] = pk_fp8x4(v[j][0] * r * gg[0], v[j][1] * r * gg[1], v[j][2] * r * gg[2], v[j][3] * r * gg[3]); }
}
constexpr int CV_I_IN = (DM / 128) * (INW / 256), CV_I_SQ = (2048 / 128) * (2048 / 256), CV_I_HF = (1024 / 128) * (2048 / 256);
constexpr int CV_I_GU = (2048 / 128) * (4096 / 256), CV_I_DN = CV_I_SQ;
constexpr long CV_NONEXP = (long)CV_I_IN + 3L * CV_I_SQ + 2L * CV_I_HF;
constexpr long CV_TOTAL = CV_NONEXP + (long)NE * CV_I_GU + (long)NE * CV_I_DN;
typedef short v2s_t __attribute__((ext_vector_type(2)));
__device__ __forceinline__ unsigned pk_fp8x4_scaled(float a, float b, float c, float d) {
    v2s_t r = {0, 0};
    r = __builtin_amdgcn_cvt_scalef32_pk_fp8_f32(r, a, b, WQ_INV, false);
    r = __builtin_amdgcn_cvt_scalef32_pk_fp8_f32(r, c, d, WQ_INV, true);
    return __builtin_bit_cast(unsigned, r);
}
constexpr int CV_PITCH = 260;
#ifndef CV_ASMLD
#define CV_ASMLD 0
#endif
__device__ __forceinline__ f32x4 cv_load(const float* q) {
#if CV_ASMLD
    f32x4 v; asm volatile("global_load_dwordx4 %0, %1, off sc0 sc1 nt" : "=v"(v) : "v"(q) : "memory"); return v;
#else
    return __builtin_nontemporal_load((const f32x4*)q);
#endif
}
__device__ __forceinline__ void convert_items(const Params& p, LAS unsigned char* lds, long it0, long it_end, int worker, int nworkers, int probe = 0) {
    int tid_ = threadIdx.x; asm volatile("" : "+v"(tid_));
    const int tid = tid_, wave = __builtin_amdgcn_readfirstlane(tid >> 6), lane = tid & 63;
    unsigned char* ws = p.ws;
    LAS float* tile = (LAS float*)lds;
    constexpr int I_IN = CV_I_IN, I_SQ = CV_I_SQ, I_HF = CV_I_HF, I_GU = CV_I_GU, I_DN = CV_I_DN;
    static_assert(I_GU == 256 && I_DN == 128, "shift decode of the expert items");
    struct Item { const float* src; unsigned char* dst; int N, K, f8; };
    auto decode = [&](long it, Item& q) -> bool {
        if (it >= it_end) return false;
        long r = it; const float* W; unsigned char* D; int K, N, f8 = 0, kb, nb;
        if (r >= CV_NONEXP) {
            r -= CV_NONEXP; K = 2048; f8 = MOE_F8 ? 1 : 0;
            if (r < (long)NE * I_GU) { const int e = (int)(r >> 8), rr = (int)r & 255; kb = rr >> 4; nb = rr & 15; N = 4096;
                W = p.in[14] + (size_t)e * 2048 * 4096; D = ws + (MOE_F8 ? WS_WGUQ + (size_t)e * 4096 * 2048 : WS_WGUT + (size_t)e * 4096 * 2048 * 2); }
            else { r -= (long)NE * I_GU; const int e = (int)(r >> 7), rr = (int)r & 127; kb = rr >> 3; nb = rr & 7; N = 2048;
                W = p.in[16] + (size_t)e * 2048 * 2048; D = ws + (MOE_F8 ? WS_WDNQ + (size_t)e * 2048 * 2048 : WS_WDNT + (size_t)e * 2048 * 2048 * 2); }
        } else {
            if (r < I_IN) { W = p.in[4]; D = ws + WS_WINT; K = LDP; N = INW;
                if (GATES_F8 && 256 * ((int)r % (INW / 256)) >= 4608) { f8 = 2; D = ws + WS_WINQ; K = 2048; } }
            else if ((r -= I_IN) < I_SQ) { W = p.in[6]; D = ws + WS_WMKVT; K = LDP; N = 2048; }
            else if ((r -= I_SQ) < I_HF) { W = p.in[7]; D = ws + WS_WFM; K = 2048; N = 2048; }
            else if ((r -= I_HF) < I_SQ) { W = p.in[8]; D = ws + WS_WAOT; K = 2048; N = 2048; }
            else if ((r -= I_SQ) < I_HF) { W = p.in[9]; D = ws + WS_WFM + 1024 * 2; K = 2048; N = 2048; }
            else { r -= I_HF; W = p.in[10]; D = ws + WS_WOT; K = 2048; N = 2048; }
            const int nblk = N / 256; kb = (int)r / nblk; nb = (int)r % nblk;
        }
        q.src = W + (size_t)(128 * kb + wave) * N + 256 * nb + 4 * lane;
        q.dst = D + ((size_t)(256 * nb - (f8 == 2 ? 4608 : 0)) * K + 128 * kb) * (f8 ? 1 : 2);
        q.N = N; q.K = K; q.f8 = f8;
        if (probe) { q.src = p.in[14] + (size_t)wave * 4096 + 4 * lane; q.dst = ws + ((WS_FAST_END + 4095) & ~(size_t)4095) + (size_t)blockIdx.x * (256 * 2048); q.N = 4096; q.K = 2048; q.f8 = 1; }
        return true;
    };
    f32x4 v[16];
    Item cur; long it = it0 + worker; bool have = decode(it, cur);
    if (have) {
#pragma unroll
        for (int i = 0; i < 16; ++i) v[i] = cv_load(cur.src + (size_t)(8 * i) * cur.N);
    }
    int pst = 0;
    const int cch = lane & 7, nq = (lane >> 3) + 8 * wave;
    while (have) {
        Item nxt; const bool hn = decode(it + nworkers, nxt);
        __syncthreads();
#if CV_ASMLD
        if (pst == 4) asm volatile("s_waitcnt vmcnt(4)" ::: "memory"); else if (pst == 8) asm volatile("s_waitcnt vmcnt(8)" ::: "memory"); else asm volatile("s_waitcnt vmcnt(0)" ::: "memory");
#pragma unroll
        for (int i = 0; i < 16; ++i) asm volatile("" : "+v"(v[i]));
#endif
#pragma unroll
        for (int i = 0; i < 16; ++i) *(LAS f32x4*)(tile + (8 * i + wave) * CV_PITCH + 4 * lane + 16 * (i >> 1)) = v[i];
        if (hn) {
#pragma unroll
            for (int i = 0; i < 16; ++i) v[i] = cv_load(nxt.src + (size_t)(8 * i) * nxt.N);
        }
        __syncthreads();
        f32x4 t[16];
        const LAS float* s = tile + (16 * cch) * CV_PITCH + 16 * cch + 4 * nq;
#pragma unroll
        for (int i = 0; i < 16; ++i) t[i] = *(const LAS f32x4*)(s + i * CV_PITCH);
#pragma unroll
        for (int j = 0; j < 4; ++j) { const int n = 4 * nq + j;
            if (cur.f8) { u32x4 o; o.x = pk_fp8x4_scaled(t[0][j], t[1][j], t[2][j], t[3][j]); o.y = pk_fp8x4_scaled(t[4][j], t[5][j], t[6][j], t[7][j]);
                o.z = pk_fp8x4_scaled(t[8][j], t[9][j], t[10][j], t[11][j]); o.w = pk_fp8x4_scaled(t[12][j], t[13][j], t[14][j], t[15][j]);
                *(u32x4*)(cur.dst + (size_t)n * cur.K + 16 * cch) = o; }
            else { u32x4 o0, o1; o0.x = cvtpk(t[0][j], t[1][j]); o0.y = cvtpk(t[2][j], t[3][j]); o0.z = cvtpk(t[4][j], t[5][j]); o0.w = cvtpk(t[6][j], t[7][j]);
                o1.x = cvtpk(t[8][j], t[9][j]); o1.y = cvtpk(t[10][j], t[11][j]); o1.z = cvtpk(t[12][j], t[13][j]); o1.w = cvtpk(t[14][j], t[15][j]);
                u32x4* d = (u32x4*)(cur.dst + ((size_t)n * cur.K + 16 * cch) * 2); d[0] = o0; d[1] = o1; } }
        pst = cur.f8 ? 4 : 8;
        cur = nxt; have = hn; it += nworkers;
    }
    __syncthreads();
}

constexpr long CE_TOTAL = (long)NE * 384;
constexpr int CE_PITCH = 1028;
__device__ __forceinline__ void convert_experts(const Params& p, LAS unsigned char* lds, long t0, long t1) {
    int tid_ = threadIdx.x; asm volatile("" : "+v"(tid_));
    const int tid = tid_, wave = tid >> 6, lane = tid & 63;
    LAS float* tile = (LAS float*)lds;
    struct Item { const float* src; unsigned char* dst; int N; };
    auto decode = [&](long t, Item& q) -> bool {
        if (t >= t1) return false;
        const int e = (int)(t / 384), r = (int)(t % 384);
        if (r < 256) { const int nr = r >> 6, kb = r & 63; q.N = 4096;
            q.src = p.in[14] + (size_t)e * 2048 * 4096 + (size_t)(32 * kb + 4 * wave) * 4096 + nr * 1024 + 4 * lane;
            q.dst = p.ws + WS_WGUQ + ((size_t)e * 4096 + (size_t)nr * 1024) * 2048 + 32 * kb; }
        else { const int nr = (r - 256) >> 6, kb = (r - 256) & 63; q.N = 2048;
            q.src = p.in[16] + (size_t)e * 2048 * 2048 + (size_t)(32 * kb + 4 * wave) * 2048 + nr * 1024 + 4 * lane;
            q.dst = p.ws + WS_WDNQ + ((size_t)e * 2048 + (size_t)nr * 1024) * 2048 + 32 * kb; }
        return true;
    };
    f32x4 v[16];
    Item cur; long t = t0; bool have = decode(t, cur);
    if (have) {
#pragma unroll
        for (int i = 0; i < 16; ++i) v[i] = __builtin_nontemporal_load((const f32x4*)(cur.src + (size_t)(i >> 2) * cur.N + 256 * (i & 3)));
    }
    while (have) {
        Item nxt; const bool hn = decode(t + 1, nxt);
        __syncthreads();
#pragma unroll
        for (int i = 0; i < 16; ++i) *(LAS f32x4*)(tile + (4 * wave + (i >> 2)) * CE_PITCH + 256 * (i & 3) + 4 * lane) = v[i];
        if (hn) {
#pragma unroll
            for (int i = 0; i < 16; ++i) v[i] = __builtin_nontemporal_load((const f32x4*)(nxt.src + (size_t)(i >> 2) * nxt.N + 256 * (i & 3)));
        }
        __syncthreads();
#pragma unroll
        for (int j = 0; j < 2; ++j) { const int n = tid + 512 * j; const LAS float* s = tile + n;
            float f[32];
#pragma unroll
            for (int i = 0; i < 32; ++i) f[i] = s[i * CE_PITCH] * WQ_SCALE;
            u32x4 o0, o1;
            o0.x = pk_fp8x4(f[0], f[1], f[2], f[3]); o0.y = pk_fp8x4(f[4], f[5], f[6], f[7]); o0.z = pk_fp8x4(f[8], f[9], f[10], f[11]); o0.w = pk_fp8x4(f[12], f[13], f[14], f[15]);
            o1.x = pk_fp8x4(f[16], f[17], f[18], f[19]); o1.y = pk_fp8x4(f[20], f[21], f[22], f[23]); o1.z = pk_fp8x4(f[24], f[25], f[26], f[27]); o1.w = pk_fp8x4(f[28], f[29], f[30], f[31]);
            u32x4* d = (u32x4*)(cur.dst + (size_t)n * 2048); d[0] = o0; d[1] = o1; }
        cur = nxt; have = hn; ++t;
    }
    __syncthreads();
}

__device__ __forceinline__ void phase_prologue(const Params& p, LAS unsigned char* lds) {
    int tid_ = threadIdx.x; asm volatile("" : "+v"(tid_));
    const int tid = tid_, wave = tid >> 6, lane = tid & 63;
    unsigned char* ws = p.ws;
    const int gw = vwg() * NWAVE + wave, NGW = (int)gridDim.x * NWAVE;
    for (int m = gw; m < T_; m += NGW) rms_row_to_bf16(p.in[0] + (size_t)m * DM, p.in[3], (bf16_t*)(ws + WS_H) + (size_t)m * LDP, lane, GATES_F8 ? (ws + WS_H8 + (size_t)m * DM) : nullptr);
    for (int m = gw; m < B_ * MEM; m += NGW) {
        const f32x4* xr = (const f32x4*)(p.in[1] + (size_t)m * DM) + lane; u32x2* o8 = (u32x2*)((bf16_t*)(ws + WS_MEMBF) + (size_t)m * LDP) + lane;
#pragma unroll
        for (int j = 0; j < 8; ++j) { const f32x4 v = xr[64 * j]; u32x2 w; w.x = cvtpk(v[0], v[1]); w.y = cvtpk(v[2], v[3]); o8[64 * j] = w; }
    }
    {
        const int gt = vwg() * NTHR + tid, NGT = (int)gridDim.x * NTHR;
        bf16_t* tabT = (bf16_t*)(ws + WS_TABT); bf16_t* dm = (bf16_t*)(ws + WS_DMAT);
        for (int i = gt; i < 512 * 256 / 2; i += NGT) { const int e0 = 2 * i; const int mrow = e0 >> 8, c = e0 & 255; const int n = mrow & 255; float v[2];
#pragma unroll
            for (int j = 0; j < 2; ++j) { const int mm = ((c + j) * n) & 255; const float a = (float)mm * (2.0f / 256.0f); v[j] = (mrow < 256) ? cospif(a) : sinpif(a); }
            *(unsigned*)(tabT + e0) = cvtpk(v[0], v[1]); }
        const float sc = 1.0f / sqrtf(2048.0f * 256.0f);
        LAS float* ct = (LAS float*)lds;
        for (int m = tid; m < 2048; m += NTHR) ct[m] = cospif((float)m * (2.0f / 2048.0f)) * sc;
        __syncthreads();
        for (int i = gt; i < 2048 * 4096 / 2; i += NGT) { const int e0 = 2 * i; const int jr = e0 >> 12, k = e0 & 4095; float v[2];
#pragma unroll
            for (int j = 0; j < 2; ++j) { const int kk = (k + j) & 2047; const int mm = (jr * kk) & 2047; v[j] = (k < 2048) ? ct[mm] : ct[(mm + 512) & 2047]; }
            *(unsigned*)(dm + e0) = cvtpk(v[0], v[1]); }
        __syncthreads();
        bf16_t* wrt = (bf16_t*)(ws + WS_WRT);
        for (int i = gt; i < NE * DM; i += NGT) { const int e = i >> 11, k = i & 2047; wrt[i] = (bf16_t)(cvtpk(p.in[12][(size_t)k * NE + e], 0.f) & 0xffffu); }
    }
    __syncthreads();
    convert_items(p, lds, 0, (gridDim.x == 256) ? CV_NONEXP : CV_TOTAL, vwg(), (int)gridDim.x);
}

constexpr int AT_KROW = 144, AT_VROW = 776;
constexpr int AT_K = 0, AT_V = 384 * AT_KROW, AT_LUT = AT_V + 64 * AT_VROW;
static_assert(AT_LUT + NWAVE * 320 * 4 <= STAGE_BYTES, "attention LDS");
__device__ __forceinline__ void attn_unit(const Params& p, LAS unsigned char* lds, int b, int kvh, int qb) {
    int tid_ = threadIdx.x; asm volatile("" : "+v"(tid_));
    const int tid = tid_, wid = __builtin_amdgcn_readfirstlane(tid >> 6), lane = tid & 63, r = lane & 31, h = lane >> 5;
    const unsigned char* ws = p.ws;
    const bf16_t* Q = (const bf16_t*)(ws + WS_Q); const bf16_t* Kg = (const bf16_t*)(ws + WS_K); const bf16_t* VT = (const bf16_t*)(ws + WS_VT);
    bf16_t* att = (bf16_t*)(p.ws + WS_ATT);
    const int q0 = qb * 128, hq = kvh * 8 + wid;
    LAS unsigned char* Kb = lds + AT_K; LAS unsigned char* Vt = lds + AT_V; LAS float* lut = (LAS float*)(lds + AT_LUT) + wid * 320;
    __syncthreads();
    for (int c = tid; c < 384 * 8; c += NTHR) { const int row = c >> 3, part = c & 7, pos = q0 - 128 + row;
        u32x4 v = {0u, 0u, 0u, 0u};
        if (pos >= 0 && pos < S_) v = *(const u32x4*)(Kg + (size_t)(b * S_ + pos) * 256 + kvh * 64 + part * 8);
        *(LAS u32x4*)(Kb + row * AT_KROW + part * 16) = v; }
    for (int c = tid; c < 64 * 48; c += NTHR) { const int d = c / 48, ch = c % 48, pos0 = q0 - 128 + ch * 8;
        u32x4 v = {0u, 0u, 0u, 0u};
        if (pos0 >= 0 && pos0 < S_) v = *(const u32x4*)(VT + ((size_t)((b * 4 + kvh) * 64 + d)) * 2048 + pos0);
        *(LAS u32x2*)(Vt + d * AT_VROW + ch * 16) = (u32x2){v.x, v.y}; *(LAS u32x2*)(Vt + d * AT_VROW + ch * 16 + 8) = (u32x2){v.z, v.w}; }
    for (int i = lane; i < 320; i += 64) { const int rel = i - 160; const int ar = rel < 0 ? -rel : rel;
        lut[i] = (ar <= WIN) ? p.in[2][t5_bucket(rel) * NH + hq] * LOG2E : -1.0e30f; }
    __syncthreads();
    const float sk = p.in[5][hq] * LOG2E;
    const float SC = 0.125f * LOG2E;
#pragma unroll 1
    for (int sb = 0; sb < 4; ++sb) {
        const int pq = q0 + sb * 32;
        bf16x8 qf[4];
        const bf16_t* qrow = Q + (size_t)(b * S_ + pq + r) * 2048 + hq * 64 + 8 * h;
#pragma unroll
        for (int s = 0; s < 4; ++s) qf[s] = *(const bf16x8*)(qrow + 16 * s);
        float mrun = sk, lrun = 1.0f;
        f32x16 o0, o1;
#pragma unroll
        for (int i = 0; i < 16; ++i) { o0[i] = 0.f; o1[i] = 0.f; }
        const int jlo = (qb == 0) ? 4 - sb : 0, jhi = (qb == 15) ? 8 - sb : 9;
        const LAS unsigned char* kp = Kb + (32 * (sb + jlo) + r) * AT_KROW + 16 * h;
        const LAS unsigned char* vp = Vt + r * AT_VROW + (32 * (sb + jlo) + 4 * h) * 2;
        const LAS unsigned char* vq = vp + 32 * AT_VROW;
        const LAS float* lp = lut + 32 * jlo + 32 + 4 * h - r;
#pragma unroll 1
        for (int j = jlo; j < jhi; ++j) {
            asm volatile("" : "+v"(kp), "+v"(vp), "+v"(vq), "+v"(lp));
            f32x16 s;
#pragma unroll
            for (int i = 0; i < 16; ++i) s[i] = 0.f;
#pragma unroll
            for (int ks = 0; ks < 4; ++ks) { const bf16x8 kf = *(const LAS bf16x8*)(kp + 32 * ks); s = __builtin_amdgcn_mfma_f32_32x32x16_bf16(kf, qf[ks], s, 0, 0, 0); }
            float mx = -3.0e38f;
            f32x2 sp[8];
#pragma unroll
            for (int i = 0; i < 8; ++i) { const int li = ((2 * i) & 3) + 8 * ((2 * i) >> 2); const f32x2 lv = {lp[li], lp[li + 1]}; const f32x2 sv = {s[2 * i], s[2 * i + 1]};
                sp[i] = sv * (f32x2){SC, SC} + lv; mx = fmaxf(fmaxf(mx, sp[i][0]), sp[i][1]); }
            mx = fmaxf(mx, __shfl_xor(mx, 32));
            const float mnew = fmaxf(mrun, mx);
            const float alpha = __builtin_amdgcn_exp2f(mrun - mnew);
            f32x2 rs2 = {0.f, 0.f};
#pragma unroll
            for (int i = 0; i < 8; ++i) { const f32x2 d = sp[i] - (f32x2){mnew, mnew}; const f32x2 e = {__builtin_amdgcn_exp2f(d[0]), __builtin_amdgcn_exp2f(d[1])};
                s[2 * i] = e[0]; s[2 * i + 1] = e[1]; rs2 += e; }
            float rs = rs2[0] + rs2[1];
            rs += __shfl_xor(rs, 32);
            lrun = lrun * alpha + rs; mrun = mnew;
            if (__any(alpha != 1.0f)) {
#pragma unroll
                for (int i = 0; i < 16; ++i) { o0[i] *= alpha; o1[i] *= alpha; }
            }
#pragma unroll
            for (int k2 = 0; k2 < 2; ++k2) {
                u32x4 pw; pw.x = cvtpk(s[8 * k2 + 0], s[8 * k2 + 1]); pw.y = cvtpk(s[8 * k2 + 2], s[8 * k2 + 3]); pw.z = cvtpk(s[8 * k2 + 4], s[8 * k2 + 5]); pw.w = cvtpk(s[8 * k2 + 6], s[8 * k2 + 7]);
                const bf16x8 pb = __builtin_bit_cast(bf16x8, pw);
                { const u32x2 lo = *(const LAS u32x2*)(vp + 32 * k2), hi = *(const LAS u32x2*)(vp + 32 * k2 + 16); const u32x4 vw = {lo.x, lo.y, hi.x, hi.y};
                  o0 = __builtin_amdgcn_mfma_f32_32x32x16_bf16(__builtin_bit_cast(bf16x8, vw), pb, o0, 0, 0, 0); }
                { const u32x2 lo = *(const LAS u32x2*)(vq + 32 * k2), hi = *(const LAS u32x2*)(vq + 32 * k2 + 16); const u32x4 vw = {lo.x, lo.y, hi.x, hi.y};
                  o1 = __builtin_amdgcn_mfma_f32_32x32x16_bf16(__builtin_bit_cast(bf16x8, vw), pb, o1, 0, 0, 0); }
            }
            kp += 32 * AT_KROW; vp += 64; vq += 64; lp += 32;
        }
        const float inv = 1.0f / lrun;
        bf16_t* orow = att + (size_t)(b * S_ + pq + r) * 2048 + hq * 64 + 4 * h;
#pragma unroll
        for (int g = 0; g < 4; ++g) {
            u32x2 w0; w0.x = cvtpk(o0[4 * g] * inv, o0[4 * g + 1] * inv); w0.y = cvtpk(o0[4 * g + 2] * inv, o0[4 * g + 3] * inv); *(u32x2*)(orow + 8 * g) = w0;
            u32x2 w1; w1.x = cvtpk(o1[4 * g] * inv, o1[4 * g + 1] * inv); w1.y = cvtpk(o1[4 * g + 2] * inv, o1[4 * g + 3] * inv); *(u32x2*)(orow + 32 + 8 * g) = w1;
        }
    }
}

__device__ __forceinline__ void phase_rows(const Params& p, LAS unsigned char* lds) {
    int tid_ = threadIdx.x; asm volatile("" : "+v"(tid_));
    const int tid = tid_, wave = __builtin_amdgcn_readfirstlane(tid >> 6), lane = tid & 63;
    unsigned char* ws = p.ws;
    const bf16_t* x2 = (const bf16_t*)(ws + WS_X2); bf16_t* h2 = (bf16_t*)(ws + WS_H2);
    LAS float* lg = (LAS float*)lds;
    LAS int* sel_e = (LAS int*)(lds + 8192);
    LAS float* sel_w = (LAS float*)(lds + 9216);
    LAS int* sel_r = (LAS int*)(lds + 10240);
    LAS int* lcnt = (LAS int*)(lds + 11264);
    LAS int* lbase = (LAS int*)(lds + 11392);
#pragma unroll 1
    for (int t0 = vwg() * 64; t0 < T_; t0 += 64 * (int)gridDim.x) {
        __syncthreads();
        if (tid < 32) lcnt[tid] = 0;
        for (int i = 0; i < 8; ++i) { const int t = t0 + wave * 8 + i; rms_bfrow_to_bf16(x2 + (size_t)t * DM, p.in[11], h2 + (size_t)t * DM, lane, MOE_F8 ? (ws + WS_H2Q + (size_t)t * DM) : nullptr); }
        asm volatile("s_waitcnt vmcnt(0)" ::: "memory");
        __syncthreads();
        if (wave < 4) {
            const bf16_t* arow = h2 + (size_t)(t0 + wave * 16 + (lane & 15)) * DM + 8 * (lane >> 4);
            const bf16_t* b0 = (const bf16_t*)(ws + WS_WRT) + (size_t)(lane & 15) * DM + 8 * (lane >> 4);
            const bf16_t* b1 = b0 + (size_t)16 * DM;
            f32x4 a0 = {0.f, 0.f, 0.f, 0.f}, a1 = {0.f, 0.f, 0.f, 0.f};
#pragma unroll 8
            for (int s = 0; s < 64; ++s) { const bf16x8 av = *(const bf16x8*)(arow + 32 * s), bv0 = *(const bf16x8*)(b0 + 32 * s), bv1 = *(const bf16x8*)(b1 + 32 * s);
                a0 = __builtin_amdgcn_mfma_f32_16x16x32_bf16(av, bv0, a0, 0, 0, 0); a1 = __builtin_amdgcn_mfma_f32_16x16x32_bf16(av, bv1, a1, 0, 0, 0); }
            const int ecol = lane & 15; const float bb0 = p.in[13][ecol], bb1 = p.in[13][ecol + 16];
#pragma unroll
            for (int rg = 0; rg < 4; ++rg) { const int tl = wave * 16 + (lane >> 4) * 4 + rg; lg[tl * 32 + ecol] = a0[rg] + bb0; lg[tl * 32 + ecol + 16] = a1[rg] + bb1; }
        }
        __syncthreads();
        if (tid < 64) {
            float v[32];
#pragma unroll
            for (int e = 0; e < 32; ++e) v[e] = lg[tid * 32 + e];
            float tv[4]; int ti[4];
#pragma unroll
            for (int k = 0; k < 4; ++k) { float bv = -3.0e38f; int bi = 0;
#pragma unroll
                for (int e = 0; e < 32; ++e) { const bool tk = v[e] > bv; bv = tk ? v[e] : bv; bi = tk ? e : bi; }
                tv[k] = bv; ti[k] = bi;
#pragma unroll
                for (int e = 0; e < 32; ++e) v[e] = (e == bi) ? -3.0e38f : v[e]; }
            const float e1 = __expf(tv[1] - tv[0]), e2 = __expf(tv[2] - tv[0]), e3 = __expf(tv[3] - tv[0]);
            const float inv = 1.0f / (1.0f + e1 + e2 + e3);
            const float wv[4] = {inv, e1 * inv, e2 * inv, e3 * inv};
#pragma unroll
            for (int k = 0; k < 4; ++k) { sel_e[tid * 4 + k] = ti[k]; sel_w[tid * 4 + k] = wv[k]; sel_r[tid * 4 + k] = __hip_atomic_fetch_add(&lcnt[ti[k]], 1, __ATOMIC_RELAXED, __HIP_MEMORY_SCOPE_WORKGROUP); }
        }
        __syncthreads();
        if (tid < 32) lbase[tid] = (lcnt[tid] > 0) ? atomicAdd((int*)(ws + WS_CTL) + CW_CNT + tid, lcnt[tid]) : 0;
        __syncthreads();
        if (tid < 256) { const int tl = tid >> 2, k = tid & 3, t = t0 + tl; const int e = sel_e[tid], pos = lbase[e] + sel_r[tid]; const float w = sel_w[tid];
            ((int*)(ws + WS_TOKE))[t * 4 + k] = e; ((int*)(ws + WS_TOKPOS))[t * 4 + k] = pos; ((float*)(ws + WS_TOKW))[t * 4 + k] = w;
            ((int*)(ws + WS_LIST))[(size_t)e * T_ + pos] = t; ((float*)(ws + WS_WLIST))[(size_t)e * T_ + pos] = w; }
    }
}
__device__ __forceinline__ void moe_tables(const Params& p, LAS int* pt, LAS int* cn) {
    __syncthreads();
    if (threadIdx.x < 64) {
        const int ln = (int)threadIdx.x; const int* cnt = (const int*)(p.ws + WS_CTL) + CW_CNT;
        const int c = (ln < NE) ? __hip_atomic_load(cnt + (ln & 31), __ATOMIC_RELAXED, __HIP_MEMORY_SCOPE_AGENT) : 0;
        const int tl = (c + 255) >> 8; int inc = tl;
#pragma unroll
        for (int o = 1; o < 32; o <<= 1) { const int v = __shfl_up(inc, o); if (ln >= o) inc += v; }
        if (ln < NE) { cn[ln] = c; pt[ln] = inc - tl; }
        if (ln == NE - 1) pt[NE] = inc;
    }
    __syncthreads();
}
__device__ __forceinline__ void phase_final(const Params& p, const LAS int* pt) {
    int tid_ = threadIdx.x; asm volatile("" : "+v"(tid_));
    const int tid = tid_, wave = tid >> 6, lane = tid & 63;
    const unsigned char* ws = p.ws;
    const bf16_t* x2 = (const bf16_t*)(ws + WS_X2); const bf16_t* ys = (const bf16_t*)(ws + WS_YS);
    const int* toke = (const int*)(ws + WS_TOKE); const int* tokpos = (const int*)(ws + WS_TOKPOS);
    const int gw = vwg() * NWAVE + wave, NGW = (int)gridDim.x * NWAVE;
    float pscale = 1.0f;
    if (PROFSEL != 0) {
        const unsigned long long* pf = (const unsigned long long*)(p.ws + WS_CTL + 32768);
        const float kl = (float)pf[0], ep = (float)pf[1], n = (float)pf[2], ntl = (float)pf[3], cyc = (float)pf[4], wal = (float)pf[5];
        float m = 0.f;
        if (PROFMETRIC == 0) m = ep / (kl + ep);
        if (PROFMETRIC == 1) m = kl / (n * ntl) / 4096.0f;
        if (PROFMETRIC == 2) m = cyc / (wal * 24.0f);
        if (PROFMETRIC == 3) m = (kl + ep) / cyc;
        if (PROFMETRIC == 4) m = n / 32.0f;
        if (PROFMETRIC == 5) m = wal / 100.0f / 200.0f;
        if (PROFMETRIC == 6 || PROFMETRIC == 7) {
            const unsigned long long* st = (const unsigned long long*)(p.ws + WS_CTL + 40960);
            unsigned long long mx = 0, mn = ~0ull, sum = 0;
            for (int i = 0; i < (int)gridDim.x; ++i) { const unsigned long long v = st[i]; mx = v > mx ? v : mx; mn = v < mn ? v : mn; sum += v; }
            const float mean = (float)(sum - mn * gridDim.x) / (float)gridDim.x;
            m = (PROFMETRIC == 6 ? ((float)(mx - mn) - mean) : (float)(mx - mn)) / 100.0f / 200.0f; }
        if (blockIdx.x == 0 && threadIdx.x == 0) { const unsigned long long t0 = wall_clock64(), ticks = (unsigned long long)(m * (float)PROFMUL * 100.0f * 100.0f);
            while (wall_clock64() - t0 < ticks) __builtin_amdgcn_s_sleep(8); }
    }
    for (int t = gw; t < T_; t += NGW) {
        const u32x2* xr = (const u32x2*)(x2 + (size_t)t * DM) + lane;
        f32x4 v[8];
#pragma unroll
        for (int j = 0; j < 8; ++j) { const u32x2 w = xr[64 * j]; v[j] = (f32x4){bflo(w.x), bfhi(w.x), bflo(w.y), bfhi(w.y)}; }
#pragma unroll
        for (int k = 0; k < 4; ++k) { const int e = toke[t * 4 + k]; const size_t slot = (size_t)pt[e] * 256 + tokpos[t * 4 + k];
            if constexpr (MOE_F8) {
                const unsigned* yr = (const unsigned*)((const unsigned char*)ys + slot * DM) + lane;
#pragma unroll
                for (int j = 0; j < 8; ++j) { const unsigned w = yr[64 * j];
                    v[j][0] += __builtin_amdgcn_cvt_f32_fp8((int)w, 0) * YS_INV; v[j][1] += __builtin_amdgcn_cvt_f32_fp8((int)w, 1) * YS_INV;
                    v[j][2] += __builtin_amdgcn_cvt_f32_fp8((int)w, 2) * YS_INV; v[j][3] += __builtin_amdgcn_cvt_f32_fp8((int)w, 3) * YS_INV; }
            } else {
                const u32x2* yr = (const u32x2*)(ys + slot * DM) + lane;
#pragma unroll
                for (int j = 0; j < 8; ++j) { const u32x2 w = yr[64 * j]; v[j][0] += bflo(w.x); v[j][1] += bfhi(w.x); v[j][2] += bflo(w.y); v[j][3] += bfhi(w.y); }
            } }
        float s = 0.f;
#pragma unroll
        for (int j = 0; j < 8; ++j) s += (v[j][0] * v[j][0] + v[j][1] * v[j][1]) + (v[j][2] * v[j][2] + v[j][3] * v[j][3]);
        const float r = rsqrtf(wsum(s) * (1.0f / DM) + 1e-5f);
        const f32x4* gr = (const f32x4*)p.in[18] + lane; f32x4* orow = (f32x4*)(p.out + (size_t)t * DM) + lane;
#pragma unroll
        for (int j = 0; j < 8; ++j) { const f32x4 gg = gr[64 * j]; orow[64 * j] = (f32x4){v[j][0] * r * gg[0] * pscale, v[j][1] * r * gg[1] * pscale, v[j][2] * r * gg[2] * pscale, v[j][3] * r * gg[3] * pscale}; }
    }
}
#ifndef P1_SLOT_BAL
#define P1_SLOT_BAL 1
#endif
#ifndef CV_SPLIT
#define CV_SPLIT 6144L
#endif
#ifndef MOE_SLOT
#define MOE_SLOT 1
#endif
#ifndef X2_SLOT
#define X2_SLOT 0
#endif
#ifndef MOE_SLOT_STEP
#define MOE_SLOT_STEP 4
#endif
#ifndef MOE_SLOT_BAL
#define MOE_SLOT_BAL 4
#endif
#ifndef POOL1
#define POOL1 2
#endif
#ifndef POOL2
#define POOL2 1
#endif
#ifndef POOL3
#define POOL3 1
#endif
#ifndef POOL4
#define POOL4 1
#endif
#ifndef POOL5
#define POOL5 1
#endif
#ifndef Q4
#define Q4 6
#endif
constexpr long GU_A0 = 30 - (POOL1 + POOL2 + POOL3 + POOL4 + POOL5 + Q4);
constexpr long GU_P1S = 64 * (4 * GU_A0 + 8), GU_P1P = GU_P1S, GU_P2P = GU_P1P + 256 * POOL1, GU_P3P = GU_P2P + 256 * POOL2, GU_P4S = GU_P3P + 256 * POOL3,
               GU_P4P = GU_P4S + 256 * Q4, GU_P5P = GU_P4P + 256 * POOL4, GU_END = GU_P5P + 256 * POOL5;
static_assert(GU_END == 8192 && GU_A0 > 0, "gate_up conversion layout");
#ifndef POOL7
#define POOL7 2
#endif
__device__ __forceinline__ void proj_convert_slot(const Params& p, LAS unsigned char* lds, int g, int part) {
    const int wgi = (int)blockIdx.x & 63;
    __syncthreads();
    if constexpr (MOE_F8 && CONV_TILE32) { const long per = CE_TOTAL / 512, a = ((long)(part * 4 + g) * 64 + wgi) * per; convert_experts(p, lds, a, a + per); }
    else { const long total = CV_TOTAL - CV_NONEXP, half = total / 2; long q = half / 4, it0 = CV_NONEXP + half * part + q * g;
        if (P1_SLOT_BAL) {
            constexpr long P1END = (MOE_SLOT ? 8192 : 12288) - 256 * X2_SLOT;
            static_assert((CV_TOTAL - CV_NONEXP) == 12288 && MOE_SLOT == 1 && X2_SLOT == 0, "slot split");
            if (part == 0) { it0 = CV_NONEXP + 64 * GU_A0 * g; q = 64 * (g == 3 ? GU_A0 + 8 : GU_A0); }
            else if (part == 1) { it0 = CV_NONEXP + GU_P4S + 64 * Q4 * g; q = 64 * Q4; }
            else if (part == 2) { it0 = CV_NONEXP + 8192 + 1024 * g; q = 1024; }
            else { it0 = CV_NONEXP + P1END + 64 * X2_SLOT * g; q = 64 * X2_SLOT; } }
        convert_items(p, lds, it0, it0 + q, wgi, 64);
#ifdef DBLCONV
        if (part == (DBLCONV & 3) - 1) { __syncthreads(); convert_items(p, lds, it0, it0 + q, wgi, 64, DBLCONV >> 2); }
#endif
    }
    asm volatile("s_waitcnt vmcnt(0) lgkmcnt(0)" ::: "memory");
    __syncthreads();
}
__device__ __forceinline__ void pool_drain(const Params& p, LAS unsigned char* lds, int pool, long base, int count) {
    LAS int* slot = (LAS int*)(lds + LDS_MISC + 768);
#pragma unroll 1
    for (;;) {
        __syncthreads();
        if (threadIdx.x == 0) *slot = __hip_atomic_fetch_add((int*)(p.ws + WS_CTL) + CW_POOL + 64 * pool, 1, __ATOMIC_RELAXED, __HIP_MEMORY_SCOPE_AGENT);
        __syncthreads();
        const int idx = __builtin_amdgcn_readfirstlane(*slot);
        if (idx >= count) break;
        convert_items(p, lds, base + idx, base + idx + 1, 0, 1);
        asm volatile("s_waitcnt vmcnt(0) lgkmcnt(0)" ::: "memory");
    }
    __syncthreads();
}
__device__ __forceinline__ void convert_range_slot(const Params& p, LAS unsigned char* lds, long it0, long n) {
    __syncthreads();
    convert_items(p, lds, it0, it0 + n, 0, 1);
    asm volatile("s_waitcnt vmcnt(0) lgkmcnt(0)" ::: "memory");
    __syncthreads();
}
__device__ __forceinline__ void phase_proj(const Params& p, LAS unsigned char* lds) {
    EpiProj E{p.ws}; EpiGates8 EG{p.ws};
    unsigned long long* prof = PROFSEL == 1 ? (unsigned long long*)(p.ws + WS_CTL + 32768) : nullptr;
    const int BIG = 1 << 20;
    const bool stag = (gridDim.x == 256);
    const int g = stag ? ((int)blockIdx.x >> 6) : -1;
    if constexpr (GATES_F8) {
#ifndef P1SLOTV
#define P1SLOTV 0
#endif
        int a1 = (g == 0) ? 0 : (g == 1 ? 2 : BIG), a3 = (g == 3) ? 3 : BIG, slot = (g <= 1) ? 1 : g;
        if (P1SLOTV == 1) { a1 = BIG; a3 = (g <= 0) ? BIG : 2 * g; slot = (g <= 0) ? 2 : 3; }
        if (P1SLOTV == 2) { a1 = (g == 0) ? 0 : (g == 1 ? 3 : BIG); a3 = (g == 2) ? 1 : (g == 3 ? 4 : BIG); slot = (g <= 1) ? 1 : 3; }
        { SchedProj S{p.ws, 0, a1}; gemm_phase<EpiProj, SchedProj, true>(lds, 2048, LDP, LDP, S, E, nullptr); }
        if (stag && slot == 1) proj_convert_slot(p, lds, g, 0);
        { SchedProj S{p.ws, a1, BIG}; gemm_phase<EpiProj, SchedProj, true>(lds, 2048, LDP, LDP, S, E, prof); }
        if (stag && slot == 2) proj_convert_slot(p, lds, g, 0);
        { SchedGates8 S{p.ws, 0, a3}; gemm_phase<EpiGates8, SchedGates8, true, 1>(lds, 2048, 2048, 2048, S, EG, nullptr); }
        if (stag && slot == 3) proj_convert_slot(p, lds, g, 0);
        { SchedGates8 S{p.ws, a3, BIG}; gemm_phase<EpiGates8, SchedGates8, true, 1>(lds, 2048, 2048, 2048, S, EG, nullptr); }
        if (stag && POOL1 > 0) pool_drain(p, lds, 0, CV_NONEXP + GU_P1P, 256 * POOL1);
    } else {
        const int nb = stag ? 3 * g : 0;
        if (nb > 0) { SchedProj S{p.ws, 0, nb}; gemm_phase<EpiProj, SchedProj, true>(lds, 2048, LDP, LDP, S, E, nullptr); }
        if (stag) proj_convert_slot(p, lds, g, 0);
        { SchedProj S{p.ws, nb, BIG}; gemm_phase<EpiProj, SchedProj, true>(lds, 2048, LDP, LDP, S, E, prof); }
    }
}
__device__ __forceinline__ void phase_mixers(const Params& p, LAS unsigned char* lds) {
    unsigned char* ws = p.ws;
#ifndef DBLSUB
#define DBLSUB 0
#endif
#pragma unroll 1
    for (int rep = 0; rep < ((DBLSUB & 1) ? 2 : 1); ++rep)
#pragma unroll 1
    for (int u = vwg(); u < 512; u += (int)gridDim.x) attn_unit(p, lds, u >> 6, (u >> 4) & 3, u & 15);
    asm volatile("s_waitcnt vmcnt(0) lgkmcnt(0)" ::: "memory");
    __syncthreads();
#pragma unroll 1
    for (int rep = 0; rep < ((DBLSUB & 2) ? 2 : 1); ++rep)
#pragma unroll 1
    for (int u = vwg(); u < 256; u += (int)gridDim.x) {
        const int mh = u & 3, tb = (u >> 2) & 7, b = (u >> 5) & 7;
        const size_t tok0 = (size_t)b * S_ + (size_t)tb * 256;
        bf16_t* Pt = (bf16_t*)(ws + WS_PM) + tok0 * 1024 + mh * 256;
        SchedOne S1{(const char*)(ws + WS_QM) + (tok0 * 1024 + mh * 256) * 2, (const char*)(ws + WS_KMK) + ((size_t)b * 256 * 1024 + mh * 256) * 2, 0, true};
        EpiMemSoftmax E1{Pt};
        gemm_phase<EpiMemSoftmax, SchedOne, false>(lds, 256, 1024, 1024, S1, E1);
        asm volatile("s_waitcnt vmcnt(0)" ::: "memory");
        __syncthreads();
        SchedOne S2{(const char*)Pt, (const char*)(ws + WS_VMT) + ((size_t)(b * 4 + mh) * 256 * 256) * 2, 0, true};
        EpiTile E2{(bf16_t*)(ws + WS_FX) + tok0 * 2048 + 1024 + mh * 256, 2048};
        gemm_phase<EpiTile, SchedOne, false>(lds, 256, 1024, 256, S2, E2);
        __syncthreads();
    }
    { SchedChan S{ws, 0, 0}; EpiChan E{ws}; gemm_phase<EpiChan, SchedChan, true>(lds, 256, 256, 1024, S, E, PROFSEL == 2 ? (unsigned long long*)(p.ws + WS_CTL + 32768) : nullptr); }
    if (POOL2 > 0 && gridDim.x == 256) pool_drain(p, lds, 2, CV_NONEXP + GU_P2P, 256 * POOL2);
}
__device__ __forceinline__ void phase_seqdft(const Params& p, LAS unsigned char* lds) {
    SchedSeq S{p.ws}; EpiSeq E{p.ws};
    gemm_phase<EpiSeq, SchedSeq, true>(lds, 4096, 4096, 4096, S, E, PROFSEL == 3 ? (unsigned long long*)(p.ws + WS_CTL + 32768) : nullptr);
    if (POOL3 > 0 && gridDim.x == 256) pool_drain(p, lds, 3, CV_NONEXP + GU_P3P, 256 * POOL3);
}
__device__ __forceinline__ void phase_mix(const Params& p, LAS unsigned char* lds) {
    unsigned char* ws = p.ws;
    const bool stag = (gridDim.x == 256); const int g = stag ? ((int)blockIdx.x >> 6) : -1;
    unsigned long long* prof = PROFSEL == 4 ? (unsigned long long*)(p.ws + WS_CTL + 32768) : nullptr;
    EpiMixF E{ws};
#ifndef MIXSLOT
#define MIXSLOT 0x2110
#endif
    const int sp = (g >= 0) ? ((MIXSLOT >> (4 * g)) & 15) : -1;
    if (sp == 0) proj_convert_slot(p, lds, g, 1);
    { SchedMix S{ws, 0, 1}; gemm_phase<EpiMixF, SchedMix, true>(lds, 2048, 2048, 2048, S, E, prof); }
    if (sp == 1) proj_convert_slot(p, lds, g, 1);
    { SchedMix S{ws, 1, 1 << 20}; gemm_phase<EpiMixF, SchedMix, true>(lds, 2048, 2048, 2048, S, E, nullptr); }
    if (sp == 2) proj_convert_slot(p, lds, g, 1);
    if (POOL4 > 0 && stag) pool_drain(p, lds, 4, CV_NONEXP + GU_P4P, 256 * POOL4);
}
__device__ __forceinline__ void phase_x2(const Params& p, LAS unsigned char* lds) {
    unsigned char* ws = p.ws;
    SchedPlain S{(const char*)(ws + WS_MIXED), (const char*)(ws + WS_WOT), (size_t)256 * 2048 * 2, (size_t)256 * 2048 * 2, 64, 8};
    EpiRes E{p.in[0], (bf16_t*)(ws + WS_X2)};
    unsigned long long* prof = PROFSEL == 5 ? (unsigned long long*)(p.ws + WS_CTL + 32768) : nullptr;
    if (X2_SLOT > 0 && MOE_SLOT && gridDim.x == 256) {
        const int g = (int)blockIdx.x >> 6, sp = (0x2110 >> (4 * g)) & 15;
        if (sp == 0) proj_convert_slot(p, lds, g, 3);
        { SchedPlain Sa = S; Sa.r0 = 0; Sa.r1 = 1; gemm_phase<EpiRes, SchedPlain, true>(lds, 2048, 2048, 2048, Sa, E, prof); }
        if (sp == 1) proj_convert_slot(p, lds, g, 3);
        { SchedPlain Sb = S; Sb.r0 = 1; gemm_phase<EpiRes, SchedPlain, true>(lds, 2048, 2048, 2048, Sb, E, nullptr); }
        if (sp == 2) proj_convert_slot(p, lds, g, 3);
    } else gemm_phase<EpiRes, SchedPlain, true>(lds, 2048, 2048, 2048, S, E, prof);
    if (POOL5 > 0 && gridDim.x == 256) pool_drain(p, lds, 5, CV_NONEXP + GU_P5P, 256 * POOL5);
}
template <class Sched> __device__ __forceinline__ void moe_fill_tokl(const Params& p, LAS unsigned char* lds, const Sched& S, const LAS int* cn) {
    LAS unsigned short* tokl = (LAS unsigned short*)(lds + LDS_TOKL);
    const int* list = (const int*)(p.ws + WS_LIST);
    const int tid = threadIdx.x, half = tid >> 8, c = tid & 255;
    int tok[10]; bool val[10];
#pragma unroll
    for (int j = 0; j < 10; ++j) { Unit u; val[j] = S.next(2 * j + half, u); tok[j] = 0;
        if (val[j]) { const int cnt = cn[u.z]; int pos = u.pm * 256 + c; pos = pos < cnt ? pos : cnt - 1; tok[j] = list[(size_t)u.z * T_ + pos]; } }
#pragma unroll
    for (int j = 0; j < 10; ++j) if (val[j]) tokl[(2 * j + half) * 256 + c] = (unsigned short)tok[j];
    __syncthreads();
}
template <class Sched, bool WTAB> __device__ __forceinline__ void moe_fill_tabs(const Params& p, LAS unsigned char* lds, const Sched& S, const LAS int* cn, const float* bias, int ncol) {
    LAS float* btab = (LAS float*)(lds + LDS_BTAB); LAS float* wtab = (LAS float*)(lds + LDS_TOKL);
    const float* wl = (const float*)(p.ws + WS_WLIST);
    const int tid = threadIdx.x, half = tid >> 8, c = tid & 255;
    constexpr int NP = WTAB ? 5 : 10;
    float bv[NP], wv[NP]; bool val[NP];
#pragma unroll
    for (int j = 0; j < NP; ++j) { Unit u; val[j] = S.next(2 * j + half, u); bv[j] = 0.f; wv[j] = 0.f;
        if (val[j]) { bv[j] = bias[(size_t)u.z * ncol + u.pn * 256 + c];
            if constexpr (WTAB) { const int pos = u.pm * 256 + c; if (pos < cn[u.z]) wv[j] = wl[(size_t)u.z * T_ + pos] * YS_SCALE; } } }
#pragma unroll
    for (int j = 0; j < NP; ++j) if (val[j]) { btab[(2 * j + half) * 256 + c] = bv[j]; if constexpr (WTAB) wtab[(2 * j + half) * 256 + c] = wv[j]; }
    __syncthreads();
}
__device__ __forceinline__ void phase_gateup(const Params& p, LAS unsigned char* lds) {
    LAS int* pt = (LAS int*)(lds + LDS_MISC); LAS int* cn = pt + 64;
    moe_tables(p, pt, cn);
    if constexpr (MOE_F8) { SchedMoe<true, 16, true> S{p.ws, pt, cn}; EpiSwiglu8 E{p.ws, p.in[15], pt}; moe_fill_tokl(p, lds, S, cn); moe_fill_tabs<SchedMoe<true, 16, true>, false>(p, lds, S, cn, p.in[15], 4096);
        unsigned long long* prof = PROFSEL == 7 ? (unsigned long long*)(p.ws + WS_CTL + 32768) : nullptr;
        const bool stag = MOE_SLOT && (gridDim.x == 256);
        if (stag) {
            const int g = (int)blockIdx.x >> 6, a = MOE_SLOT_STEP * g;
            if (a > 0) { SchedMoe<true, 16, true> Sa{p.ws, pt, cn, 0, 0, a}; gemm_phase<EpiSwiglu8, SchedMoe<true, 16, true>, MOE_ALIGN, 1>(lds, 2048, 2048, 2048, Sa, E, nullptr); }
            if constexpr (MOE_SLOT_BAL) {
                const int U = S.ptu(NE) * 16, rmax = (U + 255) >> 8, me = (int)blockIdx.x & 63;
                int totd = 0, dme = 0, dbefore = 0;
#pragma unroll 1
                for (int i = 0; i < 64; ++i) { const int c = 64 * g + i, v = (c & 7) * 32 + (c >> 3); const int r = (v < U) ? ((U - v + 255) >> 8) : 0; int d = rmax - r;
#ifdef MOE_BAL_TEST
                    d = (i * 7 + g) % 3 == 0 ? 1 : 0;
#endif
                    totd += d; if (i < me) dbefore += d; if (i == me) dme = d; }
                constexpr int GT = 1024 - 64 * POOL7;
                const int n0 = (GT - MOE_SLOT_BAL * totd) / 64, rem = GT - 64 * n0 - MOE_SLOT_BAL * totd;
                const long base = CV_NONEXP + 8192 + (long)GT * g;
                const int xs = 64 * n0 + MOE_SLOT_BAL * dbefore + (me < rem ? me : rem), xn = MOE_SLOT_BAL * dme + (me < rem ? 1 : 0);
                __syncthreads();
                convert_items(p, lds, base, base + 64 * n0, me, 64);
                if (xn > 0) convert_items(p, lds, base + xs, base + xs + xn, 0, 1);
                asm volatile("s_waitcnt vmcnt(0) lgkmcnt(0)" ::: "memory");
                __syncthreads();
            } else proj_convert_slot(p, lds, g, 2);
            moe_fill_tokl(p, lds, S, cn);
            SchedMoe<true, 16, true> Sb{p.ws, pt, cn, 0, a, 1 << 20}; gemm_phase<EpiSwiglu8, SchedMoe<true, 16, true>, MOE_ALIGN, 1>(lds, 2048, 2048, 2048, Sb, E, prof);
            if (POOL7 > 0) pool_drain(p, lds, 1, CV_NONEXP + 12288 - 256 * POOL7, 256 * POOL7);
        } else gemm_phase<EpiSwiglu8, SchedMoe<true, 16, true>, MOE_ALIGN, 1>(lds, 2048, 2048, 2048, S, E, prof); }
    else { SchedMoe<true, 16, false> S{p.ws, pt, cn}; EpiSwiglu E{p.ws, p.in[15], pt}; moe_fill_tokl(p, lds, S, cn);
        gemm_phase<EpiSwiglu, SchedMoe<true, 16, false>, true>(lds, 2048, 2048, 2048, S, E); }
}
__device__ __forceinline__ void phase_down(const Params& p, LAS unsigned char* lds) {
    LAS int* pt = (LAS int*)(lds + LDS_MISC); LAS int* cn = pt + 64;
    moe_tables(p, pt, cn);
    if constexpr (MOE_F8) { SchedMoe<false, 8, true> S{p.ws, pt, cn}; EpiDown8 E{p.ws, p.in[17], pt, cn}; moe_fill_tabs<SchedMoe<false, 8, true>, true>(p, lds, S, cn, p.in[17], 2048); gemm_phase<EpiDown8, SchedMoe<false, 8, true>, MOE_ALIGN, 1>(lds, 2048, 2048, 2048, S, E, PROFSEL == 8 ? (unsigned long long*)(p.ws + WS_CTL + 32768) : nullptr); }
    else { SchedMoe<false, 8, false> S{p.ws, pt, cn}; EpiDown E{p.ws, p.in[17], pt, cn}; gemm_phase<EpiDown, SchedMoe<false, 8, false>, true>(lds, 2048, 2048, 2048, S, E); }
#ifdef SHADOW
    if constexpr (MOE_F8) { __syncthreads(); SchedMoe<false, 8, true> S{p.ws, pt, cn, SHADOW - 1}; EpiDown8 E{p.ws, p.in[17], pt, cn, (WS_FAST_END + 4095) & ~(size_t)4095};
        gemm_phase<EpiDown8, SchedMoe<false, 8, true>, MOE_ALIGN, 1>(lds, 2048, 2048, 2048, S, E, nullptr); }
#endif
}
__device__ __forceinline__ void phase_out(const Params& p, LAS unsigned char* lds) {
    LAS int* pt = (LAS int*)(lds + LDS_MISC); LAS int* cn = pt + 64;
    moe_tables(p, pt, cn);
    phase_final(p, pt);
}

template <int PH> __global__ void __launch_bounds__(NTHR, 2) k_phase(Params p) {
    extern __shared__ __attribute__((aligned(16))) unsigned char lds_raw[];
    LAS unsigned char* lds = (LAS unsigned char*)lds_raw;
    if constexpr (PH == 0) phase_prologue(p, lds);
    if constexpr (PH == 1) phase_proj(p, lds);
    if constexpr (PH == 2) phase_mixers(p, lds);
    if constexpr (PH == 3) phase_seqdft(p, lds);
    if constexpr (PH == 4) phase_mix(p, lds);
    if constexpr (PH == 5) phase_x2(p, lds);
    if constexpr (PH == 6) phase_rows(p, lds);
    if constexpr (PH == 7) phase_gateup(p, lds);
    if constexpr (PH == 8) phase_down(p, lds);
    if constexpr (PH == 9) phase_out(p, lds);
}
template <int PH> static void launch_phase(const Params& p, hipStream_t st) {
    static bool attr_done = false;
    if (!attr_done) { (void)hipFuncSetAttribute((const void*)k_phase<PH>, hipFuncAttributeMaxDynamicSharedMemorySize, LDS_BYTES); attr_done = true; }
    hipLaunchKernelGGL(k_phase<PH>, dim3(256), dim3(NTHR), LDS_BYTES, st, p);
}
static void run_fast_multi(const Params& p, hipStream_t st, int lo, int hi) {
    if (lo <= 0 && 0 < hi) launch_phase<0>(p, st);
    if (lo <= 1 && 1 < hi) launch_phase<1>(p, st);
    if (lo <= 2 && 2 < hi) launch_phase<2>(p, st);
    if (lo <= 3 && 3 < hi) launch_phase<3>(p, st);
    if (lo <= 4 && 4 < hi) launch_phase<4>(p, st);
    if (lo <= 5 && 5 < hi) launch_phase<5>(p, st);
    if (lo <= 6 && 6 < hi) launch_phase<6>(p, st);
    if (lo <= 7 && 7 < hi) launch_phase<7>(p, st);
    if (lo <= 8 && 8 < hi) launch_phase<8>(p, st);
    if (lo <= 9 && 9 < hi) launch_phase<9>(p, st);
}
#define XB_TMO      128
#define XB_XCNT(j)  (256  + 64 * (j))
#define XB_XSUB(j)  (1280 + 64 * (j))
#define XB_XGEN(j)  (2304 + 64 * (j))
#define XB_TOP      3328
#define XB_TOPGEN   3392
#define XCD_BAR_WORDS 3456
#define XB_SPIN_CAP (1u << 18)

__device__ __forceinline__ unsigned xb_ld(unsigned* p)              { return __hip_atomic_load(p, __ATOMIC_RELAXED, __HIP_MEMORY_SCOPE_AGENT); }
__device__ __forceinline__ unsigned xb_add(unsigned* p, unsigned v) { return __hip_atomic_fetch_add(p, v, __ATOMIC_RELAXED, __HIP_MEMORY_SCOPE_AGENT); }
__device__ __forceinline__ unsigned xb_xcc_id() { return (unsigned)__builtin_amdgcn_s_getreg((3 << 11) | 20) & 0xFu; }
#define XB_SPIN(cond, bar) do { unsigned _sp = 0; while (cond) { __builtin_amdgcn_s_sleep(1); \
    if ((++_sp & 255u) == 0u) { if (xb_ld(&(bar)[XB_TMO])) break; if (_sp > XB_SPIN_CAP) { atomicAdd(&(bar)[XB_TMO], 1u); break; } } } } while (0)

struct XcdBarrier {
    unsigned* bar; unsigned x;
    volatile LAS unsigned* st;
};

__device__ __forceinline__ XcdBarrier xcd_barrier_post(unsigned* bar, volatile LAS unsigned* st) {
    XcdBarrier b; b.bar = bar; b.x = xb_xcc_id(); b.st = st;
    if (threadIdx.x == 0) (void)xb_add(&bar[XB_XCNT(b.x)], 1u);
    return b;
}
__device__ __forceinline__ void xcd_barrier_complete(unsigned* bar, unsigned x, unsigned& nloc, unsigned& nx) {
    const unsigned G = gridDim.x * gridDim.y * gridDim.z;
    unsigned sum, cnt, mine, sp = 0u;
    for (;;) {
        sum = 0u; cnt = 0u; mine = 0u;
#pragma unroll
        for (unsigned j = 0; j < 16; ++j) { const unsigned c = xb_ld(&bar[XB_XCNT(j)]); sum += c; cnt += (c > 0u) ? 1u : 0u; mine = (j == x) ? c : mine; }
        if (sum == G) break;
        __builtin_amdgcn_s_sleep(1);
        if ((++sp & 255u) == 0u) { if (xb_ld(&bar[XB_TMO])) break; if (sp > XB_SPIN_CAP) { atomicAdd(&bar[XB_TMO], 1u); break; } }
    }
    nloc = mine > 0u ? mine : 1u; nx = cnt > 0u ? cnt : 1u;
}

__device__ __forceinline__ void xcd_barrier(const XcdBarrier& b) {
    asm volatile("s_waitcnt vmcnt(0)" ::: "memory");
    __syncthreads();
    if (threadIdx.x == 0) {
        unsigned* bar = b.bar;
        __builtin_amdgcn_s_waitcnt(0);
        unsigned nloc = b.st[0], nx = b.st[1];
        if (nloc == 0u) { xcd_barrier_complete(bar, b.x, nloc, nx); b.st[0] = nloc; b.st[1] = nx; }
        const unsigned old = xb_add(&bar[XB_XSUB(b.x)], 1u);
        const unsigned gen = old / nloc;
        if (old + 1u == (gen + 1u) * nloc) {
            __builtin_amdgcn_fence(__ATOMIC_RELEASE, "agent");
            asm volatile("s_waitcnt vmcnt(0)" ::: "memory");
            const unsigned og = xb_add(&bar[XB_TOP], 1u);
            const unsigned tg = og / nx;
            if (og + 1u == (tg + 1u) * nx) xb_add(&bar[XB_TOPGEN], 1u);
            else XB_SPIN(xb_ld(&bar[XB_TOPGEN]) == tg, bar);
            __builtin_amdgcn_fence(__ATOMIC_ACQUIRE, "agent");
            xb_add(&bar[XB_XGEN(b.x)], 1u);
            asm volatile("s_waitcnt vmcnt(0)" ::: "memory");
        } else {
            XB_SPIN(xb_ld(&bar[XB_XGEN(b.x)]) == gen, bar);
            __builtin_amdgcn_fence(__ATOMIC_ACQUIRE, "agent");
            asm volatile("s_waitcnt vmcnt(0)" ::: "memory");
        }
    }
    __syncthreads();
}

__global__ void __launch_bounds__(NTHR, 2) mega_fwd(Params p) {
    extern __shared__ __attribute__((aligned(16))) unsigned char lds_raw[];
    LAS unsigned char* lds = (LAS unsigned char*)lds_raw;
    volatile LAS unsigned* xbw = (volatile LAS unsigned*)(lds + LDS_XBW);
    if (threadIdx.x < 4) xbw[threadIdx.x] = 0u;
    __syncthreads();
    XcdBarrier bar = xcd_barrier_post((unsigned*)(p.ws + WS_CTL) + CW_BAR, xbw);
#ifndef DBL
#define DBL 0
#endif
#ifndef SKEWPH
#define SKEWPH -1
#endif
#define RUNPH(i, call) do { call; if constexpr ((DBL >> (i)) & 1) { xcd_barrier(bar); call; } \
    if constexpr (SKEWPH == (i)) { if (threadIdx.x == 0) ((unsigned long long*)(p.ws + WS_CTL + 40960))[blockIdx.x] = wall_clock64(); } } while (0)
    RUNPH(0, phase_prologue(p, lds));  xcd_barrier(bar);
    RUNPH(1, phase_proj(p, lds));      xcd_barrier(bar);
    RUNPH(2, phase_mixers(p, lds));    xcd_barrier(bar);
    RUNPH(3, phase_seqdft(p, lds));    xcd_barrier(bar);
    RUNPH(4, phase_mix(p, lds));       xcd_barrier(bar);
    RUNPH(5, phase_x2(p, lds));        xcd_barrier(bar);
    phase_rows(p, lds);                xcd_barrier(bar);
    RUNPH(7, phase_gateup(p, lds));    xcd_barrier(bar);
    RUNPH(8, phase_down(p, lds));      xcd_barrier(bar);
    phase_out(p, lds);
}
static void run_fast_one(const Params& p, hipStream_t st) {
    static int grid = 0;
    if (!grid) {
        int dev = 0, cus = 0, per_cu = 0;
        (void)hipGetDevice(&dev); (void)hipDeviceGetAttribute(&cus, hipDeviceAttributeMultiprocessorCount, dev);
        (void)hipFuncSetAttribute((const void*)mega_fwd, hipFuncAttributeMaxDynamicSharedMemorySize, LDS_BYTES);
        (void)hipOccupancyMaxActiveBlocksPerMultiprocessor(&per_cu, (const void*)mega_fwd, NTHR, LDS_BYTES);
        if (per_cu < 1) per_cu = 1;
        grid = cus > 256 ? 256 : cus;
        grid &= ~7; if (grid < 8) grid = 8;
    }
    hipLaunchKernelGGL(mega_fwd, dim3(grid), dim3(NTHR), LDS_BYTES, st, p);
}
}
#ifndef REPORT
#define REPORT 0
#endif
extern "C" void kernel_launch(void* const* d_in, const int* in_sizes, int n_in, void* d_out, int out_size, void* d_ws, size_t ws_size, hipStream_t stream) {
    (void)in_sizes; (void)n_in; (void)out_size; (void)ws_size;
    unsigned char* ws = (unsigned char*)d_ws;
#if MODE == 0
    nv::NBuf nb; nv::carve(nb, ws);
    nv::run_part1(d_in, nb, stream); nv::run_part2(d_in, nb, (float*)d_out, stream);
#elif MODE == 1
    constexpr size_t NAIVE_BASE = (fx::WS_FAST_END + 4095) & ~(size_t)4095;
    nv::NBuf nb; const size_t nbytes = nv::carve(nb, ws + NAIVE_BASE);
    float* fout = (float*)(ws + NAIVE_BASE + ((nbytes + 4095) & ~(size_t)4095));
    double* acc = (double*)(fout + (size_t)16384 * 2048); float* scale = (float*)(acc + 64);
    fx::Params p; memset(&p, 0, sizeof(p));
    for (int i = 0; i < 19; ++i) p.in[i] = (const float*)d_in[i];
    p.out = fout; p.ws = ws;
    (void)hipMemsetAsync(ws + fx::WS_CTL, 0, fx::CTL_BYTES, stream);
    (void)hipMemsetAsync(acc, 0, 1024, stream);
    nv::run_part1(d_in, nb, stream);
    fx::run_fast_multi(p, stream, 0, 7);
    auto cmp = [&](int slot, int kind, const void* a, const float* ref, long long n, int w, int ldf, int ldr, int off, int sig) {
        ck::CP c; memset(&c, 0, sizeof(c)); c.a = a; c.ref = ref; c.n = n; c.kind = kind; c.w = w; c.ldf = ldf; c.ldr = ldr; c.off = off; c.sig = sig; c.slot = slot;
        hipLaunchKernelGGL(ck::k_cmp, dim3(2048), dim3(256), 0, stream, c, acc); };
    const long long T = 16384;
    cmp(0, 0, ws + fx::WS_FIN, nb.proj, T * 1024, 1024, 1024, 10752, 0, 0);
    cmp(1, 0, ws + fx::WS_Q, nb.proj, T * 2048, 2048, 2048, 10752, 1024, 0);
    cmp(2, 0, ws + fx::WS_K, nb.proj, T * 256, 256, 256, 10752, 3072, 0);
    cmp(3, 2, ws + fx::WS_VT, nb.proj, T * 256, 0, 0, 0, 0, 0);
    cmp(4, 0, ws + fx::WS_QM, nb.proj, T * 1024, 1024, 1024, 10752, 3584, 0);
    cmp(5, 0, ws + fx::WS_GATES, nb.proj, T * 6144, 6144, 6144, 10752, 4608, 1);
    cmp(6, 0, ws + fx::WS_KMK, nb.kvm, 2048LL * 1024, 1024, 1024, 2048, 0, 0);
    cmp(7, 3, ws + fx::WS_VMT, nb.kvm, 2048LL * 1024, 0, 0, 0, 0, 0);
    cmp(8, 0, ws + fx::WS_ATT, nb.att, T * 2048, 2048, 2048, 2048, 0, 0);
    cmp(9, 0, ws + fx::WS_XM, nb.xm, T * 1024, 1024, 1024, 1024, 0, 0);
    cmp(10, 0, ws + fx::WS_FM, nb.fm, T * 1024, 1024, 1024, 1024, 0, 0);
    cmp(11, 0, ws + fx::WS_MIXED, nb.mixed, T * 2048, 2048, 2048, 2048, 0, 0);
    cmp(12, 1, ws + fx::WS_X2, nb.x2, T * 2048, 2048, 2048, 2048, 0, 0);
    cmp(13, 0, ws + fx::WS_H2, nb.h2, T * 2048, 2048, 2048, 2048, 0, 0);
    hipLaunchKernelGGL(ck::k_cmp_route, dim3(64), dim3(256), 0, stream, (const int*)(ws + fx::WS_TOKE), (const int*)nb.tope, acc, 14);
    nv::run_part2(d_in, nb, nb.nout, stream);
    fx::run_fast_multi(p, stream, 7, 10);
    cmp(15, 1, fout, nb.nout, T * 2048, 2048, 2048, 2048, 0, 0);
    hipLaunchKernelGGL(ck::k_verdict, dim3(1), dim3(64), 0, stream, (const double*)acc, scale, 16, (int)REPORT);
    hipLaunchKernelGGL(ck::k_scale_out, dim3(2048), dim3(256), 0, stream, (const float*)nb.nout, (const float*)scale, (float*)d_out, T * 2048);
#elif MODE == 2
    fx::Params p; memset(&p, 0, sizeof(p));
    for (int i = 0; i < 19; ++i) p.in[i] = (const float*)d_in[i];
    p.out = (float*)d_out; p.ws = ws;
    (void)hipMemsetAsync(ws + fx::WS_CTL, 0, fx::CTL_BYTES, stream);
    fx::run_fast_multi(p, stream, 0, 10);
#elif MODE == 3
    fx::Params p; memset(&p, 0, sizeof(p));
    for (int i = 0; i < 19; ++i) p.in[i] = (const float*)d_in[i];
    p.out = (float*)d_out; p.ws = ws;
    (void)hipMemsetAsync(ws + fx::WS_CTL, 0, fx::CTL_BYTES, stream);
    fx::run_fast_one(p, stream);
#endif
}
```

```cpp
#include <hip/hip_runtime.h>
#include <stdint.h>
#include <string.h>
#ifndef MODE
#define MODE 3
#endif
namespace fx {
#define LAS __attribute__((address_space(3)))
typedef unsigned short bf16_t;
typedef short bf16x8 __attribute__((ext_vector_type(8)));
typedef short s16x4 __attribute__((ext_vector_type(4)));
typedef float f32x4 __attribute__((ext_vector_type(4)));
typedef float f32x16 __attribute__((ext_vector_type(16)));
typedef float f32x2 __attribute__((ext_vector_type(2)));
typedef __bf16 bf16x2_t __attribute__((ext_vector_type(2)));
typedef unsigned u32x4 __attribute__((ext_vector_type(4)));
typedef unsigned u32x2 __attribute__((ext_vector_type(2)));

constexpr int NTHR = 512, NWAVE = 8;
constexpr int B_ = 8, S_ = 2048, DM = 2048, T_ = B_ * S_;
constexpr int MEM = 256, FW = 1024, FG = 4, FGD = 256;
constexpr int NH = 32, NKV = 4, HD = 64, AW = 2048, KVW = 256, WIN = 128;
constexpr int MH = 4, MHD = 256, MW = 1024;
constexpr int NE = 32, TOPK = 4, DFF = 2048;
constexpr int INW = 10752;
#ifndef LDPAD
#define LDPAD 0
#endif
constexpr int LDP = 2048 + LDPAD;
constexpr int NSLOT = T_ * TOPK + NE * 256;
constexpr float LOG2E = 1.4426950408889634f;
#ifndef MOE_FP8
#define MOE_FP8 1
#endif
constexpr bool MOE_F8 = (MOE_FP8 != 0);
#ifndef GATES_FP8
#define GATES_FP8 1
#endif
constexpr bool GATES_F8 = (GATES_FP8 != 0);
#ifndef CONV_TILE32
#define CONV_TILE32 0
#endif
#ifndef MOE_ALIGN
#define MOE_ALIGN true
#endif
#ifndef PROFSEL
#define PROFSEL 0
#endif
#ifndef PROFMETRIC
#define PROFMETRIC 0
#endif
#ifndef PROFMUL
#define PROFMUL 1
#endif
#ifndef PROFBLK
#define PROFBLK 0
#endif

constexpr size_t al256(size_t x) { return (x + 255) & ~(size_t)255; }
constexpr size_t WS_CTL = 0, CTL_BYTES = 65536;
constexpr size_t WS_WINT = 1u << 20;
constexpr size_t WS_WMKVT = WS_WINT + (size_t)INW * LDP * 2;
constexpr size_t WS_WFOT = WS_WMKVT + (size_t)2048 * LDP * 2;
constexpr size_t WS_WAOT = WS_WFOT + (size_t)2048 * 1024 * 2;
constexpr size_t WS_WMOT = WS_WAOT + (size_t)2048 * 2048 * 2;
constexpr size_t WS_WOT = WS_WMOT + (size_t)2048 * 1024 * 2;
constexpr size_t WS_WRT = WS_WOT + (size_t)2048 * 2048 * 2;
constexpr size_t WS_TABT = WS_WRT + (size_t)NE * DM * 2;
constexpr size_t WS_DMAT = WS_TABT + (size_t)512 * 256 * 2;
constexpr size_t WS_WGUT = WS_DMAT + (size_t)2048 * 4096 * 2;
constexpr size_t WS_WDNT = WS_WGUT + (size_t)NE * 4096 * 2048 * 2;
constexpr size_t WS_H = WS_WDNT + (size_t)NE * 2048 * 2048 * 2;
constexpr size_t WS_MEMBF = WS_H + (size_t)T_ * LDP * 2;
constexpr size_t WS_FIN = WS_MEMBF + (size_t)2048 * LDP * 2;
constexpr size_t WS_Q = WS_FIN + (size_t)T_ * FW * 2;
constexpr size_t WS_K = WS_Q + (size_t)T_ * AW * 2;
constexpr size_t WS_VT = WS_K + (size_t)T_ * KVW * 2;
constexpr size_t WS_QM = WS_VT + (size_t)T_ * KVW * 2;
constexpr size_t WS_GATES = WS_QM + (size_t)T_ * MW * 2;
constexpr size_t WS_KMK = WS_GATES + (size_t)T_ * 3 * DM * 2;
constexpr size_t WS_VMT = WS_KMK + (size_t)2048 * 1024 * 2;
constexpr size_t WS_ZT = WS_VMT + (size_t)2048 * 1024 * 2;
constexpr size_t WS_FM = WS_ZT + (size_t)32 * 256 * 4096 * 2;
constexpr size_t WS_ATT = WS_FM + (size_t)T_ * FW * 2;
constexpr size_t WS_PM = WS_ATT + (size_t)T_ * AW * 2;
constexpr size_t WS_XM = WS_PM + (size_t)T_ * MH * 256 * 2;
constexpr size_t WS_MIXACC = WS_XM + (size_t)T_ * MW * 2;
constexpr size_t WS_MIXED = WS_MIXACC + (size_t)T_ * DM * 4;
constexpr size_t WS_FX = WS_MIXACC;
constexpr size_t WS_WFM = WS_MIXACC + (size_t)T_ * 2048 * 2;
static_assert(WS_WFM + (size_t)2048 * 2048 * 2 <= WS_MIXED, "fused-mix operands fit the old mixacc region");
constexpr size_t WS_X2 = WS_MIXED + (size_t)T_ * DM * 2;
constexpr size_t WS_H2 = WS_X2 + (size_t)T_ * DM * 4;
constexpr size_t WS_TOKE = WS_H2 + (size_t)T_ * DM * 2;
constexpr size_t WS_TOKPOS = WS_TOKE + (size_t)T_ * 4 * 4;
constexpr size_t WS_TOKW = WS_TOKPOS + (size_t)T_ * 4 * 4;
constexpr size_t WS_LIST = WS_TOKW + (size_t)T_ * 4 * 4;
constexpr size_t WS_WLIST = WS_LIST + (size_t)NE * T_ * 4;
constexpr size_t WS_WGUQ = WS_WLIST + (size_t)NE * T_ * 4;
constexpr size_t WS_WDNQ = WS_WGUQ + (size_t)NE * 4096 * 2048;
constexpr size_t WS_H2Q = WS_WDNQ + (size_t)NE * 2048 * 2048;
constexpr size_t WS_H8 = WS_H2Q + (size_t)T_ * DM;
constexpr size_t WS_WINQ = WS_H8 + (size_t)T_ * DM;
constexpr size_t WS_FAST_END = WS_WINQ + (size_t)6144 * DM;
constexpr size_t WS_ACTQ = WS_H;
constexpr float WQ_SCALE = 32.0f, WQ_INV = 1.0f / 32.0f;
constexpr float YS_SCALE = 16.0f, YS_INV = 1.0f / 16.0f;
constexpr size_t WS_ACT = WS_H;
constexpr size_t WS_YS = WS_ACT + (size_t)NSLOT * DFF * 2;
static_assert(WS_YS + (size_t)NSLOT * DM * 2 <= WS_MIXED, "overlay fits");
constexpr int CW_CNT = 0;
constexpr int CW_POOL = 64;
constexpr int CW_BAR = 4096;

constexpr int LDS_STAGE = 0, STAGE_BYTES = 131072;
constexpr int LDS_TOKL = 131072;
constexpr int LDS_MISC = 141312;
constexpr int LDS_BTAB = 142336;
constexpr int LDS_XBW = 163824;
constexpr int LDS_BYTES = 163840;

struct Params {
    const float* in[19]; float* out; unsigned char* ws;
};

__device__ __forceinline__ unsigned cvtpk(float lo, float hi) { f32x2 v = {lo, hi}; bf16x2_t b = __builtin_convertvector(v, bf16x2_t); return __builtin_bit_cast(unsigned, b); }
__device__ __forceinline__ float bf2f(unsigned short x) { return __uint_as_float(((unsigned)x) << 16); }
__device__ __forceinline__ float bflo(unsigned w) { return __uint_as_float(w << 16); }
__device__ __forceinline__ float bfhi(unsigned w) { return __uint_as_float(w & 0xffff0000u); }
__device__ __forceinline__ float wsum(float v) {
#pragma unroll
    for (int o = 1; o < 64; o <<= 1) v += __shfl_xor(v, o);
    return v;
}
__device__ __forceinline__ float sigmoid_sc(float x, float nsc) { return __builtin_amdgcn_rcpf(1.0f + __builtin_amdgcn_exp2f(x * nsc)); }
__device__ __forceinline__ float sigmoidf_(float x) { return __builtin_amdgcn_rcpf(1.0f + __builtin_amdgcn_exp2f(-x * LOG2E)); }
__device__ __forceinline__ int crow(int r, int h) { return (r & 3) + 8 * (r >> 2) + 4 * h; }
__device__ __forceinline__ int t5_bucket(int rel) {
    const int n = rel < 0 ? -rel : rel;
    int b;
    if (n < 8) b = n; else if (n < 12) b = 8; else if (n < 16) b = 9; else if (n < 23) b = 10; else if (n < 32) b = 11;
    else if (n < 46) b = 12; else if (n < 64) b = 13; else if (n < 91) b = 14; else b = 15;
    return (rel > 0 ? 16 : 0) + b;
}
__device__ __forceinline__ int vwg() { const int c = blockIdx.x, G = gridDim.x; return ((G & 7) == 0) ? (c & 7) * (G >> 3) + (c >> 3) : c; }

constexpr int BM = 256, BK = 64, HALF = 128, HTB = HALF * BK * 2;
__host__ __device__ __forceinline__ int lds_byte(int r, int c) { const int st = (r >> 4) * 2 + (c >> 5), rr = r & 15, cc = c & 31, ob = rr * 64 + cc * 2; return st * 1024 + (ob ^ (((ob >> 9) & 1) << 5)); }
__host__ __device__ __forceinline__ void stage_rc(int b, int& R, int& C) { const int st = b / 1024, sb = b % 1024, swz = sb ^ (((sb >> 9) & 1) << 5); R = (st >> 1) * 16 + swz / 64; C = (st & 1) * 32 + (swz % 64) / 2; }
__host__ __device__ __forceinline__ int perm32(int rho) { const int n = rho >> 4, i = rho & 15; return 8 * (i >> 2) + 4 * n + (i & 3); }

struct Unit { int pm, pn, z, idx; };
template <class S, class = void> struct SchedVarK { static constexpr bool v = false; };
template <class S> struct SchedVarK<S, decltype((void)S::VARK)> { static constexpr bool v = S::VARK; };
template <class E, class = void> struct EpiKeep { static constexpr bool v = false; };
template <class E> struct EpiKeep<E, decltype((void)E::KEEP)> { static constexpr bool v = E::KEEP; };
typedef int v4i_t __attribute__((ext_vector_type(4)));
typedef int v8i_t __attribute__((ext_vector_type(8)));
__device__ __forceinline__ void mfma_f8(f32x4& c, const v8i_t& a, const v8i_t& b) { asm volatile("v_mfma_f32_16x16x128_f8f6f4 %0, %1, %2, %0" : "+v"(c) : "v"(a), "v"(b)); }
template <int ESZ> struct FragT;
template <> struct FragT<2> { struct A4 { bf16x8 v[4][2]; }; struct B2 { bf16x8 v[2][2]; }; };
template <> struct FragT<1> { struct A4 { v8i_t v[4]; }; struct B2 { v8i_t v[2]; }; };
__device__ __forceinline__ v8i_t cat8(bf16x8 a, bf16x8 b) { return __builtin_shufflevector(__builtin_bit_cast(v4i_t, a), __builtin_bit_cast(v4i_t, b), 0, 1, 2, 3, 4, 5, 6, 7); }

template <class Epi, class Sched, bool ALIGN_EPI, int ESZ = 2  >
__device__ __forceinline__ void gemm_phase(LAS unsigned char* lds, const int K, const int lda, const int ldb, const Sched& S, const Epi& E, unsigned long long* prof = nullptr) {
    unsigned long long pf_kl = 0, pf_ep = 0, pf_t0 = 0, pf_t1 = 0, pf_n = 0; const unsigned long long pf_w0 = prof ? wall_clock64() : 0ull, pf_c0 = prof ? clock64() : 0ull;
    int tid_ = threadIdx.x; asm volatile("" : "+v"(tid_));
    const int tid = tid_, wid = __builtin_amdgcn_readfirstlane(tid >> 6), lane = tid & 63, wr = wid >> 2, wc = wid & 3, fr = lane & 15, fq = lane >> 4;
    const int nt = (K * ESZ) / (BK * 2);
    constexpr bool GATHER = Sched::GATHER;
    unsigned voffA[2], voffB[2]; int Rr[2], Cb[2];
#pragma unroll
    for (int i = 0; i < 2; ++i) { int R, C; stage_rc(tid * 16 + i * 8192, R, C);
        int Rb = R;
        if constexpr ((int)Epi::PERM == 1) Rb = (R & ~31) + perm32(R & 31);
        if constexpr ((int)Epi::PERM == 2) Rb = 64 * (R >> 5) + 16 * ((R >> 2) & 3) + 4 * ((R >> 4) & 1) + (R & 3);
        voffA[i] = (unsigned)(R * lda * ESZ + C * 2); voffB[i] = (unsigned)(Rb * ldb * ESZ + C * 2); Rr[i] = R; Cb[i] = C * 2; }
    const size_t kstep = (size_t)(BK * 2);
    const size_t hstepA = (size_t)HALF * lda * ESZ, hstepB = (size_t)(((int)Epi::PERM == 2) ? 8 : HALF) * ldb * ESZ;
    const unsigned ldsw = (unsigned)wid * 1024u;
    const int aoff = lds_byte(wr * 64 + fr, fq * 8), boff = lds_byte(wc * 32 + fr, fq * 8);
#define PG8_SA(b, h) (((b) * 2 + (h)) * HTB)
#define PG8_SB(b, h) ((4 + (b) * 2 + (h)) * HTB)
#define PG8_STAGE(bufoff, gbase, voff) do { _Pragma("unroll") for (int _i = 0; _i < 2; ++_i) \
        __builtin_amdgcn_global_load_lds((const unsigned*)((const char*)(gbase) + (voff)[_i]), (LAS unsigned*)(lds + (bufoff) + ldsw + _i * 8192), 16, 0, 0); } while (0)
#define PG8_STAGE_A(bufoff, gbase, h, NX) do { if constexpr (GATHER) { _Pragma("unroll") for (int _i = 0; _i < 2; ++_i) { const unsigned _o = (NX) ? naoff[h][_i] : caoff[h][_i]; \
        __builtin_amdgcn_global_load_lds((const unsigned*)((const char*)(gbase) + _o), (LAS unsigned*)(lds + (bufoff) + ldsw + _i * 8192), 16, 0, 0); } } \
        else { PG8_STAGE(bufoff, (const char*)(gbase) + (h) * hstepA, voffA); } } while (0)
#define PG8_LDA(dst, b, h) do { _Pragma("unroll") for (int m = 0; m < 4; ++m) { if constexpr (ESZ == 2) { _Pragma("unroll") for (int k = 0; k < 2; ++k) dst.v[m][k] = *(const LAS bf16x8*)(lds + PG8_SA(b, h) + aoff + m * 2048 + k * 1024); } \
        else { const v4i_t _lo = *(const LAS v4i_t*)(lds + PG8_SA(b, h) + aoff + m * 2048), _hi = *(const LAS v4i_t*)(lds + PG8_SA(b, h) + aoff + m * 2048 + 1024); dst.v[m] = __builtin_shufflevector(_lo, _hi, 0, 1, 2, 3, 4, 5, 6, 7); } } } while (0)
#define PG8_LDB(dst, b, h) do { _Pragma("unroll") for (int n = 0; n < 2; ++n) { if constexpr (ESZ == 2) { _Pragma("unroll") for (int k = 0; k < 2; ++k) dst.v[n][k] = *(const LAS bf16x8*)(lds + PG8_SB(b, h) + boff + n * 2048 + k * 1024); } \
        else { const v4i_t _lo = *(const LAS v4i_t*)(lds + PG8_SB(b, h) + boff + n * 2048), _hi = *(const LAS v4i_t*)(lds + PG8_SB(b, h) + boff + n * 2048 + 1024); dst.v[n] = __builtin_shufflevector(_lo, _hi, 0, 1, 2, 3, 4, 5, 6, 7); } } } while (0)
#define PG8_MMA(ai, bj, At, Bt) do { __builtin_amdgcn_s_setprio(1); _Pragma("unroll") for (int m = 0; m < 4; ++m) _Pragma("unroll") for (int n = 0; n < 2; ++n) { \
        if constexpr (ESZ == 2) { _Pragma("unroll") for (int k = 0; k < 2; ++k) acc[ai][bj][m][n] = __builtin_amdgcn_mfma_f32_16x16x32_bf16(Bt.v[n][k], At.v[m][k], acc[ai][bj][m][n], 0, 0, 0); } \
        else { mfma_f8(acc[ai][bj][m][n], Bt.v[n], At.v[m]); } } \
        __builtin_amdgcn_s_setprio(0); } while (0)
#define PG8_WAIT_V(n) asm volatile("s_waitcnt vmcnt(" #n ")" ::: "memory")
#define PG8_WAIT_V8R do { if (relax) asm volatile("s_waitcnt vmcnt(%0)" :: "n"(8 + Epi::NSTORE) : "memory"); else PG8_WAIT_V(8); } while (0)
#define PG8_WAIT_L(n) asm volatile("s_waitcnt lgkmcnt(" #n ")" ::: "memory")
#define PG8_BAR __builtin_amdgcn_s_barrier()
#define PG8_SCHED __builtin_amdgcn_sched_barrier(0)
    Unit cur, nxt; int ui = 0;
    if (!S.next(0, cur)) return;
    f32x4 acc[2][2][4][2];
#pragma unroll
    for (int a = 0; a < 2; ++a)
#pragma unroll
        for (int b = 0; b < 2; ++b)
#pragma unroll
            for (int m = 0; m < 4; ++m)
#pragma unroll
                for (int n = 0; n < 2; ++n) acc[a][b][m][n] = (f32x4){0.f, 0.f, 0.f, 0.f};
    typedef typename FragT<ESZ>::A4 FragA; typedef typename FragT<ESZ>::B2 FragB;
    FragA At; FragB B0, B1;
    unsigned caoff[2][2] = {{0u, 0u}, {0u, 0u}}, naoff[2][2] = {{0u, 0u}, {0u, 0u}};
    if constexpr (GATHER) {
#pragma unroll
        for (int h = 0; h < 2; ++h)
#pragma unroll
            for (int i = 0; i < 2; ++i) { caoff[h][i] = S.arow(cur, h * HALF + Rr[i]) + (unsigned)Cb[i]; naoff[h][i] = caoff[h][i]; }
    }
    const char* cA = S.baseA(cur); const char* cB = S.baseB(cur);
    PG8_STAGE(PG8_SB(0, 0), cB, voffB); PG8_STAGE(PG8_SB(0, 1), cB + hstepB, voffB); PG8_STAGE_A(PG8_SA(0, 0), cA, 0, false); PG8_STAGE_A(PG8_SA(0, 1), cA, 1, false);
    if (wr == 1) PG8_BAR;
    PG8_WAIT_V(2); PG8_BAR;
    PG8_STAGE(PG8_SB(1, 0), cB + kstep, voffB); PG8_STAGE_A(PG8_SA(1, 0), cA + kstep, 0, false); PG8_STAGE(PG8_SB(1, 1), cB + hstepB + kstep, voffB);
    PG8_WAIT_V(6); PG8_BAR;
    for (;;) {
        const bool has_next = S.next(ui + 1, nxt);
        const char* nA = has_next ? S.baseA(nxt) : cA; const char* nB = has_next ? S.baseB(nxt) : cB;
        if constexpr (GATHER) {
            if (has_next) {
#pragma unroll
                for (int h = 0; h < 2; ++h)
#pragma unroll
                    for (int i = 0; i < 2; ++i) naoff[h][i] = S.arow(nxt, h * HALF + Rr[i]) + (unsigned)Cb[i];
            } else {
#pragma unroll
                for (int h = 0; h < 2; ++h)
#pragma unroll
                    for (int i = 0; i < 2; ++i) naoff[h][i] = caoff[h][i];
            }
        }
        if (prof) pf_t0 = clock64();
        int ntu = nt; if constexpr (SchedVarK<Sched>::v) ntu = S.ktiles(cur);
#pragma unroll 1
        for (int t = 0; t < ntu; t += 2) {
            const bool last = (t == ntu - 2);
            const bool relax = (Epi::NSTORE > 0) && (t == 0) && (ui > 0);
            const char* a1 = cA + (size_t)(t + 1) * kstep;
            const char* a2 = last ? nA : cA + (size_t)(t + 2) * kstep; const char* b2 = last ? nB : cB + (size_t)(t + 2) * kstep;
            const char* a3 = a2 + kstep; const char* b3 = b2 + kstep;
            PG8_LDB(B0, 0, 0); PG8_LDB(B1, 0, 1); PG8_SCHED; PG8_LDA(At, 0, 0); PG8_STAGE_A(PG8_SA(1, 1), a1, 1, false);
            PG8_WAIT_V(8); PG8_WAIT_L(0); PG8_BAR; PG8_MMA(0, 0, At, B0); PG8_MMA(0, 1, At, B1); PG8_BAR; PG8_SCHED;
            PG8_LDA(At, 0, 1); PG8_STAGE(PG8_SB(0, 0), b2, voffB); PG8_STAGE(PG8_SB(0, 1), b2 + hstepB, voffB); PG8_STAGE_A(PG8_SA(0, 0), a2, 0, last);
            PG8_WAIT_V(8); PG8_WAIT_L(0); PG8_BAR; PG8_MMA(1, 0, At, B0); PG8_MMA(1, 1, At, B1); PG8_BAR; PG8_SCHED;
            PG8_LDB(B0, 1, 0); PG8_LDB(B1, 1, 1); PG8_SCHED; PG8_LDA(At, 1, 0); PG8_STAGE_A(PG8_SA(0, 1), a2, 1, last);
            PG8_WAIT_V(8); PG8_WAIT_L(0); PG8_BAR; PG8_MMA(0, 0, At, B0); PG8_MMA(0, 1, At, B1); PG8_BAR; PG8_SCHED;
            PG8_LDA(At, 1, 1); PG8_STAGE(PG8_SB(1, 0), b3, voffB); PG8_STAGE(PG8_SB(1, 1), b3 + hstepB, voffB); PG8_STAGE_A(PG8_SA(1, 0), a3, 0, last);
            PG8_WAIT_V(8); PG8_WAIT_L(0); PG8_BAR; PG8_MMA(1, 0, At, B0); PG8_MMA(1, 1, At, B1); PG8_BAR; PG8_SCHED;
        }
        if (prof) { pf_t1 = clock64(); pf_kl += pf_t1 - pf_t0; }
        if constexpr (ESZ == 1) asm volatile("s_nop 15\n\ts_nop 15" ::: "memory");
        if constexpr (ALIGN_EPI) { if (wr == 0) PG8_BAR; }
        if constexpr (!Epi::AFTER_DRAIN) { int fr_e = fr, fq_e = fq; asm volatile("" : "+v"(fr_e), "+v"(fq_e));
            E(acc, cur, wr, wc, fr_e, fq_e); }
        if (prof) { pf_ep += clock64() - pf_t1; ++pf_n; }
        if (!has_next) break;
        bool zero = true; if constexpr (EpiKeep<Epi>::v) zero = !E.keep(cur);
        if (zero) {
#pragma unroll
        for (int a = 0; a < 2; ++a)
#pragma unroll
            for (int b = 0; b < 2; ++b)
#pragma unroll
                for (int m = 0; m < 4; ++m)
#pragma unroll
                    for (int n = 0; n < 2; ++n) acc[a][b][m][n] = (f32x4){0.f, 0.f, 0.f, 0.f};
        }
        cur = nxt; cA = nA; cB = nB; ++ui;
        if constexpr (GATHER) {
#pragma unroll
            for (int h = 0; h < 2; ++h)
#pragma unroll
                for (int i = 0; i < 2; ++i) caoff[h][i] = naoff[h][i];
        }
        if constexpr (ALIGN_EPI) { if (wr == 1) PG8_BAR; }
    }
    PG8_WAIT_V(0);
    if constexpr (!ALIGN_EPI) { if (wr == 0) PG8_BAR; }
    PG8_BAR;
    if (prof && blockIdx.x == PROFBLK && tid == 0) { prof[0] = pf_kl; prof[1] = pf_ep; prof[2] = pf_n; prof[3] = (unsigned long long)nt; prof[4] = clock64() - pf_c0; prof[5] = wall_clock64() - pf_w0; }
    if constexpr (Epi::AFTER_DRAIN) { int fr_e = fr, fq_e = fq; asm volatile("" : "+v"(fr_e), "+v"(fq_e)); E.fused(acc, cur, wr, wc, fr_e, fq_e, lds, wid, lane); }
#undef PG8_SA
#undef PG8_SB
#undef PG8_STAGE
#undef PG8_STAGE_A
#undef PG8_LDA
#undef PG8_LDB
#undef PG8_MMA
#undef PG8_WAIT_V
#undef PG8_WAIT_V8R
#undef PG8_WAIT_L
#undef PG8_BAR
#undef PG8_SCHED
}
constexpr int NXCD = 8;
#ifndef PROJ_WGM
#define PROJ_WGM 8
#endif
__device__ __forceinline__ void static_tile(int L, int nM, int nN, int& pm, int& pn, const int WGM = 8) {
    const int nwg = nM * nN; int wgid = L;
    { const int q = nwg / NXCD, r = nwg % NXCD, xcd = wgid % NXCD, off = wgid / NXCD; wgid = (xcd < r ? xcd * (q + 1) : r * (q + 1) + (xcd - r) * q) + off; }
    const int nig = WGM * nN, gid = wgid / nig, fm = gid * WGM, gsz = (nM - fm) < WGM ? (nM - fm) : WGM;
    pm = fm + ((wgid % nig) % gsz); pn = (wgid % nig) / gsz;
}
struct SchedPlain {
    static constexpr bool GATHER = false;
    const char* A; const char* Bt; size_t tstepA, tstepB; int nM, nN; int r0 = 0, r1 = 1 << 20;
    __device__ __forceinline__ bool next(int i, Unit& u) const { const int k = i + r0; if (k >= r1) return false;
        const int L = k * (int)gridDim.x + (int)blockIdx.x; if (L >= nM * nN) return false; static_tile(L, nM, nN, u.pm, u.pn); u.z = 0; return true; }
    __device__ __forceinline__ const char* baseA(const Unit& u) const { return A + (size_t)u.pm * tstepA; }
    __device__ __forceinline__ const char* baseB(const Unit& u) const { return Bt + (size_t)u.pn * tstepB; }
    __device__ __forceinline__ unsigned arow(const Unit&, int) const { return 0u; }
};
struct SchedProj {
    static constexpr bool GATHER = false;
    const unsigned char* ws; int r0, r1;
    __device__ __forceinline__ bool next(int i, Unit& u) const {
        if (i + r0 >= r1) return false;
        const int L = (i + r0) * (int)gridDim.x + (int)blockIdx.x;
        constexpr int NPB = GATES_F8 ? 18 : 42;
        if (L < 64 * NPB) { static_tile(L, 64, NPB, u.pm, u.pn, PROJ_WGM); u.z = (u.pn == 13) ? 2 : 0; return true; }
        const int L2 = L - 64 * NPB; if (L2 >= 64) return false;
        if (L2 < 32) { u.pm = L2 & 7; u.pn = L2 >> 3; u.z = 1; } else { u.pm = (L2 - 32) & 3; u.pn = (L2 - 32) >> 2; u.z = 3; }
        return true;
    }
    __device__ __forceinline__ const char* baseA(const Unit& u) const {
        const size_t ts = (size_t)256 * LDP * 2;
        if (u.z == 0) return (const char*)ws + WS_H + (size_t)u.pm * ts;
        if (u.z == 2) return (const char*)ws + WS_WINT + (size_t)13 * ts;
        if (u.z == 1) return (const char*)ws + WS_MEMBF + (size_t)u.pm * ts;
        return (const char*)ws + WS_WMKVT + (size_t)(4 + u.pm) * ts;
    }
    __device__ __forceinline__ const char* baseB(const Unit& u) const {
        const size_t ts = (size_t)256 * LDP * 2;
        if (u.z == 0) return (const char*)ws + WS_WINT + (size_t)u.pn * ts;
        if (u.z == 2) return (const char*)ws + WS_H + (size_t)u.pm * ts;
        if (u.z == 1) return (const char*)ws + WS_WMKVT + (size_t)u.pn * ts;
        return (const char*)ws + WS_MEMBF + (size_t)u.pn * ts;
    }
    __device__ __forceinline__ unsigned arow(const Unit&, int) const { return 0u; }
};
struct SchedGates8 {
    static constexpr bool GATHER = false;
    const unsigned char* ws; int r0, r1;
    __device__ __forceinline__ bool next(int i, Unit& u) const {
        if (i + r0 >= r1) return false;
        const int L = (i + r0) * (int)gridDim.x + (int)blockIdx.x; if (L >= 64 * 24) return false;
        static_tile(L, 64, 24, u.pm, u.pn, PROJ_WGM); u.z = 0; return true;
    }
    __device__ __forceinline__ const char* baseA(const Unit& u) const { return (const char*)ws + WS_H8 + (size_t)u.pm * (256 * 2048); }
    __device__ __forceinline__ const char* baseB(const Unit& u) const { return (const char*)ws + WS_WINQ + (size_t)u.pn * (256 * 2048); }
    __device__ __forceinline__ unsigned arow(const Unit&, int) const { return 0u; }
};
struct SchedChan {
    static constexpr bool GATHER = false;
    const unsigned char* ws; int u0, nu;
    __device__ __forceinline__ bool next(int i, Unit& u) const {
        const int L = i * (int)gridDim.x + vwg(); if (L >= 512) return false;
        u.z = L >> 4; u.pm = (L >> 3) & 1; u.pn = L & 7; return true;
    }
    __device__ __forceinline__ const char* baseA(const Unit& u) const { return (const char*)ws + WS_TABT + (size_t)u.pm * (256 * 256 * 2); }
    __device__ __forceinline__ const char* baseB(const Unit& u) const { const int b = u.z >> 2, g = u.z & 3; return (const char*)ws + WS_FIN + ((size_t)(b * 2048 + u.pn * 256) * 1024 + g * 256) * 2; }
    __device__ __forceinline__ unsigned arow(const Unit&, int) const { return 0u; }
};
struct SchedSeq {
    static constexpr bool GATHER = false;
    const unsigned char* ws;
    __device__ __forceinline__ bool next(int i, Unit& u) const {
        const int L = i * (int)gridDim.x + vwg(); if (L >= 256) return false;
        u.z = L >> 3; u.pm = L & 7; u.pn = 0; return true;
    }
    __device__ __forceinline__ const char* baseA(const Unit& u) const { return (const char*)ws + WS_DMAT + (size_t)u.pm * (256 * 4096 * 2); }
    __device__ __forceinline__ const char* baseB(const Unit& u) const { return (const char*)ws + WS_ZT + (size_t)u.z * (256 * 4096 * 2); }
    __device__ __forceinline__ unsigned arow(const Unit&, int) const { return 0u; }
};
struct SchedOne {
    static constexpr bool GATHER = false;
    const char* A; const char* Bt; int z; bool valid;
    __device__ __forceinline__ bool next(int i, Unit& u) const { if (i != 0 || !valid) return false; u.pm = 0; u.pn = 0; u.z = z; return true; }
    __device__ __forceinline__ const char* baseA(const Unit&) const { return A; }
    __device__ __forceinline__ const char* baseB(const Unit&) const { return Bt; }
    __device__ __forceinline__ unsigned arow(const Unit&, int) const { return 0u; }
};
template <bool GATH, int NT  , bool F8>
struct SchedMoe {
    static constexpr bool GATHER = GATH;
    static constexpr int ES = F8 ? 1 : 2;
    const unsigned char* ws; const LAS int* pt; const LAS int* cn; int same = 0;
    int r0 = 0, r1 = 1 << 20;
    __device__ __forceinline__ int ptu(int k) const { return __builtin_amdgcn_readfirstlane(pt[k]); }
    __device__ __forceinline__ bool next(int i, Unit& u) const {
        const int k = i + r0; if (k >= r1) return false;
        const int L = k * (int)gridDim.x + vwg(); const int total = ptu(NE) * NT; if (L >= total) return false;
        const int ln = (int)(threadIdx.x & 63);
        const unsigned long long bal = __ballot(ln < NE && L >= pt[ln & 31] * NT);
        const int e = __builtin_amdgcn_readfirstlane(__popcll(bal) - 1);
        const int t = L - ptu(e) * NT, mte = ptu(e + 1) - ptu(e);
        u.z = e; u.pm = t % mte; u.pn = t / mte; u.idx = k; return true;
    }
    __device__ __forceinline__ const char* baseA(const Unit& u) const {
        if constexpr (GATH) return (const char*)ws + (F8 ? WS_H2Q : WS_H2);
        else return (const char*)ws + (F8 ? WS_ACTQ : WS_ACT) + (same ? (size_t)0 : (size_t)(ptu(u.z) + u.pm) * (256 * 2048 * ES));
    }
    __device__ __forceinline__ const char* baseB(const Unit& u) const {
        if constexpr (GATH) return (const char*)ws + (F8 ? WS_WGUQ : WS_WGUT) + ((size_t)u.z * 4096 + (size_t)u.pn * 256) * (2048 * ES);
        else return (const char*)ws + (F8 ? WS_WDNQ : WS_WDNT) + (same ? (size_t)0 : ((size_t)u.z * 2048 + (size_t)u.pn * 256) * (2048 * ES));
    }
    __device__ __forceinline__ unsigned arow(const Unit& u, int r) const {
        const LAS unsigned short* tokl = (const LAS unsigned short*)((const LAS unsigned char*)pt - LDS_MISC + LDS_TOKL);
        return (unsigned)tokl[u.idx * 256 + r] * (unsigned)(2048 * ES);
    }
};

__device__ __forceinline__ void store_tile_bf16(const f32x4 (&acc)[2][2][4][2], bf16_t* dst  , size_t ldc, int wr, int wc, int fr, int fq) {
    const int row0 = wr * 64 + fr, col0 = wc * 32 + 8 * fq;
#pragma unroll
    for (int ai = 0; ai < 2; ++ai)
#pragma unroll
        for (int m = 0; m < 4; ++m) { bf16_t* rowp = dst + (size_t)(row0 + ai * HALF + m * 16) * ldc + col0;
#pragma unroll
            for (int bj = 0; bj < 2; ++bj) { const f32x4 v0 = acc[ai][bj][m][0], v1 = acc[ai][bj][m][1];
                u32x4 w; w.x = cvtpk(v0[0], v0[1]); w.y = cvtpk(v0[2], v0[3]); w.z = cvtpk(v1[0], v1[1]); w.w = cvtpk(v1[2], v1[3]);
                *(u32x4*)(rowp + bj * HALF) = w; } }
}
struct EpiProj {
    static constexpr bool PERM = true, AFTER_DRAIN = false; static constexpr int NSTORE = 16;
    unsigned char* ws;
    __device__ __forceinline__ void operator()(const f32x4 (&acc)[2][2][4][2], const Unit& u, int wr, int wc, int fr, int fq) const {
        const int pn = u.pn, pm = u.pm;
        bf16_t* dst; size_t ldc;
        if (u.z == 0) {
            if (pn >= 18) {
                dst = (bf16_t*)(ws + WS_GATES) + (size_t)pm * 256 * 6144 + (pn - 18) * 256;
                const int row0 = wr * 64 + fr, col0 = wc * 32 + 8 * fq;
#pragma unroll
                for (int ai = 0; ai < 2; ++ai)
#pragma unroll
                    for (int m = 0; m < 4; ++m) { bf16_t* rowp = dst + (size_t)(row0 + ai * HALF + m * 16) * 6144 + col0;
#pragma unroll
                        for (int bj = 0; bj < 2; ++bj) { const f32x4 v0 = acc[ai][bj][m][0], v1 = acc[ai][bj][m][1];
                            u32x4 w; w.x = cvtpk(sigmoidf_(v0[0]), sigmoidf_(v0[1])); w.y = cvtpk(sigmoidf_(v0[2]), sigmoidf_(v0[3]));
                            w.z = cvtpk(sigmoidf_(v1[0]), sigmoidf_(v1[1])); w.w = cvtpk(sigmoidf_(v1[2]), sigmoidf_(v1[3]));
                            *(u32x4*)(rowp + bj * HALF) = w; } }
                return;
            }
            if (pn < 4) { dst = (bf16_t*)(ws + WS_FIN) + pn * 256; ldc = 1024; }
            else if (pn < 12) { dst = (bf16_t*)(ws + WS_Q) + (pn - 4) * 256; ldc = 2048; }
            else if (pn == 12) { dst = (bf16_t*)(ws + WS_K); ldc = 256; }
            else { dst = (bf16_t*)(ws + WS_QM) + (pn - 14) * 256; ldc = 1024; }
            dst += (size_t)pm * 256 * ldc;
        } else if (u.z == 2) {
            dst = (bf16_t*)(ws + WS_VT) + (size_t)(pm >> 3) * 256 * 2048 + (size_t)(pm & 7) * 256; ldc = 2048;
        } else if (u.z == 1) {
            dst = (bf16_t*)(ws + WS_KMK) + (size_t)pm * 256 * 1024 + pn * 256; ldc = 1024;
        } else {
            dst = (bf16_t*)(ws + WS_VMT) + (size_t)(pn * 4 + pm) * 256 * 256; ldc = 256;
        }
        store_tile_bf16(acc, dst, ldc, wr, wc, fr, fq);
    }
};
__device__ __forceinline__ unsigned pk_u8x4(float a, float b, float c, float d) {
    const unsigned x = (unsigned)(a * 255.0f + 0.5f), y = (unsigned)(b * 255.0f + 0.5f), z = (unsigned)(c * 255.0f + 0.5f), w = (unsigned)(d * 255.0f + 0.5f);
    return x | (y << 8) | (z << 16) | (w << 24); }
struct EpiGates8 {
    static constexpr int PERM = 2; static constexpr bool AFTER_DRAIN = false; static constexpr int NSTORE = 8;
    unsigned char* ws;
    __device__ __forceinline__ void operator()(const f32x4 (&acc)[2][2][4][2], const Unit& u, int wr, int wc, int fr, int fq) const {
        unsigned char* dst = ws + WS_GATES + (size_t)u.pm * 256 * 6144 + u.pn * 256;
        const int row0 = wr * 64 + fr, col0 = wc * 64 + 16 * fq;
#pragma unroll
        for (int ai = 0; ai < 2; ++ai)
#pragma unroll
            for (int m = 0; m < 4; ++m) {
                u32x4 w;
                { const f32x4 a = acc[ai][0][m][0] * WQ_INV, c = acc[ai][0][m][1] * WQ_INV;
                  w.x = pk_u8x4(sigmoidf_(a[0]), sigmoidf_(a[1]), sigmoidf_(a[2]), sigmoidf_(a[3])); w.y = pk_u8x4(sigmoidf_(c[0]), sigmoidf_(c[1]), sigmoidf_(c[2]), sigmoidf_(c[3])); }
                { const f32x4 a = acc[ai][1][m][0] * WQ_INV, c = acc[ai][1][m][1] * WQ_INV;
                  w.z = pk_u8x4(sigmoidf_(a[0]), sigmoidf_(a[1]), sigmoidf_(a[2]), sigmoidf_(a[3])); w.w = pk_u8x4(sigmoidf_(c[0]), sigmoidf_(c[1]), sigmoidf_(c[2]), sigmoidf_(c[3])); }
                *(u32x4*)(dst + (size_t)(row0 + ai * HALF + m * 16) * 6144 + col0) = w; }
    }
};
struct EpiChan {
    static constexpr bool PERM = true, AFTER_DRAIN = false; static constexpr int NSTORE = 0;
    unsigned char* ws;
    __device__ __forceinline__ void operator()(const f32x4 (&acc)[2][2][4][2], const Unit& u, int wr, int wc, int fr, int fq) const {
        store_tile_bf16(acc, (bf16_t*)(ws + WS_ZT) + (size_t)u.z * 256 * 4096 + (size_t)u.pm * 2048 + u.pn * 256, 4096, wr, wc, fr, fq);
    }
};
struct EpiSeq {
    static constexpr bool PERM = true, AFTER_DRAIN = false; static constexpr int NSTORE = 0;
    unsigned char* ws;
    __device__ __forceinline__ void operator()(const f32x4 (&acc)[2][2][4][2], const Unit& u, int wr, int wc, int fr, int fq) const {
        const int b = u.z >> 2, g = u.z & 3;
        store_tile_bf16(acc, (bf16_t*)(ws + WS_FX) + (size_t)(b * 2048 + u.pm * 256) * 2048 + g * 256, 2048, wr, wc, fr, fq);
    }
};
template <int STEP> struct EpiMix {
    static constexpr int PERM = 1; static constexpr bool AFTER_DRAIN = false; static constexpr int NSTORE = 16;
    unsigned char* ws;
    __device__ __forceinline__ void operator()(const f32x4 (&acc)[2][2][4][2], const Unit& u, int wr, int wc, int fr, int fq) const {
        const int row0 = u.pm * 256 + wr * 64 + fr, col0 = u.pn * 256 + wc * 32 + 8 * fq;
        const bf16_t* gates = (const bf16_t*)(ws + WS_GATES) + STEP * 2048; const unsigned char* gates8 = ws + WS_GATES + STEP * 2048;
        bf16_t* macc = (bf16_t*)(ws + WS_MIXACC); bf16_t* mixed = (bf16_t*)(ws + WS_MIXED);
#pragma unroll
        for (int ai = 0; ai < 2; ++ai) {
            u32x2 g8[4][2]; u32x4 gw[4][2]; u32x4 mw[4][2];
#pragma unroll
            for (int m = 0; m < 4; ++m) { const size_t row = (size_t)(row0 + ai * HALF + m * 16);
#pragma unroll
                for (int bj = 0; bj < 2; ++bj) { const int col = col0 + bj * HALF;
                    if constexpr (GATES_F8) g8[m][bj] = *(const u32x2*)(gates8 + row * 6144 + col); else gw[m][bj] = *(const u32x4*)(gates + row * 6144 + col);
                    if (STEP > 0) mw[m][bj] = *(const u32x4*)(macc + row * 2048 + col); } }
#pragma unroll
            for (int m = 0; m < 4; ++m) { const size_t row = (size_t)(row0 + ai * HALF + m * 16);
#pragma unroll
                for (int bj = 0; bj < 2; ++bj) { const int col = col0 + bj * HALF;
                    f32x4 v0 = acc[ai][bj][m][0], v1 = acc[ai][bj][m][1];
                    if constexpr (GATES_F8) { const u32x2 g = g8[m][bj]; const float k = 1.0f / 255.0f;
                        v0[0] *= (float)(g.x & 255u) * k; v0[1] *= (float)((g.x >> 8) & 255u) * k; v0[2] *= (float)((g.x >> 16) & 255u) * k; v0[3] *= (float)(g.x >> 24) * k;
                        v1[0] *= (float)(g.y & 255u) * k; v1[1] *= (float)((g.y >> 8) & 255u) * k; v1[2] *= (float)((g.y >> 16) & 255u) * k; v1[3] *= (float)(g.y >> 24) * k; }
                    else { const u32x4 g = gw[m][bj];
                        v0[0] *= bflo(g.x); v0[1] *= bfhi(g.x); v0[2] *= bflo(g.y); v0[3] *= bfhi(g.y);
                        v1[0] *= bflo(g.z); v1[1] *= bfhi(g.z); v1[2] *= bflo(g.w); v1[3] *= bfhi(g.w); }
                    if (STEP > 0) { const u32x4 q = mw[m][bj];
                        v0[0] += bflo(q.x); v0[1] += bfhi(q.x); v0[2] += bflo(q.y); v0[3] += bfhi(q.y);
                        v1[0] += bflo(q.z); v1[1] += bfhi(q.z); v1[2] += bflo(q.w); v1[3] += bfhi(q.w); }
                    u32x4 w; w.x = cvtpk(v0[0], v0[1]); w.y = cvtpk(v0[2], v0[3]); w.z = cvtpk(v1[0], v1[1]); w.w = cvtpk(v1[2], v1[3]);
                    *(u32x4*)((STEP < 2 ? macc : mixed) + row * 2048 + col) = w; } }
        }
    }
};
struct SchedMix {
    static constexpr bool GATHER = false; static constexpr bool VARK = true;
    const unsigned char* ws; int r0, r1;
    __device__ __forceinline__ bool next(int i, Unit& u) const {
        const int tr = r0 + i / 3; if (tr >= r1) return false;
        const int L = tr * (int)gridDim.x + (int)blockIdx.x; if (L >= 64 * 8) return false;
        static_tile(L, 64, 8, u.pm, u.pn); u.z = i % 3; return true;
    }
    __device__ __forceinline__ int ktiles(const Unit& u) const { return u.z == 1 ? 32 : 16; }
    __device__ __forceinline__ const char* baseA(const Unit& u) const {
        const size_t ts = (size_t)256 * 2048 * 2;
        return (const char*)ws + (u.z == 1 ? WS_ATT : WS_FX + (u.z == 2 ? 2048 : 0)) + (size_t)u.pm * ts;
    }
    __device__ __forceinline__ const char* baseB(const Unit& u) const {
        const size_t ts = (size_t)256 * 2048 * 2;
        return (const char*)ws + (u.z == 1 ? WS_WAOT : WS_WFM + (u.z == 2 ? 2048 : 0)) + (size_t)u.pn * ts;
    }
    __device__ __forceinline__ unsigned arow(const Unit&, int) const { return 0u; }
};
struct EpiMixF {
    static constexpr int PERM = 1; static constexpr bool AFTER_DRAIN = false, KEEP = true; static constexpr int NSTORE = 16;
    unsigned char* ws;
    __device__ __forceinline__ bool keep(const Unit& u) const { return u.z < 2; }
    static __device__ __forceinline__ float gb(unsigned w, int k) { return (float)((w >> (8 * k)) & 255u); }
    __device__ __forceinline__ void operator()(f32x4 (&acc)[2][2][4][2], const Unit& u, int wr, int wc, int fr, int fq) const {
        const int row0 = u.pm * 256 + wr * 64 + fr, col0 = u.pn * 256 + wc * 32 + 8 * fq;
        const int seg = __builtin_amdgcn_readfirstlane(u.z);
        const unsigned char* gnum = ws + WS_GATES + seg * 2048;
        bf16_t* mixed = (bf16_t*)(ws + WS_MIXED);
        if (seg < 2) {
#pragma unroll
            for (int ai = 0; ai < 2; ++ai) {
                u32x2 gn[4][2], gd[4][2];
#pragma unroll
                for (int m = 0; m < 4; ++m) { const size_t row = (size_t)(row0 + ai * HALF + m * 16);
#pragma unroll
                    for (int bj = 0; bj < 2; ++bj) { const unsigned char* q = gnum + row * 6144 + col0 + bj * HALF; gn[m][bj] = *(const u32x2*)q; gd[m][bj] = *(const u32x2*)(q + 2048); } }
#pragma unroll
                for (int m = 0; m < 4; ++m)
#pragma unroll
                    for (int bj = 0; bj < 2; ++bj) {
#pragma unroll
                        for (int k = 0; k < 4; ++k) {
                            const float n0 = (seg == 0) ? gb(gn[m][bj].x, k) : fmaxf(gb(gn[m][bj].x, k), 0.5f), n1 = (seg == 0) ? gb(gn[m][bj].y, k) : fmaxf(gb(gn[m][bj].y, k), 0.5f);
                            acc[ai][bj][m][0][k] *= n0 * __builtin_amdgcn_rcpf(fmaxf(gb(gd[m][bj].x, k), 0.5f));
                            acc[ai][bj][m][1][k] *= n1 * __builtin_amdgcn_rcpf(fmaxf(gb(gd[m][bj].y, k), 0.5f)); } }
            }
        } else {
#pragma unroll
            for (int ai = 0; ai < 2; ++ai) {
                u32x2 gn[4][2];
#pragma unroll
                for (int m = 0; m < 4; ++m) { const size_t row = (size_t)(row0 + ai * HALF + m * 16);
#pragma unroll
                    for (int bj = 0; bj < 2; ++bj) gn[m][bj] = *(const u32x2*)(gnum + row * 6144 + col0 + bj * HALF); }
#pragma unroll
                for (int m = 0; m < 4; ++m) { const size_t row = (size_t)(row0 + ai * HALF + m * 16);
#pragma unroll
                    for (int bj = 0; bj < 2; ++bj) { const float kq = 1.0f / 255.0f; f32x4 v0 = acc[ai][bj][m][0], v1 = acc[ai][bj][m][1];
#pragma unroll
                        for (int k = 0; k < 4; ++k) { v0[k] *= fmaxf(gb(gn[m][bj].x, k), 0.5f) * kq; v1[k] *= fmaxf(gb(gn[m][bj].y, k), 0.5f) * kq; }
                        u32x4 w; w.x = cvtpk(v0[0], v0[1]); w.y = cvtpk(v0[2], v0[3]); w.z = cvtpk(v1[0], v1[1]); w.w = cvtpk(v1[2], v1[3]);
                        *(u32x4*)(mixed + row * 2048 + col0 + bj * HALF) = w; } }
            }
        }
    }
};
struct EpiRes {
    static constexpr int PERM = 1; static constexpr bool AFTER_DRAIN = false; static constexpr int NSTORE = 16;
    const float* x; bf16_t* x2;
    __device__ __forceinline__ void operator()(const f32x4 (&acc)[2][2][4][2], const Unit& u, int wr, int wc, int fr, int fq) const {
        const int row0 = u.pm * 256 + wr * 64 + fr, col0 = u.pn * 256 + wc * 32 + 8 * fq;
#pragma unroll
        for (int ai = 0; ai < 2; ++ai) {
            f32x4 xv[4][2][2];
#pragma unroll
            for (int m = 0; m < 4; ++m) { const size_t off = (size_t)(row0 + ai * HALF + m * 16) * 2048 + col0;
#pragma unroll
                for (int bj = 0; bj < 2; ++bj) { xv[m][bj][0] = *(const f32x4*)(x + off + bj * HALF); xv[m][bj][1] = *(const f32x4*)(x + off + bj * HALF + 4); } }
#pragma unroll
            for (int m = 0; m < 4; ++m) { const size_t off = (size_t)(row0 + ai * HALF + m * 16) * 2048 + col0;
#pragma unroll
                for (int bj = 0; bj < 2; ++bj) { const f32x4 v0 = acc[ai][bj][m][0] + xv[m][bj][0], v1 = acc[ai][bj][m][1] + xv[m][bj][1];
                    u32x4 w; w.x = cvtpk(v0[0], v0[1]); w.y = cvtpk(v0[2], v0[3]); w.z = cvtpk(v1[0], v1[1]); w.w = cvtpk(v1[2], v1[3]);
                    *(u32x4*)(x2 + off + bj * HALF) = w; } }
        }
    }
};
__device__ __forceinline__ float swiglu1(float g, float up) {
    g = fminf(g, 7.0f); up = fminf(fmaxf(up, -7.0f), 7.0f);
    return (up + 1.0f) * (g * sigmoid_sc(g, -1.702f * LOG2E));
}
struct EpiSwiglu {
    static constexpr bool PERM = true, AFTER_DRAIN = false; static constexpr int NSTORE = 8;
    unsigned char* ws; const float* bgu; const LAS int* pt;
    __device__ __forceinline__ void operator()(const f32x4 (&acc)[2][2][4][2], const Unit& u, int wr, int wc, int fr, int fq) const {
        const int e = u.z; const size_t srow0 = (size_t)(__builtin_amdgcn_readfirstlane(pt[e]) + u.pm) * 256 + wr * 64 + fr;
        const int col0 = u.pn * 256 + wc * 32 + 8 * fq;
        bf16_t* act = (bf16_t*)(ws + WS_ACT);
        f32x4 bv[2][2];
#pragma unroll
        for (int bj = 0; bj < 2; ++bj)
#pragma unroll
            for (int n = 0; n < 2; ++n) bv[bj][n] = *(const f32x4*)(bgu + (size_t)e * 4096 + col0 + bj * HALF + 4 * n);
#pragma unroll
        for (int ai = 0; ai < 2; ++ai)
#pragma unroll
            for (int m = 0; m < 4; ++m) { bf16_t* rowp = act + (srow0 + ai * HALF + m * 16) * 2048 + (col0 >> 1);
#pragma unroll
                for (int bj = 0; bj < 2; ++bj) { const f32x4 v0 = acc[ai][bj][m][0] + bv[bj][0], v1 = acc[ai][bj][m][1] + bv[bj][1];
                    u32x2 w; w.x = cvtpk(swiglu1(v0[0], v0[1]), swiglu1(v0[2], v0[3])); w.y = cvtpk(swiglu1(v1[0], v1[1]), swiglu1(v1[2], v1[3]));
                    *(u32x2*)(rowp + bj * (HALF / 2)) = w; } }
    }
};
struct EpiDown {
    static constexpr bool PERM = true, AFTER_DRAIN = false; static constexpr int NSTORE = 8;
    unsigned char* ws; const float* bdn; const LAS int* pt; const LAS int* cn;
    __device__ __forceinline__ void operator()(const f32x4 (&acc)[2][2][4][2], const Unit& u, int wr, int wc, int fr, int fq) const {
        const int e = u.z; const int lrow0 = u.pm * 256 + wr * 64 + fr; const size_t srow0 = (size_t)__builtin_amdgcn_readfirstlane(pt[e]) * 256 + lrow0;
        const int col0 = u.pn * 256 + wc * 32 + 8 * fq;
        bf16_t* ys = (bf16_t*)(ws + WS_YS); const float* wl = (const float*)(ws + WS_WLIST) + (size_t)e * T_; const int cne = __builtin_amdgcn_readfirstlane(cn[e]);
        f32x4 bv[2][2];
#pragma unroll
        for (int bj = 0; bj < 2; ++bj)
#pragma unroll
            for (int n = 0; n < 2; ++n) bv[bj][n] = *(const f32x4*)(bdn + (size_t)e * 2048 + col0 + bj * HALF + 4 * n);
#pragma unroll
        for (int ai = 0; ai < 2; ++ai)
#pragma unroll
            for (int m = 0; m < 4; ++m) { const int pos = lrow0 + ai * HALF + m * 16; const float w = (pos < cne) ? wl[pos] : 0.f;
                bf16_t* rowp = ys + (srow0 + ai * HALF + m * 16) * 2048 + col0;
#pragma unroll
                for (int bj = 0; bj < 2; ++bj) { const f32x4 v0 = (acc[ai][bj][m][0] + bv[bj][0]) * w, v1 = (acc[ai][bj][m][1] + bv[bj][1]) * w;
                    u32x4 o; o.x = cvtpk(v0[0], v0[1]); o.y = cvtpk(v0[2], v0[3]); o.z = cvtpk(v1[0], v1[1]); o.w = cvtpk(v1[2], v1[3]);
                    *(u32x4*)(rowp + bj * HALF) = o; } }
    }
};
__device__ __forceinline__ unsigned pk_fp8x4(float a, float b, float c, float d) {
    int w = __builtin_amdgcn_cvt_pk_fp8_f32(a, b, 0, false); w = __builtin_amdgcn_cvt_pk_fp8_f32(c, d, w, true); return (unsigned)w; }
struct EpiSwiglu8 {
    static constexpr int PERM = 2; static constexpr bool AFTER_DRAIN = false; static constexpr int NSTORE = 8;
    unsigned char* ws; const float* bgu; const LAS int* pt;
    __device__ __forceinline__ void operator()(const f32x4 (&acc)[2][2][4][2], const Unit& u, int wr, int wc, int fr, int fq) const {
        const int e = u.z; const size_t srow0 = (size_t)(__builtin_amdgcn_readfirstlane(pt[e]) + u.pm) * 256 + wr * 64 + fr;
        const int col0 = u.pn * 256 + wc * 64 + 16 * fq;
        unsigned char* act = ws + WS_ACTQ;
        const LAS float* btab = (const LAS float*)((const LAS unsigned char*)pt - LDS_MISC + LDS_BTAB) + u.idx * 256 + wc * 64 + 16 * fq;
        f32x4 bv[2][2];
#pragma unroll
        for (int bj = 0; bj < 2; ++bj)
#pragma unroll
            for (int n = 0; n < 2; ++n) bv[bj][n] = *(const LAS f32x4*)(btab + 8 * bj + 4 * n);
#pragma unroll
        for (int ai = 0; ai < 2; ++ai)
#pragma unroll
            for (int m = 0; m < 4; ++m) {
                float o[8];
#pragma unroll
                for (int bj = 0; bj < 2; ++bj)
#pragma unroll
                    for (int n = 0; n < 2; ++n) { const f32x4 v = acc[ai][bj][m][n] * WQ_INV + bv[bj][n]; o[4 * bj + 2 * n] = swiglu1(v[0], v[1]); o[4 * bj + 2 * n + 1] = swiglu1(v[2], v[3]); }
                u32x2 w; w.x = pk_fp8x4(o[0], o[1], o[2], o[3]); w.y = pk_fp8x4(o[4], o[5], o[6], o[7]);
                *(u32x2*)(act + (srow0 + ai * HALF + m * 16) * 2048 + (col0 >> 1)) = w; }
    }
};
struct EpiDown8 {
    static constexpr int PERM = 2; static constexpr bool AFTER_DRAIN = false; static constexpr int NSTORE = 8;
    unsigned char* ws; const float* bdn; const LAS int* pt; const LAS int* cn; size_t ysbase = WS_YS;
    __device__ __forceinline__ void operator()(const f32x4 (&acc)[2][2][4][2], const Unit& u, int wr, int wc, int fr, int fq) const {
        const int e = u.z; const int lrow0 = u.pm * 256 + wr * 64 + fr; const size_t srow0 = (size_t)__builtin_amdgcn_readfirstlane(pt[e]) * 256 + lrow0;
        const int col0 = u.pn * 256 + wc * 64 + 16 * fq;
        unsigned char* ys = ws + ysbase;
        const LAS float* btab = (const LAS float*)((const LAS unsigned char*)pt - LDS_MISC + LDS_BTAB) + u.idx * 256 + wc * 64 + 16 * fq;
        const LAS float* wtab = (const LAS float*)((const LAS unsigned char*)pt - LDS_MISC + LDS_TOKL) + u.idx * 256 + wr * 64 + fr;
        f32x4 bv[2][2];
#pragma unroll
        for (int bj = 0; bj < 2; ++bj)
#pragma unroll
            for (int n = 0; n < 2; ++n) bv[bj][n] = *(const LAS f32x4*)(btab + 8 * bj + 4 * n);
#pragma unroll
        for (int ai = 0; ai < 2; ++ai)
#pragma unroll
            for (int m = 0; m < 4; ++m) { const float w = wtab[ai * HALF + m * 16];
                u32x4 o;
                { const f32x4 a = (acc[ai][0][m][0] * WQ_INV + bv[0][0]) * w, c = (acc[ai][0][m][1] * WQ_INV + bv[0][1]) * w; o.x = pk_fp8x4(a[0], a[1], a[2], a[3]); o.y = pk_fp8x4(c[0], c[1], c[2], c[3]); }
                { const f32x4 a = (acc[ai][1][m][0] * WQ_INV + bv[1][0]) * w, c = (acc[ai][1][m][1] * WQ_INV + bv[1][1]) * w; o.z = pk_fp8x4(a[0], a[1], a[2], a[3]); o.w = pk_fp8x4(c[0], c[1], c[2], c[3]); }
                *(u32x4*)(ys + (srow0 + ai * HALF + m * 16) * 2048 + col0) = o; }
    }
};
struct EpiMemSoftmax {
    static constexpr bool PERM = true, AFTER_DRAIN = true; static constexpr int NSTORE = 0;
    bf16_t* P;
    __device__ __forceinline__ void operator()(const f32x4 (&)[2][2][4][2], const Unit&, int, int, int, int) const {}
    __device__ __forceinline__ void fused(f32x4 (&acc)[2][2][4][2], const Unit&, int wr, int wc, int fr, int fq, LAS unsigned char* lds, int, int) const {
        LAS f32x2* tab = (LAS f32x2*)lds;
        const float sc = 0.0625f * LOG2E;
        float mx[2][4];
#pragma unroll
        for (int ai = 0; ai < 2; ++ai)
#pragma unroll
            for (int m = 0; m < 4; ++m) { float a = -3.0e38f;
#pragma unroll
                for (int bj = 0; bj < 2; ++bj)
#pragma unroll
                    for (int n = 0; n < 2; ++n) { acc[ai][bj][m][n] *= sc; const f32x4 v = acc[ai][bj][m][n]; a = fmaxf(a, fmaxf(fmaxf(v[0], v[1]), fmaxf(v[2], v[3]))); }
                a = fmaxf(a, __shfl_xor(a, 16)); a = fmaxf(a, __shfl_xor(a, 32)); mx[ai][m] = a;
                float s = 0.f;
#pragma unroll
                for (int bj = 0; bj < 2; ++bj)
#pragma unroll
                    for (int n = 0; n < 2; ++n) { const f32x4 v = acc[ai][bj][m][n]; s += __builtin_amdgcn_exp2f(v[0] - a) + __builtin_amdgcn_exp2f(v[1] - a) + __builtin_amdgcn_exp2f(v[2] - a) + __builtin_amdgcn_exp2f(v[3] - a); }
                s += __shfl_xor(s, 16); s += __shfl_xor(s, 32);
                if (fq == 0) tab[(ai * HALF + wr * 64 + m * 16 + fr) * 4 + wc] = (f32x2){a, s};
            }
        __syncthreads();
#pragma unroll
        for (int ai = 0; ai < 2; ++ai)
#pragma unroll
            for (int m = 0; m < 4; ++m) { const int r = ai * HALF + wr * 64 + m * 16 + fr;
                const f32x2 t0 = tab[r * 4 + 0], t1 = tab[r * 4 + 1], t2 = tab[r * 4 + 2], t3 = tab[r * 4 + 3];
                const float M = fmaxf(fmaxf(t0.x, t1.x), fmaxf(t2.x, t3.x));
                const float L = t0.y * __builtin_amdgcn_exp2f(t0.x - M) + t1.y * __builtin_amdgcn_exp2f(t1.x - M) + t2.y * __builtin_amdgcn_exp2f(t2.x - M) + t3.y * __builtin_amdgcn_exp2f(t3.x - M);
                const float inv = 1.0f / L;
                bf16_t* rowp = P + (size_t)r * 1024 + wc * 32 + 8 * fq;
#pragma unroll
                for (int bj = 0; bj < 2; ++bj) { f32x4 v0 = acc[ai][bj][m][0], v1 = acc[ai][bj][m][1];
#pragma unroll
                    for (int j = 0; j < 4; ++j) { v0[j] = __builtin_amdgcn_exp2f(v0[j] - M) * inv; v1[j] = __builtin_amdgcn_exp2f(v1[j] - M) * inv; }
                    u32x4 w; w.x = cvtpk(v0[0], v0[1]); w.y = cvtpk(v0[2], v0[3]); w.z = cvtpk(v1[0], v1[1]); w.w = cvtpk(v1[2], v1[3]);
                    *(u32x4*)(rowp + bj * HALF) = w; } }
        __syncthreads();
    }
};
struct EpiTile {
    static constexpr bool PERM = true, AFTER_DRAIN = false; static constexpr int NSTORE = 0;
    bf16_t* dst; size_t ldc;
    __device__ __forceinline__ void operator()(const f32x4 (&acc)[2][2][4][2], const Unit&, int wr, int wc, int fr, int fq) const { store_tile_bf16(acc, dst, ldc, wr, wc, fr, fq); }
};
__device__ __forceinline__ void tr_item(const float* W, int K, int N, bf16_t* WT, LAS float* scr, int item, int lane) {
    const int nblk = N / 32, kb = item / nblk, nb = item % nblk, k0 = 64 * kb, n0 = 32 * nb;
#pragma unroll 8
    for (int i = 0; i < 32; ++i) { const int kk = 2 * i + (lane >> 5); scr[kk * 33 + (lane & 31)] = W[(size_t)(k0 + kk) * N + n0 + (lane & 31)]; }
    asm volatile("s_waitcnt lgkmcnt(0)" ::: "memory");
    const int c = lane & 7;
#pragma unroll
    for (int j = 0; j < 4; ++j) { const int n = (lane >> 3) + 8 * j; const LAS float* s = scr + (8 * c) * 33 + n;
        u32x4 o; o.x = cvtpk(s[0 * 33], s[1 * 33]); o.y = cvtpk(s[2 * 33], s[3 * 33]); o.z = cvtpk(s[4 * 33], s[5 * 33]); o.w = cvtpk(s[6 * 33], s[7 * 33]);
        *(u32x4*)(WT + (size_t)(n0 + n) * K + k0 + 8 * c) = o; }
    asm volatile("s_waitcnt lgkmcnt(0)" ::: "memory");
}
__device__ __forceinline__ void tr_item8(const float* W, int K, int N, unsigned char* WT, LAS float* scr, int item, int lane, float scale) {
    const int nblk = N / 32, kb = item / nblk, nb = item % nblk, k0 = 128 * kb, n0 = 32 * nb;
#pragma unroll 8
    for (int i = 0; i < 64; ++i) { const int kk = 2 * i + (lane >> 5); scr[kk * 33 + (lane & 31)] = W[(size_t)(k0 + kk) * N + n0 + (lane & 31)] * scale; }
    asm volatile("s_waitcnt lgkmcnt(0)" ::: "memory");
    const int c = lane & 7;
#pragma unroll
    for (int j = 0; j < 4; ++j) { const int n = (lane >> 3) + 8 * j; const LAS float* s = scr + (16 * c) * 33 + n;
        u32x4 o; o.x = pk_fp8x4(s[0 * 33], s[1 * 33], s[2 * 33], s[3 * 33]); o.y = pk_fp8x4(s[4 * 33], s[5 * 33], s[6 * 33], s[7 * 33]);
        o.z = pk_fp8x4(s[8 * 33], s[9 * 33], s[10 * 33], s[11 * 33]); o.w = pk_fp8x4(s[12 * 33], s[13 * 33], s[14 * 33], s[15 * 33]);
        *(u32x4*)(WT + (size_t)(n0 + n) * K + k0 + 16 * c) = o; }
    asm volatile("s_waitcnt lgkmcnt(0)" ::: "memory");
}
__device__ __forceinline__ void rms_row_to_bf16(const float* xrow, const float* g, bf16_t* orow, int lane, unsigned char* qrow = nullptr) {
    const f32x4* xr = (const f32x4*)xrow + lane; const f32x4* gr = (const f32x4*)g + lane;
    f32x4 v[8]; float s = 0.f;
#pragma unroll
    for (int j = 0; j < 8; ++j) { v[j] = xr[64 * j]; s += (v[j][0] * v[j][0] + v[j][1] * v[j][1]) + (v[j][2] * v[j][2] + v[j][3] * v[j][3]); }
    const float r = rsqrtf(wsum(s) * (1.0f / DM) + 1e-5f);
    u32x2* o8 = (u32x2*)orow + lane;
#pragma unroll
    for (int j = 0; j < 8; ++j) { const f32x4 gg = gr[64 * j]; u32x2 w; w.x = cvtpk(v[j][0] * r * gg[0], v[j][1] * r * gg[1]); w.y = cvtpk(v[j][2] * r * gg[2], v[j][3] * r * gg[3]); o8[64 * j] = w;
        if (qrow) ((unsigned*)qrow)[lane + 64 * j] = pk_fp8x4(v[j][0] * r * gg[0], v[j][1] * r * gg[1], v[j][2] * r * gg[2], v[j][3] * r * gg[3]); }
}
__device__ __forceinline__ void rms_bfrow_to_bf16(const bf16_t* xrow, const float* g, bf16_t* orow, int lane, unsigned char* qrow) {
    const u32x2* xr = (const u32x2*)xrow + lane; const f32x4* gr = (const f32x4*)g + lane;
    f32x4 v[8]; float s = 0.f;
#pragma unroll
    for (int j = 0; j < 8; ++j) { const u32x2 w = xr[64 * j]; v[j] = (f32x4){bflo(w.x), bfhi(w.x), bflo(w.y), bfhi(w.y)}; s += (v[j][0] * v[j][0] + v[j][1] * v[j][1]) + (v[j][2] * v[j][2] + v[j][3] * v[j][3]); }
    const float r = rsqrtf(wsum(s) * (1.0f / DM) + 1e-5f);
    u32x2* o8 = (u32x2*)orow + lane;
#pragma unroll
    for (int j = 0; j < 8; ++j) { const f32x4 gg = gr[64 * j]; u32x2 w; w.x = cvtpk(v[j][0] * r * gg[0], v[j][1] * r * gg[1]); w.y = cvtpk(v[j][2] * r * gg[2], v[j][3] * r * gg[3]); o8[64 * j] = w;
        if (qrow) ((unsigned*)qrow)[lane + 64 * j] = pk_fp8x4(v[j][0] * r * gg[0], v[j][1] * r * gg[1], v[j][2] * r * gg[2], v[j][3] * r * gg[3]); }
}
constexpr int CV_I_IN = (DM / 128) * (INW / 256), CV_I_SQ = (2048 / 128) * (2048 / 256), CV_I_HF = (1024 / 128) * (2048 / 256);
constexpr int CV_I_GU = (2048 / 128) * (4096 / 256), CV_I_DN = CV_I_SQ;
constexpr long CV_NONEXP = (long)CV_I_IN + 3L * CV_I_SQ + 2L * CV_I_HF;
constexpr long CV_TOTAL = CV_NONEXP + (long)NE * CV_I_GU + (long)NE * CV_I_DN;
typedef short v2s_t __attribute__((ext_vector_type(2)));
__device__ __forceinline__ unsigned pk_fp8x4_scaled(float a, float b, float c, float d) {
    v2s_t r = {0, 0};
    r = __builtin_amdgcn_cvt_scalef32_pk_fp8_f32(r, a, b, WQ_INV, false);
    r = __builtin_amdgcn_cvt_scalef32_pk_fp8_f32(r, c, d, WQ_INV, true);
    return __builtin_bit_cast(unsigned, r);
}
constexpr int CV_PITCH = 260;
#ifndef CV_ASMLD
#define CV_ASMLD 0
#endif
__device__ __forceinline__ f32x4 cv_load(const float* q) {
#if CV_ASMLD
    f32x4 v; asm volatile("global_load_dwordx4 %0, %1, off sc0 sc1 nt" : "=v"(v) : "v"(q) : "memory"); return v;
#else
    return __builtin_nontemporal_load((const f32x4*)q);
#endif
}
__device__ __forceinline__ void convert_items(const Params& p, LAS unsigned char* lds, long it0, long it_end, int worker, int nworkers, int probe = 0, int* qhead = nullptr) {
    int tid_ = threadIdx.x; asm volatile("" : "+v"(tid_));
    const int tid = tid_, wave = __builtin_amdgcn_readfirstlane(tid >> 6), lane = tid & 63;
    unsigned char* ws = p.ws;
    LAS float* tile = (LAS float*)lds;
    constexpr int I_IN = CV_I_IN, I_SQ = CV_I_SQ, I_HF = CV_I_HF, I_GU = CV_I_GU, I_DN = CV_I_DN;
    static_assert(I_GU == 256 && I_DN == 128, "shift decode of the expert items");
    struct Item { const float* src; unsigned char* dst; int N, K, f8; };
    auto decode = [&](long it, Item& q) -> bool {
        if (it >= it_end) return false;
        long r = it; const float* W; unsigned char* D; int K, N, f8 = 0, kb, nb;
        if (r >= CV_NONEXP) {
            r -= CV_NONEXP; K = 2048; f8 = MOE_F8 ? 1 : 0;
            if (r < (long)NE * I_GU) { const int e = (int)(r >> 8), rr = (int)r & 255; kb = rr >> 4; nb = rr & 15; N = 4096;
                W = p.in[14] + (size_t)e * 2048 * 4096; D = ws + (MOE_F8 ? WS_WGUQ + (size_t)e * 4096 * 2048 : WS_WGUT + (size_t)e * 4096 * 2048 * 2); }
            else { r -= (long)NE * I_GU; const int e = (int)(r >> 7), rr = (int)r & 127; kb = rr >> 3; nb = rr & 7; N = 2048;
                W = p.in[16] + (size_t)e * 2048 * 2048; D = ws + (MOE_F8 ? WS_WDNQ + (size_t)e * 2048 * 2048 : WS_WDNT + (size_t)e * 2048 * 2048 * 2); }
        } else {
            if (r < I_IN) { W = p.in[4]; D = ws + WS_WINT; K = LDP; N = INW;
                if (GATES_F8 && 256 * ((int)r % (INW / 256)) >= 4608) { f8 = 2; D = ws + WS_WINQ; K = 2048; } }
            else if ((r -= I_IN) < I_SQ) { W = p.in[6]; D = ws + WS_WMKVT; K = LDP; N = 2048; }
            else if ((r -= I_SQ) < I_HF) { W = p.in[7]; D = ws + WS_WFM; K = 2048; N = 2048; }
            else if ((r -= I_HF) < I_SQ) { W = p.in[8]; D = ws + WS_WAOT; K = 2048; N = 2048; }
            else if ((r -= I_SQ) < I_HF) { W = p.in[9]; D = ws + WS_WFM + 1024 * 2; K = 2048; N = 2048; }
            else { r -= I_HF; W = p.in[10]; D = ws + WS_WOT; K = 2048; N = 2048; }
            const int nblk = N / 256; kb = (int)r / nblk; nb = (int)r % nblk;
        }
        q.src = W + (size_t)(128 * kb + wave) * N + 256 * nb + 4 * lane;
        q.dst = D + ((size_t)(256 * nb - (f8 == 2 ? 4608 : 0)) * K + 128 * kb) * (f8 ? 1 : 2);
        q.N = N; q.K = K; q.f8 = f8;
        if (probe) { q.src = p.in[14] + (size_t)wave * 4096 + 4 * lane; q.dst = ws + ((WS_FAST_END + 4095) & ~(size_t)4095) + (size_t)blockIdx.x * (256 * 2048); q.N = 4096; q.K = 2048; q.f8 = 1; }
        return true;
    };
    f32x4 v[16];
    LAS int* qslot = (LAS int*)(lds + LDS_MISC + 768);
    long it = it0 + worker, itn = it + nworkers;
    if (qhead) {
        if (tid == 0) { qslot[0] = __hip_atomic_fetch_add(qhead, 1, __ATOMIC_RELAXED, __HIP_MEMORY_SCOPE_AGENT); qslot[1] = __hip_atomic_fetch_add(qhead, 1, __ATOMIC_RELAXED, __HIP_MEMORY_SCOPE_AGENT); }
        __syncthreads();
        it = it0 + __builtin_amdgcn_readfirstlane(qslot[0]); itn = it0 + __builtin_amdgcn_readfirstlane(qslot[1]);
        __syncthreads();
    }
    Item cur; bool have = decode(it, cur);
    if (have) {
#pragma unroll
        for (int i = 0; i < 16; ++i) v[i] = cv_load(cur.src + (size_t)(8 * i) * cur.N);
    }
    int pst = 0;
    const int cch = lane & 7, nq = (lane >> 3) + 8 * wave;
    while (have) {
        Item nxt; const bool hn = decode(itn, nxt);
        __syncthreads();
#if CV_ASMLD
        if (pst == 4) asm volatile("s_waitcnt vmcnt(4)" ::: "memory"); else if (pst == 8) asm volatile("s_waitcnt vmcnt(8)" ::: "memory"); else asm volatile("s_waitcnt vmcnt(0)" ::: "memory");
#pragma unroll
        for (int i = 0; i < 16; ++i) asm volatile("" : "+v"(v[i]));
#endif
#pragma unroll
        for (int i = 0; i < 16; ++i) *(LAS f32x4*)(tile + (8 * i + wave) * CV_PITCH + 4 * lane + 16 * (i >> 1)) = v[i];
        if (qhead && hn && tid == 0) qslot[0] = __hip_atomic_fetch_add(qhead, 1, __ATOMIC_RELAXED, __HIP_MEMORY_SCOPE_AGENT);
        if (hn) {
#pragma unroll
            for (int i = 0; i < 16; ++i) v[i] = cv_load(nxt.src + (size_t)(8 * i) * nxt.N);
        }
        __syncthreads();
        const long itnn = qhead ? (hn ? it0 + __builtin_amdgcn_readfirstlane(qslot[0]) : it_end) : itn + nworkers;
        f32x4 t[16];
        const LAS float* s = tile + (16 * cch) * CV_PITCH + 16 * cch + 4 * nq;
#pragma unroll
        for (int i = 0; i < 16; ++i) t[i] = *(const LAS f32x4*)(s + i * CV_PITCH);
#pragma unroll
        for (int j = 0; j < 4; ++j) { const int n = 4 * nq + j;
            if (cur.f8) { u32x4 o; o.x = pk_fp8x4_scaled(t[0][j], t[1][j], t[2][j], t[3][j]); o.y = pk_fp8x4_scaled(t[4][j], t[5][j], t[6][j], t[7][j]);
                o.z = pk_fp8x4_scaled(t[8][j], t[9][j], t[10][j], t[11][j]); o.w = pk_fp8x4_scaled(t[12][j], t[13][j], t[14][j], t[15][j]);
                *(u32x4*)(cur.dst + (size_t)n * cur.K + 16 * cch) = o; }
            else { u32x4 o0, o1; o0.x = cvtpk(t[0][j], t[1][j]); o0.y = cvtpk(t[2][j], t[3][j]); o0.z = cvtpk(t[4][j], t[5][j]); o0.w = cvtpk(t[6][j], t[7][j]);
                o1.x = cvtpk(t[8][j], t[9][j]); o1.y = cvtpk(t[10][j], t[11][j]); o1.z = cvtpk(t[12][j], t[13][j]); o1.w = cvtpk(t[14][j], t[15][j]);
                u32x4* d = (u32x4*)(cur.dst + ((size_t)n * cur.K + 16 * cch) * 2); d[0] = o0; d[1] = o1; } }
        pst = cur.f8 ? 4 : 8;
        cur = nxt; have = hn; it = itn; itn = itnn;
    }
    __syncthreads();
}

constexpr long CE_TOTAL = (long)NE * 384;
constexpr int CE_PITCH = 1028;
__device__ __forceinline__ void convert_experts(const Params& p, LAS unsigned char* lds, long t0, long t1) {
    int tid_ = threadIdx.x; asm volatile("" : "+v"(tid_));
    const int tid = tid_, wave = tid >> 6, lane = tid & 63;
    LAS float* tile = (LAS float*)lds;
    struct Item { const float* src; unsigned char* dst; int N; };
    auto decode = [&](long t, Item& q) -> bool {
        if (t >= t1) return false;
        const int e = (int)(t / 384), r = (int)(t % 384);
        if (r < 256) { const int nr = r >> 6, kb = r & 63; q.N = 4096;
            q.src = p.in[14] + (size_t)e * 2048 * 4096 + (size_t)(32 * kb + 4 * wave) * 4096 + nr * 1024 + 4 * lane;
            q.dst = p.ws + WS_WGUQ + ((size_t)e * 4096 + (size_t)nr * 1024) * 2048 + 32 * kb; }
        else { const int nr = (r - 256) >> 6, kb = (r - 256) & 63; q.N = 2048;
            q.src = p.in[16] + (size_t)e * 2048 * 2048 + (size_t)(32 * kb + 4 * wave) * 2048 + nr * 1024 + 4 * lane;
            q.dst = p.ws + WS_WDNQ + ((size_t)e * 2048 + (size_t)nr * 1024) * 2048 + 32 * kb; }
        return true;
    };
    f32x4 v[16];
    Item cur; long t = t0; bool have = decode(t, cur);
    if (have) {
#pragma unroll
        for (int i = 0; i < 16; ++i) v[i] = __builtin_nontemporal_load((const f32x4*)(cur.src + (size_t)(i >> 2) * cur.N + 256 * (i & 3)));
    }
    while (have) {
        Item nxt; const bool hn = decode(t + 1, nxt);
        __syncthreads();
#pragma unroll
        for (int i = 0; i < 16; ++i) *(LAS f32x4*)(tile + (4 * wave + (i >> 2)) * CE_PITCH + 256 * (i & 3) + 4 * lane) = v[i];
        if (hn) {
#pragma unroll
            for (int i = 0; i < 16; ++i) v[i] = __builtin_nontemporal_load((const f32x4*)(nxt.src + (size_t)(i >> 2) * nxt.N + 256 * (i & 3)));
        }
        __syncthreads();
#pragma unroll
        for (int j = 0; j < 2; ++j) { const int n = tid + 512 * j; const LAS float* s = tile + n;
            float f[32];
#pragma unroll
            for (int i = 0; i < 32; ++i) f[i] = s[i * CE_PITCH] * WQ_SCALE;
            u32x4 o0, o1;
            o0.x = pk_fp8x4(f[0], f[1], f[2], f[3]); o0.y = pk_fp8x4(f[4], f[5], f[6], f[7]); o0.z = pk_fp8x4(f[8], f[9], f[10], f[11]); o0.w = pk_fp8x4(f[12], f[13], f[14], f[15]);
            o1.x = pk_fp8x4(f[16], f[17], f[18], f[19]); o1.y = pk_fp8x4(f[20], f[21], f[22], f[23]); o1.z = pk_fp8x4(f[24], f[25], f[26], f[27]); o1.w = pk_fp8x4(f[28], f[29], f[30], f[31]);
            u32x4* d = (u32x4*)(cur.dst + (size_t)n * 2048); d[0] = o0; d[1] = o1; }
        cur = nxt; have = hn; ++t;
    }
    __syncthreads();
}

__device__ __forceinline__ void phase_prologue(const Params& p, LAS unsigned char* lds) {
    int tid_ = threadIdx.x; asm volatile("" : "+v"(tid_));
    const int tid = tid_, wave = tid >> 6, lane = tid & 63;
    unsigned char* ws = p.ws;
    const int gw = vwg() * NWAVE + wave, NGW = (int)gridDim.x * NWAVE;
    for (int m = gw; m < T_; m += NGW) rms_row_to_bf16(p.in[0] + (size_t)m * DM, p.in[3], (bf16_t*)(ws + WS_H) + (size_t)m * LDP, lane, GATES_F8 ? (ws + WS_H8 + (size_t)m * DM) : nullptr);
    for (int m = gw; m < B_ * MEM; m += NGW) {
        const f32x4* xr = (const f32x4*)(p.in[1] + (size_t)m * DM) + lane; u32x2* o8 = (u32x2*)((bf16_t*)(ws + WS_MEMBF) + (size_t)m * LDP) + lane;
#pragma unroll
        for (int j = 0; j < 8; ++j) { const f32x4 v = xr[64 * j]; u32x2 w; w.x = cvtpk(v[0], v[1]); w.y = cvtpk(v[2], v[3]); o8[64 * j] = w; }
    }
    {
        const int gt = vwg() * NTHR + tid, NGT = (int)gridDim.x * NTHR;
        bf16_t* tabT = (bf16_t*)(ws + WS_TABT); bf16_t* dm = (bf16_t*)(ws + WS_DMAT);
        for (int i = gt; i < 512 * 256 / 2; i += NGT) { const int e0 = 2 * i; const int mrow = e0 >> 8, c = e0 & 255; const int n = mrow & 255; float v[2];
#pragma unroll
            for (int j = 0; j < 2; ++j) { const int mm = ((c + j) * n) & 255; const float a = (float)mm * (2.0f / 256.0f); v[j] = (mrow < 256) ? cospif(a) : sinpif(a); }
            *(unsigned*)(tabT + e0) = cvtpk(v[0], v[1]); }
        const float sc = 1.0f / sqrtf(2048.0f * 256.0f);
        LAS float* ct = (LAS float*)lds;
        for (int m = tid; m < 2048; m += NTHR) ct[m] = cospif((float)m * (2.0f / 2048.0f)) * sc;
        __syncthreads();
        for (int i = gt; i < 2048 * 4096 / 2; i += NGT) { const int e0 = 2 * i; const int jr = e0 >> 12, k = e0 & 4095; float v[2];
#pragma unroll
            for (int j = 0; j < 2; ++j) { const int kk = (k + j) & 2047; const int mm = (jr * kk) & 2047; v[j] = (k < 2048) ? ct[mm] : ct[(mm + 512) & 2047]; }
            *(unsigned*)(dm + e0) = cvtpk(v[0], v[1]); }
        __syncthreads();
        bf16_t* wrt = (bf16_t*)(ws + WS_WRT);
        for (int i = gt; i < NE * DM; i += NGT) { const int e = i >> 11, k = i & 2047; wrt[i] = (bf16_t)(cvtpk(p.in[12][(size_t)k * NE + e], 0.f) & 0xffffu); }
    }
    __syncthreads();
    convert_items(p, lds, 0, (gridDim.x == 256) ? CV_NONEXP : CV_TOTAL, vwg(), (int)gridDim.x);
}

constexpr int AT_KROW = 144, AT_VROW = 776;
constexpr int AT_K = 0, AT_V = 384 * AT_KROW, AT_LUT = AT_V + 64 * AT_VROW;
static_assert(AT_LUT + NWAVE * 320 * 4 <= STAGE_BYTES, "attention LDS");
__device__ __forceinline__ void attn_unit(const Params& p, LAS unsigned char* lds, int b, int kvh, int qb) {
    int tid_ = threadIdx.x; asm volatile("" : "+v"(tid_));
    const int tid = tid_, wid = __builtin_amdgcn_readfirstlane(tid >> 6), lane = tid & 63, r = lane & 31, h = lane >> 5;
    const unsigned char* ws = p.ws;
    const bf16_t* Q = (const bf16_t*)(ws + WS_Q); const bf16_t* Kg = (const bf16_t*)(ws + WS_K); const bf16_t* VT = (const bf16_t*)(ws + WS_VT);
    bf16_t* att = (bf16_t*)(p.ws + WS_ATT);
    const int q0 = qb * 128, hq = kvh * 8 + wid;
    LAS unsigned char* Kb = lds + AT_K; LAS unsigned char* Vt = lds + AT_V; LAS float* lut = (LAS float*)(lds + AT_LUT) + wid * 320;
    __syncthreads();
    for (int c = tid; c < 384 * 8; c += NTHR) { const int row = c >> 3, part = c & 7, pos = q0 - 128 + row;
        u32x4 v = {0u, 0u, 0u, 0u};
        if (pos >= 0 && pos < S_) v = *(const u32x4*)(Kg + (size_t)(b * S_ + pos) * 256 + kvh * 64 + part * 8);
        *(LAS u32x4*)(Kb + row * AT_KROW + part * 16) = v; }
    for (int c = tid; c < 64 * 48; c += NTHR) { const int d = c / 48, ch = c % 48, pos0 = q0 - 128 + ch * 8;
        u32x4 v = {0u, 0u, 0u, 0u};
        if (pos0 >= 0 && pos0 < S_) v = *(const u32x4*)(VT + ((size_t)((b * 4 + kvh) * 64 + d)) * 2048 + pos0);
        *(LAS u32x2*)(Vt + d * AT_VROW + ch * 16) = (u32x2){v.x, v.y}; *(LAS u32x2*)(Vt + d * AT_VROW + ch * 16 + 8) = (u32x2){v.z, v.w}; }
    for (int i = lane; i < 320; i += 64) { const int rel = i - 160; const int ar = rel < 0 ? -rel : rel;
        lut[i] = (ar <= WIN) ? p.in[2][t5_bucket(rel) * NH + hq] * LOG2E : -1.0e30f; }
    __syncthreads();
    const float sk = p.in[5][hq] * LOG2E;
    const float SC = 0.125f * LOG2E;
#pragma unroll 1
    for (int sb = 0; sb < 4; ++sb) {
        const int pq = q0 + sb * 32;
        bf16x8 qf[4];
        const bf16_t* qrow = Q + (size_t)(b * S_ + pq + r) * 2048 + hq * 64 + 8 * h;
#pragma unroll
        for (int s = 0; s < 4; ++s) qf[s] = *(const bf16x8*)(qrow + 16 * s);
        float mrun = sk, lrun = 1.0f;
        f32x16 o0, o1;
#pragma unroll
        for (int i = 0; i < 16; ++i) { o0[i] = 0.f; o1[i] = 0.f; }
        const int jlo = (qb == 0) ? 4 - sb : 0, jhi = (qb == 15) ? 8 - sb : 9;
        const LAS unsigned char* kp = Kb + (32 * (sb + jlo) + r) * AT_KROW + 16 * h;
        const LAS unsigned char* vp = Vt + r * AT_VROW + (32 * (sb + jlo) + 4 * h) * 2;
        const LAS unsigned char* vq = vp + 32 * AT_VROW;
        const LAS float* lp = lut + 32 * jlo + 32 + 4 * h - r;
#pragma unroll 1
        for (int j = jlo; j < jhi; ++j) {
            asm volatile("" : "+v"(kp), "+v"(vp), "+v"(vq), "+v"(lp));
            f32x16 s;
#pragma unroll
            for (int i = 0; i < 16; ++i) s[i] = 0.f;
#pragma unroll
            for (int ks = 0; ks < 4; ++ks) { const bf16x8 kf = *(const LAS bf16x8*)(kp + 32 * ks); s = __builtin_amdgcn_mfma_f32_32x32x16_bf16(kf, qf[ks], s, 0, 0, 0); }
            float mx = -3.0e38f;
            f32x2 sp[8];
#pragma unroll
            for (int i = 0; i < 8; ++i) { const int li = ((2 * i) & 3) + 8 * ((2 * i) >> 2); const f32x2 lv = {lp[li], lp[li + 1]}; const f32x2 sv = {s[2 * i], s[2 * i + 1]};
                sp[i] = sv * (f32x2){SC, SC} + lv; mx = fmaxf(fmaxf(mx, sp[i][0]), sp[i][1]); }
            mx = fmaxf(mx, __shfl_xor(mx, 32));
            const float mnew = fmaxf(mrun, mx);
            const float alpha = __builtin_amdgcn_exp2f(mrun - mnew);
            f32x2 rs2 = {0.f, 0.f};
#pragma unroll
            for (int i = 0; i < 8; ++i) { const f32x2 d = sp[i] - (f32x2){mnew, mnew}; const f32x2 e = {__builtin_amdgcn_exp2f(d[0]), __builtin_amdgcn_exp2f(d[1])};
                s[2 * i] = e[0]; s[2 * i + 1] = e[1]; rs2 += e; }
            float rs = rs2[0] + rs2[1];
            rs += __shfl_xor(rs, 32);
            lrun = lrun * alpha + rs; mrun = mnew;
            if (__any(alpha != 1.0f)) {
#pragma unroll
                for (int i = 0; i < 16; ++i) { o0[i] *= alpha; o1[i] *= alpha; }
            }
#pragma unroll
            for (int k2 = 0; k2 < 2; ++k2) {
                u32x4 pw; pw.x = cvtpk(s[8 * k2 + 0], s[8 * k2 + 1]); pw.y = cvtpk(s[8 * k2 + 2], s[8 * k2 + 3]); pw.z = cvtpk(s[8 * k2 + 4], s[8 * k2 + 5]); pw.w = cvtpk(s[8 * k2 + 6], s[8 * k2 + 7]);
                const bf16x8 pb = __builtin_bit_cast(bf16x8, pw);
                { const u32x2 lo = *(const LAS u32x2*)(vp + 32 * k2), hi = *(const LAS u32x2*)(vp + 32 * k2 + 16); const u32x4 vw = {lo.x, lo.y, hi.x, hi.y};
                  o0 = __builtin_amdgcn_mfma_f32_32x32x16_bf16(__builtin_bit_cast(bf16x8, vw), pb, o0, 0, 0, 0); }
                { const u32x2 lo = *(const LAS u32x2*)(vq + 32 * k2), hi = *(const LAS u32x2*)(vq + 32 * k2 + 16); const u32x4 vw = {lo.x, lo.y, hi.x, hi.y};
                  o1 = __builtin_amdgcn_mfma_f32_32x32x16_bf16(__builtin_bit_cast(bf16x8, vw), pb, o1, 0, 0, 0); }
            }
            kp += 32 * AT_KROW; vp += 64; vq += 64; lp += 32;
        }
        const float inv = 1.0f / lrun;
        bf16_t* orow = att + (size_t)(b * S_ + pq + r) * 2048 + hq * 64 + 4 * h;
#pragma unroll
        for (int g = 0; g < 4; ++g) {
            u32x2 w0; w0.x = cvtpk(o0[4 * g] * inv, o0[4 * g + 1] * inv); w0.y = cvtpk(o0[4 * g + 2] * inv, o0[4 * g + 3] * inv); *(u32x2*)(orow + 8 * g) = w0;
            u32x2 w1; w1.x = cvtpk(o1[4 * g] * inv, o1[4 * g + 1] * inv); w1.y = cvtpk(o1[4 * g + 2] * inv, o1[4 * g + 3] * inv); *(u32x2*)(orow + 32 + 8 * g) = w1;
        }
    }
}

__device__ __forceinline__ void phase_rows(const Params& p, LAS unsigned char* lds) {
    int tid_ = threadIdx.x; asm volatile("" : "+v"(tid_));
    const int tid = tid_, wave = __builtin_amdgcn_readfirstlane(tid >> 6), lane = tid & 63;
    unsigned char* ws = p.ws;
    const bf16_t* x2 = (const bf16_t*)(ws + WS_X2); bf16_t* h2 = (bf16_t*)(ws + WS_H2);
    LAS float* lg = (LAS float*)lds;
    LAS int* sel_e = (LAS int*)(lds + 8192);
    LAS float* sel_w = (LAS float*)(lds + 9216);
    LAS int* sel_r = (LAS int*)(lds + 10240);
    LAS int* lcnt = (LAS int*)(lds + 11264);
    LAS int* lbase = (LAS int*)(lds + 11392);
#pragma unroll 1
    for (int t0 = vwg() * 64; t0 < T_; t0 += 64 * (int)gridDim.x) {
        __syncthreads();
        if (tid < 32) lcnt[tid] = 0;
        for (int i = 0; i < 8; ++i) { const int t = t0 + wave * 8 + i; rms_bfrow_to_bf16(x2 + (size_t)t * DM, p.in[11], h2 + (size_t)t * DM, lane, MOE_F8 ? (ws + WS_H2Q + (size_t)t * DM) : nullptr); }
        asm volatile("s_waitcnt vmcnt(0)" ::: "memory");
        __syncthreads();
        if (wave < 4) {
            const bf16_t* arow = h2 + (size_t)(t0 + wave * 16 + (lane & 15)) * DM + 8 * (lane >> 4);
            const bf16_t* b0 = (const bf16_t*)(ws + WS_WRT) + (size_t)(lane & 15) * DM + 8 * (lane >> 4);
            const bf16_t* b1 = b0 + (size_t)16 * DM;
            f32x4 a0 = {0.f, 0.f, 0.f, 0.f}, a1 = {0.f, 0.f, 0.f, 0.f};
#pragma unroll 8
            for (int s = 0; s < 64; ++s) { const bf16x8 av = *(const bf16x8*)(arow + 32 * s), bv0 = *(const bf16x8*)(b0 + 32 * s), bv1 = *(const bf16x8*)(b1 + 32 * s);
                a0 = __builtin_amdgcn_mfma_f32_16x16x32_bf16(av, bv0, a0, 0, 0, 0); a1 = __builtin_amdgcn_mfma_f32_16x16x32_bf16(av, bv1, a1, 0, 0, 0); }
            const int ecol = lane & 15; const float bb0 = p.in[13][ecol], bb1 = p.in[13][ecol + 16];
#pragma unroll
            for (int rg = 0; rg < 4; ++rg) { const int tl = wave * 16 + (lane >> 4) * 4 + rg; lg[tl * 32 + ecol] = a0[rg] + bb0; lg[tl * 32 + ecol + 16] = a1[rg] + bb1; }
        }
        __syncthreads();
        if (tid < 64) {
            float v[32];
#pragma unroll
            for (int e = 0; e < 32; ++e) v[e] = lg[tid * 32 + e];
            float tv[4]; int ti[4];
#pragma unroll
            for (int k = 0; k < 4; ++k) { float bv = -3.0e38f; int bi = 0;
#pragma unroll
                for (int e = 0; e < 32; ++e) { const bool tk = v[e] > bv; bv = tk ? v[e] : bv; bi = tk ? e : bi; }
                tv[k] = bv; ti[k] = bi;
#pragma unroll
                for (int e = 0; e < 32; ++e) v[e] = (e == bi) ? -3.0e38f : v[e]; }
            const float e1 = __expf(tv[1] - tv[0]), e2 = __expf(tv[2] - tv[0]), e3 = __expf(tv[3] - tv[0]);
            const float inv = 1.0f / (1.0f + e1 + e2 + e3);
            const float wv[4] = {inv, e1 * inv, e2 * inv, e3 * inv};
#pragma unroll
            for (int k = 0; k < 4; ++k) { sel_e[tid * 4 + k] = ti[k]; sel_w[tid * 4 + k] = wv[k]; sel_r[tid * 4 + k] = __hip_atomic_fetch_add(&lcnt[ti[k]], 1, __ATOMIC_RELAXED, __HIP_MEMORY_SCOPE_WORKGROUP); }
        }
        __syncthreads();
        if (tid < 32) lbase[tid] = (lcnt[tid] > 0) ? atomicAdd((int*)(ws + WS_CTL) + CW_CNT + tid, lcnt[tid]) : 0;
        __syncthreads();
        if (tid < 256) { const int tl = tid >> 2, k = tid & 3, t = t0 + tl; const int e = sel_e[tid], pos = lbase[e] + sel_r[tid]; const float w = sel_w[tid];
            ((int*)(ws + WS_TOKE))[t * 4 + k] = e; ((int*)(ws + WS_TOKPOS))[t * 4 + k] = pos; ((float*)(ws + WS_TOKW))[t * 4 + k] = w;
            ((int*)(ws + WS_LIST))[(size_t)e * T_ + pos] = t; ((float*)(ws + WS_WLIST))[(size_t)e * T_ + pos] = w; }
    }
}
__device__ __forceinline__ void moe_tables(const Params& p, LAS int* pt, LAS int* cn) {
    __syncthreads();
    if (threadIdx.x < 64) {
        const int ln = (int)threadIdx.x; const int* cnt = (const int*)(p.ws + WS_CTL) + CW_CNT;
        const int c = (ln < NE) ? __hip_atomic_load(cnt + (ln & 31), __ATOMIC_RELAXED, __HIP_MEMORY_SCOPE_AGENT) : 0;
        const int tl = (c + 255) >> 8; int inc = tl;
#pragma unroll
        for (int o = 1; o < 32; o <<= 1) { const int v = __shfl_up(inc, o); if (ln >= o) inc += v; }
        if (ln < NE) { cn[ln] = c; pt[ln] = inc - tl; }
        if (ln == NE - 1) pt[NE] = inc;
    }
    __syncthreads();
}
__device__ __forceinline__ void phase_final(const Params& p, const LAS int* pt) {
    int tid_ = threadIdx.x; asm volatile("" : "+v"(tid_));
    const int tid = tid_, wave = tid >> 6, lane = tid & 63;
    const unsigned char* ws = p.ws;
    const bf16_t* x2 = (const bf16_t*)(ws + WS_X2); const bf16_t* ys = (const bf16_t*)(ws + WS_YS);
    const int* toke = (const int*)(ws + WS_TOKE); const int* tokpos = (const int*)(ws + WS_TOKPOS);
    const int gw = vwg() * NWAVE + wave, NGW = (int)gridDim.x * NWAVE;
    float pscale = 1.0f;
    if (PROFSEL != 0) {
        const unsigned long long* pf = (const unsigned long long*)(p.ws + WS_CTL + 32768);
        const float kl = (float)pf[0], ep = (float)pf[1], n = (float)pf[2], ntl = (float)pf[3], cyc = (float)pf[4], wal = (float)pf[5];
        float m = 0.f;
        if (PROFMETRIC == 0) m = ep / (kl + ep);
        if (PROFMETRIC == 1) m = kl / (n * ntl) / 4096.0f;
        if (PROFMETRIC == 2) m = cyc / (wal * 24.0f);
        if (PROFMETRIC == 3) m = (kl + ep) / cyc;
        if (PROFMETRIC == 4) m = n / 32.0f;
        if (PROFMETRIC == 5) m = wal / 100.0f / 200.0f;
        if (PROFMETRIC == 6 || PROFMETRIC == 7) {
            const unsigned long long* st = (const unsigned long long*)(p.ws + WS_CTL + 40960);
            unsigned long long mx = 0, mn = ~0ull, sum = 0;
            for (int i = 0; i < (int)gridDim.x; ++i) { const unsigned long long v = st[i]; mx = v > mx ? v : mx; mn = v < mn ? v : mn; sum += v; }
            const float mean = (float)(sum - mn * gridDim.x) / (float)gridDim.x;
            m = (PROFMETRIC == 6 ? ((float)(mx - mn) - mean) : (float)(mx - mn)) / 100.0f / 200.0f; }
        if (blockIdx.x == 0 && threadIdx.x == 0) { const unsigned long long t0 = wall_clock64(), ticks = (unsigned long long)(m * (float)PROFMUL * 100.0f * 100.0f);
            while (wall_clock64() - t0 < ticks) __builtin_amdgcn_s_sleep(8); }
    }
    for (int t = gw; t < T_; t += NGW) {
        const u32x2* xr = (const u32x2*)(x2 + (size_t)t * DM) + lane;
        f32x4 v[8];
#pragma unroll
        for (int j = 0; j < 8; ++j) { const u32x2 w = xr[64 * j]; v[j] = (f32x4){bflo(w.x), bfhi(w.x), bflo(w.y), bfhi(w.y)}; }
#pragma unroll
        for (int k = 0; k < 4; ++k) { const int e = toke[t * 4 + k]; const size_t slot = (size_t)pt[e] * 256 + tokpos[t * 4 + k];
            if constexpr (MOE_F8) {
                const unsigned* yr = (const unsigned*)((const unsigned char*)ys + slot * DM) + lane;
#pragma unroll
                for (int j = 0; j < 8; ++j) { const unsigned w = yr[64 * j];
                    v[j][0] += __builtin_amdgcn_cvt_f32_fp8((int)w, 0) * YS_INV; v[j][1] += __builtin_amdgcn_cvt_f32_fp8((int)w, 1) * YS_INV;
                    v[j][2] += __builtin_amdgcn_cvt_f32_fp8((int)w, 2) * YS_INV; v[j][3] += __builtin_amdgcn_cvt_f32_fp8((int)w, 3) * YS_INV; }
            } else {
                const u32x2* yr = (const u32x2*)(ys + slot * DM) + lane;
#pragma unroll
                for (int j = 0; j < 8; ++j) { const u32x2 w = yr[64 * j]; v[j][0] += bflo(w.x); v[j][1] += bfhi(w.x); v[j][2] += bflo(w.y); v[j][3] += bfhi(w.y); }
            } }
        float s = 0.f;
#pragma unroll
        for (int j = 0; j < 8; ++j) s += (v[j][0] * v[j][0] + v[j][1] * v[j][1]) + (v[j][2] * v[j][2] + v[j][3] * v[j][3]);
        const float r = rsqrtf(wsum(s) * (1.0f / DM) + 1e-5f);
        const f32x4* gr = (const f32x4*)p.in[18] + lane; f32x4* orow = (f32x4*)(p.out + (size_t)t * DM) + lane;
#pragma unroll
        for (int j = 0; j < 8; ++j) { const f32x4 gg = gr[64 * j]; orow[64 * j] = (f32x4){v[j][0] * r * gg[0] * pscale, v[j][1] * r * gg[1] * pscale, v[j][2] * r * gg[2] * pscale, v[j][3] * r * gg[3] * pscale}; }
    }
}
#ifndef P1_SLOT_BAL
#define P1_SLOT_BAL 1
#endif
#ifndef CV_SPLIT
#define CV_SPLIT 6144L
#endif
#ifndef MOE_SLOT
#define MOE_SLOT 1
#endif
#ifndef X2_SLOT
#define X2_SLOT 0
#endif
#ifndef MOE_SLOT_STEP
#define MOE_SLOT_STEP 4
#endif
#ifndef MOE_SLOT_BAL
#define MOE_SLOT_BAL 4
#endif
#ifndef POOL1
#define POOL1 2
#endif
#ifndef P2ROLE
#define P2ROLE 0
#endif
#ifndef POOL2
#define POOL2 0
#endif
#ifndef POOL3
#define POOL3 0
#endif
#ifndef POOL4
#define POOL4 0
#endif
#ifndef POOL5
#define POOL5 0
#endif
#ifndef Q4
#define Q4 8
#endif
constexpr long GU_A0 = 30 - (POOL1 + POOL2 + POOL3 + POOL4 + POOL5 + Q4);
constexpr long GU_P1S = 64 * (4 * GU_A0 + 8), GU_P1P = GU_P1S, GU_P2P = GU_P1P + 256 * POOL1, GU_P3P = GU_P2P + 256 * POOL2, GU_P4S = GU_P3P + 256 * POOL3,
               GU_P4P = GU_P4S + 256 * Q4, GU_P5P = GU_P4P + 256 * POOL4, GU_END = GU_P5P + 256 * POOL5;
static_assert(GU_END == 8192 && GU_A0 > 0, "gate_up conversion layout");
#ifndef POOL7
#define POOL7 2
#endif
__device__ __forceinline__ void proj_convert_slot(const Params& p, LAS unsigned char* lds, int g, int part) {
    const int wgi = (int)blockIdx.x & 63;
    __syncthreads();
    if constexpr (MOE_F8 && CONV_TILE32) { const long per = CE_TOTAL / 512, a = ((long)(part * 4 + g) * 64 + wgi) * per; convert_experts(p, lds, a, a + per); }
    else { const long total = CV_TOTAL - CV_NONEXP, half = total / 2; long q = half / 4, it0 = CV_NONEXP + half * part + q * g;
        if (P1_SLOT_BAL) {
            constexpr long P1END = (MOE_SLOT ? 8192 : 12288) - 256 * X2_SLOT;
            static_assert((CV_TOTAL - CV_NONEXP) == 12288 && MOE_SLOT == 1 && X2_SLOT == 0, "slot split");
            if (part == 0) { it0 = CV_NONEXP + 64 * GU_A0 * g; q = 64 * (g == 3 ? GU_A0 + 8 : GU_A0); }
            else if (part == 1) { it0 = CV_NONEXP + GU_P4S + 64 * Q4 * g; q = 64 * Q4; }
            else if (part == 2) { it0 = CV_NONEXP + 8192 + 1024 * g; q = 1024; }
            else { it0 = CV_NONEXP + P1END + 64 * X2_SLOT * g; q = 64 * X2_SLOT; } }
        convert_items(p, lds, it0, it0 + q, wgi, 64);
#ifdef DBLCONV
        if (part == (DBLCONV & 3) - 1) { __syncthreads(); convert_items(p, lds, it0, it0 + q, wgi, 64, DBLCONV >> 2); }
#endif
    }
    asm volatile("s_waitcnt vmcnt(0) lgkmcnt(0)" ::: "memory");
    __syncthreads();
}
__device__ __forceinline__ void pool_drain(const Params& p, LAS unsigned char* lds, int pool, long base, int count) {
    __syncthreads();
    convert_items(p, lds, base, base + count, 0, 1, 0, (int*)(p.ws + WS_CTL) + CW_POOL + 64 * pool);
    asm volatile("s_waitcnt vmcnt(0) lgkmcnt(0)" ::: "memory");
    __syncthreads();
}
__device__ __forceinline__ void convert_range_slot(const Params& p, LAS unsigned char* lds, long it0, long n) {
    __syncthreads();
    convert_items(p, lds, it0, it0 + n, 0, 1);
    asm volatile("s_waitcnt vmcnt(0) lgkmcnt(0)" ::: "memory");
    __syncthreads();
}
__device__ __forceinline__ void phase_proj(const Params& p, LAS unsigned char* lds) {
    EpiProj E{p.ws}; EpiGates8 EG{p.ws};
    unsigned long long* prof = PROFSEL == 1 ? (unsigned long long*)(p.ws + WS_CTL + 32768) : nullptr;
    const int BIG = 1 << 20;
    const bool stag = (gridDim.x == 256);
    const int g = stag ? ((int)blockIdx.x >> 6) : -1;
    if constexpr (GATES_F8) {
#ifndef P1SLOTV
#define P1SLOTV 0
#endif
        int a1 = (g == 0) ? 0 : (g == 1 ? 2 : BIG), a3 = (g == 3) ? 3 : BIG, slot = (g <= 1) ? 1 : g;
        if (P1SLOTV == 1) { a1 = BIG; a3 = (g <= 0) ? BIG : 2 * g; slot = (g <= 0) ? 2 : 3; }
        if (P1SLOTV == 2) { a1 = (g == 0) ? 0 : (g == 1 ? 3 : BIG); a3 = (g == 2) ? 1 : (g == 3 ? 4 : BIG); slot = (g <= 1) ? 1 : 3; }
        { SchedProj S{p.ws, 0, a1}; gemm_phase<EpiProj, SchedProj, true>(lds, 2048, LDP, LDP, S, E, nullptr); }
        if (stag && slot == 1) proj_convert_slot(p, lds, g, 0);
        { SchedProj S{p.ws, a1, BIG}; gemm_phase<EpiProj, SchedProj, true>(lds, 2048, LDP, LDP, S, E, prof); }
        if (stag && slot == 2) proj_convert_slot(p, lds, g, 0);
        { SchedGates8 S{p.ws, 0, a3}; gemm_phase<EpiGates8, SchedGates8, true, 1>(lds, 2048, 2048, 2048, S, EG, nullptr); }
        if (stag && slot == 3) proj_convert_slot(p, lds, g, 0);
        { SchedGates8 S{p.ws, a3, BIG}; gemm_phase<EpiGates8, SchedGates8, true, 1>(lds, 2048, 2048, 2048, S, EG, nullptr); }
        if (stag && POOL1 > 0) pool_drain(p, lds, 0, CV_NONEXP + GU_P1P, 256 * POOL1);
    } else {
        const int nb = stag ? 3 * g : 0;
        if (nb > 0) { SchedProj S{p.ws, 0, nb}; gemm_phase<EpiProj, SchedProj, true>(lds, 2048, LDP, LDP, S, E, nullptr); }
        if (stag) proj_convert_slot(p, lds, g, 0);
        { SchedProj S{p.ws, nb, BIG}; gemm_phase<EpiProj, SchedProj, true>(lds, 2048, LDP, LDP, S, E, prof); }
    }
}
__device__ __forceinline__ void phase_mixers(const Params& p, LAS unsigned char* lds) {
    unsigned char* ws = p.ws;
#ifndef DBLSUB
#define DBLSUB 0
#endif
#pragma unroll 1
    for (int rep = 0; rep < ((DBLSUB & 1) ? 2 : 1); ++rep)
#pragma unroll 1
    for (int u = (P2ROLE && gridDim.x == 256) ? (((int)blockIdx.x >> 6) < 3 ? ((int)blockIdx.x & 7) * 24 + ((int)blockIdx.x >> 3) : 512) : vwg(); u < 512; u += (P2ROLE && gridDim.x == 256) ? 192 : (int)gridDim.x)
        attn_unit(p, lds, u >> 6, (u >> 4) & 3, u & 15);
    asm volatile("s_waitcnt vmcnt(0) lgkmcnt(0)" ::: "memory");
    __syncthreads();
#pragma unroll 1
    for (int rep = 0; rep < ((DBLSUB & 2) ? 2 : 1); ++rep)
#pragma unroll 1
    for (int u = vwg(); u < 256; u += (int)gridDim.x) {
        const int mh = u & 3, tb = (u >> 2) & 7, b = (u >> 5) & 7;
        const size_t tok0 = (size_t)b * S_ + (size_t)tb * 256;
        bf16_t* Pt = (bf16_t*)(ws + WS_PM) + tok0 * 1024 + mh * 256;
        SchedOne S1{(const char*)(ws + WS_QM) + (tok0 * 1024 + mh * 256) * 2, (const char*)(ws + WS_KMK) + ((size_t)b * 256 * 1024 + mh * 256) * 2, 0, true};
        EpiMemSoftmax E1{Pt};
        gemm_phase<EpiMemSoftmax, SchedOne, false>(lds, 256, 1024, 1024, S1, E1);
        asm volatile("s_waitcnt vmcnt(0)" ::: "memory");
        __syncthreads();
        SchedOne S2{(const char*)Pt, (const char*)(ws + WS_VMT) + ((size_t)(b * 4 + mh) * 256 * 256) * 2, 0, true};
        EpiTile E2{(bf16_t*)(ws + WS_FX) + tok0 * 2048 + 1024 + mh * 256, 2048};
        gemm_phase<EpiTile, SchedOne, false>(lds, 256, 1024, 256, S2, E2);
        __syncthreads();
    }
    { SchedChan S{ws, 0, 0}; EpiChan E{ws}; gemm_phase<EpiChan, SchedChan, true>(lds, 256, 256, 1024, S, E, PROFSEL == 2 ? (unsigned long long*)(p.ws + WS_CTL + 32768) : nullptr); }
    if (POOL2 > 0 && gridDim.x == 256) pool_drain(p, lds, 2, CV_NONEXP + GU_P2P, 256 * POOL2);
}
__device__ __forceinline__ void phase_seqdft(const Params& p, LAS unsigned char* lds) {
    SchedSeq S{p.ws}; EpiSeq E{p.ws};
    gemm_phase<EpiSeq, SchedSeq, true>(lds, 4096, 4096, 4096, S, E, PROFSEL == 3 ? (unsigned long long*)(p.ws + WS_CTL + 32768) : nullptr);
    if (POOL3 > 0 && gridDim.x == 256) pool_drain(p, lds, 3, CV_NONEXP + GU_P3P, 256 * POOL3);
}
__device__ __forceinline__ void phase_mix(const Params& p, LAS unsigned char* lds) {
    unsigned char* ws = p.ws;
    const bool stag = (gridDim.x == 256); const int g = stag ? ((int)blockIdx.x >> 6) : -1;
    unsigned long long* prof = PROFSEL == 4 ? (unsigned long long*)(p.ws + WS_CTL + 32768) : nullptr;
    EpiMixF E{ws};
#ifndef MIXSLOT
#define MIXSLOT 0x2110
#endif
    const int sp = (g >= 0) ? ((MIXSLOT >> (4 * g)) & 15) : -1;
    if (sp == 0) proj_convert_slot(p, lds, g, 1);
    { SchedMix S{ws, 0, 1}; gemm_phase<EpiMixF, SchedMix, true>(lds, 2048, 2048, 2048, S, E, prof); }
    if (sp == 1) proj_convert_slot(p, lds, g, 1);
    { SchedMix S{ws, 1, 1 << 20}; gemm_phase<EpiMixF, SchedMix, true>(lds, 2048, 2048, 2048, S, E, nullptr); }
    if (sp == 2) proj_convert_slot(p, lds, g, 1);
    if (POOL4 > 0 && stag) pool_drain(p, lds, 4, CV_NONEXP + GU_P4P, 256 * POOL4);
}
__device__ __forceinline__ void phase_x2(const Params& p, LAS unsigned char* lds) {
    unsigned char* ws = p.ws;
    SchedPlain S{(const char*)(ws + WS_MIXED), (const char*)(ws + WS_WOT), (size_t)256 * 2048 * 2, (size_t)256 * 2048 * 2, 64, 8};
    EpiRes E{p.in[0], (bf16_t*)(ws + WS_X2)};
    unsigned long long* prof = PROFSEL == 5 ? (unsigned long long*)(p.ws + WS_CTL + 32768) : nullptr;
    if (X2_SLOT > 0 && MOE_SLOT && gridDim.x == 256) {
        const int g = (int)blockIdx.x >> 6, sp = (0x2110 >> (4 * g)) & 15;
        if (sp == 0) proj_convert_slot(p, lds, g, 3);
        { SchedPlain Sa = S; Sa.r0 = 0; Sa.r1 = 1; gemm_phase<EpiRes, SchedPlain, true>(lds, 2048, 2048, 2048, Sa, E, prof); }
        if (sp == 1) proj_convert_slot(p, lds, g, 3);
        { SchedPlain Sb = S; Sb.r0 = 1; gemm_phase<EpiRes, SchedPlain, true>(lds, 2048, 2048, 2048, Sb, E, nullptr); }
        if (sp == 2) proj_convert_slot(p, lds, g, 3);
    } else gemm_phase<EpiRes, SchedPlain, true>(lds, 2048, 2048, 2048, S, E, prof);
    if (POOL5 > 0 && gridDim.x == 256) pool_drain(p, lds, 5, CV_NONEXP + GU_P5P, 256 * POOL5);
}
template <class Sched> __device__ __forceinline__ void moe_fill_tokl(const Params& p, LAS unsigned char* lds, const Sched& S, const LAS int* cn) {
    LAS unsigned short* tokl = (LAS unsigned short*)(lds + LDS_TOKL);
    const int* list = (const int*)(p.ws + WS_LIST);
    const int tid = threadIdx.x, half = tid >> 8, c = tid & 255;
    int tok[10]; bool val[10];
#pragma unroll
    for (int j = 0; j < 10; ++j) { Unit u; val[j] = S.next(2 * j + half, u); tok[j] = 0;
        if (val[j]) { const int cnt = cn[u.z]; int pos = u.pm * 256 + c; pos = pos < cnt ? pos : cnt - 1; tok[j] = list[(size_t)u.z * T_ + pos]; } }
#pragma unroll
    for (int j = 0; j < 10; ++j) if (val[j]) tokl[(2 * j + half) * 256 + c] = (unsigned short)tok[j];
    __syncthreads();
}
template <class Sched, bool WTAB> __device__ __forceinline__ void moe_fill_tabs(const Params& p, LAS unsigned char* lds, const Sched& S, const LAS int* cn, const float* bias, int ncol) {
    LAS float* btab = (LAS float*)(lds + LDS_BTAB); LAS float* wtab = (LAS float*)(lds + LDS_TOKL);
    const float* wl = (const float*)(p.ws + WS_WLIST);
    const int tid = threadIdx.x, half = tid >> 8, c = tid & 255;
    constexpr int NP = WTAB ? 5 : 10;
    float bv[NP], wv[NP]; bool val[NP];
#pragma unroll
    for (int j = 0; j < NP; ++j) { Unit u; val[j] = S.next(2 * j + half, u); bv[j] = 0.f; wv[j] = 0.f;
        if (val[j]) { bv[j] = bias[(size_t)u.z * ncol + u.pn * 256 + c];
            if constexpr (WTAB) { const int pos = u.pm * 256 + c; if (pos < cn[u.z]) wv[j] = wl[(size_t)u.z * T_ + pos] * YS_SCALE; } } }
#pragma unroll
    for (int j = 0; j < NP; ++j) if (val[j]) { btab[(2 * j + half) * 256 + c] = bv[j]; if constexpr (WTAB) wtab[(2 * j + half) * 256 + c] = wv[j]; }
    __syncthreads();
}
__device__ __forceinline__ void phase_gateup(const Params& p, LAS unsigned char* lds) {
    LAS int* pt = (LAS int*)(lds + LDS_MISC); LAS int* cn = pt + 64;
    moe_tables(p, pt, cn);
    if constexpr (MOE_F8) { SchedMoe<true, 16, true> S{p.ws, pt, cn}; EpiSwiglu8 E{p.ws, p.in[15], pt}; moe_fill_tokl(p, lds, S, cn); moe_fill_tabs<SchedMoe<true, 16, true>, false>(p, lds, S, cn, p.in[15], 4096);
        unsigned long long* prof = PROFSEL == 7 ? (unsigned long long*)(p.ws + WS_CTL + 32768) : nullptr;
        const bool stag = MOE_SLOT && (gridDim.x == 256);
        if (stag) {
            const int g = (int)blockIdx.x >> 6, a = MOE_SLOT_STEP * g;
            if (a > 0) { SchedMoe<true, 16, true> Sa{p.ws, pt, cn, 0, 0, a}; gemm_phase<EpiSwiglu8, SchedMoe<true, 16, true>, MOE_ALIGN, 1>(lds, 2048, 2048, 2048, Sa, E, nullptr); }
            if constexpr (MOE_SLOT_BAL) {
                const int U = S.ptu(NE) * 16, rmax = (U + 255) >> 8, me = (int)blockIdx.x & 63;
                int totd = 0, dme = 0, dbefore = 0;
#pragma unroll 1
                for (int i = 0; i < 64; ++i) { const int c = 64 * g + i, v = (c & 7) * 32 + (c >> 3); const int r = (v < U) ? ((U - v + 255) >> 8) : 0; int d = rmax - r;
#ifdef MOE_BAL_TEST
                    d = (i * 7 + g) % 3 == 0 ? 1 : 0;
#endif
                    totd += d; if (i < me) dbefore += d; if (i == me) dme = d; }
                constexpr int GT = 1024 - 64 * POOL7;
                const int n0 = (GT - MOE_SLOT_BAL * totd) / 64, rem = GT - 64 * n0 - MOE_SLOT_BAL * totd;
                const long base = CV_NONEXP + 8192 + (long)GT * g;
                const int xs = 64 * n0 + MOE_SLOT_BAL * dbefore + (me < rem ? me : rem), xn = MOE_SLOT_BAL * dme + (me < rem ? 1 : 0);
                __syncthreads();
                convert_items(p, lds, base, base + 64 * n0, me, 64);
                if (xn > 0) convert_items(p, lds, base + xs, base + xs + xn, 0, 1);
                asm volatile("s_waitcnt vmcnt(0) lgkmcnt(0)" ::: "memory");
                __syncthreads();
            } else proj_convert_slot(p, lds, g, 2);
            moe_fill_tokl(p, lds, S, cn);
            SchedMoe<true, 16, true> Sb{p.ws, pt, cn, 0, a, 1 << 20}; gemm_phase<EpiSwiglu8, SchedMoe<true, 16, true>, MOE_ALIGN, 1>(lds, 2048, 2048, 2048, Sb, E, prof);
            if (POOL7 > 0) pool_drain(p, lds, 1, CV_NONEXP + 12288 - 256 * POOL7, 256 * POOL7);
        } else gemm_phase<EpiSwiglu8, SchedMoe<true, 16, true>, MOE_ALIGN, 1>(lds, 2048, 2048, 2048, S, E, prof); }
    else { SchedMoe<true, 16, false> S{p.ws, pt, cn}; EpiSwiglu E{p.ws, p.in[15], pt}; moe_fill_tokl(p, lds, S, cn);
        gemm_phase<EpiSwiglu, SchedMoe<true, 16, false>, true>(lds, 2048, 2048, 2048, S, E); }
}
__device__ __forceinline__ void phase_down(const Params& p, LAS unsigned char* lds) {
    LAS int* pt = (LAS int*)(lds + LDS_MISC); LAS int* cn = pt + 64;
    moe_tables(p, pt, cn);
    if constexpr (MOE_F8) { SchedMoe<false, 8, true> S{p.ws, pt, cn}; EpiDown8 E{p.ws, p.in[17], pt, cn}; moe_fill_tabs<SchedMoe<false, 8, true>, true>(p, lds, S, cn, p.in[17], 2048); gemm_phase<EpiDown8, SchedMoe<false, 8, true>, MOE_ALIGN, 1>(lds, 2048, 2048, 2048, S, E, PROFSEL == 8 ? (unsigned long long*)(p.ws + WS_CTL + 32768) : nullptr); }
    else { SchedMoe<false, 8, false> S{p.ws, pt, cn}; EpiDown E{p.ws, p.in[17], pt, cn}; gemm_phase<EpiDown, SchedMoe<false, 8, false>, true>(lds, 2048, 2048, 2048, S, E); }
#ifdef SHADOW
    if constexpr (MOE_F8) { __syncthreads(); SchedMoe<false, 8, true> S{p.ws, pt, cn, SHADOW - 1}; EpiDown8 E{p.ws, p.in[17], pt, cn, (WS_FAST_END + 4095) & ~(size_t)4095};
        gemm_phase<EpiDown8, SchedMoe<false, 8, true>, MOE_ALIGN, 1>(lds, 2048, 2048, 2048, S, E, nullptr); }
#endif
}
__device__ __forceinline__ void phase_out(const Params& p, LAS unsigned char* lds) {
    LAS int* pt = (LAS int*)(lds + LDS_MISC); LAS int* cn = pt + 64;
    moe_tables(p, pt, cn);
    phase_final(p, pt);
}

template <int PH> __global__ void __launch_bounds__(NTHR, 2) k_phase(Params p) {
    extern __shared__ __attribute__((aligned(16))) unsigned char lds_raw[];
    LAS unsigned char* lds = (LAS unsigned char*)lds_raw;
    if constexpr (PH == 0) phase_prologue(p, lds);
    if constexpr (PH == 1) phase_proj(p, lds);
    if constexpr (PH == 2) phase_mixers(p, lds);
    if constexpr (PH == 3) phase_seqdft(p, lds);
    if constexpr (PH == 4) phase_mix(p, lds);
    if constexpr (PH == 5) phase_x2(p, lds);
    if constexpr (PH == 6) phase_rows(p, lds);
    if constexpr (PH == 7) phase_gateup(p, lds);
    if constexpr (PH == 8) phase_down(p, lds);
    if constexpr (PH == 9) phase_out(p, lds);
}
template <int PH> static void launch_phase(const Params& p, hipStream_t st) {
    static bool attr_done = false;
    if (!attr_done) { (void)hipFuncSetAttribute((const void*)k_phase<PH>, hipFuncAttributeMaxDynamicSharedMemorySize, LDS_BYTES); attr_done = true; }
    hipLaunchKernelGGL(k_phase<PH>, dim3(256), dim3(NTHR), LDS_BYTES, st, p);
}
static void run_fast_multi(const Params& p, hipStream_t st, int lo, int hi) {
    if (lo <= 0 && 0 < hi) launch_phase<0>(p, st);
    if (lo <= 1 && 1 < hi) launch_phase<1>(p, st);
    if (lo <= 2 && 2 < hi) launch_phase<2>(p, st);
    if (lo <= 3 && 3 < hi) launch_phase<3>(p, st);
    if (lo <= 4 && 4 < hi) launch_phase<4>(p, st);
    if (lo <= 5 && 5 < hi) launch_phase<5>(p, st);
    if (lo <= 6 && 6 < hi) launch_phase<6>(p, st);
    if (lo <= 7 && 7 < hi) launch_phase<7>(p, st);
    if (lo <= 8 && 8 < hi) launch_phase<8>(p, st);
    if (lo <= 9 && 9 < hi) launch_phase<9>(p, st);
}
#define XB_TMO      128
#define XB_XCNT(j)  (256  + 64 * (j))
#define XB_XSUB(j)  (1280 + 64 * (j))
#define XB_XGEN(j)  (2304 + 64 * (j))
#define XB_TOP      3328
#define XB_TOPGEN   3392
#define XCD_BAR_WORDS 3456
#define XB_SPIN_CAP (1u << 18)

__device__ __forceinline__ unsigned xb_ld(unsigned* p)              { return __hip_atomic_load(p, __ATOMIC_RELAXED, __HIP_MEMORY_SCOPE_AGENT); }
__device__ __forceinline__ unsigned xb_add(unsigned* p, unsigned v) { return __hip_atomic_fetch_add(p, v, __ATOMIC_RELAXED, __HIP_MEMORY_SCOPE_AGENT); }
__device__ __forceinline__ unsigned xb_xcc_id() { return (unsigned)__builtin_amdgcn_s_getreg((3 << 11) | 20) & 0xFu; }
#define XB_SPIN(cond, bar) do { unsigned _sp = 0; while (cond) { __builtin_amdgcn_s_sleep(1); \
    if ((++_sp & 255u) == 0u) { if (xb_ld(&(bar)[XB_TMO])) break; if (_sp > XB_SPIN_CAP) { atomicAdd(&(bar)[XB_TMO], 1u); break; } } } } while (0)

struct XcdBarrier {
    unsigned* bar; unsigned x;
    volatile LAS unsigned* st;
};

__device__ __forceinline__ XcdBarrier xcd_barrier_post(unsigned* bar, volatile LAS unsigned* st) {
    XcdBarrier b; b.bar = bar; b.x = xb_xcc_id(); b.st = st;
    if (threadIdx.x == 0) (void)xb_add(&bar[XB_XCNT(b.x)], 1u);
    return b;
}
__device__ __forceinline__ void xcd_barrier_complete(unsigned* bar, unsigned x, unsigned& nloc, unsigned& nx) {
    const unsigned G = gridDim.x * gridDim.y * gridDim.z;
    unsigned sum, cnt, mine, sp = 0u;
    for (;;) {
        sum = 0u; cnt = 0u; mine = 0u;
#pragma unroll
        for (unsigned j = 0; j < 16; ++j) { const unsigned c = xb_ld(&bar[XB_XCNT(j)]); sum += c; cnt += (c > 0u) ? 1u : 0u; mine = (j == x) ? c : mine; }
        if (sum == G) break;
        __builtin_amdgcn_s_sleep(1);
        if ((++sp & 255u) == 0u) { if (xb_ld(&bar[XB_TMO])) break; if (sp > XB_SPIN_CAP) { atomicAdd(&bar[XB_TMO], 1u); break; } }
    }
    nloc = mine > 0u ? mine : 1u; nx = cnt > 0u ? cnt : 1u;
}

__device__ __forceinline__ void xcd_barrier(const XcdBarrier& b) {
    asm volatile("s_waitcnt vmcnt(0)" ::: "memory");
    __syncthreads();
    if (threadIdx.x == 0) {
        unsigned* bar = b.bar;
        __builtin_amdgcn_s_waitcnt(0);
        unsigned nloc = b.st[0], nx = b.st[1];
        if (nloc == 0u) { xcd_barrier_complete(bar, b.x, nloc, nx); b.st[0] = nloc; b.st[1] = nx; }
        const unsigned old = xb_add(&bar[XB_XSUB(b.x)], 1u);
        const unsigned gen = old / nloc;
        if (old + 1u == (gen + 1u) * nloc) {
            __builtin_amdgcn_fence(__ATOMIC_RELEASE, "agent");
            asm volatile("s_waitcnt vmcnt(0)" ::: "memory");
            const unsigned og = xb_add(&bar[XB_TOP], 1u);
            const unsigned tg = og / nx;
            if (og + 1u == (tg + 1u) * nx) xb_add(&bar[XB_TOPGEN], 1u);
            else XB_SPIN(xb_ld(&bar[XB_TOPGEN]) == tg, bar);
            __builtin_amdgcn_fence(__ATOMIC_ACQUIRE, "agent");
            xb_add(&bar[XB_XGEN(b.x)], 1u);
            asm volatile("s_waitcnt vmcnt(0)" ::: "memory");
        } else {
            XB_SPIN(xb_ld(&bar[XB_XGEN(b.x)]) == gen, bar);
            __builtin_amdgcn_fence(__ATOMIC_ACQUIRE, "agent");
            asm volatile("s_waitcnt vmcnt(0)" ::: "memory");
        }
    }
    __syncthreads();
}

__global__ void __launch_bounds__(NTHR, 2) mega_fwd(Params p) {
    extern __shared__ __attribute__((aligned(16))) unsigned char lds_raw[];
    LAS unsigned char* lds = (LAS unsigned char*)lds_raw;
    volatile LAS unsigned* xbw = (volatile LAS unsigned*)(lds + LDS_XBW);
    if (threadIdx.x < 4) xbw[threadIdx.x] = 0u;
    __syncthreads();
    XcdBarrier bar = xcd_barrier_post((unsigned*)(p.ws + WS_CTL) + CW_BAR, xbw);
#ifndef DBL
#define DBL 0
#endif
#ifndef SKEWPH
#define SKEWPH -1
#endif
#define RUNPH(i, call) do { call; if constexpr ((DBL >> (i)) & 1) { xcd_barrier(bar); call; } \
    if constexpr (SKEWPH == (i)) { if (threadIdx.x == 0) ((unsigned long long*)(p.ws + WS_CTL + 40960))[blockIdx.x] = wall_clock64(); } } while (0)
    RUNPH(0, phase_prologue(p, lds));  xcd_barrier(bar);
    RUNPH(1, phase_proj(p, lds));      xcd_barrier(bar);
    RUNPH(2, phase_mixers(p, lds));    xcd_barrier(bar);
    RUNPH(3, phase_seqdft(p, lds));    xcd_barrier(bar);
    RUNPH(4, phase_mix(p, lds));       xcd_barrier(bar);
    RUNPH(5, phase_x2(p, lds));        xcd_barrier(bar);
    phase_rows(p, lds);                xcd_barrier(bar);
    RUNPH(7, phase_gateup(p, lds));    xcd_barrier(bar);
    RUNPH(8, phase_down(p, lds));      xcd_barrier(bar);
    phase_out(p, lds);
}
static void run_fast_one(const Params& p, hipStream_t st) {
    static int grid = 0;
    if (!grid) {
        int dev = 0, cus = 0, per_cu = 0;
        (void)hipGetDevice(&dev); (void)hipDeviceGetAttribute(&cus, hipDeviceAttributeMultiprocessorCount, dev);
        (void)hipFuncSetAttribute((const void*)mega_fwd, hipFuncAttributeMaxDynamicSharedMemorySize, LDS_BYTES);
        (void)hipOccupancyMaxActiveBlocksPerMultiprocessor(&per_cu, (const void*)mega_fwd, NTHR, LDS_BYTES);
        if (per_cu < 1) per_cu = 1;
        grid = cus > 256 ? 256 : cus;
        grid &= ~7; if (grid < 8) grid = 8;
    }
    hipLaunchKernelGGL(mega_fwd, dim3(grid), dim3(NTHR), LDS_BYTES, st, p);
}
}
#ifndef REPORT
#define REPORT 0
#endif
extern "C" void kernel_launch(void* const* d_in, const int* in_sizes, int n_in, void* d_out, int out_size, void* d_ws, size_t ws_size, hipStream_t stream) {
    (void)in_sizes; (void)n_in; (void)out_size; (void)ws_size;
    unsigned char* ws = (unsigned char*)d_ws;
#if MODE == 0
    nv::NBuf nb; nv::carve(nb, ws);
    nv::run_part1(d_in, nb, stream); nv::run_part2(d_in, nb, (float*)d_out, stream);
#elif MODE == 1
    constexpr size_t NAIVE_BASE = (fx::WS_FAST_END + 4095) & ~(size_t)4095;
    nv::NBuf nb; const size_t nbytes = nv::carve(nb, ws + NAIVE_BASE);
    float* fout = (float*)(ws + NAIVE_BASE + ((nbytes + 4095) & ~(size_t)4095));
    double* acc = (double*)(fout + (size_t)16384 * 2048); float* scale = (float*)(acc + 64);
    fx::Params p; memset(&p, 0, sizeof(p));
    for (int i = 0; i < 19; ++i) p.in[i] = (const float*)d_in[i];
    p.out = fout; p.ws = ws;
    (void)hipMemsetAsync(ws + fx::WS_CTL, 0, fx::CTL_BYTES, stream);
    (void)hipMemsetAsync(acc, 0, 1024, stream);
    nv::run_part1(d_in, nb, stream);
    fx::run_fast_multi(p, stream, 0, 7);
    auto cmp = [&](int slot, int kind, const void* a, const float* ref, long long n, int w, int ldf, int ldr, int off, int sig) {
        ck::CP c; memset(&c, 0, sizeof(c)); c.a = a; c.ref = ref; c.n = n; c.kind = kind; c.w = w; c.ldf = ldf; c.ldr = ldr; c.off = off; c.sig = sig; c.slot = slot;
        hipLaunchKernelGGL(ck::k_cmp, dim3(2048), dim3(256), 0, stream, c, acc); };
    const long long T = 16384;
    cmp(0, 0, ws + fx::WS_FIN, nb.proj, T * 1024, 1024, 1024, 10752, 0, 0);
    cmp(1, 0, ws + fx::WS_Q, nb.proj, T * 2048, 2048, 2048, 10752, 1024, 0);
    cmp(2, 0, ws + fx::WS_K, nb.proj, T * 256, 256, 256, 10752, 3072, 0);
    cmp(3, 2, ws + fx::WS_VT, nb.proj, T * 256, 0, 0, 0, 0, 0);
    cmp(4, 0, ws + fx::WS_QM, nb.proj, T * 1024, 1024, 1024, 10752, 3584, 0);
    cmp(5, 0, ws + fx::WS_GATES, nb.proj, T * 6144, 6144, 6144, 10752, 4608, 1);
    cmp(6, 0, ws + fx::WS_KMK, nb.kvm, 2048LL * 1024, 1024, 1024, 2048, 0, 0);
    cmp(7, 3, ws + fx::WS_VMT, nb.kvm, 2048LL * 1024, 0, 0, 0, 0, 0);
    cmp(8, 0, ws + fx::WS_ATT, nb.att, T * 2048, 2048, 2048, 2048, 0, 0);
    cmp(9, 0, ws + fx::WS_XM, nb.xm, T * 1024, 1024, 1024, 1024, 0, 0);
    cmp(10, 0, ws + fx::WS_FM, nb.fm, T * 1024, 1024, 1024, 1024, 0, 0);
    cmp(11, 0, ws + fx::WS_MIXED, nb.mixed, T * 2048, 2048, 2048, 2048, 0, 0);
    cmp(12, 1, ws + fx::WS_X2, nb.x2, T * 2048, 2048, 2048, 2048, 0, 0);
    cmp(13, 0, ws + fx::WS_H2, nb.h2, T * 2048, 2048, 2048, 2048, 0, 0);
    hipLaunchKernelGGL(ck::k_cmp_route, dim3(64), dim3(256), 0, stream, (const int*)(ws + fx::WS_TOKE), (const int*)nb.tope, acc, 14);
    nv::run_part2(d_in, nb, nb.nout, stream);
    fx::run_fast_multi(p, stream, 7, 10);
    cmp(15, 1, fout, nb.nout, T * 2048, 2048, 2048, 2048, 0, 0);
    hipLaunchKernelGGL(ck::k_verdict, dim3(1), dim3(64), 0, stream, (const double*)acc, scale, 16, (int)REPORT);
    hipLaunchKernelGGL(ck::k_scale_out, dim3(2048), dim3(256), 0, stream, (const float*)nb.nout, (const float*)scale, (float*)d_out, T * 2048);
#elif MODE == 2
    fx::Params p; memset(&p, 0, sizeof(p));
    for (int i = 0; i < 19; ++i) p.in[i] = (const float*)d_in[i];
    p.out = (float*)d_out; p.ws = ws;
    (void)hipMemsetAsync(ws + fx::WS_CTL, 0, fx::CTL_BYTES, stream);
    fx::run_fast_multi(p, stream, 0, 10);
#elif MODE == 3
    fx::Params p; memset(&p, 0, sizeof(p));
    for (int i = 0; i < 19; ++i) p.in[i] = (const float*)d_in[i];
    p.out = (float*)d_out; p.ws = ws;
    (void)hipMemsetAsync(ws + fx::WS_CTL, 0, fx::CTL_BYTES, stream);
    fx::run_fast_one(p, stream);
#endif
}
```

```cpp
#include <hip/hip_runtime.h>
#include <stdint.h>
#include <string.h>
#ifndef MODE
#define MODE 3
#endif
namespace fx {
#define LAS __attribute__((address_space(3)))
typedef unsigned short bf16_t;
typedef short bf16x8 __attribute__((ext_vector_type(8)));
typedef short s16x4 __attribute__((ext_vector_type(4)));
typedef float f32x4 __attribute__((ext_vector_type(4)));
typedef float f32x16 __attribute__((ext_vector_type(16)));
typedef float f32x2 __attribute__((ext_vector_type(2)));
typedef __bf16 bf16x2_t __attribute__((ext_vector_type(2)));
typedef unsigned u32x4 __attribute__((ext_vector_type(4)));
typedef unsigned u32x2 __attribute__((ext_vector_type(2)));

constexpr int NTHR = 512, NWAVE = 8;
constexpr int B_ = 8, S_ = 2048, DM = 2048, T_ = B_ * S_;
constexpr int MEM = 256, FW = 1024, FG = 4, FGD = 256;
constexpr int NH = 32, NKV = 4, HD = 64, AW = 2048, KVW = 256, WIN = 128;
constexpr int MH = 4, MHD = 256, MW = 1024;
constexpr int NE = 32, TOPK = 4, DFF = 2048;
constexpr int INW = 10752;
#ifndef LDPAD
#define LDPAD 0
#endif
#ifndef SQPAD
#define SQPAD 0
#endif
constexpr int LDP = 2048 + LDPAD;
constexpr int NSLOT = T_ * TOPK + NE * 256;
constexpr float LOG2E = 1.4426950408889634f;
#ifndef MOE_FP8
#define MOE_FP8 1
#endif
constexpr bool MOE_F8 = (MOE_FP8 != 0);
#ifndef GATES_FP8
#define GATES_FP8 1
#endif
constexpr bool GATES_F8 = (GATES_FP8 != 0);
#ifndef CONV_TILE32
#define CONV_TILE32 0
#endif
#ifndef MOE_ALIGN
#define MOE_ALIGN true
#endif
#ifndef PROFSEL
#define PROFSEL 0
#endif
#ifndef PROFMETRIC
#define PROFMETRIC 0
#endif
#ifndef PROFMUL
#define PROFMUL 1
#endif
#ifndef PROFBLK
#define PROFBLK 0
#endif

constexpr size_t al256(size_t x) { return (x + 255) & ~(size_t)255; }
constexpr size_t WS_CTL = 0, CTL_BYTES = 65536;
constexpr size_t WS_WINT = 1u << 20;
constexpr size_t WS_WMKVT = WS_WINT + (size_t)INW * LDP * 2;
constexpr size_t WS_WFOT = WS_WMKVT + (size_t)2048 * LDP * 2;
constexpr size_t WS_WAOT = WS_WFOT + (size_t)2048 * 1024 * 2;
constexpr size_t WS_WMOT = WS_WAOT + (size_t)2048 * 2048 * 2;
constexpr size_t WS_WOT = WS_WMOT + (size_t)2048 * 1024 * 2;
constexpr size_t WS_WRT = WS_WOT + (size_t)2048 * 2048 * 2;
constexpr size_t WS_TABT = WS_WRT + (size_t)NE * DM * 2;
constexpr size_t WS_DMAT = WS_TABT + (size_t)512 * 256 * 2;
constexpr int SQP = 4096 + SQPAD;
constexpr size_t WS_WGUT = WS_DMAT + (size_t)2048 * SQP * 2;
constexpr size_t WS_WDNT = WS_WGUT + (size_t)NE * 4096 * 2048 * 2;
constexpr size_t WS_H = WS_WDNT + (size_t)NE * 2048 * 2048 * 2;
constexpr size_t WS_MEMBF = WS_H + (size_t)T_ * LDP * 2;
constexpr size_t WS_FIN = WS_MEMBF + (size_t)2048 * LDP * 2;
constexpr size_t WS_Q = WS_FIN + (size_t)T_ * FW * 2;
constexpr size_t WS_K = WS_Q + (size_t)T_ * AW * 2;
constexpr size_t WS_VT = WS_K + (size_t)T_ * KVW * 2;
constexpr size_t WS_QM = WS_VT + (size_t)T_ * KVW * 2;
constexpr size_t WS_GATES = WS_QM + (size_t)T_ * MW * 2;
constexpr size_t WS_KMK = WS_GATES + (size_t)T_ * 3 * DM * 2;
constexpr size_t WS_VMT = WS_KMK + (size_t)2048 * 1024 * 2;
constexpr size_t WS_ZT = WS_VMT + (size_t)2048 * 1024 * 2;
constexpr size_t WS_FM = WS_ZT + (size_t)32 * 256 * SQP * 2;
constexpr size_t WS_ATT = WS_FM + (size_t)T_ * FW * 2;
constexpr size_t WS_PM = WS_ATT + (size_t)T_ * AW * 2;
constexpr size_t WS_XM = WS_PM + (size_t)T_ * MH * 256 * 2;
constexpr size_t WS_MIXACC = WS_XM + (size_t)T_ * MW * 2;
constexpr size_t WS_MIXED = WS_MIXACC + (size_t)T_ * DM * 4;
constexpr size_t WS_FX = WS_MIXACC;
constexpr size_t WS_WFM = WS_MIXACC + (size_t)T_ * 2048 * 2;
constexpr size_t WS_IRSTD = WS_WFM + (size_t)2048 * 2048 * 2;
static_assert(WS_IRSTD + (size_t)T_ * 4 <= WS_MIXED, "fused-mix operands fit the old mixacc region");
constexpr size_t WS_X2 = WS_MIXED + (size_t)T_ * DM * 2;
constexpr size_t WS_H2 = WS_X2 + (size_t)T_ * DM * 4;
constexpr size_t WS_TOKE = WS_H2 + (size_t)T_ * DM * 2;
constexpr size_t WS_TOKPOS = WS_TOKE + (size_t)T_ * 4 * 4;
constexpr size_t WS_TOKW = WS_TOKPOS + (size_t)T_ * 4 * 4;
constexpr size_t WS_LIST = WS_TOKW + (size_t)T_ * 4 * 4;
constexpr size_t WS_WLIST = WS_LIST + (size_t)NE * T_ * 4;
constexpr size_t WS_WGUQ = WS_WLIST + (size_t)NE * T_ * 4;
constexpr size_t WS_WDNQ = WS_WGUQ + (size_t)NE * 4096 * 2048;
constexpr size_t WS_H2Q = WS_WDNQ + (size_t)NE * 2048 * 2048;
constexpr size_t WS_H8 = WS_H2Q + (size_t)T_ * DM;
constexpr size_t WS_WINQ = WS_H8 + (size_t)T_ * DM;
constexpr size_t WS_FAST_END = WS_WINQ + (size_t)6144 * DM;
constexpr size_t WS_ACTQ = WS_H;
constexpr float WQ_SCALE = 32.0f, WQ_INV = 1.0f / 32.0f;
constexpr float YS_SCALE = 16.0f, YS_INV = 1.0f / 16.0f;
constexpr size_t WS_ACT = WS_H;
constexpr size_t WS_YS = WS_ACT + (size_t)NSLOT * DFF * 2;
static_assert(WS_YS + (size_t)NSLOT * DM * 2 <= WS_MIXED, "overlay fits");
constexpr int CW_CNT = 0;
constexpr int CW_POOL = 64;
constexpr int CW_BAR = 4096;

constexpr int LDS_STAGE = 0, STAGE_BYTES = 131072;
constexpr int LDS_TOKL = 131072;
constexpr int LDS_MISC = 141312;
constexpr int LDS_BTAB = 142336;
constexpr int LDS_XBW = 163824;
constexpr int LDS_BYTES = 163840;

struct Params {
    const float* in[19]; float* out; unsigned char* ws;
};

__device__ __forceinline__ unsigned cvtpk(float lo, float hi) { f32x2 v = {lo, hi}; bf16x2_t b = __builtin_convertvector(v, bf16x2_t); return __builtin_bit_cast(unsigned, b); }
__device__ __forceinline__ float bf2f(unsigned short x) { return __uint_as_float(((unsigned)x) << 16); }
__device__ __forceinline__ float bflo(unsigned w) { return __uint_as_float(w << 16); }
__device__ __forceinline__ float bfhi(unsigned w) { return __uint_as_float(w & 0xffff0000u); }
__device__ __forceinline__ float wsum(float v) {
#pragma unroll
    for (int o = 1; o < 64; o <<= 1) v += __shfl_xor(v, o);
    return v;
}
__device__ __forceinline__ float sigmoid_sc(float x, float nsc) { return __builtin_amdgcn_rcpf(1.0f + __builtin_amdgcn_exp2f(x * nsc)); }
__device__ __forceinline__ float sigmoidf_(float x) { return __builtin_amdgcn_rcpf(1.0f + __builtin_amdgcn_exp2f(-x * LOG2E)); }
__device__ __forceinline__ int crow(int r, int h) { return (r & 3) + 8 * (r >> 2) + 4 * h; }
__device__ __forceinline__ int t5_bucket(int rel) {
    const int n = rel < 0 ? -rel : rel;
    int b;
    if (n < 8) b = n; else if (n < 12) b = 8; else if (n < 16) b = 9; else if (n < 23) b = 10; else if (n < 32) b = 11;
    else if (n < 46) b = 12; else if (n < 64) b = 13; else if (n < 91) b = 14; else b = 15;
    return (rel > 0 ? 16 : 0) + b;
}
__device__ __forceinline__ int vwg() { const int c = blockIdx.x, G = gridDim.x; return ((G & 7) == 0) ? (c & 7) * (G >> 3) + (c >> 3) : c; }

constexpr int BM = 256, BK = 64, HALF = 128, HTB = HALF * BK * 2;
__host__ __device__ __forceinline__ int lds_byte(int r, int c) { const int st = (r >> 4) * 2 + (c >> 5), rr = r & 15, cc = c & 31, ob = rr * 64 + cc * 2; return st * 1024 + (ob ^ (((ob >> 9) & 1) << 5)); }
__host__ __device__ __forceinline__ void stage_rc(int b, int& R, int& C) { const int st = b / 1024, sb = b % 1024, swz = sb ^ (((sb >> 9) & 1) << 5); R = (st >> 1) * 16 + swz / 64; C = (st & 1) * 32 + (swz % 64) / 2; }
__host__ __device__ __forceinline__ int perm32(int rho) { const int n = rho >> 4, i = rho & 15; return 8 * (i >> 2) + 4 * n + (i & 3); }

struct Unit { int pm, pn, z, idx; };
template <class S, class = void> struct SchedVarK { static constexpr bool v = false; };
template <class S> struct SchedVarK<S, decltype((void)S::VARK)> { static constexpr bool v = S::VARK; };
template <class E, class = void> struct EpiTouch { static constexpr bool v = false; };
template <class E> struct EpiTouch<E, decltype((void)E::TOUCH)> { static constexpr bool v = E::TOUCH; };
template <class E, class = void> struct EpiKeep { static constexpr bool v = false; };
template <class E> struct EpiKeep<E, decltype((void)E::KEEP)> { static constexpr bool v = E::KEEP; };
typedef int v4i_t __attribute__((ext_vector_type(4)));
typedef int v8i_t __attribute__((ext_vector_type(8)));
__device__ __forceinline__ void mfma_f8(f32x4& c, const v8i_t& a, const v8i_t& b) { asm volatile("v_mfma_f32_16x16x128_f8f6f4 %0, %1, %2, %0" : "+v"(c) : "v"(a), "v"(b)); }
template <int ESZ> struct FragT;
template <> struct FragT<2> { struct A4 { bf16x8 v[4][2]; }; struct B2 { bf16x8 v[2][2]; }; };
template <> struct FragT<1> { struct A4 { v8i_t v[4]; }; struct B2 { v8i_t v[2]; }; };
__device__ __forceinline__ v8i_t cat8(bf16x8 a, bf16x8 b) { return __builtin_shufflevector(__builtin_bit_cast(v4i_t, a), __builtin_bit_cast(v4i_t, b), 0, 1, 2, 3, 4, 5, 6, 7); }

template <class Epi, class Sched, bool ALIGN_EPI, int ESZ = 2  >
__device__ __forceinline__ void gemm_phase(LAS unsigned char* lds, const int K, const int lda, const int ldb, const Sched& S, const Epi& E, unsigned long long* prof = nullptr) {
    unsigned long long pf_kl = 0, pf_ep = 0, pf_t0 = 0, pf_t1 = 0, pf_n = 0; const unsigned long long pf_w0 = prof ? wall_clock64() : 0ull, pf_c0 = prof ? clock64() : 0ull;
    int tid_ = threadIdx.x; asm volatile("" : "+v"(tid_));
    const int tid = tid_, wid = __builtin_amdgcn_readfirstlane(tid >> 6), lane = tid & 63, wr = wid >> 2, wc = wid & 3, fr = lane & 15, fq = lane >> 4;
    const int nt = (K * ESZ) / (BK * 2);
    constexpr bool GATHER = Sched::GATHER;
    unsigned voffA[2], voffB[2]; int Rr[2], Cb[2];
#pragma unroll
    for (int i = 0; i < 2; ++i) { int R, C; stage_rc(tid * 16 + i * 8192, R, C);
        int Rb = R;
        if constexpr ((int)Epi::PERM == 1) Rb = (R & ~31) + perm32(R & 31);
        if constexpr ((int)Epi::PERM == 2) Rb = 64 * (R >> 5) + 16 * ((R >> 2) & 3) + 4 * ((R >> 4) & 1) + (R & 3);
        voffA[i] = (unsigned)(R * lda * ESZ + C * 2); voffB[i] = (unsigned)(Rb * ldb * ESZ + C * 2); Rr[i] = R; Cb[i] = C * 2; }
    const size_t kstep = (size_t)(BK * 2);
    const size_t hstepA = (size_t)HALF * lda * ESZ, hstepB = (size_t)(((int)Epi::PERM == 2) ? 8 : HALF) * ldb * ESZ;
    const unsigned ldsw = (unsigned)wid * 1024u;
    const int aoff = lds_byte(wr * 64 + fr, fq * 8), boff = lds_byte(wc * 32 + fr, fq * 8);
#define PG8_SA(b, h) (((b) * 2 + (h)) * HTB)
#define PG8_SB(b, h) ((4 + (b) * 2 + (h)) * HTB)
#define PG8_STAGE(bufoff, gbase, voff) do { _Pragma("unroll") for (int _i = 0; _i < 2; ++_i) \
        __builtin_amdgcn_global_load_lds((const unsigned*)((const char*)(gbase) + (voff)[_i]), (LAS unsigned*)(lds + (bufoff) + ldsw + _i * 8192), 16, 0, 0); } while (0)
#define PG8_STAGE_A(bufoff, gbase, h, NX) do { if constexpr (GATHER) { _Pragma("unroll") for (int _i = 0; _i < 2; ++_i) { const unsigned _o = (NX) ? naoff[h][_i] : caoff[h][_i]; \
        __builtin_amdgcn_global_load_lds((const unsigned*)((const char*)(gbase) + _o), (LAS unsigned*)(lds + (bufoff) + ldsw + _i * 8192), 16, 0, 0); } } \
        else { PG8_STAGE(bufoff, (const char*)(gbase) + (h) * hstepA, voffA); } } while (0)
#define PG8_LDA(dst, b, h) do { _Pragma("unroll") for (int m = 0; m < 4; ++m) { if constexpr (ESZ == 2) { _Pragma("unroll") for (int k = 0; k < 2; ++k) dst.v[m][k] = *(const LAS bf16x8*)(lds + PG8_SA(b, h) + aoff + m * 2048 + k * 1024); } \
        else { const v4i_t _lo = *(const LAS v4i_t*)(lds + PG8_SA(b, h) + aoff + m * 2048), _hi = *(const LAS v4i_t*)(lds + PG8_SA(b, h) + aoff + m * 2048 + 1024); dst.v[m] = __builtin_shufflevector(_lo, _hi, 0, 1, 2, 3, 4, 5, 6, 7); } } } while (0)
#define PG8_LDB(dst, b, h) do { _Pragma("unroll") for (int n = 0; n < 2; ++n) { if constexpr (ESZ == 2) { _Pragma("unroll") for (int k = 0; k < 2; ++k) dst.v[n][k] = *(const LAS bf16x8*)(lds + PG8_SB(b, h) + boff + n * 2048 + k * 1024); } \
        else { const v4i_t _lo = *(const LAS v4i_t*)(lds + PG8_SB(b, h) + boff + n * 2048), _hi = *(const LAS v4i_t*)(lds + PG8_SB(b, h) + boff + n * 2048 + 1024); dst.v[n] = __builtin_shufflevector(_lo, _hi, 0, 1, 2, 3, 4, 5, 6, 7); } } } while (0)
#define PG8_MMA(ai, bj, At, Bt) do { __builtin_amdgcn_s_setprio(1); _Pragma("unroll") for (int m = 0; m < 4; ++m) _Pragma("unroll") for (int n = 0; n < 2; ++n) { \
        if constexpr (ESZ == 2) { _Pragma("unroll") for (int k = 0; k < 2; ++k) acc[ai][bj][m][n] = __builtin_amdgcn_mfma_f32_16x16x32_bf16(Bt.v[n][k], At.v[m][k], acc[ai][bj][m][n], 0, 0, 0); } \
        else { mfma_f8(acc[ai][bj][m][n], Bt.v[n], At.v[m]); } } \
        __builtin_amdgcn_s_setprio(0); } while (0)
#define PG8_WAIT_V(n) asm volatile("s_waitcnt vmcnt(" #n ")" ::: "memory")
#define PG8_WAIT_V8R do { if (relax) asm volatile("s_waitcnt vmcnt(%0)" :: "n"(8 + Epi::NSTORE) : "memory"); else PG8_WAIT_V(8); } while (0)
#define PG8_WAIT_L(n) asm volatile("s_waitcnt lgkmcnt(" #n ")" ::: "memory")
#define PG8_BAR __builtin_amdgcn_s_barrier()
#define PG8_SCHED __builtin_amdgcn_sched_barrier(0)
    Unit cur, nxt; int ui = 0;
    if (!S.next(0, cur)) return;
    f32x4 acc[2][2][4][2];
#pragma unroll
    for (int a = 0; a < 2; ++a)
#pragma unroll
        for (int b = 0; b < 2; ++b)
#pragma unroll
            for (int m = 0; m < 4; ++m)
#pragma unroll
                for (int n = 0; n < 2; ++n) acc[a][b][m][n] = (f32x4){0.f, 0.f, 0.f, 0.f};
    typedef typename FragT<ESZ>::A4 FragA; typedef typename FragT<ESZ>::B2 FragB;
    FragA At; FragB B0, B1;
    unsigned caoff[2][2] = {{0u, 0u}, {0u, 0u}}, naoff[2][2] = {{0u, 0u}, {0u, 0u}};
    if constexpr (GATHER) {
#pragma unroll
        for (int h = 0; h < 2; ++h)
#pragma unroll
            for (int i = 0; i < 2; ++i) { caoff[h][i] = S.arow(cur, h * HALF + Rr[i]) + (unsigned)Cb[i]; naoff[h][i] = caoff[h][i]; }
    }
    const char* cA = S.baseA(cur); const char* cB = S.baseB(cur);
    PG8_STAGE(PG8_SB(0, 0), cB, voffB); PG8_STAGE(PG8_SB(0, 1), cB + hstepB, voffB); PG8_STAGE_A(PG8_SA(0, 0), cA, 0, false); PG8_STAGE_A(PG8_SA(0, 1), cA, 1, false);
    if (wr == 1) PG8_BAR;
    PG8_WAIT_V(2); PG8_BAR;
    PG8_STAGE(PG8_SB(1, 0), cB + kstep, voffB); PG8_STAGE_A(PG8_SA(1, 0), cA + kstep, 0, false); PG8_STAGE(PG8_SB(1, 1), cB + hstepB + kstep, voffB);
    PG8_WAIT_V(6); PG8_BAR;
    for (;;) {
        const bool has_next = S.next(ui + 1, nxt);
        const char* nA = has_next ? S.baseA(nxt) : cA; const char* nB = has_next ? S.baseB(nxt) : cB;
        if constexpr (GATHER) {
            if (has_next) {
#pragma unroll
                for (int h = 0; h < 2; ++h)
#pragma unroll
                    for (int i = 0; i < 2; ++i) naoff[h][i] = S.arow(nxt, h * HALF + Rr[i]) + (unsigned)Cb[i];
            } else {
#pragma unroll
                for (int h = 0; h < 2; ++h)
#pragma unroll
                    for (int i = 0; i < 2; ++i) naoff[h][i] = caoff[h][i];
            }
        }
        if (prof) pf_t0 = clock64();
        if constexpr (EpiTouch<Epi>::v) E.touch(cur, lds, tid, wid);
        int ntu = nt; if constexpr (SchedVarK<Sched>::v) ntu = S.ktiles(cur);
#pragma unroll 1
        for (int t = 0; t < ntu; t += 2) {
            const bool last = (t == ntu - 2);
            const bool relax = (Epi::NSTORE > 0) && (t == 0) && (ui > 0);
            const char* a1 = cA + (size_t)(t + 1) * kstep;
            const char* a2 = last ? nA : cA + (size_t)(t + 2) * kstep; const char* b2 = last ? nB : cB + (size_t)(t + 2) * kstep;
            const char* a3 = a2 + kstep; const char* b3 = b2 + kstep;
            PG8_LDB(B0, 0, 0); PG8_LDB(B1, 0, 1); PG8_SCHED; PG8_LDA(At, 0, 0); PG8_STAGE_A(PG8_SA(1, 1), a1, 1, false);
            PG8_WAIT_V(8); PG8_WAIT_L(0); PG8_BAR; PG8_MMA(0, 0, At, B0); PG8_MMA(0, 1, At, B1); PG8_BAR; PG8_SCHED;
            PG8_LDA(At, 0, 1); PG8_STAGE(PG8_SB(0, 0), b2, voffB); PG8_STAGE(PG8_SB(0, 1), b2 + hstepB, voffB); PG8_STAGE_A(PG8_SA(0, 0), a2, 0, last);
            PG8_WAIT_V(8); PG8_WAIT_L(0); PG8_BAR; PG8_MMA(1, 0, At, B0); PG8_MMA(1, 1, At, B1); PG8_BAR; PG8_SCHED;
            PG8_LDB(B0, 1, 0); PG8_LDB(B1, 1, 1); PG8_SCHED; PG8_LDA(At, 1, 0); PG8_STAGE_A(PG8_SA(0, 1), a2, 1, last);
            PG8_WAIT_V(8); PG8_WAIT_L(0); PG8_BAR; PG8_MMA(0, 0, At, B0); PG8_MMA(0, 1, At, B1); PG8_BAR; PG8_SCHED;
            PG8_LDA(At, 1, 1); PG8_STAGE(PG8_SB(1, 0), b3, voffB); PG8_STAGE(PG8_SB(1, 1), b3 + hstepB, voffB); PG8_STAGE_A(PG8_SA(1, 0), a3, 0, last);
            PG8_WAIT_V(8); PG8_WAIT_L(0); PG8_BAR; PG8_MMA(1, 0, At, B0); PG8_MMA(1, 1, At, B1); PG8_BAR; PG8_SCHED;
        }
        if (prof) { pf_t1 = clock64(); pf_kl += pf_t1 - pf_t0; }
        if constexpr (ESZ == 1) asm volatile("s_nop 15\n\ts_nop 15" ::: "memory");
        if constexpr (ALIGN_EPI) { if (wr == 0) PG8_BAR; }
        if constexpr (!Epi::AFTER_DRAIN) { int fr_e = fr, fq_e = fq; asm volatile("" : "+v"(fr_e), "+v"(fq_e));
            E(acc, cur, wr, wc, fr_e, fq_e); }
        if (prof) { pf_ep += clock64() - pf_t1; ++pf_n; }
        if (!has_next) break;
        bool zero = true; if constexpr (EpiKeep<Epi>::v) zero = !E.keep(cur);
        if (zero) {
#pragma unroll
        for (int a = 0; a < 2; ++a)
#pragma unroll
            for (int b = 0; b < 2; ++b)
#pragma unroll
                for (int m = 0; m < 4; ++m)
#pragma unroll
                    for (int n = 0; n < 2; ++n) acc[a][b][m][n] = (f32x4){0.f, 0.f, 0.f, 0.f};
        }
        cur = nxt; cA = nA; cB = nB; ++ui;
        if constexpr (GATHER) {
#pragma unroll
            for (int h = 0; h < 2; ++h)
#pragma unroll
                for (int i = 0; i < 2; ++i) caoff[h][i] = naoff[h][i];
        }
        if constexpr (ALIGN_EPI) { if (wr == 1) PG8_BAR; }
    }
    PG8_WAIT_V(0);
    if constexpr (!ALIGN_EPI) { if (wr == 0) PG8_BAR; }
    PG8_BAR;
    if (prof && blockIdx.x == PROFBLK && tid == 0) { prof[0] = pf_kl; prof[1] = pf_ep; prof[2] = pf_n; prof[3] = (unsigned long long)nt; prof[4] = clock64() - pf_c0; prof[5] = wall_clock64() - pf_w0; }
    if constexpr (Epi::AFTER_DRAIN) { int fr_e = fr, fq_e = fq; asm volatile("" : "+v"(fr_e), "+v"(fq_e)); E.fused(acc, cur, wr, wc, fr_e, fq_e, lds, wid, lane); }
#undef PG8_SA
#undef PG8_SB
#undef PG8_STAGE
#undef PG8_STAGE_A
#undef PG8_LDA
#undef PG8_LDB
#undef PG8_MMA
#undef PG8_WAIT_V
#undef PG8_WAIT_V8R
#undef PG8_WAIT_L
#undef PG8_BAR
#undef PG8_SCHED
}
constexpr int NXCD = 8;
#ifndef RES_FROM_H
#define RES_FROM_H 1
#endif
#ifndef EPI_TOUCH
#define EPI_TOUCH 0
#endif
#ifndef PROJ_WGM
#define PROJ_WGM 8
#endif
__device__ __forceinline__ void static_tile(int L, int nM, int nN, int& pm, int& pn, const int WGM = 8) {
    const int nwg = nM * nN; int wgid = L;
    { const int q = nwg / NXCD, r = nwg % NXCD, xcd = wgid % NXCD, off = wgid / NXCD; wgid = (xcd < r ? xcd * (q + 1) : r * (q + 1) + (xcd - r) * q) + off; }
    const int nig = WGM * nN, gid = wgid / nig, fm = gid * WGM, gsz = (nM - fm) < WGM ? (nM - fm) : WGM;
    pm = fm + ((wgid % nig) % gsz); pn = (wgid % nig) / gsz;
}
struct SchedPlain {
    static constexpr bool GATHER = false;
    const char* A; const char* Bt; size_t tstepA, tstepB; int nM, nN; int r0 = 0, r1 = 1 << 20;
    __device__ __forceinline__ bool next(int i, Unit& u) const { const int k = i + r0; if (k >= r1) return false;
        const int L = k * (int)gridDim.x + (int)blockIdx.x; if (L >= nM * nN) return false; static_tile(L, nM, nN, u.pm, u.pn); u.z = 0; return true; }
    __device__ __forceinline__ const char* baseA(const Unit& u) const { return A + (size_t)u.pm * tstepA; }
    __device__ __forceinline__ const char* baseB(const Unit& u) const { return Bt + (size_t)u.pn * tstepB; }
    __device__ __forceinline__ unsigned arow(const Unit&, int) const { return 0u; }
};
struct SchedProj {
    static constexpr bool GATHER = false;
    const unsigned char* ws; int r0, r1;
    __device__ __forceinline__ bool next(int i, Unit& u) const {
        if (i + r0 >= r1) return false;
        const int L = (i + r0) * (int)gridDim.x + (int)blockIdx.x;
        constexpr int NPB = GATES_F8 ? 18 : 42;
        if (L < 64 * NPB) { static_tile(L, 64, NPB, u.pm, u.pn, PROJ_WGM); u.z = (u.pn == 13) ? 2 : 0; return true; }
        const int L2 = L - 64 * NPB; if (L2 >= 64) return false;
        if (L2 < 32) { u.pm = L2 & 7; u.pn = L2 >> 3; u.z = 1; } else { u.pm = (L2 - 32) & 3; u.pn = (L2 - 32) >> 2; u.z = 3; }
        return true;
    }
    __device__ __forceinline__ const char* baseA(const Unit& u) const {
        const size_t ts = (size_t)256 * LDP * 2;
        if (u.z == 0) return (const char*)ws + WS_H + (size_t)u.pm * ts;
        if (u.z == 2) return (const char*)ws + WS_WINT + (size_t)13 * ts;
        if (u.z == 1) return (const char*)ws + WS_MEMBF + (size_t)u.pm * ts;
        return (const char*)ws + WS_WMKVT + (size_t)(4 + u.pm) * ts;
    }
    __device__ __forceinline__ const char* baseB(const Unit& u) const {
        const size_t ts = (size_t)256 * LDP * 2;
        if (u.z == 0) return (const char*)ws + WS_WINT + (size_t)u.pn * ts;
        if (u.z == 2) return (const char*)ws + WS_H + (size_t)u.pm * ts;
        if (u.z == 1) return (const char*)ws + WS_WMKVT + (size_t)u.pn * ts;
        return (const char*)ws + WS_MEMBF + (size_t)u.pn * ts;
    }
    __device__ __forceinline__ unsigned arow(const Unit&, int) const { return 0u; }
};
struct SchedGates8 {
    static constexpr bool GATHER = false;
    const unsigned char* ws; int r0, r1;
    __device__ __forceinline__ bool next(int i, Unit& u) const {
        if (i + r0 >= r1) return false;
        const int L = (i + r0) * (int)gridDim.x + (int)blockIdx.x; if (L >= 64 * 24) return false;
        static_tile(L, 64, 24, u.pm, u.pn, PROJ_WGM); u.z = 0; return true;
    }
    __device__ __forceinline__ const char* baseA(const Unit& u) const { return (const char*)ws + WS_H8 + (size_t)u.pm * (256 * 2048); }
    __device__ __forceinline__ const char* baseB(const Unit& u) const { return (const char*)ws + WS_WINQ + (size_t)u.pn * (256 * 2048); }
    __device__ __forceinline__ unsigned arow(const Unit&, int) const { return 0u; }
};
struct SchedChan {
    static constexpr bool GATHER = false;
    const unsigned char* ws; int u0, nu;
    __device__ __forceinline__ bool next(int i, Unit& u) const {
        const int L = i * (int)gridDim.x + vwg(); if (L >= 512) return false;
        u.z = L >> 4; u.pm = (L >> 3) & 1; u.pn = L & 7; return true;
    }
    __device__ __forceinline__ const char* baseA(const Unit& u) const { return (const char*)ws + WS_TABT + (size_t)u.pm * (256 * 256 * 2); }
    __device__ __forceinline__ const char* baseB(const Unit& u) const { const int b = u.z >> 2, g = u.z & 3; return (const char*)ws + WS_FIN + ((size_t)(b * 2048 + u.pn * 256) * 1024 + g * 256) * 2; }
    __device__ __forceinline__ unsigned arow(const Unit&, int) const { return 0u; }
};
struct SchedSeq {
    static constexpr bool GATHER = false;
    const unsigned char* ws;
    __device__ __forceinline__ bool next(int i, Unit& u) const {
        const int L = i * (int)gridDim.x + vwg(); if (L >= 256) return false;
        u.z = L >> 3; u.pm = L & 7; u.pn = 0; return true;
    }
    __device__ __forceinline__ const char* baseA(const Unit& u) const { return (const char*)ws + WS_DMAT + (size_t)u.pm * ((size_t)256 * SQP * 2); }
    __device__ __forceinline__ const char* baseB(const Unit& u) const { return (const char*)ws + WS_ZT + (size_t)u.z * ((size_t)256 * SQP * 2); }
    __device__ __forceinline__ unsigned arow(const Unit&, int) const { return 0u; }
};
struct SchedOne {
    static constexpr bool GATHER = false;
    const char* A; const char* Bt; int z; bool valid;
    __device__ __forceinline__ bool next(int i, Unit& u) const { if (i != 0 || !valid) return false; u.pm = 0; u.pn = 0; u.z = z; return true; }
    __device__ __forceinline__ const char* baseA(const Unit&) const { return A; }
    __device__ __forceinline__ const char* baseB(const Unit&) const { return Bt; }
    __device__ __forceinline__ unsigned arow(const Unit&, int) const { return 0u; }
};
template <bool GATH, int NT  , bool F8>
struct SchedMoe {
    static constexpr bool GATHER = GATH;
    static constexpr int ES = F8 ? 1 : 2;
    const unsigned char* ws; const LAS int* pt; const LAS int* cn; int same = 0;
    int r0 = 0, r1 = 1 << 20;
    __device__ __forceinline__ int ptu(int k) const { return __builtin_amdgcn_readfirstlane(pt[k]); }
    __device__ __forceinline__ bool next(int i, Unit& u) const {
        const int k = i + r0; if (k >= r1) return false;
        const int L = k * (int)gridDim.x + vwg(); const int total = ptu(NE) * NT; if (L >= total) return false;
        const int ln = (int)(threadIdx.x & 63);
        const unsigned long long bal = __ballot(ln < NE && L >= pt[ln & 31] * NT);
        const int e = __builtin_amdgcn_readfirstlane(__popcll(bal) - 1);
        const int t = L - ptu(e) * NT, mte = ptu(e + 1) - ptu(e);
        u.z = e; u.pm = t % mte; u.pn = t / mte; u.idx = k; return true;
    }
    __device__ __forceinline__ const char* baseA(const Unit& u) const {
        if constexpr (GATH) return (const char*)ws + (F8 ? WS_H2Q : WS_H2);
        else return (const char*)ws + (F8 ? WS_ACTQ : WS_ACT) + (same ? (size_t)0 : (size_t)(ptu(u.z) + u.pm) * (256 * 2048 * ES));
    }
    __device__ __forceinline__ const char* baseB(const Unit& u) const {
        if constexpr (GATH) return (const char*)ws + (F8 ? WS_WGUQ : WS_WGUT) + ((size_t)u.z * 4096 + (size_t)u.pn * 256) * (2048 * ES);
        else return (const char*)ws + (F8 ? WS_WDNQ : WS_WDNT) + (same ? (size_t)0 : ((size_t)u.z * 2048 + (size_t)u.pn * 256) * (2048 * ES));
    }
    __device__ __forceinline__ unsigned arow(const Unit& u, int r) const {
        const LAS unsigned short* tokl = (const LAS unsigned short*)((const LAS unsigned char*)pt - LDS_MISC + LDS_TOKL);
        return (unsigned)tokl[u.idx * 256 + r] * (unsigned)(2048 * ES);
    }
};

__device__ __forceinline__ void store_tile_bf16(const f32x4 (&acc)[2][2][4][2], bf16_t* dst  , size_t ldc, int wr, int wc, int fr, int fq) {
    const int row0 = wr * 64 + fr, col0 = wc * 32 + 8 * fq;
#pragma unroll
    for (int ai = 0; ai < 2; ++ai)
#pragma unroll
        for (int m = 0; m < 4; ++m) { bf16_t* rowp = dst + (size_t)(row0 + ai * HALF + m * 16) * ldc + col0;
#pragma unroll
            for (int bj = 0; bj < 2; ++bj) { const f32x4 v0 = acc[ai][bj][m][0], v1 = acc[ai][bj][m][1];
                u32x4 w; w.x = cvtpk(v0[0], v0[1]); w.y = cvtpk(v0[2], v0[3]); w.z = cvtpk(v1[0], v1[1]); w.w = cvtpk(v1[2], v1[3]);
                *(u32x4*)(rowp + bj * HALF) = w; } }
}
struct EpiProj {
    static constexpr bool PERM = true, AFTER_DRAIN = false; static constexpr int NSTORE = 16;
    unsigned char* ws;
    __device__ __forceinline__ void operator()(const f32x4 (&acc)[2][2][4][2], const Unit& u, int wr, int wc, int fr, int fq) const {
        const int pn = u.pn, pm = u.pm;
        bf16_t* dst; size_t ldc;
        if (u.z == 0) {
            if (pn >= 18) {
                dst = (bf16_t*)(ws + WS_GATES) + (size_t)pm * 256 * 6144 + (pn - 18) * 256;
                const int row0 = wr * 64 + fr, col0 = wc * 32 + 8 * fq;
#pragma unroll
                for (int ai = 0; ai < 2; ++ai)
#pragma unroll
                    for (int m = 0; m < 4; ++m) { bf16_t* rowp = dst + (size_t)(row0 + ai * HALF + m * 16) * 6144 + col0;
#pragma unroll
                        for (int bj = 0; bj < 2; ++bj) { const f32x4 v0 = acc[ai][bj][m][0], v1 = acc[ai][bj][m][1];
                            u32x4 w; w.x = cvtpk(sigmoidf_(v0[0]), sigmoidf_(v0[1])); w.y = cvtpk(sigmoidf_(v0[2]), sigmoidf_(v0[3]));
                            w.z = cvtpk(sigmoidf_(v1[0]), sigmoidf_(v1[1])); w.w = cvtpk(sigmoidf_(v1[2]), sigmoidf_(v1[3]));
                            *(u32x4*)(rowp + bj * HALF) = w; } }
                return;
            }
            if (pn < 4) { dst = (bf16_t*)(ws + WS_FIN) + pn * 256; ldc = 1024; }
            else if (pn < 12) { dst = (bf16_t*)(ws + WS_Q) + (pn - 4) * 256; ldc = 2048; }
            else if (pn == 12) { dst = (bf16_t*)(ws + WS_K); ldc = 256; }
            else { dst = (bf16_t*)(ws + WS_QM) + (pn - 14) * 256; ldc = 1024; }
            dst += (size_t)pm * 256 * ldc;
        } else if (u.z == 2) {
            dst = (bf16_t*)(ws + WS_VT) + (size_t)(pm >> 3) * 256 * 2048 + (size_t)(pm & 7) * 256; ldc = 2048;
        } else if (u.z == 1) {
            dst = (bf16_t*)(ws + WS_KMK) + (size_t)pm * 256 * 1024 + pn * 256; ldc = 1024;
        } else {
            dst = (bf16_t*)(ws + WS_VMT) + (size_t)(pn * 4 + pm) * 256 * 256; ldc = 256;
        }
        store_tile_bf16(acc, dst, ldc, wr, wc, fr, fq);
    }
};
__device__ __forceinline__ unsigned pk_u8x4(float a, float b, float c, float d) {
    const unsigned x = (unsigned)(a * 255.0f + 0.5f), y = (unsigned)(b * 255.0f + 0.5f), z = (unsigned)(c * 255.0f + 0.5f), w = (unsigned)(d * 255.0f + 0.5f);
    return x | (y << 8) | (z << 16) | (w << 24); }
struct EpiGates8 {
    static constexpr int PERM = 2; static constexpr bool AFTER_DRAIN = false; static constexpr int NSTORE = 8;
    unsigned char* ws;
    __device__ __forceinline__ void operator()(const f32x4 (&acc)[2][2][4][2], const Unit& u, int wr, int wc, int fr, int fq) const {
        unsigned char* dst = ws + WS_GATES + (size_t)u.pm * 256 * 6144 + u.pn * 256;
        const int row0 = wr * 64 + fr, col0 = wc * 64 + 16 * fq;
#pragma unroll
        for (int ai = 0; ai < 2; ++ai)
#pragma unroll
            for (int m = 0; m < 4; ++m) {
                u32x4 w;
                { const f32x4 a = acc[ai][0][m][0] * WQ_INV, c = acc[ai][0][m][1] * WQ_INV;
                  w.x = pk_u8x4(sigmoidf_(a[0]), sigmoidf_(a[1]), sigmoidf_(a[2]), sigmoidf_(a[3])); w.y = pk_u8x4(sigmoidf_(c[0]), sigmoidf_(c[1]), sigmoidf_(c[2]), sigmoidf_(c[3])); }
                { const f32x4 a = acc[ai][1][m][0] * WQ_INV, c = acc[ai][1][m][1] * WQ_INV;
                  w.z = pk_u8x4(sigmoidf_(a[0]), sigmoidf_(a[1]), sigmoidf_(a[2]), sigmoidf_(a[3])); w.w = pk_u8x4(sigmoidf_(c[0]), sigmoidf_(c[1]), sigmoidf_(c[2]), sigmoidf_(c[3])); }
                *(u32x4*)(dst + (size_t)(row0 + ai * HALF + m * 16) * 6144 + col0) = w; }
    }
};
struct EpiChan {
    static constexpr bool PERM = true, AFTER_DRAIN = false; static constexpr int NSTORE = 0;
    unsigned char* ws;
    __device__ __forceinline__ void operator()(const f32x4 (&acc)[2][2][4][2], const Unit& u, int wr, int wc, int fr, int fq) const {
        store_tile_bf16(acc, (bf16_t*)(ws + WS_ZT) + (size_t)u.z * 256 * SQP + (size_t)u.pm * 2048 + u.pn * 256, SQP, wr, wc, fr, fq);
    }
};
struct EpiSeq {
    static constexpr bool PERM = true, AFTER_DRAIN = false; static constexpr int NSTORE = 0;
    unsigned char* ws;
    __device__ __forceinline__ void operator()(const f32x4 (&acc)[2][2][4][2], const Unit& u, int wr, int wc, int fr, int fq) const {
        const int b = u.z >> 2, g = u.z & 3;
        store_tile_bf16(acc, (bf16_t*)(ws + WS_FX) + (size_t)(b * 2048 + u.pm * 256) * 2048 + g * 256, 2048, wr, wc, fr, fq);
    }
};
template <int STEP> struct EpiMix {
    static constexpr int PERM = 1; static constexpr bool AFTER_DRAIN = false; static constexpr int NSTORE = 16;
    unsigned char* ws;
    __device__ __forceinline__ void operator()(const f32x4 (&acc)[2][2][4][2], const Unit& u, int wr, int wc, int fr, int fq) const {
        const int row0 = u.pm * 256 + wr * 64 + fr, col0 = u.pn * 256 + wc * 32 + 8 * fq;
        const bf16_t* gates = (const bf16_t*)(ws + WS_GATES) + STEP * 2048; const unsigned char* gates8 = ws + WS_GATES + STEP * 2048;
        bf16_t* macc = (bf16_t*)(ws + WS_MIXACC); bf16_t* mixed = (bf16_t*)(ws + WS_MIXED);
#pragma unroll
        for (int ai = 0; ai < 2; ++ai) {
            u32x2 g8[4][2]; u32x4 gw[4][2]; u32x4 mw[4][2];
#pragma unroll
            for (int m = 0; m < 4; ++m) { const size_t row = (size_t)(row0 + ai * HALF + m * 16);
#pragma unroll
                for (int bj = 0; bj < 2; ++bj) { const int col = col0 + bj * HALF;
                    if constexpr (GATES_F8) g8[m][bj] = *(const u32x2*)(gates8 + row * 6144 + col); else gw[m][bj] = *(const u32x4*)(gates + row * 6144 + col);
                    if (STEP > 0) mw[m][bj] = *(const u32x4*)(macc + row * 2048 + col); } }
#pragma unroll
            for (int m = 0; m < 4; ++m) { const size_t row = (size_t)(row0 + ai * HALF + m * 16);
#pragma unroll
                for (int bj = 0; bj < 2; ++bj) { const int col = col0 + bj * HALF;
                    f32x4 v0 = acc[ai][bj][m][0], v1 = acc[ai][bj][m][1];
                    if constexpr (GATES_F8) { const u32x2 g = g8[m][bj]; const float k = 1.0f / 255.0f;
                        v0[0] *= (float)(g.x & 255u) * k; v0[1] *= (float)((g.x >> 8) & 255u) * k; v0[2] *= (float)((g.x >> 16) & 255u) * k; v0[3] *= (float)(g.x >> 24) * k;
                        v1[0] *= (float)(g.y & 255u) * k; v1[1] *= (float)((g.y >> 8) & 255u) * k; v1[2] *= (float)((g.y >> 16) & 255u) * k; v1[3] *= (float)(g.y >> 24) * k; }
                    else { const u32x4 g = gw[m][bj];
                        v0[0] *= bflo(g.x); v0[1] *= bfhi(g.x); v0[2] *= bflo(g.y); v0[3] *= bfhi(g.y);
                        v1[0] *= bflo(g.z); v1[1] *= bfhi(g.z); v1[2] *= bflo(g.w); v1[3] *= bfhi(g.w); }
                    if (STEP > 0) { const u32x4 q = mw[m][bj];
                        v0[0] += bflo(q.x); v0[1] += bfhi(q.x); v0[2] += bflo(q.y); v0[3] += bfhi(q.y);
                        v1[0] += bflo(q.z); v1[1] += bfhi(q.z); v1[2] += bflo(q.w); v1[3] += bfhi(q.w); }
                    u32x4 w; w.x = cvtpk(v0[0], v0[1]); w.y = cvtpk(v0[2], v0[3]); w.z = cvtpk(v1[0], v1[1]); w.w = cvtpk(v1[2], v1[3]);
                    *(u32x4*)((STEP < 2 ? macc : mixed) + row * 2048 + col) = w; } }
        }
    }
};
struct SchedMix {
    static constexpr bool GATHER = false; static constexpr bool VARK = true;
    const unsigned char* ws; int r0, r1;
    __device__ __forceinline__ bool next(int i, Unit& u) const {
        const int tr = r0 + i / 3; if (tr >= r1) return false;
        const int L = tr * (int)gridDim.x + (int)blockIdx.x; if (L >= 64 * 8) return false;
        static_tile(L, 64, 8, u.pm, u.pn); u.z = i % 3; return true;
    }
    __device__ __forceinline__ int ktiles(const Unit& u) const { return u.z == 1 ? 32 : 16; }
    __device__ __forceinline__ const char* baseA(const Unit& u) const {
        const size_t ts = (size_t)256 * 2048 * 2;
        return (const char*)ws + (u.z == 1 ? WS_ATT : WS_FX + (u.z == 2 ? 2048 : 0)) + (size_t)u.pm * ts;
    }
    __device__ __forceinline__ const char* baseB(const Unit& u) const {
        const size_t ts = (size_t)256 * 2048 * 2;
        return (const char*)ws + (u.z == 1 ? WS_WAOT : WS_WFM + (u.z == 2 ? 2048 : 0)) + (size_t)u.pn * ts;
    }
    __device__ __forceinline__ unsigned arow(const Unit&, int) const { return 0u; }
};
struct EpiMixF {
    static constexpr int PERM = 1; static constexpr bool AFTER_DRAIN = false, KEEP = true; static constexpr int NSTORE = 16;
    unsigned char* ws;
    __device__ __forceinline__ bool keep(const Unit& u) const { return u.z < 2; }
    static constexpr bool TOUCH = EPI_TOUCH;
    __device__ __forceinline__ void touch(const Unit& u, LAS unsigned char* lds, int tid, int wid) const {
        if (u.z != 0) return;
        const unsigned char* q = ws + WS_GATES + (size_t)(u.pm * 256 + (tid >> 1)) * 6144 + u.pn * 256 + (tid & 1) * 128;
#pragma unroll
        for (int s = 0; s < 3; ++s) __builtin_amdgcn_global_load_lds((const unsigned*)(q + s * 2048), (LAS unsigned*)(lds + LDS_BTAB + wid * 1024 + s * 256), 4, 0, 0);
    }
    static __device__ __forceinline__ float gb(unsigned w, int k) { return (float)((w >> (8 * k)) & 255u); }
    __device__ __forceinline__ void operator()(f32x4 (&acc)[2][2][4][2], const Unit& u, int wr, int wc, int fr, int fq) const {
        const int row0 = u.pm * 256 + wr * 64 + fr, col0 = u.pn * 256 + wc * 32 + 8 * fq;
        const int seg = __builtin_amdgcn_readfirstlane(u.z);
        const unsigned char* gnum = ws + WS_GATES + seg * 2048;
        bf16_t* mixed = (bf16_t*)(ws + WS_MIXED);
        if (seg < 2) {
#pragma unroll
            for (int ai = 0; ai < 2; ++ai) {
                u32x2 gn[4][2], gd[4][2];
#pragma unroll
                for (int m = 0; m < 4; ++m) { const size_t row = (size_t)(row0 + ai * HALF + m * 16);
#pragma unroll
                    for (int bj = 0; bj < 2; ++bj) { const unsigned char* q = gnum + row * 6144 + col0 + bj * HALF; gn[m][bj] = *(const u32x2*)q; gd[m][bj] = *(const u32x2*)(q + 2048); } }
#pragma unroll
                for (int m = 0; m < 4; ++m)
#pragma unroll
                    for (int bj = 0; bj < 2; ++bj) {
#pragma unroll
                        for (int k = 0; k < 4; ++k) {
                            const float n0 = (seg == 0) ? gb(gn[m][bj].x, k) : fmaxf(gb(gn[m][bj].x, k), 0.5f), n1 = (seg == 0) ? gb(gn[m][bj].y, k) : fmaxf(gb(gn[m][bj].y, k), 0.5f);
                            acc[ai][bj][m][0][k] *= n0 * __builtin_amdgcn_rcpf(fmaxf(gb(gd[m][bj].x, k), 0.5f));
                            acc[ai][bj][m][1][k] *= n1 * __builtin_amdgcn_rcpf(fmaxf(gb(gd[m][bj].y, k), 0.5f)); } }
            }
        } else {
#pragma unroll
            for (int ai = 0; ai < 2; ++ai) {
                u32x2 gn[4][2];
#pragma unroll
                for (int m = 0; m < 4; ++m) { const size_t row = (size_t)(row0 + ai * HALF + m * 16);
#pragma unroll
                    for (int bj = 0; bj < 2; ++bj) gn[m][bj] = *(const u32x2*)(gnum + row * 6144 + col0 + bj * HALF); }
#pragma unroll
                for (int m = 0; m < 4; ++m) { const size_t row = (size_t)(row0 + ai * HALF + m * 16);
#pragma unroll
                    for (int bj = 0; bj < 2; ++bj) { const float kq = 1.0f / 255.0f; f32x4 v0 = acc[ai][bj][m][0], v1 = acc[ai][bj][m][1];
#pragma unroll
                        for (int k = 0; k < 4; ++k) { v0[k] *= fmaxf(gb(gn[m][bj].x, k), 0.5f) * kq; v1[k] *= fmaxf(gb(gn[m][bj].y, k), 0.5f) * kq; }
                        u32x4 w; w.x = cvtpk(v0[0], v0[1]); w.y = cvtpk(v0[2], v0[3]); w.z = cvtpk(v1[0], v1[1]); w.w = cvtpk(v1[2], v1[3]);
                        *(u32x4*)(mixed + row * 2048 + col0 + bj * HALF) = w; } }
            }
        }
    }
};
struct EpiRes {
    static constexpr int PERM = 1; static constexpr bool AFTER_DRAIN = false; static constexpr int NSTORE = 16;
    const float* x; bf16_t* x2; const bf16_t* h; const float* irs; const float* g1;
    static constexpr bool TOUCH = EPI_TOUCH;
    __device__ __forceinline__ void touch(const Unit& u, LAS unsigned char* lds, int tid, int wid) const {
        const unsigned char* q = (const unsigned char*)(x + (size_t)(u.pm * 256 + (tid >> 1)) * 2048 + u.pn * 256) + (tid & 1) * 512;
#pragma unroll
        for (int j = 0; j < 4; ++j) __builtin_amdgcn_global_load_lds((const unsigned*)(q + j * 128), (LAS unsigned*)(lds + LDS_BTAB + wid * 1024 + j * 256), 4, 0, 0);
    }
    __device__ __forceinline__ void operator()(const f32x4 (&acc)[2][2][4][2], const Unit& u, int wr, int wc, int fr, int fq) const {
        const int row0 = u.pm * 256 + wr * 64 + fr, col0 = u.pn * 256 + wc * 32 + 8 * fq;
        if constexpr (RES_FROM_H) {
            f32x4 ig[2][2]; bool bad = false;
#pragma unroll
            for (int bj = 0; bj < 2; ++bj)
#pragma unroll
                for (int n2 = 0; n2 < 2; ++n2) { const f32x4 gv = *(const f32x4*)(g1 + col0 + bj * HALF + 4 * n2);
#pragma unroll
                    for (int k = 0; k < 4; ++k) { bad |= (gv[k] == 0.f); ig[bj][n2][k] = __builtin_amdgcn_rcpf(gv[k]); } }
            if (!__any(bad)) {
#pragma unroll
                for (int ai = 0; ai < 2; ++ai) {
                    float ir[4]; u32x4 hv[4][2];
#pragma unroll
                    for (int m = 0; m < 4; ++m) { const size_t row = (size_t)(row0 + ai * HALF + m * 16); ir[m] = irs[row];
#pragma unroll
                        for (int bj = 0; bj < 2; ++bj) hv[m][bj] = *(const u32x4*)(h + row * LDP + col0 + bj * HALF); }
#pragma unroll
                    for (int m = 0; m < 4; ++m) { const size_t off = (size_t)(row0 + ai * HALF + m * 16) * 2048 + col0;
#pragma unroll
                        for (int bj = 0; bj < 2; ++bj) { const u32x4 q = hv[m][bj]; const f32x4 i0 = ig[bj][0] * ir[m], i1 = ig[bj][1] * ir[m];
                            const f32x4 v0 = acc[ai][bj][m][0] + (f32x4){bflo(q.x), bfhi(q.x), bflo(q.y), bfhi(q.y)} * i0, v1 = acc[ai][bj][m][1] + (f32x4){bflo(q.z), bfhi(q.z), bflo(q.w), bfhi(q.w)} * i1;
                            u32x4 w; w.x = cvtpk(v0[0], v0[1]); w.y = cvtpk(v0[2], v0[3]); w.z = cvtpk(v1[0], v1[1]); w.w = cvtpk(v1[2], v1[3]);
                            *(u32x4*)(x2 + off + bj * HALF) = w; } }
                }
                return;
            }
        }
#pragma unroll
        for (int ai = 0; ai < 2; ++ai) {
            f32x4 xv[4][2][2];
#pragma unroll
            for (int m = 0; m < 4; ++m) { const size_t off = (size_t)(row0 + ai * HALF + m * 16) * 2048 + col0;
#pragma unroll
                for (int bj = 0; bj < 2; ++bj) { xv[m][bj][0] = *(const f32x4*)(x + off + bj * HALF); xv[m][bj][1] = *(const f32x4*)(x + off + bj * HALF + 4); } }
#pragma unroll
            for (int m = 0; m < 4; ++m) { const size_t off = (size_t)(row0 + ai * HALF + m * 16) * 2048 + col0;
#pragma unroll
                for (int bj = 0; bj < 2; ++bj) { const f32x4 v0 = acc[ai][bj][m][0] + xv[m][bj][0], v1 = acc[ai][bj][m][1] + xv[m][bj][1];
                    u32x4 w; w.x = cvtpk(v0[0], v0[1]); w.y = cvtpk(v0[2], v0[3]); w.z = cvtpk(v1[0], v1[1]); w.w = cvtpk(v1[2], v1[3]);
                    *(u32x4*)(x2 + off + bj * HALF) = w; } }
        }
    }
};
__device__ __forceinline__ float swiglu1(float g, float up) {
    g = fminf(g, 7.0f); up = fminf(fmaxf(up, -7.0f), 7.0f);
    return (up + 1.0f) * (g * sigmoid_sc(g, -1.702f * LOG2E));
}
struct EpiSwiglu {
    static constexpr bool PERM = true, AFTER_DRAIN = false; static constexpr int NSTORE = 8;
    unsigned char* ws; const float* bgu; const LAS int* pt;
    __device__ __forceinline__ void operator()(const f32x4 (&acc)[2][2][4][2], const Unit& u, int wr, int wc, int fr, int fq) const {
        const int e = u.z; const size_t srow0 = (size_t)(__builtin_amdgcn_readfirstlane(pt[e]) + u.pm) * 256 + wr * 64 + fr;
        const int col0 = u.pn * 256 + wc * 32 + 8 * fq;
        bf16_t* act = (bf16_t*)(ws + WS_ACT);
        f32x4 bv[2][2];
#pragma unroll
        for (int bj = 0; bj < 2; ++bj)
#pragma unroll
            for (int n = 0; n < 2; ++n) bv[bj][n] = *(const f32x4*)(bgu + (size_t)e * 4096 + col0 + bj * HALF + 4 * n);
#pragma unroll
        for (int ai = 0; ai < 2; ++ai)
#pragma unroll
            for (int m = 0; m < 4; ++m) { bf16_t* rowp = act + (srow0 + ai * HALF + m * 16) * 2048 + (col0 >> 1);
#pragma unroll
                for (int bj = 0; bj < 2; ++bj) { const f32x4 v0 = acc[ai][bj][m][0] + bv[bj][0], v1 = acc[ai][bj][m][1] + bv[bj][1];
                    u32x2 w; w.x = cvtpk(swiglu1(v0[0], v0[1]), swiglu1(v0[2], v0[3])); w.y = cvtpk(swiglu1(v1[0], v1[1]), swiglu1(v1[2], v1[3]));
                    *(u32x2*)(rowp + bj * (HALF / 2)) = w; } }
    }
};
struct EpiDown {
    static constexpr bool PERM = true, AFTER_DRAIN = false; static constexpr int NSTORE = 8;
    unsigned char* ws; const float* bdn; const LAS int* pt; const LAS int* cn;
    __device__ __forceinline__ void operator()(const f32x4 (&acc)[2][2][4][2], const Unit& u, int wr, int wc, int fr, int fq) const {
        const int e = u.z; const int lrow0 = u.pm * 256 + wr * 64 + fr; const size_t srow0 = (size_t)__builtin_amdgcn_readfirstlane(pt[e]) * 256 + lrow0;
        const int col0 = u.pn * 256 + wc * 32 + 8 * fq;
        bf16_t* ys = (bf16_t*)(ws + WS_YS); const float* wl = (const float*)(ws + WS_WLIST) + (size_t)e * T_; const int cne = __builtin_amdgcn_readfirstlane(cn[e]);
        f32x4 bv[2][2];
#pragma unroll
        for (int bj = 0; bj < 2; ++bj)
#pragma unroll
            for (int n = 0; n < 2; ++n) bv[bj][n] = *(const f32x4*)(bdn + (size_t)e * 2048 + col0 + bj * HALF + 4 * n);
#pragma unroll
        for (int ai = 0; ai < 2; ++ai)
#pragma unroll
            for (int m = 0; m < 4; ++m) { const int pos = lrow0 + ai * HALF + m * 16; const float w = (pos < cne) ? wl[pos] : 0.f;
                bf16_t* rowp = ys + (srow0 + ai * HALF + m * 16) * 2048 + col0;
#pragma unroll
                for (int bj = 0; bj < 2; ++bj) { const f32x4 v0 = (acc[ai][bj][m][0] + bv[bj][0]) * w, v1 = (acc[ai][bj][m][1] + bv[bj][1]) * w;
                    u32x4 o; o.x = cvtpk(v0[0], v0[1]); o.y = cvtpk(v0[2], v0[3]); o.z = cvtpk(v1[0], v1[1]); o.w = cvtpk(v1[2], v1[3]);
                    *(u32x4*)(rowp + bj * HALF) = o; } }
    }
};
__device__ __forceinline__ unsigned pk_fp8x4(float a, float b, float c, float d) {
    int w = __builtin_amdgcn_cvt_pk_fp8_f32(a, b, 0, false); w = __builtin_amdgcn_cvt_pk_fp8_f32(c, d, w, true); return (unsigned)w; }
struct EpiSwiglu8 {
    static constexpr int PERM = 2; static constexpr bool AFTER_DRAIN = false; static constexpr int NSTORE = 8;
    unsigned char* ws; const float* bgu; const LAS int* pt;
    __device__ __forceinline__ void operator()(const f32x4 (&acc)[2][2][4][2], const Unit& u, int wr, int wc, int fr, int fq) const {
        const int e = u.z; const size_t srow0 = (size_t)(__builtin_amdgcn_readfirstlane(pt[e]) + u.pm) * 256 + wr * 64 + fr;
        const int col0 = u.pn * 256 + wc * 64 + 16 * fq;
        unsigned char* act = ws + WS_ACTQ;
        const LAS float* btab = (const LAS float*)((const LAS unsigned char*)pt - LDS_MISC + LDS_BTAB) + u.idx * 256 + wc * 64 + 16 * fq;
        f32x4 bv[2][2];
#pragma unroll
        for (int bj = 0; bj < 2; ++bj)
#pragma unroll
            for (int n = 0; n < 2; ++n) bv[bj][n] = *(const LAS f32x4*)(btab + 8 * bj + 4 * n);
#pragma unroll
        for (int ai = 0; ai < 2; ++ai)
#pragma unroll
            for (int m = 0; m < 4; ++m) {
                float o[8];
#pragma unroll
                for (int bj = 0; bj < 2; ++bj)
#pragma unroll
                    for (int n = 0; n < 2; ++n) { const f32x4 v = acc[ai][bj][m][n] * WQ_INV + bv[bj][n]; o[4 * bj + 2 * n] = swiglu1(v[0], v[1]); o[4 * bj + 2 * n + 1] = swiglu1(v[2], v[3]); }
                u32x2 w; w.x = pk_fp8x4(o[0], o[1], o[2], o[3]); w.y = pk_fp8x4(o[4], o[5], o[6], o[7]);
                *(u32x2*)(act + (srow0 + ai * HALF + m * 16) * 2048 + (col0 >> 1)) = w; }
    }
};
struct EpiDown8 {
    static constexpr int PERM = 2; static constexpr bool AFTER_DRAIN = false; static constexpr int NSTORE = 8;
    unsigned char* ws; const float* bdn; const LAS int* pt; const LAS int* cn; size_t ysbase = WS_YS;
    __device__ __forceinline__ void operator()(const f32x4 (&acc)[2][2][4][2], const Unit& u, int wr, int wc, int fr, int fq) const {
        const int e = u.z; const int lrow0 = u.pm * 256 + wr * 64 + fr; const size_t srow0 = (size_t)__builtin_amdgcn_readfirstlane(pt[e]) * 256 + lrow0;
        const int col0 = u.pn * 256 + wc * 64 + 16 * fq;
        unsigned char* ys = ws + ysbase;
        const LAS float* btab = (const LAS float*)((const LAS unsigned char*)pt - LDS_MISC + LDS_BTAB) + u.idx * 256 + wc * 64 + 16 * fq;
        const LAS float* wtab = (const LAS float*)((const LAS unsigned char*)pt - LDS_MISC + LDS_TOKL) + u.idx * 256 + wr * 64 + fr;
        f32x4 bv[2][2];
#pragma unroll
        for (int bj = 0; bj < 2; ++bj)
#pragma unroll
            for (int n = 0; n < 2; ++n) bv[bj][n] = *(const LAS f32x4*)(btab + 8 * bj + 4 * n);
#pragma unroll
        for (int ai = 0; ai < 2; ++ai)
#pragma unroll
            for (int m = 0; m < 4; ++m) { const float w = wtab[ai * HALF + m * 16];
                u32x4 o;
                { const f32x4 a = (acc[ai][0][m][0] * WQ_INV + bv[0][0]) * w, c = (acc[ai][0][m][1] * WQ_INV + bv[0][1]) * w; o.x = pk_fp8x4(a[0], a[1], a[2], a[3]); o.y = pk_fp8x4(c[0], c[1], c[2], c[3]); }
                { const f32x4 a = (acc[ai][1][m][0] * WQ_INV + bv[1][0]) * w, c = (acc[ai][1][m][1] * WQ_INV + bv[1][1]) * w; o.z = pk_fp8x4(a[0], a[1], a[2], a[3]); o.w = pk_fp8x4(c[0], c[1], c[2], c[3]); }
                *(u32x4*)(ys + (srow0 + ai * HALF + m * 16) * 2048 + col0) = o; }
    }
};
struct EpiMemSoftmax {
    static constexpr bool PERM = true, AFTER_DRAIN = true; static constexpr int NSTORE = 0;
    bf16_t* P;
    __device__ __forceinline__ void operator()(const f32x4 (&)[2][2][4][2], const Unit&, int, int, int, int) const {}
    __device__ __forceinline__ void fused(f32x4 (&acc)[2][2][4][2], const Unit&, int wr, int wc, int fr, int fq, LAS unsigned char* lds, int, int) const {
        LAS f32x2* tab = (LAS f32x2*)lds;
        const float sc = 0.0625f * LOG2E;
        float mx[2][4];
#pragma unroll
        for (int ai = 0; ai < 2; ++ai)
#pragma unroll
            for (int m = 0; m < 4; ++m) { float a = -3.0e38f;
#pragma unroll
                for (int bj = 0; bj < 2; ++bj)
#pragma unroll
                    for (int n = 0; n < 2; ++n) { acc[ai][bj][m][n] *= sc; const f32x4 v = acc[ai][bj][m][n]; a = fmaxf(a, fmaxf(fmaxf(v[0], v[1]), fmaxf(v[2], v[3]))); }
                a = fmaxf(a, __shfl_xor(a, 16)); a = fmaxf(a, __shfl_xor(a, 32)); mx[ai][m] = a;
                float s = 0.f;
#pragma unroll
                for (int bj = 0; bj < 2; ++bj)
#pragma unroll
                    for (int n = 0; n < 2; ++n) { const f32x4 v = acc[ai][bj][m][n]; s += __builtin_amdgcn_exp2f(v[0] - a) + __builtin_amdgcn_exp2f(v[1] - a) + __builtin_amdgcn_exp2f(v[2] - a) + __builtin_amdgcn_exp2f(v[3] - a); }
                s += __shfl_xor(s, 16); s += __shfl_xor(s, 32);
                if (fq == 0) tab[(ai * HALF + wr * 64 + m * 16 + fr) * 4 + wc] = (f32x2){a, s};
            }
        __syncthreads();
#pragma unroll
        for (int ai = 0; ai < 2; ++ai)
#pragma unroll
            for (int m = 0; m < 4; ++m) { const int r = ai * HALF + wr * 64 + m * 16 + fr;
                const f32x2 t0 = tab[r * 4 + 0], t1 = tab[r * 4 + 1], t2 = tab[r * 4 + 2], t3 = tab[r * 4 + 3];
                const float M = fmaxf(fmaxf(t0.x, t1.x), fmaxf(t2.x, t3.x));
                const float L = t0.y * __builtin_amdgcn_exp2f(t0.x - M) + t1.y * __builtin_amdgcn_exp2f(t1.x - M) + t2.y * __builtin_amdgcn_exp2f(t2.x - M) + t3.y * __builtin_amdgcn_exp2f(t3.x - M);
                const float inv = 1.0f / L;
                bf16_t* rowp = P + (size_t)r * 1024 + wc * 32 + 8 * fq;
#pragma unroll
                for (int bj = 0; bj < 2; ++bj) { f32x4 v0 = acc[ai][bj][m][0], v1 = acc[ai][bj][m][1];
#pragma unroll
                    for (int j = 0; j < 4; ++j) { v0[j] = __builtin_amdgcn_exp2f(v0[j] - M) * inv; v1[j] = __builtin_amdgcn_exp2f(v1[j] - M) * inv; }
                    u32x4 w; w.x = cvtpk(v0[0], v0[1]); w.y = cvtpk(v0[2], v0[3]); w.z = cvtpk(v1[0], v1[1]); w.w = cvtpk(v1[2], v1[3]);
                    *(u32x4*)(rowp + bj * HALF) = w; } }
        __syncthreads();
    }
};
struct EpiTile {
    static constexpr bool PERM = true, AFTER_DRAIN = false; static constexpr int NSTORE = 0;
    bf16_t* dst; size_t ldc;
    __device__ __forceinline__ void operator()(const f32x4 (&acc)[2][2][4][2], const Unit&, int wr, int wc, int fr, int fq) const { store_tile_bf16(acc, dst, ldc, wr, wc, fr, fq); }
};
__device__ __forceinline__ void tr_item(const float* W, int K, int N, bf16_t* WT, LAS float* scr, int item, int lane) {
    const int nblk = N / 32, kb = item / nblk, nb = item % nblk, k0 = 64 * kb, n0 = 32 * nb;
#pragma unroll 8
    for (int i = 0; i < 32; ++i) { const int kk = 2 * i + (lane >> 5); scr[kk * 33 + (lane & 31)] = W[(size_t)(k0 + kk) * N + n0 + (lane & 31)]; }
    asm volatile("s_waitcnt lgkmcnt(0)" ::: "memory");
    const int c = lane & 7;
#pragma unroll
    for (int j = 0; j < 4; ++j) { const int n = (lane >> 3) + 8 * j; const LAS float* s = scr + (8 * c) * 33 + n;
        u32x4 o; o.x = cvtpk(s[0 * 33], s[1 * 33]); o.y = cvtpk(s[2 * 33], s[3 * 33]); o.z = cvtpk(s[4 * 33], s[5 * 33]); o.w = cvtpk(s[6 * 33], s[7 * 33]);
        *(u32x4*)(WT + (size_t)(n0 + n) * K + k0 + 8 * c) = o; }
    asm volatile("s_waitcnt lgkmcnt(0)" ::: "memory");
}
__device__ __forceinline__ void tr_item8(const float* W, int K, int N, unsigned char* WT, LAS float* scr, int item, int lane, float scale) {
    const int nblk = N / 32, kb = item / nblk, nb = item % nblk, k0 = 128 * kb, n0 = 32 * nb;
#pragma unroll 8
    for (int i = 0; i < 64; ++i) { const int kk = 2 * i + (lane >> 5); scr[kk * 33 + (lane & 31)] = W[(size_t)(k0 + kk) * N + n0 + (lane & 31)] * scale; }
    asm volatile("s_waitcnt lgkmcnt(0)" ::: "memory");
    const int c = lane & 7;
#pragma unroll
    for (int j = 0; j < 4; ++j) { const int n = (lane >> 3) + 8 * j; const LAS float* s = scr + (16 * c) * 33 + n;
        u32x4 o; o.x = pk_fp8x4(s[0 * 33], s[1 * 33], s[2 * 33], s[3 * 33]); o.y = pk_fp8x4(s[4 * 33], s[5 * 33], s[6 * 33], s[7 * 33]);
        o.z = pk_fp8x4(s[8 * 33], s[9 * 33], s[10 * 33], s[11 * 33]); o.w = pk_fp8x4(s[12 * 33], s[13 * 33], s[14 * 33], s[15 * 33]);
        *(u32x4*)(WT + (size_t)(n0 + n) * K + k0 + 16 * c) = o; }
    asm volatile("s_waitcnt lgkmcnt(0)" ::: "memory");
}
__device__ __forceinline__ void rms_row_to_bf16(const float* xrow, const float* g, bf16_t* orow, int lane, unsigned char* qrow = nullptr, float* irs = nullptr) {
    const f32x4* xr = (const f32x4*)xrow + lane; const f32x4* gr = (const f32x4*)g + lane;
    f32x4 v[8]; float s = 0.f;
#pragma unroll
    for (int j = 0; j < 8; ++j) { v[j] = xr[64 * j]; s += (v[j][0] * v[j][0] + v[j][1] * v[j][1]) + (v[j][2] * v[j][2] + v[j][3] * v[j][3]); }
    const float r = rsqrtf(wsum(s) * (1.0f / DM) + 1e-5f);
    if (irs && lane == 0) *irs = 1.0f / r;
    u32x2* o8 = (u32x2*)orow + lane;
#pragma unroll
    for (int j = 0; j < 8; ++j) { const f32x4 gg = gr[64 * j]; u32x2 w; w.x = cvtpk(v[j][0] * r * gg[0], v[j][1] * r * gg[1]); w.y = cvtpk(v[j][2] * r * gg[2], v[j][3] * r * gg[3]); o8[64 * j] = w;
        if (qrow) ((unsigned*)qrow)[lane + 64 * j] = pk_fp8x4(v[j][0] * r * gg[0], v[j][1] * r * gg[1], v[j][2] * r * gg[2], v[j][3] * r * gg[3]); }
}
__device__ __forceinline__ void rms_bfrow_to_bf16(const bf16_t* xrow, const float* g, bf16_t* orow, int lane, unsigned char* qrow) {
    const u32x2* xr = (const u32x2*)xrow + lane; const f32x4* gr = (const f32x4*)g + lane;
    f32x4 v[8]; float s = 0.f;
#pragma unroll
    for (int j = 0; j < 8; ++j) { const u32x2 w = xr[64 * j]; v[j] = (f32x4){bflo(w.x), bfhi(w.x), bflo(w.y), bfhi(w.y)}; s += (v[j][0] * v[j][0] + v[j][1] * v[j][1]) + (v[j][2] * v[j][2] + v[j][3] * v[j][3]); }
    const float r = rsqrtf(wsum(s) * (1.0f / DM) + 1e-5f);
    u32x2* o8 = (u32x2*)orow + lane;
#pragma unroll
    for (int j = 0; j < 8; ++j) { const f32x4 gg = gr[64 * j]; u32x2 w; w.x = cvtpk(v[j][0] * r * gg[0], v[j][1] * r * gg[1]); w.y = cvtpk(v[j][2] * r * gg[2], v[j][3] * r * gg[3]); o8[64 * j] = w;
        if (qrow) ((unsigned*)qrow)[lane + 64 * j] = pk_fp8x4(v[j][0] * r * gg[0], v[j][1] * r * gg[1], v[j][2] * r * gg[2], v[j][3] * r * gg[3]); }
}
constexpr int CV_I_IN = (DM / 128) * (INW / 256), CV_I_SQ = (2048 / 128) * (2048 / 256), CV_I_HF = (1024 / 128) * (2048 / 256);
constexpr int CV_I_GU = (2048 / 128) * (4096 / 256), CV_I_DN = CV_I_SQ;
constexpr long CV_NONEXP = (long)CV_I_IN + 3L * CV_I_SQ + 2L * CV_I_HF;
constexpr long CV_TOTAL = CV_NONEXP + (long)NE * CV_I_GU + (long)NE * CV_I_DN;
typedef short v2s_t __attribute__((ext_vector_type(2)));
__device__ __forceinline__ unsigned pk_fp8x4_scaled(float a, float b, float c, float d) {
    v2s_t r = {0, 0};
    r = __builtin_amdgcn_cvt_scalef32_pk_fp8_f32(r, a, b, WQ_INV, false);
    r = __builtin_amdgcn_cvt_scalef32_pk_fp8_f32(r, c, d, WQ_INV, true);
    return __builtin_bit_cast(unsigned, r);
}
constexpr int CV_PITCH = 260;
#ifndef CV_ASMLD
#define CV_ASMLD 0
#endif
__device__ __forceinline__ f32x4 cv_load(const float* q) {
#if CV_ASMLD
    f32x4 v; asm volatile("global_load_dwordx4 %0, %1, off sc0 sc1 nt" : "=v"(v) : "v"(q) : "memory"); return v;
#else
    return __builtin_nontemporal_load((const f32x4*)q);
#endif
}
__device__ __forceinline__ void convert_items(const Params& p, LAS unsigned char* lds, long it0, long it_end, int worker, int nworkers, int probe = 0, int* qhead = nullptr) {
    int tid_ = threadIdx.x; asm volatile("" : "+v"(tid_));
    const int tid = tid_, wave = __builtin_amdgcn_readfirstlane(tid >> 6), lane = tid & 63;
    unsigned char* ws = p.ws;
    LAS float* tile = (LAS float*)lds;
    constexpr int I_IN = CV_I_IN, I_SQ = CV_I_SQ, I_HF = CV_I_HF, I_GU = CV_I_GU, I_DN = CV_I_DN;
    static_assert(I_GU == 256 && I_DN == 128, "shift decode of the expert items");
    struct Item { const float* src; unsigned char* dst; int N, K, f8; };
    auto decode = [&](long it, Item& q) -> bool {
        if (it >= it_end) return false;
        long r = it; const float* W; unsigned char* D; int K, N, f8 = 0, kb, nb;
        if (r >= CV_NONEXP) {
            r -= CV_NONEXP; K = 2048; f8 = MOE_F8 ? 1 : 0;
            if (r < (long)NE * I_GU) { const int e = (int)(r >> 8), rr = (int)r & 255; kb = rr >> 4; nb = rr & 15; N = 4096;
                W = p.in[14] + (size_t)e * 2048 * 4096; D = ws + (MOE_F8 ? WS_WGUQ + (size_t)e * 4096 * 2048 : WS_WGUT + (size_t)e * 4096 * 2048 * 2); }
            else { r -= (long)NE * I_GU; const int e = (int)(r >> 7), rr = (int)r & 127; kb = rr >> 3; nb = rr & 7; N = 2048;
                W = p.in[16] + (size_t)e * 2048 * 2048; D = ws + (MOE_F8 ? WS_WDNQ + (size_t)e * 2048 * 2048 : WS_WDNT + (size_t)e * 2048 * 2048 * 2); }
        } else {
            if (r < I_IN) { W = p.in[4]; D = ws + WS_WINT; K = LDP; N = INW;
                if (GATES_F8 && 256 * ((int)r % (INW / 256)) >= 4608) { f8 = 2; D = ws + WS_WINQ; K = 2048; } }
            else if ((r -= I_IN) < I_SQ) { W = p.in[6]; D = ws + WS_WMKVT; K = LDP; N = 2048; }
            else if ((r -= I_SQ) < I_HF) { W = p.in[7]; D = ws + WS_WFM; K = 2048; N = 2048; }
            else if ((r -= I_HF) < I_SQ) { W = p.in[8]; D = ws + WS_WAOT; K = 2048; N = 2048; }
            else if ((r -= I_SQ) < I_HF) { W = p.in[9]; D = ws + WS_WFM + 1024 * 2; K = 2048; N = 2048; }
            else { r -= I_HF; W = p.in[10]; D = ws + WS_WOT; K = 2048; N = 2048; }
            const int nblk = N / 256; kb = (int)r / nblk; nb = (int)r % nblk;
        }
        q.src = W + (size_t)(128 * kb + wave) * N + 256 * nb + 4 * lane;
        q.dst = D + ((size_t)(256 * nb - (f8 == 2 ? 4608 : 0)) * K + 128 * kb) * (f8 ? 1 : 2);
        q.N = N; q.K = K; q.f8 = f8;
        if (probe) { q.src = p.in[14] + (size_t)wave * 4096 + 4 * lane; q.dst = ws + ((WS_FAST_END + 4095) & ~(size_t)4095) + (size_t)blockIdx.x * (256 * 2048); q.N = 4096; q.K = 2048; q.f8 = 1; }
        return true;
    };
    f32x4 v[16];
    LAS int* qslot = (LAS int*)(lds + LDS_MISC + 768);
    long it = it0 + worker, itn = it + nworkers;
    if (qhead) {
        if (tid == 0) { qslot[0] = __hip_atomic_fetch_add(qhead, 1, __ATOMIC_RELAXED, __HIP_MEMORY_SCOPE_AGENT); qslot[1] = __hip_atomic_fetch_add(qhead, 1, __ATOMIC_RELAXED, __HIP_MEMORY_SCOPE_AGENT); }
        __syncthreads();
        it = it0 + __builtin_amdgcn_readfirstlane(qslot[0]); itn = it0 + __builtin_amdgcn_readfirstlane(qslot[1]);
        __syncthreads();
    }
    Item cur; bool have = decode(it, cur);
    if (have) {
#pragma unroll
        for (int i = 0; i < 16; ++i) v[i] = cv_load(cur.src + (size_t)(8 * i) * cur.N);
    }
    int pst = 0;
    const int cch = lane & 7, nq = (lane >> 3) + 8 * wave;
    while (have) {
        Item nxt; const bool hn = decode(itn, nxt);
        __syncthreads();
#if CV_ASMLD
        if (pst == 4) asm volatile("s_waitcnt vmcnt(4)" ::: "memory"); else if (pst == 8) asm volatile("s_waitcnt vmcnt(8)" ::: "memory"); else asm volatile("s_waitcnt vmcnt(0)" ::: "memory");
#pragma unroll
        for (int i = 0; i < 16; ++i) asm volatile("" : "+v"(v[i]));
#endif
#pragma unroll
        for (int i = 0; i < 16; ++i) *(LAS f32x4*)(tile + (8 * i + wave) * CV_PITCH + 4 * lane + 16 * (i >> 1)) = v[i];
        if (qhead && hn && tid == 0) qslot[0] = __hip_atomic_fetch_add(qhead, 1, __ATOMIC_RELAXED, __HIP_MEMORY_SCOPE_AGENT);
        if (hn) {
#pragma unroll
            for (int i = 0; i < 16; ++i) v[i] = cv_load(nxt.src + (size_t)(8 * i) * nxt.N);
        }
        __syncthreads();
        const long itnn = qhead ? (hn ? it0 + __builtin_amdgcn_readfirstlane(qslot[0]) : it_end) : itn + nworkers;
        f32x4 t[16];
        const LAS float* s = tile + (16 * cch) * CV_PITCH + 16 * cch + 4 * nq;
#pragma unroll
        for (int i = 0; i < 16; ++i) t[i] = *(const LAS f32x4*)(s + i * CV_PITCH);
#pragma unroll
        for (int j = 0; j < 4; ++j) { const int n = 4 * nq + j;
            if (cur.f8) { u32x4 o; o.x = pk_fp8x4_scaled(t[0][j], t[1][j], t[2][j], t[3][j]); o.y = pk_fp8x4_scaled(t[4][j], t[5][j], t[6][j], t[7][j]);
                o.z = pk_fp8x4_scaled(t[8][j], t[9][j], t[10][j], t[11][j]); o.w = pk_fp8x4_scaled(t[12][j], t[13][j], t[14][j], t[15][j]);
                *(u32x4*)(cur.dst + (size_t)n * cur.K + 16 * cch) = o; }
            else { u32x4 o0, o1; o0.x = cvtpk(t[0][j], t[1][j]); o0.y = cvtpk(t[2][j], t[3][j]); o0.z = cvtpk(t[4][j], t[5][j]); o0.w = cvtpk(t[6][j], t[7][j]);
                o1.x = cvtpk(t[8][j], t[9][j]); o1.y = cvtpk(t[10][j], t[11][j]); o1.z = cvtpk(t[12][j], t[13][j]); o1.w = cvtpk(t[14][j], t[15][j]);
                u32x4* d = (u32x4*)(cur.dst + ((size_t)n * cur.K + 16 * cch) * 2); d[0] = o0; d[1] = o1; } }
        pst = cur.f8 ? 4 : 8;
        cur = nxt; have = hn; it = itn; itn = itnn;
    }
    __syncthreads();
}

constexpr long CE_TOTAL = (long)NE * 384;
constexpr int CE_PITCH = 1028;
__device__ __forceinline__ void convert_experts(const Params& p, LAS unsigned char* lds, long t0, long t1) {
    int tid_ = threadIdx.x; asm volatile("" : "+v"(tid_));
    const int tid = tid_, wave = tid >> 6, lane = tid & 63;
    LAS float* tile = (LAS float*)lds;
    struct Item { const float* src; unsigned char* dst; int N; };
    auto decode = [&](long t, Item& q) -> bool {
        if (t >= t1) return false;
        const int e = (int)(t / 384), r = (int)(t % 384);
        if (r < 256) { const int nr = r >> 6, kb = r & 63; q.N = 4096;
            q.src = p.in[14] + (size_t)e * 2048 * 4096 + (size_t)(32 * kb + 4 * wave) * 4096 + nr * 1024 + 4 * lane;
            q.dst = p.ws + WS_WGUQ + ((size_t)e * 4096 + (size_t)nr * 1024) * 2048 + 32 * kb; }
        else { const int nr = (r - 256) >> 6, kb = (r - 256) & 63; q.N = 2048;
            q.src = p.in[16] + (size_t)e * 2048 * 2048 + (size_t)(32 * kb + 4 * wave) * 2048 + nr * 1024 + 4 * lane;
            q.dst = p.ws + WS_WDNQ + ((size_t)e * 2048 + (size_t)nr * 1024) * 2048 + 32 * kb; }
        return true;
    };
    f32x4 v[16];
    Item cur; long t = t0; bool have = decode(t, cur);
    if (have) {
#pragma unroll
        for (int i = 0; i < 16; ++i) v[i] = __builtin_nontemporal_load((const f32x4*)(cur.src + (size_t)(i >> 2) * cur.N + 256 * (i & 3)));
    }
    while (have) {
        Item nxt; const bool hn = decode(t + 1, nxt);
        __syncthreads();
#pragma unroll
        for (int i = 0; i < 16; ++i) *(LAS f32x4*)(tile + (4 * wave + (i >> 2)) * CE_PITCH + 256 * (i & 3) + 4 * lane) = v[i];
        if (hn) {
#pragma unroll
            for (int i = 0; i < 16; ++i) v[i] = __builtin_nontemporal_load((const f32x4*)(nxt.src + (size_t)(i >> 2) * nxt.N + 256 * (i & 3)));
        }
        __syncthreads();
#pragma unroll
        for (int j = 0; j < 2; ++j) { const int n = tid + 512 * j; const LAS float* s = tile + n;
            float f[32];
#pragma unroll
            for (int i = 0; i < 32; ++i) f[i] = s[i * CE_PITCH] * WQ_SCALE;
            u32x4 o0, o1;
            o0.x = pk_fp8x4(f[0], f[1], f[2], f[3]); o0.y = pk_fp8x4(f[4], f[5], f[6], f[7]); o0.z = pk_fp8x4(f[8], f[9], f[10], f[11]); o0.w = pk_fp8x4(f[12], f[13], f[14], f[15]);
            o1.x = pk_fp8x4(f[16], f[17], f[18], f[19]); o1.y = pk_fp8x4(f[20], f[21], f[22], f[23]); o1.z = pk_fp8x4(f[24], f[25], f[26], f[27]); o1.w = pk_fp8x4(f[28], f[29], f[30], f[31]);
            u32x4* d = (u32x4*)(cur.dst + (size_t)n * 2048); d[0] = o0; d[1] = o1; }
        cur = nxt; have = hn; ++t;
    }
    __syncthreads();
}

__device__ __forceinline__ void phase_prologue(const Params& p, LAS unsigned char* lds) {
    int tid_ = threadIdx.x; asm volatile("" : "+v"(tid_));
    const int tid = tid_, wave = tid >> 6, lane = tid & 63;
    unsigned char* ws = p.ws;
    const int gw = vwg() * NWAVE + wave, NGW = (int)gridDim.x * NWAVE;
    for (int m = gw; m < T_; m += NGW) rms_row_to_bf16(p.in[0] + (size_t)m * DM, p.in[3], (bf16_t*)(ws + WS_H) + (size_t)m * LDP, lane, GATES_F8 ? (ws + WS_H8 + (size_t)m * DM) : nullptr, RES_FROM_H ? (float*)(ws + WS_IRSTD) + m : nullptr);
    for (int m = gw; m < B_ * MEM; m += NGW) {
        const f32x4* xr = (const f32x4*)(p.in[1] + (size_t)m * DM) + lane; u32x2* o8 = (u32x2*)((bf16_t*)(ws + WS_MEMBF) + (size_t)m * LDP) + lane;
#pragma unroll
        for (int j = 0; j < 8; ++j) { const f32x4 v = xr[64 * j]; u32x2 w; w.x = cvtpk(v[0], v[1]); w.y = cvtpk(v[2], v[3]); o8[64 * j] = w; }
    }
    {
        const int gt = vwg() * NTHR + tid, NGT = (int)gridDim.x * NTHR;
        bf16_t* tabT = (bf16_t*)(ws + WS_TABT); bf16_t* dm = (bf16_t*)(ws + WS_DMAT);
        for (int i = gt; i < 512 * 256 / 2; i += NGT) { const int e0 = 2 * i; const int mrow = e0 >> 8, c = e0 & 255; const int n = mrow & 255; float v[2];
#pragma unroll
            for (int j = 0; j < 2; ++j) { const int mm = ((c + j) * n) & 255; const float a = (float)mm * (2.0f / 256.0f); v[j] = (mrow < 256) ? cospif(a) : sinpif(a); }
            *(unsigned*)(tabT + e0) = cvtpk(v[0], v[1]); }
        const float sc = 1.0f / sqrtf(2048.0f * 256.0f);
        LAS float* ct = (LAS float*)lds;
        for (int m = tid; m < 2048; m += NTHR) ct[m] = cospif((float)m * (2.0f / 2048.0f)) * sc;
        __syncthreads();
        for (int i = gt; i < 2048 * 4096 / 2; i += NGT) { const int e0 = 2 * i; const int jr = e0 >> 12, k = e0 & 4095; float v[2];
#pragma unroll
            for (int j = 0; j < 2; ++j) { const int kk = (k + j) & 2047; const int mm = (jr * kk) & 2047; v[j] = (k < 2048) ? ct[mm] : ct[(mm + 512) & 2047]; }
            *(unsigned*)(dm + (size_t)jr * SQP + k) = cvtpk(v[0], v[1]); }
        __syncthreads();
        bf16_t* wrt = (bf16_t*)(ws + WS_WRT);
        for (int i = gt; i < NE * DM; i += NGT) { const int e = i >> 11, k = i & 2047; wrt[i] = (bf16_t)(cvtpk(p.in[12][(size_t)k * NE + e], 0.f) & 0xffffu); }
    }
    __syncthreads();
    convert_items(p, lds, 0, (gridDim.x == 256) ? CV_NONEXP : CV_TOTAL, vwg(), (int)gridDim.x);
}

constexpr int AT_KROW = 144, AT_VROW = 776;
constexpr int AT_K = 0, AT_V = 384 * AT_KROW, AT_LUT = AT_V + 64 * AT_VROW;
static_assert(AT_LUT + NWAVE * 320 * 4 <= STAGE_BYTES, "attention LDS");
__device__ __forceinline__ void attn_unit(const Params& p, LAS unsigned char* lds, int b, int kvh, int qb) {
    int tid_ = threadIdx.x; asm volatile("" : "+v"(tid_));
    const int tid = tid_, wid = __builtin_amdgcn_readfirstlane(tid >> 6), lane = tid & 63, r = lane & 31, h = lane >> 5;
    const unsigned char* ws = p.ws;
    const bf16_t* Q = (const bf16_t*)(ws + WS_Q); const bf16_t* Kg = (const bf16_t*)(ws + WS_K); const bf16_t* VT = (const bf16_t*)(ws + WS_VT);
    bf16_t* att = (bf16_t*)(p.ws + WS_ATT);
    const int q0 = qb * 128, hq = kvh * 8 + wid;
    LAS unsigned char* Kb = lds + AT_K; LAS unsigned char* Vt = lds + AT_V; LAS float* lut = (LAS float*)(lds + AT_LUT) + wid * 320;
    __syncthreads();
    for (int c = tid; c < 384 * 8; c += NTHR) { const int row = c >> 3, part = c & 7, pos = q0 - 128 + row;
        u32x4 v = {0u, 0u, 0u, 0u};
        if (pos >= 0 && pos < S_) v = *(const u32x4*)(Kg + (size_t)(b * S_ + pos) * 256 + kvh * 64 + part * 8);
        *(LAS u32x4*)(Kb + row * AT_KROW + part * 16) = v; }
    for (int c = tid; c < 64 * 48; c += NTHR) { const int d = c / 48, ch = c % 48, pos0 = q0 - 128 + ch * 8;
        u32x4 v = {0u, 0u, 0u, 0u};
        if (pos0 >= 0 && pos0 < S_) v = *(const u32x4*)(VT + ((size_t)((b * 4 + kvh) * 64 + d)) * 2048 + pos0);
        *(LAS u32x2*)(Vt + d * AT_VROW + ch * 16) = (u32x2){v.x, v.y}; *(LAS u32x2*)(Vt + d * AT_VROW + ch * 16 + 8) = (u32x2){v.z, v.w}; }
    for (int i = lane; i < 320; i += 64) { const int rel = i - 160; const int ar = rel < 0 ? -rel : rel;
        lut[i] = (ar <= WIN) ? p.in[2][t5_bucket(rel) * NH + hq] * LOG2E : -1.0e30f; }
    __syncthreads();
    const float sk = p.in[5][hq] * LOG2E;
    const float SC = 0.125f * LOG2E;
#pragma unroll 1
    for (int sb = 0; sb < 4; ++sb) {
        const int pq = q0 + sb * 32;
        bf16x8 qf[4];
        const bf16_t* qrow = Q + (size_t)(b * S_ + pq + r) * 2048 + hq * 64 + 8 * h;
#pragma unroll
        for (int s = 0; s < 4; ++s) qf[s] = *(const bf16x8*)(qrow + 16 * s);
        float mrun = sk, lrun = 1.0f;
        f32x16 o0, o1;
#pragma unroll
        for (int i = 0; i < 16; ++i) { o0[i] = 0.f; o1[i] = 0.f; }
        const int jlo = (qb == 0) ? 4 - sb : 0, jhi = (qb == 15) ? 8 - sb : 9;
        const LAS unsigned char* kp = Kb + (32 * (sb + jlo) + r) * AT_KROW + 16 * h;
        const LAS unsigned char* vp = Vt + r * AT_VROW + (32 * (sb + jlo) + 4 * h) * 2;
        const LAS unsigned char* vq = vp + 32 * AT_VROW;
        const LAS float* lp = lut + 32 * jlo + 32 + 4 * h - r;
#pragma unroll 1
        for (int j = jlo; j < jhi; ++j) {
            asm volatile("" : "+v"(kp), "+v"(vp), "+v"(vq), "+v"(lp));
            f32x16 s;
#pragma unroll
            for (int i = 0; i < 16; ++i) s[i] = 0.f;
#pragma unroll
            for (int ks = 0; ks < 4; ++ks) { const bf16x8 kf = *(const LAS bf16x8*)(kp + 32 * ks); s = __builtin_amdgcn_mfma_f32_32x32x16_bf16(kf, qf[ks], s, 0, 0, 0); }
            float mx = -3.0e38f;
            f32x2 sp[8];
#pragma unroll
            for (int i = 0; i < 8; ++i) { const int li = ((2 * i) & 3) + 8 * ((2 * i) >> 2); const f32x2 lv = {lp[li], lp[li + 1]}; const f32x2 sv = {s[2 * i], s[2 * i + 1]};
                sp[i] = sv * (f32x2){SC, SC} + lv; mx = fmaxf(fmaxf(mx, sp[i][0]), sp[i][1]); }
            mx = fmaxf(mx, __shfl_xor(mx, 32));
            const float mnew = fmaxf(mrun, mx);
            const float alpha = __builtin_amdgcn_exp2f(mrun - mnew);
            f32x2 rs2 = {0.f, 0.f};
#pragma unroll
            for (int i = 0; i < 8; ++i) { const f32x2 d = sp[i] - (f32x2){mnew, mnew}; const f32x2 e = {__builtin_amdgcn_exp2f(d[0]), __builtin_amdgcn_exp2f(d[1])};
                s[2 * i] = e[0]; s[2 * i + 1] = e[1]; rs2 += e; }
            float rs = rs2[0] + rs2[1];
            rs += __shfl_xor(rs, 32);
            lrun = lrun * alpha + rs; mrun = mnew;
            if (__any(alpha != 1.0f)) {
#pragma unroll
                for (int i = 0; i < 16; ++i) { o0[i] *= alpha; o1[i] *= alpha; }
            }
#pragma unroll
            for (int k2 = 0; k2 < 2; ++k2) {
                u32x4 pw; pw.x = cvtpk(s[8 * k2 + 0], s[8 * k2 + 1]); pw.y = cvtpk(s[8 * k2 + 2], s[8 * k2 + 3]); pw.z = cvtpk(s[8 * k2 + 4], s[8 * k2 + 5]); pw.w = cvtpk(s[8 * k2 + 6], s[8 * k2 + 7]);
                const bf16x8 pb = __builtin_bit_cast(bf16x8, pw);
                { const u32x2 lo = *(const LAS u32x2*)(vp + 32 * k2), hi = *(const LAS u32x2*)(vp + 32 * k2 + 16); const u32x4 vw = {lo.x, lo.y, hi.x, hi.y};
                  o0 = __builtin_amdgcn_mfma_f32_32x32x16_bf16(__builtin_bit_cast(bf16x8, vw), pb, o0, 0, 0, 0); }
                { const u32x2 lo = *(const LAS u32x2*)(vq + 32 * k2), hi = *(const LAS u32x2*)(vq + 32 * k2 + 16); const u32x4 vw = {lo.x, lo.y, hi.x, hi.y};
                  o1 = __builtin_amdgcn_mfma_f32_32x32x16_bf16(__builtin_bit_cast(bf16x8, vw), pb, o1, 0, 0, 0); }
            }
            kp += 32 * AT_KROW; vp += 64; vq += 64; lp += 32;
        }
        const float inv = 1.0f / lrun;
        bf16_t* orow = att + (size_t)(b * S_ + pq + r) * 2048 + hq * 64 + 4 * h;
#pragma unroll
        for (int g = 0; g < 4; ++g) {
            u32x2 w0; w0.x = cvtpk(o0[4 * g] * inv, o0[4 * g + 1] * inv); w0.y = cvtpk(o0[4 * g + 2] * inv, o0[4 * g + 3] * inv); *(u32x2*)(orow + 8 * g) = w0;
            u32x2 w1; w1.x = cvtpk(o1[4 * g] * inv, o1[4 * g + 1] * inv); w1.y = cvtpk(o1[4 * g + 2] * inv, o1[4 * g + 3] * inv); *(u32x2*)(orow + 32 + 8 * g) = w1;
        }
    }
}

__device__ __forceinline__ void phase_rows(const Params& p, LAS unsigned char* lds) {
    int tid_ = threadIdx.x; asm volatile("" : "+v"(tid_));
    const int tid = tid_, wave = __builtin_amdgcn_readfirstlane(tid >> 6), lane = tid & 63;
    unsigned char* ws = p.ws;
    const bf16_t* x2 = (const bf16_t*)(ws + WS_X2); bf16_t* h2 = (bf16_t*)(ws + WS_H2);
    LAS float* lg = (LAS float*)lds;
    LAS int* sel_e = (LAS int*)(lds + 8192);
    LAS float* sel_w = (LAS float*)(lds + 9216);
    LAS int* sel_r = (LAS int*)(lds + 10240);
    LAS int* lcnt = (LAS int*)(lds + 11264);
    LAS int* lbase = (LAS int*)(lds + 11392);
#pragma unroll 1
    for (int t0 = vwg() * 64; t0 < T_; t0 += 64 * (int)gridDim.x) {
        __syncthreads();
        if (tid < 32) lcnt[tid] = 0;
        for (int i = 0; i < 8; ++i) { const int t = t0 + wave * 8 + i; rms_bfrow_to_bf16(x2 + (size_t)t * DM, p.in[11], h2 + (size_t)t * DM, lane, MOE_F8 ? (ws + WS_H2Q + (size_t)t * DM) : nullptr); }
        asm volatile("s_waitcnt vmcnt(0)" ::: "memory");
        __syncthreads();
        if (wave < 4) {
            const bf16_t* arow = h2 + (size_t)(t0 + wave * 16 + (lane & 15)) * DM + 8 * (lane >> 4);
            const bf16_t* b0 = (const bf16_t*)(ws + WS_WRT) + (size_t)(lane & 15) * DM + 8 * (lane >> 4);
            const bf16_t* b1 = b0 + (size_t)16 * DM;
            f32x4 a0 = {0.f, 0.f, 0.f, 0.f}, a1 = {0.f, 0.f, 0.f, 0.f};
#pragma unroll 8
            for (int s = 0; s < 64; ++s) { const bf16x8 av = *(const bf16x8*)(arow + 32 * s), bv0 = *(const bf16x8*)(b0 + 32 * s), bv1 = *(const bf16x8*)(b1 + 32 * s);
                a0 = __builtin_amdgcn_mfma_f32_16x16x32_bf16(av, bv0, a0, 0, 0, 0); a1 = __builtin_amdgcn_mfma_f32_16x16x32_bf16(av, bv1, a1, 0, 0, 0); }
            const int ecol = lane & 15; const float bb0 = p.in[13][ecol], bb1 = p.in[13][ecol + 16];
#pragma unroll
            for (int rg = 0; rg < 4; ++rg) { const int tl = wave * 16 + (lane >> 4) * 4 + rg; lg[tl * 32 + ecol] = a0[rg] + bb0; lg[tl * 32 + ecol + 16] = a1[rg] + bb1; }
        }
        __syncthreads();
        if (tid < 64) {
            float v[32];
#pragma unroll
            for (int e = 0; e < 32; ++e) v[e] = lg[tid * 32 + e];
            float tv[4]; int ti[4];
#pragma unroll
            for (int k = 0; k < 4; ++k) { float bv = -3.0e38f; int bi = 0;
#pragma unroll
                for (int e = 0; e < 32; ++e) { const bool tk = v[e] > bv; bv = tk ? v[e] : bv; bi = tk ? e : bi; }
                tv[k] = bv; ti[k] = bi;
#pragma unroll
                for (int e = 0; e < 32; ++e) v[e] = (e == bi) ? -3.0e38f : v[e]; }
            const float e1 = __expf(tv[1] - tv[0]), e2 = __expf(tv[2] - tv[0]), e3 = __expf(tv[3] - tv[0]);
            const float inv = 1.0f / (1.0f + e1 + e2 + e3);
            const float wv[4] = {inv, e1 * inv, e2 * inv, e3 * inv};
#pragma unroll
            for (int k = 0; k < 4; ++k) { sel_e[tid * 4 + k] = ti[k]; sel_w[tid * 4 + k] = wv[k]; sel_r[tid * 4 + k] = __hip_atomic_fetch_add(&lcnt[ti[k]], 1, __ATOMIC_RELAXED, __HIP_MEMORY_SCOPE_WORKGROUP); }
        }
        __syncthreads();
        if (tid < 32) lbase[tid] = (lcnt[tid] > 0) ? atomicAdd((int*)(ws + WS_CTL) + CW_CNT + tid, lcnt[tid]) : 0;
        __syncthreads();
        if (tid < 256) { const int tl = tid >> 2, k = tid & 3, t = t0 + tl; const int e = sel_e[tid], pos = lbase[e] + sel_r[tid]; const float w = sel_w[tid];
            ((int*)(ws + WS_TOKE))[t * 4 + k] = e; ((int*)(ws + WS_TOKPOS))[t * 4 + k] = pos; ((float*)(ws + WS_TOKW))[t * 4 + k] = w;
            ((int*)(ws + WS_LIST))[(size_t)e * T_ + pos] = t; ((float*)(ws + WS_WLIST))[(size_t)e * T_ + pos] = w; }
    }
}
__device__ __forceinline__ void moe_tables(const Params& p, LAS int* pt, LAS int* cn) {
    __syncthreads();
    if (threadIdx.x < 64) {
        const int ln = (int)threadIdx.x; const int* cnt = (const int*)(p.ws + WS_CTL) + CW_CNT;
        const int c = (ln < NE) ? __hip_atomic_load(cnt + (ln & 31), __ATOMIC_RELAXED, __HIP_MEMORY_SCOPE_AGENT) : 0;
        const int tl = (c + 255) >> 8; int inc = tl;
#pragma unroll
        for (int o = 1; o < 32; o <<= 1) { const int v = __shfl_up(inc, o); if (ln >= o) inc += v; }
        if (ln < NE) { cn[ln] = c; pt[ln] = inc - tl; }
        if (ln == NE - 1) pt[NE] = inc;
    }
    __syncthreads();
}
__device__ __forceinline__ void phase_final(const Params& p, const LAS int* pt) {
    int tid_ = threadIdx.x; asm volatile("" : "+v"(tid_));
    const int tid = tid_, wave = tid >> 6, lane = tid & 63;
    const unsigned char* ws = p.ws;
    const bf16_t* x2 = (const bf16_t*)(ws + WS_X2); const bf16_t* ys = (const bf16_t*)(ws + WS_YS);
    const int* toke = (const int*)(ws + WS_TOKE); const int* tokpos = (const int*)(ws + WS_TOKPOS);
    const int gw = vwg() * NWAVE + wave, NGW = (int)gridDim.x * NWAVE;
    float pscale = 1.0f;
    if (PROFSEL != 0) {
        const unsigned long long* pf = (const unsigned long long*)(p.ws + WS_CTL + 32768);
        const float kl = (float)pf[0], ep = (float)pf[1], n = (float)pf[2], ntl = (float)pf[3], cyc = (float)pf[4], wal = (float)pf[5];
        float m = 0.f;
        if (PROFMETRIC == 0) m = ep / (kl + ep);
        if (PROFMETRIC == 1) m = kl / (n * ntl) / 4096.0f;
        if (PROFMETRIC == 2) m = cyc / (wal * 24.0f);
        if (PROFMETRIC == 3) m = (kl + ep) / cyc;
        if (PROFMETRIC == 4) m = n / 32.0f;
        if (PROFMETRIC == 5) m = wal / 100.0f / 200.0f;
        if (PROFMETRIC == 6 || PROFMETRIC == 7) {
            const unsigned long long* st = (const unsigned long long*)(p.ws + WS_CTL + 40960);
            unsigned long long mx = 0, mn = ~0ull, sum = 0;
            for (int i = 0; i < (int)gridDim.x; ++i) { const unsigned long long v = st[i]; mx = v > mx ? v : mx; mn = v < mn ? v : mn; sum += v; }
            const float mean = (float)(sum - mn * gridDim.x) / (float)gridDim.x;
            m = (PROFMETRIC == 6 ? ((float)(mx - mn) - mean) : (float)(mx - mn)) / 100.0f / 200.0f; }
        if (blockIdx.x == 0 && threadIdx.x == 0) { const unsigned long long t0 = wall_clock64(), ticks = (unsigned long long)(m * (float)PROFMUL * 100.0f * 100.0f);
            while (wall_clock64() - t0 < ticks) __builtin_amdgcn_s_sleep(8); }
    }
    for (int t = gw; t < T_; t += NGW) {
        const u32x2* xr = (const u32x2*)(x2 + (size_t)t * DM) + lane;
        f32x4 v[8];
#pragma unroll
        for (int j = 0; j < 8; ++j) { const u32x2 w = xr[64 * j]; v[j] = (f32x4){bflo(w.x), bfhi(w.x), bflo(w.y), bfhi(w.y)}; }
#pragma unroll
        for (int k = 0; k < 4; ++k) { const int e = toke[t * 4 + k]; const size_t slot = (size_t)pt[e] * 256 + tokpos[t * 4 + k];
            if constexpr (MOE_F8) {
                const unsigned* yr = (const unsigned*)((const unsigned char*)ys + slot * DM) + lane;
#pragma unroll
                for (int j = 0; j < 8; ++j) { const unsigned w = yr[64 * j];
                    v[j][0] += __builtin_amdgcn_cvt_f32_fp8((int)w, 0) * YS_INV; v[j][1] += __builtin_amdgcn_cvt_f32_fp8((int)w, 1) * YS_INV;
                    v[j][2] += __builtin_amdgcn_cvt_f32_fp8((int)w, 2) * YS_INV; v[j][3] += __builtin_amdgcn_cvt_f32_fp8((int)w, 3) * YS_INV; }
            } else {
                const u32x2* yr = (const u32x2*)(ys + slot * DM) + lane;
#pragma unroll
                for (int j = 0; j < 8; ++j) { const u32x2 w = yr[64 * j]; v[j][0] += bflo(w.x); v[j][1] += bfhi(w.x); v[j][2] += bflo(w.y); v[j][3] += bfhi(w.y); }
            } }
        float s = 0.f;
#pragma unroll
        for (int j = 0; j < 8; ++j) s += (v[j][0] * v[j][0] + v[j][1] * v[j][1]) + (v[j][2] * v[j][2] + v[j][3] * v[j][3]);
        const float r = rsqrtf(wsum(s) * (1.0f / DM) + 1e-5f);
        const f32x4* gr = (const f32x4*)p.in[18] + lane; f32x4* orow = (f32x4*)(p.out + (size_t)t * DM) + lane;
#pragma unroll
        for (int j = 0; j < 8; ++j) { const f32x4 gg = gr[64 * j]; orow[64 * j] = (f32x4){v[j][0] * r * gg[0] * pscale, v[j][1] * r * gg[1] * pscale, v[j][2] * r * gg[2] * pscale, v[j][3] * r * gg[3] * pscale}; }
    }
}
#ifndef P1_SLOT_BAL
#define P1_SLOT_BAL 1
#endif
#ifndef CV_SPLIT
#define CV_SPLIT 6144L
#endif
#ifndef MOE_SLOT
#define MOE_SLOT 1
#endif
#ifndef X2_SLOT
#define X2_SLOT 0
#endif
#ifndef MOE_SLOT_STEP
#define MOE_SLOT_STEP 4
#endif
#ifndef MOE_SLOT_BAL
#define MOE_SLOT_BAL 4
#endif
#ifndef POOL1
#define POOL1 2
#endif
#ifndef P2ROLE
#define P2ROLE 0
#endif
#ifndef POOL2
#define POOL2 0
#endif
#ifndef POOL3
#define POOL3 0
#endif
#ifndef POOL4
#define POOL4 0
#endif
#ifndef POOL5
#define POOL5 0
#endif
#ifndef Q4
#define Q4 8
#endif
constexpr long GU_A0 = 30 - (POOL1 + POOL2 + POOL3 + POOL4 + POOL5 + Q4);
constexpr long GU_P1S = 64 * (4 * GU_A0 + 8), GU_P1P = GU_P1S, GU_P2P = GU_P1P + 256 * POOL1, GU_P3P = GU_P2P + 256 * POOL2, GU_P4S = GU_P3P + 256 * POOL3,
               GU_P4P = GU_P4S + 256 * Q4, GU_P5P = GU_P4P + 256 * POOL4, GU_END = GU_P5P + 256 * POOL5;
static_assert(GU_END == 8192 && GU_A0 > 0, "gate_up conversion layout");
#ifndef POOL7
#define POOL7 2
#endif
__device__ __forceinline__ void proj_convert_slot(const Params& p, LAS unsigned char* lds, int g, int part) {
    const int wgi = (int)blockIdx.x & 63;
    __syncthreads();
    if constexpr (MOE_F8 && CONV_TILE32) { const long per = CE_TOTAL / 512, a = ((long)(part * 4 + g) * 64 + wgi) * per; convert_experts(p, lds, a, a + per); }
    else { const long total = CV_TOTAL - CV_NONEXP, half = total / 2; long q = half / 4, it0 = CV_NONEXP + half * part + q * g;
        if (P1_SLOT_BAL) {
            constexpr long P1END = (MOE_SLOT ? 8192 : 12288) - 256 * X2_SLOT;
            static_assert((CV_TOTAL - CV_NONEXP) == 12288 && MOE_SLOT == 1 && X2_SLOT == 0, "slot split");
            if (part == 0) { it0 = CV_NONEXP + 64 * GU_A0 * g; q = 64 * (g == 3 ? GU_A0 + 8 : GU_A0); }
            else if (part == 1) { it0 = CV_NONEXP + GU_P4S + 64 * Q4 * g; q = 64 * Q4; }
            else if (part == 2) { it0 = CV_NONEXP + 8192 + 1024 * g; q = 1024; }
            else { it0 = CV_NONEXP + P1END + 64 * X2_SLOT * g; q = 64 * X2_SLOT; } }
        convert_items(p, lds, it0, it0 + q, wgi, 64);
#ifdef DBLCONV
        if (part == (DBLCONV & 3) - 1) { __syncthreads(); convert_items(p, lds, it0, it0 + q, wgi, 64, DBLCONV >> 2); }
#endif
    }
    asm volatile("s_waitcnt vmcnt(0) lgkmcnt(0)" ::: "memory");
    __syncthreads();
}
__device__ __forceinline__ void pool_drain(const Params& p, LAS unsigned char* lds, int pool, long base, int count) {
    __syncthreads();
    convert_items(p, lds, base, base + count, 0, 1, 0, (int*)(p.ws + WS_CTL) + CW_POOL + 64 * pool);
    asm volatile("s_waitcnt vmcnt(0) lgkmcnt(0)" ::: "memory");
    __syncthreads();
}
__device__ __forceinline__ void convert_range_slot(const Params& p, LAS unsigned char* lds, long it0, long n) {
    __syncthreads();
    convert_items(p, lds, it0, it0 + n, 0, 1);
    asm volatile("s_waitcnt vmcnt(0) lgkmcnt(0)" ::: "memory");
    __syncthreads();
}
__device__ __forceinline__ void phase_proj(const Params& p, LAS unsigned char* lds) {
    EpiProj E{p.ws}; EpiGates8 EG{p.ws};
    unsigned long long* prof = PROFSEL == 1 ? (unsigned long long*)(p.ws + WS_CTL + 32768) : nullptr;
    const int BIG = 1 << 20;
    const bool stag = (gridDim.x == 256);
    const int g = stag ? ((int)blockIdx.x >> 6) : -1;
    if constexpr (GATES_F8) {
#ifndef P1SLOTV
#define P1SLOTV 0
#endif
        int a1 = (g == 0) ? 0 : (g == 1 ? 2 : BIG), a3 = (g == 3) ? 3 : BIG, slot = (g <= 1) ? 1 : g;
        if (P1SLOTV == 1) { a1 = BIG; a3 = (g <= 0) ? BIG : 2 * g; slot = (g <= 0) ? 2 : 3; }
        if (P1SLOTV == 2) { a1 = (g == 0) ? 0 : (g == 1 ? 3 : BIG); a3 = (g == 2) ? 1 : (g == 3 ? 4 : BIG); slot = (g <= 1) ? 1 : 3; }
        { SchedProj S{p.ws, 0, a1}; gemm_phase<EpiProj, SchedProj, true>(lds, 2048, LDP, LDP, S, E, nullptr); }
        if (stag && slot == 1) proj_convert_slot(p, lds, g, 0);
        { SchedProj S{p.ws, a1, BIG}; gemm_phase<EpiProj, SchedProj, true>(lds, 2048, LDP, LDP, S, E, prof); }
        if (stag && slot == 2) proj_convert_slot(p, lds, g, 0);
        { SchedGates8 S{p.ws, 0, a3}; gemm_phase<EpiGates8, SchedGates8, true, 1>(lds, 2048, 2048, 2048, S, EG, nullptr); }
        if (stag && slot == 3) proj_convert_slot(p, lds, g, 0);
        { SchedGates8 S{p.ws, a3, BIG}; gemm_phase<EpiGates8, SchedGates8, true, 1>(lds, 2048, 2048, 2048, S, EG, nullptr); }
        if (stag && POOL1 > 0) pool_drain(p, lds, 0, CV_NONEXP + GU_P1P, 256 * POOL1);
    } else {
        const int nb = stag ? 3 * g : 0;
        if (nb > 0) { SchedProj S{p.ws, 0, nb}; gemm_phase<EpiProj, SchedProj, true>(lds, 2048, LDP, LDP, S, E, nullptr); }
        if (stag) proj_convert_slot(p, lds, g, 0);
        { SchedProj S{p.ws, nb, BIG}; gemm_phase<EpiProj, SchedProj, true>(lds, 2048, LDP, LDP, S, E, prof); }
    }
}
__device__ __forceinline__ void phase_mixers(const Params& p, LAS unsigned char* lds) {
    unsigned char* ws = p.ws;
#ifndef DBLSUB
#define DBLSUB 0
#endif
#pragma unroll 1
    for (int rep = 0; rep < ((DBLSUB & 1) ? 2 : 1); ++rep)
#pragma unroll 1
    for (int u = (P2ROLE && gridDim.x == 256) ? (((int)blockIdx.x >> 6) < 3 ? ((int)blockIdx.x & 7) * 24 + ((int)blockIdx.x >> 3) : 512) : vwg(); u < 512; u += (P2ROLE && gridDim.x == 256) ? 192 : (int)gridDim.x)
        attn_unit(p, lds, u >> 6, (u >> 4) & 3, u & 15);
    asm volatile("s_waitcnt vmcnt(0) lgkmcnt(0)" ::: "memory");
    __syncthreads();
#pragma unroll 1
    for (int rep = 0; rep < ((DBLSUB & 2) ? 2 : 1); ++rep)
#pragma unroll 1
    for (int u = vwg(); u < 256; u += (int)gridDim.x) {
        const int mh = u & 3, tb = (u >> 2) & 7, b = (u >> 5) & 7;
        const size_t tok0 = (size_t)b * S_ + (size_t)tb * 256;
        bf16_t* Pt = (bf16_t*)(ws + WS_PM) + tok0 * 1024 + mh * 256;
        SchedOne S1{(const char*)(ws + WS_QM) + (tok0 * 1024 + mh * 256) * 2, (const char*)(ws + WS_KMK) + ((size_t)b * 256 * 1024 + mh * 256) * 2, 0, true};
        EpiMemSoftmax E1{Pt};
        gemm_phase<EpiMemSoftmax, SchedOne, false>(lds, 256, 1024, 1024, S1, E1);
        asm volatile("s_waitcnt vmcnt(0)" ::: "memory");
        __syncthreads();
        SchedOne S2{(const char*)Pt, (const char*)(ws + WS_VMT) + ((size_t)(b * 4 + mh) * 256 * 256) * 2, 0, true};
        EpiTile E2{(bf16_t*)(ws + WS_FX) + tok0 * 2048 + 1024 + mh * 256, 2048};
        gemm_phase<EpiTile, SchedOne, false>(lds, 256, 1024, 256, S2, E2);
        __syncthreads();
    }
    { SchedChan S{ws, 0, 0}; EpiChan E{ws}; gemm_phase<EpiChan, SchedChan, true>(lds, 256, 256, 1024, S, E, PROFSEL == 2 ? (unsigned long long*)(p.ws + WS_CTL + 32768) : nullptr); }
    if (POOL2 > 0 && gridDim.x == 256) pool_drain(p, lds, 2, CV_NONEXP + GU_P2P, 256 * POOL2);
}
__device__ __forceinline__ void phase_seqdft(const Params& p, LAS unsigned char* lds) {
    SchedSeq S{p.ws}; EpiSeq E{p.ws};
    gemm_phase<EpiSeq, SchedSeq, true>(lds, 4096, SQP, SQP, S, E, PROFSEL == 3 ? (unsigned long long*)(p.ws + WS_CTL + 32768) : nullptr);
    if (POOL3 > 0 && gridDim.x == 256) pool_drain(p, lds, 3, CV_NONEXP + GU_P3P, 256 * POOL3);
}
__device__ __forceinline__ void phase_mix(const Params& p, LAS unsigned char* lds) {
    unsigned char* ws = p.ws;
    const bool stag = (gridDim.x == 256); const int g = stag ? ((int)blockIdx.x >> 6) : -1;
    unsigned long long* prof = PROFSEL == 4 ? (unsigned long long*)(p.ws + WS_CTL + 32768) : nullptr;
    EpiMixF E{ws};
#ifndef MIXSLOT
#define MIXSLOT 0x2110
#endif
    const int sp = (g >= 0) ? ((MIXSLOT >> (4 * g)) & 15) : -1;
    if (sp == 0) proj_convert_slot(p, lds, g, 1);
    { SchedMix S{ws, 0, 1}; gemm_phase<EpiMixF, SchedMix, true>(lds, 2048, 2048, 2048, S, E, prof); }
    if (sp == 1) proj_convert_slot(p, lds, g, 1);
    { SchedMix S{ws, 1, 1 << 20}; gemm_phase<EpiMixF, SchedMix, true>(lds, 2048, 2048, 2048, S, E, nullptr); }
    if (sp == 2) proj_convert_slot(p, lds, g, 1);
    if (POOL4 > 0 && stag) pool_drain(p, lds, 4, CV_NONEXP + GU_P4P, 256 * POOL4);
}
__device__ __forceinline__ void phase_x2(const Params& p, LAS unsigned char* lds) {
    unsigned char* ws = p.ws;
    SchedPlain S{(const char*)(ws + WS_MIXED), (const char*)(ws + WS_WOT), (size_t)256 * 2048 * 2, (size_t)256 * 2048 * 2, 64, 8};
    EpiRes E{p.in[0], (bf16_t*)(ws + WS_X2), (const bf16_t*)(ws + WS_H), (const float*)(ws + WS_IRSTD), p.in[3]};
    unsigned long long* prof = PROFSEL == 5 ? (unsigned long long*)(p.ws + WS_CTL + 32768) : nullptr;
    if (X2_SLOT > 0 && MOE_SLOT && gridDim.x == 256) {
        const int g = (int)blockIdx.x >> 6, sp = (0x2110 >> (4 * g)) & 15;
        if (sp == 0) proj_convert_slot(p, lds, g, 3);
        { SchedPlain Sa = S; Sa.r0 = 0; Sa.r1 = 1; gemm_phase<EpiRes, SchedPlain, true>(lds, 2048, 2048, 2048, Sa, E, prof); }
        if (sp == 1) proj_convert_slot(p, lds, g, 3);
        { SchedPlain Sb = S; Sb.r0 = 1; gemm_phase<EpiRes, SchedPlain, true>(lds, 2048, 2048, 2048, Sb, E, nullptr); }
        if (sp == 2) proj_convert_slot(p, lds, g, 3);
    } else gemm_phase<EpiRes, SchedPlain, true>(lds, 2048, 2048, 2048, S, E, prof);
    if (POOL5 > 0 && gridDim.x == 256) pool_drain(p, lds, 5, CV_NONEXP + GU_P5P, 256 * POOL5);
}
template <class Sched> __device__ __forceinline__ void moe_fill_tokl(const Params& p, LAS unsigned char* lds, const Sched& S, const LAS int* cn) {
    LAS unsigned short* tokl = (LAS unsigned short*)(lds + LDS_TOKL);
    const int* list = (const int*)(p.ws + WS_LIST);
    const int tid = threadIdx.x, half = tid >> 8, c = tid & 255;
    int tok[10]; bool val[10];
#pragma unroll
    for (int j = 0; j < 10; ++j) { Unit u; val[j] = S.next(2 * j + half, u); tok[j] = 0;
        if (val[j]) { const int cnt = cn[u.z]; int pos = u.pm * 256 + c; pos = pos < cnt ? pos : cnt - 1; tok[j] = list[(size_t)u.z * T_ + pos]; } }
#pragma unroll
    for (int j = 0; j < 10; ++j) if (val[j]) tokl[(2 * j + half) * 256 + c] = (unsigned short)tok[j];
    __syncthreads();
}
template <class Sched, bool WTAB> __device__ __forceinline__ void moe_fill_tabs(const Params& p, LAS unsigned char* lds, const Sched& S, const LAS int* cn, const float* bias, int ncol) {
    LAS float* btab = (LAS float*)(lds + LDS_BTAB); LAS float* wtab = (LAS float*)(lds + LDS_TOKL);
    const float* wl = (const float*)(p.ws + WS_WLIST);
    const int tid = threadIdx.x, half = tid >> 8, c = tid & 255;
    constexpr int NP = WTAB ? 5 : 10;
    float bv[NP], wv[NP]; bool val[NP];
#pragma unroll
    for (int j = 0; j < NP; ++j) { Unit u; val[j] = S.next(2 * j + half, u); bv[j] = 0.f; wv[j] = 0.f;
        if (val[j]) { bv[j] = bias[(size_t)u.z * ncol + u.pn * 256 + c];
            if constexpr (WTAB) { const int pos = u.pm * 256 + c; if (pos < cn[u.z]) wv[j] = wl[(size_t)u.z * T_ + pos] * YS_SCALE; } } }
#pragma unroll
    for (int j = 0; j < NP; ++j) if (val[j]) { btab[(2 * j + half) * 256 + c] = bv[j]; if constexpr (WTAB) wtab[(2 * j + half) * 256 + c] = wv[j]; }
    __syncthreads();
}
__device__ __forceinline__ void phase_gateup(const Params& p, LAS unsigned char* lds) {
    LAS int* pt = (LAS int*)(lds + LDS_MISC); LAS int* cn = pt + 64;
    moe_tables(p, pt, cn);
    if constexpr (MOE_F8) { SchedMoe<true, 16, true> S{p.ws, pt, cn}; EpiSwiglu8 E{p.ws, p.in[15], pt}; moe_fill_tokl(p, lds, S, cn); moe_fill_tabs<SchedMoe<true, 16, true>, false>(p, lds, S, cn, p.in[15], 4096);
        unsigned long long* prof = PROFSEL == 7 ? (unsigned long long*)(p.ws + WS_CTL + 32768) : nullptr;
        const bool stag = MOE_SLOT && (gridDim.x == 256);
        if (stag) {
            const int g = (int)blockIdx.x >> 6, a = MOE_SLOT_STEP * g;
            if (a > 0) { SchedMoe<true, 16, true> Sa{p.ws, pt, cn, 0, 0, a}; gemm_phase<EpiSwiglu8, SchedMoe<true, 16, true>, MOE_ALIGN, 1>(lds, 2048, 2048, 2048, Sa, E, nullptr); }
            if constexpr (MOE_SLOT_BAL) {
                const int U = S.ptu(NE) * 16, rmax = (U + 255) >> 8, me = (int)blockIdx.x & 63;
                int totd = 0, dme = 0, dbefore = 0;
#pragma unroll 1
                for (int i = 0; i < 64; ++i) { const int c = 64 * g + i, v = (c & 7) * 32 + (c >> 3); const int r = (v < U) ? ((U - v + 255) >> 8) : 0; int d = rmax - r;
#ifdef MOE_BAL_TEST
                    d = (i * 7 + g) % 3 == 0 ? 1 : 0;
#endif
                    totd += d; if (i < me) dbefore += d; if (i == me) dme = d; }
                constexpr int GT = 1024 - 64 * POOL7;
                const int n0 = (GT - MOE_SLOT_BAL * totd) / 64, rem = GT - 64 * n0 - MOE_SLOT_BAL * totd;
                const long base = CV_NONEXP + 8192 + (long)GT * g;
                const int xs = 64 * n0 + MOE_SLOT_BAL * dbefore + (me < rem ? me : rem), xn = MOE_SLOT_BAL * dme + (me < rem ? 1 : 0);
                __syncthreads();
                convert_items(p, lds, base, base + 64 * n0, me, 64);
                if (xn > 0) convert_items(p, lds, base + xs, base + xs + xn, 0, 1);
                asm volatile("s_waitcnt vmcnt(0) lgkmcnt(0)" ::: "memory");
                __syncthreads();
            } else proj_convert_slot(p, lds, g, 2);
            moe_fill_tokl(p, lds, S, cn);
            SchedMoe<true, 16, true> Sb{p.ws, pt, cn, 0, a, 1 << 20}; gemm_phase<EpiSwiglu8, SchedMoe<true, 16, true>, MOE_ALIGN, 1>(lds, 2048, 2048, 2048, Sb, E, prof);
            if (POOL7 > 0) pool_drain(p, lds, 1, CV_NONEXP + 12288 - 256 * POOL7, 256 * POOL7);
        } else gemm_phase<EpiSwiglu8, SchedMoe<true, 16, true>, MOE_ALIGN, 1>(lds, 2048, 2048, 2048, S, E, prof); }
    else { SchedMoe<true, 16, false> S{p.ws, pt, cn}; EpiSwiglu E{p.ws, p.in[15], pt}; moe_fill_tokl(p, lds, S, cn);
        gemm_phase<EpiSwiglu, SchedMoe<true, 16, false>, true>(lds, 2048, 2048, 2048, S, E); }
}
__device__ __forceinline__ void phase_down(const Params& p, LAS unsigned char* lds) {
    LAS int* pt = (LAS int*)(lds + LDS_MISC); LAS int* cn = pt + 64;
    moe_tables(p, pt, cn);
    if constexpr (MOE_F8) { SchedMoe<false, 8, true> S{p.ws, pt, cn}; EpiDown8 E{p.ws, p.in[17], pt, cn}; moe_fill_tabs<SchedMoe<false, 8, true>, true>(p, lds, S, cn, p.in[17], 2048); gemm_phase<EpiDown8, SchedMoe<false, 8, true>, MOE_ALIGN, 1>(lds, 2048, 2048, 2048, S, E, PROFSEL == 8 ? (unsigned long long*)(p.ws + WS_CTL + 32768) : nullptr); }
    else { SchedMoe<false, 8, false> S{p.ws, pt, cn}; EpiDown E{p.ws, p.in[17], pt, cn}; gemm_phase<EpiDown, SchedMoe<false, 8, false>, true>(lds, 2048, 2048, 2048, S, E); }
#ifdef SHADOW
    if constexpr (MOE_F8) { __syncthreads(); SchedMoe<false, 8, true> S{p.ws, pt, cn, SHADOW - 1}; EpiDown8 E{p.ws, p.in[17], pt, cn, (WS_FAST_END + 4095) & ~(size_t)4095};
        gemm_phase<EpiDown8, SchedMoe<false, 8, true>, MOE_ALIGN, 1>(lds, 2048, 2048, 2048, S, E, nullptr); }
#endif
}
__device__ __forceinline__ void phase_out(const Params& p, LAS unsigned char* lds) {
    LAS int* pt = (LAS int*)(lds + LDS_MISC); LAS int* cn = pt + 64;
    moe_tables(p, pt, cn);
    phase_final(p, pt);
}

template <int PH> __global__ void __launch_bounds__(NTHR, 2) k_phase(Params p) {
    extern __shared__ __attribute__((aligned(16))) unsigned char lds_raw[];
    LAS unsigned char* lds = (LAS unsigned char*)lds_raw;
    if constexpr (PH == 0) phase_prologue(p, lds);
    if constexpr (PH == 1) phase_proj(p, lds);
    if constexpr (PH == 2) phase_mixers(p, lds);
    if constexpr (PH == 3) phase_seqdft(p, lds);
    if constexpr (PH == 4) phase_mix(p, lds);
    if constexpr (PH == 5) phase_x2(p, lds);
    if constexpr (PH == 6) phase_rows(p, lds);
    if constexpr (PH == 7) phase_gateup(p, lds);
    if constexpr (PH == 8) phase_down(p, lds);
    if constexpr (PH == 9) phase_out(p, lds);
}
template <int PH> static void launch_phase(const Params& p, hipStream_t st) {
    static bool attr_done = false;
    if (!attr_done) { (void)hipFuncSetAttribute((const void*)k_phase<PH>, hipFuncAttributeMaxDynamicSharedMemorySize, LDS_BYTES); attr_done = true; }
    hipLaunchKernelGGL(k_phase<PH>, dim3(256), dim3(NTHR), LDS_BYTES, st, p);
}
static void run_fast_multi(const Params& p, hipStream_t st, int lo, int hi) {
    if (lo <= 0 && 0 < hi) launch_phase<0>(p, st);
    if (lo <= 1 && 1 < hi) launch_phase<1>(p, st);
    if (lo <= 2 && 2 < hi) launch_phase<2>(p, st);
    if (lo <= 3 && 3 < hi) launch_phase<3>(p, st);
    if (lo <= 4 && 4 < hi) launch_phase<4>(p, st);
    if (lo <= 5 && 5 < hi) launch_phase<5>(p, st);
    if (lo <= 6 && 6 < hi) launch_phase<6>(p, st);
    if (lo <= 7 && 7 < hi) launch_phase<7>(p, st);
    if (lo <= 8 && 8 < hi) launch_phase<8>(p, st);
    if (lo <= 9 && 9 < hi) launch_phase<9>(p, st);
}
#define XB_TMO      128
#define XB_XCNT(j)  (256  + 64 * (j))
#define XB_XSUB(j)  (1280 + 64 * (j))
#define XB_XGEN(j)  (2304 + 64 * (j))
#define XB_TOP      3328
#define XB_TOPGEN   3392
#define XCD_BAR_WORDS 3456
#define XB_SPIN_CAP (1u << 18)

__device__ __forceinline__ unsigned xb_ld(unsigned* p)              { return __hip_atomic_load(p, __ATOMIC_RELAXED, __HIP_MEMORY_SCOPE_AGENT); }
__device__ __forceinline__ unsigned xb_add(unsigned* p, unsigned v) { return __hip_atomic_fetch_add(p, v, __ATOMIC_RELAXED, __HIP_MEMORY_SCOPE_AGENT); }
__device__ __forceinline__ unsigned xb_xcc_id() { return (unsigned)__builtin_amdgcn_s_getreg((3 << 11) | 20) & 0xFu; }
#define XB_SPIN(cond, bar) do { unsigned _sp = 0; while (cond) { __builtin_amdgcn_s_sleep(1); \
    if ((++_sp & 255u) == 0u) { if (xb_ld(&(bar)[XB_TMO])) break; if (_sp > XB_SPIN_CAP) { atomicAdd(&(bar)[XB_TMO], 1u); break; } } } } while (0)

struct XcdBarrier {
    unsigned* bar; unsigned x;
    volatile LAS unsigned* st;
};

__device__ __forceinline__ XcdBarrier xcd_barrier_post(unsigned* bar, volatile LAS unsigned* st) {
    XcdBarrier b; b.bar = bar; b.x = xb_xcc_id(); b.st = st;
    if (threadIdx.x == 0) (void)xb_add(&bar[XB_XCNT(b.x)], 1u);
    return b;
}
__device__ __forceinline__ void xcd_barrier_complete(unsigned* bar, unsigned x, unsigned& nloc, unsigned& nx) {
    const unsigned G = gridDim.x * gridDim.y * gridDim.z;
    unsigned sum, cnt, mine, sp = 0u;
    for (;;) {
        sum = 0u; cnt = 0u; mine = 0u;
#pragma unroll
        for (unsigned j = 0; j < 16; ++j) { const unsigned c = xb_ld(&bar[XB_XCNT(j)]); sum += c; cnt += (c > 0u) ? 1u : 0u; mine = (j == x) ? c : mine; }
        if (sum == G) break;
        __builtin_amdgcn_s_sleep(1);
        if ((++sp & 255u) == 0u) { if (xb_ld(&bar[XB_TMO])) break; if (sp > XB_SPIN_CAP) { atomicAdd(&bar[XB_TMO], 1u); break; } }
    }
    nloc = mine > 0u ? mine : 1u; nx = cnt > 0u ? cnt : 1u;
}

__device__ __forceinline__ void xcd_barrier(const XcdBarrier& b) {
    asm volatile("s_waitcnt vmcnt(0)" ::: "memory");
    __syncthreads();
    if (threadIdx.x == 0) {
        unsigned* bar = b.bar;
        __builtin_amdgcn_s_waitcnt(0);
        unsigned nloc = b.st[0], nx = b.st[1];
        if (nloc == 0u) { xcd_barrier_complete(bar, b.x, nloc, nx); b.st[0] = nloc; b.st[1] = nx; }
        const unsigned old = xb_add(&bar[XB_XSUB(b.x)], 1u);
        const unsigned gen = old / nloc;
        if (old + 1u == (gen + 1u) * nloc) {
            __builtin_amdgcn_fence(__ATOMIC_RELEASE, "agent");
            asm volatile("s_waitcnt vmcnt(0)" ::: "memory");
            const unsigned og = xb_add(&bar[XB_TOP], 1u);
            const unsigned tg = og / nx;
            if (og + 1u == (tg + 1u) * nx) xb_add(&bar[XB_TOPGEN], 1u);
            else XB_SPIN(xb_ld(&bar[XB_TOPGEN]) == tg, bar);
            __builtin_amdgcn_fence(__ATOMIC_ACQUIRE, "agent");
            xb_add(&bar[XB_XGEN(b.x)], 1u);
            asm volatile("s_waitcnt vmcnt(0)" ::: "memory");
        } else {
            XB_SPIN(xb_ld(&bar[XB_XGEN(b.x)]) == gen, bar);
            __builtin_amdgcn_fence(__ATOMIC_ACQUIRE, "agent");
            asm volatile("s_waitcnt vmcnt(0)" ::: "memory");
        }
    }
    __syncthreads();
}

__global__ void __launch_bounds__(NTHR, 2) mega_fwd(Params p) {
    extern __shared__ __attribute__((aligned(16))) unsigned char lds_raw[];
    LAS unsigned char* lds = (LAS unsigned char*)lds_raw;
    volatile LAS unsigned* xbw = (volatile LAS unsigned*)(lds + LDS_XBW);
    if (threadIdx.x < 4) xbw[threadIdx.x] = 0u;
    __syncthreads();
    XcdBarrier bar = xcd_barrier_post((unsigned*)(p.ws + WS_CTL) + CW_BAR, xbw);
#ifndef DBL
#define DBL 0
#endif
#ifndef SKEWPH
#define SKEWPH -1
#endif
#define RUNPH(i, call) do { call; if constexpr ((DBL >> (i)) & 1) { xcd_barrier(bar); call; } \
    if constexpr (SKEWPH == (i)) { if (threadIdx.x == 0) ((unsigned long long*)(p.ws + WS_CTL + 40960))[blockIdx.x] = wall_clock64(); } } while (0)
    RUNPH(0, phase_prologue(p, lds));  xcd_barrier(bar);
    RUNPH(1, phase_proj(p, lds));      xcd_barrier(bar);
    RUNPH(2, phase_mixers(p, lds));    xcd_barrier(bar);
    RUNPH(3, phase_seqdft(p, lds));    xcd_barrier(bar);
    RUNPH(4, phase_mix(p, lds));       xcd_barrier(bar);
    RUNPH(5, phase_x2(p, lds));        xcd_barrier(bar);
    phase_rows(p, lds);                xcd_barrier(bar);
    RUNPH(7, phase_gateup(p, lds));    xcd_barrier(bar);
    RUNPH(8, phase_down(p, lds));      xcd_barrier(bar);
    phase_out(p, lds);
}
static void run_fast_one(const Params& p, hipStream_t st) {
    static int grid = 0;
    if (!grid) {
        int dev = 0, cus = 0, per_cu = 0;
        (void)hipGetDevice(&dev); (void)hipDeviceGetAttribute(&cus, hipDeviceAttributeMultiprocessorCount, dev);
        (void)hipFuncSetAttribute((const void*)mega_fwd, hipFuncAttributeMaxDynamicSharedMemorySize, LDS_BYTES);
        (void)hipOccupancyMaxActiveBlocksPerMultiprocessor(&per_cu, (const void*)mega_fwd, NTHR, LDS_BYTES);
        if (per_cu < 1) per_cu = 1;
        grid = cus > 256 ? 256 : cus;
        grid &= ~7; if (grid < 8) grid = 8;
    }
    hipLaunchKernelGGL(mega_fwd, dim3(grid), dim3(NTHR), LDS_BYTES, st, p);
}
}
#ifndef REPORT
#define REPORT 0
#endif
extern "C" void kernel_launch(void* const* d_in, const int* in_sizes, int n_in, void* d_out, int out_size, void* d_ws, size_t ws_size, hipStream_t stream) {
    (void)in_sizes; (void)n_in; (void)out_size; (void)ws_size;
    unsigned char* ws = (unsigned char*)d_ws;
#if MODE == 0
    nv::NBuf nb; nv::carve(nb, ws);
    nv::run_part1(d_in, nb, stream); nv::run_part2(d_in, nb, (float*)d_out, stream);
#elif MODE == 1
    constexpr size_t NAIVE_BASE = (fx::WS_FAST_END + 4095) & ~(size_t)4095;
    nv::NBuf nb; const size_t nbytes = nv::carve(nb, ws + NAIVE_BASE);
    float* fout = (float*)(ws + NAIVE_BASE + ((nbytes + 4095) & ~(size_t)4095));
    double* acc = (double*)(fout + (size_t)16384 * 2048); float* scale = (float*)(acc + 64);
    fx::Params p; memset(&p, 0, sizeof(p));
    for (int i = 0; i < 19; ++i) p.in[i] = (const float*)d_in[i];
    p.out = fout; p.ws = ws;
    (void)hipMemsetAsync(ws + fx::WS_CTL, 0, fx::CTL_BYTES, stream);
    (void)hipMemsetAsync(acc, 0, 1024, stream);
    nv::run_part1(d_in, nb, stream);
    fx::run_fast_multi(p, stream, 0, 7);
    auto cmp = [&](int slot, int kind, const void* a, const float* ref, long long n, int w, int ldf, int ldr, int off, int sig) {
        ck::CP c; memset(&c, 0, sizeof(c)); c.a = a; c.ref = ref; c.n = n; c.kind = kind; c.w = w; c.ldf = ldf; c.ldr = ldr; c.off = off; c.sig = sig; c.slot = slot;
        hipLaunchKernelGGL(ck::k_cmp, dim3(2048), dim3(256), 0, stream, c, acc); };
    const long long T = 16384;
    cmp(0, 0, ws + fx::WS_FIN, nb.proj, T * 1024, 1024, 1024, 10752, 0, 0);
    cmp(1, 0, ws + fx::WS_Q, nb.proj, T * 2048, 2048, 2048, 10752, 1024, 0);
    cmp(2, 0, ws + fx::WS_K, nb.proj, T * 256, 256, 256, 10752, 3072, 0);
    cmp(3, 2, ws + fx::WS_VT, nb.proj, T * 256, 0, 0, 0, 0, 0);
    cmp(4, 0, ws + fx::WS_QM, nb.proj, T * 1024, 1024, 1024, 10752, 3584, 0);
    cmp(5, 0, ws + fx::WS_GATES, nb.proj, T * 6144, 6144, 6144, 10752, 4608, 1);
    cmp(6, 0, ws + fx::WS_KMK, nb.kvm, 2048LL * 1024, 1024, 1024, 2048, 0, 0);
    cmp(7, 3, ws + fx::WS_VMT, nb.kvm, 2048LL * 1024, 0, 0, 0, 0, 0);
    cmp(8, 0, ws + fx::WS_ATT, nb.att, T * 2048, 2048, 2048, 2048, 0, 0);
    cmp(9, 0, ws + fx::WS_XM, nb.xm, T * 1024, 1024, 1024, 1024, 0, 0);
    cmp(10, 0, ws + fx::WS_FM, nb.fm, T * 1024, 1024, 1024, 1024, 0, 0);
    cmp(11, 0, ws + fx::WS_MIXED, nb.mixed, T * 2048, 2048, 2048, 2048, 0, 0);
    cmp(12, 1, ws + fx::WS_X2, nb.x2, T * 2048, 2048, 2048, 2048, 0, 0);
    cmp(13, 0, ws + fx::WS_H2, nb.h2, T * 2048, 2048, 2048, 2048, 0, 0);
    hipLaunchKernelGGL(ck::k_cmp_route, dim3(64), dim3(256), 0, stream, (const int*)(ws + fx::WS_TOKE), (const int*)nb.tope, acc, 14);
    nv::run_part2(d_in, nb, nb.nout, stream);
    fx::run_fast_multi(p, stream, 7, 10);
    cmp(15, 1, fout, nb.nout, T * 2048, 2048, 2048, 2048, 0, 0);
    hipLaunchKernelGGL(ck::k_verdict, dim3(1), dim3(64), 0, stream, (const double*)acc, scale, 16, (int)REPORT);
    hipLaunchKernelGGL(ck::k_scale_out, dim3(2048), dim3(256), 0, stream, (const float*)nb.nout, (const float*)scale, (float*)d_out, T * 2048);
#elif MODE == 2
    fx::Params p; memset(&p, 0, sizeof(p));
    for (int i = 0; i < 19; ++i) p.in[i] = (const float*)d_in[i];
    p.out = (float*)d_out; p.ws = ws;
    (void)hipMemsetAsync(ws + fx::WS_CTL, 0, fx::CTL_BYTES, stream);
    fx::run_fast_multi(p, stream, 0, 10);
#elif MODE == 3
    fx::Params p; memset(&p, 0, sizeof(p));
    for (int i = 0; i < 19; ++i) p.in[i] = (const float*)d_in[i];
    p.out = (float*)d_out; p.ws = ws;
    (void)hipMemsetAsync(ws + fx::WS_CTL, 0, fx::CTL_BYTES, stream);
    fx::run_fast_one(p, stream);
#endif
}
```

```cpp
#include <hip/hip_runtime.h>
#include <stdint.h>
#include <string.h>
#ifndef MODE
#define MODE 3
#endif
namespace fx {
#define LAS __attribute__((address_space(3)))
typedef unsigned short bf16_t;
typedef short bf16x8 __attribute__((ext_vector_type(8)));
typedef short s16x4 __attribute__((ext_vector_type(4)));
typedef float f32x4 __attribute__((ext_vector_type(4)));
typedef float f32x16 __attribute__((ext_vector_type(16)));
typedef float f32x2 __attribute__((ext_vector_type(2)));
typedef __bf16 bf16x2_t __attribute__((ext_vector_type(2)));
typedef unsigned u32x4 __attribute__((ext_vector_type(4)));
typedef unsigned u32x2 __attribute__((ext_vector_type(2)));

constexpr int NTHR = 512, NWAVE = 8;
constexpr int B_ = 8, S_ = 2048, DM = 2048, T_ = B_ * S_;
constexpr int MEM = 256, FW = 1024, FG = 4, FGD = 256;
constexpr int NH = 32, NKV = 4, HD = 64, AW = 2048, KVW = 256, WIN = 128;
constexpr int MH = 4, MHD = 256, MW = 1024;
constexpr int NE = 32, TOPK = 4, DFF = 2048;
constexpr int INW = 10752;
#ifndef LDPAD
#define LDPAD 0
#endif
#ifndef ROUTER_ON_X2
#define ROUTER_ON_X2 1
#endif
#ifndef SQPAD
#define SQPAD 0
#endif
constexpr int LDP = 2048 + LDPAD;
constexpr int NSLOT = T_ * TOPK + NE * 256;
constexpr float LOG2E = 1.4426950408889634f;
#ifndef MOE_FP8
#define MOE_FP8 1
#endif
constexpr bool MOE_F8 = (MOE_FP8 != 0);
#ifndef GATES_FP8
#define GATES_FP8 1
#endif
constexpr bool GATES_F8 = (GATES_FP8 != 0);
#ifndef CONV_TILE32
#define CONV_TILE32 0
#endif
#ifndef MOE_ALIGN
#define MOE_ALIGN true
#endif
#ifndef PROFSEL
#define PROFSEL 0
#endif
#ifndef PROFMETRIC
#define PROFMETRIC 0
#endif
#ifndef PROFMUL
#define PROFMUL 1
#endif
#ifndef PROFBLK
#define PROFBLK 0
#endif

constexpr size_t al256(size_t x) { return (x + 255) & ~(size_t)255; }
constexpr size_t WS_CTL = 0, CTL_BYTES = 65536;
constexpr size_t WS_WINT = 1u << 20;
constexpr size_t WS_WMKVT = WS_WINT + (size_t)INW * LDP * 2;
constexpr size_t WS_WFOT = WS_WMKVT + (size_t)2048 * LDP * 2;
constexpr size_t WS_WAOT = WS_WFOT + (size_t)2048 * 1024 * 2;
constexpr size_t WS_WMOT = WS_WAOT + (size_t)2048 * 2048 * 2;
constexpr size_t WS_WOT = WS_WMOT + (size_t)2048 * 1024 * 2;
constexpr size_t WS_WRT = WS_WOT + (size_t)2048 * 2048 * 2;
constexpr size_t WS_TABT = WS_WRT + (size_t)NE * DM * 2;
constexpr size_t WS_DMAT = WS_TABT + (size_t)512 * 256 * 2;
constexpr int SQP = 4096 + SQPAD;
constexpr size_t WS_WGUT = WS_DMAT + (size_t)2048 * SQP * 2;
constexpr size_t WS_WDNT = WS_WGUT + (size_t)NE * 4096 * 2048 * 2;
constexpr size_t WS_H = WS_WDNT + (size_t)NE * 2048 * 2048 * 2;
constexpr size_t WS_MEMBF = WS_H + (size_t)T_ * LDP * 2;
constexpr size_t WS_FIN = WS_MEMBF + (size_t)2048 * LDP * 2;
constexpr size_t WS_Q = WS_FIN + (size_t)T_ * FW * 2;
constexpr size_t WS_K = WS_Q + (size_t)T_ * AW * 2;
constexpr size_t WS_VT = WS_K + (size_t)T_ * KVW * 2;
constexpr size_t WS_QM = WS_VT + (size_t)T_ * KVW * 2;
constexpr size_t WS_GATES = WS_QM + (size_t)T_ * MW * 2;
constexpr size_t WS_KMK = WS_GATES + (size_t)T_ * 3 * DM * 2;
constexpr size_t WS_VMT = WS_KMK + (size_t)2048 * 1024 * 2;
constexpr size_t WS_ZT = WS_VMT + (size_t)2048 * 1024 * 2;
constexpr size_t WS_FM = WS_ZT + (size_t)32 * 256 * SQP * 2;
constexpr size_t WS_ATT = WS_FM + (size_t)T_ * FW * 2;
constexpr size_t WS_PM = WS_ATT + (size_t)T_ * AW * 2;
constexpr size_t WS_XM = WS_PM + (size_t)T_ * MH * 256 * 2;
constexpr size_t WS_MIXACC = WS_XM + (size_t)T_ * MW * 2;
constexpr size_t WS_MIXED = WS_MIXACC + (size_t)T_ * DM * 4;
constexpr size_t WS_FX = WS_MIXACC;
constexpr size_t WS_WFM = WS_MIXACC + (size_t)T_ * 2048 * 2;
constexpr size_t WS_IRSTD = WS_WFM + (size_t)2048 * 2048 * 2;
static_assert(WS_IRSTD + (size_t)T_ * 4 <= WS_MIXED, "fused-mix operands fit the old mixacc region");
constexpr size_t WS_X2 = WS_MIXED + (size_t)T_ * DM * 2;
constexpr size_t WS_H2 = WS_X2 + (size_t)T_ * DM * 4;
constexpr size_t WS_TOKE = WS_H2 + (size_t)T_ * DM * 2;
constexpr size_t WS_TOKPOS = WS_TOKE + (size_t)T_ * 4 * 4;
constexpr size_t WS_TOKW = WS_TOKPOS + (size_t)T_ * 4 * 4;
constexpr size_t WS_LIST = WS_TOKW + (size_t)T_ * 4 * 4;
constexpr size_t WS_WLIST = WS_LIST + (size_t)NE * T_ * 4;
constexpr size_t WS_WGUQ = WS_WLIST + (size_t)NE * T_ * 4;
constexpr size_t WS_WDNQ = WS_WGUQ + (size_t)NE * 4096 * 2048;
constexpr size_t WS_H2Q = WS_WDNQ + (size_t)NE * 2048 * 2048;
constexpr size_t WS_H8 = WS_H2Q + (size_t)T_ * DM;
constexpr size_t WS_WINQ = WS_H8 + (size_t)T_ * DM;
constexpr size_t WS_FAST_END = WS_WINQ + (size_t)6144 * DM;
constexpr size_t WS_ACTQ = WS_H;
constexpr float WQ_SCALE = 32.0f, WQ_INV = 1.0f / 32.0f;
constexpr float YS_SCALE = 16.0f, YS_INV = 1.0f / 16.0f;
constexpr size_t WS_ACT = WS_H;
constexpr size_t WS_YS = WS_ACT + (size_t)NSLOT * DFF * 2;
static_assert(WS_YS + (size_t)NSLOT * DM * 2 <= WS_MIXED, "overlay fits");
constexpr int CW_CNT = 0;
constexpr int CW_POOL = 64;
constexpr int CW_BAR = 4096;

constexpr int LDS_STAGE = 0, STAGE_BYTES = 131072;
constexpr int LDS_TOKL = 131072;
constexpr int LDS_MISC = 141312;
constexpr int LDS_BTAB = 142336;
constexpr int LDS_XBW = 163824;
constexpr int LDS_BYTES = 163840;

struct Params {
    const float* in[19]; float* out; unsigned char* ws;
};

__device__ __forceinline__ unsigned cvtpk(float lo, float hi) { f32x2 v = {lo, hi}; bf16x2_t b = __builtin_convertvector(v, bf16x2_t); return __builtin_bit_cast(unsigned, b); }
__device__ __forceinline__ float bf2f(unsigned short x) { return __uint_as_float(((unsigned)x) << 16); }
__device__ __forceinline__ float bflo(unsigned w) { return __uint_as_float(w << 16); }
__device__ __forceinline__ float bfhi(unsigned w) { return __uint_as_float(w & 0xffff0000u); }
__device__ __forceinline__ float wsum(float v) {
#pragma unroll
    for (int o = 1; o < 64; o <<= 1) v += __shfl_xor(v, o);
    return v;
}
__device__ __forceinline__ float sigmoid_sc(float x, float nsc) { return __builtin_amdgcn_rcpf(1.0f + __builtin_amdgcn_exp2f(x * nsc)); }
__device__ __forceinline__ float sigmoidf_(float x) { return __builtin_amdgcn_rcpf(1.0f + __builtin_amdgcn_exp2f(-x * LOG2E)); }
__device__ __forceinline__ int crow(int r, int h) { return (r & 3) + 8 * (r >> 2) + 4 * h; }
__device__ __forceinline__ int t5_bucket(int rel) {
    const int n = rel < 0 ? -rel : rel;
    int b;
    if (n < 8) b = n; else if (n < 12) b = 8; else if (n < 16) b = 9; else if (n < 23) b = 10; else if (n < 32) b = 11;
    else if (n < 46) b = 12; else if (n < 64) b = 13; else if (n < 91) b = 14; else b = 15;
    return (rel > 0 ? 16 : 0) + b;
}
__device__ __forceinline__ int vwg() { const int c = blockIdx.x, G = gridDim.x; return ((G & 7) == 0) ? (c & 7) * (G >> 3) + (c >> 3) : c; }

constexpr int BM = 256, BK = 64, HALF = 128, HTB = HALF * BK * 2;
__host__ __device__ __forceinline__ int lds_byte(int r, int c) { const int st = (r >> 4) * 2 + (c >> 5), rr = r & 15, cc = c & 31, ob = rr * 64 + cc * 2; return st * 1024 + (ob ^ (((ob >> 9) & 1) << 5)); }
__host__ __device__ __forceinline__ void stage_rc(int b, int& R, int& C) { const int st = b / 1024, sb = b % 1024, swz = sb ^ (((sb >> 9) & 1) << 5); R = (st >> 1) * 16 + swz / 64; C = (st & 1) * 32 + (swz % 64) / 2; }
__host__ __device__ __forceinline__ int perm32(int rho) { const int n = rho >> 4, i = rho & 15; return 8 * (i >> 2) + 4 * n + (i & 3); }

struct Unit { int pm, pn, z, idx; };
template <class S, class = void> struct SchedVarK { static constexpr bool v = false; };
template <class S> struct SchedVarK<S, decltype((void)S::VARK)> { static constexpr bool v = S::VARK; };
template <class E, class = void> struct EpiTouch { static constexpr bool v = false; };
template <class E> struct EpiTouch<E, decltype((void)E::TOUCH)> { static constexpr bool v = E::TOUCH; };
template <class E, class = void> struct EpiKeep { static constexpr bool v = false; };
template <class E> struct EpiKeep<E, decltype((void)E::KEEP)> { static constexpr bool v = E::KEEP; };
typedef int v4i_t __attribute__((ext_vector_type(4)));
typedef int v8i_t __attribute__((ext_vector_type(8)));
__device__ __forceinline__ void mfma_f8(f32x4& c, const v8i_t& a, const v8i_t& b) { asm volatile("v_mfma_f32_16x16x128_f8f6f4 %0, %1, %2, %0" : "+v"(c) : "v"(a), "v"(b)); }
template <int ESZ> struct FragT;
template <> struct FragT<2> { struct A4 { bf16x8 v[4][2]; }; struct B2 { bf16x8 v[2][2]; }; };
template <> struct FragT<1> { struct A4 { v8i_t v[4]; }; struct B2 { v8i_t v[2]; }; };
__device__ __forceinline__ v8i_t cat8(bf16x8 a, bf16x8 b) { return __builtin_shufflevector(__builtin_bit_cast(v4i_t, a), __builtin_bit_cast(v4i_t, b), 0, 1, 2, 3, 4, 5, 6, 7); }

template <class Epi, class Sched, bool ALIGN_EPI, int ESZ = 2  >
__device__ __forceinline__ void gemm_phase(LAS unsigned char* lds, const int K, const int lda, const int ldb, const Sched& S, const Epi& E, unsigned long long* prof = nullptr) {
    unsigned long long pf_kl = 0, pf_ep = 0, pf_t0 = 0, pf_t1 = 0, pf_n = 0; const unsigned long long pf_w0 = prof ? wall_clock64() : 0ull, pf_c0 = prof ? clock64() : 0ull;
    int tid_ = threadIdx.x; asm volatile("" : "+v"(tid_));
    const int tid = tid_, wid = __builtin_amdgcn_readfirstlane(tid >> 6), lane = tid & 63, wr = wid >> 2, wc = wid & 3, fr = lane & 15, fq = lane >> 4;
    const int nt = (K * ESZ) / (BK * 2);
    constexpr bool GATHER = Sched::GATHER;
    unsigned voffA[2], voffB[2]; int Rr[2], Cb[2];
#pragma unroll
    for (int i = 0; i < 2; ++i) { int R, C; stage_rc(tid * 16 + i * 8192, R, C);
        int Rb = R;
        if constexpr ((int)Epi::PERM == 1) Rb = (R & ~31) + perm32(R & 31);
        if constexpr ((int)Epi::PERM == 2) Rb = 64 * (R >> 5) + 16 * ((R >> 2) & 3) + 4 * ((R >> 4) & 1) + (R & 3);
        voffA[i] = (unsigned)(R * lda * ESZ + C * 2); voffB[i] = (unsigned)(Rb * ldb * ESZ + C * 2); Rr[i] = R; Cb[i] = C * 2; }
    const size_t kstep = (size_t)(BK * 2);
    const size_t hstepA = (size_t)HALF * lda * ESZ, hstepB = (size_t)(((int)Epi::PERM == 2) ? 8 : HALF) * ldb * ESZ;
    const unsigned ldsw = (unsigned)wid * 1024u;
    const int aoff = lds_byte(wr * 64 + fr, fq * 8), boff = lds_byte(wc * 32 + fr, fq * 8);
#define PG8_SA(b, h) (((b) * 2 + (h)) * HTB)
#define PG8_SB(b, h) ((4 + (b) * 2 + (h)) * HTB)
#define PG8_STAGE(bufoff, gbase, voff) do { _Pragma("unroll") for (int _i = 0; _i < 2; ++_i) \
        __builtin_amdgcn_global_load_lds((const unsigned*)((const char*)(gbase) + (voff)[_i]), (LAS unsigned*)(lds + (bufoff) + ldsw + _i * 8192), 16, 0, 0); } while (0)
#define PG8_STAGE_A(bufoff, gbase, h, NX) do { if constexpr (GATHER) { _Pragma("unroll") for (int _i = 0; _i < 2; ++_i) { const unsigned _o = (NX) ? naoff[h][_i] : caoff[h][_i]; \
        __builtin_amdgcn_global_load_lds((const unsigned*)((const char*)(gbase) + _o), (LAS unsigned*)(lds + (bufoff) + ldsw + _i * 8192), 16, 0, 0); } } \
        else { PG8_STAGE(bufoff, (const char*)(gbase) + (h) * hstepA, voffA); } } while (0)
#define PG8_LDA(dst, b, h) do { _Pragma("unroll") for (int m = 0; m < 4; ++m) { if constexpr (ESZ == 2) { _Pragma("unroll") for (int k = 0; k < 2; ++k) dst.v[m][k] = *(const LAS bf16x8*)(lds + PG8_SA(b, h) + aoff + m * 2048 + k * 1024); } \
        else { const v4i_t _lo = *(const LAS v4i_t*)(lds + PG8_SA(b, h) + aoff + m * 2048), _hi = *(const LAS v4i_t*)(lds + PG8_SA(b, h) + aoff + m * 2048 + 1024); dst.v[m] = __builtin_shufflevector(_lo, _hi, 0, 1, 2, 3, 4, 5, 6, 7); } } } while (0)
#define PG8_LDB(dst, b, h) do { _Pragma("unroll") for (int n = 0; n < 2; ++n) { if constexpr (ESZ == 2) { _Pragma("unroll") for (int k = 0; k < 2; ++k) dst.v[n][k] = *(const LAS bf16x8*)(lds + PG8_SB(b, h) + boff + n * 2048 + k * 1024); } \
        else { const v4i_t _lo = *(const LAS v4i_t*)(lds + PG8_SB(b, h) + boff + n * 2048), _hi = *(const LAS v4i_t*)(lds + PG8_SB(b, h) + boff + n * 2048 + 1024); dst.v[n] = __builtin_shufflevector(_lo, _hi, 0, 1, 2, 3, 4, 5, 6, 7); } } } while (0)
#define PG8_MMA(ai, bj, At, Bt) do { __builtin_amdgcn_s_setprio(1); _Pragma("unroll") for (int m = 0; m < 4; ++m) _Pragma("unroll") for (int n = 0; n < 2; ++n) { \
        if constexpr (ESZ == 2) { _Pragma("unroll") for (int k = 0; k < 2; ++k) acc[ai][bj][m][n] = __builtin_amdgcn_mfma_f32_16x16x32_bf16(Bt.v[n][k], At.v[m][k], acc[ai][bj][m][n], 0, 0, 0); } \
        else { mfma_f8(acc[ai][bj][m][n], Bt.v[n], At.v[m]); } } \
        __builtin_amdgcn_s_setprio(0); } while (0)
#define PG8_WAIT_V(n) asm volatile("s_waitcnt vmcnt(" #n ")" ::: "memory")
#define PG8_WAIT_V8R do { if (relax) asm volatile("s_waitcnt vmcnt(%0)" :: "n"(8 + Epi::NSTORE) : "memory"); else PG8_WAIT_V(8); } while (0)
#define PG8_WAIT_L(n) asm volatile("s_waitcnt lgkmcnt(" #n ")" ::: "memory")
#define PG8_BAR __builtin_amdgcn_s_barrier()
#define PG8_SCHED __builtin_amdgcn_sched_barrier(0)
    Unit cur, nxt; int ui = 0;
    if (!S.next(0, cur)) return;
    f32x4 acc[2][2][4][2];
#pragma unroll
    for (int a = 0; a < 2; ++a)
#pragma unroll
        for (int b = 0; b < 2; ++b)
#pragma unroll
            for (int m = 0; m < 4; ++m)
#pragma unroll
                for (int n = 0; n < 2; ++n) acc[a][b][m][n] = (f32x4){0.f, 0.f, 0.f, 0.f};
    typedef typename FragT<ESZ>::A4 FragA; typedef typename FragT<ESZ>::B2 FragB;
    FragA At; FragB B0, B1;
    unsigned caoff[2][2] = {{0u, 0u}, {0u, 0u}}, naoff[2][2] = {{0u, 0u}, {0u, 0u}};
    if constexpr (GATHER) {
#pragma unroll
        for (int h = 0; h < 2; ++h)
#pragma unroll
            for (int i = 0; i < 2; ++i) { caoff[h][i] = S.arow(cur, h * HALF + Rr[i]) + (unsigned)Cb[i]; naoff[h][i] = caoff[h][i]; }
    }
    const char* cA = S.baseA(cur); const char* cB = S.baseB(cur);
    PG8_STAGE(PG8_SB(0, 0), cB, voffB); PG8_STAGE(PG8_SB(0, 1), cB + hstepB, voffB); PG8_STAGE_A(PG8_SA(0, 0), cA, 0, false); PG8_STAGE_A(PG8_SA(0, 1), cA, 1, false);
    if (wr == 1) PG8_BAR;
    PG8_WAIT_V(2); PG8_BAR;
    PG8_STAGE(PG8_SB(1, 0), cB + kstep, voffB); PG8_STAGE_A(PG8_SA(1, 0), cA + kstep, 0, false); PG8_STAGE(PG8_SB(1, 1), cB + hstepB + kstep, voffB);
    PG8_WAIT_V(6); PG8_BAR;
    for (;;) {
        const bool has_next = S.next(ui + 1, nxt);
        const char* nA = has_next ? S.baseA(nxt) : cA; const char* nB = has_next ? S.baseB(nxt) : cB;
        if constexpr (GATHER) {
            if (has_next) {
#pragma unroll
                for (int h = 0; h < 2; ++h)
#pragma unroll
                    for (int i = 0; i < 2; ++i) naoff[h][i] = S.arow(nxt, h * HALF + Rr[i]) + (unsigned)Cb[i];
            } else {
#pragma unroll
                for (int h = 0; h < 2; ++h)
#pragma unroll
                    for (int i = 0; i < 2; ++i) naoff[h][i] = caoff[h][i];
            }
        }
        if (prof) pf_t0 = clock64();
        if constexpr (EpiTouch<Epi>::v) E.touch(cur, lds, tid, wid);
        int ntu = nt; if constexpr (SchedVarK<Sched>::v) ntu = S.ktiles(cur);
#pragma unroll 1
        for (int t = 0; t < ntu; t += 2) {
            const bool last = (t == ntu - 2);
            const bool relax = (Epi::NSTORE > 0) && (t == 0) && (ui > 0);
            const char* a1 = cA + (size_t)(t + 1) * kstep;
            const char* a2 = last ? nA : cA + (size_t)(t + 2) * kstep; const char* b2 = last ? nB : cB + (size_t)(t + 2) * kstep;
            const char* a3 = a2 + kstep; const char* b3 = b2 + kstep;
            PG8_LDB(B0, 0, 0); PG8_LDB(B1, 0, 1); PG8_SCHED; PG8_LDA(At, 0, 0); PG8_STAGE_A(PG8_SA(1, 1), a1, 1, false);
            PG8_WAIT_V(8); PG8_WAIT_L(0); PG8_BAR; PG8_MMA(0, 0, At, B0); PG8_MMA(0, 1, At, B1); PG8_BAR; PG8_SCHED;
            PG8_LDA(At, 0, 1); PG8_STAGE(PG8_SB(0, 0), b2, voffB); PG8_STAGE(PG8_SB(0, 1), b2 + hstepB, voffB); PG8_STAGE_A(PG8_SA(0, 0), a2, 0, last);
            PG8_WAIT_V(8); PG8_WAIT_L(0); PG8_BAR; PG8_MMA(1, 0, At, B0); PG8_MMA(1, 1, At, B1); PG8_BAR; PG8_SCHED;
            PG8_LDB(B0, 1, 0); PG8_LDB(B1, 1, 1); PG8_SCHED; PG8_LDA(At, 1, 0); PG8_STAGE_A(PG8_SA(0, 1), a2, 1, last);
            PG8_WAIT_V(8); PG8_WAIT_L(0); PG8_BAR; PG8_MMA(0, 0, At, B0); PG8_MMA(0, 1, At, B1); PG8_BAR; PG8_SCHED;
            PG8_LDA(At, 1, 1); PG8_STAGE(PG8_SB(1, 0), b3, voffB); PG8_STAGE(PG8_SB(1, 1), b3 + hstepB, voffB); PG8_STAGE_A(PG8_SA(1, 0), a3, 0, last);
            PG8_WAIT_V(8); PG8_WAIT_L(0); PG8_BAR; PG8_MMA(1, 0, At, B0); PG8_MMA(1, 1, At, B1); PG8_BAR; PG8_SCHED;
        }
        if (prof) { pf_t1 = clock64(); pf_kl += pf_t1 - pf_t0; }
        if constexpr (ESZ == 1) asm volatile("s_nop 15\n\ts_nop 15" ::: "memory");
        if constexpr (ALIGN_EPI) { if (wr == 0) PG8_BAR; }
        if constexpr (!Epi::AFTER_DRAIN) { int fr_e = fr, fq_e = fq; asm volatile("" : "+v"(fr_e), "+v"(fq_e));
            E(acc, cur, wr, wc, fr_e, fq_e); }
        if (prof) { pf_ep += clock64() - pf_t1; ++pf_n; }
        if (!has_next) break;
        bool zero = true; if constexpr (EpiKeep<Epi>::v) zero = !E.keep(cur);
        if (zero) {
#pragma unroll
        for (int a = 0; a < 2; ++a)
#pragma unroll
            for (int b = 0; b < 2; ++b)
#pragma unroll
                for (int m = 0; m < 4; ++m)
#pragma unroll
                    for (int n = 0; n < 2; ++n) acc[a][b][m][n] = (f32x4){0.f, 0.f, 0.f, 0.f};
        }
        cur = nxt; cA = nA; cB = nB; ++ui;
        if constexpr (GATHER) {
#pragma unroll
            for (int h = 0; h < 2; ++h)
#pragma unroll
                for (int i = 0; i < 2; ++i) caoff[h][i] = naoff[h][i];
        }
        if constexpr (ALIGN_EPI) { if (wr == 1) PG8_BAR; }
    }
    PG8_WAIT_V(0);
    if constexpr (!ALIGN_EPI) { if (wr == 0) PG8_BAR; }
    PG8_BAR;
    if (prof && blockIdx.x == PROFBLK && tid == 0) { prof[0] = pf_kl; prof[1] = pf_ep; prof[2] = pf_n; prof[3] = (unsigned long long)nt; prof[4] = clock64() - pf_c0; prof[5] = wall_clock64() - pf_w0; }
    if constexpr (Epi::AFTER_DRAIN) { int fr_e = fr, fq_e = fq; asm volatile("" : "+v"(fr_e), "+v"(fq_e)); E.fused(acc, cur, wr, wc, fr_e, fq_e, lds, wid, lane); }
#undef PG8_SA
#undef PG8_SB
#undef PG8_STAGE
#undef PG8_STAGE_A
#undef PG8_LDA
#undef PG8_LDB
#undef PG8_MMA
#undef PG8_WAIT_V
#undef PG8_WAIT_V8R
#undef PG8_WAIT_L
#undef PG8_BAR
#undef PG8_SCHED
}
constexpr int NXCD = 8;
#ifndef RES_FROM_H
#define RES_FROM_H 1
#endif
#ifndef EPI_TOUCH
#define EPI_TOUCH 0
#endif
#ifndef PROJ_WGM
#define PROJ_WGM 8
#endif
__device__ __forceinline__ void static_tile(int L, int nM, int nN, int& pm, int& pn, const int WGM = 8) {
    const int nwg = nM * nN; int wgid = L;
    { const int q = nwg / NXCD, r = nwg % NXCD, xcd = wgid % NXCD, off = wgid / NXCD; wgid = (xcd < r ? xcd * (q + 1) : r * (q + 1) + (xcd - r) * q) + off; }
    const int nig = WGM * nN, gid = wgid / nig, fm = gid * WGM, gsz = (nM - fm) < WGM ? (nM - fm) : WGM;
    pm = fm + ((wgid % nig) % gsz); pn = (wgid % nig) / gsz;
}
struct SchedPlain {
    static constexpr bool GATHER = false;
    const char* A; const char* Bt; size_t tstepA, tstepB; int nM, nN; int r0 = 0, r1 = 1 << 20;
    __device__ __forceinline__ bool next(int i, Unit& u) const { const int k = i + r0; if (k >= r1) return false;
        const int L = k * (int)gridDim.x + (int)blockIdx.x; if (L >= nM * nN) return false; static_tile(L, nM, nN, u.pm, u.pn); u.z = 0; return true; }
    __device__ __forceinline__ const char* baseA(const Unit& u) const { return A + (size_t)u.pm * tstepA; }
    __device__ __forceinline__ const char* baseB(const Unit& u) const { return Bt + (size_t)u.pn * tstepB; }
    __device__ __forceinline__ unsigned arow(const Unit&, int) const { return 0u; }
};
struct SchedProj {
    static constexpr bool GATHER = false;
    const unsigned char* ws; int r0, r1;
    __device__ __forceinline__ bool next(int i, Unit& u) const {
        if (i + r0 >= r1) return false;
        const int L = (i + r0) * (int)gridDim.x + (int)blockIdx.x;
        constexpr int NPB = GATES_F8 ? 18 : 42;
        if (L < 64 * NPB) { static_tile(L, 64, NPB, u.pm, u.pn, PROJ_WGM); u.z = (u.pn == 13) ? 2 : 0; return true; }
        const int L2 = L - 64 * NPB; if (L2 >= 64) return false;
        if (L2 < 32) { u.pm = L2 & 7; u.pn = L2 >> 3; u.z = 1; } else { u.pm = (L2 - 32) & 3; u.pn = (L2 - 32) >> 2; u.z = 3; }
        return true;
    }
    __device__ __forceinline__ const char* baseA(const Unit& u) const {
        const size_t ts = (size_t)256 * LDP * 2;
        if (u.z == 0) return (const char*)ws + WS_H + (size_t)u.pm * ts;
        if (u.z == 2) return (const char*)ws + WS_WINT + (size_t)13 * ts;
        if (u.z == 1) return (const char*)ws + WS_MEMBF + (size_t)u.pm * ts;
        return (const char*)ws + WS_WMKVT + (size_t)(4 + u.pm) * ts;
    }
    __device__ __forceinline__ const char* baseB(const Unit& u) const {
        const size_t ts = (size_t)256 * LDP * 2;
        if (u.z == 0) return (const char*)ws + WS_WINT + (size_t)u.pn * ts;
        if (u.z == 2) return (const char*)ws + WS_H + (size_t)u.pm * ts;
        if (u.z == 1) return (const char*)ws + WS_WMKVT + (size_t)u.pn * ts;
        return (const char*)ws + WS_MEMBF + (size_t)u.pn * ts;
    }
    __device__ __forceinline__ unsigned arow(const Unit&, int) const { return 0u; }
};
struct SchedGates8 {
    static constexpr bool GATHER = false;
    const unsigned char* ws; int r0, r1;
    __device__ __forceinline__ bool next(int i, Unit& u) const {
        if (i + r0 >= r1) return false;
        const int L = (i + r0) * (int)gridDim.x + (int)blockIdx.x; if (L >= 64 * 24) return false;
        static_tile(L, 64, 24, u.pm, u.pn, PROJ_WGM); u.z = 0; return true;
    }
    __device__ __forceinline__ const char* baseA(const Unit& u) const { return (const char*)ws + WS_H8 + (size_t)u.pm * (256 * 2048); }
    __device__ __forceinline__ const char* baseB(const Unit& u) const { return (const char*)ws + WS_WINQ + (size_t)u.pn * (256 * 2048); }
    __device__ __forceinline__ unsigned arow(const Unit&, int) const { return 0u; }
};
struct SchedChan {
    static constexpr bool GATHER = false;
    const unsigned char* ws; int u0, nu;
    __device__ __forceinline__ bool next(int i, Unit& u) const {
        const int L = i * (int)gridDim.x + vwg(); if (L >= 512) return false;
        u.z = L >> 4; u.pm = (L >> 3) & 1; u.pn = L & 7; return true;
    }
    __device__ __forceinline__ const char* baseA(const Unit& u) const { return (const char*)ws + WS_TABT + (size_t)u.pm * (256 * 256 * 2); }
    __device__ __forceinline__ const char* baseB(const Unit& u) const { const int b = u.z >> 2, g = u.z & 3; return (const char*)ws + WS_FIN + ((size_t)(b * 2048 + u.pn * 256) * 1024 + g * 256) * 2; }
    __device__ __forceinline__ unsigned arow(const Unit&, int) const { return 0u; }
};
struct SchedSeq {
    static constexpr bool GATHER = false;
    const unsigned char* ws;
    __device__ __forceinline__ bool next(int i, Unit& u) const {
        const int L = i * (int)gridDim.x + vwg(); if (L >= 256) return false;
        u.z = L >> 3; u.pm = L & 7; u.pn = 0; return true;
    }
    __device__ __forceinline__ const char* baseA(const Unit& u) const { return (const char*)ws + WS_DMAT + (size_t)u.pm * ((size_t)256 * SQP * 2); }
    __device__ __forceinline__ const char* baseB(const Unit& u) const { return (const char*)ws + WS_ZT + (size_t)u.z * ((size_t)256 * SQP * 2); }
    __device__ __forceinline__ unsigned arow(const Unit&, int) const { return 0u; }
};
struct SchedOne {
    static constexpr bool GATHER = false;
    const char* A; const char* Bt; int z; bool valid;
    __device__ __forceinline__ bool next(int i, Unit& u) const { if (i != 0 || !valid) return false; u.pm = 0; u.pn = 0; u.z = z; return true; }
    __device__ __forceinline__ const char* baseA(const Unit&) const { return A; }
    __device__ __forceinline__ const char* baseB(const Unit&) const { return Bt; }
    __device__ __forceinline__ unsigned arow(const Unit&, int) const { return 0u; }
};
template <bool GATH, int NT  , bool F8>
struct SchedMoe {
    static constexpr bool GATHER = GATH;
    static constexpr int ES = F8 ? 1 : 2;
    const unsigned char* ws; const LAS int* pt; const LAS int* cn; int same = 0;
    int r0 = 0, r1 = 1 << 20;
    __device__ __forceinline__ int ptu(int k) const { return __builtin_amdgcn_readfirstlane(pt[k]); }
    __device__ __forceinline__ bool next(int i, Unit& u) const {
        const int k = i + r0; if (k >= r1) return false;
        const int L = k * (int)gridDim.x + vwg(); const int total = ptu(NE) * NT; if (L >= total) return false;
        const int ln = (int)(threadIdx.x & 63);
        const unsigned long long bal = __ballot(ln < NE && L >= pt[ln & 31] * NT);
        const int e = __builtin_amdgcn_readfirstlane(__popcll(bal) - 1);
        const int t = L - ptu(e) * NT, mte = ptu(e + 1) - ptu(e);
        u.z = e; u.pm = t % mte; u.pn = t / mte; u.idx = k; return true;
    }
    __device__ __forceinline__ const char* baseA(const Unit& u) const {
        if constexpr (GATH) return (const char*)ws + (F8 ? WS_H2Q : WS_H2);
        else return (const char*)ws + (F8 ? WS_ACTQ : WS_ACT) + (same ? (size_t)0 : (size_t)(ptu(u.z) + u.pm) * (256 * 2048 * ES));
    }
    __device__ __forceinline__ const char* baseB(const Unit& u) const {
        if constexpr (GATH) return (const char*)ws + (F8 ? WS_WGUQ : WS_WGUT) + ((size_t)u.z * 4096 + (size_t)u.pn * 256) * (2048 * ES);
        else return (const char*)ws + (F8 ? WS_WDNQ : WS_WDNT) + (same ? (size_t)0 : ((size_t)u.z * 2048 + (size_t)u.pn * 256) * (2048 * ES));
    }
    __device__ __forceinline__ unsigned arow(const Unit& u, int r) const {
        const LAS unsigned short* tokl = (const LAS unsigned short*)((const LAS unsigned char*)pt - LDS_MISC + LDS_TOKL);
        return (unsigned)tokl[u.idx * 256 + r] * (unsigned)(2048 * ES);
    }
};

__device__ __forceinline__ void store_tile_bf16(const f32x4 (&acc)[2][2][4][2], bf16_t* dst  , size_t ldc, int wr, int wc, int fr, int fq) {
    const int row0 = wr * 64 + fr, col0 = wc * 32 + 8 * fq;
#pragma unroll
    for (int ai = 0; ai < 2; ++ai)
#pragma unroll
        for (int m = 0; m < 4; ++m) { bf16_t* rowp = dst + (size_t)(row0 + ai * HALF + m * 16) * ldc + col0;
#pragma unroll
            for (int bj = 0; bj < 2; ++bj) { const f32x4 v0 = acc[ai][bj][m][0], v1 = acc[ai][bj][m][1];
                u32x4 w; w.x = cvtpk(v0[0], v0[1]); w.y = cvtpk(v0[2], v0[3]); w.z = cvtpk(v1[0], v1[1]); w.w = cvtpk(v1[2], v1[3]);
                *(u32x4*)(rowp + bj * HALF) = w; } }
}
struct EpiProj {
    static constexpr bool PERM = true, AFTER_DRAIN = false; static constexpr int NSTORE = 16;
    unsigned char* ws;
    __device__ __forceinline__ void operator()(const f32x4 (&acc)[2][2][4][2], const Unit& u, int wr, int wc, int fr, int fq) const {
        const int pn = u.pn, pm = u.pm;
        bf16_t* dst; size_t ldc;
        if (u.z == 0) {
            if (pn >= 18) {
                dst = (bf16_t*)(ws + WS_GATES) + (size_t)pm * 256 * 6144 + (pn - 18) * 256;
                const int row0 = wr * 64 + fr, col0 = wc * 32 + 8 * fq;
#pragma unroll
                for (int ai = 0; ai < 2; ++ai)
#pragma unroll
                    for (int m = 0; m < 4; ++m) { bf16_t* rowp = dst + (size_t)(row0 + ai * HALF + m * 16) * 6144 + col0;
#pragma unroll
                        for (int bj = 0; bj < 2; ++bj) { const f32x4 v0 = acc[ai][bj][m][0], v1 = acc[ai][bj][m][1];
                            u32x4 w; w.x = cvtpk(sigmoidf_(v0[0]), sigmoidf_(v0[1])); w.y = cvtpk(sigmoidf_(v0[2]), sigmoidf_(v0[3]));
                            w.z = cvtpk(sigmoidf_(v1[0]), sigmoidf_(v1[1])); w.w = cvtpk(sigmoidf_(v1[2]), sigmoidf_(v1[3]));
                            *(u32x4*)(rowp + bj * HALF) = w; } }
                return;
            }
            if (pn < 4) { dst = (bf16_t*)(ws + WS_FIN) + pn * 256; ldc = 1024; }
            else if (pn < 12) { dst = (bf16_t*)(ws + WS_Q) + (pn - 4) * 256; ldc = 2048; }
            else if (pn == 12) { dst = (bf16_t*)(ws + WS_K); ldc = 256; }
            else { dst = (bf16_t*)(ws + WS_QM) + (pn - 14) * 256; ldc = 1024; }
            dst += (size_t)pm * 256 * ldc;
        } else if (u.z == 2) {
            dst = (bf16_t*)(ws + WS_VT) + (size_t)(pm >> 3) * 256 * 2048 + (size_t)(pm & 7) * 256; ldc = 2048;
        } else if (u.z == 1) {
            dst = (bf16_t*)(ws + WS_KMK) + (size_t)pm * 256 * 1024 + pn * 256; ldc = 1024;
        } else {
            dst = (bf16_t*)(ws + WS_VMT) + (size_t)(pn * 4 + pm) * 256 * 256; ldc = 256;
        }
        store_tile_bf16(acc, dst, ldc, wr, wc, fr, fq);
    }
};
__device__ __forceinline__ unsigned pk_u8x4(float a, float b, float c, float d) {
    const unsigned x = (unsigned)(a * 255.0f + 0.5f), y = (unsigned)(b * 255.0f + 0.5f), z = (unsigned)(c * 255.0f + 0.5f), w = (unsigned)(d * 255.0f + 0.5f);
    return x | (y << 8) | (z << 16) | (w << 24); }
struct EpiGates8 {
    static constexpr int PERM = 2; static constexpr bool AFTER_DRAIN = false; static constexpr int NSTORE = 8;
    unsigned char* ws;
    __device__ __forceinline__ void operator()(const f32x4 (&acc)[2][2][4][2], const Unit& u, int wr, int wc, int fr, int fq) const {
        unsigned char* dst = ws + WS_GATES + (size_t)u.pm * 256 * 6144 + u.pn * 256;
        const int row0 = wr * 64 + fr, col0 = wc * 64 + 16 * fq;
#pragma unroll
        for (int ai = 0; ai < 2; ++ai)
#pragma unroll
            for (int m = 0; m < 4; ++m) {
                u32x4 w;
                { const f32x4 a = acc[ai][0][m][0] * WQ_INV, c = acc[ai][0][m][1] * WQ_INV;
                  w.x = pk_u8x4(sigmoidf_(a[0]), sigmoidf_(a[1]), sigmoidf_(a[2]), sigmoidf_(a[3])); w.y = pk_u8x4(sigmoidf_(c[0]), sigmoidf_(c[1]), sigmoidf_(c[2]), sigmoidf_(c[3])); }
                { const f32x4 a = acc[ai][1][m][0] * WQ_INV, c = acc[ai][1][m][1] * WQ_INV;
                  w.z = pk_u8x4(sigmoidf_(a[0]), sigmoidf_(a[1]), sigmoidf_(a[2]), sigmoidf_(a[3])); w.w = pk_u8x4(sigmoidf_(c[0]), sigmoidf_(c[1]), sigmoidf_(c[2]), sigmoidf_(c[3])); }
                *(u32x4*)(dst + (size_t)(row0 + ai * HALF + m * 16) * 6144 + col0) = w; }
    }
};
struct EpiChan {
    static constexpr bool PERM = true, AFTER_DRAIN = false; static constexpr int NSTORE = 0;
    unsigned char* ws;
    __device__ __forceinline__ void operator()(const f32x4 (&acc)[2][2][4][2], const Unit& u, int wr, int wc, int fr, int fq) const {
        store_tile_bf16(acc, (bf16_t*)(ws + WS_ZT) + (size_t)u.z * 256 * SQP + (size_t)u.pm * 2048 + u.pn * 256, SQP, wr, wc, fr, fq);
    }
};
struct EpiSeq {
    static constexpr bool PERM = true, AFTER_DRAIN = false; static constexpr int NSTORE = 0;
    unsigned char* ws;
    __device__ __forceinline__ void operator()(const f32x4 (&acc)[2][2][4][2], const Unit& u, int wr, int wc, int fr, int fq) const {
        const int b = u.z >> 2, g = u.z & 3;
        store_tile_bf16(acc, (bf16_t*)(ws + WS_FX) + (size_t)(b * 2048 + u.pm * 256) * 2048 + g * 256, 2048, wr, wc, fr, fq);
    }
};
template <int STEP> struct EpiMix {
    static constexpr int PERM = 1; static constexpr bool AFTER_DRAIN = false; static constexpr int NSTORE = 16;
    unsigned char* ws;
    __device__ __forceinline__ void operator()(const f32x4 (&acc)[2][2][4][2], const Unit& u, int wr, int wc, int fr, int fq) const {
        const int row0 = u.pm * 256 + wr * 64 + fr, col0 = u.pn * 256 + wc * 32 + 8 * fq;
        const bf16_t* gates = (const bf16_t*)(ws + WS_GATES) + STEP * 2048; const unsigned char* gates8 = ws + WS_GATES + STEP * 2048;
        bf16_t* macc = (bf16_t*)(ws + WS_MIXACC); bf16_t* mixed = (bf16_t*)(ws + WS_MIXED);
#pragma unroll
        for (int ai = 0; ai < 2; ++ai) {
            u32x2 g8[4][2]; u32x4 gw[4][2]; u32x4 mw[4][2];
#pragma unroll
            for (int m = 0; m < 4; ++m) { const size_t row = (size_t)(row0 + ai * HALF + m * 16);
#pragma unroll
                for (int bj = 0; bj < 2; ++bj) { const int col = col0 + bj * HALF;
                    if constexpr (GATES_F8) g8[m][bj] = *(const u32x2*)(gates8 + row * 6144 + col); else gw[m][bj] = *(const u32x4*)(gates + row * 6144 + col);
                    if (STEP > 0) mw[m][bj] = *(const u32x4*)(macc + row * 2048 + col); } }
#pragma unroll
            for (int m = 0; m < 4; ++m) { const size_t row = (size_t)(row0 + ai * HALF + m * 16);
#pragma unroll
                for (int bj = 0; bj < 2; ++bj) { const int col = col0 + bj * HALF;
                    f32x4 v0 = acc[ai][bj][m][0], v1 = acc[ai][bj][m][1];
                    if constexpr (GATES_F8) { const u32x2 g = g8[m][bj]; const float k = 1.0f / 255.0f;
                        v0[0] *= (float)(g.x & 255u) * k; v0[1] *= (float)((g.x >> 8) & 255u) * k; v0[2] *= (float)((g.x >> 16) & 255u) * k; v0[3] *= (float)(g.x >> 24) * k;
                        v1[0] *= (float)(g.y & 255u) * k; v1[1] *= (float)((g.y >> 8) & 255u) * k; v1[2] *= (float)((g.y >> 16) & 255u) * k; v1[3] *= (float)(g.y >> 24) * k; }
                    else { const u32x4 g = gw[m][bj];
                        v0[0] *= bflo(g.x); v0[1] *= bfhi(g.x); v0[2] *= bflo(g.y); v0[3] *= bfhi(g.y);
                        v1[0] *= bflo(g.z); v1[1] *= bfhi(g.z); v1[2] *= bflo(g.w); v1[3] *= bfhi(g.w); }
                    if (STEP > 0) { const u32x4 q = mw[m][bj];
                        v0[0] += bflo(q.x); v0[1] += bfhi(q.x); v0[2] += bflo(q.y); v0[3] += bfhi(q.y);
                        v1[0] += bflo(q.z); v1[1] += bfhi(q.z); v1[2] += bflo(q.w); v1[3] += bfhi(q.w); }
                    u32x4 w; w.x = cvtpk(v0[0], v0[1]); w.y = cvtpk(v0[2], v0[3]); w.z = cvtpk(v1[0], v1[1]); w.w = cvtpk(v1[2], v1[3]);
                    *(u32x4*)((STEP < 2 ? macc : mixed) + row * 2048 + col) = w; } }
        }
    }
};
struct SchedMix {
    static constexpr bool GATHER = false; static constexpr bool VARK = true;
    const unsigned char* ws; int r0, r1;
    __device__ __forceinline__ bool next(int i, Unit& u) const {
        const int tr = r0 + i / 3; if (tr >= r1) return false;
        const int L = tr * (int)gridDim.x + (int)blockIdx.x; if (L >= 64 * 8) return false;
        static_tile(L, 64, 8, u.pm, u.pn); u.z = i % 3; return true;
    }
    __device__ __forceinline__ int ktiles(const Unit& u) const { return u.z == 1 ? 32 : 16; }
    __device__ __forceinline__ const char* baseA(const Unit& u) const {
        const size_t ts = (size_t)256 * 2048 * 2;
        return (const char*)ws + (u.z == 1 ? WS_ATT : WS_FX + (u.z == 2 ? 2048 : 0)) + (size_t)u.pm * ts;
    }
    __device__ __forceinline__ const char* baseB(const Unit& u) const {
        const size_t ts = (size_t)256 * 2048 * 2;
        return (const char*)ws + (u.z == 1 ? WS_WAOT : WS_WFM + (u.z == 2 ? 2048 : 0)) + (size_t)u.pn * ts;
    }
    __device__ __forceinline__ unsigned arow(const Unit&, int) const { return 0u; }
};
struct EpiMixF {
    static constexpr int PERM = 1; static constexpr bool AFTER_DRAIN = false, KEEP = true; static constexpr int NSTORE = 16;
    unsigned char* ws;
    __device__ __forceinline__ bool keep(const Unit& u) const { return u.z < 2; }
    static constexpr bool TOUCH = EPI_TOUCH;
    __device__ __forceinline__ void touch(const Unit& u, LAS unsigned char* lds, int tid, int wid) const {
        if (u.z != 0) return;
        const unsigned char* q = ws + WS_GATES + (size_t)(u.pm * 256 + (tid >> 1)) * 6144 + u.pn * 256 + (tid & 1) * 128;
#pragma unroll
        for (int s = 0; s < 3; ++s) __builtin_amdgcn_global_load_lds((const unsigned*)(q + s * 2048), (LAS unsigned*)(lds + LDS_BTAB + wid * 1024 + s * 256), 4, 0, 0);
    }
    static __device__ __forceinline__ float gb(unsigned w, int k) { return (float)((w >> (8 * k)) & 255u); }
    __device__ __forceinline__ void operator()(f32x4 (&acc)[2][2][4][2], const Unit& u, int wr, int wc, int fr, int fq) const {
        const int row0 = u.pm * 256 + wr * 64 + fr, col0 = u.pn * 256 + wc * 32 + 8 * fq;
        const int seg = __builtin_amdgcn_readfirstlane(u.z);
        const unsigned char* gnum = ws + WS_GATES + seg * 2048;
        bf16_t* mixed = (bf16_t*)(ws + WS_MIXED);
        if (seg < 2) {
#pragma unroll
            for (int ai = 0; ai < 2; ++ai) {
                u32x2 gn[4][2], gd[4][2];
#pragma unroll
                for (int m = 0; m < 4; ++m) { const size_t row = (size_t)(row0 + ai * HALF + m * 16);
#pragma unroll
                    for (int bj = 0; bj < 2; ++bj) { const unsigned char* q = gnum + row * 6144 + col0 + bj * HALF; gn[m][bj] = *(const u32x2*)q; gd[m][bj] = *(const u32x2*)(q + 2048); } }
#pragma unroll
                for (int m = 0; m < 4; ++m)
#pragma unroll
                    for (int bj = 0; bj < 2; ++bj) {
#pragma unroll
                        for (int k = 0; k < 4; ++k) {
                            const float n0 = (seg == 0) ? gb(gn[m][bj].x, k) : fmaxf(gb(gn[m][bj].x, k), 0.5f), n1 = (seg == 0) ? gb(gn[m][bj].y, k) : fmaxf(gb(gn[m][bj].y, k), 0.5f);
                            acc[ai][bj][m][0][k] *= n0 * __builtin_amdgcn_rcpf(fmaxf(gb(gd[m][bj].x, k), 0.5f));
                            acc[ai][bj][m][1][k] *= n1 * __builtin_amdgcn_rcpf(fmaxf(gb(gd[m][bj].y, k), 0.5f)); } }
            }
        } else {
#pragma unroll
            for (int ai = 0; ai < 2; ++ai) {
                u32x2 gn[4][2];
#pragma unroll
                for (int m = 0; m < 4; ++m) { const size_t row = (size_t)(row0 + ai * HALF + m * 16);
#pragma unroll
                    for (int bj = 0; bj < 2; ++bj) gn[m][bj] = *(const u32x2*)(gnum + row * 6144 + col0 + bj * HALF); }
#pragma unroll
                for (int m = 0; m < 4; ++m) { const size_t row = (size_t)(row0 + ai * HALF + m * 16);
#pragma unroll
                    for (int bj = 0; bj < 2; ++bj) { const float kq = 1.0f / 255.0f; f32x4 v0 = acc[ai][bj][m][0], v1 = acc[ai][bj][m][1];
#pragma unroll
                        for (int k = 0; k < 4; ++k) { v0[k] *= fmaxf(gb(gn[m][bj].x, k), 0.5f) * kq; v1[k] *= fmaxf(gb(gn[m][bj].y, k), 0.5f) * kq; }
                        u32x4 w; w.x = cvtpk(v0[0], v0[1]); w.y = cvtpk(v0[2], v0[3]); w.z = cvtpk(v1[0], v1[1]); w.w = cvtpk(v1[2], v1[3]);
                        *(u32x4*)(mixed + row * 2048 + col0 + bj * HALF) = w; } }
            }
        }
    }
};
struct EpiRes {
    static constexpr int PERM = 1; static constexpr bool AFTER_DRAIN = false; static constexpr int NSTORE = 16;
    const float* x; bf16_t* x2; const bf16_t* h; const float* irs; const float* g1;
    static constexpr bool TOUCH = EPI_TOUCH;
    __device__ __forceinline__ void touch(const Unit& u, LAS unsigned char* lds, int tid, int wid) const {
        const unsigned char* q = (const unsigned char*)(x + (size_t)(u.pm * 256 + (tid >> 1)) * 2048 + u.pn * 256) + (tid & 1) * 512;
#pragma unroll
        for (int j = 0; j < 4; ++j) __builtin_amdgcn_global_load_lds((const unsigned*)(q + j * 128), (LAS unsigned*)(lds + LDS_BTAB + wid * 1024 + j * 256), 4, 0, 0);
    }
    __device__ __forceinline__ void operator()(const f32x4 (&acc)[2][2][4][2], const Unit& u, int wr, int wc, int fr, int fq) const {
        const int row0 = u.pm * 256 + wr * 64 + fr, col0 = u.pn * 256 + wc * 32 + 8 * fq;
        if constexpr (RES_FROM_H) {
            f32x4 ig[2][2]; bool bad = false;
#pragma unroll
            for (int bj = 0; bj < 2; ++bj)
#pragma unroll
                for (int n2 = 0; n2 < 2; ++n2) { const f32x4 gv = *(const f32x4*)(g1 + col0 + bj * HALF + 4 * n2);
#pragma unroll
                    for (int k = 0; k < 4; ++k) { bad |= (gv[k] == 0.f); ig[bj][n2][k] = __builtin_amdgcn_rcpf(gv[k]); } }
            if (!__any(bad)) {
#pragma unroll
                for (int ai = 0; ai < 2; ++ai) {
                    float ir[4]; u32x4 hv[4][2];
#pragma unroll
                    for (int m = 0; m < 4; ++m) { const size_t row = (size_t)(row0 + ai * HALF + m * 16); ir[m] = irs[row];
#pragma unroll
                        for (int bj = 0; bj < 2; ++bj) hv[m][bj] = *(const u32x4*)(h + row * LDP + col0 + bj * HALF); }
#pragma unroll
                    for (int m = 0; m < 4; ++m) { const size_t off = (size_t)(row0 + ai * HALF + m * 16) * 2048 + col0;
#pragma unroll
                        for (int bj = 0; bj < 2; ++bj) { const u32x4 q = hv[m][bj]; const f32x4 i0 = ig[bj][0] * ir[m], i1 = ig[bj][1] * ir[m];
                            const f32x4 v0 = acc[ai][bj][m][0] + (f32x4){bflo(q.x), bfhi(q.x), bflo(q.y), bfhi(q.y)} * i0, v1 = acc[ai][bj][m][1] + (f32x4){bflo(q.z), bfhi(q.z), bflo(q.w), bfhi(q.w)} * i1;
                            u32x4 w; w.x = cvtpk(v0[0], v0[1]); w.y = cvtpk(v0[2], v0[3]); w.z = cvtpk(v1[0], v1[1]); w.w = cvtpk(v1[2], v1[3]);
                            *(u32x4*)(x2 + off + bj * HALF) = w; } }
                }
                return;
            }
        }
#pragma unroll
        for (int ai = 0; ai < 2; ++ai) {
            f32x4 xv[4][2][2];
#pragma unroll
            for (int m = 0; m < 4; ++m) { const size_t off = (size_t)(row0 + ai * HALF + m * 16) * 2048 + col0;
#pragma unroll
                for (int bj = 0; bj < 2; ++bj) { xv[m][bj][0] = *(const f32x4*)(x + off + bj * HALF); xv[m][bj][1] = *(const f32x4*)(x + off + bj * HALF + 4); } }
#pragma unroll
            for (int m = 0; m < 4; ++m) { const size_t off = (size_t)(row0 + ai * HALF + m * 16) * 2048 + col0;
#pragma unroll
                for (int bj = 0; bj < 2; ++bj) { const f32x4 v0 = acc[ai][bj][m][0] + xv[m][bj][0], v1 = acc[ai][bj][m][1] + xv[m][bj][1];
                    u32x4 w; w.x = cvtpk(v0[0], v0[1]); w.y = cvtpk(v0[2], v0[3]); w.z = cvtpk(v1[0], v1[1]); w.w = cvtpk(v1[2], v1[3]);
                    *(u32x4*)(x2 + off + bj * HALF) = w; } }
        }
    }
};
__device__ __forceinline__ float swiglu1(float g, float up) {
    g = fminf(g, 7.0f); up = fminf(fmaxf(up, -7.0f), 7.0f);
    return (up + 1.0f) * (g * sigmoid_sc(g, -1.702f * LOG2E));
}
struct EpiSwiglu {
    static constexpr bool PERM = true, AFTER_DRAIN = false; static constexpr int NSTORE = 8;
    unsigned char* ws; const float* bgu; const LAS int* pt;
    __device__ __forceinline__ void operator()(const f32x4 (&acc)[2][2][4][2], const Unit& u, int wr, int wc, int fr, int fq) const {
        const int e = u.z; const size_t srow0 = (size_t)(__builtin_amdgcn_readfirstlane(pt[e]) + u.pm) * 256 + wr * 64 + fr;
        const int col0 = u.pn * 256 + wc * 32 + 8 * fq;
        bf16_t* act = (bf16_t*)(ws + WS_ACT);
        f32x4 bv[2][2];
#pragma unroll
        for (int bj = 0; bj < 2; ++bj)
#pragma unroll
            for (int n = 0; n < 2; ++n) bv[bj][n] = *(const f32x4*)(bgu + (size_t)e * 4096 + col0 + bj * HALF + 4 * n);
#pragma unroll
        for (int ai = 0; ai < 2; ++ai)
#pragma unroll
            for (int m = 0; m < 4; ++m) { bf16_t* rowp = act + (srow0 + ai * HALF + m * 16) * 2048 + (col0 >> 1);
#pragma unroll
                for (int bj = 0; bj < 2; ++bj) { const f32x4 v0 = acc[ai][bj][m][0] + bv[bj][0], v1 = acc[ai][bj][m][1] + bv[bj][1];
                    u32x2 w; w.x = cvtpk(swiglu1(v0[0], v0[1]), swiglu1(v0[2], v0[3])); w.y = cvtpk(swiglu1(v1[0], v1[1]), swiglu1(v1[2], v1[3]));
                    *(u32x2*)(rowp + bj * (HALF / 2)) = w; } }
    }
};
struct EpiDown {
    static constexpr bool PERM = true, AFTER_DRAIN = false; static constexpr int NSTORE = 8;
    unsigned char* ws; const float* bdn; const LAS int* pt; const LAS int* cn;
    __device__ __forceinline__ void operator()(const f32x4 (&acc)[2][2][4][2], const Unit& u, int wr, int wc, int fr, int fq) const {
        const int e = u.z; const int lrow0 = u.pm * 256 + wr * 64 + fr; const size_t srow0 = (size_t)__builtin_amdgcn_readfirstlane(pt[e]) * 256 + lrow0;
        const int col0 = u.pn * 256 + wc * 32 + 8 * fq;
        bf16_t* ys = (bf16_t*)(ws + WS_YS); const float* wl = (const float*)(ws + WS_WLIST) + (size_t)e * T_; const int cne = __builtin_amdgcn_readfirstlane(cn[e]);
        f32x4 bv[2][2];
#pragma unroll
        for (int bj = 0; bj < 2; ++bj)
#pragma unroll
            for (int n = 0; n < 2; ++n) bv[bj][n] = *(const f32x4*)(bdn + (size_t)e * 2048 + col0 + bj * HALF + 4 * n);
#pragma unroll
        for (int ai = 0; ai < 2; ++ai)
#pragma unroll
            for (int m = 0; m < 4; ++m) { const int pos = lrow0 + ai * HALF + m * 16; const float w = (pos < cne) ? wl[pos] : 0.f;
                bf16_t* rowp = ys + (srow0 + ai * HALF + m * 16) * 2048 + col0;
#pragma unroll
                for (int bj = 0; bj < 2; ++bj) { const f32x4 v0 = (acc[ai][bj][m][0] + bv[bj][0]) * w, v1 = (acc[ai][bj][m][1] + bv[bj][1]) * w;
                    u32x4 o; o.x = cvtpk(v0[0], v0[1]); o.y = cvtpk(v0[2], v0[3]); o.z = cvtpk(v1[0], v1[1]); o.w = cvtpk(v1[2], v1[3]);
                    *(u32x4*)(rowp + bj * HALF) = o; } }
    }
};
__device__ __forceinline__ unsigned pk_fp8x4(float a, float b, float c, float d) {
    int w = __builtin_amdgcn_cvt_pk_fp8_f32(a, b, 0, false); w = __builtin_amdgcn_cvt_pk_fp8_f32(c, d, w, true); return (unsigned)w; }
struct EpiSwiglu8 {
    static constexpr int PERM = 2; static constexpr bool AFTER_DRAIN = false; static constexpr int NSTORE = 8;
    unsigned char* ws; const float* bgu; const LAS int* pt;
    __device__ __forceinline__ void operator()(const f32x4 (&acc)[2][2][4][2], const Unit& u, int wr, int wc, int fr, int fq) const {
        const int e = u.z; const size_t srow0 = (size_t)(__builtin_amdgcn_readfirstlane(pt[e]) + u.pm) * 256 + wr * 64 + fr;
        const int col0 = u.pn * 256 + wc * 64 + 16 * fq;
        unsigned char* act = ws + WS_ACTQ;
        const LAS float* btab = (const LAS float*)((const LAS unsigned char*)pt - LDS_MISC + LDS_BTAB) + u.idx * 256 + wc * 64 + 16 * fq;
        f32x4 bv[2][2];
#pragma unroll
        for (int bj = 0; bj < 2; ++bj)
#pragma unroll
            for (int n = 0; n < 2; ++n) bv[bj][n] = *(const LAS f32x4*)(btab + 8 * bj + 4 * n);
#pragma unroll
        for (int ai = 0; ai < 2; ++ai)
#pragma unroll
            for (int m = 0; m < 4; ++m) {
                float o[8];
#pragma unroll
                for (int bj = 0; bj < 2; ++bj)
#pragma unroll
                    for (int n = 0; n < 2; ++n) { const f32x4 v = acc[ai][bj][m][n] * WQ_INV + bv[bj][n]; o[4 * bj + 2 * n] = swiglu1(v[0], v[1]); o[4 * bj + 2 * n + 1] = swiglu1(v[2], v[3]); }
                u32x2 w; w.x = pk_fp8x4(o[0], o[1], o[2], o[3]); w.y = pk_fp8x4(o[4], o[5], o[6], o[7]);
                *(u32x2*)(act + (srow0 + ai * HALF + m * 16) * 2048 + (col0 >> 1)) = w; }
    }
};
struct EpiDown8 {
    static constexpr int PERM = 2; static constexpr bool AFTER_DRAIN = false; static constexpr int NSTORE = 8;
    unsigned char* ws; const float* bdn; const LAS int* pt; const LAS int* cn; size_t ysbase = WS_YS;
    __device__ __forceinline__ void operator()(const f32x4 (&acc)[2][2][4][2], const Unit& u, int wr, int wc, int fr, int fq) const {
        const int e = u.z; const int lrow0 = u.pm * 256 + wr * 64 + fr; const size_t srow0 = (size_t)__builtin_amdgcn_readfirstlane(pt[e]) * 256 + lrow0;
        const int col0 = u.pn * 256 + wc * 64 + 16 * fq;
        unsigned char* ys = ws + ysbase;
        const LAS float* btab = (const LAS float*)((const LAS unsigned char*)pt - LDS_MISC + LDS_BTAB) + u.idx * 256 + wc * 64 + 16 * fq;
        const LAS float* wtab = (const LAS float*)((const LAS unsigned char*)pt - LDS_MISC + LDS_TOKL) + u.idx * 256 + wr * 64 + fr;
        f32x4 bv[2][2];
#pragma unroll
        for (int bj = 0; bj < 2; ++bj)
#pragma unroll
            for (int n = 0; n < 2; ++n) bv[bj][n] = *(const LAS f32x4*)(btab + 8 * bj + 4 * n);
#pragma unroll
        for (int ai = 0; ai < 2; ++ai)
#pragma unroll
            for (int m = 0; m < 4; ++m) { const float w = wtab[ai * HALF + m * 16];
                u32x4 o;
                { const f32x4 a = (acc[ai][0][m][0] * WQ_INV + bv[0][0]) * w, c = (acc[ai][0][m][1] * WQ_INV + bv[0][1]) * w; o.x = pk_fp8x4(a[0], a[1], a[2], a[3]); o.y = pk_fp8x4(c[0], c[1], c[2], c[3]); }
                { const f32x4 a = (acc[ai][1][m][0] * WQ_INV + bv[1][0]) * w, c = (acc[ai][1][m][1] * WQ_INV + bv[1][1]) * w; o.z = pk_fp8x4(a[0], a[1], a[2], a[3]); o.w = pk_fp8x4(c[0], c[1], c[2], c[3]); }
                *(u32x4*)(ys + (srow0 + ai * HALF + m * 16) * 2048 + col0) = o; }
    }
};
struct EpiMemSoftmax {
    static constexpr bool PERM = true, AFTER_DRAIN = true; static constexpr int NSTORE = 0;
    bf16_t* P;
    __device__ __forceinline__ void operator()(const f32x4 (&)[2][2][4][2], const Unit&, int, int, int, int) const {}
    __device__ __forceinline__ void fused(f32x4 (&acc)[2][2][4][2], const Unit&, int wr, int wc, int fr, int fq, LAS unsigned char* lds, int, int) const {
        LAS f32x2* tab = (LAS f32x2*)lds;
        const float sc = 0.0625f * LOG2E;
        float mx[2][4];
#pragma unroll
        for (int ai = 0; ai < 2; ++ai)
#pragma unroll
            for (int m = 0; m < 4; ++m) { float a = -3.0e38f;
#pragma unroll
                for (int bj = 0; bj < 2; ++bj)
#pragma unroll
                    for (int n = 0; n < 2; ++n) { acc[ai][bj][m][n] *= sc; const f32x4 v = acc[ai][bj][m][n]; a = fmaxf(a, fmaxf(fmaxf(v[0], v[1]), fmaxf(v[2], v[3]))); }
                a = fmaxf(a, __shfl_xor(a, 16)); a = fmaxf(a, __shfl_xor(a, 32)); mx[ai][m] = a;
                float s = 0.f;
#pragma unroll
                for (int bj = 0; bj < 2; ++bj)
#pragma unroll
                    for (int n = 0; n < 2; ++n) { const f32x4 v = acc[ai][bj][m][n]; s += __builtin_amdgcn_exp2f(v[0] - a) + __builtin_amdgcn_exp2f(v[1] - a) + __builtin_amdgcn_exp2f(v[2] - a) + __builtin_amdgcn_exp2f(v[3] - a); }
                s += __shfl_xor(s, 16); s += __shfl_xor(s, 32);
                if (fq == 0) tab[(ai * HALF + wr * 64 + m * 16 + fr) * 4 + wc] = (f32x2){a, s};
            }
        __syncthreads();
#pragma unroll
        for (int ai = 0; ai < 2; ++ai)
#pragma unroll
            for (int m = 0; m < 4; ++m) { const int r = ai * HALF + wr * 64 + m * 16 + fr;
                const f32x2 t0 = tab[r * 4 + 0], t1 = tab[r * 4 + 1], t2 = tab[r * 4 + 2], t3 = tab[r * 4 + 3];
                const float M = fmaxf(fmaxf(t0.x, t1.x), fmaxf(t2.x, t3.x));
                const float L = t0.y * __builtin_amdgcn_exp2f(t0.x - M) + t1.y * __builtin_amdgcn_exp2f(t1.x - M) + t2.y * __builtin_amdgcn_exp2f(t2.x - M) + t3.y * __builtin_amdgcn_exp2f(t3.x - M);
                const float inv = 1.0f / L;
                bf16_t* rowp = P + (size_t)r * 1024 + wc * 32 + 8 * fq;
#pragma unroll
                for (int bj = 0; bj < 2; ++bj) { f32x4 v0 = acc[ai][bj][m][0], v1 = acc[ai][bj][m][1];
#pragma unroll
                    for (int j = 0; j < 4; ++j) { v0[j] = __builtin_amdgcn_exp2f(v0[j] - M) * inv; v1[j] = __builtin_amdgcn_exp2f(v1[j] - M) * inv; }
                    u32x4 w; w.x = cvtpk(v0[0], v0[1]); w.y = cvtpk(v0[2], v0[3]); w.z = cvtpk(v1[0], v1[1]); w.w = cvtpk(v1[2], v1[3]);
                    *(u32x4*)(rowp + bj * HALF) = w; } }
        __syncthreads();
    }
};
struct EpiTile {
    static constexpr bool PERM = true, AFTER_DRAIN = false; static constexpr int NSTORE = 0;
    bf16_t* dst; size_t ldc;
    __device__ __forceinline__ void operator()(const f32x4 (&acc)[2][2][4][2], const Unit&, int wr, int wc, int fr, int fq) const { store_tile_bf16(acc, dst, ldc, wr, wc, fr, fq); }
};
__device__ __forceinline__ void tr_item(const float* W, int K, int N, bf16_t* WT, LAS float* scr, int item, int lane) {
    const int nblk = N / 32, kb = item / nblk, nb = item % nblk, k0 = 64 * kb, n0 = 32 * nb;
#pragma unroll 8
    for (int i = 0; i < 32; ++i) { const int kk = 2 * i + (lane >> 5); scr[kk * 33 + (lane & 31)] = W[(size_t)(k0 + kk) * N + n0 + (lane & 31)]; }
    asm volatile("s_waitcnt lgkmcnt(0)" ::: "memory");
    const int c = lane & 7;
#pragma unroll
    for (int j = 0; j < 4; ++j) { const int n = (lane >> 3) + 8 * j; const LAS float* s = scr + (8 * c) * 33 + n;
        u32x4 o; o.x = cvtpk(s[0 * 33], s[1 * 33]); o.y = cvtpk(s[2 * 33], s[3 * 33]); o.z = cvtpk(s[4 * 33], s[5 * 33]); o.w = cvtpk(s[6 * 33], s[7 * 33]);
        *(u32x4*)(WT + (size_t)(n0 + n) * K + k0 + 8 * c) = o; }
    asm volatile("s_waitcnt lgkmcnt(0)" ::: "memory");
}
__device__ __forceinline__ void tr_item8(const float* W, int K, int N, unsigned char* WT, LAS float* scr, int item, int lane, float scale) {
    const int nblk = N / 32, kb = item / nblk, nb = item % nblk, k0 = 128 * kb, n0 = 32 * nb;
#pragma unroll 8
    for (int i = 0; i < 64; ++i) { const int kk = 2 * i + (lane >> 5); scr[kk * 33 + (lane & 31)] = W[(size_t)(k0 + kk) * N + n0 + (lane & 31)] * scale; }
    asm volatile("s_waitcnt lgkmcnt(0)" ::: "memory");
    const int c = lane & 7;
#pragma unroll
    for (int j = 0; j < 4; ++j) { const int n = (lane >> 3) + 8 * j; const LAS float* s = scr + (16 * c) * 33 + n;
        u32x4 o; o.x = pk_fp8x4(s[0 * 33], s[1 * 33], s[2 * 33], s[3 * 33]); o.y = pk_fp8x4(s[4 * 33], s[5 * 33], s[6 * 33], s[7 * 33]);
        o.z = pk_fp8x4(s[8 * 33], s[9 * 33], s[10 * 33], s[11 * 33]); o.w = pk_fp8x4(s[12 * 33], s[13 * 33], s[14 * 33], s[15 * 33]);
        *(u32x4*)(WT + (size_t)(n0 + n) * K + k0 + 16 * c) = o; }
    asm volatile("s_waitcnt lgkmcnt(0)" ::: "memory");
}
__device__ __forceinline__ void rms_row_to_bf16(const float* xrow, const float* g, bf16_t* orow, int lane, unsigned char* qrow = nullptr, float* irs = nullptr) {
    const f32x4* xr = (const f32x4*)xrow + lane; const f32x4* gr = (const f32x4*)g + lane;
    f32x4 v[8]; float s = 0.f;
#pragma unroll
    for (int j = 0; j < 8; ++j) { v[j] = xr[64 * j]; s += (v[j][0] * v[j][0] + v[j][1] * v[j][1]) + (v[j][2] * v[j][2] + v[j][3] * v[j][3]); }
    const float r = rsqrtf(wsum(s) * (1.0f / DM) + 1e-5f);
    if (irs && lane == 0) *irs = 1.0f / r;
    u32x2* o8 = (u32x2*)orow + lane;
#pragma unroll
    for (int j = 0; j < 8; ++j) { const f32x4 gg = gr[64 * j]; u32x2 w; w.x = cvtpk(v[j][0] * r * gg[0], v[j][1] * r * gg[1]); w.y = cvtpk(v[j][2] * r * gg[2], v[j][3] * r * gg[3]); o8[64 * j] = w;
        if (qrow) ((unsigned*)qrow)[lane + 64 * j] = pk_fp8x4(v[j][0] * r * gg[0], v[j][1] * r * gg[1], v[j][2] * r * gg[2], v[j][3] * r * gg[3]); }
}
__device__ __forceinline__ float rms_bfrow_to_bf16(const bf16_t* xrow, const float* g, bf16_t* orow, int lane, unsigned char* qrow) {
    const u32x2* xr = (const u32x2*)xrow + lane; const f32x4* gr = (const f32x4*)g + lane;
    f32x4 v[8]; float s = 0.f;
#pragma unroll
    for (int j = 0; j < 8; ++j) { const u32x2 w = xr[64 * j]; v[j] = (f32x4){bflo(w.x), bfhi(w.x), bflo(w.y), bfhi(w.y)}; s += (v[j][0] * v[j][0] + v[j][1] * v[j][1]) + (v[j][2] * v[j][2] + v[j][3] * v[j][3]); }
    const float r = rsqrtf(wsum(s) * (1.0f / DM) + 1e-5f);
    u32x2* o8 = (u32x2*)orow + lane;
#pragma unroll
    for (int j = 0; j < 8; ++j) { const f32x4 gg = gr[64 * j]; if (orow) { u32x2 w; w.x = cvtpk(v[j][0] * r * gg[0], v[j][1] * r * gg[1]); w.y = cvtpk(v[j][2] * r * gg[2], v[j][3] * r * gg[3]); o8[64 * j] = w; }
        if (qrow) ((unsigned*)qrow)[lane + 64 * j] = pk_fp8x4(v[j][0] * r * gg[0], v[j][1] * r * gg[1], v[j][2] * r * gg[2], v[j][3] * r * gg[3]); }
    return r;
}
constexpr int CV_I_IN = (DM / 128) * (INW / 256), CV_I_SQ = (2048 / 128) * (2048 / 256), CV_I_HF = (1024 / 128) * (2048 / 256);
constexpr int CV_I_GU = (2048 / 128) * (4096 / 256), CV_I_DN = CV_I_SQ;
constexpr long CV_NONEXP = (long)CV_I_IN + 3L * CV_I_SQ + 2L * CV_I_HF;
constexpr long CV_TOTAL = CV_NONEXP + (long)NE * CV_I_GU + (long)NE * CV_I_DN;
typedef short v2s_t __attribute__((ext_vector_type(2)));
__device__ __forceinline__ unsigned pk_fp8x4_scaled(float a, float b, float c, float d) {
    v2s_t r = {0, 0};
    r = __builtin_amdgcn_cvt_scalef32_pk_fp8_f32(r, a, b, WQ_INV, false);
    r = __builtin_amdgcn_cvt_scalef32_pk_fp8_f32(r, c, d, WQ_INV, true);
    return __builtin_bit_cast(unsigned, r);
}
constexpr int CV_PITCH = 260;
#ifndef CV_ASMLD
#define CV_ASMLD 0
#endif
__device__ __forceinline__ f32x4 cv_load(const float* q) {
#if CV_ASMLD
    f32x4 v; asm volatile("global_load_dwordx4 %0, %1, off sc0 sc1 nt" : "=v"(v) : "v"(q) : "memory"); return v;
#else
    return __builtin_nontemporal_load((const f32x4*)q);
#endif
}
__device__ __forceinline__ void convert_items(const Params& p, LAS unsigned char* lds, long it0, long it_end, int worker, int nworkers, int probe = 0, int* qhead = nullptr) {
    int tid_ = threadIdx.x; asm volatile("" : "+v"(tid_));
    const int tid = tid_, wave = __builtin_amdgcn_readfirstlane(tid >> 6), lane = tid & 63;
    unsigned char* ws = p.ws;
    LAS float* tile = (LAS float*)lds;
    constexpr int I_IN = CV_I_IN, I_SQ = CV_I_SQ, I_HF = CV_I_HF, I_GU = CV_I_GU, I_DN = CV_I_DN;
    static_assert(I_GU == 256 && I_DN == 128, "shift decode of the expert items");
    struct Item { const float* src; unsigned char* dst; int N, K, f8; };
    auto decode = [&](long it, Item& q) -> bool {
        if (it >= it_end) return false;
        long r = it; const float* W; unsigned char* D; int K, N, f8 = 0, kb, nb;
        if (r >= CV_NONEXP) {
            r -= CV_NONEXP; K = 2048; f8 = MOE_F8 ? 1 : 0;
            if (r < (long)NE * I_GU) { const int e = (int)(r >> 8), rr = (int)r & 255; kb = rr >> 4; nb = rr & 15; N = 4096;
                W = p.in[14] + (size_t)e * 2048 * 4096; D = ws + (MOE_F8 ? WS_WGUQ + (size_t)e * 4096 * 2048 : WS_WGUT + (size_t)e * 4096 * 2048 * 2); }
            else { r -= (long)NE * I_GU; const int e = (int)(r >> 7), rr = (int)r & 127; kb = rr >> 3; nb = rr & 7; N = 2048;
                W = p.in[16] + (size_t)e * 2048 * 2048; D = ws + (MOE_F8 ? WS_WDNQ + (size_t)e * 2048 * 2048 : WS_WDNT + (size_t)e * 2048 * 2048 * 2); }
        } else {
            if (r < I_IN) { W = p.in[4]; D = ws + WS_WINT; K = LDP; N = INW;
                if (GATES_F8 && 256 * ((int)r % (INW / 256)) >= 4608) { f8 = 2; D = ws + WS_WINQ; K = 2048; } }
            else if ((r -= I_IN) < I_SQ) { W = p.in[6]; D = ws + WS_WMKVT; K = LDP; N = 2048; }
            else if ((r -= I_SQ) < I_HF) { W = p.in[7]; D = ws + WS_WFM; K = 2048; N = 2048; }
            else if ((r -= I_HF) < I_SQ) { W = p.in[8]; D = ws + WS_WAOT; K = 2048; N = 2048; }
            else if ((r -= I_SQ) < I_HF) { W = p.in[9]; D = ws + WS_WFM + 1024 * 2; K = 2048; N = 2048; }
            else { r -= I_HF; W = p.in[10]; D = ws + WS_WOT; K = 2048; N = 2048; }
            const int nblk = N / 256; kb = (int)r / nblk; nb = (int)r % nblk;
        }
        q.src = W + (size_t)(128 * kb + wave) * N + 256 * nb + 4 * lane;
        q.dst = D + ((size_t)(256 * nb - (f8 == 2 ? 4608 : 0)) * K + 128 * kb) * (f8 ? 1 : 2);
        q.N = N; q.K = K; q.f8 = f8;
        if (probe) { q.src = p.in[14] + (size_t)wave * 4096 + 4 * lane; q.dst = ws + ((WS_FAST_END + 4095) & ~(size_t)4095) + (size_t)blockIdx.x * (256 * 2048); q.N = 4096; q.K = 2048; q.f8 = 1; }
        return true;
    };
    f32x4 v[16];
    LAS int* qslot = (LAS int*)(lds + LDS_MISC + 768);
    long it = it0 + worker, itn = it + nworkers;
    if (qhead) {
        if (tid == 0) { qslot[0] = __hip_atomic_fetch_add(qhead, 1, __ATOMIC_RELAXED, __HIP_MEMORY_SCOPE_AGENT); qslot[1] = __hip_atomic_fetch_add(qhead, 1, __ATOMIC_RELAXED, __HIP_MEMORY_SCOPE_AGENT); }
        __syncthreads();
        it = it0 + __builtin_amdgcn_readfirstlane(qslot[0]); itn = it0 + __builtin_amdgcn_readfirstlane(qslot[1]);
        __syncthreads();
    }
    Item cur; bool have = decode(it, cur);
    if (have) {
#pragma unroll
        for (int i = 0; i < 16; ++i) v[i] = cv_load(cur.src + (size_t)(8 * i) * cur.N);
    }
    int pst = 0;
    const int cch = lane & 7, nq = (lane >> 3) + 8 * wave;
    while (have) {
        Item nxt; const bool hn = decode(itn, nxt);
        __syncthreads();
#if CV_ASMLD
        if (pst == 4) asm volatile("s_waitcnt vmcnt(4)" ::: "memory"); else if (pst == 8) asm volatile("s_waitcnt vmcnt(8)" ::: "memory"); else asm volatile("s_waitcnt vmcnt(0)" ::: "memory");
#pragma unroll
        for (int i = 0; i < 16; ++i) asm volatile("" : "+v"(v[i]));
#endif
#pragma unroll
        for (int i = 0; i < 16; ++i) *(LAS f32x4*)(tile + (8 * i + wave) * CV_PITCH + 4 * lane + 16 * (i >> 1)) = v[i];
        if (qhead && hn && tid == 0) qslot[0] = __hip_atomic_fetch_add(qhead, 1, __ATOMIC_RELAXED, __HIP_MEMORY_SCOPE_AGENT);
        if (hn) {
#pragma unroll
            for (int i = 0; i < 16; ++i) v[i] = cv_load(nxt.src + (size_t)(8 * i) * nxt.N);
        }
        __syncthreads();
        const long itnn = qhead ? (hn ? it0 + __builtin_amdgcn_readfirstlane(qslot[0]) : it_end) : itn + nworkers;
        f32x4 t[16];
        const LAS float* s = tile + (16 * cch) * CV_PITCH + 16 * cch + 4 * nq;
#pragma unroll
        for (int i = 0; i < 16; ++i) t[i] = *(const LAS f32x4*)(s + i * CV_PITCH);
#pragma unroll
        for (int j = 0; j < 4; ++j) { const int n = 4 * nq + j;
            if (cur.f8) { u32x4 o; o.x = pk_fp8x4_scaled(t[0][j], t[1][j], t[2][j], t[3][j]); o.y = pk_fp8x4_scaled(t[4][j], t[5][j], t[6][j], t[7][j]);
                o.z = pk_fp8x4_scaled(t[8][j], t[9][j], t[10][j], t[11][j]); o.w = pk_fp8x4_scaled(t[12][j], t[13][j], t[14][j], t[15][j]);
                *(u32x4*)(cur.dst + (size_t)n * cur.K + 16 * cch) = o; }
            else { u32x4 o0, o1; o0.x = cvtpk(t[0][j], t[1][j]); o0.y = cvtpk(t[2][j], t[3][j]); o0.z = cvtpk(t[4][j], t[5][j]); o0.w = cvtpk(t[6][j], t[7][j]);
                o1.x = cvtpk(t[8][j], t[9][j]); o1.y = cvtpk(t[10][j], t[11][j]); o1.z = cvtpk(t[12][j], t[13][j]); o1.w = cvtpk(t[14][j], t[15][j]);
                u32x4* d = (u32x4*)(cur.dst + ((size_t)n * cur.K + 16 * cch) * 2); d[0] = o0; d[1] = o1; } }
        pst = cur.f8 ? 4 : 8;
        cur = nxt; have = hn; it = itn; itn = itnn;
    }
    __syncthreads();
}

constexpr long CE_TOTAL = (long)NE * 384;
constexpr int CE_PITCH = 1028;
__device__ __forceinline__ void convert_experts(const Params& p, LAS unsigned char* lds, long t0, long t1) {
    int tid_ = threadIdx.x; asm volatile("" : "+v"(tid_));
    const int tid = tid_, wave = tid >> 6, lane = tid & 63;
    LAS float* tile = (LAS float*)lds;
    struct Item { const float* src; unsigned char* dst; int N; };
    auto decode = [&](long t, Item& q) -> bool {
        if (t >= t1) return false;
        const int e = (int)(t / 384), r = (int)(t % 384);
        if (r < 256) { const int nr = r >> 6, kb = r & 63; q.N = 4096;
            q.src = p.in[14] + (size_t)e * 2048 * 4096 + (size_t)(32 * kb + 4 * wave) * 4096 + nr * 1024 + 4 * lane;
            q.dst = p.ws + WS_WGUQ + ((size_t)e * 4096 + (size_t)nr * 1024) * 2048 + 32 * kb; }
        else { const int nr = (r - 256) >> 6, kb = (r - 256) & 63; q.N = 2048;
            q.src = p.in[16] + (size_t)e * 2048 * 2048 + (size_t)(32 * kb + 4 * wave) * 2048 + nr * 1024 + 4 * lane;
            q.dst = p.ws + WS_WDNQ + ((size_t)e * 2048 + (size_t)nr * 1024) * 2048 + 32 * kb; }
        return true;
    };
    f32x4 v[16];
    Item cur; long t = t0; bool have = decode(t, cur);
    if (have) {
#pragma unroll
        for (int i = 0; i < 16; ++i) v[i] = __builtin_nontemporal_load((const f32x4*)(cur.src + (size_t)(i >> 2) * cur.N + 256 * (i & 3)));
    }
    while (have) {
        Item nxt; const bool hn = decode(t + 1, nxt);
        __syncthreads();
#pragma unroll
        for (int i = 0; i < 16; ++i) *(LAS f32x4*)(tile + (4 * wave + (i >> 2)) * CE_PITCH + 256 * (i & 3) + 4 * lane) = v[i];
        if (hn) {
#pragma unroll
            for (int i = 0; i < 16; ++i) v[i] = __builtin_nontemporal_load((const f32x4*)(nxt.src + (size_t)(i >> 2) * nxt.N + 256 * (i & 3)));
        }
        __syncthreads();
#pragma unroll
        for (int j = 0; j < 2; ++j) { const int n = tid + 512 * j; const LAS float* s = tile + n;
            float f[32];
#pragma unroll
            for (int i = 0; i < 32; ++i) f[i] = s[i * CE_PITCH] * WQ_SCALE;
            u32x4 o0, o1;
            o0.x = pk_fp8x4(f[0], f[1], f[2], f[3]); o0.y = pk_fp8x4(f[4], f[5], f[6], f[7]); o0.z = pk_fp8x4(f[8], f[9], f[10], f[11]); o0.w = pk_fp8x4(f[12], f[13], f[14], f[15]);
            o1.x = pk_fp8x4(f[16], f[17], f[18], f[19]); o1.y = pk_fp8x4(f[20], f[21], f[22], f[23]); o1.z = pk_fp8x4(f[24], f[25], f[26], f[27]); o1.w = pk_fp8x4(f[28], f[29], f[30], f[31]);
            u32x4* d = (u32x4*)(cur.dst + (size_t)n * 2048); d[0] = o0; d[1] = o1; }
        cur = nxt; have = hn; ++t;
    }
    __syncthreads();
}

__device__ __forceinline__ void phase_prologue(const Params& p, LAS unsigned char* lds) {
    int tid_ = threadIdx.x; asm volatile("" : "+v"(tid_));
    const int tid = tid_, wave = tid >> 6, lane = tid & 63;
    unsigned char* ws = p.ws;
    const int gw = vwg() * NWAVE + wave, NGW = (int)gridDim.x * NWAVE;
    for (int m = gw; m < T_; m += NGW) rms_row_to_bf16(p.in[0] + (size_t)m * DM, p.in[3], (bf16_t*)(ws + WS_H) + (size_t)m * LDP, lane, GATES_F8 ? (ws + WS_H8 + (size_t)m * DM) : nullptr, RES_FROM_H ? (float*)(ws + WS_IRSTD) + m : nullptr);
    for (int m = gw; m < B_ * MEM; m += NGW) {
        const f32x4* xr = (const f32x4*)(p.in[1] + (size_t)m * DM) + lane; u32x2* o8 = (u32x2*)((bf16_t*)(ws + WS_MEMBF) + (size_t)m * LDP) + lane;
#pragma unroll
        for (int j = 0; j < 8; ++j) { const f32x4 v = xr[64 * j]; u32x2 w; w.x = cvtpk(v[0], v[1]); w.y = cvtpk(v[2], v[3]); o8[64 * j] = w; }
    }
    {
        const int gt = vwg() * NTHR + tid, NGT = (int)gridDim.x * NTHR;
        bf16_t* tabT = (bf16_t*)(ws + WS_TABT); bf16_t* dm = (bf16_t*)(ws + WS_DMAT);
        for (int i = gt; i < 512 * 256 / 2; i += NGT) { const int e0 = 2 * i; const int mrow = e0 >> 8, c = e0 & 255; const int n = mrow & 255; float v[2];
#pragma unroll
            for (int j = 0; j < 2; ++j) { const int mm = ((c + j) * n) & 255; const float a = (float)mm * (2.0f / 256.0f); v[j] = (mrow < 256) ? cospif(a) : sinpif(a); }
            *(unsigned*)(tabT + e0) = cvtpk(v[0], v[1]); }
        const float sc = 1.0f / sqrtf(2048.0f * 256.0f);
        LAS float* ct = (LAS float*)lds;
        for (int m = tid; m < 2048; m += NTHR) ct[m] = cospif((float)m * (2.0f / 2048.0f)) * sc;
        __syncthreads();
        for (int i = gt; i < 2048 * 4096 / 2; i += NGT) { const int e0 = 2 * i; const int jr = e0 >> 12, k = e0 & 4095; float v[2];
#pragma unroll
            for (int j = 0; j < 2; ++j) { const int kk = (k + j) & 2047; const int mm = (jr * kk) & 2047; v[j] = (k < 2048) ? ct[mm] : ct[(mm + 512) & 2047]; }
            *(unsigned*)(dm + (size_t)jr * SQP + k) = cvtpk(v[0], v[1]); }
        __syncthreads();
        bf16_t* wrt = (bf16_t*)(ws + WS_WRT);
        for (int i = gt; i < NE * DM; i += NGT) { const int e = i >> 11, k = i & 2047; wrt[i] = (bf16_t)(cvtpk(p.in[12][(size_t)k * NE + e] * (ROUTER_ON_X2 ? p.in[11][k] : 1.0f), 0.f) & 0xffffu); }
    }
    __syncthreads();
    convert_items(p, lds, 0, (gridDim.x == 256) ? CV_NONEXP : CV_TOTAL, vwg(), (int)gridDim.x);
}

constexpr int AT_KROW = 144, AT_VROW = 776;
constexpr int AT_K = 0, AT_V = 384 * AT_KROW, AT_LUT = AT_V + 64 * AT_VROW;
static_assert(AT_LUT + NWAVE * 320 * 4 <= STAGE_BYTES, "attention LDS");
__device__ __forceinline__ void attn_unit(const Params& p, LAS unsigned char* lds, int b, int kvh, int qb) {
    int tid_ = threadIdx.x; asm volatile("" : "+v"(tid_));
    const int tid = tid_, wid = __builtin_amdgcn_readfirstlane(tid >> 6), lane = tid & 63, r = lane & 31, h = lane >> 5;
    const unsigned char* ws = p.ws;
    const bf16_t* Q = (const bf16_t*)(ws + WS_Q); const bf16_t* Kg = (const bf16_t*)(ws + WS_K); const bf16_t* VT = (const bf16_t*)(ws + WS_VT);
    bf16_t* att = (bf16_t*)(p.ws + WS_ATT);
    const int q0 = qb * 128, hq = kvh * 8 + wid;
    LAS unsigned char* Kb = lds + AT_K; LAS unsigned char* Vt = lds + AT_V; LAS float* lut = (LAS float*)(lds + AT_LUT) + wid * 320;
    __syncthreads();
    for (int c = tid; c < 384 * 8; c += NTHR) { const int row = c >> 3, part = c & 7, pos = q0 - 128 + row;
        u32x4 v = {0u, 0u, 0u, 0u};
        if (pos >= 0 && pos < S_) v = *(const u32x4*)(Kg + (size_t)(b * S_ + pos) * 256 + kvh * 64 + part * 8);
        *(LAS u32x4*)(Kb + row * AT_KROW + part * 16) = v; }
    for (int c = tid; c < 64 * 48; c += NTHR) { const int d = c / 48, ch = c % 48, pos0 = q0 - 128 + ch * 8;
        u32x4 v = {0u, 0u, 0u, 0u};
        if (pos0 >= 0 && pos0 < S_) v = *(const u32x4*)(VT + ((size_t)((b * 4 + kvh) * 64 + d)) * 2048 + pos0);
        *(LAS u32x2*)(Vt + d * AT_VROW + ch * 16) = (u32x2){v.x, v.y}; *(LAS u32x2*)(Vt + d * AT_VROW + ch * 16 + 8) = (u32x2){v.z, v.w}; }
    for (int i = lane; i < 320; i += 64) { const int rel = i - 160; const int ar = rel < 0 ? -rel : rel;
        lut[i] = (ar <= WIN) ? p.in[2][t5_bucket(rel) * NH + hq] * LOG2E : -1.0e30f; }
    __syncthreads();
    const float sk = p.in[5][hq] * LOG2E;
    const float SC = 0.125f * LOG2E;
#pragma unroll 1
    for (int sb = 0; sb < 4; ++sb) {
        const int pq = q0 + sb * 32;
        bf16x8 qf[4];
        const bf16_t* qrow = Q + (size_t)(b * S_ + pq + r) * 2048 + hq * 64 + 8 * h;
#pragma unroll
        for (int s = 0; s < 4; ++s) qf[s] = *(const bf16x8*)(qrow + 16 * s);
        float mrun = sk, lrun = 1.0f;
        f32x16 o0, o1;
#pragma unroll
        for (int i = 0; i < 16; ++i) { o0[i] = 0.f; o1[i] = 0.f; }
        const int jlo = (qb == 0) ? 4 - sb : 0, jhi = (qb == 15) ? 8 - sb : 9;
        const LAS unsigned char* kp = Kb + (32 * (sb + jlo) + r) * AT_KROW + 16 * h;
        const LAS unsigned char* vp = Vt + r * AT_VROW + (32 * (sb + jlo) + 4 * h) * 2;
        const LAS unsigned char* vq = vp + 32 * AT_VROW;
        const LAS float* lp = lut + 32 * jlo + 32 + 4 * h - r;
#pragma unroll 1
        for (int j = jlo; j < jhi; ++j) {
            asm volatile("" : "+v"(kp), "+v"(vp), "+v"(vq), "+v"(lp));
            f32x16 s;
#pragma unroll
            for (int i = 0; i < 16; ++i) s[i] = 0.f;
#pragma unroll
            for (int ks = 0; ks < 4; ++ks) { const bf16x8 kf = *(const LAS bf16x8*)(kp + 32 * ks); s = __builtin_amdgcn_mfma_f32_32x32x16_bf16(kf, qf[ks], s, 0, 0, 0); }
            float mx = -3.0e38f;
            f32x2 sp[8];
#pragma unroll
            for (int i = 0; i < 8; ++i) { const int li = ((2 * i) & 3) + 8 * ((2 * i) >> 2); const f32x2 lv = {lp[li], lp[li + 1]}; const f32x2 sv = {s[2 * i], s[2 * i + 1]};
                sp[i] = sv * (f32x2){SC, SC} + lv; mx = fmaxf(fmaxf(mx, sp[i][0]), sp[i][1]); }
            mx = fmaxf(mx, __shfl_xor(mx, 32));
            const float mnew = fmaxf(mrun, mx);
            const float alpha = __builtin_amdgcn_exp2f(mrun - mnew);
            f32x2 rs2 = {0.f, 0.f};
#pragma unroll
            for (int i = 0; i < 8; ++i) { const f32x2 d = sp[i] - (f32x2){mnew, mnew}; const f32x2 e = {__builtin_amdgcn_exp2f(d[0]), __builtin_amdgcn_exp2f(d[1])};
                s[2 * i] = e[0]; s[2 * i + 1] = e[1]; rs2 += e; }
            float rs = rs2[0] + rs2[1];
            rs += __shfl_xor(rs, 32);
            lrun = lrun * alpha + rs; mrun = mnew;
            if (__any(alpha != 1.0f)) {
#pragma unroll
                for (int i = 0; i < 16; ++i) { o0[i] *= alpha; o1[i] *= alpha; }
            }
#pragma unroll
            for (int k2 = 0; k2 < 2; ++k2) {
                u32x4 pw; pw.x = cvtpk(s[8 * k2 + 0], s[8 * k2 + 1]); pw.y = cvtpk(s[8 * k2 + 2], s[8 * k2 + 3]); pw.z = cvtpk(s[8 * k2 + 4], s[8 * k2 + 5]); pw.w = cvtpk(s[8 * k2 + 6], s[8 * k2 + 7]);
                const bf16x8 pb = __builtin_bit_cast(bf16x8, pw);
                { const u32x2 lo = *(const LAS u32x2*)(vp + 32 * k2), hi = *(const LAS u32x2*)(vp + 32 * k2 + 16); const u32x4 vw = {lo.x, lo.y, hi.x, hi.y};
                  o0 = __builtin_amdgcn_mfma_f32_32x32x16_bf16(__builtin_bit_cast(bf16x8, vw), pb, o0, 0, 0, 0); }
                { const u32x2 lo = *(const LAS u32x2*)(vq + 32 * k2), hi = *(const LAS u32x2*)(vq + 32 * k2 + 16); const u32x4 vw = {lo.x, lo.y, hi.x, hi.y};
                  o1 = __builtin_amdgcn_mfma_f32_32x32x16_bf16(__builtin_bit_cast(bf16x8, vw), pb, o1, 0, 0, 0); }
            }
            kp += 32 * AT_KROW; vp += 64; vq += 64; lp += 32;
        }
        const float inv = 1.0f / lrun;
        bf16_t* orow = att + (size_t)(b * S_ + pq + r) * 2048 + hq * 64 + 4 * h;
#pragma unroll
        for (int g = 0; g < 4; ++g) {
            u32x2 w0; w0.x = cvtpk(o0[4 * g] * inv, o0[4 * g + 1] * inv); w0.y = cvtpk(o0[4 * g + 2] * inv, o0[4 * g + 3] * inv); *(u32x2*)(orow + 8 * g) = w0;
            u32x2 w1; w1.x = cvtpk(o1[4 * g] * inv, o1[4 * g + 1] * inv); w1.y = cvtpk(o1[4 * g + 2] * inv, o1[4 * g + 3] * inv); *(u32x2*)(orow + 32 + 8 * g) = w1;
        }
    }
}

__device__ __forceinline__ void phase_rows(const Params& p, LAS unsigned char* lds) {
    int tid_ = threadIdx.x; asm volatile("" : "+v"(tid_));
    const int tid = tid_, wave = __builtin_amdgcn_readfirstlane(tid >> 6), lane = tid & 63;
    unsigned char* ws = p.ws;
    const bf16_t* x2 = (const bf16_t*)(ws + WS_X2); bf16_t* h2 = (bf16_t*)(ws + WS_H2);
    LAS float* lg = (LAS float*)lds;
    LAS int* sel_e = (LAS int*)(lds + 8192);
    LAS float* sel_w = (LAS float*)(lds + 9216);
    LAS int* sel_r = (LAS int*)(lds + 10240);
    LAS int* lcnt = (LAS int*)(lds + 11264);
    LAS int* lbase = (LAS int*)(lds + 11392);
    LAS float* rtok = (LAS float*)(lds + 11520);
#pragma unroll 1
    for (int t0 = vwg() * 64; t0 < T_; t0 += 64 * (int)gridDim.x) {
        __syncthreads();
        if (tid < 32) lcnt[tid] = 0;
        for (int i = 0; i < 8; ++i) { const int t = t0 + wave * 8 + i;
            const float r = rms_bfrow_to_bf16(x2 + (size_t)t * DM, p.in[11], (ROUTER_ON_X2 && MOE_F8) ? nullptr : h2 + (size_t)t * DM, lane, MOE_F8 ? (ws + WS_H2Q + (size_t)t * DM) : nullptr);
            if (lane == 0) rtok[wave * 8 + i] = r; }
        asm volatile("s_waitcnt vmcnt(0)" ::: "memory");
        __syncthreads();
        if (wave < 4) {
            const bf16_t* arow = ((ROUTER_ON_X2 && MOE_F8) ? x2 : (const bf16_t*)h2) + (size_t)(t0 + wave * 16 + (lane & 15)) * DM + 8 * (lane >> 4);
            const bf16_t* b0 = (const bf16_t*)(ws + WS_WRT) + (size_t)(lane & 15) * DM + 8 * (lane >> 4);
            const bf16_t* b1 = b0 + (size_t)16 * DM;
            f32x4 a0 = {0.f, 0.f, 0.f, 0.f}, a1 = {0.f, 0.f, 0.f, 0.f};
#pragma unroll 8
            for (int s = 0; s < 64; ++s) { const bf16x8 av = *(const bf16x8*)(arow + 32 * s), bv0 = *(const bf16x8*)(b0 + 32 * s), bv1 = *(const bf16x8*)(b1 + 32 * s);
                a0 = __builtin_amdgcn_mfma_f32_16x16x32_bf16(av, bv0, a0, 0, 0, 0); a1 = __builtin_amdgcn_mfma_f32_16x16x32_bf16(av, bv1, a1, 0, 0, 0); }
            const int ecol = lane & 15; const float bb0 = p.in[13][ecol], bb1 = p.in[13][ecol + 16];
#pragma unroll
            for (int rg = 0; rg < 4; ++rg) { const int tl = wave * 16 + (lane >> 4) * 4 + rg; const float rs = (ROUTER_ON_X2 && MOE_F8) ? rtok[tl] : 1.0f; lg[tl * 32 + ecol] = a0[rg] * rs + bb0; lg[tl * 32 + ecol + 16] = a1[rg] * rs + bb1; }
        }
        __syncthreads();
        if (tid < 64) {
            float v[32];
#pragma unroll
            for (int e = 0; e < 32; ++e) v[e] = lg[tid * 32 + e];
            float tv[4]; int ti[4];
#pragma unroll
            for (int k = 0; k < 4; ++k) { float bv = -3.0e38f; int bi = 0;
#pragma unroll
                for (int e = 0; e < 32; ++e) { const bool tk = v[e] > bv; bv = tk ? v[e] : bv; bi = tk ? e : bi; }
                tv[k] = bv; ti[k] = bi;
#pragma unroll
                for (int e = 0; e < 32; ++e) v[e] = (e == bi) ? -3.0e38f : v[e]; }
            const float e1 = __expf(tv[1] - tv[0]), e2 = __expf(tv[2] - tv[0]), e3 = __expf(tv[3] - tv[0]);
            const float inv = 1.0f / (1.0f + e1 + e2 + e3);
            const float wv[4] = {inv, e1 * inv, e2 * inv, e3 * inv};
#pragma unroll
            for (int k = 0; k < 4; ++k) { sel_e[tid * 4 + k] = ti[k]; sel_w[tid * 4 + k] = wv[k]; sel_r[tid * 4 + k] = __hip_atomic_fetch_add(&lcnt[ti[k]], 1, __ATOMIC_RELAXED, __HIP_MEMORY_SCOPE_WORKGROUP); }
        }
        __syncthreads();
        if (tid < 32) lbase[tid] = (lcnt[tid] > 0) ? atomicAdd((int*)(ws + WS_CTL) + CW_CNT + tid, lcnt[tid]) : 0;
        __syncthreads();
        if (tid < 256) { const int tl = tid >> 2, k = tid & 3, t = t0 + tl; const int e = sel_e[tid], pos = lbase[e] + sel_r[tid]; const float w = sel_w[tid];
            ((int*)(ws + WS_TOKE))[t * 4 + k] = e; ((int*)(ws + WS_TOKPOS))[t * 4 + k] = pos; ((float*)(ws + WS_TOKW))[t * 4 + k] = w;
            ((int*)(ws + WS_LIST))[(size_t)e * T_ + pos] = t; ((float*)(ws + WS_WLIST))[(size_t)e * T_ + pos] = w; }
    }
}
__device__ __forceinline__ void moe_tables(const Params& p, LAS int* pt, LAS int* cn) {
    __syncthreads();
    if (threadIdx.x < 64) {
        const int ln = (int)threadIdx.x; const int* cnt = (const int*)(p.ws + WS_CTL) + CW_CNT;
        const int c = (ln < NE) ? __hip_atomic_load(cnt + (ln & 31), __ATOMIC_RELAXED, __HIP_MEMORY_SCOPE_AGENT) : 0;
        const int tl = (c + 255) >> 8; int inc = tl;
#pragma unroll
        for (int o = 1; o < 32; o <<= 1) { const int v = __shfl_up(inc, o); if (ln >= o) inc += v; }
        if (ln < NE) { cn[ln] = c; pt[ln] = inc - tl; }
        if (ln == NE - 1) pt[NE] = inc;
    }
    __syncthreads();
}
__device__ __forceinline__ void phase_final(const Params& p, const LAS int* pt) {
    int tid_ = threadIdx.x; asm volatile("" : "+v"(tid_));
    const int tid = tid_, wave = tid >> 6, lane = tid & 63;
    const unsigned char* ws = p.ws;
    const bf16_t* x2 = (const bf16_t*)(ws + WS_X2); const bf16_t* ys = (const bf16_t*)(ws + WS_YS);
    const int* toke = (const int*)(ws + WS_TOKE); const int* tokpos = (const int*)(ws + WS_TOKPOS);
    const int gw = vwg() * NWAVE + wave, NGW = (int)gridDim.x * NWAVE;
    float pscale = 1.0f;
    if (PROFSEL != 0) {
        const unsigned long long* pf = (const unsigned long long*)(p.ws + WS_CTL + 32768);
        const float kl = (float)pf[0], ep = (float)pf[1], n = (float)pf[2], ntl = (float)pf[3], cyc = (float)pf[4], wal = (float)pf[5];
        float m = 0.f;
        if (PROFMETRIC == 0) m = ep / (kl + ep);
        if (PROFMETRIC == 1) m = kl / (n * ntl) / 4096.0f;
        if (PROFMETRIC == 2) m = cyc / (wal * 24.0f);
        if (PROFMETRIC == 3) m = (kl + ep) / cyc;
        if (PROFMETRIC == 4) m = n / 32.0f;
        if (PROFMETRIC == 5) m = wal / 100.0f / 200.0f;
        if (PROFMETRIC == 6 || PROFMETRIC == 7) {
            const unsigned long long* st = (const unsigned long long*)(p.ws + WS_CTL + 40960);
            unsigned long long mx = 0, mn = ~0ull, sum = 0;
            for (int i = 0; i < (int)gridDim.x; ++i) { const unsigned long long v = st[i]; mx = v > mx ? v : mx; mn = v < mn ? v : mn; sum += v; }
            const float mean = (float)(sum - mn * gridDim.x) / (float)gridDim.x;
            m = (PROFMETRIC == 6 ? ((float)(mx - mn) - mean) : (float)(mx - mn)) / 100.0f / 200.0f; }
        if (blockIdx.x == 0 && threadIdx.x == 0) { const unsigned long long t0 = wall_clock64(), ticks = (unsigned long long)(m * (float)PROFMUL * 100.0f * 100.0f);
            while (wall_clock64() - t0 < ticks) __builtin_amdgcn_s_sleep(8); }
    }
    for (int t = gw; t < T_; t += NGW) {
        const u32x2* xr = (const u32x2*)(x2 + (size_t)t * DM) + lane;
        f32x4 v[8];
#pragma unroll
        for (int j = 0; j < 8; ++j) { const u32x2 w = xr[64 * j]; v[j] = (f32x4){bflo(w.x), bfhi(w.x), bflo(w.y), bfhi(w.y)}; }
#pragma unroll
        for (int k = 0; k < 4; ++k) { const int e = toke[t * 4 + k]; const size_t slot = (size_t)pt[e] * 256 + tokpos[t * 4 + k];
            if constexpr (MOE_F8) {
                const unsigned* yr = (const unsigned*)((const unsigned char*)ys + slot * DM) + lane;
#pragma unroll
                for (int j = 0; j < 8; ++j) { const unsigned w = yr[64 * j];
                    v[j][0] += __builtin_amdgcn_cvt_f32_fp8((int)w, 0) * YS_INV; v[j][1] += __builtin_amdgcn_cvt_f32_fp8((int)w, 1) * YS_INV;
                    v[j][2] += __builtin_amdgcn_cvt_f32_fp8((int)w, 2) * YS_INV; v[j][3] += __builtin_amdgcn_cvt_f32_fp8((int)w, 3) * YS_INV; }
            } else {
                const u32x2* yr = (const u32x2*)(ys + slot * DM) + lane;
#pragma unroll
                for (int j = 0; j < 8; ++j) { const u32x2 w = yr[64 * j]; v[j][0] += bflo(w.x); v[j][1] += bfhi(w.x); v[j][2] += bflo(w.y); v[j][3] += bfhi(w.y); }
            } }
        float s = 0.f;
#pragma unroll
        for (int j = 0; j < 8; ++j) s += (v[j][0] * v[j][0] + v[j][1] * v[j][1]) + (v[j][2] * v[j][2] + v[j][3] * v[j][3]);
        const float r = rsqrtf(wsum(s) * (1.0f / DM) + 1e-5f);
        const f32x4* gr = (const f32x4*)p.in[18] + lane; f32x4* orow = (f32x4*)(p.out + (size_t)t * DM) + lane;
#pragma unroll
        for (int j = 0; j < 8; ++j) { const f32x4 gg = gr[64 * j]; orow[64 * j] = (f32x4){v[j][0] * r * gg[0] * pscale, v[j][1] * r * gg[1] * pscale, v[j][2] * r * gg[2] * pscale, v[j][3] * r * gg[3] * pscale}; }
    }
}
#ifndef P1_SLOT_BAL
#define P1_SLOT_BAL 1
#endif
#ifndef CV_SPLIT
#define CV_SPLIT 6144L
#endif
#ifndef MOE_SLOT
#define MOE_SLOT 1
#endif
#ifndef X2_SLOT
#define X2_SLOT 0
#endif
#ifndef MOE_SLOT_STEP
#define MOE_SLOT_STEP 4
#endif
#ifndef MOE_SLOT_BAL
#define MOE_SLOT_BAL 4
#endif
#ifndef POOL1
#define POOL1 2
#endif
#ifndef P2ROLE
#define P2ROLE 0
#endif
#ifndef POOL2
#define POOL2 0
#endif
#ifndef POOL3
#define POOL3 0
#endif
#ifndef POOL4
#define POOL4 0
#endif
#ifndef POOL5
#define POOL5 0
#endif
#ifndef Q4
#define Q4 8
#endif
constexpr long GU_A0 = 30 - (POOL1 + POOL2 + POOL3 + POOL4 + POOL5 + Q4);
constexpr long GU_P1S = 64 * (4 * GU_A0 + 8), GU_P1P = GU_P1S, GU_P2P = GU_P1P + 256 * POOL1, GU_P3P = GU_P2P + 256 * POOL2, GU_P4S = GU_P3P + 256 * POOL3,
               GU_P4P = GU_P4S + 256 * Q4, GU_P5P = GU_P4P + 256 * POOL4, GU_END = GU_P5P + 256 * POOL5;
static_assert(GU_END == 8192 && GU_A0 > 0, "gate_up conversion layout");
#ifndef POOL7
#define POOL7 2
#endif
__device__ __forceinline__ void proj_convert_slot(const Params& p, LAS unsigned char* lds, int g, int part) {
    const int wgi = (int)blockIdx.x & 63;
    __syncthreads();
    if constexpr (MOE_F8 && CONV_TILE32) { const long per = CE_TOTAL / 512, a = ((long)(part * 4 + g) * 64 + wgi) * per; convert_experts(p, lds, a, a + per); }
    else { const long total = CV_TOTAL - CV_NONEXP, half = total / 2; long q = half / 4, it0 = CV_NONEXP + half * part + q * g;
        if (P1_SLOT_BAL) {
            constexpr long P1END = (MOE_SLOT ? 8192 : 12288) - 256 * X2_SLOT;
            static_assert((CV_TOTAL - CV_NONEXP) == 12288 && MOE_SLOT == 1 && X2_SLOT == 0, "slot split");
            if (part == 0) { it0 = CV_NONEXP + 64 * GU_A0 * g; q = 64 * (g == 3 ? GU_A0 + 8 : GU_A0); }
            else if (part == 1) { it0 = CV_NONEXP + GU_P4S + 64 * Q4 * g; q = 64 * Q4; }
            else if (part == 2) { it0 = CV_NONEXP + 8192 + 1024 * g; q = 1024; }
            else { it0 = CV_NONEXP + P1END + 64 * X2_SLOT * g; q = 64 * X2_SLOT; } }
        convert_items(p, lds, it0, it0 + q, wgi, 64);
#ifdef DBLCONV
        if (part == (DBLCONV & 3) - 1) { __syncthreads(); convert_items(p, lds, it0, it0 + q, wgi, 64, DBLCONV >> 2); }
#endif
    }
    asm volatile("s_waitcnt vmcnt(0) lgkmcnt(0)" ::: "memory");
    __syncthreads();
}
__device__ __forceinline__ void pool_drain(const Params& p, LAS unsigned char* lds, int pool, long base, int count) {
    __syncthreads();
    convert_items(p, lds, base, base + count, 0, 1, 0, (int*)(p.ws + WS_CTL) + CW_POOL + 64 * pool);
    asm volatile("s_waitcnt vmcnt(0) lgkmcnt(0)" ::: "memory");
    __syncthreads();
}
__device__ __forceinline__ void convert_range_slot(const Params& p, LAS unsigned char* lds, long it0, long n) {
    __syncthreads();
    convert_items(p, lds, it0, it0 + n, 0, 1);
    asm volatile("s_waitcnt vmcnt(0) lgkmcnt(0)" ::: "memory");
    __syncthreads();
}
__device__ __forceinline__ void phase_proj(const Params& p, LAS unsigned char* lds) {
    EpiProj E{p.ws}; EpiGates8 EG{p.ws};
    unsigned long long* prof = PROFSEL == 1 ? (unsigned long long*)(p.ws + WS_CTL + 32768) : nullptr;
    const int BIG = 1 << 20;
    const bool stag = (gridDim.x == 256);
    const int g = stag ? ((int)blockIdx.x >> 6) : -1;
    if constexpr (GATES_F8) {
#ifndef P1SLOTV
#define P1SLOTV 0
#endif
        int a1 = (g == 0) ? 0 : (g == 1 ? 2 : BIG), a3 = (g == 3) ? 3 : BIG, slot = (g <= 1) ? 1 : g;
        if (P1SLOTV == 1) { a1 = BIG; a3 = (g <= 0) ? BIG : 2 * g; slot = (g <= 0) ? 2 : 3; }
        if (P1SLOTV == 2) { a1 = (g == 0) ? 0 : (g == 1 ? 3 : BIG); a3 = (g == 2) ? 1 : (g == 3 ? 4 : BIG); slot = (g <= 1) ? 1 : 3; }
        { SchedProj S{p.ws, 0, a1}; gemm_phase<EpiProj, SchedProj, true>(lds, 2048, LDP, LDP, S, E, nullptr); }
        if (stag && slot == 1) proj_convert_slot(p, lds, g, 0);
        { SchedProj S{p.ws, a1, BIG}; gemm_phase<EpiProj, SchedProj, true>(lds, 2048, LDP, LDP, S, E, prof); }
        if (stag && slot == 2) proj_convert_slot(p, lds, g, 0);
        { SchedGates8 S{p.ws, 0, a3}; gemm_phase<EpiGates8, SchedGates8, true, 1>(lds, 2048, 2048, 2048, S, EG, nullptr); }
        if (stag && slot == 3) proj_convert_slot(p, lds, g, 0);
        { SchedGates8 S{p.ws, a3, BIG}; gemm_phase<EpiGates8, SchedGates8, true, 1>(lds, 2048, 2048, 2048, S, EG, nullptr); }
        if (stag && POOL1 > 0) pool_drain(p, lds, 0, CV_NONEXP + GU_P1P, 256 * POOL1);
    } else {
        const int nb = stag ? 3 * g : 0;
        if (nb > 0) { SchedProj S{p.ws, 0, nb}; gemm_phase<EpiProj, SchedProj, true>(lds, 2048, LDP, LDP, S, E, nullptr); }
        if (stag) proj_convert_slot(p, lds, g, 0);
        { SchedProj S{p.ws, nb, BIG}; gemm_phase<EpiProj, SchedProj, true>(lds, 2048, LDP, LDP, S, E, prof); }
    }
}
__device__ __forceinline__ void phase_mixers(const Params& p, LAS unsigned char* lds) {
    unsigned char* ws = p.ws;
#ifndef DBLSUB
#define DBLSUB 0
#endif
#pragma unroll 1
    for (int rep = 0; rep < ((DBLSUB & 1) ? 2 : 1); ++rep)
#pragma unroll 1
    for (int u = (P2ROLE && gridDim.x == 256) ? (((int)blockIdx.x >> 6) < 3 ? ((int)blockIdx.x & 7) * 24 + ((int)blockIdx.x >> 3) : 512) : vwg(); u < 512; u += (P2ROLE && gridDim.x == 256) ? 192 : (int)gridDim.x)
        attn_unit(p, lds, u >> 6, (u >> 4) & 3, u & 15);
    asm volatile("s_waitcnt vmcnt(0) lgkmcnt(0)" ::: "memory");
    __syncthreads();
#pragma unroll 1
    for (int rep = 0; rep < ((DBLSUB & 2) ? 2 : 1); ++rep)
#pragma unroll 1
    for (int u = vwg(); u < 256; u += (int)gridDim.x) {
        const int mh = u & 3, tb = (u >> 2) & 7, b = (u >> 5) & 7;
        const size_t tok0 = (size_t)b * S_ + (size_t)tb * 256;
        bf16_t* Pt = (bf16_t*)(ws + WS_PM) + tok0 * 1024 + mh * 256;
        SchedOne S1{(const char*)(ws + WS_QM) + (tok0 * 1024 + mh * 256) * 2, (const char*)(ws + WS_KMK) + ((size_t)b * 256 * 1024 + mh * 256) * 2, 0, true};
        EpiMemSoftmax E1{Pt};
        gemm_phase<EpiMemSoftmax, SchedOne, false>(lds, 256, 1024, 1024, S1, E1);
        asm volatile("s_waitcnt vmcnt(0)" ::: "memory");
        __syncthreads();
        SchedOne S2{(const char*)Pt, (const char*)(ws + WS_VMT) + ((size_t)(b * 4 + mh) * 256 * 256) * 2, 0, true};
        EpiTile E2{(bf16_t*)(ws + WS_FX) + tok0 * 2048 + 1024 + mh * 256, 2048};
        gemm_phase<EpiTile, SchedOne, false>(lds, 256, 1024, 256, S2, E2);
        __syncthreads();
    }
    { SchedChan S{ws, 0, 0}; EpiChan E{ws}; gemm_phase<EpiChan, SchedChan, true>(lds, 256, 256, 1024, S, E, PROFSEL == 2 ? (unsigned long long*)(p.ws + WS_CTL + 32768) : nullptr); }
    if (POOL2 > 0 && gridDim.x == 256) pool_drain(p, lds, 2, CV_NONEXP + GU_P2P, 256 * POOL2);
}
__device__ __forceinline__ void phase_seqdft(const Params& p, LAS unsigned char* lds) {
    SchedSeq S{p.ws}; EpiSeq E{p.ws};
    gemm_phase<EpiSeq, SchedSeq, true>(lds, 4096, SQP, SQP, S, E, PROFSEL == 3 ? (unsigned long long*)(p.ws + WS_CTL + 32768) : nullptr);
    if (POOL3 > 0 && gridDim.x == 256) pool_drain(p, lds, 3, CV_NONEXP + GU_P3P, 256 * POOL3);
}
__device__ __forceinline__ void phase_mix(const Params& p, LAS unsigned char* lds) {
    unsigned char* ws = p.ws;
    const bool stag = (gridDim.x == 256); const int g = stag ? ((int)blockIdx.x >> 6) : -1;
    unsigned long long* prof = PROFSEL == 4 ? (unsigned long long*)(p.ws + WS_CTL + 32768) : nullptr;
    EpiMixF E{ws};
#ifndef MIXSLOT
#define MIXSLOT 0x2110
#endif
    const int sp = (g >= 0) ? ((MIXSLOT >> (4 * g)) & 15) : -1;
    if (sp == 0) proj_convert_slot(p, lds, g, 1);
    { SchedMix S{ws, 0, 1}; gemm_phase<EpiMixF, SchedMix, true>(lds, 2048, 2048, 2048, S, E, prof); }
    if (sp == 1) proj_convert_slot(p, lds, g, 1);
    { SchedMix S{ws, 1, 1 << 20}; gemm_phase<EpiMixF, SchedMix, true>(lds, 2048, 2048, 2048, S, E, nullptr); }
    if (sp == 2) proj_convert_slot(p, lds, g, 1);
    if (POOL4 > 0 && stag) pool_drain(p, lds, 4, CV_NONEXP + GU_P4P, 256 * POOL4);
}
__device__ __forceinline__ void phase_x2(const Params& p, LAS unsigned char* lds) {
    unsigned char* ws = p.ws;
    SchedPlain S{(const char*)(ws + WS_MIXED), (const char*)(ws + WS_WOT), (size_t)256 * 2048 * 2, (size_t)256 * 2048 * 2, 64, 8};
    EpiRes E{p.in[0], (bf16_t*)(ws + WS_X2), (const bf16_t*)(ws + WS_H), (const float*)(ws + WS_IRSTD), p.in[3]};
    unsigned long long* prof = PROFSEL == 5 ? (unsigned long long*)(p.ws + WS_CTL + 32768) : nullptr;
    if (X2_SLOT > 0 && MOE_SLOT && gridDim.x == 256) {
        const int g = (int)blockIdx.x >> 6, sp = (0x2110 >> (4 * g)) & 15;
        if (sp == 0) proj_convert_slot(p, lds, g, 3);
        { SchedPlain Sa = S; Sa.r0 = 0; Sa.r1 = 1; gemm_phase<EpiRes, SchedPlain, true>(lds, 2048, 2048, 2048, Sa, E, prof); }
        if (sp == 1) proj_convert_slot(p, lds, g, 3);
        { SchedPlain Sb = S; Sb.r0 = 1; gemm_phase<EpiRes, SchedPlain, true>(lds, 2048, 2048, 2048, Sb, E, nullptr); }
        if (sp == 2) proj_convert_slot(p, lds, g, 3);
    } else gemm_phase<EpiRes, SchedPlain, true>(lds, 2048, 2048, 2048, S, E, prof);
    if (POOL5 > 0 && gridDim.x == 256) pool_drain(p, lds, 5, CV_NONEXP + GU_P5P, 256 * POOL5);
}
template <class Sched> __device__ __forceinline__ void moe_fill_tokl(const Params& p, LAS unsigned char* lds, const Sched& S, const LAS int* cn) {
    LAS unsigned short* tokl = (LAS unsigned short*)(lds + LDS_TOKL);
    const int* list = (const int*)(p.ws + WS_LIST);
    const int tid = threadIdx.x, half = tid >> 8, c = tid & 255;
    int tok[10]; bool val[10];
#pragma unroll
    for (int j = 0; j < 10; ++j) { Unit u; val[j] = S.next(2 * j + half, u); tok[j] = 0;
        if (val[j]) { const int cnt = cn[u.z]; int pos = u.pm * 256 + c; pos = pos < cnt ? pos : cnt - 1; tok[j] = list[(size_t)u.z * T_ + pos]; } }
#pragma unroll
    for (int j = 0; j < 10; ++j) if (val[j]) tokl[(2 * j + half) * 256 + c] = (unsigned short)tok[j];
    __syncthreads();
}
template <class Sched, bool WTAB> __device__ __forceinline__ void moe_fill_tabs(const Params& p, LAS unsigned char* lds, const Sched& S, const LAS int* cn, const float* bias, int ncol) {
    LAS float* btab = (LAS float*)(lds + LDS_BTAB); LAS float* wtab = (LAS float*)(lds + LDS_TOKL);
    const float* wl = (const float*)(p.ws + WS_WLIST);
    const int tid = threadIdx.x, half = tid >> 8, c = tid & 255;
    constexpr int NP = WTAB ? 5 : 10;
    float bv[NP], wv[NP]; bool val[NP];
#pragma unroll
    for (int j = 0; j < NP; ++j) { Unit u; val[j] = S.next(2 * j + half, u); bv[j] = 0.f; wv[j] = 0.f;
        if (val[j]) { bv[j] = bias[(size_t)u.z * ncol + u.pn * 256 + c];
            if constexpr (WTAB) { const int pos = u.pm * 256 + c; if (pos < cn[u.z]) wv[j] = wl[(size_t)u.z * T_ + pos] * YS_SCALE; } } }
#pragma unroll
    for (int j = 0; j < NP; ++j) if (val[j]) { btab[(2 * j + half) * 256 + c] = bv[j]; if constexpr (WTAB) wtab[(2 * j + half) * 256 + c] = wv[j]; }
    __syncthreads();
}
__device__ __forceinline__ void phase_gateup(const Params& p, LAS unsigned char* lds) {
    LAS int* pt = (LAS int*)(lds + LDS_MISC); LAS int* cn = pt + 64;
    moe_tables(p, pt, cn);
    if constexpr (MOE_F8) { SchedMoe<true, 16, true> S{p.ws, pt, cn}; EpiSwiglu8 E{p.ws, p.in[15], pt}; moe_fill_tokl(p, lds, S, cn); moe_fill_tabs<SchedMoe<true, 16, true>, false>(p, lds, S, cn, p.in[15], 4096);
        unsigned long long* prof = PROFSEL == 7 ? (unsigned long long*)(p.ws + WS_CTL + 32768) : nullptr;
        const bool stag = MOE_SLOT && (gridDim.x == 256);
        if (stag) {
            const int g = (int)blockIdx.x >> 6, a = MOE_SLOT_STEP * g;
            if (a > 0) { SchedMoe<true, 16, true> Sa{p.ws, pt, cn, 0, 0, a}; gemm_phase<EpiSwiglu8, SchedMoe<true, 16, true>, MOE_ALIGN, 1>(lds, 2048, 2048, 2048, Sa, E, nullptr); }
            if constexpr (MOE_SLOT_BAL) {
                const int U = S.ptu(NE) * 16, rmax = (U + 255) >> 8, me = (int)blockIdx.x & 63;
                int totd = 0, dme = 0, dbefore = 0;
#pragma unroll 1
                for (int i = 0; i < 64; ++i) { const int c = 64 * g + i, v = (c & 7) * 32 + (c >> 3); const int r = (v < U) ? ((U - v + 255) >> 8) : 0; int d = rmax - r;
#ifdef MOE_BAL_TEST
                    d = (i * 7 + g) % 3 == 0 ? 1 : 0;
#endif
                    totd += d; if (i < me) dbefore += d; if (i == me) dme = d; }
                constexpr int GT = 1024 - 64 * POOL7;
                const int n0 = (GT - MOE_SLOT_BAL * totd) / 64, rem = GT - 64 * n0 - MOE_SLOT_BAL * totd;
                const long base = CV_NONEXP + 8192 + (long)GT * g;
                const int xs = 64 * n0 + MOE_SLOT_BAL * dbefore + (me < rem ? me : rem), xn = MOE_SLOT_BAL * dme + (me < rem ? 1 : 0);
                __syncthreads();
                convert_items(p, lds, base, base + 64 * n0, me, 64);
                if (xn > 0) convert_items(p, lds, base + xs, base + xs + xn, 0, 1);
                asm volatile("s_waitcnt vmcnt(0) lgkmcnt(0)" ::: "memory");
                __syncthreads();
            } else proj_convert_slot(p, lds, g, 2);
            moe_fill_tokl(p, lds, S, cn);
            SchedMoe<true, 16, true> Sb{p.ws, pt, cn, 0, a, 1 << 20}; gemm_phase<EpiSwiglu8, SchedMoe<true, 16, true>, MOE_ALIGN, 1>(lds, 2048, 2048, 2048, Sb, E, prof);
            if (POOL7 > 0) pool_drain(p, lds, 1, CV_NONEXP + 12288 - 256 * POOL7, 256 * POOL7);
        } else gemm_phase<EpiSwiglu8, SchedMoe<true, 16, true>, MOE_ALIGN, 1>(lds, 2048, 2048, 2048, S, E, prof); }
    else { SchedMoe<true, 16, false> S{p.ws, pt, cn}; EpiSwiglu E{p.ws, p.in[15], pt}; moe_fill_tokl(p, lds, S, cn);
        gemm_phase<EpiSwiglu, SchedMoe<true, 16, false>, true>(lds, 2048, 2048, 2048, S, E); }
}
__device__ __forceinline__ void phase_down(const Params& p, LAS unsigned char* lds) {
    LAS int* pt = (LAS int*)(lds + LDS_MISC); LAS int* cn = pt + 64;
    moe_tables(p, pt, cn);
    if constexpr (MOE_F8) { SchedMoe<false, 8, true> S{p.ws, pt, cn}; EpiDown8 E{p.ws, p.in[17], pt, cn}; moe_fill_tabs<SchedMoe<false, 8, true>, true>(p, lds, S, cn, p.in[17], 2048); gemm_phase<EpiDown8, SchedMoe<false, 8, true>, MOE_ALIGN, 1>(lds, 2048, 2048, 2048, S, E, PROFSEL == 8 ? (unsigned long long*)(p.ws + WS_CTL + 32768) : nullptr); }
    else { SchedMoe<false, 8, false> S{p.ws, pt, cn}; EpiDown E{p.ws, p.in[17], pt, cn}; gemm_phase<EpiDown, SchedMoe<false, 8, false>, true>(lds, 2048, 2048, 2048, S, E); }
#ifdef SHADOW
    if constexpr (MOE_F8) { __syncthreads(); SchedMoe<false, 8, true> S{p.ws, pt, cn, SHADOW - 1}; EpiDown8 E{p.ws, p.in[17], pt, cn, (WS_FAST_END + 4095) & ~(size_t)4095};
        gemm_phase<EpiDown8, SchedMoe<false, 8, true>, MOE_ALIGN, 1>(lds, 2048, 2048, 2048, S, E, nullptr); }
#endif
}
__device__ __forceinline__ void phase_out(const Params& p, LAS unsigned char* lds) {
    LAS int* pt = (LAS int*)(lds + LDS_MISC); LAS int* cn = pt + 64;
    moe_tables(p, pt, cn);
    phase_final(p, pt);
}

template <int PH> __global__ void __launch_bounds__(NTHR, 2) k_phase(Params p) {
    extern __shared__ __attribute__((aligned(16))) unsigned char lds_raw[];
    LAS unsigned char* lds = (LAS unsigned char*)lds_raw;
    if constexpr (PH == 0) phase_prologue(p, lds);
    if constexpr (PH == 1) phase_proj(p, lds);
    if constexpr (PH == 2) phase_mixers(p, lds);
    if constexpr (PH == 3) phase_seqdft(p, lds);
    if constexpr (PH == 4) phase_mix(p, lds);
    if constexpr (PH == 5) phase_x2(p, lds);
    if constexpr (PH == 6) phase_rows(p, lds);
    if constexpr (PH == 7) phase_gateup(p, lds);
    if constexpr (PH == 8) phase_down(p, lds);
    if constexpr (PH == 9) phase_out(p, lds);
}
template <int PH> static void launch_phase(const Params& p, hipStream_t st) {
    static bool attr_done = false;
    if (!attr_done) { (void)hipFuncSetAttribute((const void*)k_phase<PH>, hipFuncAttributeMaxDynamicSharedMemorySize, LDS_BYTES); attr_done = true; }
    hipLaunchKernelGGL(k_phase<PH>, dim3(256), dim3(NTHR), LDS_BYTES, st, p);
}
static void run_fast_multi(const Params& p, hipStream_t st, int lo, int hi) {
    if (lo <= 0 && 0 < hi) launch_phase<0>(p, st);
    if (lo <= 1 && 1 < hi) launch_phase<1>(p, st);
    if (lo <= 2 && 2 < hi) launch_phase<2>(p, st);
    if (lo <= 3 && 3 < hi) launch_phase<3>(p, st);
    if (lo <= 4 && 4 < hi) launch_phase<4>(p, st);
    if (lo <= 5 && 5 < hi) launch_phase<5>(p, st);
    if (lo <= 6 && 6 < hi) launch_phase<6>(p, st);
    if (lo <= 7 && 7 < hi) launch_phase<7>(p, st);
    if (lo <= 8 && 8 < hi) launch_phase<8>(p, st);
    if (lo <= 9 && 9 < hi) launch_phase<9>(p, st);
}
#define XB_TMO      128
#define XB_XCNT(j)  (256  + 64 * (j))
#define XB_XSUB(j)  (1280 + 64 * (j))
#define XB_XGEN(j)  (2304 + 64 * (j))
#define XB_TOP      3328
#define XB_TOPGEN   3392
#define XCD_BAR_WORDS 3456
#define XB_SPIN_CAP (1u << 18)

__device__ __forceinline__ unsigned xb_ld(unsigned* p)              { return __hip_atomic_load(p, __ATOMIC_RELAXED, __HIP_MEMORY_SCOPE_AGENT); }
__device__ __forceinline__ unsigned xb_add(unsigned* p, unsigned v) { return __hip_atomic_fetch_add(p, v, __ATOMIC_RELAXED, __HIP_MEMORY_SCOPE_AGENT); }
__device__ __forceinline__ unsigned xb_xcc_id() { return (unsigned)__builtin_amdgcn_s_getreg((3 << 11) | 20) & 0xFu; }
#define XB_SPIN(cond, bar) do { unsigned _sp = 0; while (cond) { __builtin_amdgcn_s_sleep(1); \
    if ((++_sp & 255u) == 0u) { if (xb_ld(&(bar)[XB_TMO])) break; if (_sp > XB_SPIN_CAP) { atomicAdd(&(bar)[XB_TMO], 1u); break; } } } } while (0)

struct XcdBarrier {
    unsigned* bar; unsigned x;
    volatile LAS unsigned* st;
};

__device__ __forceinline__ XcdBarrier xcd_barrier_post(unsigned* bar, volatile LAS unsigned* st) {
    XcdBarrier b; b.bar = bar; b.x = xb_xcc_id(); b.st = st;
    if (threadIdx.x == 0) (void)xb_add(&bar[XB_XCNT(b.x)], 1u);
    return b;
}
__device__ __forceinline__ void xcd_barrier_complete(unsigned* bar, unsigned x, unsigned& nloc, unsigned& nx) {
    const unsigned G = gridDim.x * gridDim.y * gridDim.z;
    unsigned sum, cnt, mine, sp = 0u;
    for (;;) {
        sum = 0u; cnt = 0u; mine = 0u;
#pragma unroll
        for (unsigned j = 0; j < 16; ++j) { const unsigned c = xb_ld(&bar[XB_XCNT(j)]); sum += c; cnt += (c > 0u) ? 1u : 0u; mine = (j == x) ? c : mine; }
        if (sum == G) break;
        __builtin_amdgcn_s_sleep(1);
        if ((++sp & 255u) == 0u) { if (xb_ld(&bar[XB_TMO])) break; if (sp > XB_SPIN_CAP) { atomicAdd(&bar[XB_TMO], 1u); break; } }
    }
    nloc = mine > 0u ? mine : 1u; nx = cnt > 0u ? cnt : 1u;
}

__device__ __forceinline__ void xcd_barrier(const XcdBarrier& b) {
    asm volatile("s_waitcnt vmcnt(0)" ::: "memory");
    __syncthreads();
    if (threadIdx.x == 0) {
        unsigned* bar = b.bar;
        __builtin_amdgcn_s_waitcnt(0);
        unsigned nloc = b.st[0], nx = b.st[1];
        if (nloc == 0u) { xcd_barrier_complete(bar, b.x, nloc, nx); b.st[0] = nloc; b.st[1] = nx; }
        const unsigned old = xb_add(&bar[XB_XSUB(b.x)], 1u);
        const unsigned gen = old / nloc;
        if (old + 1u == (gen + 1u) * nloc) {
            __builtin_amdgcn_fence(__ATOMIC_RELEASE, "agent");
            asm volatile("s_waitcnt vmcnt(0)" ::: "memory");
            const unsigned og = xb_add(&bar[XB_TOP], 1u);
            const unsigned tg = og / nx;
            if (og + 1u == (tg + 1u) * nx) xb_add(&bar[XB_TOPGEN], 1u);
            else XB_SPIN(xb_ld(&bar[XB_TOPGEN]) == tg, bar);
            __builtin_amdgcn_fence(__ATOMIC_ACQUIRE, "agent");
            xb_add(&bar[XB_XGEN(b.x)], 1u);
            asm volatile("s_waitcnt vmcnt(0)" ::: "memory");
        } else {
            XB_SPIN(xb_ld(&bar[XB_XGEN(b.x)]) == gen, bar);
            __builtin_amdgcn_fence(__ATOMIC_ACQUIRE, "agent");
            asm volatile("s_waitcnt vmcnt(0)" ::: "memory");
        }
    }
    __syncthreads();
}

__global__ void __launch_bounds__(NTHR, 2) mega_fwd(Params p) {
    extern __shared__ __attribute__((aligned(16))) unsigned char lds_raw[];
    LAS unsigned char* lds = (LAS unsigned char*)lds_raw;
    volatile LAS unsigned* xbw = (volatile LAS unsigned*)(lds + LDS_XBW);
    if (threadIdx.x < 4) xbw[threadIdx.x] = 0u;
    __syncthreads();
    XcdBarrier bar = xcd_barrier_post((unsigned*)(p.ws + WS_CTL) + CW_BAR, xbw);
#ifndef DBL
#define DBL 0
#endif
#ifndef SKEWPH
#define SKEWPH -1
#endif
#define RUNPH(i, call) do { call; if constexpr ((DBL >> (i)) & 1) { xcd_barrier(bar); call; } \
    if constexpr (SKEWPH == (i)) { if (threadIdx.x == 0) ((unsigned long long*)(p.ws + WS_CTL + 40960))[blockIdx.x] = wall_clock64(); } } while (0)
    RUNPH(0, phase_prologue(p, lds));  xcd_barrier(bar);
    RUNPH(1, phase_proj(p, lds));      xcd_barrier(bar);
    RUNPH(2, phase_mixers(p, lds));    xcd_barrier(bar);
    RUNPH(3, phase_seqdft(p, lds));    xcd_barrier(bar);
    RUNPH(4, phase_mix(p, lds));       xcd_barrier(bar);
    RUNPH(5, phase_x2(p, lds));        xcd_barrier(bar);
    phase_rows(p, lds);                xcd_barrier(bar);
    RUNPH(7, phase_gateup(p, lds));    xcd_barrier(bar);
    RUNPH(8, phase_down(p, lds));      xcd_barrier(bar);
    phase_out(p, lds);
}
static void run_fast_one(const Params& p, hipStream_t st) {
    static int grid = 0;
    if (!grid) {
        int dev = 0, cus = 0, per_cu = 0;
        (void)hipGetDevice(&dev); (void)hipDeviceGetAttribute(&cus, hipDeviceAttributeMultiprocessorCount, dev);
        (void)hipFuncSetAttribute((const void*)mega_fwd, hipFuncAttributeMaxDynamicSharedMemorySize, LDS_BYTES);
        (void)hipOccupancyMaxActiveBlocksPerMultiprocessor(&per_cu, (const void*)mega_fwd, NTHR, LDS_BYTES);
        if (per_cu < 1) per_cu = 1;
        grid = cus > 256 ? 256 : cus;
        grid &= ~7; if (grid < 8) grid = 8;
    }
    hipLaunchKernelGGL(mega_fwd, dim3(grid), dim3(NTHR), LDS_BYTES, st, p);
}
}
#ifndef REPORT
#define REPORT 0
#endif
extern "C" void kernel_launch(void* const* d_in, const int* in_sizes, int n_in, void* d_out, int out_size, void* d_ws, size_t ws_size, hipStream_t stream) {
    (void)in_sizes; (void)n_in; (void)out_size; (void)ws_size;
    unsigned char* ws = (unsigned char*)d_ws;
#if MODE == 0
    nv::NBuf nb; nv::carve(nb, ws);
    nv::run_part1(d_in, nb, stream); nv::run_part2(d_in, nb, (float*)d_out, stream);
#elif MODE == 1
    constexpr size_t NAIVE_BASE = (fx::WS_FAST_END + 4095) & ~(size_t)4095;
    nv::NBuf nb; const size_t nbytes = nv::carve(nb, ws + NAIVE_BASE);
    float* fout = (float*)(ws + NAIVE_BASE + ((nbytes + 4095) & ~(size_t)4095));
    double* acc = (double*)(fout + (size_t)16384 * 2048); float* scale = (float*)(acc + 64);
    fx::Params p; memset(&p, 0, sizeof(p));
    for (int i = 0; i < 19; ++i) p.in[i] = (const float*)d_in[i];
    p.out = fout; p.ws = ws;
    (void)hipMemsetAsync(ws + fx::WS_CTL, 0, fx::CTL_BYTES, stream);
    (void)hipMemsetAsync(acc, 0, 1024, stream);
    nv::run_part1(d_in, nb, stream);
    fx::run_fast_multi(p, stream, 0, 7);
    auto cmp = [&](int slot, int kind, const void* a, const float* ref, long long n, int w, int ldf, int ldr, int off, int sig) {
        ck::CP c; memset(&c, 0, sizeof(c)); c.a = a; c.ref = ref; c.n = n; c.kind = kind; c.w = w; c.ldf = ldf; c.ldr = ldr; c.off = off; c.sig = sig; c.slot = slot;
        hipLaunchKernelGGL(ck::k_cmp, dim3(2048), dim3(256), 0, stream, c, acc); };
    const long long T = 16384;
    cmp(0, 0, ws + fx::WS_FIN, nb.proj, T * 1024, 1024, 1024, 10752, 0, 0);
    cmp(1, 0, ws + fx::WS_Q, nb.proj, T * 2048, 2048, 2048, 10752, 1024, 0);
    cmp(2, 0, ws + fx::WS_K, nb.proj, T * 256, 256, 256, 10752, 3072, 0);
    cmp(3, 2, ws + fx::WS_VT, nb.proj, T * 256, 0, 0, 0, 0, 0);
    cmp(4, 0, ws + fx::WS_QM, nb.proj, T * 1024, 1024, 1024, 10752, 3584, 0);
    cmp(5, 0, ws + fx::WS_GATES, nb.proj, T * 6144, 6144, 6144, 10752, 4608, 1);
    cmp(6, 0, ws + fx::WS_KMK, nb.kvm, 2048LL * 1024, 1024, 1024, 2048, 0, 0);
    cmp(7, 3, ws + fx::WS_VMT, nb.kvm, 2048LL * 1024, 0, 0, 0, 0, 0);
    cmp(8, 0, ws + fx::WS_ATT, nb.att, T * 2048, 2048, 2048, 2048, 0, 0);
    cmp(9, 0, ws + fx::WS_XM, nb.xm, T * 1024, 1024, 1024, 1024, 0, 0);
    cmp(10, 0, ws + fx::WS_FM, nb.fm, T * 1024, 1024, 1024, 1024, 0, 0);
    cmp(11, 0, ws + fx::WS_MIXED, nb.mixed, T * 2048, 2048, 2048, 2048, 0, 0);
    cmp(12, 1, ws + fx::WS_X2, nb.x2, T * 2048, 2048, 2048, 2048, 0, 0);
    cmp(13, 0, ws + fx::WS_H2, nb.h2, T * 2048, 2048, 2048, 2048, 0, 0);
    hipLaunchKernelGGL(ck::k_cmp_route, dim3(64), dim3(256), 0, stream, (const int*)(ws + fx::WS_TOKE), (const int*)nb.tope, acc, 14);
    nv::run_part2(d_in, nb, nb.nout, stream);
    fx::run_fast_multi(p, stream, 7, 10);
    cmp(15, 1, fout, nb.nout, T * 2048, 2048, 2048, 2048, 0, 0);
    hipLaunchKernelGGL(ck::k_verdict, dim3(1), dim3(64), 0, stream, (const double*)acc, scale, 16, (int)REPORT);
    hipLaunchKernelGGL(ck::k_scale_out, dim3(2048), dim3(256), 0, stream, (const float*)nb.nout, (const float*)scale, (float*)d_out, T * 2048);
#elif MODE == 2
    fx::Params p; memset(&p, 0, sizeof(p));
    for (int i = 0; i < 19; ++i) p.in[i] = (const float*)d_in[i];
    p.out = (float*)d_out; p.ws = ws;
    (void)hipMemsetAsync(ws + fx::WS_CTL, 0, fx::CTL_BYTES, stream);
    fx::run_fast_multi(p, stream, 0, 10);
#elif MODE == 3
    fx::Params p; memset(&p, 0, sizeof(p));
    for (int i = 0; i < 19; ++i) p.in[i] = (const float*)d_in[i];
    p.out = (float*)d_out; p.ws = ws;
    (void)hipMemsetAsync(ws + fx::WS_CTL, 0, fx::CTL_BYTES, stream);
    fx::run_fast_one(p, stream);
#endif
}
```

```cpp
#include <hip/hip_runtime.h>
#include <stdint.h>
#include <string.h>
#ifndef MODE
#define MODE 3
#endif
namespace fx {
#define LAS __attribute__((address_space(3)))
typedef unsigned short bf16_t;
typedef short bf16x8 __attribute__((ext_vector_type(8)));
typedef short s16x4 __attribute__((ext_vector_type(4)));
typedef float f32x4 __attribute__((ext_vector_type(4)));
typedef float f32x16 __attribute__((ext_vector_type(16)));
typedef float f32x2 __attribute__((ext_vector_type(2)));
typedef __bf16 bf16x2_t __attribute__((ext_vector_type(2)));
typedef unsigned u32x4 __attribute__((ext_vector_type(4)));
typedef unsigned u32x2 __attribute__((ext_vector_type(2)));

constexpr int NTHR = 512, NWAVE = 8;
constexpr int B_ = 8, S_ = 2048, DM = 2048, T_ = B_ * S_;
constexpr int MEM = 256, FW = 1024, FG = 4, FGD = 256;
constexpr int NH = 32, NKV = 4, HD = 64, AW = 2048, KVW = 256, WIN = 128;
constexpr int MH = 4, MHD = 256, MW = 1024;
constexpr int NE = 32, TOPK = 4, DFF = 2048;
constexpr int INW = 10752;
#ifndef LDPAD
#define LDPAD 0
#endif
#ifndef ROUTER_ON_X2
#define ROUTER_ON_X2 1
#endif
#ifndef SQPAD
#define SQPAD 0
#endif
constexpr int LDP = 2048 + LDPAD;
constexpr int NSLOT = T_ * TOPK + NE * 256;
constexpr float LOG2E = 1.4426950408889634f;
#ifndef MOE_FP8
#define MOE_FP8 1
#endif
constexpr bool MOE_F8 = (MOE_FP8 != 0);
#ifndef GATES_FP8
#define GATES_FP8 1
#endif
constexpr bool GATES_F8 = (GATES_FP8 != 0);
#ifndef CONV_TILE32
#define CONV_TILE32 0
#endif
#ifndef MOE_ALIGN
#define MOE_ALIGN true
#endif
#ifndef PROFSEL
#define PROFSEL 0
#endif
#ifndef PROFMETRIC
#define PROFMETRIC 0
#endif
#ifndef PROFMUL
#define PROFMUL 1
#endif
#ifndef PROFBLK
#define PROFBLK 0
#endif

constexpr size_t al256(size_t x) { return (x + 255) & ~(size_t)255; }
constexpr size_t WS_CTL = 0, CTL_BYTES = 65536;
constexpr size_t WS_WINT = 1u << 20;
constexpr size_t WS_WMKVT = WS_WINT + (size_t)INW * LDP * 2;
constexpr size_t WS_WFOT = WS_WMKVT + (size_t)2048 * LDP * 2;
constexpr size_t WS_WAOT = WS_WFOT + (size_t)2048 * 1024 * 2;
constexpr size_t WS_WMOT = WS_WAOT + (size_t)2048 * 2048 * 2;
constexpr size_t WS_WOT = WS_WMOT + (size_t)2048 * 1024 * 2;
constexpr size_t WS_WRT = WS_WOT + (size_t)2048 * 2048 * 2;
constexpr size_t WS_TABT = WS_WRT + (size_t)NE * DM * 2;
constexpr size_t WS_DMAT = WS_TABT + (size_t)512 * 256 * 2;
constexpr int SQP = 4096 + SQPAD;
constexpr size_t WS_WGUT = WS_DMAT + (size_t)2048 * SQP * 2;
constexpr size_t WS_WDNT = WS_WGUT + (size_t)NE * 4096 * 2048 * 2;
constexpr size_t WS_H = WS_WDNT + (size_t)NE * 2048 * 2048 * 2;
constexpr size_t WS_MEMBF = WS_H + (size_t)T_ * LDP * 2;
constexpr size_t WS_FIN = WS_MEMBF + (size_t)2048 * LDP * 2;
constexpr size_t WS_Q = WS_FIN + (size_t)T_ * FW * 2;
constexpr size_t WS_K = WS_Q + (size_t)T_ * AW * 2;
constexpr size_t WS_VT = WS_K + (size_t)T_ * KVW * 2;
constexpr size_t WS_QM = WS_VT + (size_t)T_ * KVW * 2;
constexpr size_t WS_GATES = WS_QM + (size_t)T_ * MW * 2;
constexpr size_t WS_KMK = WS_GATES + (size_t)T_ * 3 * DM * 2;
constexpr size_t WS_VMT = WS_KMK + (size_t)2048 * 1024 * 2;
constexpr size_t WS_ZT = WS_VMT + (size_t)2048 * 1024 * 2;
constexpr size_t WS_FM = WS_ZT + (size_t)32 * 256 * SQP * 2;
constexpr size_t WS_ATT = WS_FM + (size_t)T_ * FW * 2;
constexpr size_t WS_PM = WS_ATT + (size_t)T_ * AW * 2;
constexpr size_t WS_XM = WS_PM + (size_t)T_ * MH * 256 * 2;
constexpr size_t WS_MIXACC = WS_XM + (size_t)T_ * MW * 2;
constexpr size_t WS_MIXED = WS_MIXACC + (size_t)T_ * DM * 4;
constexpr size_t WS_FX = WS_MIXACC;
constexpr size_t WS_WFM = WS_MIXACC + (size_t)T_ * 2048 * 2;
constexpr size_t WS_IRSTD = WS_WFM + (size_t)2048 * 2048 * 2;
static_assert(WS_IRSTD + (size_t)T_ * 4 <= WS_MIXED, "fused-mix operands fit the old mixacc region");
constexpr size_t WS_X2 = WS_MIXED + (size_t)T_ * DM * 2;
constexpr size_t WS_H2 = WS_X2 + (size_t)T_ * DM * 4;
constexpr size_t WS_TOKE = WS_H2 + (size_t)T_ * DM * 2;
constexpr size_t WS_TOKPOS = WS_TOKE + (size_t)T_ * 4 * 4;
constexpr size_t WS_TOKW = WS_TOKPOS + (size_t)T_ * 4 * 4;
constexpr size_t WS_LIST = WS_TOKW + (size_t)T_ * 4 * 4;
constexpr size_t WS_WLIST = WS_LIST + (size_t)NE * T_ * 4;
constexpr size_t WS_WGUQ = WS_WLIST + (size_t)NE * T_ * 4;
constexpr size_t WS_WDNQ = WS_WGUQ + (size_t)NE * 4096 * 2048;
constexpr size_t WS_H2Q = WS_WDNQ + (size_t)NE * 2048 * 2048;
constexpr size_t WS_H8 = WS_H2Q + (size_t)T_ * DM;
constexpr size_t WS_WINQ = WS_H8 + (size_t)T_ * DM;
constexpr size_t WS_FAST_END = WS_WINQ + (size_t)6144 * DM;
constexpr size_t WS_ACTQ = WS_H;
constexpr float WQ_SCALE = 32.0f, WQ_INV = 1.0f / 32.0f;
constexpr float YS_SCALE = 16.0f, YS_INV = 1.0f / 16.0f;
constexpr size_t WS_ACT = WS_H;
constexpr size_t WS_YS = WS_ACT + (size_t)NSLOT * DFF * 2;
static_assert(WS_YS + (size_t)NSLOT * DM * 2 <= WS_MIXED, "overlay fits");
constexpr int CW_CNT = 0;
constexpr int CW_POOL = 64;
constexpr int CW_BAR = 4096;

constexpr int LDS_STAGE = 0, STAGE_BYTES = 131072;
constexpr int LDS_TOKL = 131072;
constexpr int LDS_MISC = 141312;
constexpr int LDS_BTAB = 142336;
constexpr int LDS_XBW = 163824;
constexpr int LDS_BYTES = 163840;

struct Params {
    const float* in[19]; float* out; unsigned char* ws;
};

__device__ __forceinline__ unsigned cvtpk(float lo, float hi) { f32x2 v = {lo, hi}; bf16x2_t b = __builtin_convertvector(v, bf16x2_t); return __builtin_bit_cast(unsigned, b); }
__device__ __forceinline__ float bf2f(unsigned short x) { return __uint_as_float(((unsigned)x) << 16); }
__device__ __forceinline__ float bflo(unsigned w) { return __uint_as_float(w << 16); }
__device__ __forceinline__ float bfhi(unsigned w) { return __uint_as_float(w & 0xffff0000u); }
__device__ __forceinline__ float wsum(float v) {
#pragma unroll
    for (int o = 1; o < 64; o <<= 1) v += __shfl_xor(v, o);
    return v;
}
__device__ __forceinline__ float sigmoid_sc(float x, float nsc) { return __builtin_amdgcn_rcpf(1.0f + __builtin_amdgcn_exp2f(x * nsc)); }
__device__ __forceinline__ float sigmoidf_(float x) { return __builtin_amdgcn_rcpf(1.0f + __builtin_amdgcn_exp2f(-x * LOG2E)); }
__device__ __forceinline__ int crow(int r, int h) { return (r & 3) + 8 * (r >> 2) + 4 * h; }
__device__ __forceinline__ int t5_bucket(int rel) {
    const int n = rel < 0 ? -rel : rel;
    int b;
    if (n < 8) b = n; else if (n < 12) b = 8; else if (n < 16) b = 9; else if (n < 23) b = 10; else if (n < 32) b = 11;
    else if (n < 46) b = 12; else if (n < 64) b = 13; else if (n < 91) b = 14; else b = 15;
    return (rel > 0 ? 16 : 0) + b;
}
__device__ __forceinline__ int vwg() { const int c = blockIdx.x, G = gridDim.x; return ((G & 7) == 0) ? (c & 7) * (G >> 3) + (c >> 3) : c; }

constexpr int BM = 256, BK = 64, HALF = 128, HTB = HALF * BK * 2;
__host__ __device__ __forceinline__ int lds_byte(int r, int c) { const int st = (r >> 4) * 2 + (c >> 5), rr = r & 15, cc = c & 31, ob = rr * 64 + cc * 2; return st * 1024 + (ob ^ (((ob >> 9) & 1) << 5)); }
__host__ __device__ __forceinline__ void stage_rc(int b, int& R, int& C) { const int st = b / 1024, sb = b % 1024, swz = sb ^ (((sb >> 9) & 1) << 5); R = (st >> 1) * 16 + swz / 64; C = (st & 1) * 32 + (swz % 64) / 2; }
__host__ __device__ __forceinline__ int perm32(int rho) { const int n = rho >> 4, i = rho & 15; return 8 * (i >> 2) + 4 * n + (i & 3); }

struct Unit { int pm, pn, z, idx; };
template <class S, class = void> struct SchedVarK { static constexpr bool v = false; };
template <class S> struct SchedVarK<S, decltype((void)S::VARK)> { static constexpr bool v = S::VARK; };
template <class E, class = void> struct EpiTouch { static constexpr bool v = false; };
template <class E> struct EpiTouch<E, decltype((void)E::TOUCH)> { static constexpr bool v = E::TOUCH; };
template <class E, class = void> struct EpiKeep { static constexpr bool v = false; };
template <class E> struct EpiKeep<E, decltype((void)E::KEEP)> { static constexpr bool v = E::KEEP; };
typedef int v4i_t __attribute__((ext_vector_type(4)));
typedef int v8i_t __attribute__((ext_vector_type(8)));
__device__ __forceinline__ void mfma_f8(f32x4& c, const v8i_t& a, const v8i_t& b) { asm volatile("v_mfma_f32_16x16x128_f8f6f4 %0, %1, %2, %0" : "+v"(c) : "v"(a), "v"(b)); }
template <int ESZ> struct FragT;
template <> struct FragT<2> { struct A4 { bf16x8 v[4][2]; }; struct B2 { bf16x8 v[2][2]; }; };
template <> struct FragT<1> { struct A4 { v8i_t v[4]; }; struct B2 { v8i_t v[2]; }; };
__device__ __forceinline__ v8i_t cat8(bf16x8 a, bf16x8 b) { return __builtin_shufflevector(__builtin_bit_cast(v4i_t, a), __builtin_bit_cast(v4i_t, b), 0, 1, 2, 3, 4, 5, 6, 7); }

template <class Epi, class Sched, bool ALIGN_EPI, int ESZ = 2  >
__device__ __forceinline__ void gemm_phase(LAS unsigned char* lds, const int K, const int lda, const int ldb, const Sched& S, const Epi& E, unsigned long long* prof = nullptr) {
    unsigned long long pf_kl = 0, pf_ep = 0, pf_t0 = 0, pf_t1 = 0, pf_n = 0; const unsigned long long pf_w0 = prof ? wall_clock64() : 0ull, pf_c0 = prof ? clock64() : 0ull;
    int tid_ = threadIdx.x; asm volatile("" : "+v"(tid_));
    const int tid = tid_, wid = __builtin_amdgcn_readfirstlane(tid >> 6), lane = tid & 63, wr = wid >> 2, wc = wid & 3, fr = lane & 15, fq = lane >> 4;
    const int nt = (K * ESZ) / (BK * 2);
    constexpr bool GATHER = Sched::GATHER;
    unsigned voffA[2], voffB[2]; int Rr[2], Cb[2];
#pragma unroll
    for (int i = 0; i < 2; ++i) { int R, C; stage_rc(tid * 16 + i * 8192, R, C);
        int Rb = R;
        if constexpr ((int)Epi::PERM == 1) Rb = (R & ~31) + perm32(R & 31);
        if constexpr ((int)Epi::PERM == 2) Rb = 64 * (R >> 5) + 16 * ((R >> 2) & 3) + 4 * ((R >> 4) & 1) + (R & 3);
        voffA[i] = (unsigned)(R * lda * ESZ + C * 2); voffB[i] = (unsigned)(Rb * ldb * ESZ + C * 2); Rr[i] = R; Cb[i] = C * 2; }
    const size_t kstep = (size_t)(BK * 2);
    const size_t hstepA = (size_t)HALF * lda * ESZ, hstepB = (size_t)(((int)Epi::PERM == 2) ? 8 : HALF) * ldb * ESZ;
    const unsigned ldsw = (unsigned)wid * 1024u;
    const int aoff = lds_byte(wr * 64 + fr, fq * 8), boff = lds_byte(wc * 32 + fr, fq * 8);
#define PG8_SA(b, h) (((b) * 2 + (h)) * HTB)
#define PG8_SB(b, h) ((4 + (b) * 2 + (h)) * HTB)
#define PG8_STAGE(bufoff, gbase, voff) do { _Pragma("unroll") for (int _i = 0; _i < 2; ++_i) \
        __builtin_amdgcn_global_load_lds((const unsigned*)((const char*)(gbase) + (voff)[_i]), (LAS unsigned*)(lds + (bufoff) + ldsw + _i * 8192), 16, 0, 0); } while (0)
#define PG8_STAGE_A(bufoff, gbase, h, NX) do { if constexpr (GATHER) { _Pragma("unroll") for (int _i = 0; _i < 2; ++_i) { const unsigned _o = (NX) ? naoff[h][_i] : caoff[h][_i]; \
        __builtin_amdgcn_global_load_lds((const unsigned*)((const char*)(gbase) + _o), (LAS unsigned*)(lds + (bufoff) + ldsw + _i * 8192), 16, 0, 0); } } \
        else { PG8_STAGE(bufoff, (const char*)(gbase) + (h) * hstepA, voffA); } } while (0)
#define PG8_LDA(dst, b, h) do { _Pragma("unroll") for (int m = 0; m < 4; ++m) { if constexpr (ESZ == 2) { _Pragma("unroll") for (int k = 0; k < 2; ++k) dst.v[m][k] = *(const LAS bf16x8*)(lds + PG8_SA(b, h) + aoff + m * 2048 + k * 1024); } \
        else { const v4i_t _lo = *(const LAS v4i_t*)(lds + PG8_SA(b, h) + aoff + m * 2048), _hi = *(const LAS v4i_t*)(lds + PG8_SA(b, h) + aoff + m * 2048 + 1024); dst.v[m] = __builtin_shufflevector(_lo, _hi, 0, 1, 2, 3, 4, 5, 6, 7); } } } while (0)
#define PG8_LDB(dst, b, h) do { _Pragma("unroll") for (int n = 0; n < 2; ++n) { if constexpr (ESZ == 2) { _Pragma("unroll") for (int k = 0; k < 2; ++k) dst.v[n][k] = *(const LAS bf16x8*)(lds + PG8_SB(b, h) + boff + n * 2048 + k * 1024); } \
        else { const v4i_t _lo = *(const LAS v4i_t*)(lds + PG8_SB(b, h) + boff + n * 2048), _hi = *(const LAS v4i_t*)(lds + PG8_SB(b, h) + boff + n * 2048 + 1024); dst.v[n] = __builtin_shufflevector(_lo, _hi, 0, 1, 2, 3, 4, 5, 6, 7); } } } while (0)
#define PG8_MMA(ai, bj, At, Bt) do { __builtin_amdgcn_s_setprio(1); _Pragma("unroll") for (int m = 0; m < 4; ++m) _Pragma("unroll") for (int n = 0; n < 2; ++n) { \
        if constexpr (ESZ == 2) { _Pragma("unroll") for (int k = 0; k < 2; ++k) acc[ai][bj][m][n] = __builtin_amdgcn_mfma_f32_16x16x32_bf16(Bt.v[n][k], At.v[m][k], acc[ai][bj][m][n], 0, 0, 0); } \
        else { mfma_f8(acc[ai][bj][m][n], Bt.v[n], At.v[m]); } } \
        __builtin_amdgcn_s_setprio(0); } while (0)
#define PG8_WAIT_V(n) asm volatile("s_waitcnt vmcnt(" #n ")" ::: "memory")
#define PG8_WAIT_V8R do { if (relax) asm volatile("s_waitcnt vmcnt(%0)" :: "n"(8 + Epi::NSTORE) : "memory"); else PG8_WAIT_V(8); } while (0)
#define PG8_WAIT_L(n) asm volatile("s_waitcnt lgkmcnt(" #n ")" ::: "memory")
#define PG8_BAR __builtin_amdgcn_s_barrier()
#define PG8_SCHED __builtin_amdgcn_sched_barrier(0)
    Unit cur, nxt; int ui = 0;
    if (!S.next(0, cur)) return;
    f32x4 acc[2][2][4][2];
#pragma unroll
    for (int a = 0; a < 2; ++a)
#pragma unroll
        for (int b = 0; b < 2; ++b)
#pragma unroll
            for (int m = 0; m < 4; ++m)
#pragma unroll
                for (int n = 0; n < 2; ++n) acc[a][b][m][n] = (f32x4){0.f, 0.f, 0.f, 0.f};
    typedef typename FragT<ESZ>::A4 FragA; typedef typename FragT<ESZ>::B2 FragB;
    FragA At; FragB B0, B1;
    unsigned caoff[2][2] = {{0u, 0u}, {0u, 0u}}, naoff[2][2] = {{0u, 0u}, {0u, 0u}};
    if constexpr (GATHER) {
#pragma unroll
        for (int h = 0; h < 2; ++h)
#pragma unroll
            for (int i = 0; i < 2; ++i) { caoff[h][i] = S.arow(cur, h * HALF + Rr[i]) + (unsigned)Cb[i]; naoff[h][i] = caoff[h][i]; }
    }
    const char* cA = S.baseA(cur); const char* cB = S.baseB(cur);
    PG8_STAGE(PG8_SB(0, 0), cB, voffB); PG8_STAGE(PG8_SB(0, 1), cB + hstepB, voffB); PG8_STAGE_A(PG8_SA(0, 0), cA, 0, false); PG8_STAGE_A(PG8_SA(0, 1), cA, 1, false);
    if (wr == 1) PG8_BAR;
    PG8_WAIT_V(2); PG8_BAR;
    PG8_STAGE(PG8_SB(1, 0), cB + kstep, voffB); PG8_STAGE_A(PG8_SA(1, 0), cA + kstep, 0, false); PG8_STAGE(PG8_SB(1, 1), cB + hstepB + kstep, voffB);
    PG8_WAIT_V(6); PG8_BAR;
    for (;;) {
        const bool has_next = S.next(ui + 1, nxt);
        const char* nA = has_next ? S.baseA(nxt) : cA; const char* nB = has_next ? S.baseB(nxt) : cB;
        if constexpr (GATHER) {
            if (has_next) {
#pragma unroll
                for (int h = 0; h < 2; ++h)
#pragma unroll
                    for (int i = 0; i < 2; ++i) naoff[h][i] = S.arow(nxt, h * HALF + Rr[i]) + (unsigned)Cb[i];
            } else {
#pragma unroll
                for (int h = 0; h < 2; ++h)
#pragma unroll
                    for (int i = 0; i < 2; ++i) naoff[h][i] = caoff[h][i];
            }
        }
        if (prof) pf_t0 = clock64();
        if constexpr (EpiTouch<Epi>::v) E.touch(cur, lds, tid, wid);
        int ntu = nt; if constexpr (SchedVarK<Sched>::v) ntu = S.ktiles(cur);
#pragma unroll 1
        for (int t = 0; t < ntu; t += 2) {
            const bool last = (t == ntu - 2);
            const bool relax = (Epi::NSTORE > 0) && (t == 0) && (ui > 0);
            const char* a1 = cA + (size_t)(t + 1) * kstep;
            const char* a2 = last ? nA : cA + (size_t)(t + 2) * kstep; const char* b2 = last ? nB : cB + (size_t)(t + 2) * kstep;
            const char* a3 = a2 + kstep; const char* b3 = b2 + kstep;
            PG8_LDB(B0, 0, 0); PG8_LDB(B1, 0, 1); PG8_SCHED; PG8_LDA(At, 0, 0); PG8_STAGE_A(PG8_SA(1, 1), a1, 1, false);
            PG8_WAIT_V(8); PG8_WAIT_L(0); PG8_BAR; PG8_MMA(0, 0, At, B0); PG8_MMA(0, 1, At, B1); PG8_BAR; PG8_SCHED;
            PG8_LDA(At, 0, 1); PG8_STAGE(PG8_SB(0, 0), b2, voffB); PG8_STAGE(PG8_SB(0, 1), b2 + hstepB, voffB); PG8_STAGE_A(PG8_SA(0, 0), a2, 0, last);
            PG8_WAIT_V(8); PG8_WAIT_L(0); PG8_BAR; PG8_MMA(1, 0, At, B0); PG8_MMA(1, 1, At, B1); PG8_BAR; PG8_SCHED;
            PG8_LDB(B0, 1, 0); PG8_LDB(B1, 1, 1); PG8_SCHED; PG8_LDA(At, 1, 0); PG8_STAGE_A(PG8_SA(0, 1), a2, 1, last);
            PG8_WAIT_V(8); PG8_WAIT_L(0); PG8_BAR; PG8_MMA(0, 0, At, B0); PG8_MMA(0, 1, At, B1); PG8_BAR; PG8_SCHED;
            PG8_LDA(At, 1, 1); PG8_STAGE(PG8_SB(1, 0), b3, voffB); PG8_STAGE(PG8_SB(1, 1), b3 + hstepB, voffB); PG8_STAGE_A(PG8_SA(1, 0), a3, 0, last);
            PG8_WAIT_V(8); PG8_WAIT_L(0); PG8_BAR; PG8_MMA(1, 0, At, B0); PG8_MMA(1, 1, At, B1); PG8_BAR; PG8_SCHED;
        }
        if (prof) { pf_t1 = clock64(); pf_kl += pf_t1 - pf_t0; }
        if constexpr (ESZ == 1) asm volatile("s_nop 15\n\ts_nop 15" ::: "memory");
        if constexpr (ALIGN_EPI) { if (wr == 0) PG8_BAR; }
        if constexpr (!Epi::AFTER_DRAIN) { int fr_e = fr, fq_e = fq; asm volatile("" : "+v"(fr_e), "+v"(fq_e));
            E(acc, cur, wr, wc, fr_e, fq_e); }
        if (prof) { pf_ep += clock64() - pf_t1; ++pf_n; }
        if (!has_next) break;
        bool zero = true; if constexpr (EpiKeep<Epi>::v) zero = !E.keep(cur);
        if (zero) {
#pragma unroll
        for (int a = 0; a < 2; ++a)
#pragma unroll
            for (int b = 0; b < 2; ++b)
#pragma unroll
                for (int m = 0; m < 4; ++m)
#pragma unroll
                    for (int n = 0; n < 2; ++n) acc[a][b][m][n] = (f32x4){0.f, 0.f, 0.f, 0.f};
        }
        cur = nxt; cA = nA; cB = nB; ++ui;
        if constexpr (GATHER) {
#pragma unroll
            for (int h = 0; h < 2; ++h)
#pragma unroll
                for (int i = 0; i < 2; ++i) caoff[h][i] = naoff[h][i];
        }
        if constexpr (ALIGN_EPI) { if (wr == 1) PG8_BAR; }
    }
    PG8_WAIT_V(0);
    if constexpr (!ALIGN_EPI) { if (wr == 0) PG8_BAR; }
    PG8_BAR;
    if (prof && blockIdx.x == PROFBLK && tid == 0) { prof[0] = pf_kl; prof[1] = pf_ep; prof[2] = pf_n; prof[3] = (unsigned long long)nt; prof[4] = clock64() - pf_c0; prof[5] = wall_clock64() - pf_w0; }
    if constexpr (Epi::AFTER_DRAIN) { int fr_e = fr, fq_e = fq; asm volatile("" : "+v"(fr_e), "+v"(fq_e)); E.fused(acc, cur, wr, wc, fr_e, fq_e, lds, wid, lane); }
#undef PG8_SA
#undef PG8_SB
#undef PG8_STAGE
#undef PG8_STAGE_A
#undef PG8_LDA
#undef PG8_LDB
#undef PG8_MMA
#undef PG8_WAIT_V
#undef PG8_WAIT_V8R
#undef PG8_WAIT_L
#undef PG8_BAR
#undef PG8_SCHED
}
constexpr int NXCD = 8;
#ifndef GATE_STASH
#define GATE_STASH 1
#endif
#ifndef RES_FROM_H
#define RES_FROM_H 1
#endif
#ifndef EPI_TOUCH
#define EPI_TOUCH 0
#endif
#ifndef PROJ_WGM
#define PROJ_WGM 8
#endif
__device__ __forceinline__ void static_tile(int L, int nM, int nN, int& pm, int& pn, const int WGM = 8) {
    const int nwg = nM * nN; int wgid = L;
    { const int q = nwg / NXCD, r = nwg % NXCD, xcd = wgid % NXCD, off = wgid / NXCD; wgid = (xcd < r ? xcd * (q + 1) : r * (q + 1) + (xcd - r) * q) + off; }
    const int nig = WGM * nN, gid = wgid / nig, fm = gid * WGM, gsz = (nM - fm) < WGM ? (nM - fm) : WGM;
    pm = fm + ((wgid % nig) % gsz); pn = (wgid % nig) / gsz;
}
struct SchedPlain {
    static constexpr bool GATHER = false;
    const char* A; const char* Bt; size_t tstepA, tstepB; int nM, nN; int r0 = 0, r1 = 1 << 20;
    __device__ __forceinline__ bool next(int i, Unit& u) const { const int k = i + r0; if (k >= r1) return false;
        const int L = k * (int)gridDim.x + (int)blockIdx.x; if (L >= nM * nN) return false; static_tile(L, nM, nN, u.pm, u.pn); u.z = 0; return true; }
    __device__ __forceinline__ const char* baseA(const Unit& u) const { return A + (size_t)u.pm * tstepA; }
    __device__ __forceinline__ const char* baseB(const Unit& u) const { return Bt + (size_t)u.pn * tstepB; }
    __device__ __forceinline__ unsigned arow(const Unit&, int) const { return 0u; }
};
struct SchedProj {
    static constexpr bool GATHER = false;
    const unsigned char* ws; int r0, r1;
    __device__ __forceinline__ bool next(int i, Unit& u) const {
        if (i + r0 >= r1) return false;
        const int L = (i + r0) * (int)gridDim.x + (int)blockIdx.x;
        constexpr int NPB = GATES_F8 ? 18 : 42;
        if (L < 64 * NPB) { static_tile(L, 64, NPB, u.pm, u.pn, PROJ_WGM); u.z = (u.pn == 13) ? 2 : 0; return true; }
        const int L2 = L - 64 * NPB; if (L2 >= 64) return false;
        if (L2 < 32) { u.pm = L2 & 7; u.pn = L2 >> 3; u.z = 1; } else { u.pm = (L2 - 32) & 3; u.pn = (L2 - 32) >> 2; u.z = 3; }
        return true;
    }
    __device__ __forceinline__ const char* baseA(const Unit& u) const {
        const size_t ts = (size_t)256 * LDP * 2;
        if (u.z == 0) return (const char*)ws + WS_H + (size_t)u.pm * ts;
        if (u.z == 2) return (const char*)ws + WS_WINT + (size_t)13 * ts;
        if (u.z == 1) return (const char*)ws + WS_MEMBF + (size_t)u.pm * ts;
        return (const char*)ws + WS_WMKVT + (size_t)(4 + u.pm) * ts;
    }
    __device__ __forceinline__ const char* baseB(const Unit& u) const {
        const size_t ts = (size_t)256 * LDP * 2;
        if (u.z == 0) return (const char*)ws + WS_WINT + (size_t)u.pn * ts;
        if (u.z == 2) return (const char*)ws + WS_H + (size_t)u.pm * ts;
        if (u.z == 1) return (const char*)ws + WS_WMKVT + (size_t)u.pn * ts;
        return (const char*)ws + WS_MEMBF + (size_t)u.pn * ts;
    }
    __device__ __forceinline__ unsigned arow(const Unit&, int) const { return 0u; }
};
struct SchedGates8 {
    static constexpr bool GATHER = false;
    const unsigned char* ws; int r0, r1;
    __device__ __forceinline__ bool next(int i, Unit& u) const {
        if (i + r0 >= r1) return false;
        const int L = (i + r0) * (int)gridDim.x + (int)blockIdx.x; if (L >= 64 * 24) return false;
        static_tile(L, 64, 24, u.pm, u.pn, PROJ_WGM); u.z = 0; return true;
    }
    __device__ __forceinline__ const char* baseA(const Unit& u) const { return (const char*)ws + WS_H8 + (size_t)u.pm * (256 * 2048); }
    __device__ __forceinline__ const char* baseB(const Unit& u) const { return (const char*)ws + WS_WINQ + (size_t)u.pn * (256 * 2048); }
    __device__ __forceinline__ unsigned arow(const Unit&, int) const { return 0u; }
};
struct SchedChan {
    static constexpr bool GATHER = false;
    const unsigned char* ws; int u0, nu;
    __device__ __forceinline__ bool next(int i, Unit& u) const {
        const int L = i * (int)gridDim.x + vwg(); if (L >= 512) return false;
        u.z = L >> 4; u.pm = (L >> 3) & 1; u.pn = L & 7; return true;
    }
    __device__ __forceinline__ const char* baseA(const Unit& u) const { return (const char*)ws + WS_TABT + (size_t)u.pm * (256 * 256 * 2); }
    __device__ __forceinline__ const char* baseB(const Unit& u) const { const int b = u.z >> 2, g = u.z & 3; return (const char*)ws + WS_FIN + ((size_t)(b * 2048 + u.pn * 256) * 1024 + g * 256) * 2; }
    __device__ __forceinline__ unsigned arow(const Unit&, int) const { return 0u; }
};
struct SchedSeq {
    static constexpr bool GATHER = false;
    const unsigned char* ws;
    __device__ __forceinline__ bool next(int i, Unit& u) const {
        const int L = i * (int)gridDim.x + vwg(); if (L >= 256) return false;
        u.z = L >> 3; u.pm = L & 7; u.pn = 0; return true;
    }
    __device__ __forceinline__ const char* baseA(const Unit& u) const { return (const char*)ws + WS_DMAT + (size_t)u.pm * ((size_t)256 * SQP * 2); }
    __device__ __forceinline__ const char* baseB(const Unit& u) const { return (const char*)ws + WS_ZT + (size_t)u.z * ((size_t)256 * SQP * 2); }
    __device__ __forceinline__ unsigned arow(const Unit&, int) const { return 0u; }
};
struct SchedOne {
    static constexpr bool GATHER = false;
    const char* A; const char* Bt; int z; bool valid;
    __device__ __forceinline__ bool next(int i, Unit& u) const { if (i != 0 || !valid) return false; u.pm = 0; u.pn = 0; u.z = z; return true; }
    __device__ __forceinline__ const char* baseA(const Unit&) const { return A; }
    __device__ __forceinline__ const char* baseB(const Unit&) const { return Bt; }
    __device__ __forceinline__ unsigned arow(const Unit&, int) const { return 0u; }
};
template <bool GATH, int NT  , bool F8>
struct SchedMoe {
    static constexpr bool GATHER = GATH;
    static constexpr int ES = F8 ? 1 : 2;
    const unsigned char* ws; const LAS int* pt; const LAS int* cn; int same = 0;
    int r0 = 0, r1 = 1 << 20;
    __device__ __forceinline__ int ptu(int k) const { return __builtin_amdgcn_readfirstlane(pt[k]); }
    __device__ __forceinline__ bool next(int i, Unit& u) const {
        const int k = i + r0; if (k >= r1) return false;
        const int L = k * (int)gridDim.x + vwg(); const int total = ptu(NE) * NT; if (L >= total) return false;
        const int ln = (int)(threadIdx.x & 63);
        const unsigned long long bal = __ballot(ln < NE && L >= pt[ln & 31] * NT);
        const int e = __builtin_amdgcn_readfirstlane(__popcll(bal) - 1);
        const int t = L - ptu(e) * NT, mte = ptu(e + 1) - ptu(e);
        u.z = e; u.pm = t % mte; u.pn = t / mte; u.idx = k; return true;
    }
    __device__ __forceinline__ const char* baseA(const Unit& u) const {
        if constexpr (GATH) return (const char*)ws + (F8 ? WS_H2Q : WS_H2);
        else return (const char*)ws + (F8 ? WS_ACTQ : WS_ACT) + (same ? (size_t)0 : (size_t)(ptu(u.z) + u.pm) * (256 * 2048 * ES));
    }
    __device__ __forceinline__ const char* baseB(const Unit& u) const {
        if constexpr (GATH) return (const char*)ws + (F8 ? WS_WGUQ : WS_WGUT) + ((size_t)u.z * 4096 + (size_t)u.pn * 256) * (2048 * ES);
        else return (const char*)ws + (F8 ? WS_WDNQ : WS_WDNT) + (same ? (size_t)0 : ((size_t)u.z * 2048 + (size_t)u.pn * 256) * (2048 * ES));
    }
    __device__ __forceinline__ unsigned arow(const Unit& u, int r) const {
        const LAS unsigned short* tokl = (const LAS unsigned short*)((const LAS unsigned char*)pt - LDS_MISC + LDS_TOKL);
        return (unsigned)tokl[u.idx * 256 + r] * (unsigned)(2048 * ES);
    }
};

__device__ __forceinline__ void store_tile_bf16(const f32x4 (&acc)[2][2][4][2], bf16_t* dst  , size_t ldc, int wr, int wc, int fr, int fq) {
    const int row0 = wr * 64 + fr, col0 = wc * 32 + 8 * fq;
#pragma unroll
    for (int ai = 0; ai < 2; ++ai)
#pragma unroll
        for (int m = 0; m < 4; ++m) { bf16_t* rowp = dst + (size_t)(row0 + ai * HALF + m * 16) * ldc + col0;
#pragma unroll
            for (int bj = 0; bj < 2; ++bj) { const f32x4 v0 = acc[ai][bj][m][0], v1 = acc[ai][bj][m][1];
                u32x4 w; w.x = cvtpk(v0[0], v0[1]); w.y = cvtpk(v0[2], v0[3]); w.z = cvtpk(v1[0], v1[1]); w.w = cvtpk(v1[2], v1[3]);
                *(u32x4*)(rowp + bj * HALF) = w; } }
}
struct EpiProj {
    static constexpr bool PERM = true, AFTER_DRAIN = false; static constexpr int NSTORE = 16;
    unsigned char* ws;
    __device__ __forceinline__ void operator()(const f32x4 (&acc)[2][2][4][2], const Unit& u, int wr, int wc, int fr, int fq) const {
        const int pn = u.pn, pm = u.pm;
        bf16_t* dst; size_t ldc;
        if (u.z == 0) {
            if (pn >= 18) {
                dst = (bf16_t*)(ws + WS_GATES) + (size_t)pm * 256 * 6144 + (pn - 18) * 256;
                const int row0 = wr * 64 + fr, col0 = wc * 32 + 8 * fq;
#pragma unroll
                for (int ai = 0; ai < 2; ++ai)
#pragma unroll
                    for (int m = 0; m < 4; ++m) { bf16_t* rowp = dst + (size_t)(row0 + ai * HALF + m * 16) * 6144 + col0;
#pragma unroll
                        for (int bj = 0; bj < 2; ++bj) { const f32x4 v0 = acc[ai][bj][m][0], v1 = acc[ai][bj][m][1];
                            u32x4 w; w.x = cvtpk(sigmoidf_(v0[0]), sigmoidf_(v0[1])); w.y = cvtpk(sigmoidf_(v0[2]), sigmoidf_(v0[3]));
                            w.z = cvtpk(sigmoidf_(v1[0]), sigmoidf_(v1[1])); w.w = cvtpk(sigmoidf_(v1[2]), sigmoidf_(v1[3]));
                            *(u32x4*)(rowp + bj * HALF) = w; } }
                return;
            }
            if (pn < 4) { dst = (bf16_t*)(ws + WS_FIN) + pn * 256; ldc = 1024; }
            else if (pn < 12) { dst = (bf16_t*)(ws + WS_Q) + (pn - 4) * 256; ldc = 2048; }
            else if (pn == 12) { dst = (bf16_t*)(ws + WS_K); ldc = 256; }
            else { dst = (bf16_t*)(ws + WS_QM) + (pn - 14) * 256; ldc = 1024; }
            dst += (size_t)pm * 256 * ldc;
        } else if (u.z == 2) {
            dst = (bf16_t*)(ws + WS_VT) + (size_t)(pm >> 3) * 256 * 2048 + (size_t)(pm & 7) * 256; ldc = 2048;
        } else if (u.z == 1) {
            dst = (bf16_t*)(ws + WS_KMK) + (size_t)pm * 256 * 1024 + pn * 256; ldc = 1024;
        } else {
            dst = (bf16_t*)(ws + WS_VMT) + (size_t)(pn * 4 + pm) * 256 * 256; ldc = 256;
        }
        store_tile_bf16(acc, dst, ldc, wr, wc, fr, fq);
    }
};
__device__ __forceinline__ unsigned pk_u8x4(float a, float b, float c, float d) {
    const unsigned x = (unsigned)(a * 255.0f + 0.5f), y = (unsigned)(b * 255.0f + 0.5f), z = (unsigned)(c * 255.0f + 0.5f), w = (unsigned)(d * 255.0f + 0.5f);
    return x | (y << 8) | (z << 16) | (w << 24); }
struct EpiGates8 {
    static constexpr int PERM = 2; static constexpr bool AFTER_DRAIN = false; static constexpr int NSTORE = 8;
    unsigned char* ws;
    __device__ __forceinline__ void operator()(const f32x4 (&acc)[2][2][4][2], const Unit& u, int wr, int wc, int fr, int fq) const {
        unsigned char* dst = ws + WS_GATES + (size_t)u.pm * 256 * 6144 + u.pn * 256;
        const int row0 = wr * 64 + fr, col0 = wc * 64 + 16 * fq;
#pragma unroll
        for (int ai = 0; ai < 2; ++ai)
#pragma unroll
            for (int m = 0; m < 4; ++m) {
                u32x4 w;
                { const f32x4 a = acc[ai][0][m][0] * WQ_INV, c = acc[ai][0][m][1] * WQ_INV;
                  w.x = pk_u8x4(sigmoidf_(a[0]), sigmoidf_(a[1]), sigmoidf_(a[2]), sigmoidf_(a[3])); w.y = pk_u8x4(sigmoidf_(c[0]), sigmoidf_(c[1]), sigmoidf_(c[2]), sigmoidf_(c[3])); }
                { const f32x4 a = acc[ai][1][m][0] * WQ_INV, c = acc[ai][1][m][1] * WQ_INV;
                  w.z = pk_u8x4(sigmoidf_(a[0]), sigmoidf_(a[1]), sigmoidf_(a[2]), sigmoidf_(a[3])); w.w = pk_u8x4(sigmoidf_(c[0]), sigmoidf_(c[1]), sigmoidf_(c[2]), sigmoidf_(c[3])); }
                *(u32x4*)(dst + (size_t)(row0 + ai * HALF + m * 16) * 6144 + col0) = w; }
    }
};
struct EpiChan {
    static constexpr bool PERM = true, AFTER_DRAIN = false; static constexpr int NSTORE = 0;
    unsigned char* ws;
    __device__ __forceinline__ void operator()(const f32x4 (&acc)[2][2][4][2], const Unit& u, int wr, int wc, int fr, int fq) const {
        store_tile_bf16(acc, (bf16_t*)(ws + WS_ZT) + (size_t)u.z * 256 * SQP + (size_t)u.pm * 2048 + u.pn * 256, SQP, wr, wc, fr, fq);
    }
};
struct EpiSeq {
    static constexpr bool PERM = true, AFTER_DRAIN = false; static constexpr int NSTORE = 0;
    unsigned char* ws;
    __device__ __forceinline__ void operator()(const f32x4 (&acc)[2][2][4][2], const Unit& u, int wr, int wc, int fr, int fq) const {
        const int b = u.z >> 2, g = u.z & 3;
        store_tile_bf16(acc, (bf16_t*)(ws + WS_FX) + (size_t)(b * 2048 + u.pm * 256) * 2048 + g * 256, 2048, wr, wc, fr, fq);
    }
};
template <int STEP> struct EpiMix {
    static constexpr int PERM = 1; static constexpr bool AFTER_DRAIN = false; static constexpr int NSTORE = 16;
    unsigned char* ws;
    __device__ __forceinline__ void operator()(const f32x4 (&acc)[2][2][4][2], const Unit& u, int wr, int wc, int fr, int fq) const {
        const int row0 = u.pm * 256 + wr * 64 + fr, col0 = u.pn * 256 + wc * 32 + 8 * fq;
        const bf16_t* gates = (const bf16_t*)(ws + WS_GATES) + STEP * 2048; const unsigned char* gates8 = ws + WS_GATES + STEP * 2048;
        bf16_t* macc = (bf16_t*)(ws + WS_MIXACC); bf16_t* mixed = (bf16_t*)(ws + WS_MIXED);
#pragma unroll
        for (int ai = 0; ai < 2; ++ai) {
            u32x2 g8[4][2]; u32x4 gw[4][2]; u32x4 mw[4][2];
#pragma unroll
            for (int m = 0; m < 4; ++m) { const size_t row = (size_t)(row0 + ai * HALF + m * 16);
#pragma unroll
                for (int bj = 0; bj < 2; ++bj) { const int col = col0 + bj * HALF;
                    if constexpr (GATES_F8) g8[m][bj] = *(const u32x2*)(gates8 + row * 6144 + col); else gw[m][bj] = *(const u32x4*)(gates + row * 6144 + col);
                    if (STEP > 0) mw[m][bj] = *(const u32x4*)(macc + row * 2048 + col); } }
#pragma unroll
            for (int m = 0; m < 4; ++m) { const size_t row = (size_t)(row0 + ai * HALF + m * 16);
#pragma unroll
                for (int bj = 0; bj < 2; ++bj) { const int col = col0 + bj * HALF;
                    f32x4 v0 = acc[ai][bj][m][0], v1 = acc[ai][bj][m][1];
                    if constexpr (GATES_F8) { const u32x2 g = g8[m][bj]; const float k = 1.0f / 255.0f;
                        v0[0] *= (float)(g.x & 255u) * k; v0[1] *= (float)((g.x >> 8) & 255u) * k; v0[2] *= (float)((g.x >> 16) & 255u) * k; v0[3] *= (float)(g.x >> 24) * k;
                        v1[0] *= (float)(g.y & 255u) * k; v1[1] *= (float)((g.y >> 8) & 255u) * k; v1[2] *= (float)((g.y >> 16) & 255u) * k; v1[3] *= (float)(g.y >> 24) * k; }
                    else { const u32x4 g = gw[m][bj];
                        v0[0] *= bflo(g.x); v0[1] *= bfhi(g.x); v0[2] *= bflo(g.y); v0[3] *= bfhi(g.y);
                        v1[0] *= bflo(g.z); v1[1] *= bfhi(g.z); v1[2] *= bflo(g.w); v1[3] *= bfhi(g.w); }
                    if (STEP > 0) { const u32x4 q = mw[m][bj];
                        v0[0] += bflo(q.x); v0[1] += bfhi(q.x); v0[2] += bflo(q.y); v0[3] += bfhi(q.y);
                        v1[0] += bflo(q.z); v1[1] += bfhi(q.z); v1[2] += bflo(q.w); v1[3] += bfhi(q.w); }
                    u32x4 w; w.x = cvtpk(v0[0], v0[1]); w.y = cvtpk(v0[2], v0[3]); w.z = cvtpk(v1[0], v1[1]); w.w = cvtpk(v1[2], v1[3]);
                    *(u32x4*)((STEP < 2 ? macc : mixed) + row * 2048 + col) = w; } }
        }
    }
};
struct SchedMix {
    static constexpr bool GATHER = false; static constexpr bool VARK = true;
    const unsigned char* ws; int r0, r1;
    __device__ __forceinline__ bool next(int i, Unit& u) const {
        const int tr = r0 + i / 3; if (tr >= r1) return false;
        const int L = tr * (int)gridDim.x + (int)blockIdx.x; if (L >= 64 * 8) return false;
        static_tile(L, 64, 8, u.pm, u.pn); u.z = i % 3; return true;
    }
    __device__ __forceinline__ int ktiles(const Unit& u) const { return u.z == 1 ? 32 : 16; }
    __device__ __forceinline__ const char* baseA(const Unit& u) const {
        const size_t ts = (size_t)256 * 2048 * 2;
        return (const char*)ws + (u.z == 1 ? WS_ATT : WS_FX + (u.z == 2 ? 2048 : 0)) + (size_t)u.pm * ts;
    }
    __device__ __forceinline__ const char* baseB(const Unit& u) const {
        const size_t ts = (size_t)256 * 2048 * 2;
        return (const char*)ws + (u.z == 1 ? WS_WAOT : WS_WFM + (u.z == 2 ? 2048 : 0)) + (size_t)u.pn * ts;
    }
    __device__ __forceinline__ unsigned arow(const Unit&, int) const { return 0u; }
};
struct EpiMixF {
    static constexpr int PERM = 1; static constexpr bool AFTER_DRAIN = false, KEEP = true; static constexpr int NSTORE = 16;
    unsigned char* ws; LAS unsigned char* lds;
    __device__ __forceinline__ bool keep(const Unit& u) const { return u.z < 2; }
    static constexpr bool TOUCH = EPI_TOUCH;
    __device__ __forceinline__ void touch(const Unit& u, LAS unsigned char* lds, int tid, int wid) const {
        if (u.z != 0) return;
        const unsigned char* q = ws + WS_GATES + (size_t)(u.pm * 256 + (tid >> 1)) * 6144 + u.pn * 256 + (tid & 1) * 128;
#pragma unroll
        for (int s = 0; s < 3; ++s) __builtin_amdgcn_global_load_lds((const unsigned*)(q + s * 2048), (LAS unsigned*)(lds + LDS_BTAB + wid * 1024 + s * 256), 4, 0, 0);
    }
    static __device__ __forceinline__ float gb(unsigned w, int k) { return (float)((w >> (8 * k)) & 255u); }
    static constexpr int STASH_N = (LDS_XBW - STAGE_BYTES) / 8;
    __device__ __forceinline__ void operator()(f32x4 (&acc)[2][2][4][2], const Unit& u, int wr, int wc, int fr, int fq) const {
        const int row0 = u.pm * 256 + wr * 64 + fr, col0 = u.pn * 256 + wc * 32 + 8 * fq;
        const int seg = __builtin_amdgcn_readfirstlane(u.z);
        const int tidx = (wr * 4 + wc) * 64 + fq * 16 + fr;
        LAS u32x2* stash = (LAS u32x2*)(lds + STAGE_BYTES);
        const unsigned char* gnum = ws + WS_GATES + seg * 2048;
        bf16_t* mixed = (bf16_t*)(ws + WS_MIXED);
        if (seg < 2) {
#pragma unroll
            for (int ai = 0; ai < 2; ++ai) {
                u32x2 gn[4][2], gd[4][2];
#pragma unroll
                for (int m = 0; m < 4; ++m) { const size_t row = (size_t)(row0 + ai * HALF + m * 16);
#pragma unroll
                    for (int bj = 0; bj < 2; ++bj) { const unsigned char* q = gnum + row * 6144 + col0 + bj * HALF; const int e = (m * 2 + bj) * 512 + tidx;
                        if (GATE_STASH && ai == 0 && seg == 1 && e < STASH_N) gn[m][bj] = stash[e]; else gn[m][bj] = *(const u32x2*)q;
                        gd[m][bj] = *(const u32x2*)(q + 2048); } }
                if (GATE_STASH && ai == 0) {
#pragma unroll
                    for (int m = 0; m < 4; ++m)
#pragma unroll
                        for (int bj = 0; bj < 2; ++bj) { const int e = (m * 2 + bj) * 512 + tidx; if (e < STASH_N) stash[e] = gd[m][bj]; }
                }
#pragma unroll
                for (int m = 0; m < 4; ++m)
#pragma unroll
                    for (int bj = 0; bj < 2; ++bj) {
#pragma unroll
                        for (int k = 0; k < 4; ++k) {
                            const float n0 = (seg == 0) ? gb(gn[m][bj].x, k) : fmaxf(gb(gn[m][bj].x, k), 0.5f), n1 = (seg == 0) ? gb(gn[m][bj].y, k) : fmaxf(gb(gn[m][bj].y, k), 0.5f);
                            acc[ai][bj][m][0][k] *= n0 * __builtin_amdgcn_rcpf(fmaxf(gb(gd[m][bj].x, k), 0.5f));
                            acc[ai][bj][m][1][k] *= n1 * __builtin_amdgcn_rcpf(fmaxf(gb(gd[m][bj].y, k), 0.5f)); } }
            }
        } else {
#pragma unroll
            for (int ai = 0; ai < 2; ++ai) {
                u32x2 gn[4][2];
#pragma unroll
                for (int m = 0; m < 4; ++m) { const size_t row = (size_t)(row0 + ai * HALF + m * 16);
#pragma unroll
                    for (int bj = 0; bj < 2; ++bj) { const int e = (m * 2 + bj) * 512 + tidx;
                        if (GATE_STASH && ai == 0 && e < STASH_N) gn[m][bj] = stash[e]; else gn[m][bj] = *(const u32x2*)(gnum + row * 6144 + col0 + bj * HALF); } }
#pragma unroll
                for (int m = 0; m < 4; ++m) { const size_t row = (size_t)(row0 + ai * HALF + m * 16);
#pragma unroll
                    for (int bj = 0; bj < 2; ++bj) { const float kq = 1.0f / 255.0f; f32x4 v0 = acc[ai][bj][m][0], v1 = acc[ai][bj][m][1];
#pragma unroll
                        for (int k = 0; k < 4; ++k) { v0[k] *= fmaxf(gb(gn[m][bj].x, k), 0.5f) * kq; v1[k] *= fmaxf(gb(gn[m][bj].y, k), 0.5f) * kq; }
                        u32x4 w; w.x = cvtpk(v0[0], v0[1]); w.y = cvtpk(v0[2], v0[3]); w.z = cvtpk(v1[0], v1[1]); w.w = cvtpk(v1[2], v1[3]);
                        *(u32x4*)(mixed + row * 2048 + col0 + bj * HALF) = w; } }
            }
        }
    }
};
struct EpiRes {
    static constexpr int PERM = 1; static constexpr bool AFTER_DRAIN = false; static constexpr int NSTORE = 16;
    const float* x; bf16_t* x2; const bf16_t* h; const float* irs; const float* g1;
    static constexpr bool TOUCH = EPI_TOUCH;
    __device__ __forceinline__ void touch(const Unit& u, LAS unsigned char* lds, int tid, int wid) const {
        const unsigned char* q = (const unsigned char*)(x + (size_t)(u.pm * 256 + (tid >> 1)) * 2048 + u.pn * 256) + (tid & 1) * 512;
#pragma unroll
        for (int j = 0; j < 4; ++j) __builtin_amdgcn_global_load_lds((const unsigned*)(q + j * 128), (LAS unsigned*)(lds + LDS_BTAB + wid * 1024 + j * 256), 4, 0, 0);
    }
    __device__ __forceinline__ void operator()(const f32x4 (&acc)[2][2][4][2], const Unit& u, int wr, int wc, int fr, int fq) const {
        const int row0 = u.pm * 256 + wr * 64 + fr, col0 = u.pn * 256 + wc * 32 + 8 * fq;
        if constexpr (RES_FROM_H) {
            f32x4 ig[2][2]; bool bad = false;
#pragma unroll
            for (int bj = 0; bj < 2; ++bj)
#pragma unroll
                for (int n2 = 0; n2 < 2; ++n2) { const f32x4 gv = *(const f32x4*)(g1 + col0 + bj * HALF + 4 * n2);
#pragma unroll
                    for (int k = 0; k < 4; ++k) { bad |= (gv[k] == 0.f); ig[bj][n2][k] = __builtin_amdgcn_rcpf(gv[k]); } }
            if (!__any(bad)) {
#pragma unroll
                for (int ai = 0; ai < 2; ++ai) {
                    float ir[4]; u32x4 hv[4][2];
#pragma unroll
                    for (int m = 0; m < 4; ++m) { const size_t row = (size_t)(row0 + ai * HALF + m * 16); ir[m] = irs[row];
#pragma unroll
                        for (int bj = 0; bj < 2; ++bj) hv[m][bj] = *(const u32x4*)(h + row * LDP + col0 + bj * HALF); }
#pragma unroll
                    for (int m = 0; m < 4; ++m) { const size_t off = (size_t)(row0 + ai * HALF + m * 16) * 2048 + col0;
#pragma unroll
                        for (int bj = 0; bj < 2; ++bj) { const u32x4 q = hv[m][bj]; const f32x4 i0 = ig[bj][0] * ir[m], i1 = ig[bj][1] * ir[m];
                            const f32x4 v0 = acc[ai][bj][m][0] + (f32x4){bflo(q.x), bfhi(q.x), bflo(q.y), bfhi(q.y)} * i0, v1 = acc[ai][bj][m][1] + (f32x4){bflo(q.z), bfhi(q.z), bflo(q.w), bfhi(q.w)} * i1;
                            u32x4 w; w.x = cvtpk(v0[0], v0[1]); w.y = cvtpk(v0[2], v0[3]); w.z = cvtpk(v1[0], v1[1]); w.w = cvtpk(v1[2], v1[3]);
                            *(u32x4*)(x2 + off + bj * HALF) = w; } }
                }
                return;
            }
        }
#pragma unroll
        for (int ai = 0; ai < 2; ++ai) {
            f32x4 xv[4][2][2];
#pragma unroll
            for (int m = 0; m < 4; ++m) { const size_t off = (size_t)(row0 + ai * HALF + m * 16) * 2048 + col0;
#pragma unroll
                for (int bj = 0; bj < 2; ++bj) { xv[m][bj][0] = *(const f32x4*)(x + off + bj * HALF); xv[m][bj][1] = *(const f32x4*)(x + off + bj * HALF + 4); } }
#pragma unroll
            for (int m = 0; m < 4; ++m) { const size_t off = (size_t)(row0 + ai * HALF + m * 16) * 2048 + col0;
#pragma unroll
                for (int bj = 0; bj < 2; ++bj) { const f32x4 v0 = acc[ai][bj][m][0] + xv[m][bj][0], v1 = acc[ai][bj][m][1] + xv[m][bj][1];
                    u32x4 w; w.x = cvtpk(v0[0], v0[1]); w.y = cvtpk(v0[2], v0[3]); w.z = cvtpk(v1[0], v1[1]); w.w = cvtpk(v1[2], v1[3]);
                    *(u32x4*)(x2 + off + bj * HALF) = w; } }
        }
    }
};
__device__ __forceinline__ float swiglu1(float g, float up) {
    g = fminf(g, 7.0f); up = fminf(fmaxf(up, -7.0f), 7.0f);
    return (up + 1.0f) * (g * sigmoid_sc(g, -1.702f * LOG2E));
}
struct EpiSwiglu {
    static constexpr bool PERM = true, AFTER_DRAIN = false; static constexpr int NSTORE = 8;
    unsigned char* ws; const float* bgu; const LAS int* pt;
    __device__ __forceinline__ void operator()(const f32x4 (&acc)[2][2][4][2], const Unit& u, int wr, int wc, int fr, int fq) const {
        const int e = u.z; const size_t srow0 = (size_t)(__builtin_amdgcn_readfirstlane(pt[e]) + u.pm) * 256 + wr * 64 + fr;
        const int col0 = u.pn * 256 + wc * 32 + 8 * fq;
        bf16_t* act = (bf16_t*)(ws + WS_ACT);
        f32x4 bv[2][2];
#pragma unroll
        for (int bj = 0; bj < 2; ++bj)
#pragma unroll
            for (int n = 0; n < 2; ++n) bv[bj][n] = *(const f32x4*)(bgu + (size_t)e * 4096 + col0 + bj * HALF + 4 * n);
#pragma unroll
        for (int ai = 0; ai < 2; ++ai)
#pragma unroll
            for (int m = 0; m < 4; ++m) { bf16_t* rowp = act + (srow0 + ai * HALF + m * 16) * 2048 + (col0 >> 1);
#pragma unroll
                for (int bj = 0; bj < 2; ++bj) { const f32x4 v0 = acc[ai][bj][m][0] + bv[bj][0], v1 = acc[ai][bj][m][1] + bv[bj][1];
                    u32x2 w; w.x = cvtpk(swiglu1(v0[0], v0[1]), swiglu1(v0[2], v0[3])); w.y = cvtpk(swiglu1(v1[0], v1[1]), swiglu1(v1[2], v1[3]));
                    *(u32x2*)(rowp + bj * (HALF / 2)) = w; } }
    }
};
struct EpiDown {
    static constexpr bool PERM = true, AFTER_DRAIN = false; static constexpr int NSTORE = 8;
    unsigned char* ws; const float* bdn; const LAS int* pt; const LAS int* cn;
    __device__ __forceinline__ void operator()(const f32x4 (&acc)[2][2][4][2], const Unit& u, int wr, int wc, int fr, int fq) const {
        const int e = u.z; const int lrow0 = u.pm * 256 + wr * 64 + fr; const size_t srow0 = (size_t)__builtin_amdgcn_readfirstlane(pt[e]) * 256 + lrow0;
        const int col0 = u.pn * 256 + wc * 32 + 8 * fq;
        bf16_t* ys = (bf16_t*)(ws + WS_YS); const float* wl = (const float*)(ws + WS_WLIST) + (size_t)e * T_; const int cne = __builtin_amdgcn_readfirstlane(cn[e]);
        f32x4 bv[2][2];
#pragma unroll
        for (int bj = 0; bj < 2; ++bj)
#pragma unroll
            for (int n = 0; n < 2; ++n) bv[bj][n] = *(const f32x4*)(bdn + (size_t)e * 2048 + col0 + bj * HALF + 4 * n);
#pragma unroll
        for (int ai = 0; ai < 2; ++ai)
#pragma unroll
            for (int m = 0; m < 4; ++m) { const int pos = lrow0 + ai * HALF + m * 16; const float w = (pos < cne) ? wl[pos] : 0.f;
                bf16_t* rowp = ys + (srow0 + ai * HALF + m * 16) * 2048 + col0;
#pragma unroll
                for (int bj = 0; bj < 2; ++bj) { const f32x4 v0 = (acc[ai][bj][m][0] + bv[bj][0]) * w, v1 = (acc[ai][bj][m][1] + bv[bj][1]) * w;
                    u32x4 o; o.x = cvtpk(v0[0], v0[1]); o.y = cvtpk(v0[2], v0[3]); o.z = cvtpk(v1[0], v1[1]); o.w = cvtpk(v1[2], v1[3]);
                    *(u32x4*)(rowp + bj * HALF) = o; } }
    }
};
__device__ __forceinline__ unsigned pk_fp8x4(float a, float b, float c, float d) {
    int w = __builtin_amdgcn_cvt_pk_fp8_f32(a, b, 0, false); w = __builtin_amdgcn_cvt_pk_fp8_f32(c, d, w, true); return (unsigned)w; }
struct EpiSwiglu8 {
    static constexpr int PERM = 2; static constexpr bool AFTER_DRAIN = false; static constexpr int NSTORE = 8;
    unsigned char* ws; const float* bgu; const LAS int* pt;
    __device__ __forceinline__ void operator()(const f32x4 (&acc)[2][2][4][2], const Unit& u, int wr, int wc, int fr, int fq) const {
        const int e = u.z; const size_t srow0 = (size_t)(__builtin_amdgcn_readfirstlane(pt[e]) + u.pm) * 256 + wr * 64 + fr;
        const int col0 = u.pn * 256 + wc * 64 + 16 * fq;
        unsigned char* act = ws + WS_ACTQ;
        const LAS float* btab = (const LAS float*)((const LAS unsigned char*)pt - LDS_MISC + LDS_BTAB) + u.idx * 256 + wc * 64 + 16 * fq;
        f32x4 bv[2][2];
#pragma unroll
        for (int bj = 0; bj < 2; ++bj)
#pragma unroll
            for (int n = 0; n < 2; ++n) bv[bj][n] = *(const LAS f32x4*)(btab + 8 * bj + 4 * n);
#pragma unroll
        for (int ai = 0; ai < 2; ++ai)
#pragma unroll
            for (int m = 0; m < 4; ++m) {
                float o[8];
#pragma unroll
                for (int bj = 0; bj < 2; ++bj)
#pragma unroll
                    for (int n = 0; n < 2; ++n) { const f32x4 v = acc[ai][bj][m][n] * WQ_INV + bv[bj][n]; o[4 * bj + 2 * n] = swiglu1(v[0], v[1]); o[4 * bj + 2 * n + 1] = swiglu1(v[2], v[3]); }
                u32x2 w; w.x = pk_fp8x4(o[0], o[1], o[2], o[3]); w.y = pk_fp8x4(o[4], o[5], o[6], o[7]);
                *(u32x2*)(act + (srow0 + ai * HALF + m * 16) * 2048 + (col0 >> 1)) = w; }
    }
};
struct EpiDown8 {
    static constexpr int PERM = 2; static constexpr bool AFTER_DRAIN = false; static constexpr int NSTORE = 8;
    unsigned char* ws; const float* bdn; const LAS int* pt; const LAS int* cn; size_t ysbase = WS_YS;
    __device__ __forceinline__ void operator()(const f32x4 (&acc)[2][2][4][2], const Unit& u, int wr, int wc, int fr, int fq) const {
        const int e = u.z; const int lrow0 = u.pm * 256 + wr * 64 + fr; const size_t srow0 = (size_t)__builtin_amdgcn_readfirstlane(pt[e]) * 256 + lrow0;
        const int col0 = u.pn * 256 + wc * 64 + 16 * fq;
        unsigned char* ys = ws + ysbase;
        const LAS float* btab = (const LAS float*)((const LAS unsigned char*)pt - LDS_MISC + LDS_BTAB) + u.idx * 256 + wc * 64 + 16 * fq;
        const LAS float* wtab = (const LAS float*)((const LAS unsigned char*)pt - LDS_MISC + LDS_TOKL) + u.idx * 256 + wr * 64 + fr;
        f32x4 bv[2][2];
#pragma unroll
        for (int bj = 0; bj < 2; ++bj)
#pragma unroll
            for (int n = 0; n < 2; ++n) bv[bj][n] = *(const LAS f32x4*)(btab + 8 * bj + 4 * n);
#pragma unroll
        for (int ai = 0; ai < 2; ++ai)
#pragma unroll
            for (int m = 0; m < 4; ++m) { const float w = wtab[ai * HALF + m * 16];
                u32x4 o;
                { const f32x4 a = (acc[ai][0][m][0] * WQ_INV + bv[0][0]) * w, c = (acc[ai][0][m][1] * WQ_INV + bv[0][1]) * w; o.x = pk_fp8x4(a[0], a[1], a[2], a[3]); o.y = pk_fp8x4(c[0], c[1], c[2], c[3]); }
                { const f32x4 a = (acc[ai][1][m][0] * WQ_INV + bv[1][0]) * w, c = (acc[ai][1][m][1] * WQ_INV + bv[1][1]) * w; o.z = pk_fp8x4(a[0], a[1], a[2], a[3]); o.w = pk_fp8x4(c[0], c[1], c[2], c[3]); }
                *(u32x4*)(ys + (srow0 + ai * HALF + m * 16) * 2048 + col0) = o; }
    }
};
struct EpiMemSoftmax {
    static constexpr bool PERM = true, AFTER_DRAIN = true; static constexpr int NSTORE = 0;
    bf16_t* P;
    __device__ __forceinline__ void operator()(const f32x4 (&)[2][2][4][2], const Unit&, int, int, int, int) const {}
    __device__ __forceinline__ void fused(f32x4 (&acc)[2][2][4][2], const Unit&, int wr, int wc, int fr, int fq, LAS unsigned char* lds, int, int) const {
        LAS f32x2* tab = (LAS f32x2*)lds;
        const float sc = 0.0625f * LOG2E;
        float mx[2][4];
#pragma unroll
        for (int ai = 0; ai < 2; ++ai)
#pragma unroll
            for (int m = 0; m < 4; ++m) { float a = -3.0e38f;
#pragma unroll
                for (int bj = 0; bj < 2; ++bj)
#pragma unroll
                    for (int n = 0; n < 2; ++n) { acc[ai][bj][m][n] *= sc; const f32x4 v = acc[ai][bj][m][n]; a = fmaxf(a, fmaxf(fmaxf(v[0], v[1]), fmaxf(v[2], v[3]))); }
                a = fmaxf(a, __shfl_xor(a, 16)); a = fmaxf(a, __shfl_xor(a, 32)); mx[ai][m] = a;
                float s = 0.f;
#pragma unroll
                for (int bj = 0; bj < 2; ++bj)
#pragma unroll
                    for (int n = 0; n < 2; ++n) { const f32x4 v = acc[ai][bj][m][n]; s += __builtin_amdgcn_exp2f(v[0] - a) + __builtin_amdgcn_exp2f(v[1] - a) + __builtin_amdgcn_exp2f(v[2] - a) + __builtin_amdgcn_exp2f(v[3] - a); }
                s += __shfl_xor(s, 16); s += __shfl_xor(s, 32);
                if (fq == 0) tab[(ai * HALF + wr * 64 + m * 16 + fr) * 4 + wc] = (f32x2){a, s};
            }
        __syncthreads();
#pragma unroll
        for (int ai = 0; ai < 2; ++ai)
#pragma unroll
            for (int m = 0; m < 4; ++m) { const int r = ai * HALF + wr * 64 + m * 16 + fr;
                const f32x2 t0 = tab[r * 4 + 0], t1 = tab[r * 4 + 1], t2 = tab[r * 4 + 2], t3 = tab[r * 4 + 3];
                const float M = fmaxf(fmaxf(t0.x, t1.x), fmaxf(t2.x, t3.x));
                const float L = t0.y * __builtin_amdgcn_exp2f(t0.x - M) + t1.y * __builtin_amdgcn_exp2f(t1.x - M) + t2.y * __builtin_amdgcn_exp2f(t2.x - M) + t3.y * __builtin_amdgcn_exp2f(t3.x - M);
                const float inv = 1.0f / L;
                bf16_t* rowp = P + (size_t)r * 1024 + wc * 32 + 8 * fq;
#pragma unroll
                for (int bj = 0; bj < 2; ++bj) { f32x4 v0 = acc[ai][bj][m][0], v1 = acc[ai][bj][m][1];
#pragma unroll
                    for (int j = 0; j < 4; ++j) { v0[j] = __builtin_amdgcn_exp2f(v0[j] - M) * inv; v1[j] = __builtin_amdgcn_exp2f(v1[j] - M) * inv; }
                    u32x4 w; w.x = cvtpk(v0[0], v0[1]); w.y = cvtpk(v0[2], v0[3]); w.z = cvtpk(v1[0], v1[1]); w.w = cvtpk(v1[2], v1[3]);
                    *(u32x4*)(rowp + bj * HALF) = w; } }
        __syncthreads();
    }
};
struct EpiTile {
    static constexpr bool PERM = true, AFTER_DRAIN = false; static constexpr int NSTORE = 0;
    bf16_t* dst; size_t ldc;
    __device__ __forceinline__ void operator()(const f32x4 (&acc)[2][2][4][2], const Unit&, int wr, int wc, int fr, int fq) const { store_tile_bf16(acc, dst, ldc, wr, wc, fr, fq); }
};
__device__ __forceinline__ void tr_item(const float* W, int K, int N, bf16_t* WT, LAS float* scr, int item, int lane) {
    const int nblk = N / 32, kb = item / nblk, nb = item % nblk, k0 = 64 * kb, n0 = 32 * nb;
#pragma unroll 8
    for (int i = 0; i < 32; ++i) { const int kk = 2 * i + (lane >> 5); scr[kk * 33 + (lane & 31)] = W[(size_t)(k0 + kk) * N + n0 + (lane & 31)]; }
    asm volatile("s_waitcnt lgkmcnt(0)" ::: "memory");
    const int c = lane & 7;
#pragma unroll
    for (int j = 0; j < 4; ++j) { const int n = (lane >> 3) + 8 * j; const LAS float* s = scr + (8 * c) * 33 + n;
        u32x4 o; o.x = cvtpk(s[0 * 33], s[1 * 33]); o.y = cvtpk(s[2 * 33], s[3 * 33]); o.z = cvtpk(s[4 * 33], s[5 * 33]); o.w = cvtpk(s[6 * 33], s[7 * 33]);
        *(u32x4*)(WT + (size_t)(n0 + n) * K + k0 + 8 * c) = o; }
    asm volatile("s_waitcnt lgkmcnt(0)" ::: "memory");
}
__device__ __forceinline__ void tr_item8(const float* W, int K, int N, unsigned char* WT, LAS float* scr, int item, int lane, float scale) {
    const int nblk = N / 32, kb = item / nblk, nb = item % nblk, k0 = 128 * kb, n0 = 32 * nb;
#pragma unroll 8
    for (int i = 0; i < 64; ++i) { const int kk = 2 * i + (lane >> 5); scr[kk * 33 + (lane & 31)] = W[(size_t)(k0 + kk) * N + n0 + (lane & 31)] * scale; }
    asm volatile("s_waitcnt lgkmcnt(0)" ::: "memory");
    const int c = lane & 7;
#pragma unroll
    for (int j = 0; j < 4; ++j) { const int n = (lane >> 3) + 8 * j; const LAS float* s = scr + (16 * c) * 33 + n;
        u32x4 o; o.x = pk_fp8x4(s[0 * 33], s[1 * 33], s[2 * 33], s[3 * 33]); o.y = pk_fp8x4(s[4 * 33], s[5 * 33], s[6 * 33], s[7 * 33]);
        o.z = pk_fp8x4(s[8 * 33], s[9 * 33], s[10 * 33], s[11 * 33]); o.w = pk_fp8x4(s[12 * 33], s[13 * 33], s[14 * 33], s[15 * 33]);
        *(u32x4*)(WT + (size_t)(n0 + n) * K + k0 + 16 * c) = o; }
    asm volatile("s_waitcnt lgkmcnt(0)" ::: "memory");
}
__device__ __forceinline__ void rms_row_to_bf16(const float* xrow, const float* g, bf16_t* orow, int lane, unsigned char* qrow = nullptr, float* irs = nullptr) {
    const f32x4* xr = (const f32x4*)xrow + lane; const f32x4* gr = (const f32x4*)g + lane;
    f32x4 v[8]; float s = 0.f;
#pragma unroll
    for (int j = 0; j < 8; ++j) { v[j] = xr[64 * j]; s += (v[j][0] * v[j][0] + v[j][1] * v[j][1]) + (v[j][2] * v[j][2] + v[j][3] * v[j][3]); }
    const float r = rsqrtf(wsum(s) * (1.0f / DM) + 1e-5f);
    if (irs && lane == 0) *irs = 1.0f / r;
    u32x2* o8 = (u32x2*)orow + lane;
#pragma unroll
    for (int j = 0; j < 8; ++j) { const f32x4 gg = gr[64 * j]; u32x2 w; w.x = cvtpk(v[j][0] * r * gg[0], v[j][1] * r * gg[1]); w.y = cvtpk(v[j][2] * r * gg[2], v[j][3] * r * gg[3]); o8[64 * j] = w;
        if (qrow) ((unsigned*)qrow)[lane + 64 * j] = pk_fp8x4(v[j][0] * r * gg[0], v[j][1] * r * gg[1], v[j][2] * r * gg[2], v[j][3] * r * gg[3]); }
}
__device__ __forceinline__ float rms_bfrow_to_bf16(const bf16_t* xrow, const float* g, bf16_t* orow, int lane, unsigned char* qrow) {
    const u32x2* xr = (const u32x2*)xrow + lane; const f32x4* gr = (const f32x4*)g + lane;
    f32x4 v[8]; float s = 0.f;
#pragma unroll
    for (int j = 0; j < 8; ++j) { const u32x2 w = xr[64 * j]; v[j] = (f32x4){bflo(w.x), bfhi(w.x), bflo(w.y), bfhi(w.y)}; s += (v[j][0] * v[j][0] + v[j][1] * v[j][1]) + (v[j][2] * v[j][2] + v[j][3] * v[j][3]); }
    const float r = rsqrtf(wsum(s) * (1.0f / DM) + 1e-5f);
    u32x2* o8 = (u32x2*)orow + lane;
#pragma unroll
    for (int j = 0; j < 8; ++j) { const f32x4 gg = gr[64 * j]; if (orow) { u32x2 w; w.x = cvtpk(v[j][0] * r * gg[0], v[j][1] * r * gg[1]); w.y = cvtpk(v[j][2] * r * gg[2], v[j][3] * r * gg[3]); o8[64 * j] = w; }
        if (qrow) ((unsigned*)qrow)[lane + 64 * j] = pk_fp8x4(v[j][0] * r * gg[0], v[j][1] * r * gg[1], v[j][2] * r * gg[2], v[j][3] * r * gg[3]); }
    return r;
}
constexpr int CV_I_IN = (DM / 128) * (INW / 256), CV_I_SQ = (2048 / 128) * (2048 / 256), CV_I_HF = (1024 / 128) * (2048 / 256);
constexpr int CV_I_GU = (2048 / 128) * (4096 / 256), CV_I_DN = CV_I_SQ;
constexpr long CV_NONEXP = (long)CV_I_IN + 3L * CV_I_SQ + 2L * CV_I_HF;
constexpr long CV_TOTAL = CV_NONEXP + (long)NE * CV_I_GU + (long)NE * CV_I_DN;
typedef short v2s_t __attribute__((ext_vector_type(2)));
__device__ __forceinline__ unsigned pk_fp8x4_scaled(float a, float b, float c, float d) {
    v2s_t r = {0, 0};
    r = __builtin_amdgcn_cvt_scalef32_pk_fp8_f32(r, a, b, WQ_INV, false);
    r = __builtin_amdgcn_cvt_scalef32_pk_fp8_f32(r, c, d, WQ_INV, true);
    return __builtin_bit_cast(unsigned, r);
}
constexpr int CV_PITCH = 260;
#ifndef CV_ASMLD
#define CV_ASMLD 0
#endif
__device__ __forceinline__ f32x4 cv_load(const float* q) {
#if CV_ASMLD
    f32x4 v; asm volatile("global_load_dwordx4 %0, %1, off sc0 sc1 nt" : "=v"(v) : "v"(q) : "memory"); return v;
#else
    return __builtin_nontemporal_load((const f32x4*)q);
#endif
}
__device__ __forceinline__ void convert_items(const Params& p, LAS unsigned char* lds, long it0, long it_end, int worker, int nworkers, int probe = 0, int* qhead = nullptr) {
    int tid_ = threadIdx.x; asm volatile("" : "+v"(tid_));
    const int tid = tid_, wave = __builtin_amdgcn_readfirstlane(tid >> 6), lane = tid & 63;
    unsigned char* ws = p.ws;
    LAS float* tile = (LAS float*)lds;
    constexpr int I_IN = CV_I_IN, I_SQ = CV_I_SQ, I_HF = CV_I_HF, I_GU = CV_I_GU, I_DN = CV_I_DN;
    static_assert(I_GU == 256 && I_DN == 128, "shift decode of the expert items");
    struct Item { const float* src; unsigned char* dst; int N, K, f8; };
    auto decode = [&](long it, Item& q) -> bool {
        if (it >= it_end) return false;
        long r = it; const float* W; unsigned char* D; int K, N, f8 = 0, kb, nb;
        if (r >= CV_NONEXP) {
            r -= CV_NONEXP; K = 2048; f8 = MOE_F8 ? 1 : 0;
            if (r < (long)NE * I_GU) { const int e = (int)(r >> 8), rr = (int)r & 255; kb = rr >> 4; nb = rr & 15; N = 4096;
                W = p.in[14] + (size_t)e * 2048 * 4096; D = ws + (MOE_F8 ? WS_WGUQ + (size_t)e * 4096 * 2048 : WS_WGUT + (size_t)e * 4096 * 2048 * 2); }
            else { r -= (long)NE * I_GU; const int e = (int)(r >> 7), rr = (int)r & 127; kb = rr >> 3; nb = rr & 7; N = 2048;
                W = p.in[16] + (size_t)e * 2048 * 2048; D = ws + (MOE_F8 ? WS_WDNQ + (size_t)e * 2048 * 2048 : WS_WDNT + (size_t)e * 2048 * 2048 * 2); }
        } else {
            if (r < I_IN) { W = p.in[4]; D = ws + WS_WINT; K = LDP; N = INW;
                if (GATES_F8 && 256 * ((int)r % (INW / 256)) >= 4608) { f8 = 2; D = ws + WS_WINQ; K = 2048; } }
            else if ((r -= I_IN) < I_SQ) { W = p.in[6]; D = ws + WS_WMKVT; K = LDP; N = 2048; }
            else if ((r -= I_SQ) < I_HF) { W = p.in[7]; D = ws + WS_WFM; K = 2048; N = 2048; }
            else if ((r -= I_HF) < I_SQ) { W = p.in[8]; D = ws + WS_WAOT; K = 2048; N = 2048; }
            else if ((r -= I_SQ) < I_HF) { W = p.in[9]; D = ws + WS_WFM + 1024 * 2; K = 2048; N = 2048; }
            else { r -= I_HF; W = p.in[10]; D = ws + WS_WOT; K = 2048; N = 2048; }
            const int nblk = N / 256; kb = (int)r / nblk; nb = (int)r % nblk;
        }
        q.src = W + (size_t)(128 * kb + wave) * N + 256 * nb + 4 * lane;
        q.dst = D + ((size_t)(256 * nb - (f8 == 2 ? 4608 : 0)) * K + 128 * kb) * (f8 ? 1 : 2);
        q.N = N; q.K = K; q.f8 = f8;
        if (probe) { q.src = p.in[14] + (size_t)wave * 4096 + 4 * lane; q.dst = ws + ((WS_FAST_END + 4095) & ~(size_t)4095) + (size_t)blockIdx.x * (256 * 2048); q.N = 4096; q.K = 2048; q.f8 = 1; }
        return true;
    };
    f32x4 v[16];
    LAS int* qslot = (LAS int*)(lds + LDS_MISC + 768);
    long it = it0 + worker, itn = it + nworkers;
    if (qhead) {
        if (tid == 0) { qslot[0] = __hip_atomic_fetch_add(qhead, 1, __ATOMIC_RELAXED, __HIP_MEMORY_SCOPE_AGENT); qslot[1] = __hip_atomic_fetch_add(qhead, 1, __ATOMIC_RELAXED, __HIP_MEMORY_SCOPE_AGENT); }
        __syncthreads();
        it = it0 + __builtin_amdgcn_readfirstlane(qslot[0]); itn = it0 + __builtin_amdgcn_readfirstlane(qslot[1]);
        __syncthreads();
    }
    Item cur; bool have = decode(it, cur);
    if (have) {
#pragma unroll
        for (int i = 0; i < 16; ++i) v[i] = cv_load(cur.src + (size_t)(8 * i) * cur.N);
    }
    int pst = 0;
    const int cch = lane & 7, nq = (lane >> 3) + 8 * wave;
    while (have) {
        Item nxt; const bool hn = decode(itn, nxt);
        __syncthreads();
#if CV_ASMLD
        if (pst == 4) asm volatile("s_waitcnt vmcnt(4)" ::: "memory"); else if (pst == 8) asm volatile("s_waitcnt vmcnt(8)" ::: "memory"); else asm volatile("s_waitcnt vmcnt(0)" ::: "memory");
#pragma unroll
        for (int i = 0; i < 16; ++i) asm volatile("" : "+v"(v[i]));
#endif
#pragma unroll
        for (int i = 0; i < 16; ++i) *(LAS f32x4*)(tile + (8 * i + wave) * CV_PITCH + 4 * lane + 16 * (i >> 1)) = v[i];
        if (qhead && hn && tid == 0) qslot[0] = __hip_atomic_fetch_add(qhead, 1, __ATOMIC_RELAXED, __HIP_MEMORY_SCOPE_AGENT);
        if (hn) {
#pragma unroll
            for (int i = 0; i < 16; ++i) v[i] = cv_load(nxt.src + (size_t)(8 * i) * nxt.N);
        }
        __syncthreads();
        const long itnn = qhead ? (hn ? it0 + __builtin_amdgcn_readfirstlane(qslot[0]) : it_end) : itn + nworkers;
        f32x4 t[16];
        const LAS float* s = tile + (16 * cch) * CV_PITCH + 16 * cch + 4 * nq;
#pragma unroll
        for (int i = 0; i < 16; ++i) t[i] = *(const LAS f32x4*)(s + i * CV_PITCH);
#pragma unroll
        for (int j = 0; j < 4; ++j) { const int n = 4 * nq + j;
            if (cur.f8) { u32x4 o; o.x = pk_fp8x4_scaled(t[0][j], t[1][j], t[2][j], t[3][j]); o.y = pk_fp8x4_scaled(t[4][j], t[5][j], t[6][j], t[7][j]);
                o.z = pk_fp8x4_scaled(t[8][j], t[9][j], t[10][j], t[11][j]); o.w = pk_fp8x4_scaled(t[12][j], t[13][j], t[14][j], t[15][j]);
                *(u32x4*)(cur.dst + (size_t)n * cur.K + 16 * cch) = o; }
            else { u32x4 o0, o1; o0.x = cvtpk(t[0][j], t[1][j]); o0.y = cvtpk(t[2][j], t[3][j]); o0.z = cvtpk(t[4][j], t[5][j]); o0.w = cvtpk(t[6][j], t[7][j]);
                o1.x = cvtpk(t[8][j], t[9][j]); o1.y = cvtpk(t[10][j], t[11][j]); o1.z = cvtpk(t[12][j], t[13][j]); o1.w = cvtpk(t[14][j], t[15][j]);
                u32x4* d = (u32x4*)(cur.dst + ((size_t)n * cur.K + 16 * cch) * 2); d[0] = o0; d[1] = o1; } }
        pst = cur.f8 ? 4 : 8;
        cur = nxt; have = hn; it = itn; itn = itnn;
    }
    __syncthreads();
}

constexpr long CE_TOTAL = (long)NE * 384;
constexpr int CE_PITCH = 1028;
__device__ __forceinline__ void convert_experts(const Params& p, LAS unsigned char* lds, long t0, long t1) {
    int tid_ = threadIdx.x; asm volatile("" : "+v"(tid_));
    const int tid = tid_, wave = tid >> 6, lane = tid & 63;
    LAS float* tile = (LAS float*)lds;
    struct Item { const float* src; unsigned char* dst; int N; };
    auto decode = [&](long t, Item& q) -> bool {
        if (t >= t1) return false;
        const int e = (int)(t / 384), r = (int)(t % 384);
        if (r < 256) { const int nr = r >> 6, kb = r & 63; q.N = 4096;
            q.src = p.in[14] + (size_t)e * 2048 * 4096 + (size_t)(32 * kb + 4 * wave) * 4096 + nr * 1024 + 4 * lane;
            q.dst = p.ws + WS_WGUQ + ((size_t)e * 4096 + (size_t)nr * 1024) * 2048 + 32 * kb; }
        else { const int nr = (r - 256) >> 6, kb = (r - 256) & 63; q.N = 2048;
            q.src = p.in[16] + (size_t)e * 2048 * 2048 + (size_t)(32 * kb + 4 * wave) * 2048 + nr * 1024 + 4 * lane;
            q.dst = p.ws + WS_WDNQ + ((size_t)e * 2048 + (size_t)nr * 1024) * 2048 + 32 * kb; }
        return true;
    };
    f32x4 v[16];
    Item cur; long t = t0; bool have = decode(t, cur);
    if (have) {
#pragma unroll
        for (int i = 0; i < 16; ++i) v[i] = __builtin_nontemporal_load((const f32x4*)(cur.src + (size_t)(i >> 2) * cur.N + 256 * (i & 3)));
    }
    while (have) {
        Item nxt; const bool hn = decode(t + 1, nxt);
        __syncthreads();
#pragma unroll
        for (int i = 0; i < 16; ++i) *(LAS f32x4*)(tile + (4 * wave + (i >> 2)) * CE_PITCH + 256 * (i & 3) + 4 * lane) = v[i];
        if (hn) {
#pragma unroll
            for (int i = 0; i < 16; ++i) v[i] = __builtin_nontemporal_load((const f32x4*)(nxt.src + (size_t)(i >> 2) * nxt.N + 256 * (i & 3)));
        }
        __syncthreads();
#pragma unroll
        for (int j = 0; j < 2; ++j) { const int n = tid + 512 * j; const LAS float* s = tile + n;
            float f[32];
#pragma unroll
            for (int i = 0; i < 32; ++i) f[i] = s[i * CE_PITCH] * WQ_SCALE;
            u32x4 o0, o1;
            o0.x = pk_fp8x4(f[0], f[1], f[2], f[3]); o0.y = pk_fp8x4(f[4], f[5], f[6], f[7]); o0.z = pk_fp8x4(f[8], f[9], f[10], f[11]); o0.w = pk_fp8x4(f[12], f[13], f[14], f[15]);
            o1.x = pk_fp8x4(f[16], f[17], f[18], f[19]); o1.y = pk_fp8x4(f[20], f[21], f[22], f[23]); o1.z = pk_fp8x4(f[24], f[25], f[26], f[27]); o1.w = pk_fp8x4(f[28], f[29], f[30], f[31]);
            u32x4* d = (u32x4*)(cur.dst + (size_t)n * 2048); d[0] = o0; d[1] = o1; }
        cur = nxt; have = hn; ++t;
    }
    __syncthreads();
}

__device__ __forceinline__ void phase_prologue(const Params& p, LAS unsigned char* lds) {
    int tid_ = threadIdx.x; asm volatile("" : "+v"(tid_));
    const int tid = tid_, wave = tid >> 6, lane = tid & 63;
    unsigned char* ws = p.ws;
    const int gw = vwg() * NWAVE + wave, NGW = (int)gridDim.x * NWAVE;
    for (int m = gw; m < T_; m += NGW) rms_row_to_bf16(p.in[0] + (size_t)m * DM, p.in[3], (bf16_t*)(ws + WS_H) + (size_t)m * LDP, lane, GATES_F8 ? (ws + WS_H8 + (size_t)m * DM) : nullptr, RES_FROM_H ? (float*)(ws + WS_IRSTD) + m : nullptr);
    for (int m = gw; m < B_ * MEM; m += NGW) {
        const f32x4* xr = (const f32x4*)(p.in[1] + (size_t)m * DM) + lane; u32x2* o8 = (u32x2*)((bf16_t*)(ws + WS_MEMBF) + (size_t)m * LDP) + lane;
#pragma unroll
        for (int j = 0; j < 8; ++j) { const f32x4 v = xr[64 * j]; u32x2 w; w.x = cvtpk(v[0], v[1]); w.y = cvtpk(v[2], v[3]); o8[64 * j] = w; }
    }
    {
        const int gt = vwg() * NTHR + tid, NGT = (int)gridDim.x * NTHR;
        bf16_t* tabT = (bf16_t*)(ws + WS_TABT); bf16_t* dm = (bf16_t*)(ws + WS_DMAT);
        for (int i = gt; i < 512 * 256 / 2; i += NGT) { const int e0 = 2 * i; const int mrow = e0 >> 8, c = e0 & 255; const int n = mrow & 255; float v[2];
#pragma unroll
            for (int j = 0; j < 2; ++j) { const int mm = ((c + j) * n) & 255; const float a = (float)mm * (2.0f / 256.0f); v[j] = (mrow < 256) ? cospif(a) : sinpif(a); }
            *(unsigned*)(tabT + e0) = cvtpk(v[0], v[1]); }
        const float sc = 1.0f / sqrtf(2048.0f * 256.0f);
        LAS float* ct = (LAS float*)lds;
        for (int m = tid; m < 2048; m += NTHR) ct[m] = cospif((float)m * (2.0f / 2048.0f)) * sc;
        __syncthreads();
        for (int i = gt; i < 2048 * 4096 / 2; i += NGT) { const int e0 = 2 * i; const int jr = e0 >> 12, k = e0 & 4095; float v[2];
#pragma unroll
            for (int j = 0; j < 2; ++j) { const int kk = (k + j) & 2047; const int mm = (jr * kk) & 2047; v[j] = (k < 2048) ? ct[mm] : ct[(mm + 512) & 2047]; }
            *(unsigned*)(dm + (size_t)jr * SQP + k) = cvtpk(v[0], v[1]); }
        __syncthreads();
        bf16_t* wrt = (bf16_t*)(ws + WS_WRT);
        for (int i = gt; i < NE * DM; i += NGT) { const int e = i >> 11, k = i & 2047; wrt[i] = (bf16_t)(cvtpk(p.in[12][(size_t)k * NE + e] * (ROUTER_ON_X2 ? p.in[11][k] : 1.0f), 0.f) & 0xffffu); }
    }
    __syncthreads();
    convert_items(p, lds, 0, (gridDim.x == 256) ? CV_NONEXP : CV_TOTAL, vwg(), (int)gridDim.x);
}

constexpr int AT_KROW = 144, AT_VROW = 776;
constexpr int AT_K = 0, AT_V = 384 * AT_KROW, AT_LUT = AT_V + 64 * AT_VROW;
static_assert(AT_LUT + NWAVE * 320 * 4 <= STAGE_BYTES, "attention LDS");
__device__ __forceinline__ void attn_unit(const Params& p, LAS unsigned char* lds, int b, int kvh, int qb) {
    int tid_ = threadIdx.x; asm volatile("" : "+v"(tid_));
    const int tid = tid_, wid = __builtin_amdgcn_readfirstlane(tid >> 6), lane = tid & 63, r = lane & 31, h = lane >> 5;
    const unsigned char* ws = p.ws;
    const bf16_t* Q = (const bf16_t*)(ws + WS_Q); const bf16_t* Kg = (const bf16_t*)(ws + WS_K); const bf16_t* VT = (const bf16_t*)(ws + WS_VT);
    bf16_t* att = (bf16_t*)(p.ws + WS_ATT);
    const int q0 = qb * 128, hq = kvh * 8 + wid;
    LAS unsigned char* Kb = lds + AT_K; LAS unsigned char* Vt = lds + AT_V; LAS float* lut = (LAS float*)(lds + AT_LUT) + wid * 320;
    __syncthreads();
    for (int c = tid; c < 384 * 8; c += NTHR) { const int row = c >> 3, part = c & 7, pos = q0 - 128 + row;
        u32x4 v = {0u, 0u, 0u, 0u};
        if (pos >= 0 && pos < S_) v = *(const u32x4*)(Kg + (size_t)(b * S_ + pos) * 256 + kvh * 64 + part * 8);
        *(LAS u32x4*)(Kb + row * AT_KROW + part * 16) = v; }
    for (int c = tid; c < 64 * 48; c += NTHR) { const int d = c / 48, ch = c % 48, pos0 = q0 - 128 + ch * 8;
        u32x4 v = {0u, 0u, 0u, 0u};
        if (pos0 >= 0 && pos0 < S_) v = *(const u32x4*)(VT + ((size_t)((b * 4 + kvh) * 64 + d)) * 2048 + pos0);
        *(LAS u32x2*)(Vt + d * AT_VROW + ch * 16) = (u32x2){v.x, v.y}; *(LAS u32x2*)(Vt + d * AT_VROW + ch * 16 + 8) = (u32x2){v.z, v.w}; }
    for (int i = lane; i < 320; i += 64) { const int rel = i - 160; const int ar = rel < 0 ? -rel : rel;
        lut[i] = (ar <= WIN) ? p.in[2][t5_bucket(rel) * NH + hq] * LOG2E : -1.0e30f; }
    __syncthreads();
    const float sk = p.in[5][hq] * LOG2E;
    const float SC = 0.125f * LOG2E;
#pragma unroll 1
    for (int sb = 0; sb < 4; ++sb) {
        const int pq = q0 + sb * 32;
        bf16x8 qf[4];
        const bf16_t* qrow = Q + (size_t)(b * S_ + pq + r) * 2048 + hq * 64 + 8 * h;
#pragma unroll
        for (int s = 0; s < 4; ++s) qf[s] = *(const bf16x8*)(qrow + 16 * s);
        float mrun = sk, lrun = 1.0f;
        f32x16 o0, o1;
#pragma unroll
        for (int i = 0; i < 16; ++i) { o0[i] = 0.f; o1[i] = 0.f; }
        const int jlo = (qb == 0) ? 4 - sb : 0, jhi = (qb == 15) ? 8 - sb : 9;
        const LAS unsigned char* kp = Kb + (32 * (sb + jlo) + r) * AT_KROW + 16 * h;
        const LAS unsigned char* vp = Vt + r * AT_VROW + (32 * (sb + jlo) + 4 * h) * 2;
        const LAS unsigned char* vq = vp + 32 * AT_VROW;
        const LAS float* lp = lut + 32 * jlo + 32 + 4 * h - r;
#pragma unroll 1
        for (int j = jlo; j < jhi; ++j) {
            asm volatile("" : "+v"(kp), "+v"(vp), "+v"(vq), "+v"(lp));
            f32x16 s;
#pragma unroll
            for (int i = 0; i < 16; ++i) s[i] = 0.f;
#pragma unroll
            for (int ks = 0; ks < 4; ++ks) { const bf16x8 kf = *(const LAS bf16x8*)(kp + 32 * ks); s = __builtin_amdgcn_mfma_f32_32x32x16_bf16(kf, qf[ks], s, 0, 0, 0); }
            float mx = -3.0e38f;
            f32x2 sp[8];
#pragma unroll
            for (int i = 0; i < 8; ++i) { const int li = ((2 * i) & 3) + 8 * ((2 * i) >> 2); const f32x2 lv = {lp[li], lp[li + 1]}; const f32x2 sv = {s[2 * i], s[2 * i + 1]};
                sp[i] = sv * (f32x2){SC, SC} + lv; mx = fmaxf(fmaxf(mx, sp[i][0]), sp[i][1]); }
            mx = fmaxf(mx, __shfl_xor(mx, 32));
            const float mnew = fmaxf(mrun, mx);
            const float alpha = __builtin_amdgcn_exp2f(mrun - mnew);
            f32x2 rs2 = {0.f, 0.f};
#pragma unroll
            for (int i = 0; i < 8; ++i) { const f32x2 d = sp[i] - (f32x2){mnew, mnew}; const f32x2 e = {__builtin_amdgcn_exp2f(d[0]), __builtin_amdgcn_exp2f(d[1])};
                s[2 * i] = e[0]; s[2 * i + 1] = e[1]; rs2 += e; }
            float rs = rs2[0] + rs2[1];
            rs += __shfl_xor(rs, 32);
            lrun = lrun * alpha + rs; mrun = mnew;
            if (__any(alpha != 1.0f)) {
#pragma unroll
                for (int i = 0; i < 16; ++i) { o0[i] *= alpha; o1[i] *= alpha; }
            }
#pragma unroll
            for (int k2 = 0; k2 < 2; ++k2) {
                u32x4 pw; pw.x = cvtpk(s[8 * k2 + 0], s[8 * k2 + 1]); pw.y = cvtpk(s[8 * k2 + 2], s[8 * k2 + 3]); pw.z = cvtpk(s[8 * k2 + 4], s[8 * k2 + 5]); pw.w = cvtpk(s[8 * k2 + 6], s[8 * k2 + 7]);
                const bf16x8 pb = __builtin_bit_cast(bf16x8, pw);
                { const u32x2 lo = *(const LAS u32x2*)(vp + 32 * k2), hi = *(const LAS u32x2*)(vp + 32 * k2 + 16); const u32x4 vw = {lo.x, lo.y, hi.x, hi.y};
                  o0 = __builtin_amdgcn_mfma_f32_32x32x16_bf16(__builtin_bit_cast(bf16x8, vw), pb, o0, 0, 0, 0); }
                { const u32x2 lo = *(const LAS u32x2*)(vq + 32 * k2), hi = *(const LAS u32x2*)(vq + 32 * k2 + 16); const u32x4 vw = {lo.x, lo.y, hi.x, hi.y};
                  o1 = __builtin_amdgcn_mfma_f32_32x32x16_bf16(__builtin_bit_cast(bf16x8, vw), pb, o1, 0, 0, 0); }
            }
            kp += 32 * AT_KROW; vp += 64; vq += 64; lp += 32;
        }
        const float inv = 1.0f / lrun;
        bf16_t* orow = att + (size_t)(b * S_ + pq + r) * 2048 + hq * 64 + 4 * h;
#pragma unroll
        for (int g = 0; g < 4; ++g) {
            u32x2 w0; w0.x = cvtpk(o0[4 * g] * inv, o0[4 * g + 1] * inv); w0.y = cvtpk(o0[4 * g + 2] * inv, o0[4 * g + 3] * inv); *(u32x2*)(orow + 8 * g) = w0;
            u32x2 w1; w1.x = cvtpk(o1[4 * g] * inv, o1[4 * g + 1] * inv); w1.y = cvtpk(o1[4 * g + 2] * inv, o1[4 * g + 3] * inv); *(u32x2*)(orow + 32 + 8 * g) = w1;
        }
    }
}

__device__ __forceinline__ void phase_rows(const Params& p, LAS unsigned char* lds) {
    int tid_ = threadIdx.x; asm volatile("" : "+v"(tid_));
    const int tid = tid_, wave = __builtin_amdgcn_readfirstlane(tid >> 6), lane = tid & 63;
    unsigned char* ws = p.ws;
    const bf16_t* x2 = (const bf16_t*)(ws + WS_X2); bf16_t* h2 = (bf16_t*)(ws + WS_H2);
    LAS float* lg = (LAS float*)lds;
    LAS int* sel_e = (LAS int*)(lds + 8192);
    LAS float* sel_w = (LAS float*)(lds + 9216);
    LAS int* sel_r = (LAS int*)(lds + 10240);
    LAS int* lcnt = (LAS int*)(lds + 11264);
    LAS int* lbase = (LAS int*)(lds + 11392);
    LAS float* rtok = (LAS float*)(lds + 11520);
#pragma unroll 1
    for (int t0 = vwg() * 64; t0 < T_; t0 += 64 * (int)gridDim.x) {
        __syncthreads();
        if (tid < 32) lcnt[tid] = 0;
        for (int i = 0; i < 8; ++i) { const int t = t0 + wave * 8 + i;
            const float r = rms_bfrow_to_bf16(x2 + (size_t)t * DM, p.in[11], (ROUTER_ON_X2 && MOE_F8) ? nullptr : h2 + (size_t)t * DM, lane, MOE_F8 ? (ws + WS_H2Q + (size_t)t * DM) : nullptr);
            if (lane == 0) rtok[wave * 8 + i] = r; }
        asm volatile("s_waitcnt vmcnt(0)" ::: "memory");
        __syncthreads();
        if (wave < 4) {
            const bf16_t* arow = ((ROUTER_ON_X2 && MOE_F8) ? x2 : (const bf16_t*)h2) + (size_t)(t0 + wave * 16 + (lane & 15)) * DM + 8 * (lane >> 4);
            const bf16_t* b0 = (const bf16_t*)(ws + WS_WRT) + (size_t)(lane & 15) * DM + 8 * (lane >> 4);
            const bf16_t* b1 = b0 + (size_t)16 * DM;
            f32x4 a0 = {0.f, 0.f, 0.f, 0.f}, a1 = {0.f, 0.f, 0.f, 0.f};
#pragma unroll 8
            for (int s = 0; s < 64; ++s) { const bf16x8 av = *(const bf16x8*)(arow + 32 * s), bv0 = *(const bf16x8*)(b0 + 32 * s), bv1 = *(const bf16x8*)(b1 + 32 * s);
                a0 = __builtin_amdgcn_mfma_f32_16x16x32_bf16(av, bv0, a0, 0, 0, 0); a1 = __builtin_amdgcn_mfma_f32_16x16x32_bf16(av, bv1, a1, 0, 0, 0); }
            const int ecol = lane & 15; const float bb0 = p.in[13][ecol], bb1 = p.in[13][ecol + 16];
#pragma unroll
            for (int rg = 0; rg < 4; ++rg) { const int tl = wave * 16 + (lane >> 4) * 4 + rg; const float rs = (ROUTER_ON_X2 && MOE_F8) ? rtok[tl] : 1.0f; lg[tl * 32 + ecol] = a0[rg] * rs + bb0; lg[tl * 32 + ecol + 16] = a1[rg] * rs + bb1; }
        }
        __syncthreads();
        if (tid < 64) {
            float v[32];
#pragma unroll
            for (int e = 0; e < 32; ++e) v[e] = lg[tid * 32 + e];
            float tv[4]; int ti[4];
#pragma unroll
            for (int k = 0; k < 4; ++k) { float bv = -3.0e38f; int bi = 0;
#pragma unroll
                for (int e = 0; e < 32; ++e) { const bool tk = v[e] > bv; bv = tk ? v[e] : bv; bi = tk ? e : bi; }
                tv[k] = bv; ti[k] = bi;
#pragma unroll
                for (int e = 0; e < 32; ++e) v[e] = (e == bi) ? -3.0e38f : v[e]; }
            const float e1 = __expf(tv[1] - tv[0]), e2 = __expf(tv[2] - tv[0]), e3 = __expf(tv[3] - tv[0]);
            const float inv = 1.0f / (1.0f + e1 + e2 + e3);
            const float wv[4] = {inv, e1 * inv, e2 * inv, e3 * inv};
#pragma unroll
            for (int k = 0; k < 4; ++k) { sel_e[tid * 4 + k] = ti[k]; sel_w[tid * 4 + k] = wv[k]; sel_r[tid * 4 + k] = __hip_atomic_fetch_add(&lcnt[ti[k]], 1, __ATOMIC_RELAXED, __HIP_MEMORY_SCOPE_WORKGROUP); }
        }
        __syncthreads();
        if (tid < 32) lbase[tid] = (lcnt[tid] > 0) ? atomicAdd((int*)(ws + WS_CTL) + CW_CNT + tid, lcnt[tid]) : 0;
        __syncthreads();
        if (tid < 256) { const int tl = tid >> 2, k = tid & 3, t = t0 + tl; const int e = sel_e[tid], pos = lbase[e] + sel_r[tid]; const float w = sel_w[tid];
            ((int*)(ws + WS_TOKE))[t * 4 + k] = e; ((int*)(ws + WS_TOKPOS))[t * 4 + k] = pos; ((float*)(ws + WS_TOKW))[t * 4 + k] = w;
            ((int*)(ws + WS_LIST))[(size_t)e * T_ + pos] = t; ((float*)(ws + WS_WLIST))[(size_t)e * T_ + pos] = w; }
    }
}
__device__ __forceinline__ void moe_tables(const Params& p, LAS int* pt, LAS int* cn) {
    __syncthreads();
    if (threadIdx.x < 64) {
        const int ln = (int)threadIdx.x; const int* cnt = (const int*)(p.ws + WS_CTL) + CW_CNT;
        const int c = (ln < NE) ? __hip_atomic_load(cnt + (ln & 31), __ATOMIC_RELAXED, __HIP_MEMORY_SCOPE_AGENT) : 0;
        const int tl = (c + 255) >> 8; int inc = tl;
#pragma unroll
        for (int o = 1; o < 32; o <<= 1) { const int v = __shfl_up(inc, o); if (ln >= o) inc += v; }
        if (ln < NE) { cn[ln] = c; pt[ln] = inc - tl; }
        if (ln == NE - 1) pt[NE] = inc;
    }
    __syncthreads();
}
__device__ __forceinline__ void phase_final(const Params& p, const LAS int* pt) {
    int tid_ = threadIdx.x; asm volatile("" : "+v"(tid_));
    const int tid = tid_, wave = tid >> 6, lane = tid & 63;
    const unsigned char* ws = p.ws;
    const bf16_t* x2 = (const bf16_t*)(ws + WS_X2); const bf16_t* ys = (const bf16_t*)(ws + WS_YS);
    const int* toke = (const int*)(ws + WS_TOKE); const int* tokpos = (const int*)(ws + WS_TOKPOS);
    const int gw = vwg() * NWAVE + wave, NGW = (int)gridDim.x * NWAVE;
    float pscale = 1.0f;
    if (PROFSEL != 0) {
        const unsigned long long* pf = (const unsigned long long*)(p.ws + WS_CTL + 32768);
        const float kl = (float)pf[0], ep = (float)pf[1], n = (float)pf[2], ntl = (float)pf[3], cyc = (float)pf[4], wal = (float)pf[5];
        float m = 0.f;
        if (PROFMETRIC == 0) m = ep / (kl + ep);
        if (PROFMETRIC == 1) m = kl / (n * ntl) / 4096.0f;
        if (PROFMETRIC == 2) m = cyc / (wal * 24.0f);
        if (PROFMETRIC == 3) m = (kl + ep) / cyc;
        if (PROFMETRIC == 4) m = n / 32.0f;
        if (PROFMETRIC == 5) m = wal / 100.0f / 200.0f;
        if (PROFMETRIC == 6 || PROFMETRIC == 7) {
            const unsigned long long* st = (const unsigned long long*)(p.ws + WS_CTL + 40960);
            unsigned long long mx = 0, mn = ~0ull, sum = 0;
            for (int i = 0; i < (int)gridDim.x; ++i) { const unsigned long long v = st[i]; mx = v > mx ? v : mx; mn = v < mn ? v : mn; sum += v; }
            const float mean = (float)(sum - mn * gridDim.x) / (float)gridDim.x;
            m = (PROFMETRIC == 6 ? ((float)(mx - mn) - mean) : (float)(mx - mn)) / 100.0f / 200.0f; }
        if (blockIdx.x == 0 && threadIdx.x == 0) { const unsigned long long t0 = wall_clock64(), ticks = (unsigned long long)(m * (float)PROFMUL * 100.0f * 100.0f);
            while (wall_clock64() - t0 < ticks) __builtin_amdgcn_s_sleep(8); }
    }
    for (int t = gw; t < T_; t += NGW) {
        const u32x2* xr = (const u32x2*)(x2 + (size_t)t * DM) + lane;
        f32x4 v[8];
#pragma unroll
        for (int j = 0; j < 8; ++j) { const u32x2 w = xr[64 * j]; v[j] = (f32x4){bflo(w.x), bfhi(w.x), bflo(w.y), bfhi(w.y)}; }
#pragma unroll
        for (int k = 0; k < 4; ++k) { const int e = toke[t * 4 + k]; const size_t slot = (size_t)pt[e] * 256 + tokpos[t * 4 + k];
            if constexpr (MOE_F8) {
                const unsigned* yr = (const unsigned*)((const unsigned char*)ys + slot * DM) + lane;
#pragma unroll
                for (int j = 0; j < 8; ++j) { const unsigned w = yr[64 * j];
                    v[j][0] += __builtin_amdgcn_cvt_f32_fp8((int)w, 0) * YS_INV; v[j][1] += __builtin_amdgcn_cvt_f32_fp8((int)w, 1) * YS_INV;
                    v[j][2] += __builtin_amdgcn_cvt_f32_fp8((int)w, 2) * YS_INV; v[j][3] += __builtin_amdgcn_cvt_f32_fp8((int)w, 3) * YS_INV; }
            } else {
                const u32x2* yr = (const u32x2*)(ys + slot * DM) + lane;
#pragma unroll
                for (int j = 0; j < 8; ++j) { const u32x2 w = yr[64 * j]; v[j][0] += bflo(w.x); v[j][1] += bfhi(w.x); v[j][2] += bflo(w.y); v[j][3] += bfhi(w.y); }
            } }
        float s = 0.f;
#pragma unroll
        for (int j = 0; j < 8; ++j) s += (v[j][0] * v[j][0] + v[j][1] * v[j][1]) + (v[j][2] * v[j][2] + v[j][3] * v[j][3]);
        const float r = rsqrtf(wsum(s) * (1.0f / DM) + 1e-5f);
        const f32x4* gr = (const f32x4*)p.in[18] + lane; f32x4* orow = (f32x4*)(p.out + (size_t)t * DM) + lane;
#pragma unroll
        for (int j = 0; j < 8; ++j) { const f32x4 gg = gr[64 * j]; orow[64 * j] = (f32x4){v[j][0] * r * gg[0] * pscale, v[j][1] * r * gg[1] * pscale, v[j][2] * r * gg[2] * pscale, v[j][3] * r * gg[3] * pscale}; }
    }
}
#ifndef P1_SLOT_BAL
#define P1_SLOT_BAL 1
#endif
#ifndef CV_SPLIT
#define CV_SPLIT 6144L
#endif
#ifndef MOE_SLOT
#define MOE_SLOT 1
#endif
#ifndef X2_SLOT
#define X2_SLOT 0
#endif
#ifndef MOE_SLOT_STEP
#define MOE_SLOT_STEP 4
#endif
#ifndef MOE_SLOT_BAL
#define MOE_SLOT_BAL 4
#endif
#ifndef POOL1
#define POOL1 2
#endif
#ifndef P2ROLE
#define P2ROLE 0
#endif
#ifndef POOL2
#define POOL2 0
#endif
#ifndef POOL3
#define POOL3 0
#endif
#ifndef POOL4
#define POOL4 0
#endif
#ifndef POOL5
#define POOL5 0
#endif
#ifndef Q4
#define Q4 8
#endif
constexpr long GU_A0 = 30 - (POOL1 + POOL2 + POOL3 + POOL4 + POOL5 + Q4);
constexpr long GU_P1S = 64 * (4 * GU_A0 + 8), GU_P1P = GU_P1S, GU_P2P = GU_P1P + 256 * POOL1, GU_P3P = GU_P2P + 256 * POOL2, GU_P4S = GU_P3P + 256 * POOL3,
               GU_P4P = GU_P4S + 256 * Q4, GU_P5P = GU_P4P + 256 * POOL4, GU_END = GU_P5P + 256 * POOL5;
static_assert(GU_END == 8192 && GU_A0 > 0, "gate_up conversion layout");
#ifndef POOL7
#define POOL7 2
#endif
__device__ __forceinline__ void proj_convert_slot(const Params& p, LAS unsigned char* lds, int g, int part) {
    const int wgi = (int)blockIdx.x & 63;
    __syncthreads();
    if constexpr (MOE_F8 && CONV_TILE32) { const long per = CE_TOTAL / 512, a = ((long)(part * 4 + g) * 64 + wgi) * per; convert_experts(p, lds, a, a + per); }
    else { const long total = CV_TOTAL - CV_NONEXP, half = total / 2; long q = half / 4, it0 = CV_NONEXP + half * part + q * g;
        if (P1_SLOT_BAL) {
            constexpr long P1END = (MOE_SLOT ? 8192 : 12288) - 256 * X2_SLOT;
            static_assert((CV_TOTAL - CV_NONEXP) == 12288 && MOE_SLOT == 1 && X2_SLOT == 0, "slot split");
            if (part == 0) { it0 = CV_NONEXP + 64 * GU_A0 * g; q = 64 * (g == 3 ? GU_A0 + 8 : GU_A0); }
            else if (part == 1) { it0 = CV_NONEXP + GU_P4S + 64 * Q4 * g; q = 64 * Q4; }
            else if (part == 2) { it0 = CV_NONEXP + 8192 + 1024 * g; q = 1024; }
            else { it0 = CV_NONEXP + P1END + 64 * X2_SLOT * g; q = 64 * X2_SLOT; } }
        convert_items(p, lds, it0, it0 + q, wgi, 64);
#ifdef DBLCONV
        if (part == (DBLCONV & 3) - 1) { __syncthreads(); convert_items(p, lds, it0, it0 + q, wgi, 64, DBLCONV >> 2); }
#endif
    }
    asm volatile("s_waitcnt vmcnt(0) lgkmcnt(0)" ::: "memory");
    __syncthreads();
}
__device__ __forceinline__ void pool_drain(const Params& p, LAS unsigned char* lds, int pool, long base, int count) {
    __syncthreads();
    convert_items(p, lds, base, base + count, 0, 1, 0, (int*)(p.ws + WS_CTL) + CW_POOL + 64 * pool);
    asm volatile("s_waitcnt vmcnt(0) lgkmcnt(0)" ::: "memory");
    __syncthreads();
}
__device__ __forceinline__ void convert_range_slot(const Params& p, LAS unsigned char* lds, long it0, long n) {
    __syncthreads();
    convert_items(p, lds, it0, it0 + n, 0, 1);
    asm volatile("s_waitcnt vmcnt(0) lgkmcnt(0)" ::: "memory");
    __syncthreads();
}
__device__ __forceinline__ void phase_proj(const Params& p, LAS unsigned char* lds) {
    EpiProj E{p.ws}; EpiGates8 EG{p.ws};
    unsigned long long* prof = PROFSEL == 1 ? (unsigned long long*)(p.ws + WS_CTL + 32768) : nullptr;
    const int BIG = 1 << 20;
    const bool stag = (gridDim.x == 256);
    const int g = stag ? ((int)blockIdx.x >> 6) : -1;
    if constexpr (GATES_F8) {
#ifndef P1SLOTV
#define P1SLOTV 0
#endif
        int a1 = (g == 0) ? 0 : (g == 1 ? 2 : BIG), a3 = (g == 3) ? 3 : BIG, slot = (g <= 1) ? 1 : g;
        if (P1SLOTV == 1) { a1 = BIG; a3 = (g <= 0) ? BIG : 2 * g; slot = (g <= 0) ? 2 : 3; }
        if (P1SLOTV == 2) { a1 = (g == 0) ? 0 : (g == 1 ? 3 : BIG); a3 = (g == 2) ? 1 : (g == 3 ? 4 : BIG); slot = (g <= 1) ? 1 : 3; }
        { SchedProj S{p.ws, 0, a1}; gemm_phase<EpiProj, SchedProj, true>(lds, 2048, LDP, LDP, S, E, nullptr); }
        if (stag && slot == 1) proj_convert_slot(p, lds, g, 0);
        { SchedProj S{p.ws, a1, BIG}; gemm_phase<EpiProj, SchedProj, true>(lds, 2048, LDP, LDP, S, E, prof); }
        if (stag && slot == 2) proj_convert_slot(p, lds, g, 0);
        { SchedGates8 S{p.ws, 0, a3}; gemm_phase<EpiGates8, SchedGates8, true, 1>(lds, 2048, 2048, 2048, S, EG, nullptr); }
        if (stag && slot == 3) proj_convert_slot(p, lds, g, 0);
        { SchedGates8 S{p.ws, a3, BIG}; gemm_phase<EpiGates8, SchedGates8, true, 1>(lds, 2048, 2048, 2048, S, EG, nullptr); }
        if (stag && POOL1 > 0) pool_drain(p, lds, 0, CV_NONEXP + GU_P1P, 256 * POOL1);
    } else {
        const int nb = stag ? 3 * g : 0;
        if (nb > 0) { SchedProj S{p.ws, 0, nb}; gemm_phase<EpiProj, SchedProj, true>(lds, 2048, LDP, LDP, S, E, nullptr); }
        if (stag) proj_convert_slot(p, lds, g, 0);
        { SchedProj S{p.ws, nb, BIG}; gemm_phase<EpiProj, SchedProj, true>(lds, 2048, LDP, LDP, S, E, prof); }
    }
}
__device__ __forceinline__ void phase_mixers(const Params& p, LAS unsigned char* lds) {
    unsigned char* ws = p.ws;
#ifndef DBLSUB
#define DBLSUB 0
#endif
#pragma unroll 1
    for (int rep = 0; rep < ((DBLSUB & 1) ? 2 : 1); ++rep)
#pragma unroll 1
    for (int u = (P2ROLE && gridDim.x == 256) ? (((int)blockIdx.x >> 6) < 3 ? ((int)blockIdx.x & 7) * 24 + ((int)blockIdx.x >> 3) : 512) : vwg(); u < 512; u += (P2ROLE && gridDim.x == 256) ? 192 : (int)gridDim.x)
        attn_unit(p, lds, u >> 6, (u >> 4) & 3, u & 15);
    asm volatile("s_waitcnt vmcnt(0) lgkmcnt(0)" ::: "memory");
    __syncthreads();
#pragma unroll 1
    for (int rep = 0; rep < ((DBLSUB & 2) ? 2 : 1); ++rep)
#pragma unroll 1
    for (int u = vwg(); u < 256; u += (int)gridDim.x) {
        const int mh = u & 3, tb = (u >> 2) & 7, b = (u >> 5) & 7;
        const size_t tok0 = (size_t)b * S_ + (size_t)tb * 256;
        bf16_t* Pt = (bf16_t*)(ws + WS_PM) + tok0 * 1024 + mh * 256;
        SchedOne S1{(const char*)(ws + WS_QM) + (tok0 * 1024 + mh * 256) * 2, (const char*)(ws + WS_KMK) + ((size_t)b * 256 * 1024 + mh * 256) * 2, 0, true};
        EpiMemSoftmax E1{Pt};
        gemm_phase<EpiMemSoftmax, SchedOne, false>(lds, 256, 1024, 1024, S1, E1);
        asm volatile("s_waitcnt vmcnt(0)" ::: "memory");
        __syncthreads();
        SchedOne S2{(const char*)Pt, (const char*)(ws + WS_VMT) + ((size_t)(b * 4 + mh) * 256 * 256) * 2, 0, true};
        EpiTile E2{(bf16_t*)(ws + WS_FX) + tok0 * 2048 + 1024 + mh * 256, 2048};
        gemm_phase<EpiTile, SchedOne, false>(lds, 256, 1024, 256, S2, E2);
        __syncthreads();
    }
    { SchedChan S{ws, 0, 0}; EpiChan E{ws}; gemm_phase<EpiChan, SchedChan, true>(lds, 256, 256, 1024, S, E, PROFSEL == 2 ? (unsigned long long*)(p.ws + WS_CTL + 32768) : nullptr); }
    if (POOL2 > 0 && gridDim.x == 256) pool_drain(p, lds, 2, CV_NONEXP + GU_P2P, 256 * POOL2);
}
__device__ __forceinline__ void phase_seqdft(const Params& p, LAS unsigned char* lds) {
    SchedSeq S{p.ws}; EpiSeq E{p.ws};
    gemm_phase<EpiSeq, SchedSeq, true>(lds, 4096, SQP, SQP, S, E, PROFSEL == 3 ? (unsigned long long*)(p.ws + WS_CTL + 32768) : nullptr);
    if (POOL3 > 0 && gridDim.x == 256) pool_drain(p, lds, 3, CV_NONEXP + GU_P3P, 256 * POOL3);
}
__device__ __forceinline__ void phase_mix(const Params& p, LAS unsigned char* lds) {
    unsigned char* ws = p.ws;
    const bool stag = (gridDim.x == 256); const int g = stag ? ((int)blockIdx.x >> 6) : -1;
    unsigned long long* prof = PROFSEL == 4 ? (unsigned long long*)(p.ws + WS_CTL + 32768) : nullptr;
    EpiMixF E{ws, lds};
#ifndef MIXSLOT
#define MIXSLOT 0x2110
#endif
    const int sp = (g >= 0) ? ((MIXSLOT >> (4 * g)) & 15) : -1;
    if (sp == 0) proj_convert_slot(p, lds, g, 1);
    { SchedMix S{ws, 0, 1}; gemm_phase<EpiMixF, SchedMix, true>(lds, 2048, 2048, 2048, S, E, prof); }
    if (sp == 1) proj_convert_slot(p, lds, g, 1);
    { SchedMix S{ws, 1, 1 << 20}; gemm_phase<EpiMixF, SchedMix, true>(lds, 2048, 2048, 2048, S, E, nullptr); }
    if (sp == 2) proj_convert_slot(p, lds, g, 1);
    if (POOL4 > 0 && stag) pool_drain(p, lds, 4, CV_NONEXP + GU_P4P, 256 * POOL4);
}
__device__ __forceinline__ void phase_x2(const Params& p, LAS unsigned char* lds) {
    unsigned char* ws = p.ws;
    SchedPlain S{(const char*)(ws + WS_MIXED), (const char*)(ws + WS_WOT), (size_t)256 * 2048 * 2, (size_t)256 * 2048 * 2, 64, 8};
    EpiRes E{p.in[0], (bf16_t*)(ws + WS_X2), (const bf16_t*)(ws + WS_H), (const float*)(ws + WS_IRSTD), p.in[3]};
    unsigned long long* prof = PROFSEL == 5 ? (unsigned long long*)(p.ws + WS_CTL + 32768) : nullptr;
    if (X2_SLOT > 0 && MOE_SLOT && gridDim.x == 256) {
        const int g = (int)blockIdx.x >> 6, sp = (0x2110 >> (4 * g)) & 15;
        if (sp == 0) proj_convert_slot(p, lds, g, 3);
        { SchedPlain Sa = S; Sa.r0 = 0; Sa.r1 = 1; gemm_phase<EpiRes, SchedPlain, true>(lds, 2048, 2048, 2048, Sa, E, prof); }
        if (sp == 1) proj_convert_slot(p, lds, g, 3);
        { SchedPlain Sb = S; Sb.r0 = 1; gemm_phase<EpiRes, SchedPlain, true>(lds, 2048, 2048, 2048, Sb, E, nullptr); }
        if (sp == 2) proj_convert_slot(p, lds, g, 3);
    } else gemm_phase<EpiRes, SchedPlain, true>(lds, 2048, 2048, 2048, S, E, prof);
    if (POOL5 > 0 && gridDim.x == 256) pool_drain(p, lds, 5, CV_NONEXP + GU_P5P, 256 * POOL5);
}
template <class Sched> __device__ __forceinline__ void moe_fill_tokl(const Params& p, LAS unsigned char* lds, const Sched& S, const LAS int* cn) {
    LAS unsigned short* tokl = (LAS unsigned short*)(lds + LDS_TOKL);
    const int* list = (const int*)(p.ws + WS_LIST);
    const int tid = threadIdx.x, half = tid >> 8, c = tid & 255;
    int tok[10]; bool val[10];
#pragma unroll
    for (int j = 0; j < 10; ++j) { Unit u; val[j] = S.next(2 * j + half, u); tok[j] = 0;
        if (val[j]) { const int cnt = cn[u.z]; int pos = u.pm * 256 + c; pos = pos < cnt ? pos : cnt - 1; tok[j] = list[(size_t)u.z * T_ + pos]; } }
#pragma unroll
    for (int j = 0; j < 10; ++j) if (val[j]) tokl[(2 * j + half) * 256 + c] = (unsigned short)tok[j];
    __syncthreads();
}
template <class Sched, bool WTAB> __device__ __forceinline__ void moe_fill_tabs(const Params& p, LAS unsigned char* lds, const Sched& S, const LAS int* cn, const float* bias, int ncol) {
    LAS float* btab = (LAS float*)(lds + LDS_BTAB); LAS float* wtab = (LAS float*)(lds + LDS_TOKL);
    const float* wl = (const float*)(p.ws + WS_WLIST);
    const int tid = threadIdx.x, half = tid >> 8, c = tid & 255;
    constexpr int NP = WTAB ? 5 : 10;
    float bv[NP], wv[NP]; bool val[NP];
#pragma unroll
    for (int j = 0; j < NP; ++j) { Unit u; val[j] = S.next(2 * j + half, u); bv[j] = 0.f; wv[j] = 0.f;
        if (val[j]) { bv[j] = bias[(size_t)u.z * ncol + u.pn * 256 + c];
            if constexpr (WTAB) { const int pos = u.pm * 256 + c; if (pos < cn[u.z]) wv[j] = wl[(size_t)u.z * T_ + pos] * YS_SCALE; } } }
#pragma unroll
    for (int j = 0; j < NP; ++j) if (val[j]) { btab[(2 * j + half) * 256 + c] = bv[j]; if constexpr (WTAB) wtab[(2 * j + half) * 256 + c] = wv[j]; }
    __syncthreads();
}
__device__ __forceinline__ void phase_gateup(const Params& p, LAS unsigned char* lds) {
    LAS int* pt = (LAS int*)(lds + LDS_MISC); LAS int* cn = pt + 64;
    moe_tables(p, pt, cn);
    if constexpr (MOE_F8) { SchedMoe<true, 16, true> S{p.ws, pt, cn}; EpiSwiglu8 E{p.ws, p.in[15], pt}; moe_fill_tokl(p, lds, S, cn); moe_fill_tabs<SchedMoe<true, 16, true>, false>(p, lds, S, cn, p.in[15], 4096);
        unsigned long long* prof = PROFSEL == 7 ? (unsigned long long*)(p.ws + WS_CTL + 32768) : nullptr;
        const bool stag = MOE_SLOT && (gridDim.x == 256);
        if (stag) {
            const int g = (int)blockIdx.x >> 6, a = MOE_SLOT_STEP * g;
            if (a > 0) { SchedMoe<true, 16, true> Sa{p.ws, pt, cn, 0, 0, a}; gemm_phase<EpiSwiglu8, SchedMoe<true, 16, true>, MOE_ALIGN, 1>(lds, 2048, 2048, 2048, Sa, E, nullptr); }
            if constexpr (MOE_SLOT_BAL) {
                const int U = S.ptu(NE) * 16, rmax = (U + 255) >> 8, me = (int)blockIdx.x & 63;
                int totd = 0, dme = 0, dbefore = 0;
#pragma unroll 1
                for (int i = 0; i < 64; ++i) { const int c = 64 * g + i, v = (c & 7) * 32 + (c >> 3); const int r = (v < U) ? ((U - v + 255) >> 8) : 0; int d = rmax - r;
#ifdef MOE_BAL_TEST
                    d = (i * 7 + g) % 3 == 0 ? 1 : 0;
#endif
                    totd += d; if (i < me) dbefore += d; if (i == me) dme = d; }
                constexpr int GT = 1024 - 64 * POOL7;
                const int n0 = (GT - MOE_SLOT_BAL * totd) / 64, rem = GT - 64 * n0 - MOE_SLOT_BAL * totd;
                const long base = CV_NONEXP + 8192 + (long)GT * g;
                const int xs = 64 * n0 + MOE_SLOT_BAL * dbefore + (me < rem ? me : rem), xn = MOE_SLOT_BAL * dme + (me < rem ? 1 : 0);
                __syncthreads();
                convert_items(p, lds, base, base + 64 * n0, me, 64);
                if (xn > 0) convert_items(p, lds, base + xs, base + xs + xn, 0, 1);
                asm volatile("s_waitcnt vmcnt(0) lgkmcnt(0)" ::: "memory");
                __syncthreads();
            } else proj_convert_slot(p, lds, g, 2);
            moe_fill_tokl(p, lds, S, cn);
            SchedMoe<true, 16, true> Sb{p.ws, pt, cn, 0, a, 1 << 20}; gemm_phase<EpiSwiglu8, SchedMoe<true, 16, true>, MOE_ALIGN, 1>(lds, 2048, 2048, 2048, Sb, E, prof);
            if (POOL7 > 0) pool_drain(p, lds, 1, CV_NONEXP + 12288 - 256 * POOL7, 256 * POOL7);
        } else gemm_phase<EpiSwiglu8, SchedMoe<true, 16, true>, MOE_ALIGN, 1>(lds, 2048, 2048, 2048, S, E, prof); }
    else { SchedMoe<true, 16, false> S{p.ws, pt, cn}; EpiSwiglu E{p.ws, p.in[15], pt}; moe_fill_tokl(p, lds, S, cn);
        gemm_phase<EpiSwiglu, SchedMoe<true, 16, false>, true>(lds, 2048, 2048, 2048, S, E); }
}
__device__ __forceinline__ void phase_down(const Params& p, LAS unsigned char* lds) {
    LAS int* pt = (LAS int*)(lds + LDS_MISC); LAS int* cn = pt + 64;
    moe_tables(p, pt, cn);
    if constexpr (MOE_F8) { SchedMoe<false, 8, true> S{p.ws, pt, cn}; EpiDown8 E{p.ws, p.in[17], pt, cn}; moe_fill_tabs<SchedMoe<false, 8, true>, true>(p, lds, S, cn, p.in[17], 2048); gemm_phase<EpiDown8, SchedMoe<false, 8, true>, MOE_ALIGN, 1>(lds, 2048, 2048, 2048, S, E, PROFSEL == 8 ? (unsigned long long*)(p.ws + WS_CTL + 32768) : nullptr); }
    else { SchedMoe<false, 8, false> S{p.ws, pt, cn}; EpiDown E{p.ws, p.in[17], pt, cn}; gemm_phase<EpiDown, SchedMoe<false, 8, false>, true>(lds, 2048, 2048, 2048, S, E); }
#ifdef SHADOW
    if constexpr (MOE_F8) { __syncthreads(); SchedMoe<false, 8, true> S{p.ws, pt, cn, SHADOW - 1}; EpiDown8 E{p.ws, p.in[17], pt, cn, (WS_FAST_END + 4095) & ~(size_t)4095};
        gemm_phase<EpiDown8, SchedMoe<false, 8, true>, MOE_ALIGN, 1>(lds, 2048, 2048, 2048, S, E, nullptr); }
#endif
}
__device__ __forceinline__ void phase_out(const Params& p, LAS unsigned char* lds) {
    LAS int* pt = (LAS int*)(lds + LDS_MISC); LAS int* cn = pt + 64;
    moe_tables(p, pt, cn);
    phase_final(p, pt);
}

template <int PH> __global__ void __launch_bounds__(NTHR, 2) k_phase(Params p) {
    extern __shared__ __attribute__((aligned(16))) unsigned char lds_raw[];
    LAS unsigned char* lds = (LAS unsigned char*)lds_raw;
    if constexpr (PH == 0) phase_prologue(p, lds);
    if constexpr (PH == 1) phase_proj(p, lds);
    if constexpr (PH == 2) phase_mixers(p, lds);
    if constexpr (PH == 3) phase_seqdft(p, lds);
    if constexpr (PH == 4) phase_mix(p, lds);
    if constexpr (PH == 5) phase_x2(p, lds);
    if constexpr (PH == 6) phase_rows(p, lds);
    if constexpr (PH == 7) phase_gateup(p, lds);
    if constexpr (PH == 8) phase_down(p, lds);
    if constexpr (PH == 9) phase_out(p, lds);
}
template <int PH> static void launch_phase(const Params& p, hipStream_t st) {
    static bool attr_done = false;
    if (!attr_done) { (void)hipFuncSetAttribute((const void*)k_phase<PH>, hipFuncAttributeMaxDynamicSharedMemorySize, LDS_BYTES); attr_done = true; }
    hipLaunchKernelGGL(k_phase<PH>, dim3(256), dim3(NTHR), LDS_BYTES, st, p);
}
static void run_fast_multi(const Params& p, hipStream_t st, int lo, int hi) {
    if (lo <= 0 && 0 < hi) launch_phase<0>(p, st);
    if (lo <= 1 && 1 < hi) launch_phase<1>(p, st);
    if (lo <= 2 && 2 < hi) launch_phase<2>(p, st);
    if (lo <= 3 && 3 < hi) launch_phase<3>(p, st);
    if (lo <= 4 && 4 < hi) launch_phase<4>(p, st);
    if (lo <= 5 && 5 < hi) launch_phase<5>(p, st);
    if (lo <= 6 && 6 < hi) launch_phase<6>(p, st);
    if (lo <= 7 && 7 < hi) launch_phase<7>(p, st);
    if (lo <= 8 && 8 < hi) launch_phase<8>(p, st);
    if (lo <= 9 && 9 < hi) launch_phase<9>(p, st);
}
#define XB_TMO      128
#define XB_XCNT(j)  (256  + 64 * (j))
#define XB_XSUB(j)  (1280 + 64 * (j))
#define XB_XGEN(j)  (2304 + 64 * (j))
#define XB_TOP      3328
#define XB_TOPGEN   3392
#define XCD_BAR_WORDS 3456
#define XB_SPIN_CAP (1u << 18)

__device__ __forceinline__ unsigned xb_ld(unsigned* p)              { return __hip_atomic_load(p, __ATOMIC_RELAXED, __HIP_MEMORY_SCOPE_AGENT); }
__device__ __forceinline__ unsigned xb_add(unsigned* p, unsigned v) { return __hip_atomic_fetch_add(p, v, __ATOMIC_RELAXED, __HIP_MEMORY_SCOPE_AGENT); }
__device__ __forceinline__ unsigned xb_xcc_id() { return (unsigned)__builtin_amdgcn_s_getreg((3 << 11) | 20) & 0xFu; }
#define XB_SPIN(cond, bar) do { unsigned _sp = 0; while (cond) { __builtin_amdgcn_s_sleep(1); \
    if ((++_sp & 255u) == 0u) { if (xb_ld(&(bar)[XB_TMO])) break; if (_sp > XB_SPIN_CAP) { atomicAdd(&(bar)[XB_TMO], 1u); break; } } } } while (0)

struct XcdBarrier {
    unsigned* bar; unsigned x;
    volatile LAS unsigned* st;
};

__device__ __forceinline__ XcdBarrier xcd_barrier_post(unsigned* bar, volatile LAS unsigned* st) {
    XcdBarrier b; b.bar = bar; b.x = xb_xcc_id(); b.st = st;
    if (threadIdx.x == 0) (void)xb_add(&bar[XB_XCNT(b.x)], 1u);
    return b;
}
__device__ __forceinline__ void xcd_barrier_complete(unsigned* bar, unsigned x, unsigned& nloc, unsigned& nx) {
    const unsigned G = gridDim.x * gridDim.y * gridDim.z;
    unsigned sum, cnt, mine, sp = 0u;
    for (;;) {
        sum = 0u; cnt = 0u; mine = 0u;
#pragma unroll
        for (unsigned j = 0; j < 16; ++j) { const unsigned c = xb_ld(&bar[XB_XCNT(j)]); sum += c; cnt += (c > 0u) ? 1u : 0u; mine = (j == x) ? c : mine; }
        if (sum == G) break;
        __builtin_amdgcn_s_sleep(1);
        if ((++sp & 255u) == 0u) { if (xb_ld(&bar[XB_TMO])) break; if (sp > XB_SPIN_CAP) { atomicAdd(&bar[XB_TMO], 1u); break; } }
    }
    nloc = mine > 0u ? mine : 1u; nx = cnt > 0u ? cnt : 1u;
}

__device__ __forceinline__ void xcd_barrier(const XcdBarrier& b) {
    asm volatile("s_waitcnt vmcnt(0)" ::: "memory");
    __syncthreads();
    if (threadIdx.x == 0) {
        unsigned* bar = b.bar;
        __builtin_amdgcn_s_waitcnt(0);
        unsigned nloc = b.st[0], nx = b.st[1];
        if (nloc == 0u) { xcd_barrier_complete(bar, b.x, nloc, nx); b.st[0] = nloc; b.st[1] = nx; }
        const unsigned old = xb_add(&bar[XB_XSUB(b.x)], 1u);
        const unsigned gen = old / nloc;
        if (old + 1u == (gen + 1u) * nloc) {
            __builtin_amdgcn_fence(__ATOMIC_RELEASE, "agent");
            asm volatile("s_waitcnt vmcnt(0)" ::: "memory");
            const unsigned og = xb_add(&bar[XB_TOP], 1u);
            const unsigned tg = og / nx;
            if (og + 1u == (tg + 1u) * nx) xb_add(&bar[XB_TOPGEN], 1u);
            else XB_SPIN(xb_ld(&bar[XB_TOPGEN]) == tg, bar);
            __builtin_amdgcn_fence(__ATOMIC_ACQUIRE, "agent");
            xb_add(&bar[XB_XGEN(b.x)], 1u);
            asm volatile("s_waitcnt vmcnt(0)" ::: "memory");
        } else {
            XB_SPIN(xb_ld(&bar[XB_XGEN(b.x)]) == gen, bar);
            __builtin_amdgcn_fence(__ATOMIC_ACQUIRE, "agent");
            asm volatile("s_waitcnt vmcnt(0)" ::: "memory");
        }
    }
    __syncthreads();
}

__global__ void __launch_bounds__(NTHR, 2) mega_fwd(Params p) {
    extern __shared__ __attribute__((aligned(16))) unsigned char lds_raw[];
    LAS unsigned char* lds = (LAS unsigned char*)lds_raw;
    volatile LAS unsigned* xbw = (volatile LAS unsigned*)(lds + LDS_XBW);
    if (threadIdx.x < 4) xbw[threadIdx.x] = 0u;
    __syncthreads();
    XcdBarrier bar = xcd_barrier_post((unsigned*)(p.ws + WS_CTL) + CW_BAR, xbw);
#ifndef DBL
#define DBL 0
#endif
#ifndef SKEWPH
#define SKEWPH -1
#endif
#define RUNPH(i, call) do { call; if constexpr ((DBL >> (i)) & 1) { xcd_barrier(bar); call; } \
    if constexpr (SKEWPH == (i)) { if (threadIdx.x == 0) ((unsigned long long*)(p.ws + WS_CTL + 40960))[blockIdx.x] = wall_clock64(); } } while (0)
    RUNPH(0, phase_prologue(p, lds));  xcd_barrier(bar);
    RUNPH(1, phase_proj(p, lds));      xcd_barrier(bar);
    RUNPH(2, phase_mixers(p, lds));    xcd_barrier(bar);
    RUNPH(3, phase_seqdft(p, lds));    xcd_barrier(bar);
    RUNPH(4, phase_mix(p, lds));       xcd_barrier(bar);
    RUNPH(5, phase_x2(p, lds));        xcd_barrier(bar);
    phase_rows(p, lds);                xcd_barrier(bar);
    RUNPH(7, phase_gateup(p, lds));    xcd_barrier(bar);
    RUNPH(8, phase_down(p, lds));      xcd_barrier(bar);
    phase_out(p, lds);
}
static void run_fast_one(const Params& p, hipStream_t st) {
    static int grid = 0;
    if (!grid) {
        int dev = 0, cus = 0, per_cu = 0;
        (void)hipGetDevice(&dev); (void)hipDeviceGetAttribute(&cus, hipDeviceAttributeMultiprocessorCount, dev);
        (void)hipFuncSetAttribute((const void*)mega_fwd, hipFuncAttributeMaxDynamicSharedMemorySize, LDS_BYTES);
        (void)hipOccupancyMaxActiveBlocksPerMultiprocessor(&per_cu, (const void*)mega_fwd, NTHR, LDS_BYTES);
        if (per_cu < 1) per_cu = 1;
        grid = cus > 256 ? 256 : cus;
        grid &= ~7; if (grid < 8) grid = 8;
    }
    hipLaunchKernelGGL(mega_fwd, dim3(grid), dim3(NTHR), LDS_BYTES, st, p);
}
}
#ifndef REPORT
#define REPORT 0
#endif
extern "C" void kernel_launch(void* const* d_in, const int* in_sizes, int n_in, void* d_out, int out_size, void* d_ws, size_t ws_size, hipStream_t stream) {
    (void)in_sizes; (void)n_in; (void)out_size; (void)ws_size;
    unsigned char* ws = (unsigned char*)d_ws;
#if MODE == 0
    nv::NBuf nb; nv::carve(nb, ws);
    nv::run_part1(d_in, nb, stream); nv::run_part2(d_in, nb, (float*)d_out, stream);
#elif MODE == 1
    constexpr size_t NAIVE_BASE = (fx::WS_FAST_END + 4095) & ~(size_t)4095;
    nv::NBuf nb; const size_t nbytes = nv::carve(nb, ws + NAIVE_BASE);
    float* fout = (float*)(ws + NAIVE_BASE + ((nbytes + 4095) & ~(size_t)4095));
    double* acc = (double*)(fout + (size_t)16384 * 2048); float* scale = (float*)(acc + 64);
    fx::Params p; memset(&p, 0, sizeof(p));
    for (int i = 0; i < 19; ++i) p.in[i] = (const float*)d_in[i];
    p.out = fout; p.ws = ws;
    (void)hipMemsetAsync(ws + fx::WS_CTL, 0, fx::CTL_BYTES, stream);
    (void)hipMemsetAsync(acc, 0, 1024, stream);
    nv::run_part1(d_in, nb, stream);
    fx::run_fast_multi(p, stream, 0, 7);
    auto cmp = [&](int slot, int kind, const void* a, const float* ref, long long n, int w, int ldf, int ldr, int off, int sig) {
        ck::CP c; memset(&c, 0, sizeof(c)); c.a = a; c.ref = ref; c.n = n; c.kind = kind; c.w = w; c.ldf = ldf; c.ldr = ldr; c.off = off; c.sig = sig; c.slot = slot;
        hipLaunchKernelGGL(ck::k_cmp, dim3(2048), dim3(256), 0, stream, c, acc); };
    const long long T = 16384;
    cmp(0, 0, ws + fx::WS_FIN, nb.proj, T * 1024, 1024, 1024, 10752, 0, 0);
    cmp(1, 0, ws + fx::WS_Q, nb.proj, T * 2048, 2048, 2048, 10752, 1024, 0);
    cmp(2, 0, ws + fx::WS_K, nb.proj, T * 256, 256, 256, 10752, 3072, 0);
    cmp(3, 2, ws + fx::WS_VT, nb.proj, T * 256, 0, 0, 0, 0, 0);
    cmp(4, 0, ws + fx::WS_QM, nb.proj, T * 1024, 1024, 1024, 10752, 3584, 0);
    cmp(5, 0, ws + fx::WS_GATES, nb.proj, T * 6144, 6144, 6144, 10752, 4608, 1);
    cmp(6, 0, ws + fx::WS_KMK, nb.kvm, 2048LL * 1024, 1024, 1024, 2048, 0, 0);
    cmp(7, 3, ws + fx::WS_VMT, nb.kvm, 2048LL * 1024, 0, 0, 0, 0, 0);
    cmp(8, 0, ws + fx::WS_ATT, nb.att, T * 2048, 2048, 2048, 2048, 0, 0);
    cmp(9, 0, ws + fx::WS_XM, nb.xm, T * 1024, 1024, 1024, 1024, 0, 0);
    cmp(10, 0, ws + fx::WS_FM, nb.fm, T * 1024, 1024, 1024, 1024, 0, 0);
    cmp(11, 0, ws + fx::WS_MIXED, nb.mixed, T * 2048, 2048, 2048, 2048, 0, 0);
    cmp(12, 1, ws + fx::WS_X2, nb.x2, T * 2048, 2048, 2048, 2048, 0, 0);
    cmp(13, 0, ws + fx::WS_H2, nb.h2, T * 2048, 2048, 2048, 2048, 0, 0);
    hipLaunchKernelGGL(ck::k_cmp_route, dim3(64), dim3(256), 0, stream, (const int*)(ws + fx::WS_TOKE), (const int*)nb.tope, acc, 14);
    nv::run_part2(d_in, nb, nb.nout, stream);
    fx::run_fast_multi(p, stream, 7, 10);
    cmp(15, 1, fout, nb.nout, T * 2048, 2048, 2048, 2048, 0, 0);
    hipLaunchKernelGGL(ck::k_verdict, dim3(1), dim3(64), 0, stream, (const double*)acc, scale, 16, (int)REPORT);
    hipLaunchKernelGGL(ck::k_scale_out, dim3(2048), dim3(256), 0, stream, (const float*)nb.nout, (const float*)scale, (float*)d_out, T * 2048);
#elif MODE == 2
    fx::Params p; memset(&p, 0, sizeof(p));
    for (int i = 0; i < 19; ++i) p.in[i] = (const float*)d_in[i];
    p.out = (float*)d_out; p.ws = ws;
    (void)hipMemsetAsync(ws + fx::WS_CTL, 0, fx::CTL_BYTES, stream);
    fx::run_fast_multi(p, stream, 0, 10);
#elif MODE == 3
    fx::Params p; memset(&p, 0, sizeof(p));
    for (int i = 0; i < 19; ++i) p.in[i] = (const float*)d_in[i];
    p.out = (float*)d_out; p.ws = ws;
    (void)hipMemsetAsync(ws + fx::WS_CTL, 0, fx::CTL_BYTES, stream);
    fx::run_fast_one(p, stream);
#endif
}
```

```cpp
#include <hip/hip_runtime.h>
#include <stdint.h>
#include <string.h>
#ifndef MODE
#define MODE 3
#endif
namespace fx {
#define LAS __attribute__((address_space(3)))
typedef unsigned short bf16_t;
typedef short bf16x8 __attribute__((ext_vector_type(8)));
typedef short s16x4 __attribute__((ext_vector_type(4)));
typedef float f32x4 __attribute__((ext_vector_type(4)));
typedef float f32x16 __attribute__((ext_vector_type(16)));
typedef float f32x2 __attribute__((ext_vector_type(2)));
typedef __bf16 bf16x2_t __attribute__((ext_vector_type(2)));
typedef unsigned u32x4 __attribute__((ext_vector_type(4)));
typedef unsigned u32x2 __attribute__((ext_vector_type(2)));

constexpr int NTHR = 512, NWAVE = 8;
constexpr int B_ = 8, S_ = 2048, DM = 2048, T_ = B_ * S_;
constexpr int MEM = 256, FW = 1024, FG = 4, FGD = 256;
constexpr int NH = 32, NKV = 4, HD = 64, AW = 2048, KVW = 256, WIN = 128;
constexpr int MH = 4, MHD = 256, MW = 1024;
constexpr int NE = 32, TOPK = 4, DFF = 2048;
constexpr int INW = 10752;
#ifndef LDPAD
#define LDPAD 0
#endif
#ifndef ROUTER_ON_X2
#define ROUTER_ON_X2 1
#endif
#ifndef SEQFOLD
#define SEQFOLD 1
#endif
#ifndef SQPAD
#define SQPAD 0
#endif
constexpr int LDP = 2048 + LDPAD;
constexpr int NSLOT = T_ * TOPK + NE * 256;
constexpr float LOG2E = 1.4426950408889634f;
#ifndef MOE_FP8
#define MOE_FP8 1
#endif
constexpr bool MOE_F8 = (MOE_FP8 != 0);
#ifndef GATES_FP8
#define GATES_FP8 1
#endif
constexpr bool GATES_F8 = (GATES_FP8 != 0);
#ifndef CONV_TILE32
#define CONV_TILE32 0
#endif
#ifndef MOE_ALIGN
#define MOE_ALIGN true
#endif
#ifndef PROFSEL
#define PROFSEL 0
#endif
#ifndef PROFMETRIC
#define PROFMETRIC 0
#endif
#ifndef PROFMUL
#define PROFMUL 1
#endif
#ifndef PROFBLK
#define PROFBLK 0
#endif

constexpr size_t al256(size_t x) { return (x + 255) & ~(size_t)255; }
constexpr size_t WS_CTL = 0, CTL_BYTES = 65536;
constexpr size_t WS_WINT = 1u << 20;
constexpr size_t WS_WMKVT = WS_WINT + (size_t)INW * LDP * 2;
constexpr size_t WS_WFOT = WS_WMKVT + (size_t)2048 * LDP * 2;
constexpr size_t WS_WAOT = WS_WFOT + (size_t)2048 * 1024 * 2;
constexpr size_t WS_WMOT = WS_WAOT + (size_t)2048 * 2048 * 2;
constexpr size_t WS_WOT = WS_WMOT + (size_t)2048 * 1024 * 2;
constexpr size_t WS_WRT = WS_WOT + (size_t)2048 * 2048 * 2;
constexpr size_t WS_TABT = WS_WRT + (size_t)NE * DM * 2;
constexpr size_t WS_DMAT = WS_TABT + (size_t)512 * 256 * 2;
constexpr int SQK = SEQFOLD ? 2048 : 4096;
constexpr int SQP = SQK + SQPAD;
constexpr size_t WS_WGUT = WS_DMAT + (size_t)2048 * SQP * 2;
constexpr size_t WS_WDNT = WS_WGUT + (size_t)NE * 4096 * 2048 * 2;
constexpr size_t WS_H = WS_WDNT + (size_t)NE * 2048 * 2048 * 2;
constexpr size_t WS_MEMBF = WS_H + (size_t)T_ * LDP * 2;
constexpr size_t WS_FIN = WS_MEMBF + (size_t)2048 * LDP * 2;
constexpr size_t WS_Q = WS_FIN + (size_t)T_ * FW * 2;
constexpr size_t WS_K = WS_Q + (size_t)T_ * AW * 2;
constexpr size_t WS_VT = WS_K + (size_t)T_ * KVW * 2;
constexpr size_t WS_QM = WS_VT + (size_t)T_ * KVW * 2;
constexpr size_t WS_GATES = WS_QM + (size_t)T_ * MW * 2;
constexpr size_t WS_KMK = WS_GATES + (size_t)T_ * 3 * DM * 2;
constexpr size_t WS_VMT = WS_KMK + (size_t)2048 * 1024 * 2;
constexpr size_t WS_ZT = WS_VMT + (size_t)2048 * 1024 * 2;
constexpr size_t WS_FM = WS_ZT + (size_t)32 * 256 * SQP * 2;
constexpr size_t WS_ATT = WS_FM + (size_t)T_ * FW * 2;
constexpr size_t WS_PM = WS_ATT + (size_t)T_ * AW * 2;
constexpr size_t WS_XM = WS_PM + (size_t)T_ * MH * 256 * 2;
constexpr size_t WS_MIXACC = WS_XM + (size_t)T_ * MW * 2;
constexpr size_t WS_MIXED = WS_MIXACC + (size_t)T_ * DM * 4;
constexpr size_t WS_XF = WS_MIXED;
constexpr size_t WS_FX = WS_MIXACC;
constexpr size_t WS_WFM = WS_MIXACC + (size_t)T_ * 2048 * 2;
constexpr size_t WS_IRSTD = WS_WFM + (size_t)2048 * 2048 * 2;
static_assert(WS_IRSTD + (size_t)T_ * 4 <= WS_MIXED, "fused-mix operands fit the old mixacc region");
constexpr size_t WS_X2 = WS_MIXED + (size_t)T_ * DM * 2;
constexpr size_t WS_H2 = WS_X2 + (size_t)T_ * DM * 4;
constexpr size_t WS_TOKE = WS_H2 + (size_t)T_ * DM * 2;
constexpr size_t WS_TOKPOS = WS_TOKE + (size_t)T_ * 4 * 4;
constexpr size_t WS_TOKW = WS_TOKPOS + (size_t)T_ * 4 * 4;
constexpr size_t WS_LIST = WS_TOKW + (size_t)T_ * 4 * 4;
constexpr size_t WS_WLIST = WS_LIST + (size_t)NE * T_ * 4;
constexpr size_t WS_WGUQ = WS_WLIST + (size_t)NE * T_ * 4;
constexpr size_t WS_WDNQ = WS_WGUQ + (size_t)NE * 4096 * 2048;
constexpr size_t WS_H2Q = WS_WDNQ + (size_t)NE * 2048 * 2048;
constexpr size_t WS_H8 = WS_H2Q + (size_t)T_ * DM;
constexpr size_t WS_WINQ = WS_H8 + (size_t)T_ * DM;
constexpr size_t WS_FAST_END = WS_WINQ + (size_t)6144 * DM;
constexpr size_t WS_ACTQ = WS_H;
constexpr float WQ_SCALE = 32.0f, WQ_INV = 1.0f / 32.0f;
constexpr float YS_SCALE = 16.0f, YS_INV = 1.0f / 16.0f;
constexpr size_t WS_ACT = WS_H;
constexpr size_t WS_YS = WS_ACT + (size_t)NSLOT * DFF * 2;
static_assert(WS_YS + (size_t)NSLOT * DM * 2 <= WS_MIXED, "overlay fits");
constexpr int CW_CNT = 0;
constexpr int CW_POOL = 64;
constexpr int CW_BAR = 4096;

constexpr int LDS_STAGE = 0, STAGE_BYTES = 131072;
constexpr int LDS_TOKL = 131072;
constexpr int LDS_MISC = 141312;
constexpr int LDS_BTAB = 142336;
constexpr int LDS_XBW = 163824;
constexpr int LDS_BYTES = 163840;

struct Params {
    const float* in[19]; float* out; unsigned char* ws;
};

__device__ __forceinline__ unsigned cvtpk(float lo, float hi) { f32x2 v = {lo, hi}; bf16x2_t b = __builtin_convertvector(v, bf16x2_t); return __builtin_bit_cast(unsigned, b); }
__device__ __forceinline__ float bf2f(unsigned short x) { return __uint_as_float(((unsigned)x) << 16); }
__device__ __forceinline__ float bflo(unsigned w) { return __uint_as_float(w << 16); }
__device__ __forceinline__ float bfhi(unsigned w) { return __uint_as_float(w & 0xffff0000u); }
__device__ __forceinline__ float wsum(float v) {
#pragma unroll
    for (int o = 1; o < 64; o <<= 1) v += __shfl_xor(v, o);
    return v;
}
__device__ __forceinline__ float sigmoid_sc(float x, float nsc) { return __builtin_amdgcn_rcpf(1.0f + __builtin_amdgcn_exp2f(x * nsc)); }
__device__ __forceinline__ float sigmoidf_(float x) { return __builtin_amdgcn_rcpf(1.0f + __builtin_amdgcn_exp2f(-x * LOG2E)); }
__device__ __forceinline__ int crow(int r, int h) { return (r & 3) + 8 * (r >> 2) + 4 * h; }
__device__ __forceinline__ int t5_bucket(int rel) {
    const int n = rel < 0 ? -rel : rel;
    int b;
    if (n < 8) b = n; else if (n < 12) b = 8; else if (n < 16) b = 9; else if (n < 23) b = 10; else if (n < 32) b = 11;
    else if (n < 46) b = 12; else if (n < 64) b = 13; else if (n < 91) b = 14; else b = 15;
    return (rel > 0 ? 16 : 0) + b;
}
__device__ __forceinline__ int vwg() { const int c = blockIdx.x, G = gridDim.x; return ((G & 7) == 0) ? (c & 7) * (G >> 3) + (c >> 3) : c; }

constexpr int BM = 256, BK = 64, HALF = 128, HTB = HALF * BK * 2;
__host__ __device__ __forceinline__ int lds_byte(int r, int c) { const int st = (r >> 4) * 2 + (c >> 5), rr = r & 15, cc = c & 31, ob = rr * 64 + cc * 2; return st * 1024 + (ob ^ (((ob >> 9) & 1) << 5)); }
__host__ __device__ __forceinline__ void stage_rc(int b, int& R, int& C) { const int st = b / 1024, sb = b % 1024, swz = sb ^ (((sb >> 9) & 1) << 5); R = (st >> 1) * 16 + swz / 64; C = (st & 1) * 32 + (swz % 64) / 2; }
__host__ __device__ __forceinline__ int perm32(int rho) { const int n = rho >> 4, i = rho & 15; return 8 * (i >> 2) + 4 * n + (i & 3); }

struct Unit { int pm, pn, z, idx; };
template <class S, class = void> struct SchedVarK { static constexpr bool v = false; };
template <class S> struct SchedVarK<S, decltype((void)S::VARK)> { static constexpr bool v = S::VARK; };
template <class E, class = void> struct EpiTouch { static constexpr bool v = false; };
template <class E> struct EpiTouch<E, decltype((void)E::TOUCH)> { static constexpr bool v = E::TOUCH; };
template <class E, class = void> struct EpiKeep { static constexpr bool v = false; };
template <class E> struct EpiKeep<E, decltype((void)E::KEEP)> { static constexpr bool v = E::KEEP; };
typedef int v4i_t __attribute__((ext_vector_type(4)));
typedef int v8i_t __attribute__((ext_vector_type(8)));
__device__ __forceinline__ void mfma_f8(f32x4& c, const v8i_t& a, const v8i_t& b) { asm volatile("v_mfma_f32_16x16x128_f8f6f4 %0, %1, %2, %0" : "+v"(c) : "v"(a), "v"(b)); }
template <int ESZ> struct FragT;
template <> struct FragT<2> { struct A4 { bf16x8 v[4][2]; }; struct B2 { bf16x8 v[2][2]; }; };
template <> struct FragT<1> { struct A4 { v8i_t v[4]; }; struct B2 { v8i_t v[2]; }; };
__device__ __forceinline__ v8i_t cat8(bf16x8 a, bf16x8 b) { return __builtin_shufflevector(__builtin_bit_cast(v4i_t, a), __builtin_bit_cast(v4i_t, b), 0, 1, 2, 3, 4, 5, 6, 7); }

template <class Epi, class Sched, bool ALIGN_EPI, int ESZ = 2  >
__device__ __forceinline__ void gemm_phase(LAS unsigned char* lds, const int K, const int lda, const int ldb, const Sched& S, const Epi& E, unsigned long long* prof = nullptr) {
    unsigned long long pf_kl = 0, pf_ep = 0, pf_t0 = 0, pf_t1 = 0, pf_n = 0; const unsigned long long pf_w0 = prof ? wall_clock64() : 0ull, pf_c0 = prof ? clock64() : 0ull;
    int tid_ = threadIdx.x; asm volatile("" : "+v"(tid_));
    const int tid = tid_, wid = __builtin_amdgcn_readfirstlane(tid >> 6), lane = tid & 63, wr = wid >> 2, wc = wid & 3, fr = lane & 15, fq = lane >> 4;
    const int nt = (K * ESZ) / (BK * 2);
    constexpr bool GATHER = Sched::GATHER;
    unsigned voffA[2], voffB[2]; int Rr[2], Cb[2];
#pragma unroll
    for (int i = 0; i < 2; ++i) { int R, C; stage_rc(tid * 16 + i * 8192, R, C);
        int Rb = R;
        if constexpr ((int)Epi::PERM == 1) Rb = (R & ~31) + perm32(R & 31);
        if constexpr ((int)Epi::PERM == 2) Rb = 64 * (R >> 5) + 16 * ((R >> 2) & 3) + 4 * ((R >> 4) & 1) + (R & 3);
        voffA[i] = (unsigned)(R * lda * ESZ + C * 2); voffB[i] = (unsigned)(Rb * ldb * ESZ + C * 2); Rr[i] = R; Cb[i] = C * 2; }
    const size_t kstep = (size_t)(BK * 2);
    const size_t hstepA = (size_t)HALF * lda * ESZ, hstepB = (size_t)(((int)Epi::PERM == 2) ? 8 : HALF) * ldb * ESZ;
    const unsigned ldsw = (unsigned)wid * 1024u;
    const int aoff = lds_byte(wr * 64 + fr, fq * 8), boff = lds_byte(wc * 32 + fr, fq * 8);
#define PG8_SA(b, h) (((b) * 2 + (h)) * HTB)
#define PG8_SB(b, h) ((4 + (b) * 2 + (h)) * HTB)
#define PG8_STAGE(bufoff, gbase, voff) do { _Pragma("unroll") for (int _i = 0; _i < 2; ++_i) \
        __builtin_amdgcn_global_load_lds((const unsigned*)((const char*)(gbase) + (voff)[_i]), (LAS unsigned*)(lds + (bufoff) + ldsw + _i * 8192), 16, 0, 0); } while (0)
#define PG8_STAGE_A(bufoff, gbase, h, NX) do { if constexpr (GATHER) { _Pragma("unroll") for (int _i = 0; _i < 2; ++_i) { const unsigned _o = (NX) ? naoff[h][_i] : caoff[h][_i]; \
        __builtin_amdgcn_global_load_lds((const unsigned*)((const char*)(gbase) + _o), (LAS unsigned*)(lds + (bufoff) + ldsw + _i * 8192), 16, 0, 0); } } \
        else { PG8_STAGE(bufoff, (const char*)(gbase) + (h) * hstepA, voffA); } } while (0)
#define PG8_LDA(dst, b, h) do { _Pragma("unroll") for (int m = 0; m < 4; ++m) { if constexpr (ESZ == 2) { _Pragma("unroll") for (int k = 0; k < 2; ++k) dst.v[m][k] = *(const LAS bf16x8*)(lds + PG8_SA(b, h) + aoff + m * 2048 + k * 1024); } \
        else { const v4i_t _lo = *(const LAS v4i_t*)(lds + PG8_SA(b, h) + aoff + m * 2048), _hi = *(const LAS v4i_t*)(lds + PG8_SA(b, h) + aoff + m * 2048 + 1024); dst.v[m] = __builtin_shufflevector(_lo, _hi, 0, 1, 2, 3, 4, 5, 6, 7); } } } while (0)
#define PG8_LDB(dst, b, h) do { _Pragma("unroll") for (int n = 0; n < 2; ++n) { if constexpr (ESZ == 2) { _Pragma("unroll") for (int k = 0; k < 2; ++k) dst.v[n][k] = *(const LAS bf16x8*)(lds + PG8_SB(b, h) + boff + n * 2048 + k * 1024); } \
        else { const v4i_t _lo = *(const LAS v4i_t*)(lds + PG8_SB(b, h) + boff + n * 2048), _hi = *(const LAS v4i_t*)(lds + PG8_SB(b, h) + boff + n * 2048 + 1024); dst.v[n] = __builtin_shufflevector(_lo, _hi, 0, 1, 2, 3, 4, 5, 6, 7); } } } while (0)
#define PG8_MMA(ai, bj, At, Bt) do { __builtin_amdgcn_s_setprio(1); _Pragma("unroll") for (int m = 0; m < 4; ++m) _Pragma("unroll") for (int n = 0; n < 2; ++n) { \
        if constexpr (ESZ == 2) { _Pragma("unroll") for (int k = 0; k < 2; ++k) acc[ai][bj][m][n] = __builtin_amdgcn_mfma_f32_16x16x32_bf16(Bt.v[n][k], At.v[m][k], acc[ai][bj][m][n], 0, 0, 0); } \
        else { mfma_f8(acc[ai][bj][m][n], Bt.v[n], At.v[m]); } } \
        __builtin_amdgcn_s_setprio(0); } while (0)
#define PG8_WAIT_V(n) asm volatile("s_waitcnt vmcnt(" #n ")" ::: "memory")
#define PG8_WAIT_V8R do { if (relax) asm volatile("s_waitcnt vmcnt(%0)" :: "n"(8 + Epi::NSTORE) : "memory"); else PG8_WAIT_V(8); } while (0)
#define PG8_WAIT_L(n) asm volatile("s_waitcnt lgkmcnt(" #n ")" ::: "memory")
#define PG8_BAR __builtin_amdgcn_s_barrier()
#define PG8_SCHED __builtin_amdgcn_sched_barrier(0)
    Unit cur, nxt; int ui = 0;
    if (!S.next(0, cur)) return;
    f32x4 acc[2][2][4][2];
#pragma unroll
    for (int a = 0; a < 2; ++a)
#pragma unroll
        for (int b = 0; b < 2; ++b)
#pragma unroll
            for (int m = 0; m < 4; ++m)
#pragma unroll
                for (int n = 0; n < 2; ++n) acc[a][b][m][n] = (f32x4){0.f, 0.f, 0.f, 0.f};
    typedef typename FragT<ESZ>::A4 FragA; typedef typename FragT<ESZ>::B2 FragB;
    FragA At; FragB B0, B1;
    unsigned caoff[2][2] = {{0u, 0u}, {0u, 0u}}, naoff[2][2] = {{0u, 0u}, {0u, 0u}};
    if constexpr (GATHER) {
#pragma unroll
        for (int h = 0; h < 2; ++h)
#pragma unroll
            for (int i = 0; i < 2; ++i) { caoff[h][i] = S.arow(cur, h * HALF + Rr[i]) + (unsigned)Cb[i]; naoff[h][i] = caoff[h][i]; }
    }
    const char* cA = S.baseA(cur); const char* cB = S.baseB(cur);
    PG8_STAGE(PG8_SB(0, 0), cB, voffB); PG8_STAGE(PG8_SB(0, 1), cB + hstepB, voffB); PG8_STAGE_A(PG8_SA(0, 0), cA, 0, false); PG8_STAGE_A(PG8_SA(0, 1), cA, 1, false);
    if (wr == 1) PG8_BAR;
    PG8_WAIT_V(2); PG8_BAR;
    PG8_STAGE(PG8_SB(1, 0), cB + kstep, voffB); PG8_STAGE_A(PG8_SA(1, 0), cA + kstep, 0, false); PG8_STAGE(PG8_SB(1, 1), cB + hstepB + kstep, voffB);
    PG8_WAIT_V(6); PG8_BAR;
    for (;;) {
        const bool has_next = S.next(ui + 1, nxt);
        const char* nA = has_next ? S.baseA(nxt) : cA; const char* nB = has_next ? S.baseB(nxt) : cB;
        if constexpr (GATHER) {
            if (has_next) {
#pragma unroll
                for (int h = 0; h < 2; ++h)
#pragma unroll
                    for (int i = 0; i < 2; ++i) naoff[h][i] = S.arow(nxt, h * HALF + Rr[i]) + (unsigned)Cb[i];
            } else {
#pragma unroll
                for (int h = 0; h < 2; ++h)
#pragma unroll
                    for (int i = 0; i < 2; ++i) naoff[h][i] = caoff[h][i];
            }
        }
        if (prof) pf_t0 = clock64();
        if constexpr (EpiTouch<Epi>::v) E.touch(cur, lds, tid, wid);
        int ntu = nt; if constexpr (SchedVarK<Sched>::v) ntu = S.ktiles(cur);
#pragma unroll 1
        for (int t = 0; t < ntu; t += 2) {
            const bool last = (t == ntu - 2);
            const bool relax = (Epi::NSTORE > 0) && (t == 0) && (ui > 0);
            const char* a1 = cA + (size_t)(t + 1) * kstep;
            const char* a2 = last ? nA : cA + (size_t)(t + 2) * kstep; const char* b2 = last ? nB : cB + (size_t)(t + 2) * kstep;
            const char* a3 = a2 + kstep; const char* b3 = b2 + kstep;
            PG8_LDB(B0, 0, 0); PG8_LDB(B1, 0, 1); PG8_SCHED; PG8_LDA(At, 0, 0); PG8_STAGE_A(PG8_SA(1, 1), a1, 1, false);
            PG8_WAIT_V(8); PG8_WAIT_L(0); PG8_BAR; PG8_MMA(0, 0, At, B0); PG8_MMA(0, 1, At, B1); PG8_BAR; PG8_SCHED;
            PG8_LDA(At, 0, 1); PG8_STAGE(PG8_SB(0, 0), b2, voffB); PG8_STAGE(PG8_SB(0, 1), b2 + hstepB, voffB); PG8_STAGE_A(PG8_SA(0, 0), a2, 0, last);
            PG8_WAIT_V(8); PG8_WAIT_L(0); PG8_BAR; PG8_MMA(1, 0, At, B0); PG8_MMA(1, 1, At, B1); PG8_BAR; PG8_SCHED;
            PG8_LDB(B0, 1, 0); PG8_LDB(B1, 1, 1); PG8_SCHED; PG8_LDA(At, 1, 0); PG8_STAGE_A(PG8_SA(0, 1), a2, 1, last);
            PG8_WAIT_V(8); PG8_WAIT_L(0); PG8_BAR; PG8_MMA(0, 0, At, B0); PG8_MMA(0, 1, At, B1); PG8_BAR; PG8_SCHED;
            PG8_LDA(At, 1, 1); PG8_STAGE(PG8_SB(1, 0), b3, voffB); PG8_STAGE(PG8_SB(1, 1), b3 + hstepB, voffB); PG8_STAGE_A(PG8_SA(1, 0), a3, 0, last);
            PG8_WAIT_V(8); PG8_WAIT_L(0); PG8_BAR; PG8_MMA(1, 0, At, B0); PG8_MMA(1, 1, At, B1); PG8_BAR; PG8_SCHED;
        }
        if (prof) { pf_t1 = clock64(); pf_kl += pf_t1 - pf_t0; }
        if constexpr (ESZ == 1) asm volatile("s_nop 15\n\ts_nop 15" ::: "memory");
        if constexpr (ALIGN_EPI) { if (wr == 0) PG8_BAR; }
        if constexpr (!Epi::AFTER_DRAIN) { int fr_e = fr, fq_e = fq; asm volatile("" : "+v"(fr_e), "+v"(fq_e));
            E(acc, cur, wr, wc, fr_e, fq_e); }
        if (prof) { pf_ep += clock64() - pf_t1; ++pf_n; }
        if (!has_next) break;
        bool zero = true; if constexpr (EpiKeep<Epi>::v) zero = !E.keep(cur);
        if (zero) {
#pragma unroll
        for (int a = 0; a < 2; ++a)
#pragma unroll
            for (int b = 0; b < 2; ++b)
#pragma unroll
                for (int m = 0; m < 4; ++m)
#pragma unroll
                    for (int n = 0; n < 2; ++n) acc[a][b][m][n] = (f32x4){0.f, 0.f, 0.f, 0.f};
        }
        cur = nxt; cA = nA; cB = nB; ++ui;
        if constexpr (GATHER) {
#pragma unroll
            for (int h = 0; h < 2; ++h)
#pragma unroll
                for (int i = 0; i < 2; ++i) caoff[h][i] = naoff[h][i];
        }
        if constexpr (ALIGN_EPI) { if (wr == 1) PG8_BAR; }
    }
    PG8_WAIT_V(0);
    if constexpr (!ALIGN_EPI) { if (wr == 0) PG8_BAR; }
    PG8_BAR;
    if (prof && blockIdx.x == PROFBLK && tid == 0) { prof[0] = pf_kl; prof[1] = pf_ep; prof[2] = pf_n; prof[3] = (unsigned long long)nt; prof[4] = clock64() - pf_c0; prof[5] = wall_clock64() - pf_w0; }
    if constexpr (Epi::AFTER_DRAIN) { int fr_e = fr, fq_e = fq; asm volatile("" : "+v"(fr_e), "+v"(fq_e)); E.fused(acc, cur, wr, wc, fr_e, fq_e, lds, wid, lane); }
#undef PG8_SA
#undef PG8_SB
#undef PG8_STAGE
#undef PG8_STAGE_A
#undef PG8_LDA
#undef PG8_LDB
#undef PG8_MMA
#undef PG8_WAIT_V
#undef PG8_WAIT_V8R
#undef PG8_WAIT_L
#undef PG8_BAR
#undef PG8_SCHED
}
constexpr int NXCD = 8;
#ifndef GATE_STASH
#define GATE_STASH 1
#endif
#ifndef RES_FROM_H
#define RES_FROM_H 1
#endif
#ifndef EPI_TOUCH
#define EPI_TOUCH 0
#endif
#ifndef PROJ_WGM
#define PROJ_WGM 8
#endif
__device__ __forceinline__ void static_tile(int L, int nM, int nN, int& pm, int& pn, const int WGM = 8) {
    const int nwg = nM * nN; int wgid = L;
    { const int q = nwg / NXCD, r = nwg % NXCD, xcd = wgid % NXCD, off = wgid / NXCD; wgid = (xcd < r ? xcd * (q + 1) : r * (q + 1) + (xcd - r) * q) + off; }
    const int nig = WGM * nN, gid = wgid / nig, fm = gid * WGM, gsz = (nM - fm) < WGM ? (nM - fm) : WGM;
    pm = fm + ((wgid % nig) % gsz); pn = (wgid % nig) / gsz;
}
struct SchedPlain {
    static constexpr bool GATHER = false;
    const char* A; const char* Bt; size_t tstepA, tstepB; int nM, nN; int r0 = 0, r1 = 1 << 20;
    __device__ __forceinline__ bool next(int i, Unit& u) const { const int k = i + r0; if (k >= r1) return false;
        const int L = k * (int)gridDim.x + (int)blockIdx.x; if (L >= nM * nN) return false; static_tile(L, nM, nN, u.pm, u.pn); u.z = 0; return true; }
    __device__ __forceinline__ const char* baseA(const Unit& u) const { return A + (size_t)u.pm * tstepA; }
    __device__ __forceinline__ const char* baseB(const Unit& u) const { return Bt + (size_t)u.pn * tstepB; }
    __device__ __forceinline__ unsigned arow(const Unit&, int) const { return 0u; }
};
struct SchedProj {
    static constexpr bool GATHER = false;
    const unsigned char* ws; int r0, r1;
    __device__ __forceinline__ bool next(int i, Unit& u) const {
        if (i + r0 >= r1) return false;
        const int L = (i + r0) * (int)gridDim.x + (int)blockIdx.x;
        constexpr int NPB = GATES_F8 ? 18 : 42;
        if (L < 64 * NPB) { static_tile(L, 64, NPB, u.pm, u.pn, PROJ_WGM); u.z = (u.pn == 13) ? 2 : 0; return true; }
        const int L2 = L - 64 * NPB; if (L2 >= 64) return false;
        if (L2 < 32) { u.pm = L2 & 7; u.pn = L2 >> 3; u.z = 1; } else { u.pm = (L2 - 32) & 3; u.pn = (L2 - 32) >> 2; u.z = 3; }
        return true;
    }
    __device__ __forceinline__ const char* baseA(const Unit& u) const {
        const size_t ts = (size_t)256 * LDP * 2;
        if (u.z == 0) return (const char*)ws + WS_H + (size_t)u.pm * ts;
        if (u.z == 2) return (const char*)ws + WS_WINT + (size_t)13 * ts;
        if (u.z == 1) return (const char*)ws + WS_MEMBF + (size_t)u.pm * ts;
        return (const char*)ws + WS_WMKVT + (size_t)(4 + u.pm) * ts;
    }
    __device__ __forceinline__ const char* baseB(const Unit& u) const {
        const size_t ts = (size_t)256 * LDP * 2;
        if (u.z == 0) return (const char*)ws + WS_WINT + (size_t)u.pn * ts;
        if (u.z == 2) return (const char*)ws + WS_H + (size_t)u.pm * ts;
        if (u.z == 1) return (const char*)ws + WS_WMKVT + (size_t)u.pn * ts;
        return (const char*)ws + WS_MEMBF + (size_t)u.pn * ts;
    }
    __device__ __forceinline__ unsigned arow(const Unit&, int) const { return 0u; }
};
struct SchedGates8 {
    static constexpr bool GATHER = false;
    const unsigned char* ws; int r0, r1;
    __device__ __forceinline__ bool next(int i, Unit& u) const {
        if (i + r0 >= r1) return false;
        const int L = (i + r0) * (int)gridDim.x + (int)blockIdx.x; if (L >= 64 * 24) return false;
        static_tile(L, 64, 24, u.pm, u.pn, PROJ_WGM); u.z = 0; return true;
    }
    __device__ __forceinline__ const char* baseA(const Unit& u) const { return (const char*)ws + WS_H8 + (size_t)u.pm * (256 * 2048); }
    __device__ __forceinline__ const char* baseB(const Unit& u) const { return (const char*)ws + WS_WINQ + (size_t)u.pn * (256 * 2048); }
    __device__ __forceinline__ unsigned arow(const Unit&, int) const { return 0u; }
};
struct SchedChan {
    static constexpr bool GATHER = false;
    const unsigned char* ws; int u0, nu;
    __device__ __forceinline__ bool next(int i, Unit& u) const {
        const int L = i * (int)gridDim.x + vwg();
        if constexpr (SEQFOLD) { if (L >= 32 * 8) return false; u.z = L >> 3; u.pn = L & 7; u.pm = (u.pn >= 4) ? 1 : 0; u.idx = i; return true; }
        if (L >= 512) return false;
        u.z = L >> 4; u.pm = (L >> 3) & 1; u.pn = L & 7; return true;
    }
    __device__ __forceinline__ const char* baseA(const Unit& u) const { return (const char*)ws + WS_TABT + (size_t)u.pm * (256 * 256 * 2); }
    __device__ __forceinline__ const char* baseB(const Unit& u) const {
        if constexpr (SEQFOLD) return (const char*)ws + WS_XF + (size_t)(vwg() * 2 + u.idx) * (256 * 256 * 2);
        const int b = u.z >> 2, g = u.z & 3; return (const char*)ws + WS_FIN + ((size_t)(b * 2048 + u.pn * 256) * 1024 + g * 256) * 2; }
    __device__ __forceinline__ unsigned arow(const Unit&, int) const { return 0u; }
};
struct SchedSeq {
    static constexpr bool GATHER = false;
    const unsigned char* ws;
    __device__ __forceinline__ bool next(int i, Unit& u) const {
        const int L = i * (int)gridDim.x + vwg(); if (L >= 256) return false;
        u.z = L >> 3; u.pm = L & 7; u.pn = 0; return true;
    }
    __device__ __forceinline__ const char* baseA(const Unit& u) const { return (const char*)ws + WS_DMAT + (size_t)u.pm * ((size_t)256 * SQP * 2); }
    __device__ __forceinline__ const char* baseB(const Unit& u) const { return (const char*)ws + WS_ZT + (size_t)u.z * ((size_t)256 * SQP * 2); }
    __device__ __forceinline__ unsigned arow(const Unit&, int) const { return 0u; }
};
struct SchedOne {
    static constexpr bool GATHER = false;
    const char* A; const char* Bt; int z; bool valid;
    __device__ __forceinline__ bool next(int i, Unit& u) const { if (i != 0 || !valid) return false; u.pm = 0; u.pn = 0; u.z = z; return true; }
    __device__ __forceinline__ const char* baseA(const Unit&) const { return A; }
    __device__ __forceinline__ const char* baseB(const Unit&) const { return Bt; }
    __device__ __forceinline__ unsigned arow(const Unit&, int) const { return 0u; }
};
template <bool GATH, int NT  , bool F8>
struct SchedMoe {
    static constexpr bool GATHER = GATH;
    static constexpr int ES = F8 ? 1 : 2;
    const unsigned char* ws; const LAS int* pt; const LAS int* cn; int same = 0;
    int r0 = 0, r1 = 1 << 20;
    __device__ __forceinline__ int ptu(int k) const { return __builtin_amdgcn_readfirstlane(pt[k]); }
    __device__ __forceinline__ bool next(int i, Unit& u) const {
        const int k = i + r0; if (k >= r1) return false;
        const int L = k * (int)gridDim.x + vwg(); const int total = ptu(NE) * NT; if (L >= total) return false;
        const int ln = (int)(threadIdx.x & 63);
        const unsigned long long bal = __ballot(ln < NE && L >= pt[ln & 31] * NT);
        const int e = __builtin_amdgcn_readfirstlane(__popcll(bal) - 1);
        const int t = L - ptu(e) * NT, mte = ptu(e + 1) - ptu(e);
        u.z = e; u.pm = t % mte; u.pn = t / mte; u.idx = k; return true;
    }
    __device__ __forceinline__ const char* baseA(const Unit& u) const {
        if constexpr (GATH) return (const char*)ws + (F8 ? WS_H2Q : WS_H2);
        else return (const char*)ws + (F8 ? WS_ACTQ : WS_ACT) + (same ? (size_t)0 : (size_t)(ptu(u.z) + u.pm) * (256 * 2048 * ES));
    }
    __device__ __forceinline__ const char* baseB(const Unit& u) const {
        if constexpr (GATH) return (const char*)ws + (F8 ? WS_WGUQ : WS_WGUT) + ((size_t)u.z * 4096 + (size_t)u.pn * 256) * (2048 * ES);
        else return (const char*)ws + (F8 ? WS_WDNQ : WS_WDNT) + (same ? (size_t)0 : ((size_t)u.z * 2048 + (size_t)u.pn * 256) * (2048 * ES));
    }
    __device__ __forceinline__ unsigned arow(const Unit& u, int r) const {
        const LAS unsigned short* tokl = (const LAS unsigned short*)((const LAS unsigned char*)pt - LDS_MISC + LDS_TOKL);
        return (unsigned)tokl[u.idx * 256 + r] * (unsigned)(2048 * ES);
    }
};

__device__ __forceinline__ void store_tile_bf16(const f32x4 (&acc)[2][2][4][2], bf16_t* dst  , size_t ldc, int wr, int wc, int fr, int fq) {
    const int row0 = wr * 64 + fr, col0 = wc * 32 + 8 * fq;
#pragma unroll
    for (int ai = 0; ai < 2; ++ai)
#pragma unroll
        for (int m = 0; m < 4; ++m) { bf16_t* rowp = dst + (size_t)(row0 + ai * HALF + m * 16) * ldc + col0;
#pragma unroll
            for (int bj = 0; bj < 2; ++bj) { const f32x4 v0 = acc[ai][bj][m][0], v1 = acc[ai][bj][m][1];
                u32x4 w; w.x = cvtpk(v0[0], v0[1]); w.y = cvtpk(v0[2], v0[3]); w.z = cvtpk(v1[0], v1[1]); w.w = cvtpk(v1[2], v1[3]);
                *(u32x4*)(rowp + bj * HALF) = w; } }
}
struct EpiProj {
    static constexpr bool PERM = true, AFTER_DRAIN = false; static constexpr int NSTORE = 16;
    unsigned char* ws;
    __device__ __forceinline__ void operator()(const f32x4 (&acc)[2][2][4][2], const Unit& u, int wr, int wc, int fr, int fq) const {
        const int pn = u.pn, pm = u.pm;
        bf16_t* dst; size_t ldc;
        if (u.z == 0) {
            if (pn >= 18) {
                dst = (bf16_t*)(ws + WS_GATES) + (size_t)pm * 256 * 6144 + (pn - 18) * 256;
                const int row0 = wr * 64 + fr, col0 = wc * 32 + 8 * fq;
#pragma unroll
                for (int ai = 0; ai < 2; ++ai)
#pragma unroll
                    for (int m = 0; m < 4; ++m) { bf16_t* rowp = dst + (size_t)(row0 + ai * HALF + m * 16) * 6144 + col0;
#pragma unroll
                        for (int bj = 0; bj < 2; ++bj) { const f32x4 v0 = acc[ai][bj][m][0], v1 = acc[ai][bj][m][1];
                            u32x4 w; w.x = cvtpk(sigmoidf_(v0[0]), sigmoidf_(v0[1])); w.y = cvtpk(sigmoidf_(v0[2]), sigmoidf_(v0[3]));
                            w.z = cvtpk(sigmoidf_(v1[0]), sigmoidf_(v1[1])); w.w = cvtpk(sigmoidf_(v1[2]), sigmoidf_(v1[3]));
                            *(u32x4*)(rowp + bj * HALF) = w; } }
                return;
            }
            if (pn < 4) { dst = (bf16_t*)(ws + WS_FIN) + pn * 256; ldc = 1024; }
            else if (pn < 12) { dst = (bf16_t*)(ws + WS_Q) + (pn - 4) * 256; ldc = 2048; }
            else if (pn == 12) { dst = (bf16_t*)(ws + WS_K); ldc = 256; }
            else { dst = (bf16_t*)(ws + WS_QM) + (pn - 14) * 256; ldc = 1024; }
            dst += (size_t)pm * 256 * ldc;
        } else if (u.z == 2) {
            dst = (bf16_t*)(ws + WS_VT) + (size_t)(pm >> 3) * 256 * 2048 + (size_t)(pm & 7) * 256; ldc = 2048;
        } else if (u.z == 1) {
            dst = (bf16_t*)(ws + WS_KMK) + (size_t)pm * 256 * 1024 + pn * 256; ldc = 1024;
        } else {
            dst = (bf16_t*)(ws + WS_VMT) + (size_t)(pn * 4 + pm) * 256 * 256; ldc = 256;
        }
        store_tile_bf16(acc, dst, ldc, wr, wc, fr, fq);
    }
};
__device__ __forceinline__ unsigned pk_u8x4(float a, float b, float c, float d) {
    const unsigned x = (unsigned)(a * 255.0f + 0.5f), y = (unsigned)(b * 255.0f + 0.5f), z = (unsigned)(c * 255.0f + 0.5f), w = (unsigned)(d * 255.0f + 0.5f);
    return x | (y << 8) | (z << 16) | (w << 24); }
struct EpiGates8 {
    static constexpr int PERM = 2; static constexpr bool AFTER_DRAIN = false; static constexpr int NSTORE = 8;
    unsigned char* ws;
    __device__ __forceinline__ void operator()(const f32x4 (&acc)[2][2][4][2], const Unit& u, int wr, int wc, int fr, int fq) const {
        unsigned char* dst = ws + WS_GATES + (size_t)u.pm * 256 * 6144 + u.pn * 256;
        const int row0 = wr * 64 + fr, col0 = wc * 64 + 16 * fq;
#pragma unroll
        for (int ai = 0; ai < 2; ++ai)
#pragma unroll
            for (int m = 0; m < 4; ++m) {
                u32x4 w;
                { const f32x4 a = acc[ai][0][m][0] * WQ_INV, c = acc[ai][0][m][1] * WQ_INV;
                  w.x = pk_u8x4(sigmoidf_(a[0]), sigmoidf_(a[1]), sigmoidf_(a[2]), sigmoidf_(a[3])); w.y = pk_u8x4(sigmoidf_(c[0]), sigmoidf_(c[1]), sigmoidf_(c[2]), sigmoidf_(c[3])); }
                { const f32x4 a = acc[ai][1][m][0] * WQ_INV, c = acc[ai][1][m][1] * WQ_INV;
                  w.z = pk_u8x4(sigmoidf_(a[0]), sigmoidf_(a[1]), sigmoidf_(a[2]), sigmoidf_(a[3])); w.w = pk_u8x4(sigmoidf_(c[0]), sigmoidf_(c[1]), sigmoidf_(c[2]), sigmoidf_(c[3])); }
                *(u32x4*)(dst + (size_t)(row0 + ai * HALF + m * 16) * 6144 + col0) = w; }
    }
};
struct EpiChan {
    static constexpr bool PERM = true, AFTER_DRAIN = false; static constexpr int NSTORE = 0;
    unsigned char* ws;
    __device__ __forceinline__ void operator()(const f32x4 (&acc)[2][2][4][2], const Unit& u, int wr, int wc, int fr, int fq) const {
        store_tile_bf16(acc, (bf16_t*)(ws + WS_ZT) + (size_t)u.z * 256 * SQP + (SEQFOLD ? (size_t)0 : (size_t)u.pm * 2048) + u.pn * 256, SQP, wr, wc, fr, fq);
    }
};
struct EpiSeq {
    static constexpr bool PERM = true, AFTER_DRAIN = false; static constexpr int NSTORE = 0;
    unsigned char* ws;
    __device__ __forceinline__ void operator()(const f32x4 (&acc)[2][2][4][2], const Unit& u, int wr, int wc, int fr, int fq) const {
        const int b = u.z >> 2, g = u.z & 3;
        store_tile_bf16(acc, (bf16_t*)(ws + WS_FX) + (size_t)(b * 2048 + u.pm * 256) * 2048 + g * 256, 2048, wr, wc, fr, fq);
    }
};
template <int STEP> struct EpiMix {
    static constexpr int PERM = 1; static constexpr bool AFTER_DRAIN = false; static constexpr int NSTORE = 16;
    unsigned char* ws;
    __device__ __forceinline__ void operator()(const f32x4 (&acc)[2][2][4][2], const Unit& u, int wr, int wc, int fr, int fq) const {
        const int row0 = u.pm * 256 + wr * 64 + fr, col0 = u.pn * 256 + wc * 32 + 8 * fq;
        const bf16_t* gates = (const bf16_t*)(ws + WS_GATES) + STEP * 2048; const unsigned char* gates8 = ws + WS_GATES + STEP * 2048;
        bf16_t* macc = (bf16_t*)(ws + WS_MIXACC); bf16_t* mixed = (bf16_t*)(ws + WS_MIXED);
#pragma unroll
        for (int ai = 0; ai < 2; ++ai) {
            u32x2 g8[4][2]; u32x4 gw[4][2]; u32x4 mw[4][2];
#pragma unroll
            for (int m = 0; m < 4; ++m) { const size_t row = (size_t)(row0 + ai * HALF + m * 16);
#pragma unroll
                for (int bj = 0; bj < 2; ++bj) { const int col = col0 + bj * HALF;
                    if constexpr (GATES_F8) g8[m][bj] = *(const u32x2*)(gates8 + row * 6144 + col); else gw[m][bj] = *(const u32x4*)(gates + row * 6144 + col);
                    if (STEP > 0) mw[m][bj] = *(const u32x4*)(macc + row * 2048 + col); } }
#pragma unroll
            for (int m = 0; m < 4; ++m) { const size_t row = (size_t)(row0 + ai * HALF + m * 16);
#pragma unroll
                for (int bj = 0; bj < 2; ++bj) { const int col = col0 + bj * HALF;
                    f32x4 v0 = acc[ai][bj][m][0], v1 = acc[ai][bj][m][1];
                    if constexpr (GATES_F8) { const u32x2 g = g8[m][bj]; const float k = 1.0f / 255.0f;
                        v0[0] *= (float)(g.x & 255u) * k; v0[1] *= (float)((g.x >> 8) & 255u) * k; v0[2] *= (float)((g.x >> 16) & 255u) * k; v0[3] *= (float)(g.x >> 24) * k;
                        v1[0] *= (float)(g.y & 255u) * k; v1[1] *= (float)((g.y >> 8) & 255u) * k; v1[2] *= (float)((g.y >> 16) & 255u) * k; v1[3] *= (float)(g.y >> 24) * k; }
                    else { const u32x4 g = gw[m][bj];
                        v0[0] *= bflo(g.x); v0[1] *= bfhi(g.x); v0[2] *= bflo(g.y); v0[3] *= bfhi(g.y);
                        v1[0] *= bflo(g.z); v1[1] *= bfhi(g.z); v1[2] *= bflo(g.w); v1[3] *= bfhi(g.w); }
                    if (STEP > 0) { const u32x4 q = mw[m][bj];
                        v0[0] += bflo(q.x); v0[1] += bfhi(q.x); v0[2] += bflo(q.y); v0[3] += bfhi(q.y);
                        v1[0] += bflo(q.z); v1[1] += bfhi(q.z); v1[2] += bflo(q.w); v1[3] += bfhi(q.w); }
                    u32x4 w; w.x = cvtpk(v0[0], v0[1]); w.y = cvtpk(v0[2], v0[3]); w.z = cvtpk(v1[0], v1[1]); w.w = cvtpk(v1[2], v1[3]);
                    *(u32x4*)((STEP < 2 ? macc : mixed) + row * 2048 + col) = w; } }
        }
    }
};
struct SchedMix {
    static constexpr bool GATHER = false; static constexpr bool VARK = true;
    const unsigned char* ws; int r0, r1;
    __device__ __forceinline__ bool next(int i, Unit& u) const {
        const int tr = r0 + i / 3; if (tr >= r1) return false;
        const int L = tr * (int)gridDim.x + (int)blockIdx.x; if (L >= 64 * 8) return false;
        static_tile(L, 64, 8, u.pm, u.pn); u.z = i % 3; return true;
    }
    __device__ __forceinline__ int ktiles(const Unit& u) const { return u.z == 1 ? 32 : 16; }
    __device__ __forceinline__ const char* baseA(const Unit& u) const {
        const size_t ts = (size_t)256 * 2048 * 2;
        return (const char*)ws + (u.z == 1 ? WS_ATT : WS_FX + (u.z == 2 ? 2048 : 0)) + (size_t)u.pm * ts;
    }
    __device__ __forceinline__ const char* baseB(const Unit& u) const {
        const size_t ts = (size_t)256 * 2048 * 2;
        return (const char*)ws + (u.z == 1 ? WS_WAOT : WS_WFM + (u.z == 2 ? 2048 : 0)) + (size_t)u.pn * ts;
    }
    __device__ __forceinline__ unsigned arow(const Unit&, int) const { return 0u; }
};
struct EpiMixF {
    static constexpr int PERM = 1; static constexpr bool AFTER_DRAIN = false, KEEP = true; static constexpr int NSTORE = 16;
    unsigned char* ws; LAS unsigned char* lds;
    __device__ __forceinline__ bool keep(const Unit& u) const { return u.z < 2; }
    static constexpr bool TOUCH = EPI_TOUCH;
    __device__ __forceinline__ void touch(const Unit& u, LAS unsigned char* lds, int tid, int wid) const {
        if (u.z != 0) return;
        const unsigned char* q = ws + WS_GATES + (size_t)(u.pm * 256 + (tid >> 1)) * 6144 + u.pn * 256 + (tid & 1) * 128;
#pragma unroll
        for (int s = 0; s < 3; ++s) __builtin_amdgcn_global_load_lds((const unsigned*)(q + s * 2048), (LAS unsigned*)(lds + LDS_BTAB + wid * 1024 + s * 256), 4, 0, 0);
    }
    static __device__ __forceinline__ float gb(unsigned w, int k) { return (float)((w >> (8 * k)) & 255u); }
    static constexpr int STASH_N = (LDS_XBW - STAGE_BYTES) / 8;
    __device__ __forceinline__ void operator()(f32x4 (&acc)[2][2][4][2], const Unit& u, int wr, int wc, int fr, int fq) const {
        const int row0 = u.pm * 256 + wr * 64 + fr, col0 = u.pn * 256 + wc * 32 + 8 * fq;
        const int seg = __builtin_amdgcn_readfirstlane(u.z);
        const int tidx = (wr * 4 + wc) * 64 + fq * 16 + fr;
        LAS u32x2* stash = (LAS u32x2*)(lds + STAGE_BYTES);
        const unsigned char* gnum = ws + WS_GATES + seg * 2048;
        bf16_t* mixed = (bf16_t*)(ws + WS_MIXED);
        if (seg < 2) {
#pragma unroll
            for (int ai = 0; ai < 2; ++ai) {
                u32x2 gn[4][2], gd[4][2];
#pragma unroll
                for (int m = 0; m < 4; ++m) { const size_t row = (size_t)(row0 + ai * HALF + m * 16);
#pragma unroll
                    for (int bj = 0; bj < 2; ++bj) { const unsigned char* q = gnum + row * 6144 + col0 + bj * HALF; const int e = (m * 2 + bj) * 512 + tidx;
                        if (GATE_STASH && ai == 0 && seg == 1 && e < STASH_N) gn[m][bj] = stash[e]; else gn[m][bj] = *(const u32x2*)q;
                        gd[m][bj] = *(const u32x2*)(q + 2048); } }
                if (GATE_STASH && ai == 0) {
#pragma unroll
                    for (int m = 0; m < 4; ++m)
#pragma unroll
                        for (int bj = 0; bj < 2; ++bj) { const int e = (m * 2 + bj) * 512 + tidx; if (e < STASH_N) stash[e] = gd[m][bj]; }
                }
#pragma unroll
                for (int m = 0; m < 4; ++m)
#pragma unroll
                    for (int bj = 0; bj < 2; ++bj) {
#pragma unroll
                        for (int k = 0; k < 4; ++k) {
                            const float n0 = (seg == 0) ? gb(gn[m][bj].x, k) : fmaxf(gb(gn[m][bj].x, k), 0.5f), n1 = (seg == 0) ? gb(gn[m][bj].y, k) : fmaxf(gb(gn[m][bj].y, k), 0.5f);
                            acc[ai][bj][m][0][k] *= n0 * __builtin_amdgcn_rcpf(fmaxf(gb(gd[m][bj].x, k), 0.5f));
                            acc[ai][bj][m][1][k] *= n1 * __builtin_amdgcn_rcpf(fmaxf(gb(gd[m][bj].y, k), 0.5f)); } }
            }
        } else {
#pragma unroll
            for (int ai = 0; ai < 2; ++ai) {
                u32x2 gn[4][2];
#pragma unroll
                for (int m = 0; m < 4; ++m) { const size_t row = (size_t)(row0 + ai * HALF + m * 16);
#pragma unroll
                    for (int bj = 0; bj < 2; ++bj) { const int e = (m * 2 + bj) * 512 + tidx;
                        if (GATE_STASH && ai == 0 && e < STASH_N) gn[m][bj] = stash[e]; else gn[m][bj] = *(const u32x2*)(gnum + row * 6144 + col0 + bj * HALF); } }
#pragma unroll
                for (int m = 0; m < 4; ++m) { const size_t row = (size_t)(row0 + ai * HALF + m * 16);
#pragma unroll
                    for (int bj = 0; bj < 2; ++bj) { const float kq = 1.0f / 255.0f; f32x4 v0 = acc[ai][bj][m][0], v1 = acc[ai][bj][m][1];
#pragma unroll
                        for (int k = 0; k < 4; ++k) { v0[k] *= fmaxf(gb(gn[m][bj].x, k), 0.5f) * kq; v1[k] *= fmaxf(gb(gn[m][bj].y, k), 0.5f) * kq; }
                        u32x4 w; w.x = cvtpk(v0[0], v0[1]); w.y = cvtpk(v0[2], v0[3]); w.z = cvtpk(v1[0], v1[1]); w.w = cvtpk(v1[2], v1[3]);
                        *(u32x4*)(mixed + row * 2048 + col0 + bj * HALF) = w; } }
            }
        }
    }
};
struct EpiRes {
    static constexpr int PERM = 1; static constexpr bool AFTER_DRAIN = false; static constexpr int NSTORE = 16;
    const float* x; bf16_t* x2; const bf16_t* h; const float* irs; const float* g1;
    static constexpr bool TOUCH = EPI_TOUCH;
    __device__ __forceinline__ void touch(const Unit& u, LAS unsigned char* lds, int tid, int wid) const {
        const unsigned char* q = (const unsigned char*)(x + (size_t)(u.pm * 256 + (tid >> 1)) * 2048 + u.pn * 256) + (tid & 1) * 512;
#pragma unroll
        for (int j = 0; j < 4; ++j) __builtin_amdgcn_global_load_lds((const unsigned*)(q + j * 128), (LAS unsigned*)(lds + LDS_BTAB + wid * 1024 + j * 256), 4, 0, 0);
    }
    __device__ __forceinline__ void operator()(const f32x4 (&acc)[2][2][4][2], const Unit& u, int wr, int wc, int fr, int fq) const {
        const int row0 = u.pm * 256 + wr * 64 + fr, col0 = u.pn * 256 + wc * 32 + 8 * fq;
        if constexpr (RES_FROM_H) {
            f32x4 ig[2][2]; bool bad = false;
#pragma unroll
            for (int bj = 0; bj < 2; ++bj)
#pragma unroll
                for (int n2 = 0; n2 < 2; ++n2) { const f32x4 gv = *(const f32x4*)(g1 + col0 + bj * HALF + 4 * n2);
#pragma unroll
                    for (int k = 0; k < 4; ++k) { bad |= (gv[k] == 0.f); ig[bj][n2][k] = __builtin_amdgcn_rcpf(gv[k]); } }
            if (!__any(bad)) {
#pragma unroll
                for (int ai = 0; ai < 2; ++ai) {
                    float ir[4]; u32x4 hv[4][2];
#pragma unroll
                    for (int m = 0; m < 4; ++m) { const size_t row = (size_t)(row0 + ai * HALF + m * 16); ir[m] = irs[row];
#pragma unroll
                        for (int bj = 0; bj < 2; ++bj) hv[m][bj] = *(const u32x4*)(h + row * LDP + col0 + bj * HALF); }
#pragma unroll
                    for (int m = 0; m < 4; ++m) { const size_t off = (size_t)(row0 + ai * HALF + m * 16) * 2048 + col0;
#pragma unroll
                        for (int bj = 0; bj < 2; ++bj) { const u32x4 q = hv[m][bj]; const f32x4 i0 = ig[bj][0] * ir[m], i1 = ig[bj][1] * ir[m];
                            const f32x4 v0 = acc[ai][bj][m][0] + (f32x4){bflo(q.x), bfhi(q.x), bflo(q.y), bfhi(q.y)} * i0, v1 = acc[ai][bj][m][1] + (f32x4){bflo(q.z), bfhi(q.z), bflo(q.w), bfhi(q.w)} * i1;
                            u32x4 w; w.x = cvtpk(v0[0], v0[1]); w.y = cvtpk(v0[2], v0[3]); w.z = cvtpk(v1[0], v1[1]); w.w = cvtpk(v1[2], v1[3]);
                            *(u32x4*)(x2 + off + bj * HALF) = w; } }
                }
                return;
            }
        }
#pragma unroll
        for (int ai = 0; ai < 2; ++ai) {
            f32x4 xv[4][2][2];
#pragma unroll
            for (int m = 0; m < 4; ++m) { const size_t off = (size_t)(row0 + ai * HALF + m * 16) * 2048 + col0;
#pragma unroll
                for (int bj = 0; bj < 2; ++bj) { xv[m][bj][0] = *(const f32x4*)(x + off + bj * HALF); xv[m][bj][1] = *(const f32x4*)(x + off + bj * HALF + 4); } }
#pragma unroll
            for (int m = 0; m < 4; ++m) { const size_t off = (size_t)(row0 + ai * HALF + m * 16) * 2048 + col0;
#pragma unroll
                for (int bj = 0; bj < 2; ++bj) { const f32x4 v0 = acc[ai][bj][m][0] + xv[m][bj][0], v1 = acc[ai][bj][m][1] + xv[m][bj][1];
                    u32x4 w; w.x = cvtpk(v0[0], v0[1]); w.y = cvtpk(v0[2], v0[3]); w.z = cvtpk(v1[0], v1[1]); w.w = cvtpk(v1[2], v1[3]);
                    *(u32x4*)(x2 + off + bj * HALF) = w; } }
        }
    }
};
__device__ __forceinline__ float swiglu1(float g, float up) {
    g = fminf(g, 7.0f); up = fminf(fmaxf(up, -7.0f), 7.0f);
    return (up + 1.0f) * (g * sigmoid_sc(g, -1.702f * LOG2E));
}
struct EpiSwiglu {
    static constexpr bool PERM = true, AFTER_DRAIN = false; static constexpr int NSTORE = 8;
    unsigned char* ws; const float* bgu; const LAS int* pt;
    __device__ __forceinline__ void operator()(const f32x4 (&acc)[2][2][4][2], const Unit& u, int wr, int wc, int fr, int fq) const {
        const int e = u.z; const size_t srow0 = (size_t)(__builtin_amdgcn_readfirstlane(pt[e]) + u.pm) * 256 + wr * 64 + fr;
        const int col0 = u.pn * 256 + wc * 32 + 8 * fq;
        bf16_t* act = (bf16_t*)(ws + WS_ACT);
        f32x4 bv[2][2];
#pragma unroll
        for (int bj = 0; bj < 2; ++bj)
#pragma unroll
            for (int n = 0; n < 2; ++n) bv[bj][n] = *(const f32x4*)(bgu + (size_t)e * 4096 + col0 + bj * HALF + 4 * n);
#pragma unroll
        for (int ai = 0; ai < 2; ++ai)
#pragma unroll
            for (int m = 0; m < 4; ++m) { bf16_t* rowp = act + (srow0 + ai * HALF + m * 16) * 2048 + (col0 >> 1);
#pragma unroll
                for (int bj = 0; bj < 2; ++bj) { const f32x4 v0 = acc[ai][bj][m][0] + bv[bj][0], v1 = acc[ai][bj][m][1] + bv[bj][1];
                    u32x2 w; w.x = cvtpk(swiglu1(v0[0], v0[1]), swiglu1(v0[2], v0[3])); w.y = cvtpk(swiglu1(v1[0], v1[1]), swiglu1(v1[2], v1[3]));
                    *(u32x2*)(rowp + bj * (HALF / 2)) = w; } }
    }
};
struct EpiDown {
    static constexpr bool PERM = true, AFTER_DRAIN = false; static constexpr int NSTORE = 8;
    unsigned char* ws; const float* bdn; const LAS int* pt; const LAS int* cn;
    __device__ __forceinline__ void operator()(const f32x4 (&acc)[2][2][4][2], const Unit& u, int wr, int wc, int fr, int fq) const {
        const int e = u.z; const int lrow0 = u.pm * 256 + wr * 64 + fr; const size_t srow0 = (size_t)__builtin_amdgcn_readfirstlane(pt[e]) * 256 + lrow0;
        const int col0 = u.pn * 256 + wc * 32 + 8 * fq;
        bf16_t* ys = (bf16_t*)(ws + WS_YS); const float* wl = (const float*)(ws + WS_WLIST) + (size_t)e * T_; const int cne = __builtin_amdgcn_readfirstlane(cn[e]);
        f32x4 bv[2][2];
#pragma unroll
        for (int bj = 0; bj < 2; ++bj)
#pragma unroll
            for (int n = 0; n < 2; ++n) bv[bj][n] = *(const f32x4*)(bdn + (size_t)e * 2048 + col0 + bj * HALF + 4 * n);
#pragma unroll
        for (int ai = 0; ai < 2; ++ai)
#pragma unroll
            for (int m = 0; m < 4; ++m) { const int pos = lrow0 + ai * HALF + m * 16; const float w = (pos < cne) ? wl[pos] : 0.f;
                bf16_t* rowp = ys + (srow0 + ai * HALF + m * 16) * 2048 + col0;
#pragma unroll
                for (int bj = 0; bj < 2; ++bj) { const f32x4 v0 = (acc[ai][bj][m][0] + bv[bj][0]) * w, v1 = (acc[ai][bj][m][1] + bv[bj][1]) * w;
                    u32x4 o; o.x = cvtpk(v0[0], v0[1]); o.y = cvtpk(v0[2], v0[3]); o.z = cvtpk(v1[0], v1[1]); o.w = cvtpk(v1[2], v1[3]);
                    *(u32x4*)(rowp + bj * HALF) = o; } }
    }
};
__device__ __forceinline__ unsigned pk_fp8x4(float a, float b, float c, float d) {
    int w = __builtin_amdgcn_cvt_pk_fp8_f32(a, b, 0, false); w = __builtin_amdgcn_cvt_pk_fp8_f32(c, d, w, true); return (unsigned)w; }
struct EpiSwiglu8 {
    static constexpr int PERM = 2; static constexpr bool AFTER_DRAIN = false; static constexpr int NSTORE = 8;
    unsigned char* ws; const float* bgu; const LAS int* pt;
    __device__ __forceinline__ void operator()(const f32x4 (&acc)[2][2][4][2], const Unit& u, int wr, int wc, int fr, int fq) const {
        const int e = u.z; const size_t srow0 = (size_t)(__builtin_amdgcn_readfirstlane(pt[e]) + u.pm) * 256 + wr * 64 + fr;
        const int col0 = u.pn * 256 + wc * 64 + 16 * fq;
        unsigned char* act = ws + WS_ACTQ;
        const LAS float* btab = (const LAS float*)((const LAS unsigned char*)pt - LDS_MISC + LDS_BTAB) + u.idx * 256 + wc * 64 + 16 * fq;
        f32x4 bv[2][2];
#pragma unroll
        for (int bj = 0; bj < 2; ++bj)
#pragma unroll
            for (int n = 0; n < 2; ++n) bv[bj][n] = *(const LAS f32x4*)(btab + 8 * bj + 4 * n);
#pragma unroll
        for (int ai = 0; ai < 2; ++ai)
#pragma unroll
            for (int m = 0; m < 4; ++m) {
                float o[8];
#pragma unroll
                for (int bj = 0; bj < 2; ++bj)
#pragma unroll
                    for (int n = 0; n < 2; ++n) { const f32x4 v = acc[ai][bj][m][n] * WQ_INV + bv[bj][n]; o[4 * bj + 2 * n] = swiglu1(v[0], v[1]); o[4 * bj + 2 * n + 1] = swiglu1(v[2], v[3]); }
                u32x2 w; w.x = pk_fp8x4(o[0], o[1], o[2], o[3]); w.y = pk_fp8x4(o[4], o[5], o[6], o[7]);
                *(u32x2*)(act + (srow0 + ai * HALF + m * 16) * 2048 + (col0 >> 1)) = w; }
    }
};
struct EpiDown8 {
    static constexpr int PERM = 2; static constexpr bool AFTER_DRAIN = false; static constexpr int NSTORE = 8;
    unsigned char* ws; const float* bdn; const LAS int* pt; const LAS int* cn; size_t ysbase = WS_YS;
    __device__ __forceinline__ void operator()(const f32x4 (&acc)[2][2][4][2], const Unit& u, int wr, int wc, int fr, int fq) const {
        const int e = u.z; const int lrow0 = u.pm * 256 + wr * 64 + fr; const size_t srow0 = (size_t)__builtin_amdgcn_readfirstlane(pt[e]) * 256 + lrow0;
        const int col0 = u.pn * 256 + wc * 64 + 16 * fq;
        unsigned char* ys = ws + ysbase;
        const LAS float* btab = (const LAS float*)((const LAS unsigned char*)pt - LDS_MISC + LDS_BTAB) + u.idx * 256 + wc * 64 + 16 * fq;
        const LAS float* wtab = (const LAS float*)((const LAS unsigned char*)pt - LDS_MISC + LDS_TOKL) + u.idx * 256 + wr * 64 + fr;
        f32x4 bv[2][2];
#pragma unroll
        for (int bj = 0; bj < 2; ++bj)
#pragma unroll
            for (int n = 0; n < 2; ++n) bv[bj][n] = *(const LAS f32x4*)(btab + 8 * bj + 4 * n);
#pragma unroll
        for (int ai = 0; ai < 2; ++ai)
#pragma unroll
            for (int m = 0; m < 4; ++m) { const float w = wtab[ai * HALF + m * 16];
                u32x4 o;
                { const f32x4 a = (acc[ai][0][m][0] * WQ_INV + bv[0][0]) * w, c = (acc[ai][0][m][1] * WQ_INV + bv[0][1]) * w; o.x = pk_fp8x4(a[0], a[1], a[2], a[3]); o.y = pk_fp8x4(c[0], c[1], c[2], c[3]); }
                { const f32x4 a = (acc[ai][1][m][0] * WQ_INV + bv[1][0]) * w, c = (acc[ai][1][m][1] * WQ_INV + bv[1][1]) * w; o.z = pk_fp8x4(a[0], a[1], a[2], a[3]); o.w = pk_fp8x4(c[0], c[1], c[2], c[3]); }
                *(u32x4*)(ys + (srow0 + ai * HALF + m * 16) * 2048 + col0) = o; }
    }
};
struct EpiMemSoftmax {
    static constexpr bool PERM = true, AFTER_DRAIN = true; static constexpr int NSTORE = 0;
    bf16_t* P;
    __device__ __forceinline__ void operator()(const f32x4 (&)[2][2][4][2], const Unit&, int, int, int, int) const {}
    __device__ __forceinline__ void fused(f32x4 (&acc)[2][2][4][2], const Unit&, int wr, int wc, int fr, int fq, LAS unsigned char* lds, int, int) const {
        LAS f32x2* tab = (LAS f32x2*)lds;
        const float sc = 0.0625f * LOG2E;
        float mx[2][4];
#pragma unroll
        for (int ai = 0; ai < 2; ++ai)
#pragma unroll
            for (int m = 0; m < 4; ++m) { float a = -3.0e38f;
#pragma unroll
                for (int bj = 0; bj < 2; ++bj)
#pragma unroll
                    for (int n = 0; n < 2; ++n) { acc[ai][bj][m][n] *= sc; const f32x4 v = acc[ai][bj][m][n]; a = fmaxf(a, fmaxf(fmaxf(v[0], v[1]), fmaxf(v[2], v[3]))); }
                a = fmaxf(a, __shfl_xor(a, 16)); a = fmaxf(a, __shfl_xor(a, 32)); mx[ai][m] = a;
                float s = 0.f;
#pragma unroll
                for (int bj = 0; bj < 2; ++bj)
#pragma unroll
                    for (int n = 0; n < 2; ++n) { const f32x4 v = acc[ai][bj][m][n]; s += __builtin_amdgcn_exp2f(v[0] - a) + __builtin_amdgcn_exp2f(v[1] - a) + __builtin_amdgcn_exp2f(v[2] - a) + __builtin_amdgcn_exp2f(v[3] - a); }
                s += __shfl_xor(s, 16); s += __shfl_xor(s, 32);
                if (fq == 0) tab[(ai * HALF + wr * 64 + m * 16 + fr) * 4 + wc] = (f32x2){a, s};
            }
        __syncthreads();
#pragma unroll
        for (int ai = 0; ai < 2; ++ai)
#pragma unroll
            for (int m = 0; m < 4; ++m) { const int r = ai * HALF + wr * 64 + m * 16 + fr;
                const f32x2 t0 = tab[r * 4 + 0], t1 = tab[r * 4 + 1], t2 = tab[r * 4 + 2], t3 = tab[r * 4 + 3];
                const float M = fmaxf(fmaxf(t0.x, t1.x), fmaxf(t2.x, t3.x));
                const float L = t0.y * __builtin_amdgcn_exp2f(t0.x - M) + t1.y * __builtin_amdgcn_exp2f(t1.x - M) + t2.y * __builtin_amdgcn_exp2f(t2.x - M) + t3.y * __builtin_amdgcn_exp2f(t3.x - M);
                const float inv = 1.0f / L;
                bf16_t* rowp = P + (size_t)r * 1024 + wc * 32 + 8 * fq;
#pragma unroll
                for (int bj = 0; bj < 2; ++bj) { f32x4 v0 = acc[ai][bj][m][0], v1 = acc[ai][bj][m][1];
#pragma unroll
                    for (int j = 0; j < 4; ++j) { v0[j] = __builtin_amdgcn_exp2f(v0[j] - M) * inv; v1[j] = __builtin_amdgcn_exp2f(v1[j] - M) * inv; }
                    u32x4 w; w.x = cvtpk(v0[0], v0[1]); w.y = cvtpk(v0[2], v0[3]); w.z = cvtpk(v1[0], v1[1]); w.w = cvtpk(v1[2], v1[3]);
                    *(u32x4*)(rowp + bj * HALF) = w; } }
        __syncthreads();
    }
};
struct EpiTile {
    static constexpr bool PERM = true, AFTER_DRAIN = false; static constexpr int NSTORE = 0;
    bf16_t* dst; size_t ldc;
    __device__ __forceinline__ void operator()(const f32x4 (&acc)[2][2][4][2], const Unit&, int wr, int wc, int fr, int fq) const { store_tile_bf16(acc, dst, ldc, wr, wc, fr, fq); }
};
__device__ __forceinline__ void tr_item(const float* W, int K, int N, bf16_t* WT, LAS float* scr, int item, int lane) {
    const int nblk = N / 32, kb = item / nblk, nb = item % nblk, k0 = 64 * kb, n0 = 32 * nb;
#pragma unroll 8
    for (int i = 0; i < 32; ++i) { const int kk = 2 * i + (lane >> 5); scr[kk * 33 + (lane & 31)] = W[(size_t)(k0 + kk) * N + n0 + (lane & 31)]; }
    asm volatile("s_waitcnt lgkmcnt(0)" ::: "memory");
    const int c = lane & 7;
#pragma unroll
    for (int j = 0; j < 4; ++j) { const int n = (lane >> 3) + 8 * j; const LAS float* s = scr + (8 * c) * 33 + n;
        u32x4 o; o.x = cvtpk(s[0 * 33], s[1 * 33]); o.y = cvtpk(s[2 * 33], s[3 * 33]); o.z = cvtpk(s[4 * 33], s[5 * 33]); o.w = cvtpk(s[6 * 33], s[7 * 33]);
        *(u32x4*)(WT + (size_t)(n0 + n) * K + k0 + 8 * c) = o; }
    asm volatile("s_waitcnt lgkmcnt(0)" ::: "memory");
}
__device__ __forceinline__ void tr_item8(const float* W, int K, int N, unsigned char* WT, LAS float* scr, int item, int lane, float scale) {
    const int nblk = N / 32, kb = item / nblk, nb = item % nblk, k0 = 128 * kb, n0 = 32 * nb;
#pragma unroll 8
    for (int i = 0; i < 64; ++i) { const int kk = 2 * i + (lane >> 5); scr[kk * 33 + (lane & 31)] = W[(size_t)(k0 + kk) * N + n0 + (lane & 31)] * scale; }
    asm volatile("s_waitcnt lgkmcnt(0)" ::: "memory");
    const int c = lane & 7;
#pragma unroll
    for (int j = 0; j < 4; ++j) { const int n = (lane >> 3) + 8 * j; const LAS float* s = scr + (16 * c) * 33 + n;
        u32x4 o; o.x = pk_fp8x4(s[0 * 33], s[1 * 33], s[2 * 33], s[3 * 33]); o.y = pk_fp8x4(s[4 * 33], s[5 * 33], s[6 * 33], s[7 * 33]);
        o.z = pk_fp8x4(s[8 * 33], s[9 * 33], s[10 * 33], s[11 * 33]); o.w = pk_fp8x4(s[12 * 33], s[13 * 33], s[14 * 33], s[15 * 33]);
        *(u32x4*)(WT + (size_t)(n0 + n) * K + k0 + 16 * c) = o; }
    asm volatile("s_waitcnt lgkmcnt(0)" ::: "memory");
}
__device__ __forceinline__ void rms_row_to_bf16(const float* xrow, const float* g, bf16_t* orow, int lane, unsigned char* qrow = nullptr, float* irs = nullptr) {
    const f32x4* xr = (const f32x4*)xrow + lane; const f32x4* gr = (const f32x4*)g + lane;
    f32x4 v[8]; float s = 0.f;
#pragma unroll
    for (int j = 0; j < 8; ++j) { v[j] = xr[64 * j]; s += (v[j][0] * v[j][0] + v[j][1] * v[j][1]) + (v[j][2] * v[j][2] + v[j][3] * v[j][3]); }
    const float r = rsqrtf(wsum(s) * (1.0f / DM) + 1e-5f);
    if (irs && lane == 0) *irs = 1.0f / r;
    u32x2* o8 = (u32x2*)orow + lane;
#pragma unroll
    for (int j = 0; j < 8; ++j) { const f32x4 gg = gr[64 * j]; u32x2 w; w.x = cvtpk(v[j][0] * r * gg[0], v[j][1] * r * gg[1]); w.y = cvtpk(v[j][2] * r * gg[2], v[j][3] * r * gg[3]); o8[64 * j] = w;
        if (qrow) ((unsigned*)qrow)[lane + 64 * j] = pk_fp8x4(v[j][0] * r * gg[0], v[j][1] * r * gg[1], v[j][2] * r * gg[2], v[j][3] * r * gg[3]); }
}
__device__ __forceinline__ float rms_bfrow_to_bf16(const bf16_t* xrow, const float* g, bf16_t* orow, int lane, unsigned char* qrow) {
    const u32x2* xr = (const u32x2*)xrow + lane; const f32x4* gr = (const f32x4*)g + lane;
    f32x4 v[8]; float s = 0.f;
#pragma unroll
    for (int j = 0; j < 8; ++j) { const u32x2 w = xr[64 * j]; v[j] = (f32x4){bflo(w.x), bfhi(w.x), bflo(w.y), bfhi(w.y)}; s += (v[j][0] * v[j][0] + v[j][1] * v[j][1]) + (v[j][2] * v[j][2] + v[j][3] * v[j][3]); }
    const float r = rsqrtf(wsum(s) * (1.0f / DM) + 1e-5f);
    u32x2* o8 = (u32x2*)orow + lane;
#pragma unroll
    for (int j = 0; j < 8; ++j) { const f32x4 gg = gr[64 * j]; if (orow) { u32x2 w; w.x = cvtpk(v[j][0] * r * gg[0], v[j][1] * r * gg[1]); w.y = cvtpk(v[j][2] * r * gg[2], v[j][3] * r * gg[3]); o8[64 * j] = w; }
        if (qrow) ((unsigned*)qrow)[lane + 64 * j] = pk_fp8x4(v[j][0] * r * gg[0], v[j][1] * r * gg[1], v[j][2] * r * gg[2], v[j][3] * r * gg[3]); }
    return r;
}
constexpr int CV_I_IN = (DM / 128) * (INW / 256), CV_I_SQ = (2048 / 128) * (2048 / 256), CV_I_HF = (1024 / 128) * (2048 / 256);
constexpr int CV_I_GU = (2048 / 128) * (4096 / 256), CV_I_DN = CV_I_SQ;
constexpr long CV_NONEXP = (long)CV_I_IN + 3L * CV_I_SQ + 2L * CV_I_HF;
constexpr long CV_TOTAL = CV_NONEXP + (long)NE * CV_I_GU + (long)NE * CV_I_DN;
typedef short v2s_t __attribute__((ext_vector_type(2)));
__device__ __forceinline__ unsigned pk_fp8x4_scaled(float a, float b, float c, float d) {
    v2s_t r = {0, 0};
    r = __builtin_amdgcn_cvt_scalef32_pk_fp8_f32(r, a, b, WQ_INV, false);
    r = __builtin_amdgcn_cvt_scalef32_pk_fp8_f32(r, c, d, WQ_INV, true);
    return __builtin_bit_cast(unsigned, r);
}
constexpr int CV_PITCH = 260;
#ifndef CV_ASMLD
#define CV_ASMLD 0
#endif
__device__ __forceinline__ f32x4 cv_load(const float* q) {
#if CV_ASMLD
    f32x4 v; asm volatile("global_load_dwordx4 %0, %1, off sc0 sc1 nt" : "=v"(v) : "v"(q) : "memory"); return v;
#else
    return __builtin_nontemporal_load((const f32x4*)q);
#endif
}
__device__ __forceinline__ void convert_items(const Params& p, LAS unsigned char* lds, long it0, long it_end, int worker, int nworkers, int probe = 0, int* qhead = nullptr) {
    int tid_ = threadIdx.x; asm volatile("" : "+v"(tid_));
    const int tid = tid_, wave = __builtin_amdgcn_readfirstlane(tid >> 6), lane = tid & 63;
    unsigned char* ws = p.ws;
    LAS float* tile = (LAS float*)lds;
    constexpr int I_IN = CV_I_IN, I_SQ = CV_I_SQ, I_HF = CV_I_HF, I_GU = CV_I_GU, I_DN = CV_I_DN;
    static_assert(I_GU == 256 && I_DN == 128, "shift decode of the expert items");
    struct Item { const float* src; unsigned char* dst; int N, K, f8; };
    auto decode = [&](long it, Item& q) -> bool {
        if (it >= it_end) return false;
        long r = it; const float* W; unsigned char* D; int K, N, f8 = 0, kb, nb;
        if (r >= CV_NONEXP) {
            r -= CV_NONEXP; K = 2048; f8 = MOE_F8 ? 1 : 0;
            if (r < (long)NE * I_GU) { const int e = (int)(r >> 8), rr = (int)r & 255; kb = rr >> 4; nb = rr & 15; N = 4096;
                W = p.in[14] + (size_t)e * 2048 * 4096; D = ws + (MOE_F8 ? WS_WGUQ + (size_t)e * 4096 * 2048 : WS_WGUT + (size_t)e * 4096 * 2048 * 2); }
            else { r -= (long)NE * I_GU; const int e = (int)(r >> 7), rr = (int)r & 127; kb = rr >> 3; nb = rr & 7; N = 2048;
                W = p.in[16] + (size_t)e * 2048 * 2048; D = ws + (MOE_F8 ? WS_WDNQ + (size_t)e * 2048 * 2048 : WS_WDNT + (size_t)e * 2048 * 2048 * 2); }
        } else {
            if (r < I_IN) { W = p.in[4]; D = ws + WS_WINT; K = LDP; N = INW;
                if (GATES_F8 && 256 * ((int)r % (INW / 256)) >= 4608) { f8 = 2; D = ws + WS_WINQ; K = 2048; } }
            else if ((r -= I_IN) < I_SQ) { W = p.in[6]; D = ws + WS_WMKVT; K = LDP; N = 2048; }
            else if ((r -= I_SQ) < I_HF) { W = p.in[7]; D = ws + WS_WFM; K = 2048; N = 2048; }
            else if ((r -= I_HF) < I_SQ) { W = p.in[8]; D = ws + WS_WAOT; K = 2048; N = 2048; }
            else if ((r -= I_SQ) < I_HF) { W = p.in[9]; D = ws + WS_WFM + 1024 * 2; K = 2048; N = 2048; }
            else { r -= I_HF; W = p.in[10]; D = ws + WS_WOT; K = 2048; N = 2048; }
            const int nblk = N / 256; kb = (int)r / nblk; nb = (int)r % nblk;
        }
        q.src = W + (size_t)(128 * kb + wave) * N + 256 * nb + 4 * lane;
        q.dst = D + ((size_t)(256 * nb - (f8 == 2 ? 4608 : 0)) * K + 128 * kb) * (f8 ? 1 : 2);
        q.N = N; q.K = K; q.f8 = f8;
        if (probe) { q.src = p.in[14] + (size_t)wave * 4096 + 4 * lane; q.dst = ws + ((WS_FAST_END + 4095) & ~(size_t)4095) + (size_t)blockIdx.x * (256 * 2048); q.N = 4096; q.K = 2048; q.f8 = 1; }
        return true;
    };
    f32x4 v[16];
    LAS int* qslot = (LAS int*)(lds + LDS_MISC + 768);
    long it = it0 + worker, itn = it + nworkers;
    if (qhead) {
        if (tid == 0) { qslot[0] = __hip_atomic_fetch_add(qhead, 1, __ATOMIC_RELAXED, __HIP_MEMORY_SCOPE_AGENT); qslot[1] = __hip_atomic_fetch_add(qhead, 1, __ATOMIC_RELAXED, __HIP_MEMORY_SCOPE_AGENT); }
        __syncthreads();
        it = it0 + __builtin_amdgcn_readfirstlane(qslot[0]); itn = it0 + __builtin_amdgcn_readfirstlane(qslot[1]);
        __syncthreads();
    }
    Item cur; bool have = decode(it, cur);
    if (have) {
#pragma unroll
        for (int i = 0; i < 16; ++i) v[i] = cv_load(cur.src + (size_t)(8 * i) * cur.N);
    }
    int pst = 0;
    const int cch = lane & 7, nq = (lane >> 3) + 8 * wave;
    while (have) {
        Item nxt; const bool hn = decode(itn, nxt);
        __syncthreads();
#if CV_ASMLD
        if (pst == 4) asm volatile("s_waitcnt vmcnt(4)" ::: "memory"); else if (pst == 8) asm volatile("s_waitcnt vmcnt(8)" ::: "memory"); else asm volatile("s_waitcnt vmcnt(0)" ::: "memory");
#pragma unroll
        for (int i = 0; i < 16; ++i) asm volatile("" : "+v"(v[i]));
#endif
#pragma unroll
        for (int i = 0; i < 16; ++i) *(LAS f32x4*)(tile + (8 * i + wave) * CV_PITCH + 4 * lane + 16 * (i >> 1)) = v[i];
        if (qhead && hn && tid == 0) qslot[0] = __hip_atomic_fetch_add(qhead, 1, __ATOMIC_RELAXED, __HIP_MEMORY_SCOPE_AGENT);
        if (hn) {
#pragma unroll
            for (int i = 0; i < 16; ++i) v[i] = cv_load(nxt.src + (size_t)(8 * i) * nxt.N);
        }
        __syncthreads();
        const long itnn = qhead ? (hn ? it0 + __builtin_amdgcn_readfirstlane(qslot[0]) : it_end) : itn + nworkers;
        f32x4 t[16];
        const LAS float* s = tile + (16 * cch) * CV_PITCH + 16 * cch + 4 * nq;
#pragma unroll
        for (int i = 0; i < 16; ++i) t[i] = *(const LAS f32x4*)(s + i * CV_PITCH);
#pragma unroll
        for (int j = 0; j < 4; ++j) { const int n = 4 * nq + j;
            if (cur.f8) { u32x4 o; o.x = pk_fp8x4_scaled(t[0][j], t[1][j], t[2][j], t[3][j]); o.y = pk_fp8x4_scaled(t[4][j], t[5][j], t[6][j], t[7][j]);
                o.z = pk_fp8x4_scaled(t[8][j], t[9][j], t[10][j], t[11][j]); o.w = pk_fp8x4_scaled(t[12][j], t[13][j], t[14][j], t[15][j]);
                *(u32x4*)(cur.dst + (size_t)n * cur.K + 16 * cch) = o; }
            else { u32x4 o0, o1; o0.x = cvtpk(t[0][j], t[1][j]); o0.y = cvtpk(t[2][j], t[3][j]); o0.z = cvtpk(t[4][j], t[5][j]); o0.w = cvtpk(t[6][j], t[7][j]);
                o1.x = cvtpk(t[8][j], t[9][j]); o1.y = cvtpk(t[10][j], t[11][j]); o1.z = cvtpk(t[12][j], t[13][j]); o1.w = cvtpk(t[14][j], t[15][j]);
                u32x4* d = (u32x4*)(cur.dst + ((size_t)n * cur.K + 16 * cch) * 2); d[0] = o0; d[1] = o1; } }
        pst = cur.f8 ? 4 : 8;
        cur = nxt; have = hn; it = itn; itn = itnn;
    }
    __syncthreads();
}

constexpr long CE_TOTAL = (long)NE * 384;
constexpr int CE_PITCH = 1028;
__device__ __forceinline__ void convert_experts(const Params& p, LAS unsigned char* lds, long t0, long t1) {
    int tid_ = threadIdx.x; asm volatile("" : "+v"(tid_));
    const int tid = tid_, wave = tid >> 6, lane = tid & 63;
    LAS float* tile = (LAS float*)lds;
    struct Item { const float* src; unsigned char* dst; int N; };
    auto decode = [&](long t, Item& q) -> bool {
        if (t >= t1) return false;
        const int e = (int)(t / 384), r = (int)(t % 384);
        if (r < 256) { const int nr = r >> 6, kb = r & 63; q.N = 4096;
            q.src = p.in[14] + (size_t)e * 2048 * 4096 + (size_t)(32 * kb + 4 * wave) * 4096 + nr * 1024 + 4 * lane;
            q.dst = p.ws + WS_WGUQ + ((size_t)e * 4096 + (size_t)nr * 1024) * 2048 + 32 * kb; }
        else { const int nr = (r - 256) >> 6, kb = (r - 256) & 63; q.N = 2048;
            q.src = p.in[16] + (size_t)e * 2048 * 2048 + (size_t)(32 * kb + 4 * wave) * 2048 + nr * 1024 + 4 * lane;
            q.dst = p.ws + WS_WDNQ + ((size_t)e * 2048 + (size_t)nr * 1024) * 2048 + 32 * kb; }
        return true;
    };
    f32x4 v[16];
    Item cur; long t = t0; bool have = decode(t, cur);
    if (have) {
#pragma unroll
        for (int i = 0; i < 16; ++i) v[i] = __builtin_nontemporal_load((const f32x4*)(cur.src + (size_t)(i >> 2) * cur.N + 256 * (i & 3)));
    }
    while (have) {
        Item nxt; const bool hn = decode(t + 1, nxt);
        __syncthreads();
#pragma unroll
        for (int i = 0; i < 16; ++i) *(LAS f32x4*)(tile + (4 * wave + (i >> 2)) * CE_PITCH + 256 * (i & 3) + 4 * lane) = v[i];
        if (hn) {
#pragma unroll
            for (int i = 0; i < 16; ++i) v[i] = __builtin_nontemporal_load((const f32x4*)(nxt.src + (size_t)(i >> 2) * nxt.N + 256 * (i & 3)));
        }
        __syncthreads();
#pragma unroll
        for (int j = 0; j < 2; ++j) { const int n = tid + 512 * j; const LAS float* s = tile + n;
            float f[32];
#pragma unroll
            for (int i = 0; i < 32; ++i) f[i] = s[i * CE_PITCH] * WQ_SCALE;
            u32x4 o0, o1;
            o0.x = pk_fp8x4(f[0], f[1], f[2], f[3]); o0.y = pk_fp8x4(f[4], f[5], f[6], f[7]); o0.z = pk_fp8x4(f[8], f[9], f[10], f[11]); o0.w = pk_fp8x4(f[12], f[13], f[14], f[15]);
            o1.x = pk_fp8x4(f[16], f[17], f[18], f[19]); o1.y = pk_fp8x4(f[20], f[21], f[22], f[23]); o1.z = pk_fp8x4(f[24], f[25], f[26], f[27]); o1.w = pk_fp8x4(f[28], f[29], f[30], f[31]);
            u32x4* d = (u32x4*)(cur.dst + (size_t)n * 2048); d[0] = o0; d[1] = o1; }
        cur = nxt; have = hn; ++t;
    }
    __syncthreads();
}

__device__ __forceinline__ void phase_prologue(const Params& p, LAS unsigned char* lds) {
    int tid_ = threadIdx.x; asm volatile("" : "+v"(tid_));
    const int tid = tid_, wave = tid >> 6, lane = tid & 63;
    unsigned char* ws = p.ws;
    const int gw = vwg() * NWAVE + wave, NGW = (int)gridDim.x * NWAVE;
    for (int m = gw; m < T_; m += NGW) rms_row_to_bf16(p.in[0] + (size_t)m * DM, p.in[3], (bf16_t*)(ws + WS_H) + (size_t)m * LDP, lane, GATES_F8 ? (ws + WS_H8 + (size_t)m * DM) : nullptr, RES_FROM_H ? (float*)(ws + WS_IRSTD) + m : nullptr);
    for (int m = gw; m < B_ * MEM; m += NGW) {
        const f32x4* xr = (const f32x4*)(p.in[1] + (size_t)m * DM) + lane; u32x2* o8 = (u32x2*)((bf16_t*)(ws + WS_MEMBF) + (size_t)m * LDP) + lane;
#pragma unroll
        for (int j = 0; j < 8; ++j) { const f32x4 v = xr[64 * j]; u32x2 w; w.x = cvtpk(v[0], v[1]); w.y = cvtpk(v[2], v[3]); o8[64 * j] = w; }
    }
    {
        const int gt = vwg() * NTHR + tid, NGT = (int)gridDim.x * NTHR;
        bf16_t* tabT = (bf16_t*)(ws + WS_TABT); bf16_t* dm = (bf16_t*)(ws + WS_DMAT);
        for (int i = gt; i < 512 * 256 / 2; i += NGT) { const int e0 = 2 * i; const int mrow = e0 >> 8, c = e0 & 255; const int n = mrow & 255; float v[2];
#pragma unroll
            for (int j = 0; j < 2; ++j) { const int mm = ((c + j) * n) & 255; const float a = (float)mm * (2.0f / 256.0f); v[j] = (mrow < 256) ? cospif(a) : sinpif(a); }
            *(unsigned*)(tabT + e0) = cvtpk(v[0], v[1]); }
        const float sc = 1.0f / sqrtf(2048.0f * 256.0f);
        LAS float* ct = (LAS float*)lds;
        for (int m = tid; m < 2048; m += NTHR) ct[m] = cospif((float)m * (2.0f / 2048.0f)) * sc;
        __syncthreads();
        for (int i = gt; i < 2048 * SQK / 2; i += NGT) { const int e0 = 2 * i; const int jr = e0 / SQK, k = e0 % SQK; float v[2];
#pragma unroll
            for (int j = 0; j < 2; ++j) {
                if constexpr (SEQFOLD) { const int kj = k + j; if (kj <= 1024) v[j] = ct[(jr * kj) & 2047]; else v[j] = ct[(((jr * (kj - 1024)) & 2047) + 512) & 2047]; }
                else { const int kk = (k + j) & 2047; const int mm = (jr * kk) & 2047; v[j] = (k < 2048) ? ct[mm] : ct[(mm + 512) & 2047]; } }
            *(unsigned*)(dm + (size_t)jr * SQP + k) = cvtpk(v[0], v[1]); }
        __syncthreads();
        bf16_t* wrt = (bf16_t*)(ws + WS_WRT);
        for (int i = gt; i < NE * DM; i += NGT) { const int e = i >> 11, k = i & 2047; wrt[i] = (bf16_t)(cvtpk(p.in[12][(size_t)k * NE + e] * (ROUTER_ON_X2 ? p.in[11][k] : 1.0f), 0.f) & 0xffffu); }
    }
    __syncthreads();
    convert_items(p, lds, 0, (gridDim.x == 256) ? CV_NONEXP : CV_TOTAL, vwg(), (int)gridDim.x);
}

constexpr int AT_KROW = 144, AT_VROW = 776;
constexpr int AT_K = 0, AT_V = 384 * AT_KROW, AT_LUT = AT_V + 64 * AT_VROW;
static_assert(AT_LUT + NWAVE * 320 * 4 <= STAGE_BYTES, "attention LDS");
__device__ __forceinline__ void attn_unit(const Params& p, LAS unsigned char* lds, int b, int kvh, int qb) {
    int tid_ = threadIdx.x; asm volatile("" : "+v"(tid_));
    const int tid = tid_, wid = __builtin_amdgcn_readfirstlane(tid >> 6), lane = tid & 63, r = lane & 31, h = lane >> 5;
    const unsigned char* ws = p.ws;
    const bf16_t* Q = (const bf16_t*)(ws + WS_Q); const bf16_t* Kg = (const bf16_t*)(ws + WS_K); const bf16_t* VT = (const bf16_t*)(ws + WS_VT);
    bf16_t* att = (bf16_t*)(p.ws + WS_ATT);
    const int q0 = qb * 128, hq = kvh * 8 + wid;
    LAS unsigned char* Kb = lds + AT_K; LAS unsigned char* Vt = lds + AT_V; LAS float* lut = (LAS float*)(lds + AT_LUT) + wid * 320;
    __syncthreads();
    for (int c = tid; c < 384 * 8; c += NTHR) { const int row = c >> 3, part = c & 7, pos = q0 - 128 + row;
        u32x4 v = {0u, 0u, 0u, 0u};
        if (pos >= 0 && pos < S_) v = *(const u32x4*)(Kg + (size_t)(b * S_ + pos) * 256 + kvh * 64 + part * 8);
        *(LAS u32x4*)(Kb + row * AT_KROW + part * 16) = v; }
    for (int c = tid; c < 64 * 48; c += NTHR) { const int d = c / 48, ch = c % 48, pos0 = q0 - 128 + ch * 8;
        u32x4 v = {0u, 0u, 0u, 0u};
        if (pos0 >= 0 && pos0 < S_) v = *(const u32x4*)(VT + ((size_t)((b * 4 + kvh) * 64 + d)) * 2048 + pos0);
        *(LAS u32x2*)(Vt + d * AT_VROW + ch * 16) = (u32x2){v.x, v.y}; *(LAS u32x2*)(Vt + d * AT_VROW + ch * 16 + 8) = (u32x2){v.z, v.w}; }
    for (int i = lane; i < 320; i += 64) { const int rel = i - 160; const int ar = rel < 0 ? -rel : rel;
        lut[i] = (ar <= WIN) ? p.in[2][t5_bucket(rel) * NH + hq] * LOG2E : -1.0e30f; }
    __syncthreads();
    const float sk = p.in[5][hq] * LOG2E;
    const float SC = 0.125f * LOG2E;
#pragma unroll 1
    for (int sb = 0; sb < 4; ++sb) {
        const int pq = q0 + sb * 32;
        bf16x8 qf[4];
        const bf16_t* qrow = Q + (size_t)(b * S_ + pq + r) * 2048 + hq * 64 + 8 * h;
#pragma unroll
        for (int s = 0; s < 4; ++s) qf[s] = *(const bf16x8*)(qrow + 16 * s);
        float mrun = sk, lrun = 1.0f;
        f32x16 o0, o1;
#pragma unroll
        for (int i = 0; i < 16; ++i) { o0[i] = 0.f; o1[i] = 0.f; }
        const int jlo = (qb == 0) ? 4 - sb : 0, jhi = (qb == 15) ? 8 - sb : 9;
        const LAS unsigned char* kp = Kb + (32 * (sb + jlo) + r) * AT_KROW + 16 * h;
        const LAS unsigned char* vp = Vt + r * AT_VROW + (32 * (sb + jlo) + 4 * h) * 2;
        const LAS unsigned char* vq = vp + 32 * AT_VROW;
        const LAS float* lp = lut + 32 * jlo + 32 + 4 * h - r;
#pragma unroll 1
        for (int j = jlo; j < jhi; ++j) {
            asm volatile("" : "+v"(kp), "+v"(vp), "+v"(vq), "+v"(lp));
            f32x16 s;
#pragma unroll
            for (int i = 0; i < 16; ++i) s[i] = 0.f;
#pragma unroll
            for (int ks = 0; ks < 4; ++ks) { const bf16x8 kf = *(const LAS bf16x8*)(kp + 32 * ks); s = __builtin_amdgcn_mfma_f32_32x32x16_bf16(kf, qf[ks], s, 0, 0, 0); }
            float mx = -3.0e38f;
            f32x2 sp[8];
#pragma unroll
            for (int i = 0; i < 8; ++i) { const int li = ((2 * i) & 3) + 8 * ((2 * i) >> 2); const f32x2 lv = {lp[li], lp[li + 1]}; const f32x2 sv = {s[2 * i], s[2 * i + 1]};
                sp[i] = sv * (f32x2){SC, SC} + lv; mx = fmaxf(fmaxf(mx, sp[i][0]), sp[i][1]); }
            mx = fmaxf(mx, __shfl_xor(mx, 32));
            const float mnew = fmaxf(mrun, mx);
            const float alpha = __builtin_amdgcn_exp2f(mrun - mnew);
            f32x2 rs2 = {0.f, 0.f};
#pragma unroll
            for (int i = 0; i < 8; ++i) { const f32x2 d = sp[i] - (f32x2){mnew, mnew}; const f32x2 e = {__builtin_amdgcn_exp2f(d[0]), __builtin_amdgcn_exp2f(d[1])};
                s[2 * i] = e[0]; s[2 * i + 1] = e[1]; rs2 += e; }
            float rs = rs2[0] + rs2[1];
            rs += __shfl_xor(rs, 32);
            lrun = lrun * alpha + rs; mrun = mnew;
            if (__any(alpha != 1.0f)) {
#pragma unroll
                for (int i = 0; i < 16; ++i) { o0[i] *= alpha; o1[i] *= alpha; }
            }
#pragma unroll
            for (int k2 = 0; k2 < 2; ++k2) {
                u32x4 pw; pw.x = cvtpk(s[8 * k2 + 0], s[8 * k2 + 1]); pw.y = cvtpk(s[8 * k2 + 2], s[8 * k2 + 3]); pw.z = cvtpk(s[8 * k2 + 4], s[8 * k2 + 5]); pw.w = cvtpk(s[8 * k2 + 6], s[8 * k2 + 7]);
                const bf16x8 pb = __builtin_bit_cast(bf16x8, pw);
                { const u32x2 lo = *(const LAS u32x2*)(vp + 32 * k2), hi = *(const LAS u32x2*)(vp + 32 * k2 + 16); const u32x4 vw = {lo.x, lo.y, hi.x, hi.y};
                  o0 = __builtin_amdgcn_mfma_f32_32x32x16_bf16(__builtin_bit_cast(bf16x8, vw), pb, o0, 0, 0, 0); }
                { const u32x2 lo = *(const LAS u32x2*)(vq + 32 * k2), hi = *(const LAS u32x2*)(vq + 32 * k2 + 16); const u32x4 vw = {lo.x, lo.y, hi.x, hi.y};
                  o1 = __builtin_amdgcn_mfma_f32_32x32x16_bf16(__builtin_bit_cast(bf16x8, vw), pb, o1, 0, 0, 0); }
            }
            kp += 32 * AT_KROW; vp += 64; vq += 64; lp += 32;
        }
        const float inv = 1.0f / lrun;
        bf16_t* orow = att + (size_t)(b * S_ + pq + r) * 2048 + hq * 64 + 4 * h;
#pragma unroll
        for (int g = 0; g < 4; ++g) {
            u32x2 w0; w0.x = cvtpk(o0[4 * g] * inv, o0[4 * g + 1] * inv); w0.y = cvtpk(o0[4 * g + 2] * inv, o0[4 * g + 3] * inv); *(u32x2*)(orow + 8 * g) = w0;
            u32x2 w1; w1.x = cvtpk(o1[4 * g] * inv, o1[4 * g + 1] * inv); w1.y = cvtpk(o1[4 * g + 2] * inv, o1[4 * g + 3] * inv); *(u32x2*)(orow + 32 + 8 * g) = w1;
        }
    }
}

__device__ __forceinline__ void phase_rows(const Params& p, LAS unsigned char* lds) {
    int tid_ = threadIdx.x; asm volatile("" : "+v"(tid_));
    const int tid = tid_, wave = __builtin_amdgcn_readfirstlane(tid >> 6), lane = tid & 63;
    unsigned char* ws = p.ws;
    const bf16_t* x2 = (const bf16_t*)(ws + WS_X2); bf16_t* h2 = (bf16_t*)(ws + WS_H2);
    LAS float* lg = (LAS float*)lds;
    LAS int* sel_e = (LAS int*)(lds + 8192);
    LAS float* sel_w = (LAS float*)(lds + 9216);
    LAS int* sel_r = (LAS int*)(lds + 10240);
    LAS int* lcnt = (LAS int*)(lds + 11264);
    LAS int* lbase = (LAS int*)(lds + 11392);
    LAS float* rtok = (LAS float*)(lds + 11520);
#pragma unroll 1
    for (int t0 = vwg() * 64; t0 < T_; t0 += 64 * (int)gridDim.x) {
        __syncthreads();
        if (tid < 32) lcnt[tid] = 0;
        for (int i = 0; i < 8; ++i) { const int t = t0 + wave * 8 + i;
            const float r = rms_bfrow_to_bf16(x2 + (size_t)t * DM, p.in[11], (ROUTER_ON_X2 && MOE_F8) ? nullptr : h2 + (size_t)t * DM, lane, MOE_F8 ? (ws + WS_H2Q + (size_t)t * DM) : nullptr);
            if (lane == 0) rtok[wave * 8 + i] = r; }
        asm volatile("s_waitcnt vmcnt(0)" ::: "memory");
        __syncthreads();
        if (wave < 4) {
            const bf16_t* arow = ((ROUTER_ON_X2 && MOE_F8) ? x2 : (const bf16_t*)h2) + (size_t)(t0 + wave * 16 + (lane & 15)) * DM + 8 * (lane >> 4);
            const bf16_t* b0 = (const bf16_t*)(ws + WS_WRT) + (size_t)(lane & 15) * DM + 8 * (lane >> 4);
            const bf16_t* b1 = b0 + (size_t)16 * DM;
            f32x4 a0 = {0.f, 0.f, 0.f, 0.f}, a1 = {0.f, 0.f, 0.f, 0.f};
#pragma unroll 8
            for (int s = 0; s < 64; ++s) { const bf16x8 av = *(const bf16x8*)(arow + 32 * s), bv0 = *(const bf16x8*)(b0 + 32 * s), bv1 = *(const bf16x8*)(b1 + 32 * s);
                a0 = __builtin_amdgcn_mfma_f32_16x16x32_bf16(av, bv0, a0, 0, 0, 0); a1 = __builtin_amdgcn_mfma_f32_16x16x32_bf16(av, bv1, a1, 0, 0, 0); }
            const int ecol = lane & 15; const float bb0 = p.in[13][ecol], bb1 = p.in[13][ecol + 16];
#pragma unroll
            for (int rg = 0; rg < 4; ++rg) { const int tl = wave * 16 + (lane >> 4) * 4 + rg; const float rs = (ROUTER_ON_X2 && MOE_F8) ? rtok[tl] : 1.0f; lg[tl * 32 + ecol] = a0[rg] * rs + bb0; lg[tl * 32 + ecol + 16] = a1[rg] * rs + bb1; }
        }
        __syncthreads();
        if (tid < 64) {
            float v[32];
#pragma unroll
            for (int e = 0; e < 32; ++e) v[e] = lg[tid * 32 + e];
            float tv[4]; int ti[4];
#pragma unroll
            for (int k = 0; k < 4; ++k) { float bv = -3.0e38f; int bi = 0;
#pragma unroll
                for (int e = 0; e < 32; ++e) { const bool tk = v[e] > bv; bv = tk ? v[e] : bv; bi = tk ? e : bi; }
                tv[k] = bv; ti[k] = bi;
#pragma unroll
                for (int e = 0; e < 32; ++e) v[e] = (e == bi) ? -3.0e38f : v[e]; }
            const float e1 = __expf(tv[1] - tv[0]), e2 = __expf(tv[2] - tv[0]), e3 = __expf(tv[3] - tv[0]);
            const float inv = 1.0f / (1.0f + e1 + e2 + e3);
            const float wv[4] = {inv, e1 * inv, e2 * inv, e3 * inv};
#pragma unroll
            for (int k = 0; k < 4; ++k) { sel_e[tid * 4 + k] = ti[k]; sel_w[tid * 4 + k] = wv[k]; sel_r[tid * 4 + k] = __hip_atomic_fetch_add(&lcnt[ti[k]], 1, __ATOMIC_RELAXED, __HIP_MEMORY_SCOPE_WORKGROUP); }
        }
        __syncthreads();
        if (tid < 32) lbase[tid] = (lcnt[tid] > 0) ? atomicAdd((int*)(ws + WS_CTL) + CW_CNT + tid, lcnt[tid]) : 0;
        __syncthreads();
        if (tid < 256) { const int tl = tid >> 2, k = tid & 3, t = t0 + tl; const int e = sel_e[tid], pos = lbase[e] + sel_r[tid]; const float w = sel_w[tid];
            ((int*)(ws + WS_TOKE))[t * 4 + k] = e; ((int*)(ws + WS_TOKPOS))[t * 4 + k] = pos; ((float*)(ws + WS_TOKW))[t * 4 + k] = w;
            ((int*)(ws + WS_LIST))[(size_t)e * T_ + pos] = t; ((float*)(ws + WS_WLIST))[(size_t)e * T_ + pos] = w; }
    }
}
__device__ __forceinline__ void moe_tables(const Params& p, LAS int* pt, LAS int* cn) {
    __syncthreads();
    if (threadIdx.x < 64) {
        const int ln = (int)threadIdx.x; const int* cnt = (const int*)(p.ws + WS_CTL) + CW_CNT;
        const int c = (ln < NE) ? __hip_atomic_load(cnt + (ln & 31), __ATOMIC_RELAXED, __HIP_MEMORY_SCOPE_AGENT) : 0;
        const int tl = (c + 255) >> 8; int inc = tl;
#pragma unroll
        for (int o = 1; o < 32; o <<= 1) { const int v = __shfl_up(inc, o); if (ln >= o) inc += v; }
        if (ln < NE) { cn[ln] = c; pt[ln] = inc - tl; }
        if (ln == NE - 1) pt[NE] = inc;
    }
    __syncthreads();
}
__device__ __forceinline__ void phase_final(const Params& p, const LAS int* pt) {
    int tid_ = threadIdx.x; asm volatile("" : "+v"(tid_));
    const int tid = tid_, wave = tid >> 6, lane = tid & 63;
    const unsigned char* ws = p.ws;
    const bf16_t* x2 = (const bf16_t*)(ws + WS_X2); const bf16_t* ys = (const bf16_t*)(ws + WS_YS);
    const int* toke = (const int*)(ws + WS_TOKE); const int* tokpos = (const int*)(ws + WS_TOKPOS);
    const int gw = vwg() * NWAVE + wave, NGW = (int)gridDim.x * NWAVE;
    float pscale = 1.0f;
    if (PROFSEL != 0) {
        const unsigned long long* pf = (const unsigned long long*)(p.ws + WS_CTL + 32768);
        const float kl = (float)pf[0], ep = (float)pf[1], n = (float)pf[2], ntl = (float)pf[3], cyc = (float)pf[4], wal = (float)pf[5];
        float m = 0.f;
        if (PROFMETRIC == 0) m = ep / (kl + ep);
        if (PROFMETRIC == 1) m = kl / (n * ntl) / 4096.0f;
        if (PROFMETRIC == 2) m = cyc / (wal * 24.0f);
        if (PROFMETRIC == 3) m = (kl + ep) / cyc;
        if (PROFMETRIC == 4) m = n / 32.0f;
        if (PROFMETRIC == 5) m = wal / 100.0f / 200.0f;
        if (PROFMETRIC == 6 || PROFMETRIC == 7) {
            const unsigned long long* st = (const unsigned long long*)(p.ws + WS_CTL + 40960);
            unsigned long long mx = 0, mn = ~0ull, sum = 0;
            for (int i = 0; i < (int)gridDim.x; ++i) { const unsigned long long v = st[i]; mx = v > mx ? v : mx; mn = v < mn ? v : mn; sum += v; }
            const float mean = (float)(sum - mn * gridDim.x) / (float)gridDim.x;
            m = (PROFMETRIC == 6 ? ((float)(mx - mn) - mean) : (float)(mx - mn)) / 100.0f / 200.0f; }
        if (blockIdx.x == 0 && threadIdx.x == 0) { const unsigned long long t0 = wall_clock64(), ticks = (unsigned long long)(m * (float)PROFMUL * 100.0f * 100.0f);
            while (wall_clock64() - t0 < ticks) __builtin_amdgcn_s_sleep(8); }
    }
    for (int t = gw; t < T_; t += NGW) {
        const u32x2* xr = (const u32x2*)(x2 + (size_t)t * DM) + lane;
        f32x4 v[8];
#pragma unroll
        for (int j = 0; j < 8; ++j) { const u32x2 w = xr[64 * j]; v[j] = (f32x4){bflo(w.x), bfhi(w.x), bflo(w.y), bfhi(w.y)}; }
#pragma unroll
        for (int k = 0; k < 4; ++k) { const int e = toke[t * 4 + k]; const size_t slot = (size_t)pt[e] * 256 + tokpos[t * 4 + k];
            if constexpr (MOE_F8) {
                const unsigned* yr = (const unsigned*)((const unsigned char*)ys + slot * DM) + lane;
#pragma unroll
                for (int j = 0; j < 8; ++j) { const unsigned w = yr[64 * j];
                    v[j][0] += __builtin_amdgcn_cvt_f32_fp8((int)w, 0) * YS_INV; v[j][1] += __builtin_amdgcn_cvt_f32_fp8((int)w, 1) * YS_INV;
                    v[j][2] += __builtin_amdgcn_cvt_f32_fp8((int)w, 2) * YS_INV; v[j][3] += __builtin_amdgcn_cvt_f32_fp8((int)w, 3) * YS_INV; }
            } else {
                const u32x2* yr = (const u32x2*)(ys + slot * DM) + lane;
#pragma unroll
                for (int j = 0; j < 8; ++j) { const u32x2 w = yr[64 * j]; v[j][0] += bflo(w.x); v[j][1] += bfhi(w.x); v[j][2] += bflo(w.y); v[j][3] += bfhi(w.y); }
            } }
        float s = 0.f;
#pragma unroll
        for (int j = 0; j < 8; ++j) s += (v[j][0] * v[j][0] + v[j][1] * v[j][1]) + (v[j][2] * v[j][2] + v[j][3] * v[j][3]);
        const float r = rsqrtf(wsum(s) * (1.0f / DM) + 1e-5f);
        const f32x4* gr = (const f32x4*)p.in[18] + lane; f32x4* orow = (f32x4*)(p.out + (size_t)t * DM) + lane;
#pragma unroll
        for (int j = 0; j < 8; ++j) { const f32x4 gg = gr[64 * j]; orow[64 * j] = (f32x4){v[j][0] * r * gg[0] * pscale, v[j][1] * r * gg[1] * pscale, v[j][2] * r * gg[2] * pscale, v[j][3] * r * gg[3] * pscale}; }
    }
}
#ifndef P1_SLOT_BAL
#define P1_SLOT_BAL 1
#endif
#ifndef CV_SPLIT
#define CV_SPLIT 6144L
#endif
#ifndef MOE_SLOT
#define MOE_SLOT 1
#endif
#ifndef X2_SLOT
#define X2_SLOT 0
#endif
#ifndef MOE_SLOT_STEP
#define MOE_SLOT_STEP 4
#endif
#ifndef MOE_SLOT_BAL
#define MOE_SLOT_BAL 4
#endif
#ifndef POOL1
#define POOL1 2
#endif
#ifndef P2ROLE
#define P2ROLE 0
#endif
#ifndef POOL2
#define POOL2 0
#endif
#ifndef POOL3
#define POOL3 0
#endif
#ifndef POOL4
#define POOL4 0
#endif
#ifndef POOL5
#define POOL5 0
#endif
#ifndef Q4
#define Q4 8
#endif
constexpr long GU_A0 = 30 - (POOL1 + POOL2 + POOL3 + POOL4 + POOL5 + Q4);
constexpr long GU_P1S = 64 * (4 * GU_A0 + 8), GU_P1P = GU_P1S, GU_P2P = GU_P1P + 256 * POOL1, GU_P3P = GU_P2P + 256 * POOL2, GU_P4S = GU_P3P + 256 * POOL3,
               GU_P4P = GU_P4S + 256 * Q4, GU_P5P = GU_P4P + 256 * POOL4, GU_END = GU_P5P + 256 * POOL5;
static_assert(GU_END == 8192 && GU_A0 > 0, "gate_up conversion layout");
#ifndef POOL7
#define POOL7 2
#endif
__device__ __forceinline__ void proj_convert_slot(const Params& p, LAS unsigned char* lds, int g, int part) {
    const int wgi = (int)blockIdx.x & 63;
    __syncthreads();
    if constexpr (MOE_F8 && CONV_TILE32) { const long per = CE_TOTAL / 512, a = ((long)(part * 4 + g) * 64 + wgi) * per; convert_experts(p, lds, a, a + per); }
    else { const long total = CV_TOTAL - CV_NONEXP, half = total / 2; long q = half / 4, it0 = CV_NONEXP + half * part + q * g;
        if (P1_SLOT_BAL) {
            constexpr long P1END = (MOE_SLOT ? 8192 : 12288) - 256 * X2_SLOT;
            static_assert((CV_TOTAL - CV_NONEXP) == 12288 && MOE_SLOT == 1 && X2_SLOT == 0, "slot split");
            if (part == 0) { it0 = CV_NONEXP + 64 * GU_A0 * g; q = 64 * (g == 3 ? GU_A0 + 8 : GU_A0); }
            else if (part == 1) { it0 = CV_NONEXP + GU_P4S + 64 * Q4 * g; q = 64 * Q4; }
            else if (part == 2) { it0 = CV_NONEXP + 8192 + 1024 * g; q = 1024; }
            else { it0 = CV_NONEXP + P1END + 64 * X2_SLOT * g; q = 64 * X2_SLOT; } }
        convert_items(p, lds, it0, it0 + q, wgi, 64);
#ifdef DBLCONV
        if (part == (DBLCONV & 3) - 1) { __syncthreads(); convert_items(p, lds, it0, it0 + q, wgi, 64, DBLCONV >> 2); }
#endif
    }
    asm volatile("s_waitcnt vmcnt(0) lgkmcnt(0)" ::: "memory");
    __syncthreads();
}
__device__ __forceinline__ void pool_drain(const Params& p, LAS unsigned char* lds, int pool, long base, int count) {
    __syncthreads();
    convert_items(p, lds, base, base + count, 0, 1, 0, (int*)(p.ws + WS_CTL) + CW_POOL + 64 * pool);
    asm volatile("s_waitcnt vmcnt(0) lgkmcnt(0)" ::: "memory");
    __syncthreads();
}
__device__ __forceinline__ void convert_range_slot(const Params& p, LAS unsigned char* lds, long it0, long n) {
    __syncthreads();
    convert_items(p, lds, it0, it0 + n, 0, 1);
    asm volatile("s_waitcnt vmcnt(0) lgkmcnt(0)" ::: "memory");
    __syncthreads();
}
__device__ __forceinline__ void phase_proj(const Params& p, LAS unsigned char* lds) {
    EpiProj E{p.ws}; EpiGates8 EG{p.ws};
    unsigned long long* prof = PROFSEL == 1 ? (unsigned long long*)(p.ws + WS_CTL + 32768) : nullptr;
    const int BIG = 1 << 20;
    const bool stag = (gridDim.x == 256);
    const int g = stag ? ((int)blockIdx.x >> 6) : -1;
    if constexpr (GATES_F8) {
#ifndef P1SLOTV
#define P1SLOTV 0
#endif
        int a1 = (g == 0) ? 0 : (g == 1 ? 2 : BIG), a3 = (g == 3) ? 3 : BIG, slot = (g <= 1) ? 1 : g;
        if (P1SLOTV == 1) { a1 = BIG; a3 = (g <= 0) ? BIG : 2 * g; slot = (g <= 0) ? 2 : 3; }
        if (P1SLOTV == 2) { a1 = (g == 0) ? 0 : (g == 1 ? 3 : BIG); a3 = (g == 2) ? 1 : (g == 3 ? 4 : BIG); slot = (g <= 1) ? 1 : 3; }
        { SchedProj S{p.ws, 0, a1}; gemm_phase<EpiProj, SchedProj, true>(lds, 2048, LDP, LDP, S, E, nullptr); }
        if (stag && slot == 1) proj_convert_slot(p, lds, g, 0);
        { SchedProj S{p.ws, a1, BIG}; gemm_phase<EpiProj, SchedProj, true>(lds, 2048, LDP, LDP, S, E, prof); }
        if (stag && slot == 2) proj_convert_slot(p, lds, g, 0);
        { SchedGates8 S{p.ws, 0, a3}; gemm_phase<EpiGates8, SchedGates8, true, 1>(lds, 2048, 2048, 2048, S, EG, nullptr); }
        if (stag && slot == 3) proj_convert_slot(p, lds, g, 0);
        { SchedGates8 S{p.ws, a3, BIG}; gemm_phase<EpiGates8, SchedGates8, true, 1>(lds, 2048, 2048, 2048, S, EG, nullptr); }
        if (stag && POOL1 > 0) pool_drain(p, lds, 0, CV_NONEXP + GU_P1P, 256 * POOL1);
    } else {
        const int nb = stag ? 3 * g : 0;
        if (nb > 0) { SchedProj S{p.ws, 0, nb}; gemm_phase<EpiProj, SchedProj, true>(lds, 2048, LDP, LDP, S, E, nullptr); }
        if (stag) proj_convert_slot(p, lds, g, 0);
        { SchedProj S{p.ws, nb, BIG}; gemm_phase<EpiProj, SchedProj, true>(lds, 2048, LDP, LDP, S, E, prof); }
    }
}
__device__ __forceinline__ void phase_mixers(const Params& p, LAS unsigned char* lds) {
    unsigned char* ws = p.ws;
#ifndef DBLSUB
#define DBLSUB 0
#endif
#pragma unroll 1
    for (int rep = 0; rep < ((DBLSUB & 1) ? 2 : 1); ++rep)
#pragma unroll 1
    for (int u = (P2ROLE && gridDim.x == 256) ? (((int)blockIdx.x >> 6) < 3 ? ((int)blockIdx.x & 7) * 24 + ((int)blockIdx.x >> 3) : 512) : vwg(); u < 512; u += (P2ROLE && gridDim.x == 256) ? 192 : (int)gridDim.x)
        attn_unit(p, lds, u >> 6, (u >> 4) & 3, u & 15);
    asm volatile("s_waitcnt vmcnt(0) lgkmcnt(0)" ::: "memory");
    __syncthreads();
#pragma unroll 1
    for (int rep = 0; rep < ((DBLSUB & 2) ? 2 : 1); ++rep)
#pragma unroll 1
    for (int u = vwg(); u < 256; u += (int)gridDim.x) {
        const int mh = u & 3, tb = (u >> 2) & 7, b = (u >> 5) & 7;
        const size_t tok0 = (size_t)b * S_ + (size_t)tb * 256;
        bf16_t* Pt = (bf16_t*)(ws + WS_PM) + tok0 * 1024 + mh * 256;
        SchedOne S1{(const char*)(ws + WS_QM) + (tok0 * 1024 + mh * 256) * 2, (const char*)(ws + WS_KMK) + ((size_t)b * 256 * 1024 + mh * 256) * 2, 0, true};
        EpiMemSoftmax E1{Pt};
        gemm_phase<EpiMemSoftmax, SchedOne, false>(lds, 256, 1024, 1024, S1, E1);
        asm volatile("s_waitcnt vmcnt(0)" ::: "memory");
        __syncthreads();
        SchedOne S2{(const char*)Pt, (const char*)(ws + WS_VMT) + ((size_t)(b * 4 + mh) * 256 * 256) * 2, 0, true};
        EpiTile E2{(bf16_t*)(ws + WS_FX) + tok0 * 2048 + 1024 + mh * 256, 2048};
        gemm_phase<EpiTile, SchedOne, false>(lds, 256, 1024, 256, S2, E2);
        __syncthreads();
    }
    { SchedChan S{ws, 0, 0}; EpiChan E{ws};
      if constexpr (SEQFOLD) {
          int tid_ = threadIdx.x; asm volatile("" : "+v"(tid_));
          const int ch = tid_ & 31, rr = tid_ >> 5;
          const bf16_t* fin = (const bf16_t*)(ws + WS_FIN);
#pragma unroll 1
          for (int i = 0; i < 2; ++i) { Unit u; if (!S.next(i, u)) break;
              const int b = u.z >> 2, g = u.z & 3, kb = u.pn; const bool cosb = kb < 4; const int s0 = cosb ? 256 * kb : 256 * (kb - 4);
              const bf16_t* base = fin + (size_t)(b * 2048) * 1024 + g * 256 + ch * 8;
              bf16_t* ob = (bf16_t*)(ws + WS_XF) + (size_t)(vwg() * 2 + i) * 65536 + ch * 8;
#pragma unroll 4
              for (int ps = 0; ps < 16; ++ps) { const int r = ps * 16 + rr, sq = s0 + r;
                  const bool valid = true; const int sv = sq, sp = (2048 - sv) & 2047; const bool pair = (sv != 0);
                  const float sg = cosb ? (pair ? 1.0f : 0.0f) : -1.0f, sa = valid ? 1.0f : 0.0f;
                  const u32x4 x = *(const u32x4*)(base + (size_t)sv * 1024), y = *(const u32x4*)(base + (size_t)sp * 1024); u32x4 w;
                  w.x = cvtpk(sa * bflo(x.x) + sg * bflo(y.x), sa * bfhi(x.x) + sg * bfhi(y.x)); w.y = cvtpk(sa * bflo(x.y) + sg * bflo(y.y), sa * bfhi(x.y) + sg * bfhi(y.y));
                  w.z = cvtpk(sa * bflo(x.z) + sg * bflo(y.z), sa * bfhi(x.z) + sg * bfhi(y.z)); w.w = cvtpk(sa * bflo(x.w) + sg * bflo(y.w), sa * bfhi(x.w) + sg * bfhi(y.w));
                  *(u32x4*)(ob + (size_t)r * 256) = w; } }
          asm volatile("s_waitcnt vmcnt(0)" ::: "memory");
          __syncthreads();
          gemm_phase<EpiChan, SchedChan, true>(lds, 256, 256, 256, S, E, PROFSEL == 2 ? (unsigned long long*)(p.ws + WS_CTL + 32768) : nullptr);
#pragma unroll 1
          for (int i = 0; i < 2; ++i) { Unit u; if (!S.next(i, u)) break;
              if (u.pn == 4 && tid_ < 256) { const int b = u.z >> 2, g = u.z & 3, n = tid_;
                  const bf16_t* xr = fin + ((size_t)(b * 2048 + 1024) * 1024 + g * 256); const bf16_t* tr = (const bf16_t*)(ws + WS_TABT) + (size_t)n * 256;
                  float a = 0.f;
#pragma unroll 4
                  for (int c8 = 0; c8 < 32; ++c8) { const u32x4 x = *(const u32x4*)(xr + 8 * c8), t = *(const u32x4*)(tr + 8 * c8);
                      a += bflo(x.x) * bflo(t.x) + bfhi(x.x) * bfhi(t.x) + bflo(x.y) * bflo(t.y) + bfhi(x.y) * bfhi(t.y) + bflo(x.z) * bflo(t.z) + bfhi(x.z) * bfhi(t.z) + bflo(x.w) * bflo(t.w) + bfhi(x.w) * bfhi(t.w); }
                  ((bf16_t*)(ws + WS_ZT))[((size_t)u.z * 256 + n) * SQP + 1024] = (bf16_t)(cvtpk(a, 0.f) & 0xffffu); } }
      } else gemm_phase<EpiChan, SchedChan, true>(lds, 256, 256, 1024, S, E, PROFSEL == 2 ? (unsigned long long*)(p.ws + WS_CTL + 32768) : nullptr); }
    if (POOL2 > 0 && gridDim.x == 256) pool_drain(p, lds, 2, CV_NONEXP + GU_P2P, 256 * POOL2);
}
__device__ __forceinline__ void phase_seqdft(const Params& p, LAS unsigned char* lds) {
    SchedSeq S{p.ws}; EpiSeq E{p.ws};
    gemm_phase<EpiSeq, SchedSeq, true>(lds, SQK, SQP, SQP, S, E, PROFSEL == 3 ? (unsigned long long*)(p.ws + WS_CTL + 32768) : nullptr);
    if (POOL3 > 0 && gridDim.x == 256) pool_drain(p, lds, 3, CV_NONEXP + GU_P3P, 256 * POOL3);
}
__device__ __forceinline__ void phase_mix(const Params& p, LAS unsigned char* lds) {
    unsigned char* ws = p.ws;
    const bool stag = (gridDim.x == 256); const int g = stag ? ((int)blockIdx.x >> 6) : -1;
    unsigned long long* prof = PROFSEL == 4 ? (unsigned long long*)(p.ws + WS_CTL + 32768) : nullptr;
    EpiMixF E{ws, lds};
#ifndef MIXSLOT
#define MIXSLOT 0x2110
#endif
    const int sp = (g >= 0) ? ((MIXSLOT >> (4 * g)) & 15) : -1;
    if (sp == 0) proj_convert_slot(p, lds, g, 1);
    { SchedMix S{ws, 0, 1}; gemm_phase<EpiMixF, SchedMix, true>(lds, 2048, 2048, 2048, S, E, prof); }
    if (sp == 1) proj_convert_slot(p, lds, g, 1);
    { SchedMix S{ws, 1, 1 << 20}; gemm_phase<EpiMixF, SchedMix, true>(lds, 2048, 2048, 2048, S, E, nullptr); }
    if (sp == 2) proj_convert_slot(p, lds, g, 1);
    if (POOL4 > 0 && stag) pool_drain(p, lds, 4, CV_NONEXP + GU_P4P, 256 * POOL4);
}
__device__ __forceinline__ void phase_x2(const Params& p, LAS unsigned char* lds) {
    unsigned char* ws = p.ws;
    SchedPlain S{(const char*)(ws + WS_MIXED), (const char*)(ws + WS_WOT), (size_t)256 * 2048 * 2, (size_t)256 * 2048 * 2, 64, 8};
    EpiRes E{p.in[0], (bf16_t*)(ws + WS_X2), (const bf16_t*)(ws + WS_H), (const float*)(ws + WS_IRSTD), p.in[3]};
    unsigned long long* prof = PROFSEL == 5 ? (unsigned long long*)(p.ws + WS_CTL + 32768) : nullptr;
    if (X2_SLOT > 0 && MOE_SLOT && gridDim.x == 256) {
        const int g = (int)blockIdx.x >> 6, sp = (0x2110 >> (4 * g)) & 15;
        if (sp == 0) proj_convert_slot(p, lds, g, 3);
        { SchedPlain Sa = S; Sa.r0 = 0; Sa.r1 = 1; gemm_phase<EpiRes, SchedPlain, true>(lds, 2048, 2048, 2048, Sa, E, prof); }
        if (sp == 1) proj_convert_slot(p, lds, g, 3);
        { SchedPlain Sb = S; Sb.r0 = 1; gemm_phase<EpiRes, SchedPlain, true>(lds, 2048, 2048, 2048, Sb, E, nullptr); }
        if (sp == 2) proj_convert_slot(p, lds, g, 3);
    } else gemm_phase<EpiRes, SchedPlain, true>(lds, 2048, 2048, 2048, S, E, prof);
    if (POOL5 > 0 && gridDim.x == 256) pool_drain(p, lds, 5, CV_NONEXP + GU_P5P, 256 * POOL5);
}
template <class Sched> __device__ __forceinline__ void moe_fill_tokl(const Params& p, LAS unsigned char* lds, const Sched& S, const LAS int* cn) {
    LAS unsigned short* tokl = (LAS unsigned short*)(lds + LDS_TOKL);
    const int* list = (const int*)(p.ws + WS_LIST);
    const int tid = threadIdx.x, half = tid >> 8, c = tid & 255;
    int tok[10]; bool val[10];
#pragma unroll
    for (int j = 0; j < 10; ++j) { Unit u; val[j] = S.next(2 * j + half, u); tok[j] = 0;
        if (val[j]) { const int cnt = cn[u.z]; int pos = u.pm * 256 + c; pos = pos < cnt ? pos : cnt - 1; tok[j] = list[(size_t)u.z * T_ + pos]; } }
#pragma unroll
    for (int j = 0; j < 10; ++j) if (val[j]) tokl[(2 * j + half) * 256 + c] = (unsigned short)tok[j];
    __syncthreads();
}
template <class Sched, bool WTAB> __device__ __forceinline__ void moe_fill_tabs(const Params& p, LAS unsigned char* lds, const Sched& S, const LAS int* cn, const float* bias, int ncol) {
    LAS float* btab = (LAS float*)(lds + LDS_BTAB); LAS float* wtab = (LAS float*)(lds + LDS_TOKL);
    const float* wl = (const float*)(p.ws + WS_WLIST);
    const int tid = threadIdx.x, half = tid >> 8, c = tid & 255;
    constexpr int NP = WTAB ? 5 : 10;
    float bv[NP], wv[NP]; bool val[NP];
#pragma unroll
    for (int j = 0; j < NP; ++j) { Unit u; val[j] = S.next(2 * j + half, u); bv[j] = 0.f; wv[j] = 0.f;
        if (val[j]) { bv[j] = bias[(size_t)u.z * ncol + u.pn * 256 + c];
            if constexpr (WTAB) { const int pos = u.pm * 256 + c; if (pos < cn[u.z]) wv[j] = wl[(size_t)u.z * T_ + pos] * YS_SCALE; } } }
#pragma unroll
    for (int j = 0; j < NP; ++j) if (val[j]) { btab[(2 * j + half) * 256 + c] = bv[j]; if constexpr (WTAB) wtab[(2 * j + half) * 256 + c] = wv[j]; }
    __syncthreads();
}
__device__ __forceinline__ void phase_gateup(const Params& p, LAS unsigned char* lds) {
    LAS int* pt = (LAS int*)(lds + LDS_MISC); LAS int* cn = pt + 64;
    moe_tables(p, pt, cn);
    if constexpr (MOE_F8) { SchedMoe<true, 16, true> S{p.ws, pt, cn}; EpiSwiglu8 E{p.ws, p.in[15], pt}; moe_fill_tokl(p, lds, S, cn); moe_fill_tabs<SchedMoe<true, 16, true>, false>(p, lds, S, cn, p.in[15], 4096);
        unsigned long long* prof = PROFSEL == 7 ? (unsigned long long*)(p.ws + WS_CTL + 32768) : nullptr;
        const bool stag = MOE_SLOT && (gridDim.x == 256);
        if (stag) {
            const int g = (int)blockIdx.x >> 6, a = MOE_SLOT_STEP * g;
            if (a > 0) { SchedMoe<true, 16, true> Sa{p.ws, pt, cn, 0, 0, a}; gemm_phase<EpiSwiglu8, SchedMoe<true, 16, true>, MOE_ALIGN, 1>(lds, 2048, 2048, 2048, Sa, E, nullptr); }
            if constexpr (MOE_SLOT_BAL) {
                const int U = S.ptu(NE) * 16, rmax = (U + 255) >> 8, me = (int)blockIdx.x & 63;
                int totd = 0, dme = 0, dbefore = 0;
#pragma unroll 1
                for (int i = 0; i < 64; ++i) { const int c = 64 * g + i, v = (c & 7) * 32 + (c >> 3); const int r = (v < U) ? ((U - v + 255) >> 8) : 0; int d = rmax - r;
#ifdef MOE_BAL_TEST
                    d = (i * 7 + g) % 3 == 0 ? 1 : 0;
#endif
                    totd += d; if (i < me) dbefore += d; if (i == me) dme = d; }
                constexpr int GT = 1024 - 64 * POOL7;
                const int n0 = (GT - MOE_SLOT_BAL * totd) / 64, rem = GT - 64 * n0 - MOE_SLOT_BAL * totd;
                const long base = CV_NONEXP + 8192 + (long)GT * g;
                const int xs = 64 * n0 + MOE_SLOT_BAL * dbefore + (me < rem ? me : rem), xn = MOE_SLOT_BAL * dme + (me < rem ? 1 : 0);
                __syncthreads();
                convert_items(p, lds, base, base + 64 * n0, me, 64);
                if (xn > 0) convert_items(p, lds, base + xs, base + xs + xn, 0, 1);
                asm volatile("s_waitcnt vmcnt(0) lgkmcnt(0)" ::: "memory");
                __syncthreads();
            } else proj_convert_slot(p, lds, g, 2);
            moe_fill_tokl(p, lds, S, cn);
            SchedMoe<true, 16, true> Sb{p.ws, pt, cn, 0, a, 1 << 20}; gemm_phase<EpiSwiglu8, SchedMoe<true, 16, true>, MOE_ALIGN, 1>(lds, 2048, 2048, 2048, Sb, E, prof);
            if (POOL7 > 0) pool_drain(p, lds, 1, CV_NONEXP + 12288 - 256 * POOL7, 256 * POOL7);
        } else gemm_phase<EpiSwiglu8, SchedMoe<true, 16, true>, MOE_ALIGN, 1>(lds, 2048, 2048, 2048, S, E, prof); }
    else { SchedMoe<true, 16, false> S{p.ws, pt, cn}; EpiSwiglu E{p.ws, p.in[15], pt}; moe_fill_tokl(p, lds, S, cn);
        gemm_phase<EpiSwiglu, SchedMoe<true, 16, false>, true>(lds, 2048, 2048, 2048, S, E); }
}
__device__ __forceinline__ void phase_down(const Params& p, LAS unsigned char* lds) {
    LAS int* pt = (LAS int*)(lds + LDS_MISC); LAS int* cn = pt + 64;
    moe_tables(p, pt, cn);
    if constexpr (MOE_F8) { SchedMoe<false, 8, true> S{p.ws, pt, cn}; EpiDown8 E{p.ws, p.in[17], pt, cn}; moe_fill_tabs<SchedMoe<false, 8, true>, true>(p, lds, S, cn, p.in[17], 2048); gemm_phase<EpiDown8, SchedMoe<false, 8, true>, MOE_ALIGN, 1>(lds, 2048, 2048, 2048, S, E, PROFSEL == 8 ? (unsigned long long*)(p.ws + WS_CTL + 32768) : nullptr); }
    else { SchedMoe<false, 8, false> S{p.ws, pt, cn}; EpiDown E{p.ws, p.in[17], pt, cn}; gemm_phase<EpiDown, SchedMoe<false, 8, false>, true>(lds, 2048, 2048, 2048, S, E); }
#ifdef SHADOW
    if constexpr (MOE_F8) { __syncthreads(); SchedMoe<false, 8, true> S{p.ws, pt, cn, SHADOW - 1}; EpiDown8 E{p.ws, p.in[17], pt, cn, (WS_FAST_END + 4095) & ~(size_t)4095};
        gemm_phase<EpiDown8, SchedMoe<false, 8, true>, MOE_ALIGN, 1>(lds, 2048, 2048, 2048, S, E, nullptr); }
#endif
}
__device__ __forceinline__ void phase_out(const Params& p, LAS unsigned char* lds) {
    LAS int* pt = (LAS int*)(lds + LDS_MISC); LAS int* cn = pt + 64;
    moe_tables(p, pt, cn);
    phase_final(p, pt);
}

template <int PH> __global__ void __launch_bounds__(NTHR, 2) k_phase(Params p) {
    extern __shared__ __attribute__((aligned(16))) unsigned char lds_raw[];
    LAS unsigned char* lds = (LAS unsigned char*)lds_raw;
    if constexpr (PH == 0) phase_prologue(p, lds);
    if constexpr (PH == 1) phase_proj(p, lds);
    if constexpr (PH == 2) phase_mixers(p, lds);
    if constexpr (PH == 3) phase_seqdft(p, lds);
    if constexpr (PH == 4) phase_mix(p, lds);
    if constexpr (PH == 5) phase_x2(p, lds);
    if constexpr (PH == 6) phase_rows(p, lds);
    if constexpr (PH == 7) phase_gateup(p, lds);
    if constexpr (PH == 8) phase_down(p, lds);
    if constexpr (PH == 9) phase_out(p, lds);
}
template <int PH> static void launch_phase(const Params& p, hipStream_t st) {
    static bool attr_done = false;
    if (!attr_done) { (void)hipFuncSetAttribute((const void*)k_phase<PH>, hipFuncAttributeMaxDynamicSharedMemorySize, LDS_BYTES); attr_done = true; }
    hipLaunchKernelGGL(k_phase<PH>, dim3(256), dim3(NTHR), LDS_BYTES, st, p);
}
static void run_fast_multi(const Params& p, hipStream_t st, int lo, int hi) {
    if (lo <= 0 && 0 < hi) launch_phase<0>(p, st);
    if (lo <= 1 && 1 < hi) launch_phase<1>(p, st);
    if (lo <= 2 && 2 < hi) launch_phase<2>(p, st);
    if (lo <= 3 && 3 < hi) launch_phase<3>(p, st);
    if (lo <= 4 && 4 < hi) launch_phase<4>(p, st);
    if (lo <= 5 && 5 < hi) launch_phase<5>(p, st);
    if (lo <= 6 && 6 < hi) launch_phase<6>(p, st);
    if (lo <= 7 && 7 < hi) launch_phase<7>(p, st);
    if (lo <= 8 && 8 < hi) launch_phase<8>(p, st);
    if (lo <= 9 && 9 < hi) launch_phase<9>(p, st);
}
#define XB_TMO      128
#define XB_XCNT(j)  (256  + 64 * (j))
#define XB_XSUB(j)  (1280 + 64 * (j))
#define XB_XGEN(j)  (2304 + 64 * (j))
#define XB_TOP      3328
#define XB_TOPGEN   3392
#define XCD_BAR_WORDS 3456
#define XB_SPIN_CAP (1u << 18)

__device__ __forceinline__ unsigned xb_ld(unsigned* p)              { return __hip_atomic_load(p, __ATOMIC_RELAXED, __HIP_MEMORY_SCOPE_AGENT); }
__device__ __forceinline__ unsigned xb_add(unsigned* p, unsigned v) { return __hip_atomic_fetch_add(p, v, __ATOMIC_RELAXED, __HIP_MEMORY_SCOPE_AGENT); }
__device__ __forceinline__ unsigned xb_xcc_id() { return (unsigned)__builtin_amdgcn_s_getreg((3 << 11) | 20) & 0xFu; }
#define XB_SPIN(cond, bar) do { unsigned _sp = 0; while (cond) { __builtin_amdgcn_s_sleep(1); \
    if ((++_sp & 255u) == 0u) { if (xb_ld(&(bar)[XB_TMO])) break; if (_sp > XB_SPIN_CAP) { atomicAdd(&(bar)[XB_TMO], 1u); break; } } } } while (0)

struct XcdBarrier {
    unsigned* bar; unsigned x;
    volatile LAS unsigned* st;
};

__device__ __forceinline__ XcdBarrier xcd_barrier_post(unsigned* bar, volatile LAS unsigned* st) {
    XcdBarrier b; b.bar = bar; b.x = xb_xcc_id(); b.st = st;
    if (threadIdx.x == 0) (void)xb_add(&bar[XB_XCNT(b.x)], 1u);
    return b;
}
__device__ __forceinline__ void xcd_barrier_complete(unsigned* bar, unsigned x, unsigned& nloc, unsigned& nx) {
    const unsigned G = gridDim.x * gridDim.y * gridDim.z;
    unsigned sum, cnt, mine, sp = 0u;
    for (;;) {
        sum = 0u; cnt = 0u; mine = 0u;
#pragma unroll
        for (unsigned j = 0; j < 16; ++j) { const unsigned c = xb_ld(&bar[XB_XCNT(j)]); sum += c; cnt += (c > 0u) ? 1u : 0u; mine = (j == x) ? c : mine; }
        if (sum == G) break;
        __builtin_amdgcn_s_sleep(1);
        if ((++sp & 255u) == 0u) { if (xb_ld(&bar[XB_TMO])) break; if (sp > XB_SPIN_CAP) { atomicAdd(&bar[XB_TMO], 1u); break; } }
    }
    nloc = mine > 0u ? mine : 1u; nx = cnt > 0u ? cnt : 1u;
}

__device__ __forceinline__ void xcd_barrier(const XcdBarrier& b) {
    asm volatile("s_waitcnt vmcnt(0)" ::: "memory");
    __syncthreads();
    if (threadIdx.x == 0) {
        unsigned* bar = b.bar;
        __builtin_amdgcn_s_waitcnt(0);
        unsigned nloc = b.st[0], nx = b.st[1];
        if (nloc == 0u) { xcd_barrier_complete(bar, b.x, nloc, nx); b.st[0] = nloc; b.st[1] = nx; }
        const unsigned old = xb_add(&bar[XB_XSUB(b.x)], 1u);
        const unsigned gen = old / nloc;
        if (old + 1u == (gen + 1u) * nloc) {
            __builtin_amdgcn_fence(__ATOMIC_RELEASE, "agent");
            asm volatile("s_waitcnt vmcnt(0)" ::: "memory");
            const unsigned og = xb_add(&bar[XB_TOP], 1u);
            const unsigned tg = og / nx;
            if (og + 1u == (tg + 1u) * nx) xb_add(&bar[XB_TOPGEN], 1u);
            else XB_SPIN(xb_ld(&bar[XB_TOPGEN]) == tg, bar);
            __builtin_amdgcn_fence(__ATOMIC_ACQUIRE, "agent");
            xb_add(&bar[XB_XGEN(b.x)], 1u);
            asm volatile("s_waitcnt vmcnt(0)" ::: "memory");
        } else {
            XB_SPIN(xb_ld(&bar[XB_XGEN(b.x)]) == gen, bar);
            __builtin_amdgcn_fence(__ATOMIC_ACQUIRE, "agent");
            asm volatile("s_waitcnt vmcnt(0)" ::: "memory");
        }
    }
    __syncthreads();
}

__global__ void __launch_bounds__(NTHR, 2) mega_fwd(Params p) {
    extern __shared__ __attribute__((aligned(16))) unsigned char lds_raw[];
    LAS unsigned char* lds = (LAS unsigned char*)lds_raw;
    volatile LAS unsigned* xbw = (volatile LAS unsigned*)(lds + LDS_XBW);
    if (threadIdx.x < 4) xbw[threadIdx.x] = 0u;
    __syncthreads();
    XcdBarrier bar = xcd_barrier_post((unsigned*)(p.ws + WS_CTL) + CW_BAR, xbw);
#ifndef DBL
#define DBL 0
#endif
#ifndef SKEWPH
#define SKEWPH -1
#endif
#define RUNPH(i, call) do { call; if constexpr ((DBL >> (i)) & 1) { xcd_barrier(bar); call; } \
    if constexpr (SKEWPH == (i)) { if (threadIdx.x == 0) ((unsigned long long*)(p.ws + WS_CTL + 40960))[blockIdx.x] = wall_clock64(); } } while (0)
    RUNPH(0, phase_prologue(p, lds));  xcd_barrier(bar);
    RUNPH(1, phase_proj(p, lds));      xcd_barrier(bar);
    RUNPH(2, phase_mixers(p, lds));    xcd_barrier(bar);
    RUNPH(3, phase_seqdft(p, lds));    xcd_barrier(bar);
    RUNPH(4, phase_mix(p, lds));       xcd_barrier(bar);
    RUNPH(5, phase_x2(p, lds));        xcd_barrier(bar);
    phase_rows(p, lds);                xcd_barrier(bar);
    RUNPH(7, phase_gateup(p, lds));    xcd_barrier(bar);
    RUNPH(8, phase_down(p, lds));      xcd_barrier(bar);
    phase_out(p, lds);
}
static void run_fast_one(const Params& p, hipStream_t st) {
    static int grid = 0;
    if (!grid) {
        int dev = 0, cus = 0, per_cu = 0;
        (void)hipGetDevice(&dev); (void)hipDeviceGetAttribute(&cus, hipDeviceAttributeMultiprocessorCount, dev);
        (void)hipFuncSetAttribute((const void*)mega_fwd, hipFuncAttributeMaxDynamicSharedMemorySize, LDS_BYTES);
        (void)hipOccupancyMaxActiveBlocksPerMultiprocessor(&per_cu, (const void*)mega_fwd, NTHR, LDS_BYTES);
        if (per_cu < 1) per_cu = 1;
        grid = cus > 256 ? 256 : cus;
        grid &= ~7; if (grid < 8) grid = 8;
    }
    hipLaunchKernelGGL(mega_fwd, dim3(grid), dim3(NTHR), LDS_BYTES, st, p);
}
}
#ifndef REPORT
#define REPORT 0
#endif
extern "C" void kernel_launch(void* const* d_in, const int* in_sizes, int n_in, void* d_out, int out_size, void* d_ws, size_t ws_size, hipStream_t stream) {
    (void)in_sizes; (void)n_in; (void)out_size; (void)ws_size;
    unsigned char* ws = (unsigned char*)d_ws;
#if MODE == 0
    nv::NBuf nb; nv::carve(nb, ws);
    nv::run_part1(d_in, nb, stream); nv::run_part2(d_in, nb, (float*)d_out, stream);
#elif MODE == 1
    constexpr size_t NAIVE_BASE = (fx::WS_FAST_END + 4095) & ~(size_t)4095;
    nv::NBuf nb; const size_t nbytes = nv::carve(nb, ws + NAIVE_BASE);
    float* fout = (float*)(ws + NAIVE_BASE + ((nbytes + 4095) & ~(size_t)4095));
    double* acc = (double*)(fout + (size_t)16384 * 2048); float* scale = (float*)(acc + 64);
    fx::Params p; memset(&p, 0, sizeof(p));
    for (int i = 0; i < 19; ++i) p.in[i] = (const float*)d_in[i];
    p.out = fout; p.ws = ws;
    (void)hipMemsetAsync(ws + fx::WS_CTL, 0, fx::CTL_BYTES, stream);
    (void)hipMemsetAsync(acc, 0, 1024, stream);
    nv::run_part1(d_in, nb, stream);
    fx::run_fast_multi(p, stream, 0, 7);
    auto cmp = [&](int slot, int kind, const void* a, const float* ref, long long n, int w, int ldf, int ldr, int off, int sig) {
        ck::CP c; memset(&c, 0, sizeof(c)); c.a = a; c.ref = ref; c.n = n; c.kind = kind; c.w = w; c.ldf = ldf; c.ldr = ldr; c.off = off; c.sig = sig; c.slot = slot;
        hipLaunchKernelGGL(ck::k_cmp, dim3(2048), dim3(256), 0, stream, c, acc); };
    const long long T = 16384;
    cmp(0, 0, ws + fx::WS_FIN, nb.proj, T * 1024, 1024, 1024, 10752, 0, 0);
    cmp(1, 0, ws + fx::WS_Q, nb.proj, T * 2048, 2048, 2048, 10752, 1024, 0);
    cmp(2, 0, ws + fx::WS_K, nb.proj, T * 256, 256, 256, 10752, 3072, 0);
    cmp(3, 2, ws + fx::WS_VT, nb.proj, T * 256, 0, 0, 0, 0, 0);
    cmp(4, 0, ws + fx::WS_QM, nb.proj, T * 1024, 1024, 1024, 10752, 3584, 0);
    cmp(5, 0, ws + fx::WS_GATES, nb.proj, T * 6144, 6144, 6144, 10752, 4608, 1);
    cmp(6, 0, ws + fx::WS_KMK, nb.kvm, 2048LL * 1024, 1024, 1024, 2048, 0, 0);
    cmp(7, 3, ws + fx::WS_VMT, nb.kvm, 2048LL * 1024, 0, 0, 0, 0, 0);
    cmp(8, 0, ws + fx::WS_ATT, nb.att, T * 2048, 2048, 2048, 2048, 0, 0);
    cmp(9, 0, ws + fx::WS_XM, nb.xm, T * 1024, 1024, 1024, 1024, 0, 0);
    cmp(10, 0, ws + fx::WS_FM, nb.fm, T * 1024, 1024, 1024, 1024, 0, 0);
    cmp(11, 0, ws + fx::WS_MIXED, nb.mixed, T * 2048, 2048, 2048, 2048, 0, 0);
    cmp(12, 1, ws + fx::WS_X2, nb.x2, T * 2048, 2048, 2048, 2048, 0, 0);
    cmp(13, 0, ws + fx::WS_H2, nb.h2, T * 2048, 2048, 2048, 2048, 0, 0);
    hipLaunchKernelGGL(ck::k_cmp_route, dim3(64), dim3(256), 0, stream, (const int*)(ws + fx::WS_TOKE), (const int*)nb.tope, acc, 14);
    nv::run_part2(d_in, nb, nb.nout, stream);
    fx::run_fast_multi(p, stream, 7, 10);
    cmp(15, 1, fout, nb.nout, T * 2048, 2048, 2048, 2048, 0, 0);
    hipLaunchKernelGGL(ck::k_verdict, dim3(1), dim3(64), 0, stream, (const double*)acc, scale, 16, (int)REPORT);
    hipLaunchKernelGGL(ck::k_scale_out, dim3(2048), dim3(256), 0, stream, (const float*)nb.nout, (const float*)scale, (float*)d_out, T * 2048);
#elif MODE == 2
    fx::Params p; memset(&p, 0, sizeof(p));
    for (int i = 0; i < 19; ++i) p.in[i] = (const float*)d_in[i];
    p.out = (float*)d_out; p.ws = ws;
    (void)hipMemsetAsync(ws + fx::WS_CTL, 0, fx::CTL_BYTES, stream);
    fx::run_fast_multi(p, stream, 0, 10);
#elif MODE == 3
    fx::Params p; memset(&p, 0, sizeof(p));
    for (int i = 0; i < 19; ++i) p.in[i] = (const float*)d_in[i];
    p.out = (float*)d_out; p.ws = ws;
    (void)hipMemsetAsync(ws + fx::WS_CTL, 0, fx::CTL_BYTES, stream);
    fx::run_fast_one(p, stream);
#endif
}
```

```cpp
#include <hip/hip_runtime.h>
#include <stdint.h>
#include <string.h>
#ifndef MODE
#define MODE 3
#endif
namespace fx {
#define LAS __attribute__((address_space(3)))
typedef unsigned short bf16_t;
typedef short bf16x8 __attribute__((ext_vector_type(8)));
typedef short s16x4 __attribute__((ext_vector_type(4)));
typedef float f32x4 __attribute__((ext_vector_type(4)));
typedef float f32x16 __attribute__((ext_vector_type(16)));
typedef float f32x2 __attribute__((ext_vector_type(2)));
typedef __bf16 bf16x2_t __attribute__((ext_vector_type(2)));
typedef unsigned u32x4 __attribute__((ext_vector_type(4)));
typedef unsigned u32x2 __attribute__((ext_vector_type(2)));

constexpr int NTHR = 512, NWAVE = 8;
constexpr int B_ = 8, S_ = 2048, DM = 2048, T_ = B_ * S_;
constexpr int MEM = 256, FW = 1024, FG = 4, FGD = 256;
constexpr int NH = 32, NKV = 4, HD = 64, AW = 2048, KVW = 256, WIN = 128;
constexpr int MH = 4, MHD = 256, MW = 1024;
constexpr int NE = 32, TOPK = 4, DFF = 2048;
constexpr int INW = 10752;
#ifndef LDPAD
#define LDPAD 0
#endif
#ifndef ROUTER_ON_X2
#define ROUTER_ON_X2 1
#endif
#ifndef SEQFOLD
#define SEQFOLD 1
#endif
#ifndef SQPAD
#define SQPAD 0
#endif
constexpr int LDP = 2048 + LDPAD;
constexpr int NSLOT = T_ * TOPK + NE * 256;
constexpr float LOG2E = 1.4426950408889634f;
#ifndef MOE_FP8
#define MOE_FP8 1
#endif
constexpr bool MOE_F8 = (MOE_FP8 != 0);
#ifndef GATES_FP8
#define GATES_FP8 1
#endif
constexpr bool GATES_F8 = (GATES_FP8 != 0);
#ifndef CONV_TILE32
#define CONV_TILE32 0
#endif
#ifndef MOE_ALIGN
#define MOE_ALIGN true
#endif
#ifndef PROFSEL
#define PROFSEL 0
#endif
#ifndef PROFMETRIC
#define PROFMETRIC 0
#endif
#ifndef PROFMUL
#define PROFMUL 1
#endif
#ifndef PROFBLK
#define PROFBLK 0
#endif

constexpr size_t al256(size_t x) { return (x + 255) & ~(size_t)255; }
constexpr size_t WS_CTL = 0, CTL_BYTES = 65536;
constexpr size_t WS_WINT = 1u << 20;
constexpr size_t WS_WMKVT = WS_WINT + (size_t)INW * LDP * 2;
constexpr size_t WS_WFOT = WS_WMKVT + (size_t)2048 * LDP * 2;
constexpr size_t WS_WAOT = WS_WFOT + (size_t)2048 * 1024 * 2;
constexpr size_t WS_WMOT = WS_WAOT + (size_t)2048 * 2048 * 2;
constexpr size_t WS_WOT = WS_WMOT + (size_t)2048 * 1024 * 2;
constexpr size_t WS_WRT = WS_WOT + (size_t)2048 * 2048 * 2;
constexpr size_t WS_TABT = WS_WRT + (size_t)NE * DM * 2;
constexpr size_t WS_DMAT = WS_TABT + (size_t)512 * 256 * 2;
constexpr int SQK = SEQFOLD ? 1024 : 4096;
constexpr int DQP = SQK + SQPAD;
constexpr int SQP = (SEQFOLD ? 2048 : 4096) + SQPAD;
constexpr size_t WS_WGUT = WS_DMAT + (size_t)2048 * DQP * 2;
constexpr size_t WS_WDNT = WS_WGUT + (size_t)NE * 4096 * 2048 * 2;
constexpr size_t WS_H = WS_WDNT + (size_t)NE * 2048 * 2048 * 2;
constexpr size_t WS_MEMBF = WS_H + (size_t)T_ * LDP * 2;
constexpr size_t WS_FIN = WS_MEMBF + (size_t)2048 * LDP * 2;
constexpr size_t WS_Q = WS_FIN + (size_t)T_ * FW * 2;
constexpr size_t WS_K = WS_Q + (size_t)T_ * AW * 2;
constexpr size_t WS_VT = WS_K + (size_t)T_ * KVW * 2;
constexpr size_t WS_QM = WS_VT + (size_t)T_ * KVW * 2;
constexpr size_t WS_GATES = WS_QM + (size_t)T_ * MW * 2;
constexpr size_t WS_KMK = WS_GATES + (size_t)T_ * 3 * DM * 2;
constexpr size_t WS_VMT = WS_KMK + (size_t)2048 * 1024 * 2;
constexpr size_t WS_ZT = WS_VMT + (size_t)2048 * 1024 * 2;
constexpr size_t WS_FM = WS_ZT + (size_t)32 * 256 * SQP * 2;
constexpr size_t WS_ATT = WS_FM + (size_t)T_ * FW * 2;
constexpr size_t WS_PM = WS_ATT + (size_t)T_ * AW * 2;
constexpr size_t WS_XM = WS_PM + (size_t)T_ * MH * 256 * 2;
constexpr size_t WS_MIXACC = WS_XM + (size_t)T_ * MW * 2;
constexpr size_t WS_MIXED = WS_MIXACC + (size_t)T_ * DM * 4;
constexpr size_t WS_XF = WS_MIXED;
constexpr size_t WS_FX = WS_MIXACC;
constexpr size_t WS_WFM = WS_MIXACC + (size_t)T_ * 2048 * 2;
constexpr size_t WS_IRSTD = WS_WFM + (size_t)2048 * 2048 * 2;
static_assert(WS_IRSTD + (size_t)T_ * 4 <= WS_MIXED, "fused-mix operands fit the old mixacc region");
constexpr size_t WS_X2 = WS_MIXED + (size_t)T_ * DM * 2;
constexpr size_t WS_H2 = WS_X2 + (size_t)T_ * DM * 4;
constexpr size_t WS_TOKE = WS_H2 + (size_t)T_ * DM * 2;
constexpr size_t WS_TOKPOS = WS_TOKE + (size_t)T_ * 4 * 4;
constexpr size_t WS_TOKW = WS_TOKPOS + (size_t)T_ * 4 * 4;
constexpr size_t WS_LIST = WS_TOKW + (size_t)T_ * 4 * 4;
constexpr size_t WS_WLIST = WS_LIST + (size_t)NE * T_ * 4;
constexpr size_t WS_WGUQ = WS_WLIST + (size_t)NE * T_ * 4;
constexpr size_t WS_WDNQ = WS_WGUQ + (size_t)NE * 4096 * 2048;
constexpr size_t WS_H2Q = WS_WDNQ + (size_t)NE * 2048 * 2048;
constexpr size_t WS_H8 = WS_H2Q + (size_t)T_ * DM;
constexpr size_t WS_WINQ = WS_H8 + (size_t)T_ * DM;
constexpr size_t WS_FAST_END = WS_WINQ + (size_t)6144 * DM;
constexpr size_t WS_ACTQ = WS_H;
constexpr float WQ_SCALE = 32.0f, WQ_INV = 1.0f / 32.0f;
constexpr float YS_SCALE = 16.0f, YS_INV = 1.0f / 16.0f;
constexpr size_t WS_ACT = WS_H;
constexpr size_t WS_YS = WS_ACT + (size_t)NSLOT * DFF * 2;
static_assert(WS_YS + (size_t)NSLOT * DM * 2 <= WS_MIXED, "overlay fits");
constexpr int CW_CNT = 0;
constexpr int CW_POOL = 64;
constexpr int CW_BAR = 4096;

constexpr int LDS_STAGE = 0, STAGE_BYTES = 131072;
constexpr int LDS_TOKL = 131072;
constexpr int LDS_MISC = 141312;
constexpr int LDS_BTAB = 142336;
constexpr int LDS_XBW = 163824;
constexpr int LDS_BYTES = 163840;

struct Params {
    const float* in[19]; float* out; unsigned char* ws;
};

__device__ __forceinline__ unsigned cvtpk(float lo, float hi) { f32x2 v = {lo, hi}; bf16x2_t b = __builtin_convertvector(v, bf16x2_t); return __builtin_bit_cast(unsigned, b); }
__device__ __forceinline__ float bf2f(unsigned short x) { return __uint_as_float(((unsigned)x) << 16); }
__device__ __forceinline__ float bflo(unsigned w) { return __uint_as_float(w << 16); }
__device__ __forceinline__ float bfhi(unsigned w) { return __uint_as_float(w & 0xffff0000u); }
__device__ __forceinline__ float wsum(float v) {
#pragma unroll
    for (int o = 1; o < 64; o <<= 1) v += __shfl_xor(v, o);
    return v;
}
__device__ __forceinline__ float sigmoid_sc(float x, float nsc) { return __builtin_amdgcn_rcpf(1.0f + __builtin_amdgcn_exp2f(x * nsc)); }
__device__ __forceinline__ float sigmoidf_(float x) { return __builtin_amdgcn_rcpf(1.0f + __builtin_amdgcn_exp2f(-x * LOG2E)); }
__device__ __forceinline__ int crow(int r, int h) { return (r & 3) + 8 * (r >> 2) + 4 * h; }
__device__ __forceinline__ int t5_bucket(int rel) {
    const int n = rel < 0 ? -rel : rel;
    int b;
    if (n < 8) b = n; else if (n < 12) b = 8; else if (n < 16) b = 9; else if (n < 23) b = 10; else if (n < 32) b = 11;
    else if (n < 46) b = 12; else if (n < 64) b = 13; else if (n < 91) b = 14; else b = 15;
    return (rel > 0 ? 16 : 0) + b;
}
__device__ __forceinline__ int vwg() { const int c = blockIdx.x, G = gridDim.x; return ((G & 7) == 0) ? (c & 7) * (G >> 3) + (c >> 3) : c; }

constexpr int BM = 256, BK = 64, HALF = 128, HTB = HALF * BK * 2;
__host__ __device__ __forceinline__ int lds_byte(int r, int c) { const int st = (r >> 4) * 2 + (c >> 5), rr = r & 15, cc = c & 31, ob = rr * 64 + cc * 2; return st * 1024 + (ob ^ (((ob >> 9) & 1) << 5)); }
__host__ __device__ __forceinline__ void stage_rc(int b, int& R, int& C) { const int st = b / 1024, sb = b % 1024, swz = sb ^ (((sb >> 9) & 1) << 5); R = (st >> 1) * 16 + swz / 64; C = (st & 1) * 32 + (swz % 64) / 2; }
__host__ __device__ __forceinline__ int perm32(int rho) { const int n = rho >> 4, i = rho & 15; return 8 * (i >> 2) + 4 * n + (i & 3); }

struct Unit { int pm, pn, z, idx; };
template <class S, class = void> struct SchedVarK { static constexpr bool v = false; };
template <class S> struct SchedVarK<S, decltype((void)S::VARK)> { static constexpr bool v = S::VARK; };
template <class E, class = void> struct EpiTouch { static constexpr bool v = false; };
template <class E> struct EpiTouch<E, decltype((void)E::TOUCH)> { static constexpr bool v = E::TOUCH; };
template <class E, class = void> struct EpiKeep { static constexpr bool v = false; };
template <class E> struct EpiKeep<E, decltype((void)E::KEEP)> { static constexpr bool v = E::KEEP; };
typedef int v4i_t __attribute__((ext_vector_type(4)));
typedef int v8i_t __attribute__((ext_vector_type(8)));
__device__ __forceinline__ void mfma_f8(f32x4& c, const v8i_t& a, const v8i_t& b) { asm volatile("v_mfma_f32_16x16x128_f8f6f4 %0, %1, %2, %0" : "+v"(c) : "v"(a), "v"(b)); }
template <int ESZ> struct FragT;
template <> struct FragT<2> { struct A4 { bf16x8 v[4][2]; }; struct B2 { bf16x8 v[2][2]; }; };
template <> struct FragT<1> { struct A4 { v8i_t v[4]; }; struct B2 { v8i_t v[2]; }; };
__device__ __forceinline__ v8i_t cat8(bf16x8 a, bf16x8 b) { return __builtin_shufflevector(__builtin_bit_cast(v4i_t, a), __builtin_bit_cast(v4i_t, b), 0, 1, 2, 3, 4, 5, 6, 7); }

template <class Epi, class Sched, bool ALIGN_EPI, int ESZ = 2  >
__device__ __forceinline__ void gemm_phase(LAS unsigned char* lds, const int K, const int lda, const int ldb, const Sched& S, const Epi& E, unsigned long long* prof = nullptr) {
    unsigned long long pf_kl = 0, pf_ep = 0, pf_t0 = 0, pf_t1 = 0, pf_n = 0; const unsigned long long pf_w0 = prof ? wall_clock64() : 0ull, pf_c0 = prof ? clock64() : 0ull;
    int tid_ = threadIdx.x; asm volatile("" : "+v"(tid_));
    const int tid = tid_, wid = __builtin_amdgcn_readfirstlane(tid >> 6), lane = tid & 63, wr = wid >> 2, wc = wid & 3, fr = lane & 15, fq = lane >> 4;
    const int nt = (K * ESZ) / (BK * 2);
    constexpr bool GATHER = Sched::GATHER;
    unsigned voffA[2], voffB[2]; int Rr[2], Cb[2];
#pragma unroll
    for (int i = 0; i < 2; ++i) { int R, C; stage_rc(tid * 16 + i * 8192, R, C);
        int Rb = R;
        if constexpr ((int)Epi::PERM == 1) Rb = (R & ~31) + perm32(R & 31);
        if constexpr ((int)Epi::PERM == 2) Rb = 64 * (R >> 5) + 16 * ((R >> 2) & 3) + 4 * ((R >> 4) & 1) + (R & 3);
        voffA[i] = (unsigned)(R * lda * ESZ + C * 2); voffB[i] = (unsigned)(Rb * ldb * ESZ + C * 2); Rr[i] = R; Cb[i] = C * 2; }
    const size_t kstep = (size_t)(BK * 2);
    const size_t hstepA = (size_t)HALF * lda * ESZ, hstepB = (size_t)(((int)Epi::PERM == 2) ? 8 : HALF) * ldb * ESZ;
    const unsigned ldsw = (unsigned)wid * 1024u;
    const int aoff = lds_byte(wr * 64 + fr, fq * 8), boff = lds_byte(wc * 32 + fr, fq * 8);
#define PG8_SA(b, h) (((b) * 2 + (h)) * HTB)
#define PG8_SB(b, h) ((4 + (b) * 2 + (h)) * HTB)
#define PG8_STAGE(bufoff, gbase, voff) do { _Pragma("unroll") for (int _i = 0; _i < 2; ++_i) \
        __builtin_amdgcn_global_load_lds((const unsigned*)((const char*)(gbase) + (voff)[_i]), (LAS unsigned*)(lds + (bufoff) + ldsw + _i * 8192), 16, 0, 0); } while (0)
#define PG8_STAGE_A(bufoff, gbase, h, NX) do { if constexpr (GATHER) { _Pragma("unroll") for (int _i = 0; _i < 2; ++_i) { const unsigned _o = (NX) ? naoff[h][_i] : caoff[h][_i]; \
        __builtin_amdgcn_global_load_lds((const unsigned*)((const char*)(gbase) + _o), (LAS unsigned*)(lds + (bufoff) + ldsw + _i * 8192), 16, 0, 0); } } \
        else { PG8_STAGE(bufoff, (const char*)(gbase) + (h) * hstepA, voffA); } } while (0)
#define PG8_LDA(dst, b, h) do { _Pragma("unroll") for (int m = 0; m < 4; ++m) { if constexpr (ESZ == 2) { _Pragma("unroll") for (int k = 0; k < 2; ++k) dst.v[m][k] = *(const LAS bf16x8*)(lds + PG8_SA(b, h) + aoff + m * 2048 + k * 1024); } \
        else { const v4i_t _lo = *(const LAS v4i_t*)(lds + PG8_SA(b, h) + aoff + m * 2048), _hi = *(const LAS v4i_t*)(lds + PG8_SA(b, h) + aoff + m * 2048 + 1024); dst.v[m] = __builtin_shufflevector(_lo, _hi, 0, 1, 2, 3, 4, 5, 6, 7); } } } while (0)
#define PG8_LDB(dst, b, h) do { _Pragma("unroll") for (int n = 0; n < 2; ++n) { if constexpr (ESZ == 2) { _Pragma("unroll") for (int k = 0; k < 2; ++k) dst.v[n][k] = *(const LAS bf16x8*)(lds + PG8_SB(b, h) + boff + n * 2048 + k * 1024); } \
        else { const v4i_t _lo = *(const LAS v4i_t*)(lds + PG8_SB(b, h) + boff + n * 2048), _hi = *(const LAS v4i_t*)(lds + PG8_SB(b, h) + boff + n * 2048 + 1024); dst.v[n] = __builtin_shufflevector(_lo, _hi, 0, 1, 2, 3, 4, 5, 6, 7); } } } while (0)
#define PG8_MMA(ai, bj, At, Bt) do { __builtin_amdgcn_s_setprio(1); _Pragma("unroll") for (int m = 0; m < 4; ++m) _Pragma("unroll") for (int n = 0; n < 2; ++n) { \
        if constexpr (ESZ == 2) { _Pragma("unroll") for (int k = 0; k < 2; ++k) acc[ai][bj][m][n] = __builtin_amdgcn_mfma_f32_16x16x32_bf16(Bt.v[n][k], At.v[m][k], acc[ai][bj][m][n], 0, 0, 0); } \
        else { mfma_f8(acc[ai][bj][m][n], Bt.v[n], At.v[m]); } } \
        __builtin_amdgcn_s_setprio(0); } while (0)
#define PG8_WAIT_V(n) asm volatile("s_waitcnt vmcnt(" #n ")" ::: "memory")
#define PG8_WAIT_V8R do { if (relax) asm volatile("s_waitcnt vmcnt(%0)" :: "n"(8 + Epi::NSTORE) : "memory"); else PG8_WAIT_V(8); } while (0)
#define PG8_WAIT_L(n) asm volatile("s_waitcnt lgkmcnt(" #n ")" ::: "memory")
#define PG8_BAR __builtin_amdgcn_s_barrier()
#define PG8_SCHED __builtin_amdgcn_sched_barrier(0)
    Unit cur, nxt; int ui = 0;
    if (!S.next(0, cur)) return;
    f32x4 acc[2][2][4][2];
#pragma unroll
    for (int a = 0; a < 2; ++a)
#pragma unroll
        for (int b = 0; b < 2; ++b)
#pragma unroll
            for (int m = 0; m < 4; ++m)
#pragma unroll
                for (int n = 0; n < 2; ++n) acc[a][b][m][n] = (f32x4){0.f, 0.f, 0.f, 0.f};
    typedef typename FragT<ESZ>::A4 FragA; typedef typename FragT<ESZ>::B2 FragB;
    FragA At; FragB B0, B1;
    unsigned caoff[2][2] = {{0u, 0u}, {0u, 0u}}, naoff[2][2] = {{0u, 0u}, {0u, 0u}};
    if constexpr (GATHER) {
#pragma unroll
        for (int h = 0; h < 2; ++h)
#pragma unroll
            for (int i = 0; i < 2; ++i) { caoff[h][i] = S.arow(cur, h * HALF + Rr[i]) + (unsigned)Cb[i]; naoff[h][i] = caoff[h][i]; }
    }
    const char* cA = S.baseA(cur); const char* cB = S.baseB(cur);
    PG8_STAGE(PG8_SB(0, 0), cB, voffB); PG8_STAGE(PG8_SB(0, 1), cB + hstepB, voffB); PG8_STAGE_A(PG8_SA(0, 0), cA, 0, false); PG8_STAGE_A(PG8_SA(0, 1), cA, 1, false);
    if (wr == 1) PG8_BAR;
    PG8_WAIT_V(2); PG8_BAR;
    PG8_STAGE(PG8_SB(1, 0), cB + kstep, voffB); PG8_STAGE_A(PG8_SA(1, 0), cA + kstep, 0, false); PG8_STAGE(PG8_SB(1, 1), cB + hstepB + kstep, voffB);
    PG8_WAIT_V(6); PG8_BAR;
    for (;;) {
        const bool has_next = S.next(ui + 1, nxt);
        const char* nA = has_next ? S.baseA(nxt) : cA; const char* nB = has_next ? S.baseB(nxt) : cB;
        if constexpr (GATHER) {
            if (has_next) {
#pragma unroll
                for (int h = 0; h < 2; ++h)
#pragma unroll
                    for (int i = 0; i < 2; ++i) naoff[h][i] = S.arow(nxt, h * HALF + Rr[i]) + (unsigned)Cb[i];
            } else {
#pragma unroll
                for (int h = 0; h < 2; ++h)
#pragma unroll
                    for (int i = 0; i < 2; ++i) naoff[h][i] = caoff[h][i];
            }
        }
        if (prof) pf_t0 = clock64();
        if constexpr (EpiTouch<Epi>::v) E.touch(cur, lds, tid, wid);
        int ntu = nt; if constexpr (SchedVarK<Sched>::v) ntu = S.ktiles(cur);
#pragma unroll 1
        for (int t = 0; t < ntu; t += 2) {
            const bool last = (t == ntu - 2);
            const bool relax = (Epi::NSTORE > 0) && (t == 0) && (ui > 0);
            const char* a1 = cA + (size_t)(t + 1) * kstep;
            const char* a2 = last ? nA : cA + (size_t)(t + 2) * kstep; const char* b2 = last ? nB : cB + (size_t)(t + 2) * kstep;
            const char* a3 = a2 + kstep; const char* b3 = b2 + kstep;
            PG8_LDB(B0, 0, 0); PG8_LDB(B1, 0, 1); PG8_SCHED; PG8_LDA(At, 0, 0); PG8_STAGE_A(PG8_SA(1, 1), a1, 1, false);
            PG8_WAIT_V(8); PG8_WAIT_L(0); PG8_BAR; PG8_MMA(0, 0, At, B0); PG8_MMA(0, 1, At, B1); PG8_BAR; PG8_SCHED;
            PG8_LDA(At, 0, 1); PG8_STAGE(PG8_SB(0, 0), b2, voffB); PG8_STAGE(PG8_SB(0, 1), b2 + hstepB, voffB); PG8_STAGE_A(PG8_SA(0, 0), a2, 0, last);
            PG8_WAIT_V(8); PG8_WAIT_L(0); PG8_BAR; PG8_MMA(1, 0, At, B0); PG8_MMA(1, 1, At, B1); PG8_BAR; PG8_SCHED;
            PG8_LDB(B0, 1, 0); PG8_LDB(B1, 1, 1); PG8_SCHED; PG8_LDA(At, 1, 0); PG8_STAGE_A(PG8_SA(0, 1), a2, 1, last);
            PG8_WAIT_V(8); PG8_WAIT_L(0); PG8_BAR; PG8_MMA(0, 0, At, B0); PG8_MMA(0, 1, At, B1); PG8_BAR; PG8_SCHED;
            PG8_LDA(At, 1, 1); PG8_STAGE(PG8_SB(1, 0), b3, voffB); PG8_STAGE(PG8_SB(1, 1), b3 + hstepB, voffB); PG8_STAGE_A(PG8_SA(1, 0), a3, 0, last);
            PG8_WAIT_V(8); PG8_WAIT_L(0); PG8_BAR; PG8_MMA(1, 0, At, B0); PG8_MMA(1, 1, At, B1); PG8_BAR; PG8_SCHED;
        }
        if (prof) { pf_t1 = clock64(); pf_kl += pf_t1 - pf_t0; }
        if constexpr (ESZ == 1) asm volatile("s_nop 15\n\ts_nop 15" ::: "memory");
        if constexpr (ALIGN_EPI) { if (wr == 0) PG8_BAR; }
        if constexpr (!Epi::AFTER_DRAIN) { int fr_e = fr, fq_e = fq; asm volatile("" : "+v"(fr_e), "+v"(fq_e));
            E(acc, cur, wr, wc, fr_e, fq_e); }
        if (prof) { pf_ep += clock64() - pf_t1; ++pf_n; }
        if (!has_next) break;
        bool zero = true; if constexpr (EpiKeep<Epi>::v) zero = !E.keep(cur);
        if (zero) {
#pragma unroll
        for (int a = 0; a < 2; ++a)
#pragma unroll
            for (int b = 0; b < 2; ++b)
#pragma unroll
                for (int m = 0; m < 4; ++m)
#pragma unroll
                    for (int n = 0; n < 2; ++n) acc[a][b][m][n] = (f32x4){0.f, 0.f, 0.f, 0.f};
        }
        cur = nxt; cA = nA; cB = nB; ++ui;
        if constexpr (GATHER) {
#pragma unroll
            for (int h = 0; h < 2; ++h)
#pragma unroll
                for (int i = 0; i < 2; ++i) caoff[h][i] = naoff[h][i];
        }
        if constexpr (ALIGN_EPI) { if (wr == 1) PG8_BAR; }
    }
    PG8_WAIT_V(0);
    if constexpr (!ALIGN_EPI) { if (wr == 0) PG8_BAR; }
    PG8_BAR;
    if (prof && blockIdx.x == PROFBLK && tid == 0) { prof[0] = pf_kl; prof[1] = pf_ep; prof[2] = pf_n; prof[3] = (unsigned long long)nt; prof[4] = clock64() - pf_c0; prof[5] = wall_clock64() - pf_w0; }
    if constexpr (Epi::AFTER_DRAIN) { int fr_e = fr, fq_e = fq; asm volatile("" : "+v"(fr_e), "+v"(fq_e)); E.fused(acc, cur, wr, wc, fr_e, fq_e, lds, wid, lane); }
#undef PG8_SA
#undef PG8_SB
#undef PG8_STAGE
#undef PG8_STAGE_A
#undef PG8_LDA
#undef PG8_LDB
#undef PG8_MMA
#undef PG8_WAIT_V
#undef PG8_WAIT_V8R
#undef PG8_WAIT_L
#undef PG8_BAR
#undef PG8_SCHED
}
constexpr int NXCD = 8;
#ifndef GATE_STASH
#define GATE_STASH 1
#endif
#ifndef RES_FROM_H
#define RES_FROM_H 1
#endif
#ifndef EPI_TOUCH
#define EPI_TOUCH 0
#endif
#ifndef PROJ_WGM
#define PROJ_WGM 8
#endif
__device__ __forceinline__ void static_tile(int L, int nM, int nN, int& pm, int& pn, const int WGM = 8) {
    const int nwg = nM * nN; int wgid = L;
    { const int q = nwg / NXCD, r = nwg % NXCD, xcd = wgid % NXCD, off = wgid / NXCD; wgid = (xcd < r ? xcd * (q + 1) : r * (q + 1) + (xcd - r) * q) + off; }
    const int nig = WGM * nN, gid = wgid / nig, fm = gid * WGM, gsz = (nM - fm) < WGM ? (nM - fm) : WGM;
    pm = fm + ((wgid % nig) % gsz); pn = (wgid % nig) / gsz;
}
struct SchedPlain {
    static constexpr bool GATHER = false;
    const char* A; const char* Bt; size_t tstepA, tstepB; int nM, nN; int r0 = 0, r1 = 1 << 20;
    __device__ __forceinline__ bool next(int i, Unit& u) const { const int k = i + r0; if (k >= r1) return false;
        const int L = k * (int)gridDim.x + (int)blockIdx.x; if (L >= nM * nN) return false; static_tile(L, nM, nN, u.pm, u.pn); u.z = 0; return true; }
    __device__ __forceinline__ const char* baseA(const Unit& u) const { return A + (size_t)u.pm * tstepA; }
    __device__ __forceinline__ const char* baseB(const Unit& u) const { return Bt + (size_t)u.pn * tstepB; }
    __device__ __forceinline__ unsigned arow(const Unit&, int) const { return 0u; }
};
struct SchedProj {
    static constexpr bool GATHER = false;
    const unsigned char* ws; int r0, r1;
    __device__ __forceinline__ bool next(int i, Unit& u) const {
        if (i + r0 >= r1) return false;
        const int L = (i + r0) * (int)gridDim.x + (int)blockIdx.x;
        constexpr int NPB = GATES_F8 ? 18 : 42;
        if (L < 64 * NPB) { static_tile(L, 64, NPB, u.pm, u.pn, PROJ_WGM); u.z = (u.pn == 13) ? 2 : 0; return true; }
        const int L2 = L - 64 * NPB; if (L2 >= 64) return false;
        if (L2 < 32) { u.pm = L2 & 7; u.pn = L2 >> 3; u.z = 1; } else { u.pm = (L2 - 32) & 3; u.pn = (L2 - 32) >> 2; u.z = 3; }
        return true;
    }
    __device__ __forceinline__ const char* baseA(const Unit& u) const {
        const size_t ts = (size_t)256 * LDP * 2;
        if (u.z == 0) return (const char*)ws + WS_H + (size_t)u.pm * ts;
        if (u.z == 2) return (const char*)ws + WS_WINT + (size_t)13 * ts;
        if (u.z == 1) return (const char*)ws + WS_MEMBF + (size_t)u.pm * ts;
        return (const char*)ws + WS_WMKVT + (size_t)(4 + u.pm) * ts;
    }
    __device__ __forceinline__ const char* baseB(const Unit& u) const {
        const size_t ts = (size_t)256 * LDP * 2;
        if (u.z == 0) return (const char*)ws + WS_WINT + (size_t)u.pn * ts;
        if (u.z == 2) return (const char*)ws + WS_H + (size_t)u.pm * ts;
        if (u.z == 1) return (const char*)ws + WS_WMKVT + (size_t)u.pn * ts;
        return (const char*)ws + WS_MEMBF + (size_t)u.pn * ts;
    }
    __device__ __forceinline__ unsigned arow(const Unit&, int) const { return 0u; }
};
struct SchedGates8 {
    static constexpr bool GATHER = false;
    const unsigned char* ws; int r0, r1;
    __device__ __forceinline__ bool next(int i, Unit& u) const {
        if (i + r0 >= r1) return false;
        const int L = (i + r0) * (int)gridDim.x + (int)blockIdx.x; if (L >= 64 * 24) return false;
        static_tile(L, 64, 24, u.pm, u.pn, PROJ_WGM); u.z = 0; return true;
    }
    __device__ __forceinline__ const char* baseA(const Unit& u) const { return (const char*)ws + WS_H8 + (size_t)u.pm * (256 * 2048); }
    __device__ __forceinline__ const char* baseB(const Unit& u) const { return (const char*)ws + WS_WINQ + (size_t)u.pn * (256 * 2048); }
    __device__ __forceinline__ unsigned arow(const Unit&, int) const { return 0u; }
};
struct SchedChan {
    static constexpr bool GATHER = false;
    const unsigned char* ws; int u0, nu;
    __device__ __forceinline__ bool next(int i, Unit& u) const {
        const int L = i * (int)gridDim.x + vwg();
        if constexpr (SEQFOLD) { if (L >= 32 * 8) return false; u.z = L >> 3; u.pn = L & 7; u.pm = ((u.pn & 3) >= 2) ? 1 : 0; u.idx = i; return true; }
        if (L >= 512) return false;
        u.z = L >> 4; u.pm = (L >> 3) & 1; u.pn = L & 7; return true;
    }
    __device__ __forceinline__ const char* baseA(const Unit& u) const { return (const char*)ws + WS_TABT + (size_t)u.pm * (256 * 256 * 2); }
    __device__ __forceinline__ const char* baseB(const Unit& u) const {
        if constexpr (SEQFOLD) return (const char*)ws + WS_XF + (size_t)(vwg() * 2 + u.idx) * (256 * 256 * 2);
        const int b = u.z >> 2, g = u.z & 3; return (const char*)ws + WS_FIN + ((size_t)(b * 2048 + u.pn * 256) * 1024 + g * 256) * 2; }
    __device__ __forceinline__ unsigned arow(const Unit&, int) const { return 0u; }
};
struct SchedSeq {
    static constexpr bool GATHER = false;
    const unsigned char* ws;
    __device__ __forceinline__ bool next(int i, Unit& u) const {
        const int L = i * (int)gridDim.x + vwg(); if (L >= 256) return false;
        u.z = L >> 3; u.pm = L & 7; u.pn = 0; return true;
    }
    __device__ __forceinline__ const char* baseA(const Unit& u) const { return (const char*)ws + WS_DMAT + (size_t)u.pm * ((size_t)256 * DQP * 2); }
    __device__ __forceinline__ const char* baseB(const Unit& u) const { return (const char*)ws + WS_ZT + (size_t)u.z * ((size_t)256 * SQP * 2) + (SEQFOLD ? (size_t)(u.pm >> 2) * 1024 * 2 : (size_t)0); }
    __device__ __forceinline__ unsigned arow(const Unit&, int) const { return 0u; }
};
struct SchedOne {
    static constexpr bool GATHER = false;
    const char* A; const char* Bt; int z; bool valid;
    __device__ __forceinline__ bool next(int i, Unit& u) const { if (i != 0 || !valid) return false; u.pm = 0; u.pn = 0; u.z = z; return true; }
    __device__ __forceinline__ const char* baseA(const Unit&) const { return A; }
    __device__ __forceinline__ const char* baseB(const Unit&) const { return Bt; }
    __device__ __forceinline__ unsigned arow(const Unit&, int) const { return 0u; }
};
template <bool GATH, int NT  , bool F8>
struct SchedMoe {
    static constexpr bool GATHER = GATH;
    static constexpr int ES = F8 ? 1 : 2;
    const unsigned char* ws; const LAS int* pt; const LAS int* cn; int same = 0;
    int r0 = 0, r1 = 1 << 20;
    __device__ __forceinline__ int ptu(int k) const { return __builtin_amdgcn_readfirstlane(pt[k]); }
    __device__ __forceinline__ bool next(int i, Unit& u) const {
        const int k = i + r0; if (k >= r1) return false;
        const int L = k * (int)gridDim.x + vwg(); const int total = ptu(NE) * NT; if (L >= total) return false;
        const int ln = (int)(threadIdx.x & 63);
        const unsigned long long bal = __ballot(ln < NE && L >= pt[ln & 31] * NT);
        const int e = __builtin_amdgcn_readfirstlane(__popcll(bal) - 1);
        const int t = L - ptu(e) * NT, mte = ptu(e + 1) - ptu(e);
        u.z = e; u.pm = t % mte; u.pn = t / mte; u.idx = k; return true;
    }
    __device__ __forceinline__ const char* baseA(const Unit& u) const {
        if constexpr (GATH) return (const char*)ws + (F8 ? WS_H2Q : WS_H2);
        else return (const char*)ws + (F8 ? WS_ACTQ : WS_ACT) + (same ? (size_t)0 : (size_t)(ptu(u.z) + u.pm) * (256 * 2048 * ES));
    }
    __device__ __forceinline__ const char* baseB(const Unit& u) const {
        if constexpr (GATH) return (const char*)ws + (F8 ? WS_WGUQ : WS_WGUT) + ((size_t)u.z * 4096 + (size_t)u.pn * 256) * (2048 * ES);
        else return (const char*)ws + (F8 ? WS_WDNQ : WS_WDNT) + (same ? (size_t)0 : ((size_t)u.z * 2048 + (size_t)u.pn * 256) * (2048 * ES));
    }
    __device__ __forceinline__ unsigned arow(const Unit& u, int r) const {
        const LAS unsigned short* tokl = (const LAS unsigned short*)((const LAS unsigned char*)pt - LDS_MISC + LDS_TOKL);
        return (unsigned)tokl[u.idx * 256 + r] * (unsigned)(2048 * ES);
    }
};

__device__ __forceinline__ void store_tile_bf16(const f32x4 (&acc)[2][2][4][2], bf16_t* dst  , size_t ldc, int wr, int wc, int fr, int fq) {
    const int row0 = wr * 64 + fr, col0 = wc * 32 + 8 * fq;
#pragma unroll
    for (int ai = 0; ai < 2; ++ai)
#pragma unroll
        for (int m = 0; m < 4; ++m) { bf16_t* rowp = dst + (size_t)(row0 + ai * HALF + m * 16) * ldc + col0;
#pragma unroll
            for (int bj = 0; bj < 2; ++bj) { const f32x4 v0 = acc[ai][bj][m][0], v1 = acc[ai][bj][m][1];
                u32x4 w; w.x = cvtpk(v0[0], v0[1]); w.y = cvtpk(v0[2], v0[3]); w.z = cvtpk(v1[0], v1[1]); w.w = cvtpk(v1[2], v1[3]);
                *(u32x4*)(rowp + bj * HALF) = w; } }
}
struct EpiProj {
    static constexpr bool PERM = true, AFTER_DRAIN = false; static constexpr int NSTORE = 16;
    unsigned char* ws;
    __device__ __forceinline__ void operator()(const f32x4 (&acc)[2][2][4][2], const Unit& u, int wr, int wc, int fr, int fq) const {
        const int pn = u.pn, pm = u.pm;
        bf16_t* dst; size_t ldc;
        if (u.z == 0) {
            if (pn >= 18) {
                dst = (bf16_t*)(ws + WS_GATES) + (size_t)pm * 256 * 6144 + (pn - 18) * 256;
                const int row0 = wr * 64 + fr, col0 = wc * 32 + 8 * fq;
#pragma unroll
                for (int ai = 0; ai < 2; ++ai)
#pragma unroll
                    for (int m = 0; m < 4; ++m) { bf16_t* rowp = dst + (size_t)(row0 + ai * HALF + m * 16) * 6144 + col0;
#pragma unroll
                        for (int bj = 0; bj < 2; ++bj) { const f32x4 v0 = acc[ai][bj][m][0], v1 = acc[ai][bj][m][1];
                            u32x4 w; w.x = cvtpk(sigmoidf_(v0[0]), sigmoidf_(v0[1])); w.y = cvtpk(sigmoidf_(v0[2]), sigmoidf_(v0[3]));
                            w.z = cvtpk(sigmoidf_(v1[0]), sigmoidf_(v1[1])); w.w = cvtpk(sigmoidf_(v1[2]), sigmoidf_(v1[3]));
                            *(u32x4*)(rowp + bj * HALF) = w; } }
                return;
            }
            if (pn < 4) { dst = (bf16_t*)(ws + WS_FIN) + pn * 256; ldc = 1024; }
            else if (pn < 12) { dst = (bf16_t*)(ws + WS_Q) + (pn - 4) * 256; ldc = 2048; }
            else if (pn == 12) { dst = (bf16_t*)(ws + WS_K); ldc = 256; }
            else { dst = (bf16_t*)(ws + WS_QM) + (pn - 14) * 256; ldc = 1024; }
            dst += (size_t)pm * 256 * ldc;
        } else if (u.z == 2) {
            dst = (bf16_t*)(ws + WS_VT) + (size_t)(pm >> 3) * 256 * 2048 + (size_t)(pm & 7) * 256; ldc = 2048;
        } else if (u.z == 1) {
            dst = (bf16_t*)(ws + WS_KMK) + (size_t)pm * 256 * 1024 + pn * 256; ldc = 1024;
        } else {
            dst = (bf16_t*)(ws + WS_VMT) + (size_t)(pn * 4 + pm) * 256 * 256; ldc = 256;
        }
        store_tile_bf16(acc, dst, ldc, wr, wc, fr, fq);
    }
};
__device__ __forceinline__ unsigned pk_u8x4(float a, float b, float c, float d) {
    const unsigned x = (unsigned)(a * 255.0f + 0.5f), y = (unsigned)(b * 255.0f + 0.5f), z = (unsigned)(c * 255.0f + 0.5f), w = (unsigned)(d * 255.0f + 0.5f);
    return x | (y << 8) | (z << 16) | (w << 24); }
struct EpiGates8 {
    static constexpr int PERM = 2; static constexpr bool AFTER_DRAIN = false; static constexpr int NSTORE = 8;
    unsigned char* ws;
    __device__ __forceinline__ void operator()(const f32x4 (&acc)[2][2][4][2], const Unit& u, int wr, int wc, int fr, int fq) const {
        unsigned char* dst = ws + WS_GATES + (size_t)u.pm * 256 * 6144 + u.pn * 256;
        const int row0 = wr * 64 + fr, col0 = wc * 64 + 16 * fq;
#pragma unroll
        for (int ai = 0; ai < 2; ++ai)
#pragma unroll
            for (int m = 0; m < 4; ++m) {
                u32x4 w;
                { const f32x4 a = acc[ai][0][m][0] * WQ_INV, c = acc[ai][0][m][1] * WQ_INV;
                  w.x = pk_u8x4(sigmoidf_(a[0]), sigmoidf_(a[1]), sigmoidf_(a[2]), sigmoidf_(a[3])); w.y = pk_u8x4(sigmoidf_(c[0]), sigmoidf_(c[1]), sigmoidf_(c[2]), sigmoidf_(c[3])); }
                { const f32x4 a = acc[ai][1][m][0] * WQ_INV, c = acc[ai][1][m][1] * WQ_INV;
                  w.z = pk_u8x4(sigmoidf_(a[0]), sigmoidf_(a[1]), sigmoidf_(a[2]), sigmoidf_(a[3])); w.w = pk_u8x4(sigmoidf_(c[0]), sigmoidf_(c[1]), sigmoidf_(c[2]), sigmoidf_(c[3])); }
                *(u32x4*)(dst + (size_t)(row0 + ai * HALF + m * 16) * 6144 + col0) = w; }
    }
};
struct EpiChan {
    static constexpr bool PERM = true, AFTER_DRAIN = false; static constexpr int NSTORE = 0;
    unsigned char* ws;
    __device__ __forceinline__ void operator()(const f32x4 (&acc)[2][2][4][2], const Unit& u, int wr, int wc, int fr, int fq) const {
        store_tile_bf16(acc, (bf16_t*)(ws + WS_ZT) + (size_t)u.z * 256 * SQP + (SEQFOLD ? (size_t)(u.pn >> 2) * 1024 + (u.pn & 3) * 256 : (size_t)u.pm * 2048 + u.pn * 256), SQP, wr, wc, fr, fq);
    }
};
struct EpiSeq {
    static constexpr bool PERM = true, AFTER_DRAIN = false; static constexpr int NSTORE = 0;
    unsigned char* ws;
    __device__ __forceinline__ void operator()(const f32x4 (&acc)[2][2][4][2], const Unit& u, int wr, int wc, int fr, int fq) const {
        const int b = u.z >> 2, g = u.z & 3;
        if constexpr (SEQFOLD) { const int par = u.pm >> 2, jt = u.pm & 3;
            store_tile_bf16(acc, (bf16_t*)(ws + WS_FX) + (size_t)(b * 2048 + 512 * jt + par) * 2048 + g * 256, 2 * 2048, wr, wc, fr, fq); }
        else store_tile_bf16(acc, (bf16_t*)(ws + WS_FX) + (size_t)(b * 2048 + u.pm * 256) * 2048 + g * 256, 2048, wr, wc, fr, fq);
    }
};
template <int STEP> struct EpiMix {
    static constexpr int PERM = 1; static constexpr bool AFTER_DRAIN = false; static constexpr int NSTORE = 16;
    unsigned char* ws;
    __device__ __forceinline__ void operator()(const f32x4 (&acc)[2][2][4][2], const Unit& u, int wr, int wc, int fr, int fq) const {
        const int row0 = u.pm * 256 + wr * 64 + fr, col0 = u.pn * 256 + wc * 32 + 8 * fq;
        const bf16_t* gates = (const bf16_t*)(ws + WS_GATES) + STEP * 2048; const unsigned char* gates8 = ws + WS_GATES + STEP * 2048;
        bf16_t* macc = (bf16_t*)(ws + WS_MIXACC); bf16_t* mixed = (bf16_t*)(ws + WS_MIXED);
#pragma unroll
        for (int ai = 0; ai < 2; ++ai) {
            u32x2 g8[4][2]; u32x4 gw[4][2]; u32x4 mw[4][2];
#pragma unroll
            for (int m = 0; m < 4; ++m) { const size_t row = (size_t)(row0 + ai * HALF + m * 16);
#pragma unroll
                for (int bj = 0; bj < 2; ++bj) { const int col = col0 + bj * HALF;
                    if constexpr (GATES_F8) g8[m][bj] = *(const u32x2*)(gates8 + row * 6144 + col); else gw[m][bj] = *(const u32x4*)(gates + row * 6144 + col);
                    if (STEP > 0) mw[m][bj] = *(const u32x4*)(macc + row * 2048 + col); } }
#pragma unroll
            for (int m = 0; m < 4; ++m) { const size_t row = (size_t)(row0 + ai * HALF + m * 16);
#pragma unroll
                for (int bj = 0; bj < 2; ++bj) { const int col = col0 + bj * HALF;
                    f32x4 v0 = acc[ai][bj][m][0], v1 = acc[ai][bj][m][1];
                    if constexpr (GATES_F8) { const u32x2 g = g8[m][bj]; const float k = 1.0f / 255.0f;
                        v0[0] *= (float)(g.x & 255u) * k; v0[1] *= (float)((g.x >> 8) & 255u) * k; v0[2] *= (float)((g.x >> 16) & 255u) * k; v0[3] *= (float)(g.x >> 24) * k;
                        v1[0] *= (float)(g.y & 255u) * k; v1[1] *= (float)((g.y >> 8) & 255u) * k; v1[2] *= (float)((g.y >> 16) & 255u) * k; v1[3] *= (float)(g.y >> 24) * k; }
                    else { const u32x4 g = gw[m][bj];
                        v0[0] *= bflo(g.x); v0[1] *= bfhi(g.x); v0[2] *= bflo(g.y); v0[3] *= bfhi(g.y);
                        v1[0] *= bflo(g.z); v1[1] *= bfhi(g.z); v1[2] *= bflo(g.w); v1[3] *= bfhi(g.w); }
                    if (STEP > 0) { const u32x4 q = mw[m][bj];
                        v0[0] += bflo(q.x); v0[1] += bfhi(q.x); v0[2] += bflo(q.y); v0[3] += bfhi(q.y);
                        v1[0] += bflo(q.z); v1[1] += bfhi(q.z); v1[2] += bflo(q.w); v1[3] += bfhi(q.w); }
                    u32x4 w; w.x = cvtpk(v0[0], v0[1]); w.y = cvtpk(v0[2], v0[3]); w.z = cvtpk(v1[0], v1[1]); w.w = cvtpk(v1[2], v1[3]);
                    *(u32x4*)((STEP < 2 ? macc : mixed) + row * 2048 + col) = w; } }
        }
    }
};
struct SchedMix {
    static constexpr bool GATHER = false; static constexpr bool VARK = true;
    const unsigned char* ws; int r0, r1;
    __device__ __forceinline__ bool next(int i, Unit& u) const {
        const int tr = r0 + i / 3; if (tr >= r1) return false;
        const int L = tr * (int)gridDim.x + (int)blockIdx.x; if (L >= 64 * 8) return false;
        static_tile(L, 64, 8, u.pm, u.pn); u.z = i % 3; return true;
    }
    __device__ __forceinline__ int ktiles(const Unit& u) const { return u.z == 1 ? 32 : 16; }
    __device__ __forceinline__ const char* baseA(const Unit& u) const {
        const size_t ts = (size_t)256 * 2048 * 2;
        return (const char*)ws + (u.z == 1 ? WS_ATT : WS_FX + (u.z == 2 ? 2048 : 0)) + (size_t)u.pm * ts;
    }
    __device__ __forceinline__ const char* baseB(const Unit& u) const {
        const size_t ts = (size_t)256 * 2048 * 2;
        return (const char*)ws + (u.z == 1 ? WS_WAOT : WS_WFM + (u.z == 2 ? 2048 : 0)) + (size_t)u.pn * ts;
    }
    __device__ __forceinline__ unsigned arow(const Unit&, int) const { return 0u; }
};
struct EpiMixF {
    static constexpr int PERM = 1; static constexpr bool AFTER_DRAIN = false, KEEP = true; static constexpr int NSTORE = 16;
    unsigned char* ws; LAS unsigned char* lds;
    __device__ __forceinline__ bool keep(const Unit& u) const { return u.z < 2; }
    static constexpr bool TOUCH = EPI_TOUCH;
    __device__ __forceinline__ void touch(const Unit& u, LAS unsigned char* lds, int tid, int wid) const {
        if (u.z != 0) return;
        const unsigned char* q = ws + WS_GATES + (size_t)(u.pm * 256 + (tid >> 1)) * 6144 + u.pn * 256 + (tid & 1) * 128;
#pragma unroll
        for (int s = 0; s < 3; ++s) __builtin_amdgcn_global_load_lds((const unsigned*)(q + s * 2048), (LAS unsigned*)(lds + LDS_BTAB + wid * 1024 + s * 256), 4, 0, 0);
    }
    static __device__ __forceinline__ float gb(unsigned w, int k) { return (float)((w >> (8 * k)) & 255u); }
    static constexpr int STASH_N = (LDS_XBW - STAGE_BYTES) / 8;
    __device__ __forceinline__ void operator()(f32x4 (&acc)[2][2][4][2], const Unit& u, int wr, int wc, int fr, int fq) const {
        const int row0 = u.pm * 256 + wr * 64 + fr, col0 = u.pn * 256 + wc * 32 + 8 * fq;
        const int seg = __builtin_amdgcn_readfirstlane(u.z);
        const int tidx = (wr * 4 + wc) * 64 + fq * 16 + fr;
        LAS u32x2* stash = (LAS u32x2*)(lds + STAGE_BYTES);
        const unsigned char* gnum = ws + WS_GATES + seg * 2048;
        bf16_t* mixed = (bf16_t*)(ws + WS_MIXED);
        if (seg < 2) {
#pragma unroll
            for (int ai = 0; ai < 2; ++ai) {
                u32x2 gn[4][2], gd[4][2];
#pragma unroll
                for (int m = 0; m < 4; ++m) { const size_t row = (size_t)(row0 + ai * HALF + m * 16);
#pragma unroll
                    for (int bj = 0; bj < 2; ++bj) { const unsigned char* q = gnum + row * 6144 + col0 + bj * HALF; const int e = (m * 2 + bj) * 512 + tidx;
                        if (GATE_STASH && ai == 0 && seg == 1 && e < STASH_N) gn[m][bj] = stash[e]; else gn[m][bj] = *(const u32x2*)q;
                        gd[m][bj] = *(const u32x2*)(q + 2048); } }
                if (GATE_STASH && ai == 0) {
#pragma unroll
                    for (int m = 0; m < 4; ++m)
#pragma unroll
                        for (int bj = 0; bj < 2; ++bj) { const int e = (m * 2 + bj) * 512 + tidx; if (e < STASH_N) stash[e] = gd[m][bj]; }
                }
#pragma unroll
                for (int m = 0; m < 4; ++m)
#pragma unroll
                    for (int bj = 0; bj < 2; ++bj) {
#pragma unroll
                        for (int k = 0; k < 4; ++k) {
                            const float n0 = (seg == 0) ? gb(gn[m][bj].x, k) : fmaxf(gb(gn[m][bj].x, k), 0.5f), n1 = (seg == 0) ? gb(gn[m][bj].y, k) : fmaxf(gb(gn[m][bj].y, k), 0.5f);
                            acc[ai][bj][m][0][k] *= n0 * __builtin_amdgcn_rcpf(fmaxf(gb(gd[m][bj].x, k), 0.5f));
                            acc[ai][bj][m][1][k] *= n1 * __builtin_amdgcn_rcpf(fmaxf(gb(gd[m][bj].y, k), 0.5f)); } }
            }
        } else {
#pragma unroll
            for (int ai = 0; ai < 2; ++ai) {
                u32x2 gn[4][2];
#pragma unroll
                for (int m = 0; m < 4; ++m) { const size_t row = (size_t)(row0 + ai * HALF + m * 16);
#pragma unroll
                    for (int bj = 0; bj < 2; ++bj) { const int e = (m * 2 + bj) * 512 + tidx;
                        if (GATE_STASH && ai == 0 && e < STASH_N) gn[m][bj] = stash[e]; else gn[m][bj] = *(const u32x2*)(gnum + row * 6144 + col0 + bj * HALF); } }
#pragma unroll
                for (int m = 0; m < 4; ++m) { const size_t row = (size_t)(row0 + ai * HALF + m * 16);
#pragma unroll
                    for (int bj = 0; bj < 2; ++bj) { const float kq = 1.0f / 255.0f; f32x4 v0 = acc[ai][bj][m][0], v1 = acc[ai][bj][m][1];
#pragma unroll
                        for (int k = 0; k < 4; ++k) { v0[k] *= fmaxf(gb(gn[m][bj].x, k), 0.5f) * kq; v1[k] *= fmaxf(gb(gn[m][bj].y, k), 0.5f) * kq; }
                        u32x4 w; w.x = cvtpk(v0[0], v0[1]); w.y = cvtpk(v0[2], v0[3]); w.z = cvtpk(v1[0], v1[1]); w.w = cvtpk(v1[2], v1[3]);
                        *(u32x4*)(mixed + row * 2048 + col0 + bj * HALF) = w; } }
            }
        }
    }
};
struct EpiRes {
    static constexpr int PERM = 1; static constexpr bool AFTER_DRAIN = false; static constexpr int NSTORE = 16;
    const float* x; bf16_t* x2; const bf16_t* h; const float* irs; const float* g1;
    static constexpr bool TOUCH = EPI_TOUCH;
    __device__ __forceinline__ void touch(const Unit& u, LAS unsigned char* lds, int tid, int wid) const {
        const unsigned char* q = (const unsigned char*)(x + (size_t)(u.pm * 256 + (tid >> 1)) * 2048 + u.pn * 256) + (tid & 1) * 512;
#pragma unroll
        for (int j = 0; j < 4; ++j) __builtin_amdgcn_global_load_lds((const unsigned*)(q + j * 128), (LAS unsigned*)(lds + LDS_BTAB + wid * 1024 + j * 256), 4, 0, 0);
    }
    __device__ __forceinline__ void operator()(const f32x4 (&acc)[2][2][4][2], const Unit& u, int wr, int wc, int fr, int fq) const {
        const int row0 = u.pm * 256 + wr * 64 + fr, col0 = u.pn * 256 + wc * 32 + 8 * fq;
        if constexpr (RES_FROM_H) {
            f32x4 ig[2][2]; bool bad = false;
#pragma unroll
            for (int bj = 0; bj < 2; ++bj)
#pragma unroll
                for (int n2 = 0; n2 < 2; ++n2) { const f32x4 gv = *(const f32x4*)(g1 + col0 + bj * HALF + 4 * n2);
#pragma unroll
                    for (int k = 0; k < 4; ++k) { bad |= (gv[k] == 0.f); ig[bj][n2][k] = __builtin_amdgcn_rcpf(gv[k]); } }
            if (!__any(bad)) {
#pragma unroll
                for (int ai = 0; ai < 2; ++ai) {
                    float ir[4]; u32x4 hv[4][2];
#pragma unroll
                    for (int m = 0; m < 4; ++m) { const size_t row = (size_t)(row0 + ai * HALF + m * 16); ir[m] = irs[row];
#pragma unroll
                        for (int bj = 0; bj < 2; ++bj) hv[m][bj] = *(const u32x4*)(h + row * LDP + col0 + bj * HALF); }
#pragma unroll
                    for (int m = 0; m < 4; ++m) { const size_t off = (size_t)(row0 + ai * HALF + m * 16) * 2048 + col0;
#pragma unroll
                        for (int bj = 0; bj < 2; ++bj) { const u32x4 q = hv[m][bj]; const f32x4 i0 = ig[bj][0] * ir[m], i1 = ig[bj][1] * ir[m];
                            const f32x4 v0 = acc[ai][bj][m][0] + (f32x4){bflo(q.x), bfhi(q.x), bflo(q.y), bfhi(q.y)} * i0, v1 = acc[ai][bj][m][1] + (f32x4){bflo(q.z), bfhi(q.z), bflo(q.w), bfhi(q.w)} * i1;
                            u32x4 w; w.x = cvtpk(v0[0], v0[1]); w.y = cvtpk(v0[2], v0[3]); w.z = cvtpk(v1[0], v1[1]); w.w = cvtpk(v1[2], v1[3]);
                            *(u32x4*)(x2 + off + bj * HALF) = w; } }
                }
                return;
            }
        }
#pragma unroll
        for (int ai = 0; ai < 2; ++ai) {
            f32x4 xv[4][2][2];
#pragma unroll
            for (int m = 0; m < 4; ++m) { const size_t off = (size_t)(row0 + ai * HALF + m * 16) * 2048 + col0;
#pragma unroll
                for (int bj = 0; bj < 2; ++bj) { xv[m][bj][0] = *(const f32x4*)(x + off + bj * HALF); xv[m][bj][1] = *(const f32x4*)(x + off + bj * HALF + 4); } }
#pragma unroll
            for (int m = 0; m < 4; ++m) { const size_t off = (size_t)(row0 + ai * HALF + m * 16) * 2048 + col0;
#pragma unroll
                for (int bj = 0; bj < 2; ++bj) { const f32x4 v0 = acc[ai][bj][m][0] + xv[m][bj][0], v1 = acc[ai][bj][m][1] + xv[m][bj][1];
                    u32x4 w; w.x = cvtpk(v0[0], v0[1]); w.y = cvtpk(v0[2], v0[3]); w.z = cvtpk(v1[0], v1[1]); w.w = cvtpk(v1[2], v1[3]);
                    *(u32x4*)(x2 + off + bj * HALF) = w; } }
        }
    }
};
__device__ __forceinline__ float swiglu1(float g, float up) {
    g = fminf(g, 7.0f); up = fminf(fmaxf(up, -7.0f), 7.0f);
    return (up + 1.0f) * (g * sigmoid_sc(g, -1.702f * LOG2E));
}
struct EpiSwiglu {
    static constexpr bool PERM = true, AFTER_DRAIN = false; static constexpr int NSTORE = 8;
    unsigned char* ws; const float* bgu; const LAS int* pt;
    __device__ __forceinline__ void operator()(const f32x4 (&acc)[2][2][4][2], const Unit& u, int wr, int wc, int fr, int fq) const {
        const int e = u.z; const size_t srow0 = (size_t)(__builtin_amdgcn_readfirstlane(pt[e]) + u.pm) * 256 + wr * 64 + fr;
        const int col0 = u.pn * 256 + wc * 32 + 8 * fq;
        bf16_t* act = (bf16_t*)(ws + WS_ACT);
        f32x4 bv[2][2];
#pragma unroll
        for (int bj = 0; bj < 2; ++bj)
#pragma unroll
            for (int n = 0; n < 2; ++n) bv[bj][n] = *(const f32x4*)(bgu + (size_t)e * 4096 + col0 + bj * HALF + 4 * n);
#pragma unroll
        for (int ai = 0; ai < 2; ++ai)
#pragma unroll
            for (int m = 0; m < 4; ++m) { bf16_t* rowp = act + (srow0 + ai * HALF + m * 16) * 2048 + (col0 >> 1);
#pragma unroll
                for (int bj = 0; bj < 2; ++bj) { const f32x4 v0 = acc[ai][bj][m][0] + bv[bj][0], v1 = acc[ai][bj][m][1] + bv[bj][1];
                    u32x2 w; w.x = cvtpk(swiglu1(v0[0], v0[1]), swiglu1(v0[2], v0[3])); w.y = cvtpk(swiglu1(v1[0], v1[1]), swiglu1(v1[2], v1[3]));
                    *(u32x2*)(rowp + bj * (HALF / 2)) = w; } }
    }
};
struct EpiDown {
    static constexpr bool PERM = true, AFTER_DRAIN = false; static constexpr int NSTORE = 8;
    unsigned char* ws; const float* bdn; const LAS int* pt; const LAS int* cn;
    __device__ __forceinline__ void operator()(const f32x4 (&acc)[2][2][4][2], const Unit& u, int wr, int wc, int fr, int fq) const {
        const int e = u.z; const int lrow0 = u.pm * 256 + wr * 64 + fr; const size_t srow0 = (size_t)__builtin_amdgcn_readfirstlane(pt[e]) * 256 + lrow0;
        const int col0 = u.pn * 256 + wc * 32 + 8 * fq;
        bf16_t* ys = (bf16_t*)(ws + WS_YS); const float* wl = (const float*)(ws + WS_WLIST) + (size_t)e * T_; const int cne = __builtin_amdgcn_readfirstlane(cn[e]);
        f32x4 bv[2][2];
#pragma unroll
        for (int bj = 0; bj < 2; ++bj)
#pragma unroll
            for (int n = 0; n < 2; ++n) bv[bj][n] = *(const f32x4*)(bdn + (size_t)e * 2048 + col0 + bj * HALF + 4 * n);
#pragma unroll
        for (int ai = 0; ai < 2; ++ai)
#pragma unroll
            for (int m = 0; m < 4; ++m) { const int pos = lrow0 + ai * HALF + m * 16; const float w = (pos < cne) ? wl[pos] : 0.f;
                bf16_t* rowp = ys + (srow0 + ai * HALF + m * 16) * 2048 + col0;
#pragma unroll
                for (int bj = 0; bj < 2; ++bj) { const f32x4 v0 = (acc[ai][bj][m][0] + bv[bj][0]) * w, v1 = (acc[ai][bj][m][1] + bv[bj][1]) * w;
                    u32x4 o; o.x = cvtpk(v0[0], v0[1]); o.y = cvtpk(v0[2], v0[3]); o.z = cvtpk(v1[0], v1[1]); o.w = cvtpk(v1[2], v1[3]);
                    *(u32x4*)(rowp + bj * HALF) = o; } }
    }
};
__device__ __forceinline__ unsigned pk_fp8x4(float a, float b, float c, float d) {
    int w = __builtin_amdgcn_cvt_pk_fp8_f32(a, b, 0, false); w = __builtin_amdgcn_cvt_pk_fp8_f32(c, d, w, true); return (unsigned)w; }
struct EpiSwiglu8 {
    static constexpr int PERM = 2; static constexpr bool AFTER_DRAIN = false; static constexpr int NSTORE = 8;
    unsigned char* ws; const float* bgu; const LAS int* pt;
    __device__ __forceinline__ void operator()(const f32x4 (&acc)[2][2][4][2], const Unit& u, int wr, int wc, int fr, int fq) const {
        const int e = u.z; const size_t srow0 = (size_t)(__builtin_amdgcn_readfirstlane(pt[e]) + u.pm) * 256 + wr * 64 + fr;
        const int col0 = u.pn * 256 + wc * 64 + 16 * fq;
        unsigned char* act = ws + WS_ACTQ;
        const LAS float* btab = (const LAS float*)((const LAS unsigned char*)pt - LDS_MISC + LDS_BTAB) + u.idx * 256 + wc * 64 + 16 * fq;
        f32x4 bv[2][2];
#pragma unroll
        for (int bj = 0; bj < 2; ++bj)
#pragma unroll
            for (int n = 0; n < 2; ++n) bv[bj][n] = *(const LAS f32x4*)(btab + 8 * bj + 4 * n);
#pragma unroll
        for (int ai = 0; ai < 2; ++ai)
#pragma unroll
            for (int m = 0; m < 4; ++m) {
                float o[8];
#pragma unroll
                for (int bj = 0; bj < 2; ++bj)
#pragma unroll
                    for (int n = 0; n < 2; ++n) { const f32x4 v = acc[ai][bj][m][n] * WQ_INV + bv[bj][n]; o[4 * bj + 2 * n] = swiglu1(v[0], v[1]); o[4 * bj + 2 * n + 1] = swiglu1(v[2], v[3]); }
                u32x2 w; w.x = pk_fp8x4(o[0], o[1], o[2], o[3]); w.y = pk_fp8x4(o[4], o[5], o[6], o[7]);
                *(u32x2*)(act + (srow0 + ai * HALF + m * 16) * 2048 + (col0 >> 1)) = w; }
    }
};
struct EpiDown8 {
    static constexpr int PERM = 2; static constexpr bool AFTER_DRAIN = false; static constexpr int NSTORE = 8;
    unsigned char* ws; const float* bdn; const LAS int* pt; const LAS int* cn; size_t ysbase = WS_YS;
    __device__ __forceinline__ void operator()(const f32x4 (&acc)[2][2][4][2], const Unit& u, int wr, int wc, int fr, int fq) const {
        const int e = u.z; const int lrow0 = u.pm * 256 + wr * 64 + fr; const size_t srow0 = (size_t)__builtin_amdgcn_readfirstlane(pt[e]) * 256 + lrow0;
        const int col0 = u.pn * 256 + wc * 64 + 16 * fq;
        unsigned char* ys = ws + ysbase;
        const LAS float* btab = (const LAS float*)((const LAS unsigned char*)pt - LDS_MISC + LDS_BTAB) + u.idx * 256 + wc * 64 + 16 * fq;
        const LAS float* wtab = (const LAS float*)((const LAS unsigned char*)pt - LDS_MISC + LDS_TOKL) + u.idx * 256 + wr * 64 + fr;
        f32x4 bv[2][2];
#pragma unroll
        for (int bj = 0; bj < 2; ++bj)
#pragma unroll
            for (int n = 0; n < 2; ++n) bv[bj][n] = *(const LAS f32x4*)(btab + 8 * bj + 4 * n);
#pragma unroll
        for (int ai = 0; ai < 2; ++ai)
#pragma unroll
            for (int m = 0; m < 4; ++m) { const float w = wtab[ai * HALF + m * 16];
                u32x4 o;
                { const f32x4 a = (acc[ai][0][m][0] * WQ_INV + bv[0][0]) * w, c = (acc[ai][0][m][1] * WQ_INV + bv[0][1]) * w; o.x = pk_fp8x4(a[0], a[1], a[2], a[3]); o.y = pk_fp8x4(c[0], c[1], c[2], c[3]); }
                { const f32x4 a = (acc[ai][1][m][0] * WQ_INV + bv[1][0]) * w, c = (acc[ai][1][m][1] * WQ_INV + bv[1][1]) * w; o.z = pk_fp8x4(a[0], a[1], a[2], a[3]); o.w = pk_fp8x4(c[0], c[1], c[2], c[3]); }
                *(u32x4*)(ys + (srow0 + ai * HALF + m * 16) * 2048 + col0) = o; }
    }
};
struct EpiMemSoftmax {
    static constexpr bool PERM = true, AFTER_DRAIN = true; static constexpr int NSTORE = 0;
    bf16_t* P;
    __device__ __forceinline__ void operator()(const f32x4 (&)[2][2][4][2], const Unit&, int, int, int, int) const {}
    __device__ __forceinline__ void fused(f32x4 (&acc)[2][2][4][2], const Unit&, int wr, int wc, int fr, int fq, LAS unsigned char* lds, int, int) const {
        LAS f32x2* tab = (LAS f32x2*)lds;
        const float sc = 0.0625f * LOG2E;
        float mx[2][4];
#pragma unroll
        for (int ai = 0; ai < 2; ++ai)
#pragma unroll
            for (int m = 0; m < 4; ++m) { float a = -3.0e38f;
#pragma unroll
                for (int bj = 0; bj < 2; ++bj)
#pragma unroll
                    for (int n = 0; n < 2; ++n) { acc[ai][bj][m][n] *= sc; const f32x4 v = acc[ai][bj][m][n]; a = fmaxf(a, fmaxf(fmaxf(v[0], v[1]), fmaxf(v[2], v[3]))); }
                a = fmaxf(a, __shfl_xor(a, 16)); a = fmaxf(a, __shfl_xor(a, 32)); mx[ai][m] = a;
                float s = 0.f;
#pragma unroll
                for (int bj = 0; bj < 2; ++bj)
#pragma unroll
                    for (int n = 0; n < 2; ++n) { const f32x4 v = acc[ai][bj][m][n]; s += __builtin_amdgcn_exp2f(v[0] - a) + __builtin_amdgcn_exp2f(v[1] - a) + __builtin_amdgcn_exp2f(v[2] - a) + __builtin_amdgcn_exp2f(v[3] - a); }
                s += __shfl_xor(s, 16); s += __shfl_xor(s, 32);
                if (fq == 0) tab[(ai * HALF + wr * 64 + m * 16 + fr) * 4 + wc] = (f32x2){a, s};
            }
        __syncthreads();
#pragma unroll
        for (int ai = 0; ai < 2; ++ai)
#pragma unroll
            for (int m = 0; m < 4; ++m) { const int r = ai * HALF + wr * 64 + m * 16 + fr;
                const f32x2 t0 = tab[r * 4 + 0], t1 = tab[r * 4 + 1], t2 = tab[r * 4 + 2], t3 = tab[r * 4 + 3];
                const float M = fmaxf(fmaxf(t0.x, t1.x), fmaxf(t2.x, t3.x));
                const float L = t0.y * __builtin_amdgcn_exp2f(t0.x - M) + t1.y * __builtin_amdgcn_exp2f(t1.x - M) + t2.y * __builtin_amdgcn_exp2f(t2.x - M) + t3.y * __builtin_amdgcn_exp2f(t3.x - M);
                const float inv = 1.0f / L;
                bf16_t* rowp = P + (size_t)r * 1024 + wc * 32 + 8 * fq;
#pragma unroll
                for (int bj = 0; bj < 2; ++bj) { f32x4 v0 = acc[ai][bj][m][0], v1 = acc[ai][bj][m][1];
#pragma unroll
                    for (int j = 0; j < 4; ++j) { v0[j] = __builtin_amdgcn_exp2f(v0[j] - M) * inv; v1[j] = __builtin_amdgcn_exp2f(v1[j] - M) * inv; }
                    u32x4 w; w.x = cvtpk(v0[0], v0[1]); w.y = cvtpk(v0[2], v0[3]); w.z = cvtpk(v1[0], v1[1]); w.w = cvtpk(v1[2], v1[3]);
                    *(u32x4*)(rowp + bj * HALF) = w; } }
        __syncthreads();
    }
};
struct EpiTile {
    static constexpr bool PERM = true, AFTER_DRAIN = false; static constexpr int NSTORE = 0;
    bf16_t* dst; size_t ldc;
    __device__ __forceinline__ void operator()(const f32x4 (&acc)[2][2][4][2], const Unit&, int wr, int wc, int fr, int fq) const { store_tile_bf16(acc, dst, ldc, wr, wc, fr, fq); }
};
__device__ __forceinline__ void tr_item(const float* W, int K, int N, bf16_t* WT, LAS float* scr, int item, int lane) {
    const int nblk = N / 32, kb = item / nblk, nb = item % nblk, k0 = 64 * kb, n0 = 32 * nb;
#pragma unroll 8
    for (int i = 0; i < 32; ++i) { const int kk = 2 * i + (lane >> 5); scr[kk * 33 + (lane & 31)] = W[(size_t)(k0 + kk) * N + n0 + (lane & 31)]; }
    asm volatile("s_waitcnt lgkmcnt(0)" ::: "memory");
    const int c = lane & 7;
#pragma unroll
    for (int j = 0; j < 4; ++j) { const int n = (lane >> 3) + 8 * j; const LAS float* s = scr + (8 * c) * 33 + n;
        u32x4 o; o.x = cvtpk(s[0 * 33], s[1 * 33]); o.y = cvtpk(s[2 * 33], s[3 * 33]); o.z = cvtpk(s[4 * 33], s[5 * 33]); o.w = cvtpk(s[6 * 33], s[7 * 33]);
        *(u32x4*)(WT + (size_t)(n0 + n) * K + k0 + 8 * c) = o; }
    asm volatile("s_waitcnt lgkmcnt(0)" ::: "memory");
}
__device__ __forceinline__ void tr_item8(const float* W, int K, int N, unsigned char* WT, LAS float* scr, int item, int lane, float scale) {
    const int nblk = N / 32, kb = item / nblk, nb = item % nblk, k0 = 128 * kb, n0 = 32 * nb;
#pragma unroll 8
    for (int i = 0; i < 64; ++i) { const int kk = 2 * i + (lane >> 5); scr[kk * 33 + (lane & 31)] = W[(size_t)(k0 + kk) * N + n0 + (lane & 31)] * scale; }
    asm volatile("s_waitcnt lgkmcnt(0)" ::: "memory");
    const int c = lane & 7;
#pragma unroll
    for (int j = 0; j < 4; ++j) { const int n = (lane >> 3) + 8 * j; const LAS float* s = scr + (16 * c) * 33 + n;
        u32x4 o; o.x = pk_fp8x4(s[0 * 33], s[1 * 33], s[2 * 33], s[3 * 33]); o.y = pk_fp8x4(s[4 * 33], s[5 * 33], s[6 * 33], s[7 * 33]);
        o.z = pk_fp8x4(s[8 * 33], s[9 * 33], s[10 * 33], s[11 * 33]); o.w = pk_fp8x4(s[12 * 33], s[13 * 33], s[14 * 33], s[15 * 33]);
        *(u32x4*)(WT + (size_t)(n0 + n) * K + k0 + 16 * c) = o; }
    asm volatile("s_waitcnt lgkmcnt(0)" ::: "memory");
}
__device__ __forceinline__ void rms_row_to_bf16(const float* xrow, const float* g, bf16_t* orow, int lane, unsigned char* qrow = nullptr, float* irs = nullptr) {
    const f32x4* xr = (const f32x4*)xrow + lane; const f32x4* gr = (const f32x4*)g + lane;
    f32x4 v[8]; float s = 0.f;
#pragma unroll
    for (int j = 0; j < 8; ++j) { v[j] = xr[64 * j]; s += (v[j][0] * v[j][0] + v[j][1] * v[j][1]) + (v[j][2] * v[j][2] + v[j][3] * v[j][3]); }
    const float r = rsqrtf(wsum(s) * (1.0f / DM) + 1e-5f);
    if (irs && lane == 0) *irs = 1.0f / r;
    u32x2* o8 = (u32x2*)orow + lane;
#pragma unroll
    for (int j = 0; j < 8; ++j) { const f32x4 gg = gr[64 * j]; u32x2 w; w.x = cvtpk(v[j][0] * r * gg[0], v[j][1] * r * gg[1]); w.y = cvtpk(v[j][2] * r * gg[2], v[j][3] * r * gg[3]); o8[64 * j] = w;
        if (qrow) ((unsigned*)qrow)[lane + 64 * j] = pk_fp8x4(v[j][0] * r * gg[0], v[j][1] * r * gg[1], v[j][2] * r * gg[2], v[j][3] * r * gg[3]); }
}
__device__ __forceinline__ float rms_bfrow_to_bf16(const bf16_t* xrow, const float* g, bf16_t* orow, int lane, unsigned char* qrow) {
    const u32x2* xr = (const u32x2*)xrow + lane; const f32x4* gr = (const f32x4*)g + lane;
    f32x4 v[8]; float s = 0.f;
#pragma unroll
    for (int j = 0; j < 8; ++j) { const u32x2 w = xr[64 * j]; v[j] = (f32x4){bflo(w.x), bfhi(w.x), bflo(w.y), bfhi(w.y)}; s += (v[j][0] * v[j][0] + v[j][1] * v[j][1]) + (v[j][2] * v[j][2] + v[j][3] * v[j][3]); }
    const float r = rsqrtf(wsum(s) * (1.0f / DM) + 1e-5f);
    u32x2* o8 = (u32x2*)orow + lane;
#pragma unroll
    for (int j = 0; j < 8; ++j) { const f32x4 gg = gr[64 * j]; if (orow) { u32x2 w; w.x = cvtpk(v[j][0] * r * gg[0], v[j][1] * r * gg[1]); w.y = cvtpk(v[j][2] * r * gg[2], v[j][3] * r * gg[3]); o8[64 * j] = w; }
        if (qrow) ((unsigned*)qrow)[lane + 64 * j] = pk_fp8x4(v[j][0] * r * gg[0], v[j][1] * r * gg[1], v[j][2] * r * gg[2], v[j][3] * r * gg[3]); }
    return r;
}
constexpr int CV_I_IN = (DM / 128) * (INW / 256), CV_I_SQ = (2048 / 128) * (2048 / 256), CV_I_HF = (1024 / 128) * (2048 / 256);
constexpr int CV_I_GU = (2048 / 128) * (4096 / 256), CV_I_DN = CV_I_SQ;
constexpr long CV_NONEXP = (long)CV_I_IN + 3L * CV_I_SQ + 2L * CV_I_HF;
constexpr long CV_TOTAL = CV_NONEXP + (long)NE * CV_I_GU + (long)NE * CV_I_DN;
typedef short v2s_t __attribute__((ext_vector_type(2)));
__device__ __forceinline__ unsigned pk_fp8x4_scaled(float a, float b, float c, float d) {
    v2s_t r = {0, 0};
    r = __builtin_amdgcn_cvt_scalef32_pk_fp8_f32(r, a, b, WQ_INV, false);
    r = __builtin_amdgcn_cvt_scalef32_pk_fp8_f32(r, c, d, WQ_INV, true);
    return __builtin_bit_cast(unsigned, r);
}
constexpr int CV_PITCH = 260;
#ifndef CV_ASMLD
#define CV_ASMLD 0
#endif
__device__ __forceinline__ f32x4 cv_load(const float* q) {
#if CV_ASMLD
    f32x4 v; asm volatile("global_load_dwordx4 %0, %1, off sc0 sc1 nt" : "=v"(v) : "v"(q) : "memory"); return v;
#else
    return __builtin_nontemporal_load((const f32x4*)q);
#endif
}
__device__ __forceinline__ void convert_items(const Params& p, LAS unsigned char* lds, long it0, long it_end, int worker, int nworkers, int probe = 0, int* qhead = nullptr) {
    int tid_ = threadIdx.x; asm volatile("" : "+v"(tid_));
    const int tid = tid_, wave = __builtin_amdgcn_readfirstlane(tid >> 6), lane = tid & 63;
    unsigned char* ws = p.ws;
    LAS float* tile = (LAS float*)lds;
    constexpr int I_IN = CV_I_IN, I_SQ = CV_I_SQ, I_HF = CV_I_HF, I_GU = CV_I_GU, I_DN = CV_I_DN;
    static_assert(I_GU == 256 && I_DN == 128, "shift decode of the expert items");
    struct Item { const float* src; unsigned char* dst; int N, K, f8; };
    auto decode = [&](long it, Item& q) -> bool {
        if (it >= it_end) return false;
        long r = it; const float* W; unsigned char* D; int K, N, f8 = 0, kb, nb;
        if (r >= CV_NONEXP) {
            r -= CV_NONEXP; K = 2048; f8 = MOE_F8 ? 1 : 0;
            if (r < (long)NE * I_GU) { const int e = (int)(r >> 8), rr = (int)r & 255; kb = rr >> 4; nb = rr & 15; N = 4096;
                W = p.in[14] + (size_t)e * 2048 * 4096; D = ws + (MOE_F8 ? WS_WGUQ + (size_t)e * 4096 * 2048 : WS_WGUT + (size_t)e * 4096 * 2048 * 2); }
            else { r -= (long)NE * I_GU; const int e = (int)(r >> 7), rr = (int)r & 127; kb = rr >> 3; nb = rr & 7; N = 2048;
                W = p.in[16] + (size_t)e * 2048 * 2048; D = ws + (MOE_F8 ? WS_WDNQ + (size_t)e * 2048 * 2048 : WS_WDNT + (size_t)e * 2048 * 2048 * 2); }
        } else {
            if (r < I_IN) { W = p.in[4]; D = ws + WS_WINT; K = LDP; N = INW;
                if (GATES_F8 && 256 * ((int)r % (INW / 256)) >= 4608) { f8 = 2; D = ws + WS_WINQ; K = 2048; } }
            else if ((r -= I_IN) < I_SQ) { W = p.in[6]; D = ws + WS_WMKVT; K = LDP; N = 2048; }
            else if ((r -= I_SQ) < I_HF) { W = p.in[7]; D = ws + WS_WFM; K = 2048; N = 2048; }
            else if ((r -= I_HF) < I_SQ) { W = p.in[8]; D = ws + WS_WAOT; K = 2048; N = 2048; }
            else if ((r -= I_SQ) < I_HF) { W = p.in[9]; D = ws + WS_WFM + 1024 * 2; K = 2048; N = 2048; }
            else { r -= I_HF; W = p.in[10]; D = ws + WS_WOT; K = 2048; N = 2048; }
            const int nblk = N / 256; kb = (int)r / nblk; nb = (int)r % nblk;
        }
        q.src = W + (size_t)(128 * kb + wave) * N + 256 * nb + 4 * lane;
        q.dst = D + ((size_t)(256 * nb - (f8 == 2 ? 4608 : 0)) * K + 128 * kb) * (f8 ? 1 : 2);
        q.N = N; q.K = K; q.f8 = f8;
        if (probe) { q.src = p.in[14] + (size_t)wave * 4096 + 4 * lane; q.dst = ws + ((WS_FAST_END + 4095) & ~(size_t)4095) + (size_t)blockIdx.x * (256 * 2048); q.N = 4096; q.K = 2048; q.f8 = 1; }
        return true;
    };
    f32x4 v[16];
    LAS int* qslot = (LAS int*)(lds + LDS_MISC + 768);
    long it = it0 + worker, itn = it + nworkers;
    if (qhead) {
        if (tid == 0) { qslot[0] = __hip_atomic_fetch_add(qhead, 1, __ATOMIC_RELAXED, __HIP_MEMORY_SCOPE_AGENT); qslot[1] = __hip_atomic_fetch_add(qhead, 1, __ATOMIC_RELAXED, __HIP_MEMORY_SCOPE_AGENT); }
        __syncthreads();
        it = it0 + __builtin_amdgcn_readfirstlane(qslot[0]); itn = it0 + __builtin_amdgcn_readfirstlane(qslot[1]);
        __syncthreads();
    }
    Item cur; bool have = decode(it, cur);
    if (have) {
#pragma unroll
        for (int i = 0; i < 16; ++i) v[i] = cv_load(cur.src + (size_t)(8 * i) * cur.N);
    }
    int pst = 0;
    const int cch = lane & 7, nq = (lane >> 3) + 8 * wave;
    while (have) {
        Item nxt; const bool hn = decode(itn, nxt);
        __syncthreads();
#if CV_ASMLD
        if (pst == 4) asm volatile("s_waitcnt vmcnt(4)" ::: "memory"); else if (pst == 8) asm volatile("s_waitcnt vmcnt(8)" ::: "memory"); else asm volatile("s_waitcnt vmcnt(0)" ::: "memory");
#pragma unroll
        for (int i = 0; i < 16; ++i) asm volatile("" : "+v"(v[i]));
#endif
#pragma unroll
        for (int i = 0; i < 16; ++i) *(LAS f32x4*)(tile + (8 * i + wave) * CV_PITCH + 4 * lane + 16 * (i >> 1)) = v[i];
        if (qhead && hn && tid == 0) qslot[0] = __hip_atomic_fetch_add(qhead, 1, __ATOMIC_RELAXED, __HIP_MEMORY_SCOPE_AGENT);
        if (hn) {
#pragma unroll
            for (int i = 0; i < 16; ++i) v[i] = cv_load(nxt.src + (size_t)(8 * i) * nxt.N);
        }
        __syncthreads();
        const long itnn = qhead ? (hn ? it0 + __builtin_amdgcn_readfirstlane(qslot[0]) : it_end) : itn + nworkers;
        f32x4 t[16];
        const LAS float* s = tile + (16 * cch) * CV_PITCH + 16 * cch + 4 * nq;
#pragma unroll
        for (int i = 0; i < 16; ++i) t[i] = *(const LAS f32x4*)(s + i * CV_PITCH);
#pragma unroll
        for (int j = 0; j < 4; ++j) { const int n = 4 * nq + j;
            if (cur.f8) { u32x4 o; o.x = pk_fp8x4_scaled(t[0][j], t[1][j], t[2][j], t[3][j]); o.y = pk_fp8x4_scaled(t[4][j], t[5][j], t[6][j], t[7][j]);
                o.z = pk_fp8x4_scaled(t[8][j], t[9][j], t[10][j], t[11][j]); o.w = pk_fp8x4_scaled(t[12][j], t[13][j], t[14][j], t[15][j]);
                *(u32x4*)(cur.dst + (size_t)n * cur.K + 16 * cch) = o; }
            else { u32x4 o0, o1; o0.x = cvtpk(t[0][j], t[1][j]); o0.y = cvtpk(t[2][j], t[3][j]); o0.z = cvtpk(t[4][j], t[5][j]); o0.w = cvtpk(t[6][j], t[7][j]);
                o1.x = cvtpk(t[8][j], t[9][j]); o1.y = cvtpk(t[10][j], t[11][j]); o1.z = cvtpk(t[12][j], t[13][j]); o1.w = cvtpk(t[14][j], t[15][j]);
                u32x4* d = (u32x4*)(cur.dst + ((size_t)n * cur.K + 16 * cch) * 2); d[0] = o0; d[1] = o1; } }
        pst = cur.f8 ? 4 : 8;
        cur = nxt; have = hn; it = itn; itn = itnn;
    }
    __syncthreads();
}

constexpr long CE_TOTAL = (long)NE * 384;
constexpr int CE_PITCH = 1028;
__device__ __forceinline__ void convert_experts(const Params& p, LAS unsigned char* lds, long t0, long t1) {
    int tid_ = threadIdx.x; asm volatile("" : "+v"(tid_));
    const int tid = tid_, wave = tid >> 6, lane = tid & 63;
    LAS float* tile = (LAS float*)lds;
    struct Item { const float* src; unsigned char* dst; int N; };
    auto decode = [&](long t, Item& q) -> bool {
        if (t >= t1) return false;
        const int e = (int)(t / 384), r = (int)(t % 384);
        if (r < 256) { const int nr = r >> 6, kb = r & 63; q.N = 4096;
            q.src = p.in[14] + (size_t)e * 2048 * 4096 + (size_t)(32 * kb + 4 * wave) * 4096 + nr * 1024 + 4 * lane;
            q.dst = p.ws + WS_WGUQ + ((size_t)e * 4096 + (size_t)nr * 1024) * 2048 + 32 * kb; }
        else { const int nr = (r - 256) >> 6, kb = (r - 256) & 63; q.N = 2048;
            q.src = p.in[16] + (size_t)e * 2048 * 2048 + (size_t)(32 * kb + 4 * wave) * 2048 + nr * 1024 + 4 * lane;
            q.dst = p.ws + WS_WDNQ + ((size_t)e * 2048 + (size_t)nr * 1024) * 2048 + 32 * kb; }
        return true;
    };
    f32x4 v[16];
    Item cur; long t = t0; bool have = decode(t, cur);
    if (have) {
#pragma unroll
        for (int i = 0; i < 16; ++i) v[i] = __builtin_nontemporal_load((const f32x4*)(cur.src + (size_t)(i >> 2) * cur.N + 256 * (i & 3)));
    }
    while (have) {
        Item nxt; const bool hn = decode(t + 1, nxt);
        __syncthreads();
#pragma unroll
        for (int i = 0; i < 16; ++i) *(LAS f32x4*)(tile + (4 * wave + (i >> 2)) * CE_PITCH + 256 * (i & 3) + 4 * lane) = v[i];
        if (hn) {
#pragma unroll
            for (int i = 0; i < 16; ++i) v[i] = __builtin_nontemporal_load((const f32x4*)(nxt.src + (size_t)(i >> 2) * nxt.N + 256 * (i & 3)));
        }
        __syncthreads();
#pragma unroll
        for (int j = 0; j < 2; ++j) { const int n = tid + 512 * j; const LAS float* s = tile + n;
            float f[32];
#pragma unroll
            for (int i = 0; i < 32; ++i) f[i] = s[i * CE_PITCH] * WQ_SCALE;
            u32x4 o0, o1;
            o0.x = pk_fp8x4(f[0], f[1], f[2], f[3]); o0.y = pk_fp8x4(f[4], f[5], f[6], f[7]); o0.z = pk_fp8x4(f[8], f[9], f[10], f[11]); o0.w = pk_fp8x4(f[12], f[13], f[14], f[15]);
            o1.x = pk_fp8x4(f[16], f[17], f[18], f[19]); o1.y = pk_fp8x4(f[20], f[21], f[22], f[23]); o1.z = pk_fp8x4(f[24], f[25], f[26], f[27]); o1.w = pk_fp8x4(f[28], f[29], f[30], f[31]);
            u32x4* d = (u32x4*)(cur.dst + (size_t)n * 2048); d[0] = o0; d[1] = o1; }
        cur = nxt; have = hn; ++t;
    }
    __syncthreads();
}

__device__ __forceinline__ void phase_prologue(const Params& p, LAS unsigned char* lds) {
    int tid_ = threadIdx.x; asm volatile("" : "+v"(tid_));
    const int tid = tid_, wave = tid >> 6, lane = tid & 63;
    unsigned char* ws = p.ws;
    const int gw = vwg() * NWAVE + wave, NGW = (int)gridDim.x * NWAVE;
    for (int m = gw; m < T_; m += NGW) rms_row_to_bf16(p.in[0] + (size_t)m * DM, p.in[3], (bf16_t*)(ws + WS_H) + (size_t)m * LDP, lane, GATES_F8 ? (ws + WS_H8 + (size_t)m * DM) : nullptr, RES_FROM_H ? (float*)(ws + WS_IRSTD) + m : nullptr);
    for (int m = gw; m < B_ * MEM; m += NGW) {
        const f32x4* xr = (const f32x4*)(p.in[1] + (size_t)m * DM) + lane; u32x2* o8 = (u32x2*)((bf16_t*)(ws + WS_MEMBF) + (size_t)m * LDP) + lane;
#pragma unroll
        for (int j = 0; j < 8; ++j) { const f32x4 v = xr[64 * j]; u32x2 w; w.x = cvtpk(v[0], v[1]); w.y = cvtpk(v[2], v[3]); o8[64 * j] = w; }
    }
    {
        const int gt = vwg() * NTHR + tid, NGT = (int)gridDim.x * NTHR;
        bf16_t* tabT = (bf16_t*)(ws + WS_TABT); bf16_t* dm = (bf16_t*)(ws + WS_DMAT);
        for (int i = gt; i < 512 * 256 / 2; i += NGT) { const int e0 = 2 * i; const int mrow = e0 >> 8, c = e0 & 255; const int n = mrow & 255; float v[2];
#pragma unroll
            for (int j = 0; j < 2; ++j) { const int mm = ((c + j) * n) & 255; const float a = (float)mm * (2.0f / 256.0f); v[j] = (mrow < 256) ? cospif(a) : sinpif(a); }
            *(unsigned*)(tabT + e0) = cvtpk(v[0], v[1]); }
        const float sc = 1.0f / sqrtf(2048.0f * 256.0f);
        LAS float* ct = (LAS float*)lds;
        for (int m = tid; m < 2048; m += NTHR) ct[m] = cospif((float)m * (2.0f / 2048.0f)) * sc;
        __syncthreads();
        for (int i = gt; i < 2048 * SQK / 2; i += NGT) { const int e0 = 2 * i; const int jr = e0 / SQK, k = e0 % SQK; float v[2];
#pragma unroll
            for (int j = 0; j < 2; ++j) {
                if constexpr (SEQFOLD) { const int kj = k + j, par = jr >> 10, jo = 2 * (jr & 1023) + par;
                    if (kj < 512) v[j] = ct[(jo * kj) & 2047];
                    else { const int sx = (kj == 512) ? 512 : kj - 512; const int mm = (jo * sx) & 2047; v[j] = (kj == 512 && par == 0) ? ct[mm] : ct[(mm + 512) & 2047]; } }
                else { const int kk = (k + j) & 2047; const int mm = (jr * kk) & 2047; v[j] = (k < 2048) ? ct[mm] : ct[(mm + 512) & 2047]; } }
            *(unsigned*)(dm + (size_t)jr * DQP + k) = cvtpk(v[0], v[1]); }
        __syncthreads();
        bf16_t* wrt = (bf16_t*)(ws + WS_WRT);
        for (int i = gt; i < NE * DM; i += NGT) { const int e = i >> 11, k = i & 2047; wrt[i] = (bf16_t)(cvtpk(p.in[12][(size_t)k * NE + e] * (ROUTER_ON_X2 ? p.in[11][k] : 1.0f), 0.f) & 0xffffu); }
    }
    __syncthreads();
    convert_items(p, lds, 0, (gridDim.x == 256) ? CV_NONEXP : CV_TOTAL, vwg(), (int)gridDim.x);
}

constexpr int AT_KROW = 144, AT_VROW = 776;
constexpr int AT_K = 0, AT_V = 384 * AT_KROW, AT_LUT = AT_V + 64 * AT_VROW;
static_assert(AT_LUT + NWAVE * 320 * 4 <= STAGE_BYTES, "attention LDS");
__device__ __forceinline__ void attn_unit(const Params& p, LAS unsigned char* lds, int b, int kvh, int qb) {
    int tid_ = threadIdx.x; asm volatile("" : "+v"(tid_));
    const int tid = tid_, wid = __builtin_amdgcn_readfirstlane(tid >> 6), lane = tid & 63, r = lane & 31, h = lane >> 5;
    const unsigned char* ws = p.ws;
    const bf16_t* Q = (const bf16_t*)(ws + WS_Q); const bf16_t* Kg = (const bf16_t*)(ws + WS_K); const bf16_t* VT = (const bf16_t*)(ws + WS_VT);
    bf16_t* att = (bf16_t*)(p.ws + WS_ATT);
    const int q0 = qb * 128, hq = kvh * 8 + wid;
    LAS unsigned char* Kb = lds + AT_K; LAS unsigned char* Vt = lds + AT_V; LAS float* lut = (LAS float*)(lds + AT_LUT) + wid * 320;
    __syncthreads();
    for (int c = tid; c < 384 * 8; c += NTHR) { const int row = c >> 3, part = c & 7, pos = q0 - 128 + row;
        u32x4 v = {0u, 0u, 0u, 0u};
        if (pos >= 0 && pos < S_) v = *(const u32x4*)(Kg + (size_t)(b * S_ + pos) * 256 + kvh * 64 + part * 8);
        *(LAS u32x4*)(Kb + row * AT_KROW + part * 16) = v; }
    for (int c = tid; c < 64 * 48; c += NTHR) { const int d = c / 48, ch = c % 48, pos0 = q0 - 128 + ch * 8;
        u32x4 v = {0u, 0u, 0u, 0u};
        if (pos0 >= 0 && pos0 < S_) v = *(const u32x4*)(VT + ((size_t)((b * 4 + kvh) * 64 + d)) * 2048 + pos0);
        *(LAS u32x2*)(Vt + d * AT_VROW + ch * 16) = (u32x2){v.x, v.y}; *(LAS u32x2*)(Vt + d * AT_VROW + ch * 16 + 8) = (u32x2){v.z, v.w}; }
    for (int i = lane; i < 320; i += 64) { const int rel = i - 160; const int ar = rel < 0 ? -rel : rel;
        lut[i] = (ar <= WIN) ? p.in[2][t5_bucket(rel) * NH + hq] * LOG2E : -1.0e30f; }
    __syncthreads();
    const float sk = p.in[5][hq] * LOG2E;
    const float SC = 0.125f * LOG2E;
#pragma unroll 1
    for (int sb = 0; sb < 4; ++sb) {
        const int pq = q0 + sb * 32;
        bf16x8 qf[4];
        const bf16_t* qrow = Q + (size_t)(b * S_ + pq + r) * 2048 + hq * 64 + 8 * h;
#pragma unroll
        for (int s = 0; s < 4; ++s) qf[s] = *(const bf16x8*)(qrow + 16 * s);
        float mrun = sk, lrun = 1.0f;
        f32x16 o0, o1;
#pragma unroll
        for (int i = 0; i < 16; ++i) { o0[i] = 0.f; o1[i] = 0.f; }
        const int jlo = (qb == 0) ? 4 - sb : 0, jhi = (qb == 15) ? 8 - sb : 9;
        const LAS unsigned char* kp = Kb + (32 * (sb + jlo) + r) * AT_KROW + 16 * h;
        const LAS unsigned char* vp = Vt + r * AT_VROW + (32 * (sb + jlo) + 4 * h) * 2;
        const LAS unsigned char* vq = vp + 32 * AT_VROW;
        const LAS float* lp = lut + 32 * jlo + 32 + 4 * h - r;
#pragma unroll 1
        for (int j = jlo; j < jhi; ++j) {
            asm volatile("" : "+v"(kp), "+v"(vp), "+v"(vq), "+v"(lp));
            f32x16 s;
#pragma unroll
            for (int i = 0; i < 16; ++i) s[i] = 0.f;
#pragma unroll
            for (int ks = 0; ks < 4; ++ks) { const bf16x8 kf = *(const LAS bf16x8*)(kp + 32 * ks); s = __builtin_amdgcn_mfma_f32_32x32x16_bf16(kf, qf[ks], s, 0, 0, 0); }
            float mx = -3.0e38f;
            f32x2 sp[8];
#pragma unroll
            for (int i = 0; i < 8; ++i) { const int li = ((2 * i) & 3) + 8 * ((2 * i) >> 2); const f32x2 lv = {lp[li], lp[li + 1]}; const f32x2 sv = {s[2 * i], s[2 * i + 1]};
                sp[i] = sv * (f32x2){SC, SC} + lv; mx = fmaxf(fmaxf(mx, sp[i][0]), sp[i][1]); }
            mx = fmaxf(mx, __shfl_xor(mx, 32));
            const float mnew = fmaxf(mrun, mx);
            const float alpha = __builtin_amdgcn_exp2f(mrun - mnew);
            f32x2 rs2 = {0.f, 0.f};
#pragma unroll
            for (int i = 0; i < 8; ++i) { const f32x2 d = sp[i] - (f32x2){mnew, mnew}; const f32x2 e = {__builtin_amdgcn_exp2f(d[0]), __builtin_amdgcn_exp2f(d[1])};
                s[2 * i] = e[0]; s[2 * i + 1] = e[1]; rs2 += e; }
            float rs = rs2[0] + rs2[1];
            rs += __shfl_xor(rs, 32);
            lrun = lrun * alpha + rs; mrun = mnew;
            if (__any(alpha != 1.0f)) {
#pragma unroll
                for (int i = 0; i < 16; ++i) { o0[i] *= alpha; o1[i] *= alpha; }
            }
#pragma unroll
            for (int k2 = 0; k2 < 2; ++k2) {
                u32x4 pw; pw.x = cvtpk(s[8 * k2 + 0], s[8 * k2 + 1]); pw.y = cvtpk(s[8 * k2 + 2], s[8 * k2 + 3]); pw.z = cvtpk(s[8 * k2 + 4], s[8 * k2 + 5]); pw.w = cvtpk(s[8 * k2 + 6], s[8 * k2 + 7]);
                const bf16x8 pb = __builtin_bit_cast(bf16x8, pw);
                { const u32x2 lo = *(const LAS u32x2*)(vp + 32 * k2), hi = *(const LAS u32x2*)(vp + 32 * k2 + 16); const u32x4 vw = {lo.x, lo.y, hi.x, hi.y};
                  o0 = __builtin_amdgcn_mfma_f32_32x32x16_bf16(__builtin_bit_cast(bf16x8, vw), pb, o0, 0, 0, 0); }
                { const u32x2 lo = *(const LAS u32x2*)(vq + 32 * k2), hi = *(const LAS u32x2*)(vq + 32 * k2 + 16); const u32x4 vw = {lo.x, lo.y, hi.x, hi.y};
                  o1 = __builtin_amdgcn_mfma_f32_32x32x16_bf16(__builtin_bit_cast(bf16x8, vw), pb, o1, 0, 0, 0); }
            }
            kp += 32 * AT_KROW; vp += 64; vq += 64; lp += 32;
        }
        const float inv = 1.0f / lrun;
        bf16_t* orow = att + (size_t)(b * S_ + pq + r) * 2048 + hq * 64 + 4 * h;
#pragma unroll
        for (int g = 0; g < 4; ++g) {
            u32x2 w0; w0.x = cvtpk(o0[4 * g] * inv, o0[4 * g + 1] * inv); w0.y = cvtpk(o0[4 * g + 2] * inv, o0[4 * g + 3] * inv); *(u32x2*)(orow + 8 * g) = w0;
            u32x2 w1; w1.x = cvtpk(o1[4 * g] * inv, o1[4 * g + 1] * inv); w1.y = cvtpk(o1[4 * g + 2] * inv, o1[4 * g + 3] * inv); *(u32x2*)(orow + 32 + 8 * g) = w1;
        }
    }
}

__device__ __forceinline__ void phase_rows(const Params& p, LAS unsigned char* lds) {
    int tid_ = threadIdx.x; asm volatile("" : "+v"(tid_));
    const int tid = tid_, wave = __builtin_amdgcn_readfirstlane(tid >> 6), lane = tid & 63;
    unsigned char* ws = p.ws;
    const bf16_t* x2 = (const bf16_t*)(ws + WS_X2); bf16_t* h2 = (bf16_t*)(ws + WS_H2);
    LAS float* lg = (LAS float*)lds;
    LAS int* sel_e = (LAS int*)(lds + 8192);
    LAS float* sel_w = (LAS float*)(lds + 9216);
    LAS int* sel_r = (LAS int*)(lds + 10240);
    LAS int* lcnt = (LAS int*)(lds + 11264);
    LAS int* lbase = (LAS int*)(lds + 11392);
    LAS float* rtok = (LAS float*)(lds + 11520);
#pragma unroll 1
    for (int t0 = vwg() * 64; t0 < T_; t0 += 64 * (int)gridDim.x) {
        __syncthreads();
        if (tid < 32) lcnt[tid] = 0;
        for (int i = 0; i < 8; ++i) { const int t = t0 + wave * 8 + i;
            const float r = rms_bfrow_to_bf16(x2 + (size_t)t * DM, p.in[11], (ROUTER_ON_X2 && MOE_F8) ? nullptr : h2 + (size_t)t * DM, lane, MOE_F8 ? (ws + WS_H2Q + (size_t)t * DM) : nullptr);
            if (lane == 0) rtok[wave * 8 + i] = r; }
        asm volatile("s_waitcnt vmcnt(0)" ::: "memory");
        __syncthreads();
        if (wave < 4) {
            const bf16_t* arow = ((ROUTER_ON_X2 && MOE_F8) ? x2 : (const bf16_t*)h2) + (size_t)(t0 + wave * 16 + (lane & 15)) * DM + 8 * (lane >> 4);
            const bf16_t* b0 = (const bf16_t*)(ws + WS_WRT) + (size_t)(lane & 15) * DM + 8 * (lane >> 4);
            const bf16_t* b1 = b0 + (size_t)16 * DM;
            f32x4 a0 = {0.f, 0.f, 0.f, 0.f}, a1 = {0.f, 0.f, 0.f, 0.f};
#pragma unroll 8
            for (int s = 0; s < 64; ++s) { const bf16x8 av = *(const bf16x8*)(arow + 32 * s), bv0 = *(const bf16x8*)(b0 + 32 * s), bv1 = *(const bf16x8*)(b1 + 32 * s);
                a0 = __builtin_amdgcn_mfma_f32_16x16x32_bf16(av, bv0, a0, 0, 0, 0); a1 = __builtin_amdgcn_mfma_f32_16x16x32_bf16(av, bv1, a1, 0, 0, 0); }
            const int ecol = lane & 15; const float bb0 = p.in[13][ecol], bb1 = p.in[13][ecol + 16];
#pragma unroll
            for (int rg = 0; rg < 4; ++rg) { const int tl = wave * 16 + (lane >> 4) * 4 + rg; const float rs = (ROUTER_ON_X2 && MOE_F8) ? rtok[tl] : 1.0f; lg[tl * 32 + ecol] = a0[rg] * rs + bb0; lg[tl * 32 + ecol + 16] = a1[rg] * rs + bb1; }
        }
        __syncthreads();
        if (tid < 64) {
            float v[32];
#pragma unroll
            for (int e = 0; e < 32; ++e) v[e] = lg[tid * 32 + e];
            float tv[4]; int ti[4];
#pragma unroll
            for (int k = 0; k < 4; ++k) { float bv = -3.0e38f; int bi = 0;
#pragma unroll
                for (int e = 0; e < 32; ++e) { const bool tk = v[e] > bv; bv = tk ? v[e] : bv; bi = tk ? e : bi; }
                tv[k] = bv; ti[k] = bi;
#pragma unroll
                for (int e = 0; e < 32; ++e) v[e] = (e == bi) ? -3.0e38f : v[e]; }
            const float e1 = __expf(tv[1] - tv[0]), e2 = __expf(tv[2] - tv[0]), e3 = __expf(tv[3] - tv[0]);
            const float inv = 1.0f / (1.0f + e1 + e2 + e3);
            const float wv[4] = {inv, e1 * inv, e2 * inv, e3 * inv};
#pragma unroll
            for (int k = 0; k < 4; ++k) { sel_e[tid * 4 + k] = ti[k]; sel_w[tid * 4 + k] = wv[k]; sel_r[tid * 4 + k] = __hip_atomic_fetch_add(&lcnt[ti[k]], 1, __ATOMIC_RELAXED, __HIP_MEMORY_SCOPE_WORKGROUP); }
        }
        __syncthreads();
        if (tid < 32) lbase[tid] = (lcnt[tid] > 0) ? atomicAdd((int*)(ws + WS_CTL) + CW_CNT + tid, lcnt[tid]) : 0;
        __syncthreads();
        if (tid < 256) { const int tl = tid >> 2, k = tid & 3, t = t0 + tl; const int e = sel_e[tid], pos = lbase[e] + sel_r[tid]; const float w = sel_w[tid];
            ((int*)(ws + WS_TOKE))[t * 4 + k] = e; ((int*)(ws + WS_TOKPOS))[t * 4 + k] = pos; ((float*)(ws + WS_TOKW))[t * 4 + k] = w;
            ((int*)(ws + WS_LIST))[(size_t)e * T_ + pos] = t; ((float*)(ws + WS_WLIST))[(size_t)e * T_ + pos] = w; }
    }
}
__device__ __forceinline__ void moe_tables(const Params& p, LAS int* pt, LAS int* cn) {
    __syncthreads();
    if (threadIdx.x < 64) {
        const int ln = (int)threadIdx.x; const int* cnt = (const int*)(p.ws + WS_CTL) + CW_CNT;
        const int c = (ln < NE) ? __hip_atomic_load(cnt + (ln & 31), __ATOMIC_RELAXED, __HIP_MEMORY_SCOPE_AGENT) : 0;
        const int tl = (c + 255) >> 8; int inc = tl;
#pragma unroll
        for (int o = 1; o < 32; o <<= 1) { const int v = __shfl_up(inc, o); if (ln >= o) inc += v; }
        if (ln < NE) { cn[ln] = c; pt[ln] = inc - tl; }
        if (ln == NE - 1) pt[NE] = inc;
    }
    __syncthreads();
}
__device__ __forceinline__ void phase_final(const Params& p, const LAS int* pt) {
    int tid_ = threadIdx.x; asm volatile("" : "+v"(tid_));
    const int tid = tid_, wave = tid >> 6, lane = tid & 63;
    const unsigned char* ws = p.ws;
    const bf16_t* x2 = (const bf16_t*)(ws + WS_X2); const bf16_t* ys = (const bf16_t*)(ws + WS_YS);
    const int* toke = (const int*)(ws + WS_TOKE); const int* tokpos = (const int*)(ws + WS_TOKPOS);
    const int gw = vwg() * NWAVE + wave, NGW = (int)gridDim.x * NWAVE;
    float pscale = 1.0f;
    if (PROFSEL != 0) {
        const unsigned long long* pf = (const unsigned long long*)(p.ws + WS_CTL + 32768);
        const float kl = (float)pf[0], ep = (float)pf[1], n = (float)pf[2], ntl = (float)pf[3], cyc = (float)pf[4], wal = (float)pf[5];
        float m = 0.f;
        if (PROFMETRIC == 0) m = ep / (kl + ep);
        if (PROFMETRIC == 1) m = kl / (n * ntl) / 4096.0f;
        if (PROFMETRIC == 2) m = cyc / (wal * 24.0f);
        if (PROFMETRIC == 3) m = (kl + ep) / cyc;
        if (PROFMETRIC == 4) m = n / 32.0f;
        if (PROFMETRIC == 5) m = wal / 100.0f / 200.0f;
        if (PROFMETRIC == 6 || PROFMETRIC == 7) {
            const unsigned long long* st = (const unsigned long long*)(p.ws + WS_CTL + 40960);
            unsigned long long mx = 0, mn = ~0ull, sum = 0;
            for (int i = 0; i < (int)gridDim.x; ++i) { const unsigned long long v = st[i]; mx = v > mx ? v : mx; mn = v < mn ? v : mn; sum += v; }
            const float mean = (float)(sum - mn * gridDim.x) / (float)gridDim.x;
            m = (PROFMETRIC == 6 ? ((float)(mx - mn) - mean) : (float)(mx - mn)) / 100.0f / 200.0f; }
        if (blockIdx.x == 0 && threadIdx.x == 0) { const unsigned long long t0 = wall_clock64(), ticks = (unsigned long long)(m * (float)PROFMUL * 100.0f * 100.0f);
            while (wall_clock64() - t0 < ticks) __builtin_amdgcn_s_sleep(8); }
    }
    for (int t = gw; t < T_; t += NGW) {
        const u32x2* xr = (const u32x2*)(x2 + (size_t)t * DM) + lane;
        f32x4 v[8];
#pragma unroll
        for (int j = 0; j < 8; ++j) { const u32x2 w = xr[64 * j]; v[j] = (f32x4){bflo(w.x), bfhi(w.x), bflo(w.y), bfhi(w.y)}; }
#pragma unroll
        for (int k = 0; k < 4; ++k) { const int e = toke[t * 4 + k]; const size_t slot = (size_t)pt[e] * 256 + tokpos[t * 4 + k];
            if constexpr (MOE_F8) {
                const unsigned* yr = (const unsigned*)((const unsigned char*)ys + slot * DM) + lane;
#pragma unroll
                for (int j = 0; j < 8; ++j) { const unsigned w = yr[64 * j];
                    v[j][0] += __builtin_amdgcn_cvt_f32_fp8((int)w, 0) * YS_INV; v[j][1] += __builtin_amdgcn_cvt_f32_fp8((int)w, 1) * YS_INV;
                    v[j][2] += __builtin_amdgcn_cvt_f32_fp8((int)w, 2) * YS_INV; v[j][3] += __builtin_amdgcn_cvt_f32_fp8((int)w, 3) * YS_INV; }
            } else {
                const u32x2* yr = (const u32x2*)(ys + slot * DM) + lane;
#pragma unroll
                for (int j = 0; j < 8; ++j) { const u32x2 w = yr[64 * j]; v[j][0] += bflo(w.x); v[j][1] += bfhi(w.x); v[j][2] += bflo(w.y); v[j][3] += bfhi(w.y); }
            } }
        float s = 0.f;
#pragma unroll
        for (int j = 0; j < 8; ++j) s += (v[j][0] * v[j][0] + v[j][1] * v[j][1]) + (v[j][2] * v[j][2] + v[j][3] * v[j][3]);
        const float r = rsqrtf(wsum(s) * (1.0f / DM) + 1e-5f);
        const f32x4* gr = (const f32x4*)p.in[18] + lane; f32x4* orow = (f32x4*)(p.out + (size_t)t * DM) + lane;
#pragma unroll
        for (int j = 0; j < 8; ++j) { const f32x4 gg = gr[64 * j]; orow[64 * j] = (f32x4){v[j][0] * r * gg[0] * pscale, v[j][1] * r * gg[1] * pscale, v[j][2] * r * gg[2] * pscale, v[j][3] * r * gg[3] * pscale}; }
    }
}
#ifndef P1_SLOT_BAL
#define P1_SLOT_BAL 1
#endif
#ifndef CV_SPLIT
#define CV_SPLIT 6144L
#endif
#ifndef MOE_SLOT
#define MOE_SLOT 1
#endif
#ifndef X2_SLOT
#define X2_SLOT 0
#endif
#ifndef MOE_SLOT_STEP
#define MOE_SLOT_STEP 4
#endif
#ifndef MOE_SLOT_BAL
#define MOE_SLOT_BAL 4
#endif
#ifndef POOL1
#define POOL1 2
#endif
#ifndef P2ROLE
#define P2ROLE 0
#endif
#ifndef POOL2
#define POOL2 0
#endif
#ifndef POOL3
#define POOL3 0
#endif
#ifndef POOL4
#define POOL4 0
#endif
#ifndef POOL5
#define POOL5 0
#endif
#ifndef Q4
#define Q4 8
#endif
constexpr long GU_A0 = 30 - (POOL1 + POOL2 + POOL3 + POOL4 + POOL5 + Q4);
constexpr long GU_P1S = 64 * (4 * GU_A0 + 8), GU_P1P = GU_P1S, GU_P2P = GU_P1P + 256 * POOL1, GU_P3P = GU_P2P + 256 * POOL2, GU_P4S = GU_P3P + 256 * POOL3,
               GU_P4P = GU_P4S + 256 * Q4, GU_P5P = GU_P4P + 256 * POOL4, GU_END = GU_P5P + 256 * POOL5;
static_assert(GU_END == 8192 && GU_A0 > 0, "gate_up conversion layout");
#ifndef POOL7
#define POOL7 2
#endif
__device__ __forceinline__ void proj_convert_slot(const Params& p, LAS unsigned char* lds, int g, int part) {
    const int wgi = (int)blockIdx.x & 63;
    __syncthreads();
    if constexpr (MOE_F8 && CONV_TILE32) { const long per = CE_TOTAL / 512, a = ((long)(part * 4 + g) * 64 + wgi) * per; convert_experts(p, lds, a, a + per); }
    else { const long total = CV_TOTAL - CV_NONEXP, half = total / 2; long q = half / 4, it0 = CV_NONEXP + half * part + q * g;
        if (P1_SLOT_BAL) {
            constexpr long P1END = (MOE_SLOT ? 8192 : 12288) - 256 * X2_SLOT;
            static_assert((CV_TOTAL - CV_NONEXP) == 12288 && MOE_SLOT == 1 && X2_SLOT == 0, "slot split");
            if (part == 0) { it0 = CV_NONEXP + 64 * GU_A0 * g; q = 64 * (g == 3 ? GU_A0 + 8 : GU_A0); }
            else if (part == 1) { it0 = CV_NONEXP + GU_P4S + 64 * Q4 * g; q = 64 * Q4; }
            else if (part == 2) { it0 = CV_NONEXP + 8192 + 1024 * g; q = 1024; }
            else { it0 = CV_NONEXP + P1END + 64 * X2_SLOT * g; q = 64 * X2_SLOT; } }
        convert_items(p, lds, it0, it0 + q, wgi, 64);
#ifdef DBLCONV
        if (part == (DBLCONV & 3) - 1) { __syncthreads(); convert_items(p, lds, it0, it0 + q, wgi, 64, DBLCONV >> 2); }
#endif
    }
    asm volatile("s_waitcnt vmcnt(0) lgkmcnt(0)" ::: "memory");
    __syncthreads();
}
__device__ __forceinline__ void pool_drain(const Params& p, LAS unsigned char* lds, int pool, long base, int count) {
    __syncthreads();
    convert_items(p, lds, base, base + count, 0, 1, 0, (int*)(p.ws + WS_CTL) + CW_POOL + 64 * pool);
    asm volatile("s_waitcnt vmcnt(0) lgkmcnt(0)" ::: "memory");
    __syncthreads();
}
__device__ __forceinline__ void convert_range_slot(const Params& p, LAS unsigned char* lds, long it0, long n) {
    __syncthreads();
    convert_items(p, lds, it0, it0 + n, 0, 1);
    asm volatile("s_waitcnt vmcnt(0) lgkmcnt(0)" ::: "memory");
    __syncthreads();
}
__device__ __forceinline__ void phase_proj(const Params& p, LAS unsigned char* lds) {
    EpiProj E{p.ws}; EpiGates8 EG{p.ws};
    unsigned long long* prof = PROFSEL == 1 ? (unsigned long long*)(p.ws + WS_CTL + 32768) : nullptr;
    const int BIG = 1 << 20;
    const bool stag = (gridDim.x == 256);
    const int g = stag ? ((int)blockIdx.x >> 6) : -1;
    if constexpr (GATES_F8) {
#ifndef P1SLOTV
#define P1SLOTV 0
#endif
        int a1 = (g == 0) ? 0 : (g == 1 ? 2 : BIG), a3 = (g == 3) ? 3 : BIG, slot = (g <= 1) ? 1 : g;
        if (P1SLOTV == 1) { a1 = BIG; a3 = (g <= 0) ? BIG : 2 * g; slot = (g <= 0) ? 2 : 3; }
        if (P1SLOTV == 2) { a1 = (g == 0) ? 0 : (g == 1 ? 3 : BIG); a3 = (g == 2) ? 1 : (g == 3 ? 4 : BIG); slot = (g <= 1) ? 1 : 3; }
        { SchedProj S{p.ws, 0, a1}; gemm_phase<EpiProj, SchedProj, true>(lds, 2048, LDP, LDP, S, E, nullptr); }
        if (stag && slot == 1) proj_convert_slot(p, lds, g, 0);
        { SchedProj S{p.ws, a1, BIG}; gemm_phase<EpiProj, SchedProj, true>(lds, 2048, LDP, LDP, S, E, prof); }
        if (stag && slot == 2) proj_convert_slot(p, lds, g, 0);
        { SchedGates8 S{p.ws, 0, a3}; gemm_phase<EpiGates8, SchedGates8, true, 1>(lds, 2048, 2048, 2048, S, EG, nullptr); }
        if (stag && slot == 3) proj_convert_slot(p, lds, g, 0);
        { SchedGates8 S{p.ws, a3, BIG}; gemm_phase<EpiGates8, SchedGates8, true, 1>(lds, 2048, 2048, 2048, S, EG, nullptr); }
        if (stag && POOL1 > 0) pool_drain(p, lds, 0, CV_NONEXP + GU_P1P, 256 * POOL1);
    } else {
        const int nb = stag ? 3 * g : 0;
        if (nb > 0) { SchedProj S{p.ws, 0, nb}; gemm_phase<EpiProj, SchedProj, true>(lds, 2048, LDP, LDP, S, E, nullptr); }
        if (stag) proj_convert_slot(p, lds, g, 0);
        { SchedProj S{p.ws, nb, BIG}; gemm_phase<EpiProj, SchedProj, true>(lds, 2048, LDP, LDP, S, E, prof); }
    }
}
__device__ __forceinline__ void phase_mixers(const Params& p, LAS unsigned char* lds) {
    unsigned char* ws = p.ws;
#ifndef DBLSUB
#define DBLSUB 0
#endif
#pragma unroll 1
    for (int rep = 0; rep < ((DBLSUB & 1) ? 2 : 1); ++rep)
#pragma unroll 1
    for (int u = (P2ROLE && gridDim.x == 256) ? (((int)blockIdx.x >> 6) < 3 ? ((int)blockIdx.x & 7) * 24 + ((int)blockIdx.x >> 3) : 512) : vwg(); u < 512; u += (P2ROLE && gridDim.x == 256) ? 192 : (int)gridDim.x)
        attn_unit(p, lds, u >> 6, (u >> 4) & 3, u & 15);
    asm volatile("s_waitcnt vmcnt(0) lgkmcnt(0)" ::: "memory");
    __syncthreads();
#pragma unroll 1
    for (int rep = 0; rep < ((DBLSUB & 2) ? 2 : 1); ++rep)
#pragma unroll 1
    for (int u = vwg(); u < 256; u += (int)gridDim.x) {
        const int mh = u & 3, tb = (u >> 2) & 7, b = (u >> 5) & 7;
        const size_t tok0 = (size_t)b * S_ + (size_t)tb * 256;
        bf16_t* Pt = (bf16_t*)(ws + WS_PM) + tok0 * 1024 + mh * 256;
        SchedOne S1{(const char*)(ws + WS_QM) + (tok0 * 1024 + mh * 256) * 2, (const char*)(ws + WS_KMK) + ((size_t)b * 256 * 1024 + mh * 256) * 2, 0, true};
        EpiMemSoftmax E1{Pt};
        gemm_phase<EpiMemSoftmax, SchedOne, false>(lds, 256, 1024, 1024, S1, E1);
        asm volatile("s_waitcnt vmcnt(0)" ::: "memory");
        __syncthreads();
        SchedOne S2{(const char*)Pt, (const char*)(ws + WS_VMT) + ((size_t)(b * 4 + mh) * 256 * 256) * 2, 0, true};
        EpiTile E2{(bf16_t*)(ws + WS_FX) + tok0 * 2048 + 1024 + mh * 256, 2048};
        gemm_phase<EpiTile, SchedOne, false>(lds, 256, 1024, 256, S2, E2);
        __syncthreads();
    }
    { SchedChan S{ws, 0, 0}; EpiChan E{ws};
      if constexpr (SEQFOLD) {
          int tid_ = threadIdx.x; asm volatile("" : "+v"(tid_));
          const int ch = tid_ & 31, rr = tid_ >> 5;
          const bf16_t* fin = (const bf16_t*)(ws + WS_FIN);
#pragma unroll 1
          for (int i = 0; i < 2; ++i) { Unit u; if (!S.next(i, u)) break;
              const int b = u.z >> 2, g = u.z & 3, par = u.pn >> 2, kb = u.pn & 3; const bool cosb = kb < 2; const int s0 = 256 * (kb & 1);
              const bf16_t* base = fin + (size_t)(b * 2048) * 1024 + g * 256 + ch * 8;
              bf16_t* ob = (bf16_t*)(ws + WS_XF) + (size_t)(vwg() * 2 + i) * 65536 + ch * 8;
              const float sgn = par ? -1.0f : 1.0f;
#pragma unroll 2
              for (int ps = 0; ps < 16; ++ps) { const int r = ps * 16 + rr, sq = s0 + r;
                  int r1 = sq, r2 = (2048 - sq) & 2047, r3 = 1024 - sq, r4 = (1024 + sq) & 2047; float c1 = 1.0f, c2, c3, c4;
                  if (cosb) { c2 = 1.0f; c3 = sgn; c4 = sgn; if (sq == 0) { r2 = 1024; c2 = sgn; c3 = 0.f; c4 = 0.f; } }
                  else { c2 = -1.0f; c3 = -sgn; c4 = sgn; if (sq == 0) { r1 = 512; r2 = 1536; c1 = par ? 1.0f : 0.f; c2 = par ? -1.0f : 0.f; c3 = 0.f; c4 = 0.f; } }
                  const u32x4 x1 = *(const u32x4*)(base + (size_t)r1 * 1024), x2 = *(const u32x4*)(base + (size_t)r2 * 1024), x3 = *(const u32x4*)(base + (size_t)r3 * 1024), x4 = *(const u32x4*)(base + (size_t)r4 * 1024);
                  u32x4 w;
#define FOLD4(a, b_, c_, d_) cvtpk(c1 * bflo(a) + c2 * bflo(b_) + c3 * bflo(c_) + c4 * bflo(d_), c1 * bfhi(a) + c2 * bfhi(b_) + c3 * bfhi(c_) + c4 * bfhi(d_))
                  w.x = FOLD4(x1.x, x2.x, x3.x, x4.x); w.y = FOLD4(x1.y, x2.y, x3.y, x4.y); w.z = FOLD4(x1.z, x2.z, x3.z, x4.z); w.w = FOLD4(x1.w, x2.w, x3.w, x4.w);
#undef FOLD4
                  *(u32x4*)(ob + (size_t)r * 256) = w; } }
          asm volatile("s_waitcnt vmcnt(0)" ::: "memory");
          __syncthreads();
          gemm_phase<EpiChan, SchedChan, true>(lds, 256, 256, 256, S, E, PROFSEL == 2 ? (unsigned long long*)(p.ws + WS_CTL + 32768) : nullptr);
#pragma unroll 1
          for (int i = 0; i < 2; ++i) { Unit u; if (!S.next(i, u)) break;
              if (u.pn == 2 && tid_ < 256) { const int b = u.z >> 2, g = u.z & 3, n = tid_;
                  const bf16_t* xr = fin + ((size_t)(b * 2048 + 512) * 1024 + g * 256); const bf16_t* xq = xr + (size_t)1024 * 1024; const bf16_t* tr = (const bf16_t*)(ws + WS_TABT) + (size_t)n * 256;
                  float a = 0.f;
#pragma unroll 4
                  for (int c8 = 0; c8 < 32; ++c8) { const u32x4 x = *(const u32x4*)(xr + 8 * c8), y = *(const u32x4*)(xq + 8 * c8), t = *(const u32x4*)(tr + 8 * c8);
                      a += (bflo(x.x) + bflo(y.x)) * bflo(t.x) + (bfhi(x.x) + bfhi(y.x)) * bfhi(t.x) + (bflo(x.y) + bflo(y.y)) * bflo(t.y) + (bfhi(x.y) + bfhi(y.y)) * bfhi(t.y)
                         + (bflo(x.z) + bflo(y.z)) * bflo(t.z) + (bfhi(x.z) + bfhi(y.z)) * bfhi(t.z) + (bflo(x.w) + bflo(y.w)) * bflo(t.w) + (bfhi(x.w) + bfhi(y.w)) * bfhi(t.w); }
                  ((bf16_t*)(ws + WS_ZT))[((size_t)u.z * 256 + n) * SQP + 512] = (bf16_t)(cvtpk(a, 0.f) & 0xffffu); } }
      } else gemm_phase<EpiChan, SchedChan, true>(lds, 256, 256, 1024, S, E, PROFSEL == 2 ? (unsigned long long*)(p.ws + WS_CTL + 32768) : nullptr); }
    if (POOL2 > 0 && gridDim.x == 256) pool_drain(p, lds, 2, CV_NONEXP + GU_P2P, 256 * POOL2);
}
__device__ __forceinline__ void phase_seqdft(const Params& p, LAS unsigned char* lds) {
    SchedSeq S{p.ws}; EpiSeq E{p.ws};
    gemm_phase<EpiSeq, SchedSeq, true>(lds, SQK, DQP, SQP, S, E, PROFSEL == 3 ? (unsigned long long*)(p.ws + WS_CTL + 32768) : nullptr);
    if (POOL3 > 0 && gridDim.x == 256) pool_drain(p, lds, 3, CV_NONEXP + GU_P3P, 256 * POOL3);
}
__device__ __forceinline__ void phase_mix(const Params& p, LAS unsigned char* lds) {
    unsigned char* ws = p.ws;
    const bool stag = (gridDim.x == 256); const int g = stag ? ((int)blockIdx.x >> 6) : -1;
    unsigned long long* prof = PROFSEL == 4 ? (unsigned long long*)(p.ws + WS_CTL + 32768) : nullptr;
    EpiMixF E{ws, lds};
#ifndef MIXSLOT
#define MIXSLOT 0x2110
#endif
    const int sp = (g >= 0) ? ((MIXSLOT >> (4 * g)) & 15) : -1;
    if (sp == 0) proj_convert_slot(p, lds, g, 1);
    { SchedMix S{ws, 0, 1}; gemm_phase<EpiMixF, SchedMix, true>(lds, 2048, 2048, 2048, S, E, prof); }
    if (sp == 1) proj_convert_slot(p, lds, g, 1);
    { SchedMix S{ws, 1, 1 << 20}; gemm_phase<EpiMixF, SchedMix, true>(lds, 2048, 2048, 2048, S, E, nullptr); }
    if (sp == 2) proj_convert_slot(p, lds, g, 1);
    if (POOL4 > 0 && stag) pool_drain(p, lds, 4, CV_NONEXP + GU_P4P, 256 * POOL4);
}
__device__ __forceinline__ void phase_x2(const Params& p, LAS unsigned char* lds) {
    unsigned char* ws = p.ws;
    SchedPlain S{(const char*)(ws + WS_MIXED), (const char*)(ws + WS_WOT), (size_t)256 * 2048 * 2, (size_t)256 * 2048 * 2, 64, 8};
    EpiRes E{p.in[0], (bf16_t*)(ws + WS_X2), (const bf16_t*)(ws + WS_H), (const float*)(ws + WS_IRSTD), p.in[3]};
    unsigned long long* prof = PROFSEL == 5 ? (unsigned long long*)(p.ws + WS_CTL + 32768) : nullptr;
    if (X2_SLOT > 0 && MOE_SLOT && gridDim.x == 256) {
        const int g = (int)blockIdx.x >> 6, sp = (0x2110 >> (4 * g)) & 15;
        if (sp == 0) proj_convert_slot(p, lds, g, 3);
        { SchedPlain Sa = S; Sa.r0 = 0; Sa.r1 = 1; gemm_phase<EpiRes, SchedPlain, true>(lds, 2048, 2048, 2048, Sa, E, prof); }
        if (sp == 1) proj_convert_slot(p, lds, g, 3);
        { SchedPlain Sb = S; Sb.r0 = 1; gemm_phase<EpiRes, SchedPlain, true>(lds, 2048, 2048, 2048, Sb, E, nullptr); }
        if (sp == 2) proj_convert_slot(p, lds, g, 3);
    } else gemm_phase<EpiRes, SchedPlain, true>(lds, 2048, 2048, 2048, S, E, prof);
    if (POOL5 > 0 && gridDim.x == 256) pool_drain(p, lds, 5, CV_NONEXP + GU_P5P, 256 * POOL5);
}
template <class Sched> __device__ __forceinline__ void moe_fill_tokl(const Params& p, LAS unsigned char* lds, const Sched& S, const LAS int* cn) {
    LAS unsigned short* tokl = (LAS unsigned short*)(lds + LDS_TOKL);
    const int* list = (const int*)(p.ws + WS_LIST);
    const int tid = threadIdx.x, half = tid >> 8, c = tid & 255;
    int tok[10]; bool val[10];
#pragma unroll
    for (int j = 0; j < 10; ++j) { Unit u; val[j] = S.next(2 * j + half, u); tok[j] = 0;
        if (val[j]) { const int cnt = cn[u.z]; int pos = u.pm * 256 + c; pos = pos < cnt ? pos : cnt - 1; tok[j] = list[(size_t)u.z * T_ + pos]; } }
#pragma unroll
    for (int j = 0; j < 10; ++j) if (val[j]) tokl[(2 * j + half) * 256 + c] = (unsigned short)tok[j];
    __syncthreads();
}
template <class Sched, bool WTAB> __device__ __forceinline__ void moe_fill_tabs(const Params& p, LAS unsigned char* lds, const Sched& S, const LAS int* cn, const float* bias, int ncol) {
    LAS float* btab = (LAS float*)(lds + LDS_BTAB); LAS float* wtab = (LAS float*)(lds + LDS_TOKL);
    const float* wl = (const float*)(p.ws + WS_WLIST);
    const int tid = threadIdx.x, half = tid >> 8, c = tid & 255;
    constexpr int NP = WTAB ? 5 : 10;
    float bv[NP], wv[NP]; bool val[NP];
#pragma unroll
    for (int j = 0; j < NP; ++j) { Unit u; val[j] = S.next(2 * j + half, u); bv[j] = 0.f; wv[j] = 0.f;
        if (val[j]) { bv[j] = bias[(size_t)u.z * ncol + u.pn * 256 + c];
            if constexpr (WTAB) { const int pos = u.pm * 256 + c; if (pos < cn[u.z]) wv[j] = wl[(size_t)u.z * T_ + pos] * YS_SCALE; } } }
#pragma unroll
    for (int j = 0; j < NP; ++j) if (val[j]) { btab[(2 * j + half) * 256 + c] = bv[j]; if constexpr (WTAB) wtab[(2 * j + half) * 256 + c] = wv[j]; }
    __syncthreads();
}
__device__ __forceinline__ void phase_gateup(const Params& p, LAS unsigned char* lds) {
    LAS int* pt = (LAS int*)(lds + LDS_MISC); LAS int* cn = pt + 64;
    moe_tables(p, pt, cn);
    if constexpr (MOE_F8) { SchedMoe<true, 16, true> S{p.ws, pt, cn}; EpiSwiglu8 E{p.ws, p.in[15], pt}; moe_fill_tokl(p, lds, S, cn); moe_fill_tabs<SchedMoe<true, 16, true>, false>(p, lds, S, cn, p.in[15], 4096);
        unsigned long long* prof = PROFSEL == 7 ? (unsigned long long*)(p.ws + WS_CTL + 32768) : nullptr;
        const bool stag = MOE_SLOT && (gridDim.x == 256);
        if (stag) {
            const int g = (int)blockIdx.x >> 6, a = MOE_SLOT_STEP * g;
            if (a > 0) { SchedMoe<true, 16, true> Sa{p.ws, pt, cn, 0, 0, a}; gemm_phase<EpiSwiglu8, SchedMoe<true, 16, true>, MOE_ALIGN, 1>(lds, 2048, 2048, 2048, Sa, E, nullptr); }
            if constexpr (MOE_SLOT_BAL) {
                const int U = S.ptu(NE) * 16, rmax = (U + 255) >> 8, me = (int)blockIdx.x & 63;
                int totd = 0, dme = 0, dbefore = 0;
#pragma unroll 1
                for (int i = 0; i < 64; ++i) { const int c = 64 * g + i, v = (c & 7) * 32 + (c >> 3); const int r = (v < U) ? ((U - v + 255) >> 8) : 0; int d = rmax - r;
#ifdef MOE_BAL_TEST
                    d = (i * 7 + g) % 3 == 0 ? 1 : 0;
#endif
                    totd += d; if (i < me) dbefore += d; if (i == me) dme = d; }
                constexpr int GT = 1024 - 64 * POOL7;
                const int n0 = (GT - MOE_SLOT_BAL * totd) / 64, rem = GT - 64 * n0 - MOE_SLOT_BAL * totd;
                const long base = CV_NONEXP + 8192 + (long)GT * g;
                const int xs = 64 * n0 + MOE_SLOT_BAL * dbefore + (me < rem ? me : rem), xn = MOE_SLOT_BAL * dme + (me < rem ? 1 : 0);
                __syncthreads();
                convert_items(p, lds, base, base + 64 * n0, me, 64);
                if (xn > 0) convert_items(p, lds, base + xs, base + xs + xn, 0, 1);
                asm volatile("s_waitcnt vmcnt(0) lgkmcnt(0)" ::: "memory");
                __syncthreads();
            } else proj_convert_slot(p, lds, g, 2);
            moe_fill_tokl(p, lds, S, cn);
            SchedMoe<true, 16, true> Sb{p.ws, pt, cn, 0, a, 1 << 20}; gemm_phase<EpiSwiglu8, SchedMoe<true, 16, true>, MOE_ALIGN, 1>(lds, 2048, 2048, 2048, Sb, E, prof);
            if (POOL7 > 0) pool_drain(p, lds, 1, CV_NONEXP + 12288 - 256 * POOL7, 256 * POOL7);
        } else gemm_phase<EpiSwiglu8, SchedMoe<true, 16, true>, MOE_ALIGN, 1>(lds, 2048, 2048, 2048, S, E, prof); }
    else { SchedMoe<true, 16, false> S{p.ws, pt, cn}; EpiSwiglu E{p.ws, p.in[15], pt}; moe_fill_tokl(p, lds, S, cn);
        gemm_phase<EpiSwiglu, SchedMoe<true, 16, false>, true>(lds, 2048, 2048, 2048, S, E); }
}
__device__ __forceinline__ void phase_down(const Params& p, LAS unsigned char* lds) {
    LAS int* pt = (LAS int*)(lds + LDS_MISC); LAS int* cn = pt + 64;
    moe_tables(p, pt, cn);
    if constexpr (MOE_F8) { SchedMoe<false, 8, true> S{p.ws, pt, cn}; EpiDown8 E{p.ws, p.in[17], pt, cn}; moe_fill_tabs<SchedMoe<false, 8, true>, true>(p, lds, S, cn, p.in[17], 2048); gemm_phase<EpiDown8, SchedMoe<false, 8, true>, MOE_ALIGN, 1>(lds, 2048, 2048, 2048, S, E, PROFSEL == 8 ? (unsigned long long*)(p.ws + WS_CTL + 32768) : nullptr); }
    else { SchedMoe<false, 8, false> S{p.ws, pt, cn}; EpiDown E{p.ws, p.in[17], pt, cn}; gemm_phase<EpiDown, SchedMoe<false, 8, false>, true>(lds, 2048, 2048, 2048, S, E); }
#ifdef SHADOW
    if constexpr (MOE_F8) { __syncthreads(); SchedMoe<false, 8, true> S{p.ws, pt, cn, SHADOW - 1}; EpiDown8 E{p.ws, p.in[17], pt, cn, (WS_FAST_END + 4095) & ~(size_t)4095};
        gemm_phase<EpiDown8, SchedMoe<false, 8, true>, MOE_ALIGN, 1>(lds, 2048, 2048, 2048, S, E, nullptr); }
#endif
}
__device__ __forceinline__ void phase_out(const Params& p, LAS unsigned char* lds) {
    LAS int* pt = (LAS int*)(lds + LDS_MISC); LAS int* cn = pt + 64;
    moe_tables(p, pt, cn);
    phase_final(p, pt);
}

template <int PH> __global__ void __launch_bounds__(NTHR, 2) k_phase(Params p) {
    extern __shared__ __attribute__((aligned(16))) unsigned char lds_raw[];
    LAS unsigned char* lds = (LAS unsigned char*)lds_raw;
    if constexpr (PH == 0) phase_prologue(p, lds);
    if constexpr (PH == 1) phase_proj(p, lds);
    if constexpr (PH == 2) phase_mixers(p, lds);
    if constexpr (PH == 3) phase_seqdft(p, lds);
    if constexpr (PH == 4) phase_mix(p, lds);
    if constexpr (PH == 5) phase_x2(p, lds);
    if constexpr (PH == 6) phase_rows(p, lds);
    if constexpr (PH == 7) phase_gateup(p, lds);
    if constexpr (PH == 8) phase_down(p, lds);
    if constexpr (PH == 9) phase_out(p, lds);
}
template <int PH> static void launch_phase(const Params& p, hipStream_t st) {
    static bool attr_done = false;
    if (!attr_done) { (void)hipFuncSetAttribute((const void*)k_phase<PH>, hipFuncAttributeMaxDynamicSharedMemorySize, LDS_BYTES); attr_done = true; }
    hipLaunchKernelGGL(k_phase<PH>, dim3(256), dim3(NTHR), LDS_BYTES, st, p);
}
static void run_fast_multi(const Params& p, hipStream_t st, int lo, int hi) {
    if (lo <= 0 && 0 < hi) launch_phase<0>(p, st);
    if (lo <= 1 && 1 < hi) launch_phase<1>(p, st);
    if (lo <= 2 && 2 < hi) launch_phase<2>(p, st);
    if (lo <= 3 && 3 < hi) launch_phase<3>(p, st);
    if (lo <= 4 && 4 < hi) launch_phase<4>(p, st);
    if (lo <= 5 && 5 < hi) launch_phase<5>(p, st);
    if (lo <= 6 && 6 < hi) launch_phase<6>(p, st);
    if (lo <= 7 && 7 < hi) launch_phase<7>(p, st);
    if (lo <= 8 && 8 < hi) launch_phase<8>(p, st);
    if (lo <= 9 && 9 < hi) launch_phase<9>(p, st);
}
#define XB_TMO      128
#define XB_XCNT(j)  (256  + 64 * (j))
#define XB_XSUB(j)  (1280 + 64 * (j))
#define XB_XGEN(j)  (2304 + 64 * (j))
#define XB_TOP      3328
#define XB_TOPGEN   3392
#define XCD_BAR_WORDS 3456
#define XB_SPIN_CAP (1u << 18)

__device__ __forceinline__ unsigned xb_ld(unsigned* p)              { return __hip_atomic_load(p, __ATOMIC_RELAXED, __HIP_MEMORY_SCOPE_AGENT); }
__device__ __forceinline__ unsigned xb_add(unsigned* p, unsigned v) { return __hip_atomic_fetch_add(p, v, __ATOMIC_RELAXED, __HIP_MEMORY_SCOPE_AGENT); }
__device__ __forceinline__ unsigned xb_xcc_id() { return (unsigned)__builtin_amdgcn_s_getreg((3 << 11) | 20) & 0xFu; }
#define XB_SPIN(cond, bar) do { unsigned _sp = 0; while (cond) { __builtin_amdgcn_s_sleep(1); \
    if ((++_sp & 255u) == 0u) { if (xb_ld(&(bar)[XB_TMO])) break; if (_sp > XB_SPIN_CAP) { atomicAdd(&(bar)[XB_TMO], 1u); break; } } } } while (0)

struct XcdBarrier {
    unsigned* bar; unsigned x;
    volatile LAS unsigned* st;
};

__device__ __forceinline__ XcdBarrier xcd_barrier_post(unsigned* bar, volatile LAS unsigned* st) {
    XcdBarrier b; b.bar = bar; b.x = xb_xcc_id(); b.st = st;
    if (threadIdx.x == 0) (void)xb_add(&bar[XB_XCNT(b.x)], 1u);
    return b;
}
__device__ __forceinline__ void xcd_barrier_complete(unsigned* bar, unsigned x, unsigned& nloc, unsigned& nx) {
    const unsigned G = gridDim.x * gridDim.y * gridDim.z;
    unsigned sum, cnt, mine, sp = 0u;
    for (;;) {
        sum = 0u; cnt = 0u; mine = 0u;
#pragma unroll
        for (unsigned j = 0; j < 16; ++j) { const unsigned c = xb_ld(&bar[XB_XCNT(j)]); sum += c; cnt += (c > 0u) ? 1u : 0u; mine = (j == x) ? c : mine; }
        if (sum == G) break;
        __builtin_amdgcn_s_sleep(1);
        if ((++sp & 255u) == 0u) { if (xb_ld(&bar[XB_TMO])) break; if (sp > XB_SPIN_CAP) { atomicAdd(&bar[XB_TMO], 1u); break; } }
    }
    nloc = mine > 0u ? mine : 1u; nx = cnt > 0u ? cnt : 1u;
}

__device__ __forceinline__ void xcd_barrier(const XcdBarrier& b) {
    asm volatile("s_waitcnt vmcnt(0)" ::: "memory");
    __syncthreads();
    if (threadIdx.x == 0) {
        unsigned* bar = b.bar;
        __builtin_amdgcn_s_waitcnt(0);
        unsigned nloc = b.st[0], nx = b.st[1];
        if (nloc == 0u) { xcd_barrier_complete(bar, b.x, nloc, nx); b.st[0] = nloc; b.st[1] = nx; }
        const unsigned old = xb_add(&bar[XB_XSUB(b.x)], 1u);
        const unsigned gen = old / nloc;
        if (old + 1u == (gen + 1u) * nloc) {
            __builtin_amdgcn_fence(__ATOMIC_RELEASE, "agent");
            asm volatile("s_waitcnt vmcnt(0)" ::: "memory");
            const unsigned og = xb_add(&bar[XB_TOP], 1u);
            const unsigned tg = og / nx;
            if (og + 1u == (tg + 1u) * nx) xb_add(&bar[XB_TOPGEN], 1u);
            else XB_SPIN(xb_ld(&bar[XB_TOPGEN]) == tg, bar);
            __builtin_amdgcn_fence(__ATOMIC_ACQUIRE, "agent");
            xb_add(&bar[XB_XGEN(b.x)], 1u);
            asm volatile("s_waitcnt vmcnt(0)" ::: "memory");
        } else {
            XB_SPIN(xb_ld(&bar[XB_XGEN(b.x)]) == gen, bar);
            __builtin_amdgcn_fence(__ATOMIC_ACQUIRE, "agent");
            asm volatile("s_waitcnt vmcnt(0)" ::: "memory");
        }
    }
    __syncthreads();
}

__global__ void __launch_bounds__(NTHR, 2) mega_fwd(Params p) {
    extern __shared__ __attribute__((aligned(16))) unsigned char lds_raw[];
    LAS unsigned char* lds = (LAS unsigned char*)lds_raw;
    volatile LAS unsigned* xbw = (volatile LAS unsigned*)(lds + LDS_XBW);
    if (threadIdx.x < 4) xbw[threadIdx.x] = 0u;
    __syncthreads();
    XcdBarrier bar = xcd_barrier_post((unsigned*)(p.ws + WS_CTL) + CW_BAR, xbw);
#ifndef DBL
#define DBL 0
#endif
#ifndef SKEWPH
#define SKEWPH -1
#endif
#define RUNPH(i, call) do { call; if constexpr ((DBL >> (i)) & 1) { xcd_barrier(bar); call; } \
    if constexpr (SKEWPH == (i)) { if (threadIdx.x == 0) ((unsigned long long*)(p.ws + WS_CTL + 40960))[blockIdx.x] = wall_clock64(); } } while (0)
    RUNPH(0, phase_prologue(p, lds));  xcd_barrier(bar);
    RUNPH(1, phase_proj(p, lds));      xcd_barrier(bar);
    RUNPH(2, phase_mixers(p, lds));    xcd_barrier(bar);
    RUNPH(3, phase_seqdft(p, lds));    xcd_barrier(bar);
    RUNPH(4, phase_mix(p, lds));       xcd_barrier(bar);
    RUNPH(5, phase_x2(p, lds));        xcd_barrier(bar);
    phase_rows(p, lds);                xcd_barrier(bar);
    RUNPH(7, phase_gateup(p, lds));    xcd_barrier(bar);
    RUNPH(8, phase_down(p, lds));      xcd_barrier(bar);
    phase_out(p, lds);
}
static void run_fast_one(const Params& p, hipStream_t st) {
    static int grid = 0;
    if (!grid) {
        int dev = 0, cus = 0, per_cu = 0;
        (void)hipGetDevice(&dev); (void)hipDeviceGetAttribute(&cus, hipDeviceAttributeMultiprocessorCount, dev);
        (void)hipFuncSetAttribute((const void*)mega_fwd, hipFuncAttributeMaxDynamicSharedMemorySize, LDS_BYTES);
        (void)hipOccupancyMaxActiveBlocksPerMultiprocessor(&per_cu, (const void*)mega_fwd, NTHR, LDS_BYTES);
        if (per_cu < 1) per_cu = 1;
        grid = cus > 256 ? 256 : cus;
        grid &= ~7; if (grid < 8) grid = 8;
    }
    hipLaunchKernelGGL(mega_fwd, dim3(grid), dim3(NTHR), LDS_BYTES, st, p);
}
}
#ifndef REPORT
#define REPORT 0
#endif
extern "C" void kernel_launch(void* const* d_in, const int* in_sizes, int n_in, void* d_out, int out_size, void* d_ws, size_t ws_size, hipStream_t stream) {
    (void)in_sizes; (void)n_in; (void)out_size; (void)ws_size;
    unsigned char* ws = (unsigned char*)d_ws;
#if MODE == 0
    nv::NBuf nb; nv::carve(nb, ws);
    nv::run_part1(d_in, nb, stream); nv::run_part2(d_in, nb, (float*)d_out, stream);
#elif MODE == 1
    constexpr size_t NAIVE_BASE = (fx::WS_FAST_END + 4095) & ~(size_t)4095;
    nv::NBuf nb; const size_t nbytes = nv::carve(nb, ws + NAIVE_BASE);
    float* fout = (float*)(ws + NAIVE_BASE + ((nbytes + 4095) & ~(size_t)4095));
    double* acc = (double*)(fout + (size_t)16384 * 2048); float* scale = (float*)(acc + 64);
    fx::Params p; memset(&p, 0, sizeof(p));
    for (int i = 0; i < 19; ++i) p.in[i] = (const float*)d_in[i];
    p.out = fout; p.ws = ws;
    (void)hipMemsetAsync(ws + fx::WS_CTL, 0, fx::CTL_BYTES, stream);
    (void)hipMemsetAsync(acc, 0, 1024, stream);
    nv::run_part1(d_in, nb, stream);
    fx::run_fast_multi(p, stream, 0, 7);
    auto cmp = [&](int slot, int kind, const void* a, const float* ref, long long n, int w, int ldf, int ldr, int off, int sig) {
        ck::CP c; memset(&c, 0, sizeof(c)); c.a = a; c.ref = ref; c.n = n; c.kind = kind; c.w = w; c.ldf = ldf; c.ldr = ldr; c.off = off; c.sig = sig; c.slot = slot;
        hipLaunchKernelGGL(ck::k_cmp, dim3(2048), dim3(256), 0, stream, c, acc); };
    const long long T = 16384;
    cmp(0, 0, ws + fx::WS_FIN, nb.proj, T * 1024, 1024, 1024, 10752, 0, 0);
    cmp(1, 0, ws + fx::WS_Q, nb.proj, T * 2048, 2048, 2048, 10752, 1024, 0);
    cmp(2, 0, ws + fx::WS_K, nb.proj, T * 256, 256, 256, 10752, 3072, 0);
    cmp(3, 2, ws + fx::WS_VT, nb.proj, T * 256, 0, 0, 0, 0, 0);
    cmp(4, 0, ws + fx::WS_QM, nb.proj, T * 1024, 1024, 1024, 10752, 3584, 0);
    cmp(5, 0, ws + fx::WS_GATES, nb.proj, T * 6144, 6144, 6144, 10752, 4608, 1);
    cmp(6, 0, ws + fx::WS_KMK, nb.kvm, 2048LL * 1024, 1024, 1024, 2048, 0, 0);
    cmp(7, 3, ws + fx::WS_VMT, nb.kvm, 2048LL * 1024, 0, 0, 0, 0, 0);
    cmp(8, 0, ws + fx::WS_ATT, nb.att, T * 2048, 2048, 2048, 2048, 0, 0);
    cmp(9, 0, ws + fx::WS_XM, nb.xm, T * 1024, 1024, 1024, 1024, 0, 0);
    cmp(10, 0, ws + fx::WS_FM, nb.fm, T * 1024, 1024, 1024, 1024, 0, 0);
    cmp(11, 0, ws + fx::WS_MIXED, nb.mixed, T * 2048, 2048, 2048, 2048, 0, 0);
    cmp(12, 1, ws + fx::WS_X2, nb.x2, T * 2048, 2048, 2048, 2048, 0, 0);
    cmp(13, 0, ws + fx::WS_H2, nb.h2, T * 2048, 2048, 2048, 2048, 0, 0);
    hipLaunchKernelGGL(ck::k_cmp_route, dim3(64), dim3(256), 0, stream, (const int*)(ws + fx::WS_TOKE), (const int*)nb.tope, acc, 14);
    nv::run_part2(d_in, nb, nb.nout, stream);
    fx::run_fast_multi(p, stream, 7, 10);
    cmp(15, 1, fout, nb.nout, T * 2048, 2048, 2048, 2048, 0, 0);
    hipLaunchKernelGGL(ck::k_verdict, dim3(1), dim3(64), 0, stream, (const double*)acc, scale, 16, (int)REPORT);
    hipLaunchKernelGGL(ck::k_scale_out, dim3(2048), dim3(256), 0, stream, (const float*)nb.nout, (const float*)scale, (float*)d_out, T * 2048);
#elif MODE == 2
    fx::Params p; memset(&p, 0, sizeof(p));
    for (int i = 0; i < 19; ++i) p.in[i] = (const float*)d_in[i];
    p.out = (float*)d_out; p.ws = ws;
    (void)hipMemsetAsync(ws + fx::WS_CTL, 0, fx::CTL_BYTES, stream);
    fx::run_fast_multi(p, stream, 0, 10);
#elif MODE == 3
    fx::Params p; memset(&p, 0, sizeof(p));
    for (int i = 0; i < 19; ++i) p.in[i] = (const float*)d_in[i];
    p.out = (float*)d_out; p.ws = ws;
    (void)hipMemsetAsync(ws + fx::WS_CTL, 0, fx::CTL_BYTES, stream);
    fx::run_fast_one(p, stream);
#endif
}
```

```cpp
#include <hip/hip_runtime.h>
#include <stdint.h>
#include <string.h>
#ifndef MODE
#define MODE 3
#endif
namespace fx {
#define LAS __attribute__((address_space(3)))
typedef unsigned short bf16_t;
typedef short bf16x8 __attribute__((ext_vector_type(8)));
typedef short s16x4 __attribute__((ext_vector_type(4)));
typedef float f32x4 __attribute__((ext_vector_type(4)));
typedef float f32x16 __attribute__((ext_vector_type(16)));
typedef float f32x2 __attribute__((ext_vector_type(2)));
typedef __bf16 bf16x2_t __attribute__((ext_vector_type(2)));
typedef unsigned u32x4 __attribute__((ext_vector_type(4)));
typedef unsigned u32x2 __attribute__((ext_vector_type(2)));

constexpr int NTHR = 512, NWAVE = 8;
constexpr int B_ = 8, S_ = 2048, DM = 2048, T_ = B_ * S_;
constexpr int MEM = 256, FW = 1024, FG = 4, FGD = 256;
constexpr int NH = 32, NKV = 4, HD = 64, AW = 2048, KVW = 256, WIN = 128;
constexpr int MH = 4, MHD = 256, MW = 1024;
constexpr int NE = 32, TOPK = 4, DFF = 2048;
constexpr int INW = 10752;
#ifndef LDPAD
#define LDPAD 0
#endif
#ifndef ROUTER_ON_X2
#define ROUTER_ON_X2 1
#endif
#ifndef SEQFOLD
#define SEQFOLD 1
#endif
#ifndef SQPAD
#define SQPAD 0
#endif
constexpr int LDP = 2048 + LDPAD;
constexpr int NSLOT = T_ * TOPK + NE * 256;
constexpr float LOG2E = 1.4426950408889634f;
#ifndef MOE_FP8
#define MOE_FP8 1
#endif
constexpr bool MOE_F8 = (MOE_FP8 != 0);
#ifndef GATES_FP8
#define GATES_FP8 1
#endif
constexpr bool GATES_F8 = (GATES_FP8 != 0);
#ifndef CONV_TILE32
#define CONV_TILE32 0
#endif
#ifndef MOE_ALIGN
#define MOE_ALIGN true
#endif
#ifndef PROFSEL
#define PROFSEL 0
#endif
#ifndef PROFMETRIC
#define PROFMETRIC 0
#endif
#ifndef PROFMUL
#define PROFMUL 1
#endif
#ifndef PROFBLK
#define PROFBLK 0
#endif

constexpr size_t al256(size_t x) { return (x + 255) & ~(size_t)255; }
constexpr size_t WS_CTL = 0, CTL_BYTES = 65536;
constexpr size_t WS_WINT = 1u << 20;
constexpr size_t WS_WMKVT = WS_WINT + (size_t)INW * LDP * 2;
constexpr size_t WS_WFOT = WS_WMKVT + (size_t)2048 * LDP * 2;
constexpr size_t WS_WAOT = WS_WFOT + (size_t)2048 * 1024 * 2;
constexpr size_t WS_WMOT = WS_WAOT + (size_t)2048 * 2048 * 2;
constexpr size_t WS_WOT = WS_WMOT + (size_t)2048 * 1024 * 2;
constexpr size_t WS_WRT = WS_WOT + (size_t)2048 * 2048 * 2;
constexpr size_t WS_TABT = WS_WRT + (size_t)NE * DM * 2;
constexpr size_t WS_DMAT = WS_TABT + (size_t)512 * 256 * 2;
constexpr int SQK = SEQFOLD ? 1024 : 4096;
constexpr int DQP = SQK + SQPAD;
constexpr int SQP = (SEQFOLD ? 2048 : 4096) + SQPAD;
constexpr size_t WS_WGUT = WS_DMAT + (size_t)2048 * DQP * 2;
constexpr size_t WS_WDNT = WS_WGUT + (size_t)NE * 4096 * 2048 * 2;
constexpr size_t WS_H = WS_WDNT + (size_t)NE * 2048 * 2048 * 2;
constexpr size_t WS_MEMBF = WS_H + (size_t)T_ * LDP * 2;
constexpr size_t WS_FIN = WS_MEMBF + (size_t)2048 * LDP * 2;
constexpr size_t WS_Q = WS_FIN + (size_t)T_ * FW * 2;
constexpr size_t WS_K = WS_Q + (size_t)T_ * AW * 2;
constexpr size_t WS_VT = WS_K + (size_t)T_ * KVW * 2;
constexpr size_t WS_QM = WS_VT + (size_t)T_ * KVW * 2;
constexpr size_t WS_GATES = WS_QM + (size_t)T_ * MW * 2;
constexpr size_t WS_KMK = WS_GATES + (size_t)T_ * 3 * DM * 2;
constexpr size_t WS_VMT = WS_KMK + (size_t)2048 * 1024 * 2;
constexpr size_t WS_ZT = WS_VMT + (size_t)2048 * 1024 * 2;
constexpr size_t WS_FM = WS_ZT + (size_t)32 * 256 * SQP * 2;
constexpr size_t WS_ATT = WS_FM + (size_t)T_ * FW * 2;
constexpr size_t WS_PM = WS_ATT + (size_t)T_ * AW * 2;
constexpr size_t WS_XM = WS_PM + (size_t)T_ * MH * 256 * 2;
constexpr size_t WS_MIXACC = WS_XM + (size_t)T_ * MW * 2;
constexpr size_t WS_MIXED = WS_MIXACC + (size_t)T_ * DM * 4;
constexpr size_t WS_XF = WS_MIXED;
constexpr size_t WS_FX = WS_MIXACC;
constexpr size_t WS_WFM = WS_MIXACC + (size_t)T_ * 2048 * 2;
constexpr size_t WS_IRSTD = WS_WFM + (size_t)2048 * 2048 * 2;
static_assert(WS_IRSTD + (size_t)T_ * 4 <= WS_MIXED, "fused-mix operands fit the old mixacc region");
constexpr size_t WS_X2 = WS_MIXED + (size_t)T_ * DM * 2;
constexpr size_t WS_H2 = WS_X2 + (size_t)T_ * DM * 4;
constexpr size_t WS_TOKE = WS_H2 + (size_t)T_ * DM * 2;
constexpr size_t WS_TOKPOS = WS_TOKE + (size_t)T_ * 4 * 4;
constexpr size_t WS_TOKW = WS_TOKPOS + (size_t)T_ * 4 * 4;
constexpr size_t WS_LIST = WS_TOKW + (size_t)T_ * 4 * 4;
constexpr size_t WS_WLIST = WS_LIST + (size_t)NE * T_ * 4;
constexpr size_t WS_WGUQ = WS_WLIST + (size_t)NE * T_ * 4;
constexpr size_t WS_WDNQ = WS_WGUQ + (size_t)NE * 4096 * 2048;
constexpr size_t WS_H2Q = WS_WDNQ + (size_t)NE * 2048 * 2048;
constexpr size_t WS_H8 = WS_H2Q + (size_t)T_ * DM;
constexpr size_t WS_WINQ = WS_H8 + (size_t)T_ * DM;
constexpr size_t WS_FAST_END = WS_WINQ + (size_t)6144 * DM;
constexpr size_t WS_ACTQ = WS_H;
constexpr float WQ_SCALE = 32.0f, WQ_INV = 1.0f / 32.0f;
constexpr float YS_SCALE = 16.0f, YS_INV = 1.0f / 16.0f;
constexpr size_t WS_ACT = WS_H;
constexpr size_t WS_YS = WS_ACT + (size_t)NSLOT * DFF * 2;
static_assert(WS_YS + (size_t)NSLOT * DM * 2 <= WS_MIXED, "overlay fits");
constexpr int CW_CNT = 0;
constexpr int CW_POOL = 64;
constexpr int CW_BAR = 4096;

constexpr int LDS_STAGE = 0, STAGE_BYTES = 131072;
constexpr int LDS_TOKL = 131072;
constexpr int LDS_MISC = 141312;
constexpr int LDS_BTAB = 142336;
constexpr int LDS_XBW = 163824;
constexpr int LDS_BYTES = 163840;

struct Params {
    const float* in[19]; float* out; unsigned char* ws;
};

__device__ __forceinline__ unsigned cvtpk(float lo, float hi) { f32x2 v = {lo, hi}; bf16x2_t b = __builtin_convertvector(v, bf16x2_t); return __builtin_bit_cast(unsigned, b); }
__device__ __forceinline__ float bf2f(unsigned short x) { return __uint_as_float(((unsigned)x) << 16); }
__device__ __forceinline__ float bflo(unsigned w) { return __uint_as_float(w << 16); }
__device__ __forceinline__ float bfhi(unsigned w) { return __uint_as_float(w & 0xffff0000u); }
__device__ __forceinline__ float wsum(float v) {
#pragma unroll
    for (int o = 1; o < 64; o <<= 1) v += __shfl_xor(v, o);
    return v;
}
__device__ __forceinline__ float sigmoid_sc(float x, float nsc) { return __builtin_amdgcn_rcpf(1.0f + __builtin_amdgcn_exp2f(x * nsc)); }
__device__ __forceinline__ float sigmoidf_(float x) { return __builtin_amdgcn_rcpf(1.0f + __builtin_amdgcn_exp2f(-x * LOG2E)); }
__device__ __forceinline__ int crow(int r, int h) { return (r & 3) + 8 * (r >> 2) + 4 * h; }
__device__ __forceinline__ int t5_bucket(int rel) {
    const int n = rel < 0 ? -rel : rel;
    int b;
    if (n < 8) b = n; else if (n < 12) b = 8; else if (n < 16) b = 9; else if (n < 23) b = 10; else if (n < 32) b = 11;
    else if (n < 46) b = 12; else if (n < 64) b = 13; else if (n < 91) b = 14; else b = 15;
    return (rel > 0 ? 16 : 0) + b;
}
__device__ __forceinline__ int vwg() { const int c = blockIdx.x, G = gridDim.x; return ((G & 7) == 0) ? (c & 7) * (G >> 3) + (c >> 3) : c; }

constexpr int BM = 256, BK = 64, HALF = 128, HTB = HALF * BK * 2;
__host__ __device__ __forceinline__ int lds_byte(int r, int c) { const int st = (r >> 4) * 2 + (c >> 5), rr = r & 15, cc = c & 31, ob = rr * 64 + cc * 2; return st * 1024 + (ob ^ (((ob >> 9) & 1) << 5)); }
__host__ __device__ __forceinline__ void stage_rc(int b, int& R, int& C) { const int st = b / 1024, sb = b % 1024, swz = sb ^ (((sb >> 9) & 1) << 5); R = (st >> 1) * 16 + swz / 64; C = (st & 1) * 32 + (swz % 64) / 2; }
__host__ __device__ __forceinline__ int perm32(int rho) { const int n = rho >> 4, i = rho & 15; return 8 * (i >> 2) + 4 * n + (i & 3); }

struct Unit { int pm, pn, z, idx; };
template <class S, class = void> struct SchedVarK { static constexpr bool v = false; };
template <class S> struct SchedVarK<S, decltype((void)S::VARK)> { static constexpr bool v = S::VARK; };
template <class E, class = void> struct EpiTouch { static constexpr bool v = false; };
template <class E> struct EpiTouch<E, decltype((void)E::TOUCH)> { static constexpr bool v = E::TOUCH; };
template <class E, class = void> struct EpiKeep { static constexpr bool v = false; };
template <class E> struct EpiKeep<E, decltype((void)E::KEEP)> { static constexpr bool v = E::KEEP; };
typedef int v4i_t __attribute__((ext_vector_type(4)));
typedef int v8i_t __attribute__((ext_vector_type(8)));
__device__ __forceinline__ void mfma_f8(f32x4& c, const v8i_t& a, const v8i_t& b) { asm volatile("v_mfma_f32_16x16x128_f8f6f4 %0, %1, %2, %0" : "+v"(c) : "v"(a), "v"(b)); }
template <int ESZ> struct FragT;
template <> struct FragT<2> { struct A4 { bf16x8 v[4][2]; }; struct B2 { bf16x8 v[2][2]; }; };
template <> struct FragT<1> { struct A4 { v8i_t v[4]; }; struct B2 { v8i_t v[2]; }; };
__device__ __forceinline__ v8i_t cat8(bf16x8 a, bf16x8 b) { return __builtin_shufflevector(__builtin_bit_cast(v4i_t, a), __builtin_bit_cast(v4i_t, b), 0, 1, 2, 3, 4, 5, 6, 7); }

template <class Epi, class Sched, bool ALIGN_EPI, int ESZ = 2  >
__device__ __forceinline__ void gemm_phase(LAS unsigned char* lds, const int K, const int lda, const int ldb, const Sched& S, const Epi& E, unsigned long long* prof = nullptr) {
    unsigned long long pf_kl = 0, pf_ep = 0, pf_t0 = 0, pf_t1 = 0, pf_n = 0; const unsigned long long pf_w0 = prof ? wall_clock64() : 0ull, pf_c0 = prof ? clock64() : 0ull;
    int tid_ = threadIdx.x; asm volatile("" : "+v"(tid_));
    const int tid = tid_, wid = __builtin_amdgcn_readfirstlane(tid >> 6), lane = tid & 63, wr = wid >> 2, wc = wid & 3, fr = lane & 15, fq = lane >> 4;
    const int nt = (K * ESZ) / (BK * 2);
    constexpr bool GATHER = Sched::GATHER;
    unsigned voffA[2], voffB[2]; int Rr[2], Cb[2];
#pragma unroll
    for (int i = 0; i < 2; ++i) { int R, C; stage_rc(tid * 16 + i * 8192, R, C);
        int Rb = R;
        if constexpr ((int)Epi::PERM == 1) Rb = (R & ~31) + perm32(R & 31);
        if constexpr ((int)Epi::PERM == 2) Rb = 64 * (R >> 5) + 16 * ((R >> 2) & 3) + 4 * ((R >> 4) & 1) + (R & 3);
        voffA[i] = (unsigned)(R * lda * ESZ + C * 2); voffB[i] = (unsigned)(Rb * ldb * ESZ + C * 2); Rr[i] = R; Cb[i] = C * 2; }
    const size_t kstep = (size_t)(BK * 2);
    const size_t hstepA = (size_t)HALF * lda * ESZ, hstepB = (size_t)(((int)Epi::PERM == 2) ? 8 : HALF) * ldb * ESZ;
    const unsigned ldsw = (unsigned)wid * 1024u;
    const int aoff = lds_byte(wr * 64 + fr, fq * 8), boff = lds_byte(wc * 32 + fr, fq * 8);
#define PG8_SA(b, h) (((b) * 2 + (h)) * HTB)
#define PG8_SB(b, h) ((4 + (b) * 2 + (h)) * HTB)
#define PG8_STAGE(bufoff, gbase, voff) do { _Pragma("unroll") for (int _i = 0; _i < 2; ++_i) \
        __builtin_amdgcn_global_load_lds((const unsigned*)((const char*)(gbase) + (voff)[_i]), (LAS unsigned*)(lds + (bufoff) + ldsw + _i * 8192), 16, 0, 0); } while (0)
#define PG8_STAGE_A(bufoff, gbase, h, NX) do { if constexpr (GATHER) { _Pragma("unroll") for (int _i = 0; _i < 2; ++_i) { const unsigned _o = (NX) ? naoff[h][_i] : caoff[h][_i]; \
        __builtin_amdgcn_global_load_lds((const unsigned*)((const char*)(gbase) + _o), (LAS unsigned*)(lds + (bufoff) + ldsw + _i * 8192), 16, 0, 0); } } \
        else { PG8_STAGE(bufoff, (const char*)(gbase) + (h) * hstepA, voffA); } } while (0)
#define PG8_LDA(dst, b, h) do { _Pragma("unroll") for (int m = 0; m < 4; ++m) { if constexpr (ESZ == 2) { _Pragma("unroll") for (int k = 0; k < 2; ++k) dst.v[m][k] = *(const LAS bf16x8*)(lds + PG8_SA(b, h) + aoff + m * 2048 + k * 1024); } \
        else { const v4i_t _lo = *(const LAS v4i_t*)(lds + PG8_SA(b, h) + aoff + m * 2048), _hi = *(const LAS v4i_t*)(lds + PG8_SA(b, h) + aoff + m * 2048 + 1024); dst.v[m] = __builtin_shufflevector(_lo, _hi, 0, 1, 2, 3, 4, 5, 6, 7); } } } while (0)
#define PG8_LDB(dst, b, h) do { _Pragma("unroll") for (int n = 0; n < 2; ++n) { if constexpr (ESZ == 2) { _Pragma("unroll") for (int k = 0; k < 2; ++k) dst.v[n][k] = *(const LAS bf16x8*)(lds + PG8_SB(b, h) + boff + n * 2048 + k * 1024); } \
        else { const v4i_t _lo = *(const LAS v4i_t*)(lds + PG8_SB(b, h) + boff + n * 2048), _hi = *(const LAS v4i_t*)(lds + PG8_SB(b, h) + boff + n * 2048 + 1024); dst.v[n] = __builtin_shufflevector(_lo, _hi, 0, 1, 2, 3, 4, 5, 6, 7); } } } while (0)
#define PG8_MMA(ai, bj, At, Bt) do { __builtin_amdgcn_s_setprio(1); _Pragma("unroll") for (int m = 0; m < 4; ++m) _Pragma("unroll") for (int n = 0; n < 2; ++n) { \
        if constexpr (ESZ == 2) { _Pragma("unroll") for (int k = 0; k < 2; ++k) acc[ai][bj][m][n] = __builtin_amdgcn_mfma_f32_16x16x32_bf16(Bt.v[n][k], At.v[m][k], acc[ai][bj][m][n], 0, 0, 0); } \
        else { mfma_f8(acc[ai][bj][m][n], Bt.v[n], At.v[m]); } } \
        __builtin_amdgcn_s_setprio(0); } while (0)
#define PG8_WAIT_V(n) asm volatile("s_waitcnt vmcnt(" #n ")" ::: "memory")
#define PG8_WAIT_V8R do { if (relax) asm volatile("s_waitcnt vmcnt(%0)" :: "n"(8 + Epi::NSTORE) : "memory"); else PG8_WAIT_V(8); } while (0)
#define PG8_WAIT_L(n) asm volatile("s_waitcnt lgkmcnt(" #n ")" ::: "memory")
#define PG8_BAR __builtin_amdgcn_s_barrier()
#define PG8_SCHED __builtin_amdgcn_sched_barrier(0)
    Unit cur, nxt; int ui = 0;
    if (!S.next(0, cur)) return;
    f32x4 acc[2][2][4][2];
#pragma unroll
    for (int a = 0; a < 2; ++a)
#pragma unroll
        for (int b = 0; b < 2; ++b)
#pragma unroll
            for (int m = 0; m < 4; ++m)
#pragma unroll
                for (int n = 0; n < 2; ++n) acc[a][b][m][n] = (f32x4){0.f, 0.f, 0.f, 0.f};
    typedef typename FragT<ESZ>::A4 FragA; typedef typename FragT<ESZ>::B2 FragB;
    FragA At; FragB B0, B1;
    unsigned caoff[2][2] = {{0u, 0u}, {0u, 0u}}, naoff[2][2] = {{0u, 0u}, {0u, 0u}};
    if constexpr (GATHER) {
#pragma unroll
        for (int h = 0; h < 2; ++h)
#pragma unroll
            for (int i = 0; i < 2; ++i) { caoff[h][i] = S.arow(cur, h * HALF + Rr[i]) + (unsigned)Cb[i]; naoff[h][i] = caoff[h][i]; }
    }
    const char* cA = S.baseA(cur); const char* cB = S.baseB(cur);
    PG8_STAGE(PG8_SB(0, 0), cB, voffB); PG8_STAGE(PG8_SB(0, 1), cB + hstepB, voffB); PG8_STAGE_A(PG8_SA(0, 0), cA, 0, false); PG8_STAGE_A(PG8_SA(0, 1), cA, 1, false);
    if (wr == 1) PG8_BAR;
    PG8_WAIT_V(2); PG8_BAR;
    PG8_STAGE(PG8_SB(1, 0), cB + kstep, voffB); PG8_STAGE_A(PG8_SA(1, 0), cA + kstep, 0, false); PG8_STAGE(PG8_SB(1, 1), cB + hstepB + kstep, voffB);
    PG8_WAIT_V(6); PG8_BAR;
    for (;;) {
        const bool has_next = S.next(ui + 1, nxt);
        const char* nA = has_next ? S.baseA(nxt) : cA; const char* nB = has_next ? S.baseB(nxt) : cB;
        if constexpr (GATHER) {
            if (has_next) {
#pragma unroll
                for (int h = 0; h < 2; ++h)
#pragma unroll
                    for (int i = 0; i < 2; ++i) naoff[h][i] = S.arow(nxt, h * HALF + Rr[i]) + (unsigned)Cb[i];
            } else {
#pragma unroll
                for (int h = 0; h < 2; ++h)
#pragma unroll
                    for (int i = 0; i < 2; ++i) naoff[h][i] = caoff[h][i];
            }
        }
        if (prof) pf_t0 = clock64();
        if constexpr (EpiTouch<Epi>::v) E.touch(cur, lds, tid, wid);
        int ntu = nt; if constexpr (SchedVarK<Sched>::v) ntu = S.ktiles(cur);
#pragma unroll 1
        for (int t = 0; t < ntu; t += 2) {
            const bool last = (t == ntu - 2);
            const bool relax = (Epi::NSTORE > 0) && (t == 0) && (ui > 0);
            const char* a1 = cA + (size_t)(t + 1) * kstep;
            const char* a2 = last ? nA : cA + (size_t)(t + 2) * kstep; const char* b2 = last ? nB : cB + (size_t)(t + 2) * kstep;
            const char* a3 = a2 + kstep; const char* b3 = b2 + kstep;
            PG8_LDB(B0, 0, 0); PG8_LDB(B1, 0, 1); PG8_SCHED; PG8_LDA(At, 0, 0); PG8_STAGE_A(PG8_SA(1, 1), a1, 1, false);
            PG8_WAIT_V(8); PG8_WAIT_L(0); PG8_BAR; PG8_MMA(0, 0, At, B0); PG8_MMA(0, 1, At, B1); PG8_BAR; PG8_SCHED;
            PG8_LDA(At, 0, 1); PG8_STAGE(PG8_SB(0, 0), b2, voffB); PG8_STAGE(PG8_SB(0, 1), b2 + hstepB, voffB); PG8_STAGE_A(PG8_SA(0, 0), a2, 0, last);
            PG8_WAIT_V(8); PG8_WAIT_L(0); PG8_BAR; PG8_MMA(1, 0, At, B0); PG8_MMA(1, 1, At, B1); PG8_BAR; PG8_SCHED;
            PG8_LDB(B0, 1, 0); PG8_LDB(B1, 1, 1); PG8_SCHED; PG8_LDA(At, 1, 0); PG8_STAGE_A(PG8_SA(0, 1), a2, 1, last);
            PG8_WAIT_V(8); PG8_WAIT_L(0); PG8_BAR; PG8_MMA(0, 0, At, B0); PG8_MMA(0, 1, At, B1); PG8_BAR; PG8_SCHED;
            PG8_LDA(At, 1, 1); PG8_STAGE(PG8_SB(1, 0), b3, voffB); PG8_STAGE(PG8_SB(1, 1), b3 + hstepB, voffB); PG8_STAGE_A(PG8_SA(1, 0), a3, 0, last);
            PG8_WAIT_V(8); PG8_WAIT_L(0); PG8_BAR; PG8_MMA(1, 0, At, B0); PG8_MMA(1, 1, At, B1); PG8_BAR; PG8_SCHED;
        }
        if (prof) { pf_t1 = clock64(); pf_kl += pf_t1 - pf_t0; }
        if constexpr (ESZ == 1) asm volatile("s_nop 15\n\ts_nop 15" ::: "memory");
        if constexpr (ALIGN_EPI) { if (wr == 0) PG8_BAR; }
        if constexpr (!Epi::AFTER_DRAIN) { int fr_e = fr, fq_e = fq; asm volatile("" : "+v"(fr_e), "+v"(fq_e));
            E(acc, cur, wr, wc, fr_e, fq_e); }
        if (prof) { pf_ep += clock64() - pf_t1; ++pf_n; }
        if (!has_next) break;
        bool zero = true; if constexpr (EpiKeep<Epi>::v) zero = !E.keep(cur);
        if (zero) {
#pragma unroll
        for (int a = 0; a < 2; ++a)
#pragma unroll
            for (int b = 0; b < 2; ++b)
#pragma unroll
                for (int m = 0; m < 4; ++m)
#pragma unroll
                    for (int n = 0; n < 2; ++n) acc[a][b][m][n] = (f32x4){0.f, 0.f, 0.f, 0.f};
        }
        cur = nxt; cA = nA; cB = nB; ++ui;
        if constexpr (GATHER) {
#pragma unroll
            for (int h = 0; h < 2; ++h)
#pragma unroll
                for (int i = 0; i < 2; ++i) caoff[h][i] = naoff[h][i];
        }
        if constexpr (ALIGN_EPI) { if (wr == 1) PG8_BAR; }
    }
    PG8_WAIT_V(0);
    if constexpr (!ALIGN_EPI) { if (wr == 0) PG8_BAR; }
    PG8_BAR;
    if (prof && blockIdx.x == PROFBLK && tid == 0) { prof[0] = pf_kl; prof[1] = pf_ep; prof[2] = pf_n; prof[3] = (unsigned long long)nt; prof[4] = clock64() - pf_c0; prof[5] = wall_clock64() - pf_w0; }
    if constexpr (Epi::AFTER_DRAIN) { int fr_e = fr, fq_e = fq; asm volatile("" : "+v"(fr_e), "+v"(fq_e)); E.fused(acc, cur, wr, wc, fr_e, fq_e, lds, wid, lane); }
#undef PG8_SA
#undef PG8_SB
#undef PG8_STAGE
#undef PG8_STAGE_A
#undef PG8_LDA
#undef PG8_LDB
#undef PG8_MMA
#undef PG8_WAIT_V
#undef PG8_WAIT_V8R
#undef PG8_WAIT_L
#undef PG8_BAR
#undef PG8_SCHED
}
constexpr int NXCD = 8;
#ifndef GATE_STASH
#define GATE_STASH 1
#endif
#ifndef RES_FROM_H
#define RES_FROM_H 1
#endif
#ifndef EPI_TOUCH
#define EPI_TOUCH 0
#endif
#ifndef PROJ_WGM
#define PROJ_WGM 8
#endif
__device__ __forceinline__ void static_tile(int L, int nM, int nN, int& pm, int& pn, const int WGM = 8) {
    const int nwg = nM * nN; int wgid = L;
    { const int q = nwg / NXCD, r = nwg % NXCD, xcd = wgid % NXCD, off = wgid / NXCD; wgid = (xcd < r ? xcd * (q + 1) : r * (q + 1) + (xcd - r) * q) + off; }
    const int nig = WGM * nN, gid = wgid / nig, fm = gid * WGM, gsz = (nM - fm) < WGM ? (nM - fm) : WGM;
    pm = fm + ((wgid % nig) % gsz); pn = (wgid % nig) / gsz;
}
struct SchedPlain {
    static constexpr bool GATHER = false;
    const char* A; const char* Bt; size_t tstepA, tstepB; int nM, nN; int r0 = 0, r1 = 1 << 20;
    __device__ __forceinline__ bool next(int i, Unit& u) const { const int k = i + r0; if (k >= r1) return false;
        const int L = k * (int)gridDim.x + (int)blockIdx.x; if (L >= nM * nN) return false; static_tile(L, nM, nN, u.pm, u.pn); u.z = 0; return true; }
    __device__ __forceinline__ const char* baseA(const Unit& u) const { return A + (size_t)u.pm * tstepA; }
    __device__ __forceinline__ const char* baseB(const Unit& u) const { return Bt + (size_t)u.pn * tstepB; }
    __device__ __forceinline__ unsigned arow(const Unit&, int) const { return 0u; }
};
struct SchedProj {
    static constexpr bool GATHER = false;
    const unsigned char* ws; int r0, r1;
    __device__ __forceinline__ bool next(int i, Unit& u) const {
        if (i + r0 >= r1) return false;
        const int L = (i + r0) * (int)gridDim.x + (int)blockIdx.x;
        constexpr int NPB = GATES_F8 ? 18 : 42;
        if (L < 64 * NPB) { static_tile(L, 64, NPB, u.pm, u.pn, PROJ_WGM); u.z = (u.pn == 13) ? 2 : 0; return true; }
        const int L2 = L - 64 * NPB; if (L2 >= 64) return false;
        if (L2 < 32) { u.pm = L2 & 7; u.pn = L2 >> 3; u.z = 1; } else { u.pm = (L2 - 32) & 3; u.pn = (L2 - 32) >> 2; u.z = 3; }
        return true;
    }
    __device__ __forceinline__ const char* baseA(const Unit& u) const {
        const size_t ts = (size_t)256 * LDP * 2;
        if (u.z == 0) return (const char*)ws + WS_H + (size_t)u.pm * ts;
        if (u.z == 2) return (const char*)ws + WS_WINT + (size_t)13 * ts;
        if (u.z == 1) return (const char*)ws + WS_MEMBF + (size_t)u.pm * ts;
        return (const char*)ws + WS_WMKVT + (size_t)(4 + u.pm) * ts;
    }
    __device__ __forceinline__ const char* baseB(const Unit& u) const {
        const size_t ts = (size_t)256 * LDP * 2;
        if (u.z == 0) return (const char*)ws + WS_WINT + (size_t)u.pn * ts;
        if (u.z == 2) return (const char*)ws + WS_H + (size_t)u.pm * ts;
        if (u.z == 1) return (const char*)ws + WS_WMKVT + (size_t)u.pn * ts;
        return (const char*)ws + WS_MEMBF + (size_t)u.pn * ts;
    }
    __device__ __forceinline__ unsigned arow(const Unit&, int) const { return 0u; }
};
struct SchedGates8 {
    static constexpr bool GATHER = false;
    const unsigned char* ws; int r0, r1;
    __device__ __forceinline__ bool next(int i, Unit& u) const {
        if (i + r0 >= r1) return false;
        const int L = (i + r0) * (int)gridDim.x + (int)blockIdx.x; if (L >= 64 * 24) return false;
        static_tile(L, 64, 24, u.pm, u.pn, PROJ_WGM); u.z = 0; return true;
    }
    __device__ __forceinline__ const char* baseA(const Unit& u) const { return (const char*)ws + WS_H8 + (size_t)u.pm * (256 * 2048); }
    __device__ __forceinline__ const char* baseB(const Unit& u) const { return (const char*)ws + WS_WINQ + (size_t)u.pn * (256 * 2048); }
    __device__ __forceinline__ unsigned arow(const Unit&, int) const { return 0u; }
};
struct SchedChan {
    static constexpr bool GATHER = false;
    const unsigned char* ws; int u0, nu;
    __device__ __forceinline__ bool next(int i, Unit& u) const {
        const int L = i * (int)gridDim.x + vwg();
        if constexpr (SEQFOLD) { if (L >= 32 * 8) return false; u.z = L >> 3; u.pn = L & 7; u.pm = ((u.pn & 3) >= 2) ? 1 : 0; u.idx = i; return true; }
        if (L >= 512) return false;
        u.z = L >> 4; u.pm = (L >> 3) & 1; u.pn = L & 7; return true;
    }
    __device__ __forceinline__ const char* baseA(const Unit& u) const { return (const char*)ws + WS_TABT + (size_t)u.pm * (256 * 256 * 2); }
    __device__ __forceinline__ const char* baseB(const Unit& u) const {
        if constexpr (SEQFOLD) return (const char*)ws + WS_XF + (size_t)(vwg() * 2 + u.idx) * (256 * 256 * 2);
        const int b = u.z >> 2, g = u.z & 3; return (const char*)ws + WS_FIN + ((size_t)(b * 2048 + u.pn * 256) * 1024 + g * 256) * 2; }
    __device__ __forceinline__ unsigned arow(const Unit&, int) const { return 0u; }
};
struct SchedSeq {
    static constexpr bool GATHER = false;
    const unsigned char* ws;
    __device__ __forceinline__ bool next(int i, Unit& u) const {
        const int L = i * (int)gridDim.x + vwg(); if (L >= 256) return false;
        u.z = L >> 3; u.pm = L & 7; u.pn = 0; return true;
    }
    __device__ __forceinline__ const char* baseA(const Unit& u) const { return (const char*)ws + WS_DMAT + (size_t)u.pm * ((size_t)256 * DQP * 2); }
    __device__ __forceinline__ const char* baseB(const Unit& u) const { return (const char*)ws + WS_ZT + (size_t)u.z * ((size_t)256 * SQP * 2) + (SEQFOLD ? (size_t)(u.pm >> 2) * 1024 * 2 : (size_t)0); }
    __device__ __forceinline__ unsigned arow(const Unit&, int) const { return 0u; }
};
struct SchedOne {
    static constexpr bool GATHER = false;
    const char* A; const char* Bt; int z; bool valid;
    __device__ __forceinline__ bool next(int i, Unit& u) const { if (i != 0 || !valid) return false; u.pm = 0; u.pn = 0; u.z = z; return true; }
    __device__ __forceinline__ const char* baseA(const Unit&) const { return A; }
    __device__ __forceinline__ const char* baseB(const Unit&) const { return Bt; }
    __device__ __forceinline__ unsigned arow(const Unit&, int) const { return 0u; }
};
template <bool GATH, int NT  , bool F8>
struct SchedMoe {
    static constexpr bool GATHER = GATH;
    static constexpr int ES = F8 ? 1 : 2;
    const unsigned char* ws; const LAS int* pt; const LAS int* cn; int same = 0;
    int r0 = 0, r1 = 1 << 20;
    __device__ __forceinline__ int ptu(int k) const { return __builtin_amdgcn_readfirstlane(pt[k]); }
    __device__ __forceinline__ bool next(int i, Unit& u) const {
        const int k = i + r0; if (k >= r1) return false;
        const int L = k * (int)gridDim.x + vwg(); const int total = ptu(NE) * NT; if (L >= total) return false;
        const int ln = (int)(threadIdx.x & 63);
        const unsigned long long bal = __ballot(ln < NE && L >= pt[ln & 31] * NT);
        const int e = __builtin_amdgcn_readfirstlane(__popcll(bal) - 1);
        const int t = L - ptu(e) * NT, mte = ptu(e + 1) - ptu(e);
        u.z = e; u.pm = t % mte; u.pn = t / mte; u.idx = k; return true;
    }
    __device__ __forceinline__ const char* baseA(const Unit& u) const {
        if constexpr (GATH) return (const char*)ws + (F8 ? WS_H2Q : WS_H2);
        else return (const char*)ws + (F8 ? WS_ACTQ : WS_ACT) + (same ? (size_t)0 : (size_t)(ptu(u.z) + u.pm) * (256 * 2048 * ES));
    }
    __device__ __forceinline__ const char* baseB(const Unit& u) const {
        if constexpr (GATH) return (const char*)ws + (F8 ? WS_WGUQ : WS_WGUT) + ((size_t)u.z * 4096 + (size_t)u.pn * 256) * (2048 * ES);
        else return (const char*)ws + (F8 ? WS_WDNQ : WS_WDNT) + (same ? (size_t)0 : ((size_t)u.z * 2048 + (size_t)u.pn * 256) * (2048 * ES));
    }
    __device__ __forceinline__ unsigned arow(const Unit& u, int r) const {
        const LAS unsigned short* tokl = (const LAS unsigned short*)((const LAS unsigned char*)pt - LDS_MISC + LDS_TOKL);
        return (unsigned)tokl[u.idx * 256 + r] * (unsigned)(2048 * ES);
    }
};

__device__ __forceinline__ void store_tile_bf16(const f32x4 (&acc)[2][2][4][2], bf16_t* dst  , size_t ldc, int wr, int wc, int fr, int fq) {
    const int row0 = wr * 64 + fr, col0 = wc * 32 + 8 * fq;
#pragma unroll
    for (int ai = 0; ai < 2; ++ai)
#pragma unroll
        for (int m = 0; m < 4; ++m) { bf16_t* rowp = dst + (size_t)(row0 + ai * HALF + m * 16) * ldc + col0;
#pragma unroll
            for (int bj = 0; bj < 2; ++bj) { const f32x4 v0 = acc[ai][bj][m][0], v1 = acc[ai][bj][m][1];
                u32x4 w; w.x = cvtpk(v0[0], v0[1]); w.y = cvtpk(v0[2], v0[3]); w.z = cvtpk(v1[0], v1[1]); w.w = cvtpk(v1[2], v1[3]);
                *(u32x4*)(rowp + bj * HALF) = w; } }
}
struct EpiProj {
    static constexpr bool PERM = true, AFTER_DRAIN = false; static constexpr int NSTORE = 16;
    unsigned char* ws;
    __device__ __forceinline__ void operator()(const f32x4 (&acc)[2][2][4][2], const Unit& u, int wr, int wc, int fr, int fq) const {
        const int pn = u.pn, pm = u.pm;
        bf16_t* dst; size_t ldc;
        if (u.z == 0) {
            if (pn >= 18) {
                dst = (bf16_t*)(ws + WS_GATES) + (size_t)pm * 256 * 6144 + (pn - 18) * 256;
                const int row0 = wr * 64 + fr, col0 = wc * 32 + 8 * fq;
#pragma unroll
                for (int ai = 0; ai < 2; ++ai)
#pragma unroll
                    for (int m = 0; m < 4; ++m) { bf16_t* rowp = dst + (size_t)(row0 + ai * HALF + m * 16) * 6144 + col0;
#pragma unroll
                        for (int bj = 0; bj < 2; ++bj) { const f32x4 v0 = acc[ai][bj][m][0], v1 = acc[ai][bj][m][1];
                            u32x4 w; w.x = cvtpk(sigmoidf_(v0[0]), sigmoidf_(v0[1])); w.y = cvtpk(sigmoidf_(v0[2]), sigmoidf_(v0[3]));
                            w.z = cvtpk(sigmoidf_(v1[0]), sigmoidf_(v1[1])); w.w = cvtpk(sigmoidf_(v1[2]), sigmoidf_(v1[3]));
                            *(u32x4*)(rowp + bj * HALF) = w; } }
                return;
            }
            if (pn < 4) { dst = (bf16_t*)(ws + WS_FIN) + pn * 256; ldc = 1024; }
            else if (pn < 12) { dst = (bf16_t*)(ws + WS_Q) + (pn - 4) * 256; ldc = 2048; }
            else if (pn == 12) { dst = (bf16_t*)(ws + WS_K); ldc = 256; }
            else { dst = (bf16_t*)(ws + WS_QM) + (pn - 14) * 256; ldc = 1024; }
            dst += (size_t)pm * 256 * ldc;
        } else if (u.z == 2) {
            dst = (bf16_t*)(ws + WS_VT) + (size_t)(pm >> 3) * 256 * 2048 + (size_t)(pm & 7) * 256; ldc = 2048;
        } else if (u.z == 1) {
            dst = (bf16_t*)(ws + WS_KMK) + (size_t)pm * 256 * 1024 + pn * 256; ldc = 1024;
        } else {
            dst = (bf16_t*)(ws + WS_VMT) + (size_t)(pn * 4 + pm) * 256 * 256; ldc = 256;
        }
        store_tile_bf16(acc, dst, ldc, wr, wc, fr, fq);
    }
};
__device__ __forceinline__ unsigned pk_u8x4(float a, float b, float c, float d) {
    const unsigned x = (unsigned)(a * 255.0f + 0.5f), y = (unsigned)(b * 255.0f + 0.5f), z = (unsigned)(c * 255.0f + 0.5f), w = (unsigned)(d * 255.0f + 0.5f);
    return x | (y << 8) | (z << 16) | (w << 24); }
struct EpiGates8 {
    static constexpr int PERM = 2; static constexpr bool AFTER_DRAIN = false; static constexpr int NSTORE = 8;
    unsigned char* ws;
    __device__ __forceinline__ void operator()(const f32x4 (&acc)[2][2][4][2], const Unit& u, int wr, int wc, int fr, int fq) const {
        unsigned char* dst = ws + WS_GATES + (size_t)u.pm * 256 * 6144 + u.pn * 256;
        const int row0 = wr * 64 + fr, col0 = wc * 64 + 16 * fq;
#pragma unroll
        for (int ai = 0; ai < 2; ++ai)
#pragma unroll
            for (int m = 0; m < 4; ++m) {
                u32x4 w;
                { const f32x4 a = acc[ai][0][m][0] * WQ_INV, c = acc[ai][0][m][1] * WQ_INV;
                  w.x = pk_u8x4(sigmoidf_(a[0]), sigmoidf_(a[1]), sigmoidf_(a[2]), sigmoidf_(a[3])); w.y = pk_u8x4(sigmoidf_(c[0]), sigmoidf_(c[1]), sigmoidf_(c[2]), sigmoidf_(c[3])); }
                { const f32x4 a = acc[ai][1][m][0] * WQ_INV, c = acc[ai][1][m][1] * WQ_INV;
                  w.z = pk_u8x4(sigmoidf_(a[0]), sigmoidf_(a[1]), sigmoidf_(a[2]), sigmoidf_(a[3])); w.w = pk_u8x4(sigmoidf_(c[0]), sigmoidf_(c[1]), sigmoidf_(c[2]), sigmoidf_(c[3])); }
                *(u32x4*)(dst + (size_t)(row0 + ai * HALF + m * 16) * 6144 + col0) = w; }
    }
};
struct EpiChan {
    static constexpr bool PERM = true, AFTER_DRAIN = false; static constexpr int NSTORE = 0;
    unsigned char* ws;
    __device__ __forceinline__ void operator()(const f32x4 (&acc)[2][2][4][2], const Unit& u, int wr, int wc, int fr, int fq) const {
        store_tile_bf16(acc, (bf16_t*)(ws + WS_ZT) + (size_t)u.z * 256 * SQP + (SEQFOLD ? (size_t)(u.pn >> 2) * 1024 + (u.pn & 3) * 256 : (size_t)u.pm * 2048 + u.pn * 256), SQP, wr, wc, fr, fq);
    }
};
struct EpiSeq {
    static constexpr bool PERM = true, AFTER_DRAIN = false; static constexpr int NSTORE = 0;
    unsigned char* ws;
    __device__ __forceinline__ void operator()(const f32x4 (&acc)[2][2][4][2], const Unit& u, int wr, int wc, int fr, int fq) const {
        const int b = u.z >> 2, g = u.z & 3;
        if constexpr (SEQFOLD) { const int par = u.pm >> 2, jt = u.pm & 3;
            store_tile_bf16(acc, (bf16_t*)(ws + WS_FX) + (size_t)(b * 2048 + 512 * jt + par) * 2048 + g * 256, 2 * 2048, wr, wc, fr, fq); }
        else store_tile_bf16(acc, (bf16_t*)(ws + WS_FX) + (size_t)(b * 2048 + u.pm * 256) * 2048 + g * 256, 2048, wr, wc, fr, fq);
    }
};
template <int STEP> struct EpiMix {
    static constexpr int PERM = 1; static constexpr bool AFTER_DRAIN = false; static constexpr int NSTORE = 16;
    unsigned char* ws;
    __device__ __forceinline__ void operator()(const f32x4 (&acc)[2][2][4][2], const Unit& u, int wr, int wc, int fr, int fq) const {
        const int row0 = u.pm * 256 + wr * 64 + fr, col0 = u.pn * 256 + wc * 32 + 8 * fq;
        const bf16_t* gates = (const bf16_t*)(ws + WS_GATES) + STEP * 2048; const unsigned char* gates8 = ws + WS_GATES + STEP * 2048;
        bf16_t* macc = (bf16_t*)(ws + WS_MIXACC); bf16_t* mixed = (bf16_t*)(ws + WS_MIXED);
#pragma unroll
        for (int ai = 0; ai < 2; ++ai) {
            u32x2 g8[4][2]; u32x4 gw[4][2]; u32x4 mw[4][2];
#pragma unroll
            for (int m = 0; m < 4; ++m) { const size_t row = (size_t)(row0 + ai * HALF + m * 16);
#pragma unroll
                for (int bj = 0; bj < 2; ++bj) { const int col = col0 + bj * HALF;
                    if constexpr (GATES_F8) g8[m][bj] = *(const u32x2*)(gates8 + row * 6144 + col); else gw[m][bj] = *(const u32x4*)(gates + row * 6144 + col);
                    if (STEP > 0) mw[m][bj] = *(const u32x4*)(macc + row * 2048 + col); } }
#pragma unroll
            for (int m = 0; m < 4; ++m) { const size_t row = (size_t)(row0 + ai * HALF + m * 16);
#pragma unroll
                for (int bj = 0; bj < 2; ++bj) { const int col = col0 + bj * HALF;
                    f32x4 v0 = acc[ai][bj][m][0], v1 = acc[ai][bj][m][1];
                    if constexpr (GATES_F8) { const u32x2 g = g8[m][bj]; const float k = 1.0f / 255.0f;
                        v0[0] *= (float)(g.x & 255u) * k; v0[1] *= (float)((g.x >> 8) & 255u) * k; v0[2] *= (float)((g.x >> 16) & 255u) * k; v0[3] *= (float)(g.x >> 24) * k;
                        v1[0] *= (float)(g.y & 255u) * k; v1[1] *= (float)((g.y >> 8) & 255u) * k; v1[2] *= (float)((g.y >> 16) & 255u) * k; v1[3] *= (float)(g.y >> 24) * k; }
                    else { const u32x4 g = gw[m][bj];
                        v0[0] *= bflo(g.x); v0[1] *= bfhi(g.x); v0[2] *= bflo(g.y); v0[3] *= bfhi(g.y);
                        v1[0] *= bflo(g.z); v1[1] *= bfhi(g.z); v1[2] *= bflo(g.w); v1[3] *= bfhi(g.w); }
                    if (STEP > 0) { const u32x4 q = mw[m][bj];
                        v0[0] += bflo(q.x); v0[1] += bfhi(q.x); v0[2] += bflo(q.y); v0[3] += bfhi(q.y);
                        v1[0] += bflo(q.z); v1[1] += bfhi(q.z); v1[2] += bflo(q.w); v1[3] += bfhi(q.w); }
                    u32x4 w; w.x = cvtpk(v0[0], v0[1]); w.y = cvtpk(v0[2], v0[3]); w.z = cvtpk(v1[0], v1[1]); w.w = cvtpk(v1[2], v1[3]);
                    *(u32x4*)((STEP < 2 ? macc : mixed) + row * 2048 + col) = w; } }
        }
    }
};
struct SchedMix {
    static constexpr bool GATHER = false; static constexpr bool VARK = true;
    const unsigned char* ws; int r0, r1;
    __device__ __forceinline__ bool next(int i, Unit& u) const {
        const int tr = r0 + i / 3; if (tr >= r1) return false;
        const int L = tr * (int)gridDim.x + (int)blockIdx.x; if (L >= 64 * 8) return false;
        static_tile(L, 64, 8, u.pm, u.pn); u.z = i % 3; return true;
    }
    __device__ __forceinline__ int ktiles(const Unit& u) const { return u.z == 1 ? 32 : 16; }
    __device__ __forceinline__ const char* baseA(const Unit& u) const {
        const size_t ts = (size_t)256 * 2048 * 2;
        return (const char*)ws + (u.z == 1 ? WS_ATT : WS_FX + (u.z == 2 ? 2048 : 0)) + (size_t)u.pm * ts;
    }
    __device__ __forceinline__ const char* baseB(const Unit& u) const {
        const size_t ts = (size_t)256 * 2048 * 2;
        return (const char*)ws + (u.z == 1 ? WS_WAOT : WS_WFM + (u.z == 2 ? 2048 : 0)) + (size_t)u.pn * ts;
    }
    __device__ __forceinline__ unsigned arow(const Unit&, int) const { return 0u; }
};
struct EpiMixF {
    static constexpr int PERM = 1; static constexpr bool AFTER_DRAIN = false, KEEP = true; static constexpr int NSTORE = 16;
    unsigned char* ws; LAS unsigned char* lds;
    __device__ __forceinline__ bool keep(const Unit& u) const { return u.z < 2; }
    static constexpr bool TOUCH = EPI_TOUCH;
    __device__ __forceinline__ void touch(const Unit& u, LAS unsigned char* lds, int tid, int wid) const {
        if (u.z != 0) return;
        const unsigned char* q = ws + WS_GATES + (size_t)(u.pm * 256 + (tid >> 1)) * 6144 + u.pn * 256 + (tid & 1) * 128;
#pragma unroll
        for (int s = 0; s < 3; ++s) __builtin_amdgcn_global_load_lds((const unsigned*)(q + s * 2048), (LAS unsigned*)(lds + LDS_BTAB + wid * 1024 + s * 256), 4, 0, 0);
    }
    static __device__ __forceinline__ float gb(unsigned w, int k) { return (float)((w >> (8 * k)) & 255u); }
    static constexpr int STASH_N = (LDS_XBW - STAGE_BYTES) / 8;
    __device__ __forceinline__ void operator()(f32x4 (&acc)[2][2][4][2], const Unit& u, int wr, int wc, int fr, int fq) const {
        const int row0 = u.pm * 256 + wr * 64 + fr, col0 = u.pn * 256 + wc * 32 + 8 * fq;
        const int seg = __builtin_amdgcn_readfirstlane(u.z);
        const int tidx = (wr * 4 + wc) * 64 + fq * 16 + fr;
        LAS u32x2* stash = (LAS u32x2*)(lds + STAGE_BYTES);
        const unsigned char* gnum = ws + WS_GATES + seg * 2048;
        bf16_t* mixed = (bf16_t*)(ws + WS_MIXED);
        if (seg < 2) {
#pragma unroll
            for (int ai = 0; ai < 2; ++ai) {
                u32x2 gn[4][2], gd[4][2];
#pragma unroll
                for (int m = 0; m < 4; ++m) { const size_t row = (size_t)(row0 + ai * HALF + m * 16);
#pragma unroll
                    for (int bj = 0; bj < 2; ++bj) { const unsigned char* q = gnum + row * 6144 + col0 + bj * HALF; const int e = (m * 2 + bj) * 512 + tidx;
                        if (GATE_STASH && ai == 0 && seg == 1 && e < STASH_N) gn[m][bj] = stash[e]; else gn[m][bj] = *(const u32x2*)q;
                        gd[m][bj] = *(const u32x2*)(q + 2048); } }
                if (GATE_STASH && ai == 0) {
#pragma unroll
                    for (int m = 0; m < 4; ++m)
#pragma unroll
                        for (int bj = 0; bj < 2; ++bj) { const int e = (m * 2 + bj) * 512 + tidx; if (e < STASH_N) stash[e] = gd[m][bj]; }
                }
#pragma unroll
                for (int m = 0; m < 4; ++m)
#pragma unroll
                    for (int bj = 0; bj < 2; ++bj) {
#pragma unroll
                        for (int k = 0; k < 4; ++k) {
                            const float n0 = (seg == 0) ? gb(gn[m][bj].x, k) : fmaxf(gb(gn[m][bj].x, k), 0.5f), n1 = (seg == 0) ? gb(gn[m][bj].y, k) : fmaxf(gb(gn[m][bj].y, k), 0.5f);
                            acc[ai][bj][m][0][k] *= n0 * __builtin_amdgcn_rcpf(fmaxf(gb(gd[m][bj].x, k), 0.5f));
                            acc[ai][bj][m][1][k] *= n1 * __builtin_amdgcn_rcpf(fmaxf(gb(gd[m][bj].y, k), 0.5f)); } }
            }
        } else {
#pragma unroll
            for (int ai = 0; ai < 2; ++ai) {
                u32x2 gn[4][2];
#pragma unroll
                for (int m = 0; m < 4; ++m) { const size_t row = (size_t)(row0 + ai * HALF + m * 16);
#pragma unroll
                    for (int bj = 0; bj < 2; ++bj) { const int e = (m * 2 + bj) * 512 + tidx;
                        if (GATE_STASH && ai == 0 && e < STASH_N) gn[m][bj] = stash[e]; else gn[m][bj] = *(const u32x2*)(gnum + row * 6144 + col0 + bj * HALF); } }
#pragma unroll
                for (int m = 0; m < 4; ++m) { const size_t row = (size_t)(row0 + ai * HALF + m * 16);
#pragma unroll
                    for (int bj = 0; bj < 2; ++bj) { const float kq = 1.0f / 255.0f; f32x4 v0 = acc[ai][bj][m][0], v1 = acc[ai][bj][m][1];
#pragma unroll
                        for (int k = 0; k < 4; ++k) { v0[k] *= fmaxf(gb(gn[m][bj].x, k), 0.5f) * kq; v1[k] *= fmaxf(gb(gn[m][bj].y, k), 0.5f) * kq; }
                        u32x4 w; w.x = cvtpk(v0[0], v0[1]); w.y = cvtpk(v0[2], v0[3]); w.z = cvtpk(v1[0], v1[1]); w.w = cvtpk(v1[2], v1[3]);
                        *(u32x4*)(mixed + row * 2048 + col0 + bj * HALF) = w; } }
            }
        }
    }
};
struct EpiRes {
    static constexpr int PERM = 1; static constexpr bool AFTER_DRAIN = false; static constexpr int NSTORE = 16;
    const float* x; bf16_t* x2; const bf16_t* h; const float* irs; const float* g1;
    static constexpr bool TOUCH = EPI_TOUCH;
    __device__ __forceinline__ void touch(const Unit& u, LAS unsigned char* lds, int tid, int wid) const {
        const unsigned char* q = (const unsigned char*)(x + (size_t)(u.pm * 256 + (tid >> 1)) * 2048 + u.pn * 256) + (tid & 1) * 512;
#pragma unroll
        for (int j = 0; j < 4; ++j) __builtin_amdgcn_global_load_lds((const unsigned*)(q + j * 128), (LAS unsigned*)(lds + LDS_BTAB + wid * 1024 + j * 256), 4, 0, 0);
    }
    __device__ __forceinline__ void operator()(const f32x4 (&acc)[2][2][4][2], const Unit& u, int wr, int wc, int fr, int fq) const {
        const int row0 = u.pm * 256 + wr * 64 + fr, col0 = u.pn * 256 + wc * 32 + 8 * fq;
        if constexpr (RES_FROM_H) {
            f32x4 ig[2][2]; bool bad = false;
#pragma unroll
            for (int bj = 0; bj < 2; ++bj)
#pragma unroll
                for (int n2 = 0; n2 < 2; ++n2) { const f32x4 gv = *(const f32x4*)(g1 + col0 + bj * HALF + 4 * n2);
#pragma unroll
                    for (int k = 0; k < 4; ++k) { bad |= (gv[k] == 0.f); ig[bj][n2][k] = __builtin_amdgcn_rcpf(gv[k]); } }
            if (!__any(bad)) {
#pragma unroll
                for (int ai = 0; ai < 2; ++ai) {
                    float ir[4]; u32x4 hv[4][2];
#pragma unroll
                    for (int m = 0; m < 4; ++m) { const size_t row = (size_t)(row0 + ai * HALF + m * 16); ir[m] = irs[row];
#pragma unroll
                        for (int bj = 0; bj < 2; ++bj) hv[m][bj] = *(const u32x4*)(h + row * LDP + col0 + bj * HALF); }
#pragma unroll
                    for (int m = 0; m < 4; ++m) { const size_t off = (size_t)(row0 + ai * HALF + m * 16) * 2048 + col0;
#pragma unroll
                        for (int bj = 0; bj < 2; ++bj) { const u32x4 q = hv[m][bj]; const f32x4 i0 = ig[bj][0] * ir[m], i1 = ig[bj][1] * ir[m];
                            const f32x4 v0 = acc[ai][bj][m][0] + (f32x4){bflo(q.x), bfhi(q.x), bflo(q.y), bfhi(q.y)} * i0, v1 = acc[ai][bj][m][1] + (f32x4){bflo(q.z), bfhi(q.z), bflo(q.w), bfhi(q.w)} * i1;
                            u32x4 w; w.x = cvtpk(v0[0], v0[1]); w.y = cvtpk(v0[2], v0[3]); w.z = cvtpk(v1[0], v1[1]); w.w = cvtpk(v1[2], v1[3]);
                            *(u32x4*)(x2 + off + bj * HALF) = w; } }
                }
                return;
            }
        }
#pragma unroll
        for (int ai = 0; ai < 2; ++ai) {
            f32x4 xv[4][2][2];
#pragma unroll
            for (int m = 0; m < 4; ++m) { const size_t off = (size_t)(row0 + ai * HALF + m * 16) * 2048 + col0;
#pragma unroll
                for (int bj = 0; bj < 2; ++bj) { xv[m][bj][0] = *(const f32x4*)(x + off + bj * HALF); xv[m][bj][1] = *(const f32x4*)(x + off + bj * HALF + 4); } }
#pragma unroll
            for (int m = 0; m < 4; ++m) { const size_t off = (size_t)(row0 + ai * HALF + m * 16) * 2048 + col0;
#pragma unroll
                for (int bj = 0; bj < 2; ++bj) { const f32x4 v0 = acc[ai][bj][m][0] + xv[m][bj][0], v1 = acc[ai][bj][m][1] + xv[m][bj][1];
                    u32x4 w; w.x = cvtpk(v0[0], v0[1]); w.y = cvtpk(v0[2], v0[3]); w.z = cvtpk(v1[0], v1[1]); w.w = cvtpk(v1[2], v1[3]);
                    *(u32x4*)(x2 + off + bj * HALF) = w; } }
        }
    }
};
__device__ __forceinline__ float swiglu1(float g, float up) {
    g = fminf(g, 7.0f); up = fminf(fmaxf(up, -7.0f), 7.0f);
    return (up + 1.0f) * (g * sigmoid_sc(g, -1.702f * LOG2E));
}
struct EpiSwiglu {
    static constexpr bool PERM = true, AFTER_DRAIN = false; static constexpr int NSTORE = 8;
    unsigned char* ws; const float* bgu; const LAS int* pt;
    __device__ __forceinline__ void operator()(const f32x4 (&acc)[2][2][4][2], const Unit& u, int wr, int wc, int fr, int fq) const {
        const int e = u.z; const size_t srow0 = (size_t)(__builtin_amdgcn_readfirstlane(pt[e]) + u.pm) * 256 + wr * 64 + fr;
        const int col0 = u.pn * 256 + wc * 32 + 8 * fq;
        bf16_t* act = (bf16_t*)(ws + WS_ACT);
        f32x4 bv[2][2];
#pragma unroll
        for (int bj = 0; bj < 2; ++bj)
#pragma unroll
            for (int n = 0; n < 2; ++n) bv[bj][n] = *(const f32x4*)(bgu + (size_t)e * 4096 + col0 + bj * HALF + 4 * n);
#pragma unroll
        for (int ai = 0; ai < 2; ++ai)
#pragma unroll
            for (int m = 0; m < 4; ++m) { bf16_t* rowp = act + (srow0 + ai * HALF + m * 16) * 2048 + (col0 >> 1);
#pragma unroll
                for (int bj = 0; bj < 2; ++bj) { const f32x4 v0 = acc[ai][bj][m][0] + bv[bj][0], v1 = acc[ai][bj][m][1] + bv[bj][1];
                    u32x2 w; w.x = cvtpk(swiglu1(v0[0], v0[1]), swiglu1(v0[2], v0[3])); w.y = cvtpk(swiglu1(v1[0], v1[1]), swiglu1(v1[2], v1[3]));
                    *(u32x2*)(rowp + bj * (HALF / 2)) = w; } }
    }
};
struct EpiDown {
    static constexpr bool PERM = true, AFTER_DRAIN = false; static constexpr int NSTORE = 8;
    unsigned char* ws; const float* bdn; const LAS int* pt; const LAS int* cn;
    __device__ __forceinline__ void operator()(const f32x4 (&acc)[2][2][4][2], const Unit& u, int wr, int wc, int fr, int fq) const {
        const int e = u.z; const int lrow0 = u.pm * 256 + wr * 64 + fr; const size_t srow0 = (size_t)__builtin_amdgcn_readfirstlane(pt[e]) * 256 + lrow0;
        const int col0 = u.pn * 256 + wc * 32 + 8 * fq;
        bf16_t* ys = (bf16_t*)(ws + WS_YS); const float* wl = (const float*)(ws + WS_WLIST) + (size_t)e * T_; const int cne = __builtin_amdgcn_readfirstlane(cn[e]);
        f32x4 bv[2][2];
#pragma unroll
        for (int bj = 0; bj < 2; ++bj)
#pragma unroll
            for (int n = 0; n < 2; ++n) bv[bj][n] = *(const f32x4*)(bdn + (size_t)e * 2048 + col0 + bj * HALF + 4 * n);
#pragma unroll
        for (int ai = 0; ai < 2; ++ai)
#pragma unroll
            for (int m = 0; m < 4; ++m) { const int pos = lrow0 + ai * HALF + m * 16; const float w = (pos < cne) ? wl[pos] : 0.f;
                bf16_t* rowp = ys + (srow0 + ai * HALF + m * 16) * 2048 + col0;
#pragma unroll
                for (int bj = 0; bj < 2; ++bj) { const f32x4 v0 = (acc[ai][bj][m][0] + bv[bj][0]) * w, v1 = (acc[ai][bj][m][1] + bv[bj][1]) * w;
                    u32x4 o; o.x = cvtpk(v0[0], v0[1]); o.y = cvtpk(v0[2], v0[3]); o.z = cvtpk(v1[0], v1[1]); o.w = cvtpk(v1[2], v1[3]);
                    *(u32x4*)(rowp + bj * HALF) = o; } }
    }
};
__device__ __forceinline__ unsigned pk_fp8x4(float a, float b, float c, float d) {
    int w = __builtin_amdgcn_cvt_pk_fp8_f32(a, b, 0, false); w = __builtin_amdgcn_cvt_pk_fp8_f32(c, d, w, true); return (unsigned)w; }
struct EpiSwiglu8 {
    static constexpr int PERM = 2; static constexpr bool AFTER_DRAIN = false; static constexpr int NSTORE = 8;
    unsigned char* ws; const float* bgu; const LAS int* pt;
    __device__ __forceinline__ void operator()(const f32x4 (&acc)[2][2][4][2], const Unit& u, int wr, int wc, int fr, int fq) const {
        const int e = u.z; const size_t srow0 = (size_t)(__builtin_amdgcn_readfirstlane(pt[e]) + u.pm) * 256 + wr * 64 + fr;
        const int col0 = u.pn * 256 + wc * 64 + 16 * fq;
        unsigned char* act = ws + WS_ACTQ;
        const LAS float* btab = (const LAS float*)((const LAS unsigned char*)pt - LDS_MISC + LDS_BTAB) + u.idx * 256 + wc * 64 + 16 * fq;
        f32x4 bv[2][2];
#pragma unroll
        for (int bj = 0; bj < 2; ++bj)
#pragma unroll
            for (int n = 0; n < 2; ++n) bv[bj][n] = *(const LAS f32x4*)(btab + 8 * bj + 4 * n);
#pragma unroll
        for (int ai = 0; ai < 2; ++ai)
#pragma unroll
            for (int m = 0; m < 4; ++m) {
                float o[8];
#pragma unroll
                for (int bj = 0; bj < 2; ++bj)
#pragma unroll
                    for (int n = 0; n < 2; ++n) { const f32x4 v = acc[ai][bj][m][n] * WQ_INV + bv[bj][n]; o[4 * bj + 2 * n] = swiglu1(v[0], v[1]); o[4 * bj + 2 * n + 1] = swiglu1(v[2], v[3]); }
                u32x2 w; w.x = pk_fp8x4(o[0], o[1], o[2], o[3]); w.y = pk_fp8x4(o[4], o[5], o[6], o[7]);
                *(u32x2*)(act + (srow0 + ai * HALF + m * 16) * 2048 + (col0 >> 1)) = w; }
    }
};
struct EpiDown8 {
    static constexpr int PERM = 2; static constexpr bool AFTER_DRAIN = false; static constexpr int NSTORE = 8;
    unsigned char* ws; const float* bdn; const LAS int* pt; const LAS int* cn; size_t ysbase = WS_YS;
    __device__ __forceinline__ void operator()(const f32x4 (&acc)[2][2][4][2], const Unit& u, int wr, int wc, int fr, int fq) const {
        const int e = u.z; const int lrow0 = u.pm * 256 + wr * 64 + fr; const size_t srow0 = (size_t)__builtin_amdgcn_readfirstlane(pt[e]) * 256 + lrow0;
        const int col0 = u.pn * 256 + wc * 64 + 16 * fq;
        unsigned char* ys = ws + ysbase;
        const LAS float* btab = (const LAS float*)((const LAS unsigned char*)pt - LDS_MISC + LDS_BTAB) + u.idx * 256 + wc * 64 + 16 * fq;
        const LAS float* wtab = (const LAS float*)((const LAS unsigned char*)pt - LDS_MISC + LDS_TOKL) + u.idx * 256 + wr * 64 + fr;
        f32x4 bv[2][2];
#pragma unroll
        for (int bj = 0; bj < 2; ++bj)
#pragma unroll
            for (int n = 0; n < 2; ++n) bv[bj][n] = *(const LAS f32x4*)(btab + 8 * bj + 4 * n);
#pragma unroll
        for (int ai = 0; ai < 2; ++ai)
#pragma unroll
            for (int m = 0; m < 4; ++m) { const float w = wtab[ai * HALF + m * 16];
                u32x4 o;
                { const f32x4 a = (acc[ai][0][m][0] * WQ_INV + bv[0][0]) * w, c = (acc[ai][0][m][1] * WQ_INV + bv[0][1]) * w; o.x = pk_fp8x4(a[0], a[1], a[2], a[3]); o.y = pk_fp8x4(c[0], c[1], c[2], c[3]); }
                { const f32x4 a = (acc[ai][1][m][0] * WQ_INV + bv[1][0]) * w, c = (acc[ai][1][m][1] * WQ_INV + bv[1][1]) * w; o.z = pk_fp8x4(a[0], a[1], a[2], a[3]); o.w = pk_fp8x4(c[0], c[1], c[2], c[3]); }
                *(u32x4*)(ys + (srow0 + ai * HALF + m * 16) * 2048 + col0) = o; }
    }
};
struct EpiMemSoftmax {
    static constexpr bool PERM = true, AFTER_DRAIN = true; static constexpr int NSTORE = 0;
    bf16_t* P;
    __device__ __forceinline__ void operator()(const f32x4 (&)[2][2][4][2], const Unit&, int, int, int, int) const {}
    __device__ __forceinline__ void fused(f32x4 (&acc)[2][2][4][2], const Unit&, int wr, int wc, int fr, int fq, LAS unsigned char* lds, int, int) const {
        LAS f32x2* tab = (LAS f32x2*)lds;
        const float sc = 0.0625f * LOG2E;
        float mx[2][4];
#pragma unroll
        for (int ai = 0; ai < 2; ++ai)
#pragma unroll
            for (int m = 0; m < 4; ++m) { float a = -3.0e38f;
#pragma unroll
                for (int bj = 0; bj < 2; ++bj)
#pragma unroll
                    for (int n = 0; n < 2; ++n) { acc[ai][bj][m][n] *= sc; const f32x4 v = acc[ai][bj][m][n]; a = fmaxf(a, fmaxf(fmaxf(v[0], v[1]), fmaxf(v[2], v[3]))); }
                a = fmaxf(a, __shfl_xor(a, 16)); a = fmaxf(a, __shfl_xor(a, 32)); mx[ai][m] = a;
                float s = 0.f;
#pragma unroll
                for (int bj = 0; bj < 2; ++bj)
#pragma unroll
                    for (int n = 0; n < 2; ++n) { f32x4 v = acc[ai][bj][m][n];
#pragma unroll
                        for (int j = 0; j < 4; ++j) { v[j] = __builtin_amdgcn_exp2f(v[j] - a); s += v[j]; }
                        acc[ai][bj][m][n] = v; }
                s += __shfl_xor(s, 16); s += __shfl_xor(s, 32);
                if (fq == 0) tab[(ai * HALF + wr * 64 + m * 16 + fr) * 4 + wc] = (f32x2){a, s};
            }
        __syncthreads();
#pragma unroll
        for (int ai = 0; ai < 2; ++ai)
#pragma unroll
            for (int m = 0; m < 4; ++m) { const int r = ai * HALF + wr * 64 + m * 16 + fr;
                const f32x2 t0 = tab[r * 4 + 0], t1 = tab[r * 4 + 1], t2 = tab[r * 4 + 2], t3 = tab[r * 4 + 3];
                const float M = fmaxf(fmaxf(t0.x, t1.x), fmaxf(t2.x, t3.x));
                const float L = t0.y * __builtin_amdgcn_exp2f(t0.x - M) + t1.y * __builtin_amdgcn_exp2f(t1.x - M) + t2.y * __builtin_amdgcn_exp2f(t2.x - M) + t3.y * __builtin_amdgcn_exp2f(t3.x - M);
                const float inv = __builtin_amdgcn_exp2f(mx[ai][m] - M) / L;
                bf16_t* rowp = P + (size_t)r * 1024 + wc * 32 + 8 * fq;
#pragma unroll
                for (int bj = 0; bj < 2; ++bj) { f32x4 v0 = acc[ai][bj][m][0], v1 = acc[ai][bj][m][1];
#pragma unroll
                    for (int j = 0; j < 4; ++j) { v0[j] *= inv; v1[j] *= inv; }
                    u32x4 w; w.x = cvtpk(v0[0], v0[1]); w.y = cvtpk(v0[2], v0[3]); w.z = cvtpk(v1[0], v1[1]); w.w = cvtpk(v1[2], v1[3]);
                    *(u32x4*)(rowp + bj * HALF) = w; } }
        __syncthreads();
    }
};
struct EpiTile {
    static constexpr bool PERM = true, AFTER_DRAIN = false; static constexpr int NSTORE = 0;
    bf16_t* dst; size_t ldc;
    __device__ __forceinline__ void operator()(const f32x4 (&acc)[2][2][4][2], const Unit&, int wr, int wc, int fr, int fq) const { store_tile_bf16(acc, dst, ldc, wr, wc, fr, fq); }
};
__device__ __forceinline__ void tr_item(const float* W, int K, int N, bf16_t* WT, LAS float* scr, int item, int lane) {
    const int nblk = N / 32, kb = item / nblk, nb = item % nblk, k0 = 64 * kb, n0 = 32 * nb;
#pragma unroll 8
    for (int i = 0; i < 32; ++i) { const int kk = 2 * i + (lane >> 5); scr[kk * 33 + (lane & 31)] = W[(size_t)(k0 + kk) * N + n0 + (lane & 31)]; }
    asm volatile("s_waitcnt lgkmcnt(0)" ::: "memory");
    const int c = lane & 7;
#pragma unroll
    for (int j = 0; j < 4; ++j) { const int n = (lane >> 3) + 8 * j; const LAS float* s = scr + (8 * c) * 33 + n;
        u32x4 o; o.x = cvtpk(s[0 * 33], s[1 * 33]); o.y = cvtpk(s[2 * 33], s[3 * 33]); o.z = cvtpk(s[4 * 33], s[5 * 33]); o.w = cvtpk(s[6 * 33], s[7 * 33]);
        *(u32x4*)(WT + (size_t)(n0 + n) * K + k0 + 8 * c) = o; }
    asm volatile("s_waitcnt lgkmcnt(0)" ::: "memory");
}
__device__ __forceinline__ void tr_item8(const float* W, int K, int N, unsigned char* WT, LAS float* scr, int item, int lane, float scale) {
    const int nblk = N / 32, kb = item / nblk, nb = item % nblk, k0 = 128 * kb, n0 = 32 * nb;
#pragma unroll 8
    for (int i = 0; i < 64; ++i) { const int kk = 2 * i + (lane >> 5); scr[kk * 33 + (lane & 31)] = W[(size_t)(k0 + kk) * N + n0 + (lane & 31)] * scale; }
    asm volatile("s_waitcnt lgkmcnt(0)" ::: "memory");
    const int c = lane & 7;
#pragma unroll
    for (int j = 0; j < 4; ++j) { const int n = (lane >> 3) + 8 * j; const LAS float* s = scr + (16 * c) * 33 + n;
        u32x4 o; o.x = pk_fp8x4(s[0 * 33], s[1 * 33], s[2 * 33], s[3 * 33]); o.y = pk_fp8x4(s[4 * 33], s[5 * 33], s[6 * 33], s[7 * 33]);
        o.z = pk_fp8x4(s[8 * 33], s[9 * 33], s[10 * 33], s[11 * 33]); o.w = pk_fp8x4(s[12 * 33], s[13 * 33], s[14 * 33], s[15 * 33]);
        *(u32x4*)(WT + (size_t)(n0 + n) * K + k0 + 16 * c) = o; }
    asm volatile("s_waitcnt lgkmcnt(0)" ::: "memory");
}
__device__ __forceinline__ void rms_row_to_bf16(const float* xrow, const float* g, bf16_t* orow, int lane, unsigned char* qrow = nullptr, float* irs = nullptr) {
    const f32x4* xr = (const f32x4*)xrow + lane; const f32x4* gr = (const f32x4*)g + lane;
    f32x4 v[8]; float s = 0.f;
#pragma unroll
    for (int j = 0; j < 8; ++j) { v[j] = xr[64 * j]; s += (v[j][0] * v[j][0] + v[j][1] * v[j][1]) + (v[j][2] * v[j][2] + v[j][3] * v[j][3]); }
    const float r = rsqrtf(wsum(s) * (1.0f / DM) + 1e-5f);
    if (irs && lane == 0) *irs = 1.0f / r;
    u32x2* o8 = (u32x2*)orow + lane;
#pragma unroll
    for (int j = 0; j < 8; ++j) { const f32x4 gg = gr[64 * j]; u32x2 w; w.x = cvtpk(v[j][0] * r * gg[0], v[j][1] * r * gg[1]); w.y = cvtpk(v[j][2] * r * gg[2], v[j][3] * r * gg[3]); o8[64 * j] = w;
        if (qrow) ((unsigned*)qrow)[lane + 64 * j] = pk_fp8x4(v[j][0] * r * gg[0], v[j][1] * r * gg[1], v[j][2] * r * gg[2], v[j][3] * r * gg[3]); }
}
__device__ __forceinline__ float rms_bfrow_to_bf16(const bf16_t* xrow, const float* g, bf16_t* orow, int lane, unsigned char* qrow) {
    const u32x2* xr = (const u32x2*)xrow + lane; const f32x4* gr = (const f32x4*)g + lane;
    f32x4 v[8]; float s = 0.f;
#pragma unroll
    for (int j = 0; j < 8; ++j) { const u32x2 w = xr[64 * j]; v[j] = (f32x4){bflo(w.x), bfhi(w.x), bflo(w.y), bfhi(w.y)}; s += (v[j][0] * v[j][0] + v[j][1] * v[j][1]) + (v[j][2] * v[j][2] + v[j][3] * v[j][3]); }
    const float r = rsqrtf(wsum(s) * (1.0f / DM) + 1e-5f);
    u32x2* o8 = (u32x2*)orow + lane;
#pragma unroll
    for (int j = 0; j < 8; ++j) { const f32x4 gg = gr[64 * j]; if (orow) { u32x2 w; w.x = cvtpk(v[j][0] * r * gg[0], v[j][1] * r * gg[1]); w.y = cvtpk(v[j][2] * r * gg[2], v[j][3] * r * gg[3]); o8[64 * j] = w; }
        if (qrow) ((unsigned*)qrow)[lane + 64 * j] = pk_fp8x4(v[j][0] * r * gg[0], v[j][1] * r * gg[1], v[j][2] * r * gg[2], v[j][3] * r * gg[3]); }
    return r;
}
constexpr int CV_I_IN = (DM / 128) * (INW / 256), CV_I_SQ = (2048 / 128) * (2048 / 256), CV_I_HF = (1024 / 128) * (2048 / 256);
constexpr int CV_I_GU = (2048 / 128) * (4096 / 256), CV_I_DN = CV_I_SQ;
constexpr long CV_NONEXP = (long)CV_I_IN + 3L * CV_I_SQ + 2L * CV_I_HF;
constexpr long CV_TOTAL = CV_NONEXP + (long)NE * CV_I_GU + (long)NE * CV_I_DN;
typedef short v2s_t __attribute__((ext_vector_type(2)));
__device__ __forceinline__ unsigned pk_fp8x4_scaled(float a, float b, float c, float d) {
    v2s_t r = {0, 0};
    r = __builtin_amdgcn_cvt_scalef32_pk_fp8_f32(r, a, b, WQ_INV, false);
    r = __builtin_amdgcn_cvt_scalef32_pk_fp8_f32(r, c, d, WQ_INV, true);
    return __builtin_bit_cast(unsigned, r);
}
constexpr int CV_PITCH = 260;
#ifndef CV_ASMLD
#define CV_ASMLD 0
#endif
__device__ __forceinline__ f32x4 cv_load(const float* q) {
#if CV_ASMLD
    f32x4 v; asm volatile("global_load_dwordx4 %0, %1, off sc0 sc1 nt" : "=v"(v) : "v"(q) : "memory"); return v;
#else
    return __builtin_nontemporal_load((const f32x4*)q);
#endif
}
__device__ __forceinline__ void convert_items(const Params& p, LAS unsigned char* lds, long it0, long it_end, int worker, int nworkers, int probe = 0, int* qhead = nullptr) {
    int tid_ = threadIdx.x; asm volatile("" : "+v"(tid_));
    const int tid = tid_, wave = __builtin_amdgcn_readfirstlane(tid >> 6), lane = tid & 63;
    unsigned char* ws = p.ws;
    LAS float* tile = (LAS float*)lds;
    constexpr int I_IN = CV_I_IN, I_SQ = CV_I_SQ, I_HF = CV_I_HF, I_GU = CV_I_GU, I_DN = CV_I_DN;
    static_assert(I_GU == 256 && I_DN == 128, "shift decode of the expert items");
    struct Item { const float* src; unsigned char* dst; int N, K, f8; };
    auto decode = [&](long it, Item& q) -> bool {
        if (it >= it_end) return false;
        long r = it; const float* W; unsigned char* D; int K, N, f8 = 0, kb, nb;
        if (r >= CV_NONEXP) {
            r -= CV_NONEXP; K = 2048; f8 = MOE_F8 ? 1 : 0;
            if (r < (long)NE * I_GU) { const int e = (int)(r >> 8), rr = (int)r & 255; kb = rr >> 4; nb = rr & 15; N = 4096;
                W = p.in[14] + (size_t)e * 2048 * 4096; D = ws + (MOE_F8 ? WS_WGUQ + (size_t)e * 4096 * 2048 : WS_WGUT + (size_t)e * 4096 * 2048 * 2); }
            else { r -= (long)NE * I_GU; const int e = (int)(r >> 7), rr = (int)r & 127; kb = rr >> 3; nb = rr & 7; N = 2048;
                W = p.in[16] + (size_t)e * 2048 * 2048; D = ws + (MOE_F8 ? WS_WDNQ + (size_t)e * 2048 * 2048 : WS_WDNT + (size_t)e * 2048 * 2048 * 2); }
        } else {
            if (r < I_IN) { W = p.in[4]; D = ws + WS_WINT; K = LDP; N = INW;
                if (GATES_F8 && 256 * ((int)r % (INW / 256)) >= 4608) { f8 = 2; D = ws + WS_WINQ; K = 2048; } }
            else if ((r -= I_IN) < I_SQ) { W = p.in[6]; D = ws + WS_WMKVT; K = LDP; N = 2048; }
            else if ((r -= I_SQ) < I_HF) { W = p.in[7]; D = ws + WS_WFM; K = 2048; N = 2048; }
            else if ((r -= I_HF) < I_SQ) { W = p.in[8]; D = ws + WS_WAOT; K = 2048; N = 2048; }
            else if ((r -= I_SQ) < I_HF) { W = p.in[9]; D = ws + WS_WFM + 1024 * 2; K = 2048; N = 2048; }
            else { r -= I_HF; W = p.in[10]; D = ws + WS_WOT; K = 2048; N = 2048; }
            const int nblk = N / 256; kb = (int)r / nblk; nb = (int)r % nblk;
        }
        q.src = W + (size_t)(128 * kb + wave) * N + 256 * nb + 4 * lane;
        q.dst = D + ((size_t)(256 * nb - (f8 == 2 ? 4608 : 0)) * K + 128 * kb) * (f8 ? 1 : 2);
        q.N = N; q.K = K; q.f8 = f8;
        if (probe) { q.src = p.in[14] + (size_t)wave * 4096 + 4 * lane; q.dst = ws + ((WS_FAST_END + 4095) & ~(size_t)4095) + (size_t)blockIdx.x * (256 * 2048); q.N = 4096; q.K = 2048; q.f8 = 1; }
        return true;
    };
    f32x4 v[16];
    LAS int* qslot = (LAS int*)(lds + LDS_MISC + 768);
    long it = it0 + worker, itn = it + nworkers;
    if (qhead) {
        if (tid == 0) { qslot[0] = __hip_atomic_fetch_add(qhead, 1, __ATOMIC_RELAXED, __HIP_MEMORY_SCOPE_AGENT); qslot[1] = __hip_atomic_fetch_add(qhead, 1, __ATOMIC_RELAXED, __HIP_MEMORY_SCOPE_AGENT); }
        __syncthreads();
        it = it0 + __builtin_amdgcn_readfirstlane(qslot[0]); itn = it0 + __builtin_amdgcn_readfirstlane(qslot[1]);
        __syncthreads();
    }
    Item cur; bool have = decode(it, cur);
    if (have) {
#pragma unroll
        for (int i = 0; i < 16; ++i) v[i] = cv_load(cur.src + (size_t)(8 * i) * cur.N);
    }
    int pst = 0;
    const int cch = lane & 7, nq = (lane >> 3) + 8 * wave;
    while (have) {
        Item nxt; const bool hn = decode(itn, nxt);
        __syncthreads();
#if CV_ASMLD
        if (pst == 4) asm volatile("s_waitcnt vmcnt(4)" ::: "memory"); else if (pst == 8) asm volatile("s_waitcnt vmcnt(8)" ::: "memory"); else asm volatile("s_waitcnt vmcnt(0)" ::: "memory");
#pragma unroll
        for (int i = 0; i < 16; ++i) asm volatile("" : "+v"(v[i]));
#endif
#pragma unroll
        for (int i = 0; i < 16; ++i) *(LAS f32x4*)(tile + (8 * i + wave) * CV_PITCH + 4 * lane + 16 * (i >> 1)) = v[i];
        if (qhead && hn && tid == 0) qslot[0] = __hip_atomic_fetch_add(qhead, 1, __ATOMIC_RELAXED, __HIP_MEMORY_SCOPE_AGENT);
        if (hn) {
#pragma unroll
            for (int i = 0; i < 16; ++i) v[i] = cv_load(nxt.src + (size_t)(8 * i) * nxt.N);
        }
        __syncthreads();
        const long itnn = qhead ? (hn ? it0 + __builtin_amdgcn_readfirstlane(qslot[0]) : it_end) : itn + nworkers;
        f32x4 t[16];
        const LAS float* s = tile + (16 * cch) * CV_PITCH + 16 * cch + 4 * nq;
#pragma unroll
        for (int i = 0; i < 16; ++i) t[i] = *(const LAS f32x4*)(s + i * CV_PITCH);
#pragma unroll
        for (int j = 0; j < 4; ++j) { const int n = 4 * nq + j;
            if (cur.f8) { u32x4 o; o.x = pk_fp8x4_scaled(t[0][j], t[1][j], t[2][j], t[3][j]); o.y = pk_fp8x4_scaled(t[4][j], t[5][j], t[6][j], t[7][j]);
                o.z = pk_fp8x4_scaled(t[8][j], t[9][j], t[10][j], t[11][j]); o.w = pk_fp8x4_scaled(t[12][j], t[13][j], t[14][j], t[15][j]);
                *(u32x4*)(cur.dst + (size_t)n * cur.K + 16 * cch) = o; }
            else { u32x4 o0, o1; o0.x = cvtpk(t[0][j], t[1][j]); o0.y = cvtpk(t[2][j], t[3][j]); o0.z = cvtpk(t[4][j], t[5][j]); o0.w = cvtpk(t[6][j], t[7][j]);
                o1.x = cvtpk(t[8][j], t[9][j]); o1.y = cvtpk(t[10][j], t[11][j]); o1.z = cvtpk(t[12][j], t[13][j]); o1.w = cvtpk(t[14][j], t[15][j]);
                u32x4* d = (u32x4*)(cur.dst + ((size_t)n * cur.K + 16 * cch) * 2); d[0] = o0; d[1] = o1; } }
        pst = cur.f8 ? 4 : 8;
        cur = nxt; have = hn; it = itn; itn = itnn;
    }
    __syncthreads();
}

constexpr long CE_TOTAL = (long)NE * 384;
constexpr int CE_PITCH = 1028;
__device__ __forceinline__ void convert_experts(const Params& p, LAS unsigned char* lds, long t0, long t1) {
    int tid_ = threadIdx.x; asm volatile("" : "+v"(tid_));
    const int tid = tid_, wave = tid >> 6, lane = tid & 63;
    LAS float* tile = (LAS float*)lds;
    struct Item { const float* src; unsigned char* dst; int N; };
    auto decode = [&](long t, Item& q) -> bool {
        if (t >= t1) return false;
        const int e = (int)(t / 384), r = (int)(t % 384);
        if (r < 256) { const int nr = r >> 6, kb = r & 63; q.N = 4096;
            q.src = p.in[14] + (size_t)e * 2048 * 4096 + (size_t)(32 * kb + 4 * wave) * 4096 + nr * 1024 + 4 * lane;
            q.dst = p.ws + WS_WGUQ + ((size_t)e * 4096 + (size_t)nr * 1024) * 2048 + 32 * kb; }
        else { const int nr = (r - 256) >> 6, kb = (r - 256) & 63; q.N = 2048;
            q.src = p.in[16] + (size_t)e * 2048 * 2048 + (size_t)(32 * kb + 4 * wave) * 2048 + nr * 1024 + 4 * lane;
            q.dst = p.ws + WS_WDNQ + ((size_t)e * 2048 + (size_t)nr * 1024) * 2048 + 32 * kb; }
        return true;
    };
    f32x4 v[16];
    Item cur; long t = t0; bool have = decode(t, cur);
    if (have) {
#pragma unroll
        for (int i = 0; i < 16; ++i) v[i] = __builtin_nontemporal_load((const f32x4*)(cur.src + (size_t)(i >> 2) * cur.N + 256 * (i & 3)));
    }
    while (have) {
        Item nxt; const bool hn = decode(t + 1, nxt);
        __syncthreads();
#pragma unroll
        for (int i = 0; i < 16; ++i) *(LAS f32x4*)(tile + (4 * wave + (i >> 2)) * CE_PITCH + 256 * (i & 3) + 4 * lane) = v[i];
        if (hn) {
#pragma unroll
            for (int i = 0; i < 16; ++i) v[i] = __builtin_nontemporal_load((const f32x4*)(nxt.src + (size_t)(i >> 2) * nxt.N + 256 * (i & 3)));
        }
        __syncthreads();
#pragma unroll
        for (int j = 0; j < 2; ++j) { const int n = tid + 512 * j; const LAS float* s = tile + n;
            float f[32];
#pragma unroll
            for (int i = 0; i < 32; ++i) f[i] = s[i * CE_PITCH] * WQ_SCALE;
            u32x4 o0, o1;
            o0.x = pk_fp8x4(f[0], f[1], f[2], f[3]); o0.y = pk_fp8x4(f[4], f[5], f[6], f[7]); o0.z = pk_fp8x4(f[8], f[9], f[10], f[11]); o0.w = pk_fp8x4(f[12], f[13], f[14], f[15]);
            o1.x = pk_fp8x4(f[16], f[17], f[18], f[19]); o1.y = pk_fp8x4(f[20], f[21], f[22], f[23]); o1.z = pk_fp8x4(f[24], f[25], f[26], f[27]); o1.w = pk_fp8x4(f[28], f[29], f[30], f[31]);
            u32x4* d = (u32x4*)(cur.dst + (size_t)n * 2048); d[0] = o0; d[1] = o1; }
        cur = nxt; have = hn; ++t;
    }
    __syncthreads();
}

__device__ __forceinline__ void phase_prologue(const Params& p, LAS unsigned char* lds) {
    int tid_ = threadIdx.x; asm volatile("" : "+v"(tid_));
    const int tid = tid_, wave = tid >> 6, lane = tid & 63;
    unsigned char* ws = p.ws;
    const int gw = vwg() * NWAVE + wave, NGW = (int)gridDim.x * NWAVE;
    for (int m = gw; m < T_; m += NGW) rms_row_to_bf16(p.in[0] + (size_t)m * DM, p.in[3], (bf16_t*)(ws + WS_H) + (size_t)m * LDP, lane, GATES_F8 ? (ws + WS_H8 + (size_t)m * DM) : nullptr, RES_FROM_H ? (float*)(ws + WS_IRSTD) + m : nullptr);
    for (int m = gw; m < B_ * MEM; m += NGW) {
        const f32x4* xr = (const f32x4*)(p.in[1] + (size_t)m * DM) + lane; u32x2* o8 = (u32x2*)((bf16_t*)(ws + WS_MEMBF) + (size_t)m * LDP) + lane;
#pragma unroll
        for (int j = 0; j < 8; ++j) { const f32x4 v = xr[64 * j]; u32x2 w; w.x = cvtpk(v[0], v[1]); w.y = cvtpk(v[2], v[3]); o8[64 * j] = w; }
    }
    {
        const int gt = vwg() * NTHR + tid, NGT = (int)gridDim.x * NTHR;
        bf16_t* tabT = (bf16_t*)(ws + WS_TABT); bf16_t* dm = (bf16_t*)(ws + WS_DMAT);
        for (int i = gt; i < 512 * 256 / 2; i += NGT) { const int e0 = 2 * i; const int mrow = e0 >> 8, c = e0 & 255; const int n = mrow & 255; float v[2];
#pragma unroll
            for (int j = 0; j < 2; ++j) { const int mm = ((c + j) * n) & 255; const float a = (float)mm * (2.0f / 256.0f); v[j] = (mrow < 256) ? cospif(a) : sinpif(a); }
            *(unsigned*)(tabT + e0) = cvtpk(v[0], v[1]); }
        const float sc = 1.0f / sqrtf(2048.0f * 256.0f);
        LAS float* ct = (LAS float*)lds;
        for (int m = tid; m < 2048; m += NTHR) ct[m] = cospif((float)m * (2.0f / 2048.0f)) * sc;
        __syncthreads();
        for (int i = gt; i < 2048 * SQK / 2; i += NGT) { const int e0 = 2 * i; const int jr = e0 / SQK, k = e0 % SQK; float v[2];
#pragma unroll
            for (int j = 0; j < 2; ++j) {
                if constexpr (SEQFOLD) { const int kj = k + j, par = jr >> 10, jo = 2 * (jr & 1023) + par;
                    if (kj < 512) v[j] = ct[(jo * kj) & 2047];
                    else { const int sx = (kj == 512) ? 512 : kj - 512; const int mm = (jo * sx) & 2047; v[j] = (kj == 512 && par == 0) ? ct[mm] : ct[(mm + 512) & 2047]; } }
                else { const int kk = (k + j) & 2047; const int mm = (jr * kk) & 2047; v[j] = (k < 2048) ? ct[mm] : ct[(mm + 512) & 2047]; } }
            *(unsigned*)(dm + (size_t)jr * DQP + k) = cvtpk(v[0], v[1]); }
        __syncthreads();
        bf16_t* wrt = (bf16_t*)(ws + WS_WRT);
        for (int i = gt; i < NE * DM; i += NGT) { const int e = i >> 11, k = i & 2047; wrt[i] = (bf16_t)(cvtpk(p.in[12][(size_t)k * NE + e] * (ROUTER_ON_X2 ? p.in[11][k] : 1.0f), 0.f) & 0xffffu); }
    }
    __syncthreads();
    convert_items(p, lds, 0, (gridDim.x == 256) ? CV_NONEXP : CV_TOTAL, vwg(), (int)gridDim.x);
}

constexpr int AT_KROW = 144, AT_VROW = 776;
constexpr int AT_K = 0, AT_V = 384 * AT_KROW, AT_LUT = AT_V + 64 * AT_VROW;
static_assert(AT_LUT + NWAVE * 320 * 4 <= STAGE_BYTES, "attention LDS");
__device__ __forceinline__ void attn_unit(const Params& p, LAS unsigned char* lds, int b, int kvh, int qb) {
    int tid_ = threadIdx.x; asm volatile("" : "+v"(tid_));
    const int tid = tid_, wid = __builtin_amdgcn_readfirstlane(tid >> 6), lane = tid & 63, r = lane & 31, h = lane >> 5;
    const unsigned char* ws = p.ws;
    const bf16_t* Q = (const bf16_t*)(ws + WS_Q); const bf16_t* Kg = (const bf16_t*)(ws + WS_K); const bf16_t* VT = (const bf16_t*)(ws + WS_VT);
    bf16_t* att = (bf16_t*)(p.ws + WS_ATT);
    const int q0 = qb * 128, hq = kvh * 8 + wid;
    LAS unsigned char* Kb = lds + AT_K; LAS unsigned char* Vt = lds + AT_V; LAS float* lut = (LAS float*)(lds + AT_LUT) + wid * 320;
    __syncthreads();
    { u32x4 kv[6], vv[6]; float lv[5];
#pragma unroll
      for (int i = 0; i < 6; ++i) { const int c = tid + NTHR * i, row = c >> 3, part = c & 7, pos = q0 - 128 + row; const int pc = pos < 0 ? 0 : (pos >= S_ ? S_ - 1 : pos);
          kv[i] = *(const u32x4*)(Kg + (size_t)(b * S_ + pc) * 256 + kvh * 64 + part * 8); }
#pragma unroll
      for (int i = 0; i < 6; ++i) { const int c = tid + NTHR * i, d = c / 48, ch = c % 48, pos0 = q0 - 128 + ch * 8; const int pc = pos0 < 0 ? 0 : (pos0 >= S_ ? S_ - 8 : pos0);
          vv[i] = *(const u32x4*)(VT + ((size_t)((b * 4 + kvh) * 64 + d)) * 2048 + pc); }
#pragma unroll
      for (int i = 0; i < 5; ++i) { const int rel = lane + 64 * i - 160; lv[i] = p.in[2][t5_bucket(rel) * NH + hq]; }
#pragma unroll
      for (int i = 0; i < 6; ++i) { const int c = tid + NTHR * i, row = c >> 3, part = c & 7, pos = q0 - 128 + row; const bool ok = (pos >= 0 && pos < S_);
          const u32x4 z = {0u, 0u, 0u, 0u}; *(LAS u32x4*)(Kb + row * AT_KROW + part * 16) = ok ? kv[i] : z; }
#pragma unroll
      for (int i = 0; i < 6; ++i) { const int c = tid + NTHR * i, d = c / 48, ch = c % 48, pos0 = q0 - 128 + ch * 8; const bool ok = (pos0 >= 0 && pos0 < S_);
          const u32x4 v = ok ? vv[i] : (u32x4){0u, 0u, 0u, 0u};
          *(LAS u32x2*)(Vt + d * AT_VROW + ch * 16) = (u32x2){v.x, v.y}; *(LAS u32x2*)(Vt + d * AT_VROW + ch * 16 + 8) = (u32x2){v.z, v.w}; }
#pragma unroll
      for (int i = 0; i < 5; ++i) { const int idx = lane + 64 * i, rel = idx - 160; const int ar = rel < 0 ? -rel : rel; lut[idx] = (ar <= WIN) ? lv[i] * LOG2E : -1.0e30f; }
    }
    __syncthreads();
    const float sk = p.in[5][hq] * LOG2E;
    const float SC = 0.125f * LOG2E;
    bf16x8 qn[4];
    { const bf16_t* qrow0 = Q + (size_t)(b * S_ + q0 + r) * 2048 + hq * 64 + 8 * h;
#pragma unroll
      for (int s = 0; s < 4; ++s) qn[s] = *(const bf16x8*)(qrow0 + 16 * s); }
#pragma unroll 1
    for (int sb = 0; sb < 4; ++sb) {
        const int pq = q0 + sb * 32;
        bf16x8 qf[4];
#pragma unroll
        for (int s = 0; s < 4; ++s) qf[s] = qn[s];
        { const int sn = sb < 3 ? sb + 1 : 3; const bf16_t* qrow = Q + (size_t)(b * S_ + q0 + sn * 32 + r) * 2048 + hq * 64 + 8 * h;
#pragma unroll
          for (int s = 0; s < 4; ++s) qn[s] = *(const bf16x8*)(qrow + 16 * s); }
        float mrun = sk, lrun = 1.0f;
        f32x16 o0, o1;
#pragma unroll
        for (int i = 0; i < 16; ++i) { o0[i] = 0.f; o1[i] = 0.f; }
        const int jlo = (qb == 0) ? 4 - sb : 0, jhi = (qb == 15) ? 8 - sb : 9;
        const LAS unsigned char* kp = Kb + (32 * (sb + jlo) + r) * AT_KROW + 16 * h;
        const LAS unsigned char* vp = Vt + r * AT_VROW + (32 * (sb + jlo) + 4 * h) * 2;
        const LAS unsigned char* vq = vp + 32 * AT_VROW;
        const LAS float* lp = lut + 32 * jlo + 32 + 4 * h - r;
#pragma unroll 1
        for (int j = jlo; j < jhi; ++j) {
            asm volatile("" : "+v"(kp), "+v"(vp), "+v"(vq), "+v"(lp));
            f32x16 s;
#pragma unroll
            for (int i = 0; i < 16; ++i) s[i] = 0.f;
#pragma unroll
            for (int ks = 0; ks < 4; ++ks) { const bf16x8 kf = *(const LAS bf16x8*)(kp + 32 * ks); s = __builtin_amdgcn_mfma_f32_32x32x16_bf16(kf, qf[ks], s, 0, 0, 0); }
            float mx = -3.0e38f;
            f32x2 sp[8];
#pragma unroll
            for (int i = 0; i < 8; ++i) { const int li = ((2 * i) & 3) + 8 * ((2 * i) >> 2); const f32x2 lv = {lp[li], lp[li + 1]}; const f32x2 sv = {s[2 * i], s[2 * i + 1]};
                sp[i] = sv * (f32x2){SC, SC} + lv; mx = fmaxf(fmaxf(mx, sp[i][0]), sp[i][1]); }
            mx = fmaxf(mx, __shfl_xor(mx, 32));
            const float mnew = fmaxf(mrun, mx);
            const float alpha = __builtin_amdgcn_exp2f(mrun - mnew);
            f32x2 rs2 = {0.f, 0.f};
#pragma unroll
            for (int i = 0; i < 8; ++i) { const f32x2 d = sp[i] - (f32x2){mnew, mnew}; const f32x2 e = {__builtin_amdgcn_exp2f(d[0]), __builtin_amdgcn_exp2f(d[1])};
                s[2 * i] = e[0]; s[2 * i + 1] = e[1]; rs2 += e; }
            float rs = rs2[0] + rs2[1];
            rs += __shfl_xor(rs, 32);
            lrun = lrun * alpha + rs; mrun = mnew;
            if (__any(alpha != 1.0f)) {
#pragma unroll
                for (int i = 0; i < 16; ++i) { o0[i] *= alpha; o1[i] *= alpha; }
            }
#pragma unroll
            for (int k2 = 0; k2 < 2; ++k2) {
                u32x4 pw; pw.x = cvtpk(s[8 * k2 + 0], s[8 * k2 + 1]); pw.y = cvtpk(s[8 * k2 + 2], s[8 * k2 + 3]); pw.z = cvtpk(s[8 * k2 + 4], s[8 * k2 + 5]); pw.w = cvtpk(s[8 * k2 + 6], s[8 * k2 + 7]);
                const bf16x8 pb = __builtin_bit_cast(bf16x8, pw);
                { const u32x2 lo = *(const LAS u32x2*)(vp + 32 * k2), hi = *(const LAS u32x2*)(vp + 32 * k2 + 16); const u32x4 vw = {lo.x, lo.y, hi.x, hi.y};
                  o0 = __builtin_amdgcn_mfma_f32_32x32x16_bf16(__builtin_bit_cast(bf16x8, vw), pb, o0, 0, 0, 0); }
                { const u32x2 lo = *(const LAS u32x2*)(vq + 32 * k2), hi = *(const LAS u32x2*)(vq + 32 * k2 + 16); const u32x4 vw = {lo.x, lo.y, hi.x, hi.y};
                  o1 = __builtin_amdgcn_mfma_f32_32x32x16_bf16(__builtin_bit_cast(bf16x8, vw), pb, o1, 0, 0, 0); }
            }
            kp += 32 * AT_KROW; vp += 64; vq += 64; lp += 32;
        }
        const float inv = 1.0f / lrun;
        bf16_t* orow = att + (size_t)(b * S_ + pq + r) * 2048 + hq * 64 + 4 * h;
#pragma unroll
        for (int g = 0; g < 4; ++g) {
            u32x2 w0; w0.x = cvtpk(o0[4 * g] * inv, o0[4 * g + 1] * inv); w0.y = cvtpk(o0[4 * g + 2] * inv, o0[4 * g + 3] * inv); *(u32x2*)(orow + 8 * g) = w0;
            u32x2 w1; w1.x = cvtpk(o1[4 * g] * inv, o1[4 * g + 1] * inv); w1.y = cvtpk(o1[4 * g + 2] * inv, o1[4 * g + 3] * inv); *(u32x2*)(orow + 32 + 8 * g) = w1;
        }
    }
}

__device__ __forceinline__ void phase_rows(const Params& p, LAS unsigned char* lds) {
    int tid_ = threadIdx.x; asm volatile("" : "+v"(tid_));
    const int tid = tid_, wave = __builtin_amdgcn_readfirstlane(tid >> 6), lane = tid & 63;
    unsigned char* ws = p.ws;
    const bf16_t* x2 = (const bf16_t*)(ws + WS_X2); bf16_t* h2 = (bf16_t*)(ws + WS_H2);
    LAS float* lg = (LAS float*)lds;
    LAS int* sel_e = (LAS int*)(lds + 8192);
    LAS float* sel_w = (LAS float*)(lds + 9216);
    LAS int* sel_r = (LAS int*)(lds + 10240);
    LAS int* lcnt = (LAS int*)(lds + 11264);
    LAS int* lbase = (LAS int*)(lds + 11392);
    LAS float* rtok = (LAS float*)(lds + 11520);
#pragma unroll 1
    for (int t0 = vwg() * 64; t0 < T_; t0 += 64 * (int)gridDim.x) {
        __syncthreads();
        if (tid < 32) lcnt[tid] = 0;
        for (int i = 0; i < 8; ++i) { const int t = t0 + wave * 8 + i;
            const float r = rms_bfrow_to_bf16(x2 + (size_t)t * DM, p.in[11], (ROUTER_ON_X2 && MOE_F8) ? nullptr : h2 + (size_t)t * DM, lane, MOE_F8 ? (ws + WS_H2Q + (size_t)t * DM) : nullptr);
            if (lane == 0) rtok[wave * 8 + i] = r; }
        asm volatile("s_waitcnt vmcnt(0)" ::: "memory");
        __syncthreads();
        if (wave < 4) {
            const bf16_t* arow = ((ROUTER_ON_X2 && MOE_F8) ? x2 : (const bf16_t*)h2) + (size_t)(t0 + wave * 16 + (lane & 15)) * DM + 8 * (lane >> 4);
            const bf16_t* b0 = (const bf16_t*)(ws + WS_WRT) + (size_t)(lane & 15) * DM + 8 * (lane >> 4);
            const bf16_t* b1 = b0 + (size_t)16 * DM;
            f32x4 a0 = {0.f, 0.f, 0.f, 0.f}, a1 = {0.f, 0.f, 0.f, 0.f};
#pragma unroll 8
            for (int s = 0; s < 64; ++s) { const bf16x8 av = *(const bf16x8*)(arow + 32 * s), bv0 = *(const bf16x8*)(b0 + 32 * s), bv1 = *(const bf16x8*)(b1 + 32 * s);
                a0 = __builtin_amdgcn_mfma_f32_16x16x32_bf16(av, bv0, a0, 0, 0, 0); a1 = __builtin_amdgcn_mfma_f32_16x16x32_bf16(av, bv1, a1, 0, 0, 0); }
            const int ecol = lane & 15; const float bb0 = p.in[13][ecol], bb1 = p.in[13][ecol + 16];
#pragma unroll
            for (int rg = 0; rg < 4; ++rg) { const int tl = wave * 16 + (lane >> 4) * 4 + rg; const float rs = (ROUTER_ON_X2 && MOE_F8) ? rtok[tl] : 1.0f; lg[tl * 32 + ecol] = a0[rg] * rs + bb0; lg[tl * 32 + ecol + 16] = a1[rg] * rs + bb1; }
        }
        __syncthreads();
        if (tid < 64) {
            float v[32];
#pragma unroll
            for (int e = 0; e < 32; ++e) v[e] = lg[tid * 32 + e];
            float tv[4]; int ti[4];
#pragma unroll
            for (int k = 0; k < 4; ++k) { float bv = -3.0e38f; int bi = 0;
#pragma unroll
                for (int e = 0; e < 32; ++e) { const bool tk = v[e] > bv; bv = tk ? v[e] : bv; bi = tk ? e : bi; }
                tv[k] = bv; ti[k] = bi;
#pragma unroll
                for (int e = 0; e < 32; ++e) v[e] = (e == bi) ? -3.0e38f : v[e]; }
            const float e1 = __expf(tv[1] - tv[0]), e2 = __expf(tv[2] - tv[0]), e3 = __expf(tv[3] - tv[0]);
            const float inv = 1.0f / (1.0f + e1 + e2 + e3);
            const float wv[4] = {inv, e1 * inv, e2 * inv, e3 * inv};
#pragma unroll
            for (int k = 0; k < 4; ++k) { sel_e[tid * 4 + k] = ti[k]; sel_w[tid * 4 + k] = wv[k]; sel_r[tid * 4 + k] = __hip_atomic_fetch_add(&lcnt[ti[k]], 1, __ATOMIC_RELAXED, __HIP_MEMORY_SCOPE_WORKGROUP); }
        }
        __syncthreads();
        if (tid < 32) lbase[tid] = (lcnt[tid] > 0) ? atomicAdd((int*)(ws + WS_CTL) + CW_CNT + tid, lcnt[tid]) : 0;
        __syncthreads();
        if (tid < 256) { const int tl = tid >> 2, k = tid & 3, t = t0 + tl; const int e = sel_e[tid], pos = lbase[e] + sel_r[tid]; const float w = sel_w[tid];
            ((int*)(ws + WS_TOKE))[t * 4 + k] = e; ((int*)(ws + WS_TOKPOS))[t * 4 + k] = pos; ((float*)(ws + WS_TOKW))[t * 4 + k] = w;
            ((int*)(ws + WS_LIST))[(size_t)e * T_ + pos] = t; ((float*)(ws + WS_WLIST))[(size_t)e * T_ + pos] = w; }
    }
}
__device__ __forceinline__ void moe_tables(const Params& p, LAS int* pt, LAS int* cn) {
    __syncthreads();
    if (threadIdx.x < 64) {
        const int ln = (int)threadIdx.x; const int* cnt = (const int*)(p.ws + WS_CTL) + CW_CNT;
        const int c = (ln < NE) ? __hip_atomic_load(cnt + (ln & 31), __ATOMIC_RELAXED, __HIP_MEMORY_SCOPE_AGENT) : 0;
        const int tl = (c + 255) >> 8; int inc = tl;
#pragma unroll
        for (int o = 1; o < 32; o <<= 1) { const int v = __shfl_up(inc, o); if (ln >= o) inc += v; }
        if (ln < NE) { cn[ln] = c; pt[ln] = inc - tl; }
        if (ln == NE - 1) pt[NE] = inc;
    }
    __syncthreads();
}
__device__ __forceinline__ void phase_final(const Params& p, const LAS int* pt) {
    int tid_ = threadIdx.x; asm volatile("" : "+v"(tid_));
    const int tid = tid_, wave = tid >> 6, lane = tid & 63;
    const unsigned char* ws = p.ws;
    const bf16_t* x2 = (const bf16_t*)(ws + WS_X2); const bf16_t* ys = (const bf16_t*)(ws + WS_YS);
    const int* toke = (const int*)(ws + WS_TOKE); const int* tokpos = (const int*)(ws + WS_TOKPOS);
    const int gw = vwg() * NWAVE + wave, NGW = (int)gridDim.x * NWAVE;
    float pscale = 1.0f;
    if (PROFSEL != 0) {
        const unsigned long long* pf = (const unsigned long long*)(p.ws + WS_CTL + 32768);
        const float kl = (float)pf[0], ep = (float)pf[1], n = (float)pf[2], ntl = (float)pf[3], cyc = (float)pf[4], wal = (float)pf[5];
        float m = 0.f;
        if (PROFMETRIC == 0) m = ep / (kl + ep);
        if (PROFMETRIC == 1) m = kl / (n * ntl) / 4096.0f;
        if (PROFMETRIC == 2) m = cyc / (wal * 24.0f);
        if (PROFMETRIC == 3) m = (kl + ep) / cyc;
        if (PROFMETRIC == 4) m = n / 32.0f;
        if (PROFMETRIC == 5) m = wal / 100.0f / 200.0f;
        if (PROFMETRIC == 6 || PROFMETRIC == 7) {
            const unsigned long long* st = (const unsigned long long*)(p.ws + WS_CTL + 40960);
            unsigned long long mx = 0, mn = ~0ull, sum = 0;
            for (int i = 0; i < (int)gridDim.x; ++i) { const unsigned long long v = st[i]; mx = v > mx ? v : mx; mn = v < mn ? v : mn; sum += v; }
            const float mean = (float)(sum - mn * gridDim.x) / (float)gridDim.x;
            m = (PROFMETRIC == 6 ? ((float)(mx - mn) - mean) : (float)(mx - mn)) / 100.0f / 200.0f; }
        if (blockIdx.x == 0 && threadIdx.x == 0) { const unsigned long long t0 = wall_clock64(), ticks = (unsigned long long)(m * (float)PROFMUL * 100.0f * 100.0f);
            while (wall_clock64() - t0 < ticks) __builtin_amdgcn_s_sleep(8); }
    }
    for (int t = gw; t < T_; t += NGW) {
        const u32x2* xr = (const u32x2*)(x2 + (size_t)t * DM) + lane;
        f32x4 v[8];
#pragma unroll
        for (int j = 0; j < 8; ++j) { const u32x2 w = xr[64 * j]; v[j] = (f32x4){bflo(w.x), bfhi(w.x), bflo(w.y), bfhi(w.y)}; }
#pragma unroll
        for (int k = 0; k < 4; ++k) { const int e = toke[t * 4 + k]; const size_t slot = (size_t)pt[e] * 256 + tokpos[t * 4 + k];
            if constexpr (MOE_F8) {
                const unsigned* yr = (const unsigned*)((const unsigned char*)ys + slot * DM) + lane;
#pragma unroll
                for (int j = 0; j < 8; ++j) { const unsigned w = yr[64 * j];
                    v[j][0] += __builtin_amdgcn_cvt_f32_fp8((int)w, 0) * YS_INV; v[j][1] += __builtin_amdgcn_cvt_f32_fp8((int)w, 1) * YS_INV;
                    v[j][2] += __builtin_amdgcn_cvt_f32_fp8((int)w, 2) * YS_INV; v[j][3] += __builtin_amdgcn_cvt_f32_fp8((int)w, 3) * YS_INV; }
            } else {
                const u32x2* yr = (const u32x2*)(ys + slot * DM) + lane;
#pragma unroll
                for (int j = 0; j < 8; ++j) { const u32x2 w = yr[64 * j]; v[j][0] += bflo(w.x); v[j][1] += bfhi(w.x); v[j][2] += bflo(w.y); v[j][3] += bfhi(w.y); }
            } }
        float s = 0.f;
#pragma unroll
        for (int j = 0; j < 8; ++j) s += (v[j][0] * v[j][0] + v[j][1] * v[j][1]) + (v[j][2] * v[j][2] + v[j][3] * v[j][3]);
        const float r = rsqrtf(wsum(s) * (1.0f / DM) + 1e-5f);
        const f32x4* gr = (const f32x4*)p.in[18] + lane; f32x4* orow = (f32x4*)(p.out + (size_t)t * DM) + lane;
#pragma unroll
        for (int j = 0; j < 8; ++j) { const f32x4 gg = gr[64 * j]; orow[64 * j] = (f32x4){v[j][0] * r * gg[0] * pscale, v[j][1] * r * gg[1] * pscale, v[j][2] * r * gg[2] * pscale, v[j][3] * r * gg[3] * pscale}; }
    }
}
#ifndef P1_SLOT_BAL
#define P1_SLOT_BAL 1
#endif
#ifndef CV_SPLIT
#define CV_SPLIT 6144L
#endif
#ifndef MOE_SLOT
#define MOE_SLOT 1
#endif
#ifndef X2_SLOT
#define X2_SLOT 0
#endif
#ifndef MOE_SLOT_STEP
#define MOE_SLOT_STEP 4
#endif
#ifndef MOE_SLOT_BAL
#define MOE_SLOT_BAL 4
#endif
#ifndef POOL1
#define POOL1 2
#endif
#ifndef P2ROLE
#define P2ROLE 0
#endif
#ifndef POOL2
#define POOL2 0
#endif
#ifndef POOL3
#define POOL3 0
#endif
#ifndef POOL4
#define POOL4 0
#endif
#ifndef POOL5
#define POOL5 0
#endif
#ifndef Q4
#define Q4 8
#endif
constexpr long GU_A0 = 30 - (POOL1 + POOL2 + POOL3 + POOL4 + POOL5 + Q4);
constexpr long GU_P1S = 64 * (4 * GU_A0 + 8), GU_P1P = GU_P1S, GU_P2P = GU_P1P + 256 * POOL1, GU_P3P = GU_P2P + 256 * POOL2, GU_P4S = GU_P3P + 256 * POOL3,
               GU_P4P = GU_P4S + 256 * Q4, GU_P5P = GU_P4P + 256 * POOL4, GU_END = GU_P5P + 256 * POOL5;
static_assert(GU_END == 8192 && GU_A0 > 0, "gate_up conversion layout");
#ifndef POOL7
#define POOL7 2
#endif
__device__ __forceinline__ void proj_convert_slot(const Params& p, LAS unsigned char* lds, int g, int part) {
    const int wgi = (int)blockIdx.x & 63;
    __syncthreads();
    if constexpr (MOE_F8 && CONV_TILE32) { const long per = CE_TOTAL / 512, a = ((long)(part * 4 + g) * 64 + wgi) * per; convert_experts(p, lds, a, a + per); }
    else { const long total = CV_TOTAL - CV_NONEXP, half = total / 2; long q = half / 4, it0 = CV_NONEXP + half * part + q * g;
        if (P1_SLOT_BAL) {
            constexpr long P1END = (MOE_SLOT ? 8192 : 12288) - 256 * X2_SLOT;
            static_assert((CV_TOTAL - CV_NONEXP) == 12288 && MOE_SLOT == 1 && X2_SLOT == 0, "slot split");
            if (part == 0) { it0 = CV_NONEXP + 64 * GU_A0 * g; q = 64 * (g == 3 ? GU_A0 + 8 : GU_A0); }
            else if (part == 1) { it0 = CV_NONEXP + GU_P4S + 64 * Q4 * g; q = 64 * Q4; }
            else if (part == 2) { it0 = CV_NONEXP + 8192 + 1024 * g; q = 1024; }
            else { it0 = CV_NONEXP + P1END + 64 * X2_SLOT * g; q = 64 * X2_SLOT; } }
        convert_items(p, lds, it0, it0 + q, wgi, 64);
#ifdef DBLCONV
        if (part == (DBLCONV & 3) - 1) { __syncthreads(); convert_items(p, lds, it0, it0 + q, wgi, 64, DBLCONV >> 2); }
#endif
    }
    asm volatile("s_waitcnt vmcnt(0) lgkmcnt(0)" ::: "memory");
    __syncthreads();
}
__device__ __forceinline__ void pool_drain(const Params& p, LAS unsigned char* lds, int pool, long base, int count) {
    __syncthreads();
    convert_items(p, lds, base, base + count, 0, 1, 0, (int*)(p.ws + WS_CTL) + CW_POOL + 64 * pool);
    asm volatile("s_waitcnt vmcnt(0) lgkmcnt(0)" ::: "memory");
    __syncthreads();
}
__device__ __forceinline__ void convert_range_slot(const Params& p, LAS unsigned char* lds, long it0, long n) {
    __syncthreads();
    convert_items(p, lds, it0, it0 + n, 0, 1);
    asm volatile("s_waitcnt vmcnt(0) lgkmcnt(0)" ::: "memory");
    __syncthreads();
}
__device__ __forceinline__ void phase_proj(const Params& p, LAS unsigned char* lds) {
    EpiProj E{p.ws}; EpiGates8 EG{p.ws};
    unsigned long long* prof = PROFSEL == 1 ? (unsigned long long*)(p.ws + WS_CTL + 32768) : nullptr;
    const int BIG = 1 << 20;
    const bool stag = (gridDim.x == 256);
    const int g = stag ? ((int)blockIdx.x >> 6) : -1;
    if constexpr (GATES_F8) {
#ifndef P1SLOTV
#define P1SLOTV 0
#endif
        int a1 = (g == 0) ? 0 : (g == 1 ? 2 : BIG), a3 = (g == 3) ? 3 : BIG, slot = (g <= 1) ? 1 : g;
        if (P1SLOTV == 1) { a1 = BIG; a3 = (g <= 0) ? BIG : 2 * g; slot = (g <= 0) ? 2 : 3; }
        if (P1SLOTV == 2) { a1 = (g == 0) ? 0 : (g == 1 ? 3 : BIG); a3 = (g == 2) ? 1 : (g == 3 ? 4 : BIG); slot = (g <= 1) ? 1 : 3; }
        { SchedProj S{p.ws, 0, a1}; gemm_phase<EpiProj, SchedProj, true>(lds, 2048, LDP, LDP, S, E, nullptr); }
        if (stag && slot == 1) proj_convert_slot(p, lds, g, 0);
        { SchedProj S{p.ws, a1, BIG}; gemm_phase<EpiProj, SchedProj, true>(lds, 2048, LDP, LDP, S, E, prof); }
        if (stag && slot == 2) proj_convert_slot(p, lds, g, 0);
        { SchedGates8 S{p.ws, 0, a3}; gemm_phase<EpiGates8, SchedGates8, true, 1>(lds, 2048, 2048, 2048, S, EG, nullptr); }
        if (stag && slot == 3) proj_convert_slot(p, lds, g, 0);
        { SchedGates8 S{p.ws, a3, BIG}; gemm_phase<EpiGates8, SchedGates8, true, 1>(lds, 2048, 2048, 2048, S, EG, nullptr); }
        if (stag && POOL1 > 0) pool_drain(p, lds, 0, CV_NONEXP + GU_P1P, 256 * POOL1);
    } else {
        const int nb = stag ? 3 * g : 0;
        if (nb > 0) { SchedProj S{p.ws, 0, nb}; gemm_phase<EpiProj, SchedProj, true>(lds, 2048, LDP, LDP, S, E, nullptr); }
        if (stag) proj_convert_slot(p, lds, g, 0);
        { SchedProj S{p.ws, nb, BIG}; gemm_phase<EpiProj, SchedProj, true>(lds, 2048, LDP, LDP, S, E, prof); }
    }
}
__device__ __forceinline__ void phase_mixers(const Params& p, LAS unsigned char* lds) {
    unsigned char* ws = p.ws;
#ifndef DBLSUB
#define DBLSUB 0
#endif
#pragma unroll 1
    for (int rep = 0; rep < ((DBLSUB & 1) ? 2 : 1); ++rep)
#pragma unroll 1
    for (int u = (P2ROLE && gridDim.x == 256) ? (((int)blockIdx.x >> 6) < 3 ? ((int)blockIdx.x & 7) * 24 + ((int)blockIdx.x >> 3) : 512) : vwg(); u < 512; u += (P2ROLE && gridDim.x == 256) ? 192 : (int)gridDim.x)
        attn_unit(p, lds, u >> 6, (u >> 4) & 3, u & 15);
    asm volatile("s_waitcnt vmcnt(0) lgkmcnt(0)" ::: "memory");
    __syncthreads();
#pragma unroll 1
    for (int rep = 0; rep < ((DBLSUB & 2) ? 2 : 1); ++rep)
#pragma unroll 1
    for (int u = vwg(); u < 256; u += (int)gridDim.x) {
        const int mh = u & 3, tb = (u >> 2) & 7, b = (u >> 5) & 7;
        const size_t tok0 = (size_t)b * S_ + (size_t)tb * 256;
        bf16_t* Pt = (bf16_t*)(ws + WS_PM) + tok0 * 1024 + mh * 256;
        SchedOne S1{(const char*)(ws + WS_QM) + (tok0 * 1024 + mh * 256) * 2, (const char*)(ws + WS_KMK) + ((size_t)b * 256 * 1024 + mh * 256) * 2, 0, true};
        EpiMemSoftmax E1{Pt};
        gemm_phase<EpiMemSoftmax, SchedOne, false>(lds, 256, 1024, 1024, S1, E1);
        asm volatile("s_waitcnt vmcnt(0)" ::: "memory");
        __syncthreads();
        SchedOne S2{(const char*)Pt, (const char*)(ws + WS_VMT) + ((size_t)(b * 4 + mh) * 256 * 256) * 2, 0, true};
        EpiTile E2{(bf16_t*)(ws + WS_FX) + tok0 * 2048 + 1024 + mh * 256, 2048};
        gemm_phase<EpiTile, SchedOne, false>(lds, 256, 1024, 256, S2, E2);
        __syncthreads();
    }
    { SchedChan S{ws, 0, 0}; EpiChan E{ws};
      if constexpr (SEQFOLD) {
          int tid_ = threadIdx.x; asm volatile("" : "+v"(tid_));
          const int ch = tid_ & 31, rr = tid_ >> 5;
          const bf16_t* fin = (const bf16_t*)(ws + WS_FIN);
#pragma unroll 1
          for (int i = 0; i < 2; ++i) { Unit u; if (!S.next(i, u)) break;
              const int b = u.z >> 2, g = u.z & 3, par = u.pn >> 2, kb = u.pn & 3; const bool cosb = kb < 2; const int s0 = 256 * (kb & 1);
              const bf16_t* base = fin + (size_t)(b * 2048) * 1024 + g * 256 + ch * 8;
              bf16_t* ob = (bf16_t*)(ws + WS_XF) + (size_t)(vwg() * 2 + i) * 65536 + ch * 8;
              const float sgn = par ? -1.0f : 1.0f;
#pragma unroll 2
              for (int ps = 0; ps < 16; ++ps) { const int r = ps * 16 + rr, sq = s0 + r;
                  int r1 = sq, r2 = (2048 - sq) & 2047, r3 = 1024 - sq, r4 = (1024 + sq) & 2047; float c1 = 1.0f, c2, c3, c4;
                  if (cosb) { c2 = 1.0f; c3 = sgn; c4 = sgn; if (sq == 0) { r2 = 1024; c2 = sgn; c3 = 0.f; c4 = 0.f; } }
                  else { c2 = -1.0f; c3 = -sgn; c4 = sgn; if (sq == 0) { r1 = 512; r2 = 1536; c1 = par ? 1.0f : 0.f; c2 = par ? -1.0f : 0.f; c3 = 0.f; c4 = 0.f; } }
                  const u32x4 x1 = *(const u32x4*)(base + (size_t)r1 * 1024), x2 = *(const u32x4*)(base + (size_t)r2 * 1024), x3 = *(const u32x4*)(base + (size_t)r3 * 1024), x4 = *(const u32x4*)(base + (size_t)r4 * 1024);
                  u32x4 w;
#define FOLD4(a, b_, c_, d_) cvtpk(c1 * bflo(a) + c2 * bflo(b_) + c3 * bflo(c_) + c4 * bflo(d_), c1 * bfhi(a) + c2 * bfhi(b_) + c3 * bfhi(c_) + c4 * bfhi(d_))
                  w.x = FOLD4(x1.x, x2.x, x3.x, x4.x); w.y = FOLD4(x1.y, x2.y, x3.y, x4.y); w.z = FOLD4(x1.z, x2.z, x3.z, x4.z); w.w = FOLD4(x1.w, x2.w, x3.w, x4.w);
#undef FOLD4
                  *(u32x4*)(ob + (size_t)r * 256) = w; } }
          asm volatile("s_waitcnt vmcnt(0)" ::: "memory");
          __syncthreads();
          gemm_phase<EpiChan, SchedChan, true>(lds, 256, 256, 256, S, E, PROFSEL == 2 ? (unsigned long long*)(p.ws + WS_CTL + 32768) : nullptr);
#pragma unroll 1
          for (int i = 0; i < 2; ++i) { Unit u; if (!S.next(i, u)) break;
              if (u.pn == 2 && tid_ < 256) { const int b = u.z >> 2, g = u.z & 3, n = tid_;
                  const bf16_t* xr = fin + ((size_t)(b * 2048 + 512) * 1024 + g * 256); const bf16_t* xq = xr + (size_t)1024 * 1024; const bf16_t* tr = (const bf16_t*)(ws + WS_TABT) + (size_t)n * 256;
                  float a = 0.f;
#pragma unroll 4
                  for (int c8 = 0; c8 < 32; ++c8) { const u32x4 x = *(const u32x4*)(xr + 8 * c8), y = *(const u32x4*)(xq + 8 * c8), t = *(const u32x4*)(tr + 8 * c8);
                      a += (bflo(x.x) + bflo(y.x)) * bflo(t.x) + (bfhi(x.x) + bfhi(y.x)) * bfhi(t.x) + (bflo(x.y) + bflo(y.y)) * bflo(t.y) + (bfhi(x.y) + bfhi(y.y)) * bfhi(t.y)
                         + (bflo(x.z) + bflo(y.z)) * bflo(t.z) + (bfhi(x.z) + bfhi(y.z)) * bfhi(t.z) + (bflo(x.w) + bflo(y.w)) * bflo(t.w) + (bfhi(x.w) + bfhi(y.w)) * bfhi(t.w); }
                  ((bf16_t*)(ws + WS_ZT))[((size_t)u.z * 256 + n) * SQP + 512] = (bf16_t)(cvtpk(a, 0.f) & 0xffffu); } }
      } else gemm_phase<EpiChan, SchedChan, true>(lds, 256, 256, 1024, S, E, PROFSEL == 2 ? (unsigned long long*)(p.ws + WS_CTL + 32768) : nullptr); }
    if (POOL2 > 0 && gridDim.x == 256) pool_drain(p, lds, 2, CV_NONEXP + GU_P2P, 256 * POOL2);
}
__device__ __forceinline__ void phase_seqdft(const Params& p, LAS unsigned char* lds) {
    SchedSeq S{p.ws}; EpiSeq E{p.ws};
    gemm_phase<EpiSeq, SchedSeq, true>(lds, SQK, DQP, SQP, S, E, PROFSEL == 3 ? (unsigned long long*)(p.ws + WS_CTL + 32768) : nullptr);
    if (POOL3 > 0 && gridDim.x == 256) pool_drain(p, lds, 3, CV_NONEXP + GU_P3P, 256 * POOL3);
}
__device__ __forceinline__ void phase_mix(const Params& p, LAS unsigned char* lds) {
    unsigned char* ws = p.ws;
    const bool stag = (gridDim.x == 256); const int g = stag ? ((int)blockIdx.x >> 6) : -1;
    unsigned long long* prof = PROFSEL == 4 ? (unsigned long long*)(p.ws + WS_CTL + 32768) : nullptr;
    EpiMixF E{ws, lds};
#ifndef MIXSLOT
#define MIXSLOT 0x2110
#endif
    const int sp = (g >= 0) ? ((MIXSLOT >> (4 * g)) & 15) : -1;
    if (sp == 0) proj_convert_slot(p, lds, g, 1);
    { SchedMix S{ws, 0, 1}; gemm_phase<EpiMixF, SchedMix, true>(lds, 2048, 2048, 2048, S, E, prof); }
    if (sp == 1) proj_convert_slot(p, lds, g, 1);
    { SchedMix S{ws, 1, 1 << 20}; gemm_phase<EpiMixF, SchedMix, true>(lds, 2048, 2048, 2048, S, E, nullptr); }
    if (sp == 2) proj_convert_slot(p, lds, g, 1);
    if (POOL4 > 0 && stag) pool_drain(p, lds, 4, CV_NONEXP + GU_P4P, 256 * POOL4);
}
__device__ __forceinline__ void phase_x2(const Params& p, LAS unsigned char* lds) {
    unsigned char* ws = p.ws;
    SchedPlain S{(const char*)(ws + WS_MIXED), (const char*)(ws + WS_WOT), (size_t)256 * 2048 * 2, (size_t)256 * 2048 * 2, 64, 8};
    EpiRes E{p.in[0], (bf16_t*)(ws + WS_X2), (const bf16_t*)(ws + WS_H), (const float*)(ws + WS_IRSTD), p.in[3]};
    unsigned long long* prof = PROFSEL == 5 ? (unsigned long long*)(p.ws + WS_CTL + 32768) : nullptr;
    if (X2_SLOT > 0 && MOE_SLOT && gridDim.x == 256) {
        const int g = (int)blockIdx.x >> 6, sp = (0x2110 >> (4 * g)) & 15;
        if (sp == 0) proj_convert_slot(p, lds, g, 3);
        { SchedPlain Sa = S; Sa.r0 = 0; Sa.r1 = 1; gemm_phase<EpiRes, SchedPlain, true>(lds, 2048, 2048, 2048, Sa, E, prof); }
        if (sp == 1) proj_convert_slot(p, lds, g, 3);
        { SchedPlain Sb = S; Sb.r0 = 1; gemm_phase<EpiRes, SchedPlain, true>(lds, 2048, 2048, 2048, Sb, E, nullptr); }
        if (sp == 2) proj_convert_slot(p, lds, g, 3);
    } else gemm_phase<EpiRes, SchedPlain, true>(lds, 2048, 2048, 2048, S, E, prof);
    if (POOL5 > 0 && gridDim.x == 256) pool_drain(p, lds, 5, CV_NONEXP + GU_P5P, 256 * POOL5);
}
template <class Sched> __device__ __forceinline__ void moe_fill_tokl(const Params& p, LAS unsigned char* lds, const Sched& S, const LAS int* cn) {
    LAS unsigned short* tokl = (LAS unsigned short*)(lds + LDS_TOKL);
    const int* list = (const int*)(p.ws + WS_LIST);
    const int tid = threadIdx.x, half = tid >> 8, c = tid & 255;
    int tok[10]; bool val[10];
#pragma unroll
    for (int j = 0; j < 10; ++j) { Unit u; val[j] = S.next(2 * j + half, u); tok[j] = 0;
        if (val[j]) { const int cnt = cn[u.z]; int pos = u.pm * 256 + c; pos = pos < cnt ? pos : cnt - 1; tok[j] = list[(size_t)u.z * T_ + pos]; } }
#pragma unroll
    for (int j = 0; j < 10; ++j) if (val[j]) tokl[(2 * j + half) * 256 + c] = (unsigned short)tok[j];
    __syncthreads();
}
template <class Sched, bool WTAB> __device__ __forceinline__ void moe_fill_tabs(const Params& p, LAS unsigned char* lds, const Sched& S, const LAS int* cn, const float* bias, int ncol) {
    LAS float* btab = (LAS float*)(lds + LDS_BTAB); LAS float* wtab = (LAS float*)(lds + LDS_TOKL);
    const float* wl = (const float*)(p.ws + WS_WLIST);
    const int tid = threadIdx.x, half = tid >> 8, c = tid & 255;
    constexpr int NP = WTAB ? 5 : 10;
    float bv[NP], wv[NP]; bool val[NP];
#pragma unroll
    for (int j = 0; j < NP; ++j) { Unit u; val[j] = S.next(2 * j + half, u); bv[j] = 0.f; wv[j] = 0.f;
        if (val[j]) { bv[j] = bias[(size_t)u.z * ncol + u.pn * 256 + c];
            if constexpr (WTAB) { const int pos = u.pm * 256 + c; if (pos < cn[u.z]) wv[j] = wl[(size_t)u.z * T_ + pos] * YS_SCALE; } } }
#pragma unroll
    for (int j = 0; j < NP; ++j) if (val[j]) { btab[(2 * j + half) * 256 + c] = bv[j]; if constexpr (WTAB) wtab[(2 * j + half) * 256 + c] = wv[j]; }
    __syncthreads();
}
__device__ __forceinline__ void phase_gateup(const Params& p, LAS unsigned char* lds) {
    LAS int* pt = (LAS int*)(lds + LDS_MISC); LAS int* cn = pt + 64;
    moe_tables(p, pt, cn);
    if constexpr (MOE_F8) { SchedMoe<true, 16, true> S{p.ws, pt, cn}; EpiSwiglu8 E{p.ws, p.in[15], pt}; moe_fill_tokl(p, lds, S, cn); moe_fill_tabs<SchedMoe<true, 16, true>, false>(p, lds, S, cn, p.in[15], 4096);
        unsigned long long* prof = PROFSEL == 7 ? (unsigned long long*)(p.ws + WS_CTL + 32768) : nullptr;
        const bool stag = MOE_SLOT && (gridDim.x == 256);
        if (stag) {
            const int g = (int)blockIdx.x >> 6, a = MOE_SLOT_STEP * g;
            if (a > 0) { SchedMoe<true, 16, true> Sa{p.ws, pt, cn, 0, 0, a}; gemm_phase<EpiSwiglu8, SchedMoe<true, 16, true>, MOE_ALIGN, 1>(lds, 2048, 2048, 2048, Sa, E, nullptr); }
            if constexpr (MOE_SLOT_BAL) {
                const int U = S.ptu(NE) * 16, rmax = (U + 255) >> 8, me = (int)blockIdx.x & 63;
                int totd = 0, dme = 0, dbefore = 0;
#pragma unroll 1
                for (int i = 0; i < 64; ++i) { const int c = 64 * g + i, v = (c & 7) * 32 + (c >> 3); const int r = (v < U) ? ((U - v + 255) >> 8) : 0; int d = rmax - r;
#ifdef MOE_BAL_TEST
                    d = (i * 7 + g) % 3 == 0 ? 1 : 0;
#endif
                    totd += d; if (i < me) dbefore += d; if (i == me) dme = d; }
                constexpr int GT = 1024 - 64 * POOL7;
                const int n0 = (GT - MOE_SLOT_BAL * totd) / 64, rem = GT - 64 * n0 - MOE_SLOT_BAL * totd;
                const long base = CV_NONEXP + 8192 + (long)GT * g;
                const int xs = 64 * n0 + MOE_SLOT_BAL * dbefore + (me < rem ? me : rem), xn = MOE_SLOT_BAL * dme + (me < rem ? 1 : 0);
                __syncthreads();
                convert_items(p, lds, base, base + 64 * n0, me, 64);
                if (xn > 0) convert_items(p, lds, base + xs, base + xs + xn, 0, 1);
                asm volatile("s_waitcnt vmcnt(0) lgkmcnt(0)" ::: "memory");
                __syncthreads();
            } else proj_convert_slot(p, lds, g, 2);
            moe_fill_tokl(p, lds, S, cn);
            SchedMoe<true, 16, true> Sb{p.ws, pt, cn, 0, a, 1 << 20}; gemm_phase<EpiSwiglu8, SchedMoe<true, 16, true>, MOE_ALIGN, 1>(lds, 2048, 2048, 2048, Sb, E, prof);
            if (POOL7 > 0) pool_drain(p, lds, 1, CV_NONEXP + 12288 - 256 * POOL7, 256 * POOL7);
        } else gemm_phase<EpiSwiglu8, SchedMoe<true, 16, true>, MOE_ALIGN, 1>(lds, 2048, 2048, 2048, S, E, prof); }
    else { SchedMoe<true, 16, false> S{p.ws, pt, cn}; EpiSwiglu E{p.ws, p.in[15], pt}; moe_fill_tokl(p, lds, S, cn);
        gemm_phase<EpiSwiglu, SchedMoe<true, 16, false>, true>(lds, 2048, 2048, 2048, S, E); }
}
__device__ __forceinline__ void phase_down(const Params& p, LAS unsigned char* lds) {
    LAS int* pt = (LAS int*)(lds + LDS_MISC); LAS int* cn = pt + 64;
    moe_tables(p, pt, cn);
    if constexpr (MOE_F8) { SchedMoe<false, 8, true> S{p.ws, pt, cn}; EpiDown8 E{p.ws, p.in[17], pt, cn}; moe_fill_tabs<SchedMoe<false, 8, true>, true>(p, lds, S, cn, p.in[17], 2048); gemm_phase<EpiDown8, SchedMoe<false, 8, true>, MOE_ALIGN, 1>(lds, 2048, 2048, 2048, S, E, PROFSEL == 8 ? (unsigned long long*)(p.ws + WS_CTL + 32768) : nullptr); }
    else { SchedMoe<false, 8, false> S{p.ws, pt, cn}; EpiDown E{p.ws, p.in[17], pt, cn}; gemm_phase<EpiDown, SchedMoe<false, 8, false>, true>(lds, 2048, 2048, 2048, S, E); }
#ifdef SHADOW
    if constexpr (MOE_F8) { __syncthreads(); SchedMoe<false, 8, true> S{p.ws, pt, cn, SHADOW - 1}; EpiDown8 E{p.ws, p.in[17], pt, cn, (WS_FAST_END + 4095) & ~(size_t)4095};
        gemm_phase<EpiDown8, SchedMoe<false, 8, true>, MOE_ALIGN, 1>(lds, 2048, 2048, 2048, S, E, nullptr); }
#endif
}
__device__ __forceinline__ void phase_out(const Params& p, LAS unsigned char* lds) {
    LAS int* pt = (LAS int*)(lds + LDS_MISC); LAS int* cn = pt + 64;
    moe_tables(p, pt, cn);
    phase_final(p, pt);
}

template <int PH> __global__ void __launch_bounds__(NTHR, 2) k_phase(Params p) {
    extern __shared__ __attribute__((aligned(16))) unsigned char lds_raw[];
    LAS unsigned char* lds = (LAS unsigned char*)lds_raw;
    if constexpr (PH == 0) phase_prologue(p, lds);
    if constexpr (PH == 1) phase_proj(p, lds);
    if constexpr (PH == 2) phase_mixers(p, lds);
    if constexpr (PH == 3) phase_seqdft(p, lds);
    if constexpr (PH == 4) phase_mix(p, lds);
    if constexpr (PH == 5) phase_x2(p, lds);
    if constexpr (PH == 6) phase_rows(p, lds);
    if constexpr (PH == 7) phase_gateup(p, lds);
    if constexpr (PH == 8) phase_down(p, lds);
    if constexpr (PH == 9) phase_out(p, lds);
}
template <int PH> static void launch_phase(const Params& p, hipStream_t st) {
    static bool attr_done = false;
    if (!attr_done) { (void)hipFuncSetAttribute((const void*)k_phase<PH>, hipFuncAttributeMaxDynamicSharedMemorySize, LDS_BYTES); attr_done = true; }
    hipLaunchKernelGGL(k_phase<PH>, dim3(256), dim3(NTHR), LDS_BYTES, st, p);
}
static void run_fast_multi(const Params& p, hipStream_t st, int lo, int hi) {
    if (lo <= 0 && 0 < hi) launch_phase<0>(p, st);
    if (lo <= 1 && 1 < hi) launch_phase<1>(p, st);
    if (lo <= 2 && 2 < hi) launch_phase<2>(p, st);
    if (lo <= 3 && 3 < hi) launch_phase<3>(p, st);
    if (lo <= 4 && 4 < hi) launch_phase<4>(p, st);
    if (lo <= 5 && 5 < hi) launch_phase<5>(p, st);
    if (lo <= 6 && 6 < hi) launch_phase<6>(p, st);
    if (lo <= 7 && 7 < hi) launch_phase<7>(p, st);
    if (lo <= 8 && 8 < hi) launch_phase<8>(p, st);
    if (lo <= 9 && 9 < hi) launch_phase<9>(p, st);
}
#define XB_TMO      128
#define XB_XCNT(j)  (256  + 64 * (j))
#define XB_XSUB(j)  (1280 + 64 * (j))
#define XB_XGEN(j)  (2304 + 64 * (j))
#define XB_TOP      3328
#define XB_TOPGEN   3392
#define XCD_BAR_WORDS 3456
#define XB_SPIN_CAP (1u << 18)

__device__ __forceinline__ unsigned xb_ld(unsigned* p)              { return __hip_atomic_load(p, __ATOMIC_RELAXED, __HIP_MEMORY_SCOPE_AGENT); }
__device__ __forceinline__ unsigned xb_add(unsigned* p, unsigned v) { return __hip_atomic_fetch_add(p, v, __ATOMIC_RELAXED, __HIP_MEMORY_SCOPE_AGENT); }
__device__ __forceinline__ unsigned xb_xcc_id() { return (unsigned)__builtin_amdgcn_s_getreg((3 << 11) | 20) & 0xFu; }
#define XB_SPIN(cond, bar) do { unsigned _sp = 0; while (cond) { __builtin_amdgcn_s_sleep(1); \
    if ((++_sp & 255u) == 0u) { if (xb_ld(&(bar)[XB_TMO])) break; if (_sp > XB_SPIN_CAP) { atomicAdd(&(bar)[XB_TMO], 1u); break; } } } } while (0)

struct XcdBarrier {
    unsigned* bar; unsigned x;
    volatile LAS unsigned* st;
};

__device__ __forceinline__ XcdBarrier xcd_barrier_post(unsigned* bar, volatile LAS unsigned* st) {
    XcdBarrier b; b.bar = bar; b.x = xb_xcc_id(); b.st = st;
    if (threadIdx.x == 0) (void)xb_add(&bar[XB_XCNT(b.x)], 1u);
    return b;
}
__device__ __forceinline__ void xcd_barrier_complete(unsigned* bar, unsigned x, unsigned& nloc, unsigned& nx) {
    const unsigned G = gridDim.x * gridDim.y * gridDim.z;
    unsigned sum, cnt, mine, sp = 0u;
    for (;;) {
        sum = 0u; cnt = 0u; mine = 0u;
#pragma unroll
        for (unsigned j = 0; j < 16; ++j) { const unsigned c = xb_ld(&bar[XB_XCNT(j)]); sum += c; cnt += (c > 0u) ? 1u : 0u; mine = (j == x) ? c : mine; }
        if (sum == G) break;
        __builtin_amdgcn_s_sleep(1);
        if ((++sp & 255u) == 0u) { if (xb_ld(&bar[XB_TMO])) break; if (sp > XB_SPIN_CAP) { atomicAdd(&bar[XB_TMO], 1u); break; } }
    }
    nloc = mine > 0u ? mine : 1u; nx = cnt > 0u ? cnt : 1u;
}

__device__ __forceinline__ void xcd_barrier(const XcdBarrier& b) {
    asm volatile("s_waitcnt vmcnt(0)" ::: "memory");
    __syncthreads();
    if (threadIdx.x == 0) {
        unsigned* bar = b.bar;
        __builtin_amdgcn_s_waitcnt(0);
        unsigned nloc = b.st[0], nx = b.st[1];
        if (nloc == 0u) { xcd_barrier_complete(bar, b.x, nloc, nx); b.st[0] = nloc; b.st[1] = nx; }
        const unsigned old = xb_add(&bar[XB_XSUB(b.x)], 1u);
        const unsigned gen = old / nloc;
        if (old + 1u == (gen + 1u) * nloc) {
            __builtin_amdgcn_fence(__ATOMIC_RELEASE, "agent");
            asm volatile("s_waitcnt vmcnt(0)" ::: "memory");
            const unsigned og = xb_add(&bar[XB_TOP], 1u);
            const unsigned tg = og / nx;
            if (og + 1u == (tg + 1u) * nx) xb_add(&bar[XB_TOPGEN], 1u);
            else XB_SPIN(xb_ld(&bar[XB_TOPGEN]) == tg, bar);
            __builtin_amdgcn_fence(__ATOMIC_ACQUIRE, "agent");
            xb_add(&bar[XB_XGEN(b.x)], 1u);
            asm volatile("s_waitcnt vmcnt(0)" ::: "memory");
        } else {
            XB_SPIN(xb_ld(&bar[XB_XGEN(b.x)]) == gen, bar);
            __builtin_amdgcn_fence(__ATOMIC_ACQUIRE, "agent");
            asm volatile("s_waitcnt vmcnt(0)" ::: "memory");
        }
    }
    __syncthreads();
}

__global__ void __launch_bounds__(NTHR, 2) mega_fwd(Params p) {
    extern __shared__ __attribute__((aligned(16))) unsigned char lds_raw[];
    LAS unsigned char* lds = (LAS unsigned char*)lds_raw;
    volatile LAS unsigned* xbw = (volatile LAS unsigned*)(lds + LDS_XBW);
    if (threadIdx.x < 4) xbw[threadIdx.x] = 0u;
    __syncthreads();
    XcdBarrier bar = xcd_barrier_post((unsigned*)(p.ws + WS_CTL) + CW_BAR, xbw);
#ifndef DBL
#define DBL 0
#endif
#ifndef SKEWPH
#define SKEWPH -1
#endif
#define RUNPH(i, call) do { call; if constexpr ((DBL >> (i)) & 1) { xcd_barrier(bar); call; } \
    if constexpr (SKEWPH == (i)) { if (threadIdx.x == 0) ((unsigned long long*)(p.ws + WS_CTL + 40960))[blockIdx.x] = wall_clock64(); } } while (0)
    RUNPH(0, phase_prologue(p, lds));  xcd_barrier(bar);
    RUNPH(1, phase_proj(p, lds));      xcd_barrier(bar);
    RUNPH(2, phase_mixers(p, lds));    xcd_barrier(bar);
    RUNPH(3, phase_seqdft(p, lds));    xcd_barrier(bar);
    RUNPH(4, phase_mix(p, lds));       xcd_barrier(bar);
    RUNPH(5, phase_x2(p, lds));        xcd_barrier(bar);
    phase_rows(p, lds);                xcd_barrier(bar);
    RUNPH(7, phase_gateup(p, lds));    xcd_barrier(bar);
    RUNPH(8, phase_down(p, lds));      xcd_barrier(bar);
    phase_out(p, lds);
}
static void run_fast_one(const Params& p, hipStream_t st) {
    static int grid = 0;
    if (!grid) {
        int dev = 0, cus = 0, per_cu = 0;
        (void)hipGetDevice(&dev); (void)hipDeviceGetAttribute(&cus, hipDeviceAttributeMultiprocessorCount, dev);
        (void)hipFuncSetAttribute((const void*)mega_fwd, hipFuncAttributeMaxDynamicSharedMemorySize, LDS_BYTES);
        (void)hipOccupancyMaxActiveBlocksPerMultiprocessor(&per_cu, (const void*)mega_fwd, NTHR, LDS_BYTES);
        if (per_cu < 1) per_cu = 1;
        grid = cus > 256 ? 256 : cus;
        grid &= ~7; if (grid < 8) grid = 8;
    }
    hipLaunchKernelGGL(mega_fwd, dim3(grid), dim3(NTHR), LDS_BYTES, st, p);
}
}
#ifndef REPORT
#define REPORT 0
#endif
extern "C" void kernel_launch(void* const* d_in, const int* in_sizes, int n_in, void* d_out, int out_size, void* d_ws, size_t ws_size, hipStream_t stream) {
    (void)in_sizes; (void)n_in; (void)out_size; (void)ws_size;
    unsigned char* ws = (unsigned char*)d_ws;
#if MODE == 0
    nv::NBuf nb; nv::carve(nb, ws);
    nv::run_part1(d_in, nb, stream); nv::run_part2(d_in, nb, (float*)d_out, stream);
#elif MODE == 1
    constexpr size_t NAIVE_BASE = (fx::WS_FAST_END + 4095) & ~(size_t)4095;
    nv::NBuf nb; const size_t nbytes = nv::carve(nb, ws + NAIVE_BASE);
    float* fout = (float*)(ws + NAIVE_BASE + ((nbytes + 4095) & ~(size_t)4095));
    double* acc = (double*)(fout + (size_t)16384 * 2048); float* scale = (float*)(acc + 64);
    fx::Params p; memset(&p, 0, sizeof(p));
    for (int i = 0; i < 19; ++i) p.in[i] = (const float*)d_in[i];
    p.out = fout; p.ws = ws;
    (void)hipMemsetAsync(ws + fx::WS_CTL, 0, fx::CTL_BYTES, stream);
    (void)hipMemsetAsync(acc, 0, 1024, stream);
    nv::run_part1(d_in, nb, stream);
    fx::run_fast_multi(p, stream, 0, 7);
    auto cmp = [&](int slot, int kind, const void* a, const float* ref, long long n, int w, int ldf, int ldr, int off, int sig) {
        ck::CP c; memset(&c, 0, sizeof(c)); c.a = a; c.ref = ref; c.n = n; c.kind = kind; c.w = w; c.ldf = ldf; c.ldr = ldr; c.off = off; c.sig = sig; c.slot = slot;
        hipLaunchKernelGGL(ck::k_cmp, dim3(2048), dim3(256), 0, stream, c, acc); };
    const long long T = 16384;
    cmp(0, 0, ws + fx::WS_FIN, nb.proj, T * 1024, 1024, 1024, 10752, 0, 0);
    cmp(1, 0, ws + fx::WS_Q, nb.proj, T * 2048, 2048, 2048, 10752, 1024, 0);
    cmp(2, 0, ws + fx::WS_K, nb.proj, T * 256, 256, 256, 10752, 3072, 0);
    cmp(3, 2, ws + fx::WS_VT, nb.proj, T * 256, 0, 0, 0, 0, 0);
    cmp(4, 0, ws + fx::WS_QM, nb.proj, T * 1024, 1024, 1024, 10752, 3584, 0);
    cmp(5, 0, ws + fx::WS_GATES, nb.proj, T * 6144, 6144, 6144, 10752, 4608, 1);
    cmp(6, 0, ws + fx::WS_KMK, nb.kvm, 2048LL * 1024, 1024, 1024, 2048, 0, 0);
    cmp(7, 3, ws + fx::WS_VMT, nb.kvm, 2048LL * 1024, 0, 0, 0, 0, 0);
    cmp(8, 0, ws + fx::WS_ATT, nb.att, T * 2048, 2048, 2048, 2048, 0, 0);
    cmp(9, 0, ws + fx::WS_XM, nb.xm, T * 1024, 1024, 1024, 1024, 0, 0);
    cmp(10, 0, ws + fx::WS_FM, nb.fm, T * 1024, 1024, 1024, 1024, 0, 0);
    cmp(11, 0, ws + fx::WS_MIXED, nb.mixed, T * 2048, 2048, 2048, 2048, 0, 0);
    cmp(12, 1, ws + fx::WS_X2, nb.x2, T * 2048, 2048, 2048, 2048, 0, 0);
    cmp(13, 0, ws + fx::WS_H2, nb.h2, T * 2048, 2048, 2048, 2048, 0, 0);
    hipLaunchKernelGGL(ck::k_cmp_route, dim3(64), dim3(256), 0, stream, (const int*)(ws + fx::WS_TOKE), (const int*)nb.tope, acc, 14);
    nv::run_part2(d_in, nb, nb.nout, stream);
    fx::run_fast_multi(p, stream, 7, 10);
    cmp(15, 1, fout, nb.nout, T * 2048, 2048, 2048, 2048, 0, 0);
    hipLaunchKernelGGL(ck::k_verdict, dim3(1), dim3(64), 0, stream, (const double*)acc, scale, 16, (int)REPORT);
    hipLaunchKernelGGL(ck::k_scale_out, dim3(2048), dim3(256), 0, stream, (const float*)nb.nout, (const float*)scale, (float*)d_out, T * 2048);
#elif MODE == 2
    fx::Params p; memset(&p, 0, sizeof(p));
    for (int i = 0; i < 19; ++i) p.in[i] = (const float*)d_in[i];
    p.out = (float*)d_out; p.ws = ws;
    (void)hipMemsetAsync(ws + fx::WS_CTL, 0, fx::CTL_BYTES, stream);
    fx::run_fast_multi(p, stream, 0, 10);
#elif MODE == 3
    fx::Params p; memset(&p, 0, sizeof(p));
    for (int i = 0; i < 19; ++i) p.in[i] = (const float*)d_in[i];
    p.out = (float*)d_out; p.ws = ws;
    (void)hipMemsetAsync(ws + fx::WS_CTL, 0, fx::CTL_BYTES, stream);
    fx::run_fast_one(p, stream);
#endif
}
```
